# Optimizing an MI355X kernel written in HIP

```python
import math
import jax, jax.numpy as jnp
from jax import lax
import numpy as np

D_MODEL = 1024
BATCH = 8
SEQ = 4096
DEPTH = 2

CHUNK = 64
NORM_EPS = 1e-6

RWKV_HEAD_SIZE = 64
RWKV_WIDTH = D_MODEL
RWKV_HEADS = RWKV_WIDTH // RWKV_HEAD_SIZE
DECAY_LORA = 64
ICLR_LORA = 64
VRES_LORA = 32
GATE_LORA = 160
RWKV_GN_EPS = 64e-5

SSD_WIDTH = 2 * D_MODEL
SSD_HEAD_DIM = 64
SSD_HEADS = SSD_WIDTH // SSD_HEAD_DIM
SSD_STATE = 128
SSD_GROUPS = 4
SSD_CONV = 4
SSD_CONV_CH = SSD_WIDTH + 2 * SSD_GROUPS * SSD_STATE

PEER_HEADS = 8
PEER_NKEYS = 128
PEER_EXPERTS = PEER_NKEYS * PEER_NKEYS
PEER_TOPK = 16
PEER_QDIM = 256
PEER_TOKEN_BLOCK = 128

RWKV_SPLITS = (RWKV_WIDTH, RWKV_WIDTH, RWKV_WIDTH, DECAY_LORA, ICLR_LORA, GATE_LORA)
RWKV_PROJ = sum(RWKV_SPLITS)
SSD_SPLITS = (SSD_WIDTH, SSD_CONV_CH, SSD_HEADS)
SSD_PROJ = sum(SSD_SPLITS)
GATE_PROJ = 2 * D_MODEL
IN_PROJ = RWKV_PROJ + SSD_PROJ + GATE_PROJ

kernel_name = 'hybrid_rwkv7_ssd_peer_block'


def rmsnorm(x, g):
    xf = x.astype(jnp.float32)
    y = xf * lax.rsqrt(jnp.mean(xf * xf, axis=-1, keepdims=True) + NORM_EPS)
    return (y * g.astype(jnp.float32)).astype(x.dtype)


def split_last(t, sizes):
    out, start = [], 0
    for s in sizes:
        out.append(t[..., start:start + s])
        start += s
    return out


def shift_prev(x):
    return jnp.pad(x, ((0, 0), (1, 0), (0, 0)))[:, :-1]


def causal_depthwise_conv(x, w, b):
    T = x.shape[1]
    xp = jnp.pad(x, ((0, 0), (SSD_CONV - 1, 0), (0, 0)))
    y = b
    for j in range(SSD_CONV):
        y = y + xp[:, j:j + T] * w[j]
    return y


def rwkv7_recurrence(r, w, k, v, a, b):
    Bsz, T, H, N = r.shape

    def step(S, inp):
        r_t, w_t, k_t, v_t, a_t, b_t = inp
        sa = jnp.einsum('bhvk,bhk->bhv', S, a_t)
        S = S * w_t[:, :, None, :] + sa[..., None] * b_t[:, :, None, :] + v_t[..., None] * k_t[:, :, None, :]
        return S, jnp.einsum('bhvk,bhk->bhv', S, r_t)

    xs = tuple(jnp.moveaxis(t.astype(jnp.float32), 1, 0) for t in (r, w, k, v, a, b))
    _, ys = lax.scan(step, jnp.zeros((Bsz, H, N, N), jnp.float32), xs)
    return jnp.moveaxis(ys, 0, 1)


def rwkv7_time_mix(p, v_first, vres, mu, w0, w2, a0, a2, g2, k_k, k_a, r_k, ln_w, ln_b, w_branch):
    Bsz, T, _ = p.shape
    H, N = RWKV_HEADS, RWKV_HEAD_SIZE
    p = p + (shift_prev(p) - p) * mu
    r, k, v, wd, ad, gd = split_last(p, RWKV_SPLITS)
    w_log = -jax.nn.softplus(-(w0 + jnp.tanh(wd) @ w2).astype(jnp.float32)) - 0.5
    decay = jnp.exp(-jnp.exp(w_log))
    a = jax.nn.sigmoid(a0 + ad @ a2)
    g = jax.nn.sigmoid(gd) @ g2
    if vres is None:
        v_first = v
    else:
        v0, v1, v2 = vres
        v = v + (v_first - v) * jax.nn.sigmoid(v0 + (v @ v1) @ v2)
    heads = lambda t: t.reshape(Bsz, T, H, N)
    r, k, v, a, decay = heads(r), heads(k), heads(v), heads(a), heads(decay)
    kk = (k * k_k.reshape(H, N)).astype(jnp.float32)
    kk = kk * lax.rsqrt(jnp.sum(kk * kk, axis=-1, keepdims=True) + 1e-12)
    k = k * (1.0 + (a - 1.0) * k_a.reshape(H, N))
    y = rwkv7_recurrence(r, decay, k, v, -kk, kk * a)
    mean = jnp.mean(y, axis=-1, keepdims=True)
    var = jnp.mean(jnp.square(y - mean), axis=-1, keepdims=True)
    y = (y - mean) * lax.rsqrt(var + RWKV_GN_EPS) * ln_w.reshape(H, N) + ln_b.reshape(H, N)
    y = y + jnp.sum(r * k * r_k, axis=-1, keepdims=True) * v
    y = y.reshape(Bsz, T, RWKV_WIDTH).astype(p.dtype) * g
    return y @ w_branch, v_first


def ssd_chunked_scan(X, a, Bm, Cm):
    Bsz, T, H, P = X.shape
    G, N = Bm.shape[2], Bm.shape[3]
    Hg = H // G
    nc = T // CHUNK
    to_chunks = lambda t: jnp.moveaxis(t.reshape(Bsz, nc, CHUNK, *t.shape[2:]), 1, 0)
    Xc = to_chunks(X.reshape(Bsz, T, G, Hg, P))
    ac = to_chunks(a.reshape(Bsz, T, G, Hg))
    Bc, Cc = to_chunks(Bm), to_chunks(Cm)
    causal = jnp.tril(jnp.ones((CHUNK, CHUNK), dtype=bool))[None, :, :, None, None]

    def step(state, inp):
        x_c, a_c, b_c, c_c = inp
        acs = jnp.cumsum(a_c.astype(jnp.float32), axis=1)
        seg = acs[:, :, None] - acs[:, None, :]
        Lmat = jnp.exp(jnp.where(causal, seg, -jnp.inf))
        cb = jnp.einsum('bign,bjgn->bijg', c_c, b_c)
        y_diag = jnp.einsum('bijgh,bjghp->bighp', Lmat * cb[..., None], x_c)
        y_off = jnp.einsum('bign,bghpn->bighp', c_c, state) * jnp.exp(acs)[..., None]
        decay_to_end = jnp.exp(acs[:, -1:] - acs)
        state = state * jnp.exp(acs[:, -1])[..., None, None] + jnp.einsum('bjgn,bjgh,bjghp->bghpn', b_c, decay_to_end, x_c)
        return state, y_diag + y_off

    state0 = jnp.zeros((Bsz, G, Hg, P, N), jnp.float32)
    _, ys = lax.scan(step, state0, (Xc, ac, Bc, Cc))
    return jnp.moveaxis(ys, 0, 1).reshape(Bsz, T, H, P)


def ssd_mixer(p, conv_w, conv_b, dt_bias, A_log, D_skip, norm_g, w_branch):
    Bsz, T, _ = p.shape
    z, xbc, dt_raw = split_last(p, SSD_SPLITS)
    xbc = jax.nn.silu(causal_depthwise_conv(xbc, conv_w, conv_b))
    xs, Bm, Cm = split_last(xbc, (SSD_WIDTH, SSD_GROUPS * SSD_STATE, SSD_GROUPS * SSD_STATE))
    dt = jax.nn.softplus((dt_raw + dt_bias).astype(jnp.float32))
    A = -jnp.exp(A_log.astype(jnp.float32))
    xh = xs.reshape(Bsz, T, SSD_HEADS, SSD_HEAD_DIM)
    y = ssd_chunked_scan(xh * dt[..., None], dt * A,
                         Bm.reshape(Bsz, T, SSD_GROUPS, SSD_STATE),
                         Cm.reshape(Bsz, T, SSD_GROUPS, SSD_STATE))
    y = y + xh * D_skip[:, None]
    y = y.reshape(Bsz, T, SSD_WIDTH) * jax.nn.silu(z)
    gs = SSD_WIDTH // SSD_GROUPS
    y = rmsnorm(y.reshape(Bsz, T, SSD_GROUPS, gs), norm_g.reshape(SSD_GROUPS, gs))
    return y.reshape(Bsz, T, SSD_WIDTH).astype(p.dtype) @ w_branch


def peer_ffn(u, w_q, sub_keys, expert_down, expert_up):
    Bsz, T, D = u.shape
    half = PEER_QDIM // 2
    blocks = u.reshape(-1, PEER_TOKEN_BLOCK, D)

    def block_fn(xb):
        q = (xb @ w_q).reshape(PEER_TOKEN_BLOCK, PEER_HEADS, 2, half)
        s = jnp.einsum('thcd,hckd->thck', q, sub_keys).astype(jnp.float32)
        top_s, top_i = lax.top_k(s, PEER_TOPK)
        cand_s = (top_s[:, :, 0, :, None] + top_s[:, :, 1, None, :]).reshape(PEER_TOKEN_BLOCK, PEER_HEADS, -1)
        cand_i = (top_i[:, :, 0, :, None] * PEER_NKEYS + top_i[:, :, 1, None, :]).reshape(PEER_TOKEN_BLOCK, PEER_HEADS, -1)
        best_s, best_pos = lax.top_k(cand_s, PEER_TOPK)
        idx = jnp.take_along_axis(cand_i, best_pos, axis=-1)
        gate = jax.nn.softmax(best_s, axis=-1)
        act = jax.nn.gelu(jnp.einsum('td,thkd->thk', xb, expert_down[idx]).astype(jnp.float32))
        return jnp.einsum('thk,thkd->td', (gate * act).astype(xb.dtype), expert_up[idx])

    return lax.map(block_fn, blocks).reshape(Bsz, T, D)


def setup_inputs(seed: int = 0) -> dict:
    key = jax.random.key(seed)
    ks = iter(jax.random.split(key, 40))
    nrm = lambda shape, scale: jax.random.normal(next(ks), shape, jnp.float32) * scale
    uni = lambda shape, lo, hi: jax.random.uniform(next(ks), shape, jnp.float32, lo, hi)
    L, D = DEPTH, D_MODEL
    dt_init = jnp.exp(uni((L, SSD_HEADS), math.log(1e-3), math.log(1e-1)))
    dt_bias = dt_init + jnp.log(-jnp.expm1(-dt_init))
    return {
        'x': nrm((BATCH, SEQ, D), 1.0),
        'norm_mix_g': 1.0 + nrm((L, D), 0.02),
        'w_in': nrm((L, D, IN_PROJ), D ** -0.5),
        'rwkv_mu': uni((L, RWKV_PROJ), 0.0, 1.0),
        'rwkv_w0': uni((L, RWKV_WIDTH), -5.0, 1.0),
        'rwkv_w2': nrm((L, DECAY_LORA, RWKV_WIDTH), 0.1 * DECAY_LORA ** -0.5),
        'rwkv_a0': nrm((L, RWKV_WIDTH), 0.1),
        'rwkv_a2': nrm((L, ICLR_LORA, RWKV_WIDTH), 0.1 * ICLR_LORA ** -0.5),
        'rwkv_g2': nrm((L, GATE_LORA, RWKV_WIDTH), GATE_LORA ** -0.5),
        'rwkv_v0': 1.0 + nrm((L - 1, RWKV_WIDTH), 0.1),
        'rwkv_v1': nrm((L - 1, RWKV_WIDTH, VRES_LORA), RWKV_WIDTH ** -0.5),
        'rwkv_v2': nrm((L - 1, VRES_LORA, RWKV_WIDTH), VRES_LORA ** -0.5),
        'rwkv_k_k': 0.85 + nrm((L, RWKV_WIDTH), 0.05),
        'rwkv_k_a': 1.0 + nrm((L, RWKV_WIDTH), 0.05),
        'rwkv_r_k': nrm((L, RWKV_HEADS, RWKV_HEAD_SIZE), 0.1),
        'rwkv_ln_w': 1.0 + nrm((L, RWKV_WIDTH), 0.02),
        'rwkv_ln_b': nrm((L, RWKV_WIDTH), 0.02),
        'w_rwkv_branch': nrm((L, RWKV_WIDTH, D), RWKV_WIDTH ** -0.5),
        'ssd_conv_w': nrm((L, SSD_CONV, SSD_CONV_CH), 0.5),
        'ssd_conv_b': nrm((L, SSD_CONV_CH), 0.02),
        'ssd_dt_bias': dt_bias,
        'ssd_A_log': jnp.log(uni((L, SSD_HEADS), 1.0, 16.0)),
        'ssd_D': 1.0 + nrm((L, SSD_HEADS), 0.1),
        'ssd_norm_g': 1.0 + nrm((L, SSD_WIDTH), 0.02),
        'w_ssd_branch': nrm((L, SSD_WIDTH, D), SSD_WIDTH ** -0.5),
        'w_out': nrm((L, D, D), D ** -0.5),
        'norm_ffn_g': 1.0 + nrm((L, D), 0.02),
        'peer_w_q': nrm((L, D, PEER_HEADS * PEER_QDIM), D ** -0.5),
        'peer_sub_keys': nrm((L, PEER_HEADS, 2, PEER_NKEYS, PEER_QDIM // 2), (PEER_QDIM // 2) ** -0.5),
        'peer_down': nrm((L, PEER_EXPERTS, D), D ** -0.5),
        'peer_up': nrm((L, PEER_EXPERTS, D), PEER_HEADS ** -0.5),
        'norm_final_g': 1.0 + nrm((D,), 0.02),
    }


def reference(x, norm_mix_g, w_in, rwkv_mu, rwkv_w0, rwkv_w2, rwkv_a0, rwkv_a2, rwkv_g2,
              rwkv_v0, rwkv_v1, rwkv_v2, rwkv_k_k, rwkv_k_a, rwkv_r_k, rwkv_ln_w, rwkv_ln_b,
              w_rwkv_branch, ssd_conv_w, ssd_conv_b, ssd_dt_bias, ssd_A_log, ssd_D, ssd_norm_g,
              w_ssd_branch, w_out, norm_ffn_g, peer_w_q, peer_sub_keys, peer_down, peer_up,
              norm_final_g):
    h = x
    v_first = None
    for l in range(DEPTH):
        u = rmsnorm(h, norm_mix_g[l])
        proj = u @ w_in[l]
        p_rwkv, p_ssd, gates = split_last(proj, (RWKV_PROJ, SSD_PROJ, GATE_PROJ))
        vres = None if l == 0 else (rwkv_v0[l - 1], rwkv_v1[l - 1], rwkv_v2[l - 1])
        y_a, v_first = rwkv7_time_mix(p_rwkv, v_first, vres, rwkv_mu[l], rwkv_w0[l], rwkv_w2[l],
                                      rwkv_a0[l], rwkv_a2[l], rwkv_g2[l], rwkv_k_k[l], rwkv_k_a[l],
                                      rwkv_r_k[l], rwkv_ln_w[l], rwkv_ln_b[l], w_rwkv_branch[l])
        y_b = ssd_mixer(p_ssd, ssd_conv_w[l], ssd_conv_b[l], ssd_dt_bias[l], ssd_A_log[l], ssd_D[l],
                        ssd_norm_g[l], w_ssd_branch[l])
        g_a, g_b = split_last(gates, (D_MODEL, D_MODEL))
        mixed = jax.nn.sigmoid(g_a) * y_a + jax.nn.sigmoid(g_b) * y_b
        h = h + mixed @ w_out[l]
        h = h + peer_ffn(rmsnorm(h, norm_ffn_g[l]), peer_w_q[l], peer_sub_keys[l], peer_down[l], peer_up[l])
    return rmsnorm(h, norm_final_g)
```

```cpp
#include <hip/hip_runtime.h>
#include <cstdio>
#include <cstdint>

#ifndef PROBE_DUP
#define PROBE_DUP 0
#endif
#ifndef MK_MULTI
#define MK_MULTI 0
#endif

#define GAS __attribute__((address_space(1)))
#define LAS __attribute__((address_space(3)))
typedef unsigned short bf16;
typedef unsigned v4u __attribute__((ext_vector_type(4)));
typedef unsigned v2u __attribute__((ext_vector_type(2)));
typedef float f32x4 __attribute__((ext_vector_type(4)));
typedef float f32x2 __attribute__((ext_vector_type(2)));
typedef short bf16x8 __attribute__((ext_vector_type(8)));
typedef __bf16 bf2_t __attribute__((ext_vector_type(2)));

constexpr int D = 1024, BATCH = 8, T = 4096, M = BATCH * T, MH = M / 2, DEPTH = 2;
constexpr int RW_PROJ = 3360, SSD_PROJ = 5152, IN_PROJ = 10560;
constexpr int N1P = 3584, N2P = 5120, N3P = 2048, NINP = N1P + N2P + N3P;
constexpr int DT_COL = RW_PROJ;
constexpr int KL = 384;
constexpr int NEXP = 16384;

constexpr size_t MiB = 1u << 20;
constexpr size_t WS_CTL = 0, CTL_BYTES = 1 * MiB;
constexpr size_t WS_WIN = 1 * MiB;
constexpr size_t WIN_L = (size_t)NINP * D * 2;
constexpr size_t WS_WA = 44 * MiB;
constexpr size_t WS_WB = 48 * MiB;
constexpr size_t WS_WO = 56 * MiB;
constexpr size_t WS_WQK = 60 * MiB;
constexpr size_t WS_WLORA = 68 * MiB;
constexpr size_t WLORA_L = (size_t)4096 * KL * 2;
constexpr size_t WS_U = 74 * MiB;
constexpr size_t WS_VF = 138 * MiB;
constexpr size_t WS_OV = 202 * MiB;
constexpr size_t OV_PR = 0, OV_ELOG = 112 * MiB, OV_ASIG = 144 * MiB, OV_GG = 176 * MiB, OV_VMIX = 208 * MiB, OV_AL = 240 * MiB, OV_YA = 272 * MiB;
constexpr size_t OV_PS = 0, OV_XBC = 168 * MiB, OV_DT = 305 * MiB, OV_DA = 307 * MiB;
constexpr size_t OV_GATES = 168 * MiB, OV_MIXED = 232 * MiB;
constexpr size_t OV_DOWN = 0, OV_UP = 32 * MiB, OV_PSCALE = 48 * MiB  , OV_SC = 64 * MiB, OV_IDX = 192 * MiB, OV_GATE = 208 * MiB;
constexpr size_t OV_BON = 304 * MiB;
constexpr size_t WS_END = WS_OV + 309 * MiB;
static_assert(WS_WIN + 2 * WIN_L <= WS_WA, "map");

constexpr int LDS_BYTES = 147456;
constexpr int LDS_MISC = 145408;
constexpr int CW_BAR = 4096;

__device__ __forceinline__ unsigned f2bf(float f) { unsigned u = __builtin_bit_cast(unsigned, f); return (u + 0x7fffu + ((u >> 16) & 1u)) >> 16; }
__device__ __forceinline__ unsigned pk2(float lo, float hi) { unsigned r; asm volatile("v_cvt_pk_bf16_f32 %0, %1, %2" : "=v"(r) : "v"(lo), "v"(hi)); return r; }
typedef __bf16 bf16x2_t __attribute__((ext_vector_type(2)));
__device__ __forceinline__ unsigned pk2c(float lo, float hi) { bf16x2_t v; v.x = (__bf16)lo; v.y = (__bf16)hi; return __builtin_bit_cast(unsigned, v); }
__device__ __forceinline__ float bflo(unsigned u) { return __builtin_bit_cast(float, u << 16); }
__device__ __forceinline__ float bfhi(unsigned u) { return __builtin_bit_cast(float, u & 0xffff0000u); }
__device__ __forceinline__ float bf1(bf16 u) { return __builtin_bit_cast(float, ((unsigned)u) << 16); }
__device__ __forceinline__ float sigmoidf_(float x) { return 1.f / (1.f + __expf(-x)); }
__device__ __forceinline__ float siluf_(float x) { return x / (1.f + __expf(-x)); }
template <int CTRL> __device__ __forceinline__ float dpp_mov(float x) { return __int_as_float(__builtin_amdgcn_update_dpp(0, __float_as_int(x), CTRL, 0xF, 0xF, true)); }
__device__ __forceinline__ float sum4(float x) { x += dpp_mov<0xB1>(x); x += dpp_mov<0x4E>(x); return x; }
__device__ __forceinline__ float sum16(float x) { x += dpp_mov<0xB1>(x); x += dpp_mov<0x4E>(x); x += dpp_mov<0x141>(x); x += dpp_mov<0x140>(x); return x; }
__device__ __forceinline__ float sum64(float x) { x = sum16(x); x += __shfl_xor(x, 16); x += __shfl_xor(x, 32); return x; }
__device__ __forceinline__ void unpack8(const v4u& q, float (&o)[8]) { o[0] = bflo(q.x); o[1] = bfhi(q.x); o[2] = bflo(q.y); o[3] = bfhi(q.y); o[4] = bflo(q.z); o[5] = bfhi(q.z); o[6] = bflo(q.w); o[7] = bfhi(q.w); }
__device__ __forceinline__ v4u pack8(const float (&o)[8]) { v4u q; q.x = pk2(o[0], o[1]); q.y = pk2(o[2], o[3]); q.z = pk2(o[4], o[5]); q.w = pk2(o[6], o[7]); return q; }

typedef short s16x4 __attribute__((ext_vector_type(4)));
__device__ __forceinline__ void lds_barrier() { asm volatile("s_waitcnt lgkmcnt(0)\n\ts_barrier" ::: "memory"); }
__device__ __forceinline__ bf16x8 tr_frag(unsigned base_bytes, int stride, int k0, int c0, int lane) {
    const int i16 = lane & 15, qq = i16 >> 2, p = i16 & 3, q = lane >> 4;
    const unsigned a0 = base_bytes + (unsigned)(((k0 + 8 * q + qq) * stride + c0 + 4 * p) * 2), a1 = a0 + (unsigned)(8 * stride);
    s16x4 lo, hi;
    asm volatile("ds_read_b64_tr_b16 %0, %2\n\tds_read_b64_tr_b16 %1, %3\n\ts_waitcnt lgkmcnt(0)" : "=&v"(lo), "=&v"(hi) : "v"(a0), "v"(a1) : "memory");
    return __builtin_shufflevector(lo, hi, 0, 1, 2, 3, 4, 5, 6, 7);
}

namespace pg8 {
constexpr int BM = 256, BK = 64, HALF = 128, HTB = HALF * BK * 2, STAGE_BYTES = 8 * HTB, NXCD = 8, WGM = 8;
__host__ __device__ __forceinline__ int lds_byte(int r, int c) { const int st = (r >> 4) * 2 + (c >> 5), rr = r & 15, cc = c & 31, ob = rr * 64 + cc * 2; return st * 1024 + (ob ^ (((ob >> 9) & 1) << 5)); }
__host__ __device__ __forceinline__ void stage_rc(int b, int& R, int& C) { const int st = b / 1024, sb = b % 1024, swz = sb ^ (((sb >> 9) & 1) << 5); R = (st >> 1) * 16 + swz / 64; C = (st & 1) * 32 + (swz % 64) / 2; }
__host__ __device__ __forceinline__ int perm32(int rho) { const int n = rho >> 4, i = rho & 15; return 8 * (i >> 2) + 4 * n + (i & 3); }
struct Unit { int pm, pn; };
struct Gemm { const bf16* A; const bf16* Bt; int M, N, K, lda; int kwin; };
__device__ __forceinline__ void unit_kwin(const Gemm& g, const Unit& u, int& k0t, int& ntl) { k0t = 0; ntl = g.K / BK; if (g.kwin) { const int blk = u.pn >> 2; if (blk < 2) { k0t = 0; ntl = 2; } else if (blk == 2) { k0t = 2; ntl = 4; } else { k0t = 4; ntl = 2; } } }
struct StaticOrder {
    int nM, nN, nwg, G, c;
    __device__ void init(int M_, int N_, int G_, int c_) { nM = M_ / BM; nN = N_ / BM; nwg = nM * nN; G = G_; c = c_; }
    __device__ bool next(int i, Unit& u) const {
        const long L = (long)i * G + c; if (L >= nwg) return false;
        int wgid = (int)L; { const int q = nwg / NXCD, r = nwg % NXCD, xcd = wgid % NXCD, off = wgid / NXCD; wgid = (xcd < r ? xcd * (q + 1) : r * (q + 1) + (xcd - r) * q) + off; }
        const int nig = WGM * nN, gid = wgid / nig, fm = gid * WGM, gsz = (nM - fm) < WGM ? (nM - fm) : WGM;
        u.pm = fm + ((wgid % nig) % gsz); u.pn = (wgid % nig) / gsz; return true;
    }
};
template <class F> struct EpiRow8 {
    static constexpr bool PERM = true;
    F f;
    __device__ __forceinline__ void operator()(const f32x4 (&acc)[2][2][4][2], const Unit& u, int wr, int wc, int fr, int fq) const {
        const int row0 = u.pm * BM + wr * 64 + fr, col0 = u.pn * BM + wc * 32 + 8 * fq;
#pragma unroll
        for (int ai = 0; ai < 2; ++ai)
#pragma unroll
            for (int m = 0; m < 4; ++m)
#pragma unroll
                for (int bj = 0; bj < 2; ++bj) f(row0 + ai * HALF + m * 16, col0 + bj * HALF, acc[ai][bj][m][0], acc[ai][bj][m][1], u.pn);
    }
};

template <class Epi>
__device__ __forceinline__ void gemm_phase(LAS unsigned char* lds, const Gemm g, const StaticOrder& S, const Epi& E) {
    const int tid = threadIdx.x, wid = __builtin_amdgcn_readfirstlane(tid >> 6), lane = tid & 63, wr = wid >> 2, wc = wid & 3, fr = lane & 15, fq = lane >> 4;
    const int K = g.K, lda = g.lda;
    unsigned voffA[2], voffB[2];
#pragma unroll
    for (int i = 0; i < 2; ++i) { int R, C; stage_rc(tid * 16 + i * 8192, R, C); const int Rb = Epi::PERM ? ((R & ~31) + perm32(R & 31)) : R;
        voffA[i] = (unsigned)(R * lda + C) * 2u; voffB[i] = (unsigned)(Rb * K + C) * 2u; }
    const size_t kstep = (size_t)(BK * 2);
    const size_t hstepA = (size_t)HALF * lda * 2, hstepB = (size_t)HALF * K * 2;
    const size_t tstepA = 2 * hstepA, tstepB = 2 * hstepB;
    const unsigned ldsw = (unsigned)wid * 1024u;
    const int aoff = lds_byte(wr * 64 + fr, fq * 8), boff = lds_byte(wc * 32 + fr, fq * 8);
#define PG8_SA(b, h) (((b) * 2 + (h)) * HTB)
#define PG8_SB(b, h) ((4 + (b) * 2 + (h)) * HTB)
#define PG8_STAGE(bufoff, gbase, voff) do { _Pragma("unroll") for (int _i = 0; _i < 2; ++_i) \
        __builtin_amdgcn_global_load_lds((const unsigned*)((const char*)(gbase) + (voff)[_i]), (LAS unsigned*)(lds + (bufoff) + ldsw + _i * 8192), 16, 0, 0); } while (0)
#define PG8_LDA(dst, b, h) do { _Pragma("unroll") for (int m = 0; m < 4; ++m) _Pragma("unroll") for (int k = 0; k < 2; ++k) dst[m][k] = *(const LAS bf16x8*)(lds + PG8_SA(b, h) + aoff + m * 2048 + k * 1024); } while (0)
#define PG8_LDB(dst, b, h) do { _Pragma("unroll") for (int n = 0; n < 2; ++n) _Pragma("unroll") for (int k = 0; k < 2; ++k) dst[n][k] = *(const LAS bf16x8*)(lds + PG8_SB(b, h) + boff + n * 2048 + k * 1024); } while (0)
#define PG8_MMA(ai, bj, At, Bt) do { __builtin_amdgcn_s_setprio(1); _Pragma("unroll") for (int m = 0; m < 4; ++m) _Pragma("unroll") for (int n = 0; n < 2; ++n) _Pragma("unroll") for (int k = 0; k < 2; ++k) \
        acc[ai][bj][m][n] = __builtin_amdgcn_mfma_f32_16x16x32_bf16(Bt[n][k], At[m][k], acc[ai][bj][m][n], 0, 0, 0); __builtin_amdgcn_s_setprio(0); } while (0)
#define PG8_WAIT_V(n) asm volatile("s_waitcnt vmcnt(" #n ")" ::: "memory")
#define PG8_WAIT_L(n) asm volatile("s_waitcnt lgkmcnt(" #n ")" ::: "memory")
#define PG8_BAR __builtin_amdgcn_s_barrier()
#define PG8_SCHED __builtin_amdgcn_sched_barrier(0)
    Unit cur, nxt; int ui = 0;
    if (!S.next(0, cur)) return;
    f32x4 acc[2][2][4][2];
#pragma unroll
    for (int a = 0; a < 2; ++a)
#pragma unroll
        for (int b = 0; b < 2; ++b)
#pragma unroll
            for (int m = 0; m < 4; ++m)
#pragma unroll
                for (int n = 0; n < 2; ++n) acc[a][b][m][n] = (f32x4){0.f, 0.f, 0.f, 0.f};
    bf16x8 At[4][2], B0[2][2], B1[2][2];
    int k0c, nt; unit_kwin(g, cur, k0c, nt);
    const char* cA = (const char*)g.A + (size_t)cur.pm * tstepA + (size_t)k0c * kstep; const char* cB = (const char*)g.Bt + (size_t)cur.pn * tstepB + (size_t)k0c * kstep;
    PG8_STAGE(PG8_SB(0, 0), cB, voffB); PG8_STAGE(PG8_SA(0, 0), cA, voffA); PG8_STAGE(PG8_SB(0, 1), cB + hstepB, voffB); PG8_STAGE(PG8_SA(0, 1), cA + hstepA, voffA);
    if (wr == 1) PG8_BAR;
    PG8_WAIT_V(4); PG8_BAR;
    PG8_STAGE(PG8_SB(1, 0), cB + kstep, voffB); PG8_STAGE(PG8_SA(1, 0), cA + kstep, voffA); PG8_STAGE(PG8_SB(1, 1), cB + hstepB + kstep, voffB);
    PG8_WAIT_V(6); PG8_BAR;
    for (;;) {
        const bool has_next = S.next(ui + 1, nxt);
        int k0n = 0, ntn = nt; if (has_next) unit_kwin(g, nxt, k0n, ntn);
        const char* nA = has_next ? (const char*)g.A + (size_t)nxt.pm * tstepA + (size_t)k0n * kstep : cA; const char* nB = has_next ? (const char*)g.Bt + (size_t)nxt.pn * tstepB + (size_t)k0n * kstep : cB;
        for (int t = 0; t < nt; t += 2) {
            const bool last = (t == nt - 2);
            const char* a1 = cA + (size_t)(t + 1) * kstep;
            const char* a2 = last ? nA : cA + (size_t)(t + 2) * kstep; const char* b2 = last ? nB : cB + (size_t)(t + 2) * kstep;
            const char* a3 = a2 + kstep; const char* b3 = b2 + kstep;
            PG8_LDB(B0, 0, 0); PG8_SCHED; PG8_LDA(At, 0, 0); PG8_STAGE(PG8_SA(1, 1), a1 + hstepA, voffA);
            PG8_WAIT_L(8); PG8_BAR; PG8_WAIT_L(0); PG8_MMA(0, 0, At, B0); PG8_BAR; PG8_SCHED;
            PG8_LDB(B1, 0, 1); PG8_STAGE(PG8_SB(0, 0), b2, voffB);
            PG8_BAR; PG8_WAIT_L(0); PG8_MMA(0, 1, At, B1); PG8_BAR;
            PG8_LDA(At, 0, 1); PG8_STAGE(PG8_SA(0, 0), a2, voffA);
            PG8_BAR; PG8_WAIT_L(0); PG8_MMA(1, 0, At, B0); PG8_BAR; PG8_SCHED;
            PG8_STAGE(PG8_SB(0, 1), b2 + hstepB, voffB);
            PG8_WAIT_V(6); PG8_BAR; PG8_MMA(1, 1, At, B1); PG8_BAR;
            PG8_LDB(B0, 1, 0); PG8_SCHED; PG8_LDA(At, 1, 0); PG8_STAGE(PG8_SA(0, 1), a2 + hstepA, voffA);
            PG8_WAIT_L(8); PG8_BAR; PG8_WAIT_L(0); PG8_MMA(0, 0, At, B0); PG8_BAR; PG8_SCHED;
            PG8_LDB(B1, 1, 1); PG8_STAGE(PG8_SB(1, 0), b3, voffB);
            PG8_BAR; PG8_WAIT_L(0); PG8_MMA(0, 1, At, B1); PG8_BAR;
            PG8_LDA(At, 1, 1); PG8_STAGE(PG8_SA(1, 0), a3, voffA);
            PG8_BAR; PG8_WAIT_L(0); PG8_MMA(1, 0, At, B0); PG8_BAR; PG8_SCHED;
            PG8_STAGE(PG8_SB(1, 1), b3 + hstepB, voffB);
            PG8_WAIT_V(6); PG8_BAR; PG8_MMA(1, 1, At, B1); PG8_BAR;
        }
        E(acc, cur, wr, wc, fr, fq);
        if (!has_next) break;
#pragma unroll
        for (int a = 0; a < 2; ++a)
#pragma unroll
            for (int b = 0; b < 2; ++b)
#pragma unroll
                for (int m = 0; m < 4; ++m)
#pragma unroll
                    for (int n = 0; n < 2; ++n) acc[a][b][m][n] = (f32x4){0.f, 0.f, 0.f, 0.f};
        cur = nxt; cA = nA; cB = nB; nt = ntn; ++ui;
    }
    PG8_WAIT_V(0);
    if (wr == 0) PG8_BAR;
    PG8_BAR;
#undef PG8_SA
#undef PG8_SB
#undef PG8_STAGE
#undef PG8_LDA
#undef PG8_LDB
#undef PG8_MMA
#undef PG8_WAIT_V
#undef PG8_WAIT_L
#undef PG8_BAR
#undef PG8_SCHED
}
}

#define XB_TMO      128
#define XB_XCNT(j)  (256  + 64 * (j))
#define XB_XSUB(j)  (1280 + 64 * (j))
#define XB_XGEN(j)  (2304 + 64 * (j))
#define XB_TOP      3328
#define XB_TOPGEN   3392
#define XCD_BAR_WORDS 3456
#define XB_SPIN_CAP (1u << 18)
__device__ __forceinline__ unsigned xb_ld(unsigned* p)              { return __hip_atomic_load(p, __ATOMIC_RELAXED, __HIP_MEMORY_SCOPE_AGENT); }
__device__ __forceinline__ unsigned xb_add(unsigned* p, unsigned v) { return __hip_atomic_fetch_add(p, v, __ATOMIC_RELAXED, __HIP_MEMORY_SCOPE_AGENT); }
__device__ __forceinline__ unsigned xb_xcc_id() { return (unsigned)__builtin_amdgcn_s_getreg((3 << 11) | 20) & 0xFu; }
#define XB_SPIN(cond, bar) do { unsigned _sp = 0; while (cond) { __builtin_amdgcn_s_sleep(1); \
    if ((++_sp & 255u) == 0u) { if (xb_ld(&(bar)[XB_TMO])) break; if (_sp > XB_SPIN_CAP) { atomicAdd(&(bar)[XB_TMO], 1u); break; } } } } while (0)
struct XcdBarrier { unsigned* bar; unsigned x; volatile LAS unsigned* st; };
__device__ __forceinline__ XcdBarrier xcd_barrier_post(unsigned* bar, volatile LAS unsigned* st) {
    XcdBarrier b; b.bar = bar; b.x = xb_xcc_id(); b.st = st;
    if (threadIdx.x == 0) (void)xb_add(&bar[XB_XCNT(b.x)], 1u);
    return b;
}
__device__ __forceinline__ void xcd_barrier_complete(unsigned* bar, unsigned x, unsigned& nloc, unsigned& nx) {
    const unsigned G = gridDim.x * gridDim.y * gridDim.z;
    unsigned sum, cnt, mine, sp = 0u;
    for (;;) {
        sum = 0u; cnt = 0u; mine = 0u;
#pragma unroll
        for (unsigned j = 0; j < 16; ++j) { const unsigned c = xb_ld(&bar[XB_XCNT(j)]); sum += c; cnt += (c > 0u) ? 1u : 0u; mine = (j == x) ? c : mine; }
        if (sum == G) break;
        __builtin_amdgcn_s_sleep(1);
        if ((++sp & 255u) == 0u) { if (xb_ld(&bar[XB_TMO])) break; if (sp > XB_SPIN_CAP) { atomicAdd(&bar[XB_TMO], 1u); break; } }
    }
    nloc = mine > 0u ? mine : 1u; nx = cnt > 0u ? cnt : 1u;
}
__device__ __forceinline__ void xcd_barrier(const XcdBarrier& b) {
    asm volatile("s_waitcnt vmcnt(0)" ::: "memory");
    __syncthreads();
    if (threadIdx.x == 0) {
        unsigned* bar = b.bar;
        __builtin_amdgcn_s_waitcnt(0);
        unsigned nloc = b.st[0], nx = b.st[1];
        if (nloc == 0u) { xcd_barrier_complete(bar, b.x, nloc, nx); b.st[0] = nloc; b.st[1] = nx; }
        const unsigned old = xb_add(&bar[XB_XSUB(b.x)], 1u);
        const unsigned gen = old / nloc;
        if (old + 1u == (gen + 1u) * nloc) {
            __builtin_amdgcn_fence(__ATOMIC_RELEASE, "agent");
            asm volatile("s_waitcnt vmcnt(0)" ::: "memory");
            const unsigned og = xb_add(&bar[XB_TOP], 1u);
            const unsigned tg = og / nx;
            if (og + 1u == (tg + 1u) * nx) xb_add(&bar[XB_TOPGEN], 1u);
            else XB_SPIN(xb_ld(&bar[XB_TOPGEN]) == tg, bar);
            __builtin_amdgcn_fence(__ATOMIC_ACQUIRE, "agent");
            xb_add(&bar[XB_XGEN(b.x)], 1u);
            asm volatile("s_waitcnt vmcnt(0)" ::: "memory");
        } else {
            XB_SPIN(xb_ld(&bar[XB_XGEN(b.x)]) == gen, bar);
            __builtin_amdgcn_fence(__ATOMIC_ACQUIRE, "agent");
            asm volatile("s_waitcnt vmcnt(0)" ::: "memory");
        }
    }
    __syncthreads();
}

struct Args { const float* in[32]; float* out; unsigned char* ws; int lo, hi; };
typedef const Args __attribute__((address_space(4))) KArgs;
enum { I_X = 0, I_NMG, I_WIN, I_MU, I_W0, I_W2, I_A0, I_A2, I_G2, I_V0, I_V1, I_V2, I_KK, I_KA, I_RK, I_LNW, I_LNB, I_WRB, I_CW, I_CB, I_DTB, I_ALOG, I_SD, I_SNG, I_WSB, I_WOUT, I_NFG, I_WQ, I_SK, I_PD, I_PU, I_NFIN };

struct FStoreBf16 { bf16* O; int ldc;
    __device__ __forceinline__ void operator()(int row, int col, f32x4 v0, f32x4 v1, int) const {
        v4u w; w.x = pk2(v0[0], v0[1]); w.y = pk2(v0[2], v0[3]); w.z = pk2(v1[0], v1[1]); w.w = pk2(v1[2], v1[3]);
        *(v4u*)(O + (size_t)row * ldc + col) = w; } };
struct FSigmoidBf16 { bf16* O; int ldc;
    __device__ __forceinline__ void operator()(int row, int col, f32x4 v0, f32x4 v1, int) const {
        v4u w; w.x = pk2(sigmoidf_(v0[0]), sigmoidf_(v0[1])); w.y = pk2(sigmoidf_(v0[2]), sigmoidf_(v0[3])); w.z = pk2(sigmoidf_(v1[0]), sigmoidf_(v1[1])); w.w = pk2(sigmoidf_(v1[2]), sigmoidf_(v1[3]));
        *(v4u*)(O + (size_t)row * ldc + col) = w; } };
struct EpiLora {
    static constexpr bool PERM = true;
    bf16 *elog, *asig, *gg, *vmix; const bf16* vf; const float *w0, *a0, *v0;
    template <int BLK> __device__ __forceinline__ void run(const f32x4 (&acc)[2][2][4][2], int row0, int col0) const {
#pragma unroll
        for (int bj = 0; bj < 2; ++bj) {
            const int c = (col0 + bj * 128) & 1023;
            float bias[8];
            if (BLK == 0 || BLK == 1 || BLK == 3) { const float* bp = (BLK == 0 ? w0 : (BLK == 1 ? a0 : v0)) + c; const f32x4 b0 = *(const f32x4*)bp, b1 = *(const f32x4*)(bp + 4);
                bias[0] = b0[0]; bias[1] = b0[1]; bias[2] = b0[2]; bias[3] = b0[3]; bias[4] = b1[0]; bias[5] = b1[1]; bias[6] = b1[2]; bias[7] = b1[3]; }
#pragma unroll
            for (int ai = 0; ai < 2; ++ai)
#pragma unroll
                for (int m = 0; m < 4; ++m) {
                    const int row = row0 + ai * 128 + m * 16; const size_t o = (size_t)row * D + c;
                    const f32x4 v0_ = acc[ai][bj][m][0], v1_ = acc[ai][bj][m][1];
                    float a[8] = {v0_[0], v0_[1], v0_[2], v0_[3], v1_[0], v1_[1], v1_[2], v1_[3]};
                    if (BLK == 0) {
#pragma unroll
                        for (int e = 0; e < 8; ++e) a[e] = -0.6065306597f * sigmoidf_(bias[e] + a[e]);
                        *(v4u*)(elog + o) = pack8(a);
                    } else if (BLK == 1) {
#pragma unroll
                        for (int e = 0; e < 8; ++e) a[e] = sigmoidf_(bias[e] + a[e]);
                        *(v4u*)(asig + o) = pack8(a);
                    } else if (BLK == 2) {
                        *(v4u*)(gg + o) = pack8(a);
                    } else {
                        float vs[8], vfv[8]; unpack8(*(const v4u*)(vmix + o), vs); unpack8(*(const v4u*)(vf + o), vfv);
#pragma unroll
                        for (int e = 0; e < 8; ++e) a[e] = vs[e] + (vfv[e] - vs[e]) * sigmoidf_(bias[e] + a[e]);
                        *(v4u*)(vmix + o) = pack8(a);
                        asm volatile("" ::: "memory");
                    }
                }
        }
    }
    __device__ __forceinline__ void operator()(const f32x4 (&acc)[2][2][4][2], const pg8::Unit& u, int wr, int wc, int fr, int fq) const {
        const int row0 = u.pm * 256 + wr * 64 + fr, col0 = u.pn * 256 + wc * 32 + 8 * fq;
        const int blk = u.pn >> 2;
        if (blk == 0) run<0>(acc, row0, col0); else if (blk == 1) run<1>(acc, row0, col0); else if (blk == 2) run<2>(acc, row0, col0); else run<3>(acc, row0, col0);
    }
};
struct FMixA { const bf16* gates; bf16* mixed;
    __device__ __forceinline__ void operator()(int row, int col, f32x4 v0, f32x4 v1, int) const {
        float g[8]; unpack8(*(const v4u*)(gates + (size_t)row * 2048 + col), g);
        float a[8] = {v0[0] * g[0], v0[1] * g[1], v0[2] * g[2], v0[3] * g[3], v1[0] * g[4], v1[1] * g[5], v1[2] * g[6], v1[3] * g[7]};
        *(v4u*)(mixed + (size_t)row * D + col) = pack8(a); } };
struct FMixB { const bf16* gates; bf16* mixed;
    __device__ __forceinline__ void operator()(int row, int col, f32x4 v0, f32x4 v1, int) const {
        float g[8], mx[8]; unpack8(*(const v4u*)(gates + (size_t)row * 2048 + 1024 + col), g); unpack8(*(const v4u*)(mixed + (size_t)row * D + col), mx);
        float a[8] = {mx[0] + v0[0] * g[0], mx[1] + v0[1] * g[1], mx[2] + v0[2] * g[2], mx[3] + v0[3] * g[3], mx[4] + v1[0] * g[4], mx[5] + v1[1] * g[5], mx[6] + v1[2] * g[6], mx[7] + v1[3] * g[7]};
        *(v4u*)(mixed + (size_t)row * D + col) = pack8(a); } };
struct FResid { const float* base; float* h;
    __device__ __forceinline__ void operator()(int row, int col, f32x4 v0, f32x4 v1, int) const {
        const f32x4* s = (const f32x4*)(base + (size_t)row * D + col); f32x4* p = (f32x4*)(h + (size_t)row * D + col);
        const f32x4 a = s[0], b = s[1]; p[0] = a + v0; p[1] = b + v1; } };

struct Ctx { int tid, lane, wave, G, bid; LAS unsigned char* lds; };

__device__ __forceinline__ void transpose_item(const float* W, int K, int N, bf16* WT, int row_off, LAS float* scr, int item, int lane) {
    const int nblk = N / 32, kb = item / nblk, nb = item % nblk, k0 = 64 * kb, n0 = 32 * nb;
#pragma unroll 8
    for (int i = 0; i < 32; ++i) { const int kk = 2 * i + (lane >> 5); scr[kk * 33 + (lane & 31)] = W[(size_t)(k0 + kk) * N + n0 + (lane & 31)]; }
    asm volatile("s_waitcnt lgkmcnt(0)" ::: "memory");
    const int c = lane & 7;
#pragma unroll
    for (int j = 0; j < 4; ++j) { const int n = (lane >> 3) + 8 * j; const LAS float* s = scr + (8 * c) * 33 + n;
        v4u o; o.x = pk2(s[0 * 33], s[1 * 33]); o.y = pk2(s[2 * 33], s[3 * 33]); o.z = pk2(s[4 * 33], s[5 * 33]); o.w = pk2(s[6 * 33], s[7 * 33]);
        *(v4u*)(WT + (size_t)(row_off + n0 + n) * K + k0 + 8 * c) = o; }
    asm volatile("s_waitcnt lgkmcnt(0)" ::: "memory");
}
__device__ __forceinline__ int winrow(int n) {
    if (n < RW_PROJ) return n;
    if (n < RW_PROJ + 5120) return N1P + (n - RW_PROJ);
    if (n < RW_PROJ + SSD_PROJ) return DT_COL + (n - RW_PROJ - 5120);
    return N1P + N2P + (n - RW_PROJ - SSD_PROJ); }

__device__ __forceinline__ void phase_prologue(const Ctx& c, KArgs& a) {
    unsigned char* ws = a.ws;
    LAS float* scr = (LAS float*)(c.lds + c.wave * 16384);
    const int gw = c.bid * 8 + c.wave, NGW = c.G * 8;
    constexpr int I_IN = 16 * (IN_PROJ / 32), I_A = 16 * 32, I_B = 32 * 32, I_O = 16 * 32, I_L = I_IN + I_A + I_B + I_O;
    for (int it = gw; it < 2 * I_L; it += NGW) {
        const int l = it / I_L; int r = it % I_L;
        if (r < I_IN) { const int nb = r % (IN_PROJ / 32); transpose_item(a.in[I_WIN] + (size_t)l * D * IN_PROJ, D, IN_PROJ, (bf16*)(ws + WS_WIN + l * WIN_L), winrow(nb * 32) - nb * 32, scr, r, c.lane); continue; } r -= I_IN;
        if (r < I_A) { transpose_item(a.in[I_WRB] + (size_t)l * D * D, D, D, (bf16*)(ws + WS_WA) + (size_t)l * D * D, 0, scr, r, c.lane); continue; } r -= I_A;
        if (r < I_B) { transpose_item(a.in[I_WSB] + (size_t)l * 2048 * D, 2048, D, (bf16*)(ws + WS_WB) + (size_t)l * D * 2048, 0, scr, r, c.lane); continue; } r -= I_B;
        transpose_item(a.in[I_WOUT] + (size_t)l * D * D, D, D, (bf16*)(ws + WS_WO) + (size_t)l * D * D, 0, scr, r, c.lane);
    }
    for (int it = c.bid * 512 + c.tid; it < 2 * 192 * 128; it += c.G * 512) {
        const int l = it / (192 * 128), r = (it / 128) % 192, q = it % 128;
        *(v4u*)((bf16*)(ws + WS_WIN + l * WIN_L) + (size_t)(DT_COL + 32 + r) * D + q * 8) = (v4u){0u, 0u, 0u, 0u};
    }
    for (int it = c.bid * 512 + c.tid; it < 2 * 4096 * KL; it += c.G * 512) {
        const int l = it / (4096 * KL), n = (it / KL) % 4096, k = it % KL; const int blk = n >> 10, cc = n & 1023;
        float v = 0.f;
        if (blk == 0) { if (k < 64) v = a.in[I_W2][((size_t)l * 64 + k) * D + cc]; }
        else if (blk == 1) { if (k >= 64 && k < 128) v = a.in[I_A2][((size_t)l * 64 + (k - 64)) * D + cc]; }
        else if (blk == 2) { if (k >= 128 && k < 288) v = a.in[I_G2][((size_t)l * 160 + (k - 128)) * D + cc]; }
        else { if (l == 1 && k >= 288 && k < 320) v = a.in[I_V2][(size_t)(k - 288) * D + cc]; }
        ((bf16*)(ws + WS_WLORA + l * WLORA_L))[(size_t)n * KL + k] = (bf16)f2bf(v);
    }
    __syncthreads();
    LAS float* wqL = (LAS float*)c.lds;
    LAS float* kyL = (LAS float*)(c.lds + 32768);
    for (int it = c.bid; it < 2 * 16 * 16; it += c.G) {
        const int l = it >> 8, hc = (it >> 4) & 15, k0 = (it & 15) * 64;
        const float* wq = a.in[I_WQ] + (size_t)l * D * 2048; const float* ky = a.in[I_SK] + ((size_t)l * 16 + hc) * 128 * 128;
        for (int e = c.tid; e < 64 * 128; e += 512) wqL[e] = wq[(size_t)(k0 + (e >> 7)) * 2048 + hc * 128 + (e & 127)];
        for (int e = c.tid; e < 128 * 128; e += 512) kyL[(e >> 7) * 129 + (e & 127)] = ky[e];
        __syncthreads();
        const int key = c.tid & 127, kg = c.tid >> 7;
        float acc[16];
#pragma unroll
        for (int i = 0; i < 16; ++i) acc[i] = 0.f;
        for (int d = 0; d < 128; ++d) { const float kv = kyL[key * 129 + d];
#pragma unroll
            for (int i = 0; i < 16; ++i) acc[i] += wqL[(kg * 16 + i) * 128 + d] * kv; }
        bf16* o = (bf16*)(ws + WS_WQK) + ((size_t)l * 2048 + hc * 128 + key) * D + k0 + kg * 16;
        v4u q0, q1; q0.x = pk2(acc[0], acc[1]); q0.y = pk2(acc[2], acc[3]); q0.z = pk2(acc[4], acc[5]); q0.w = pk2(acc[6], acc[7]);
        q1.x = pk2(acc[8], acc[9]); q1.y = pk2(acc[10], acc[11]); q1.z = pk2(acc[12], acc[13]); q1.w = pk2(acc[14], acc[15]);
        *(v4u*)o = q0; *(v4u*)(o + 8) = q1;
        __syncthreads();
    }
}

__device__ __forceinline__ void phase_rmsnorm(const Ctx& c, const float* src, const float* g, bf16* U, float* copy_to) {
    const int gw = c.bid * 8 + c.wave, NGW = c.G * 8;
    f32x4 gv[4];
#pragma unroll
    for (int j = 0; j < 4; ++j) gv[j] = *((const f32x4*)g + c.lane + 64 * j);
    for (int m = gw; m < M; m += NGW) {
        const f32x4* xr = (const f32x4*)(src + (size_t)m * D) + c.lane;
        f32x4 v[4]; float s = 0.f;
#pragma unroll
        for (int j = 0; j < 4; ++j) { v[j] = xr[64 * j]; s += (v[j].x * v[j].x + v[j].y * v[j].y) + (v[j].z * v[j].z + v[j].w * v[j].w); }
        if (copy_to) { f32x4* cr = (f32x4*)(copy_to + (size_t)m * D) + c.lane;
#pragma unroll
            for (int j = 0; j < 4; ++j) cr[64 * j] = v[j]; }
        const float r = rsqrtf(sum64(s) * (1.f / D) + 1e-6f);
        v2u* o = (v2u*)(U + (size_t)m * D) + c.lane;
#pragma unroll
        for (int j = 0; j < 4; ++j) { v2u w; w.x = pk2(v[j].x * r * gv[j].x, v[j].y * r * gv[j].y); w.y = pk2(v[j].z * r * gv[j].z, v[j].w * r * gv[j].w); o[64 * j] = w; }
    }
}
__device__ __forceinline__ void phase_final(const Ctx& c, float* out, const float* g) {
    const int gw = c.bid * 8 + c.wave, NGW = c.G * 8;
    f32x4 gv[4];
#pragma unroll
    for (int j = 0; j < 4; ++j) gv[j] = *((const f32x4*)g + c.lane + 64 * j);
    for (int m = gw; m < M; m += NGW) {
        f32x4* xr = (f32x4*)(out + (size_t)m * D) + c.lane;
        f32x4 v[4]; float s = 0.f;
#pragma unroll
        for (int j = 0; j < 4; ++j) { v[j] = xr[64 * j]; s += (v[j].x * v[j].x + v[j].y * v[j].y) + (v[j].z * v[j].z + v[j].w * v[j].w); }
        const float r = rsqrtf(sum64(s) * (1.f / D) + 1e-6f);
#pragma unroll
        for (int j = 0; j < 4; ++j) xr[64 * j] = v[j] * r * gv[j];
    }
}

__device__ __forceinline__ void phase_rwkv_prep(const Ctx& c, KArgs& a, int l, int hb) {
    unsigned char* ws = a.ws;
    const bf16* PR = (const bf16*)(ws + WS_OV + OV_PR);
    bf16* AL = (bf16*)(ws + WS_OV + OV_AL);
    bf16* VS = l == 0 ? (bf16*)(ws + WS_VF) + (size_t)hb * MH * D : (bf16*)(ws + WS_OV + OV_VMIX);
    const float* mu = a.in[I_MU] + (size_t)l * RW_PROJ;
    LAS bf16* v1L = (LAS bf16*)c.lds;
    if (l == 1) {
        const float* v1 = a.in[I_V1];
        for (int e = c.tid; e < 1024 * 32; e += 512) { const int cc = e >> 5, j = e & 31; v1L[((cc & 15) * 64 + (cc >> 4)) * 40 + j] = (bf16)f2bf(v1[e]); }
        __syncthreads();
    }
    const int gw = c.bid * 8 + c.wave, NGW = c.G * 8, lane = c.lane;
    float muv[16], mul[8];
#pragma unroll
    for (int e = 0; e < 16; ++e) muv[e] = mu[2048 + 16 * lane + e];
#pragma unroll
    for (int e = 0; e < 8; ++e) mul[e] = lane < 36 ? mu[3072 + 8 * lane + e] : 0.f;
    for (int m = gw; m < MH; m += NGW) {
        const bool has_prev = (m & (T - 1)) != 0;
        const bf16* row = PR + (size_t)m * N1P; const bf16* prow = row - N1P;
        float vs[16];
        {
            float p[16], pp[16];
            const v4u q0 = *(const v4u*)(row + 2048 + 16 * lane), q1 = *(const v4u*)(row + 2048 + 16 * lane + 8);
            v4u r0 = (v4u){0u, 0u, 0u, 0u}, r1 = r0;
            if (has_prev) { r0 = *(const v4u*)(prow + 2048 + 16 * lane); r1 = *(const v4u*)(prow + 2048 + 16 * lane + 8); }
            float t8[8];
            unpack8(q0, t8);
#pragma unroll
            for (int e = 0; e < 8; ++e) p[e] = t8[e];
            unpack8(q1, t8);
#pragma unroll
            for (int e = 0; e < 8; ++e) p[8 + e] = t8[e];
            unpack8(r0, t8);
#pragma unroll
            for (int e = 0; e < 8; ++e) pp[e] = t8[e];
            unpack8(r1, t8);
#pragma unroll
            for (int e = 0; e < 8; ++e) pp[8 + e] = t8[e];
#pragma unroll
            for (int e = 0; e < 16; ++e) vs[e] = p[e] + (pp[e] - p[e]) * muv[e];
            v4u o0, o1;
            o0.x = pk2(vs[0], vs[1]); o0.y = pk2(vs[2], vs[3]); o0.z = pk2(vs[4], vs[5]); o0.w = pk2(vs[6], vs[7]);
            o1.x = pk2(vs[8], vs[9]); o1.y = pk2(vs[10], vs[11]); o1.z = pk2(vs[12], vs[13]); o1.w = pk2(vs[14], vs[15]);
            *(v4u*)(VS + (size_t)m * D + 16 * lane) = o0; *(v4u*)(VS + (size_t)m * D + 16 * lane + 8) = o1;
        }
        if (lane < 36) {
            float p[8], pp[8], s[8];
            unpack8(*(const v4u*)(row + 3072 + 8 * lane), p);
            v4u r0 = (v4u){0u, 0u, 0u, 0u}; if (has_prev) r0 = *(const v4u*)(prow + 3072 + 8 * lane);
            unpack8(r0, pp);
#pragma unroll
            for (int e = 0; e < 8; ++e) { const float x = p[e] + (pp[e] - p[e]) * mul[e]; s[e] = lane < 8 ? tanhf(x) : (lane < 16 ? x : sigmoidf_(x)); }
            *(v4u*)(AL + (size_t)m * KL + 8 * lane) = pack8(s);
        } else if (lane < 48 && !(l == 1 && lane < 40)) {
            *(v4u*)(AL + (size_t)m * KL + 8 * lane) = (v4u){0u, 0u, 0u, 0u};
        }
        if (l == 1) {
            float acc[32];
#pragma unroll
            for (int j = 0; j < 32; ++j) acc[j] = 0.f;
#pragma unroll
            for (int i = 0; i < 16; ++i) {
                const LAS v4u* wp = (const LAS v4u*)(v1L + (i * 64 + lane) * 40);
#pragma unroll
                for (int q = 0; q < 4; ++q) { float w8[8]; const v4u wq_ = wp[q]; unpack8(wq_, w8);
#pragma unroll
                    for (int e = 0; e < 8; ++e) acc[q * 8 + e] += vs[i] * w8[e]; }
            }
#pragma unroll
            for (int s = 32, half = 16; s >= 2; s >>= 1, half >>= 1) {
                const bool up = (lane & s) != 0;
#pragma unroll
                for (int i = 0; i < 16; ++i) if (i < half) { const float send = up ? acc[i] : acc[i + half]; const float keep = up ? acc[i + half] : acc[i]; acc[i] = keep + __shfl_xor(send, s); }
            }
            acc[0] += __shfl_xor(acc[0], 1);
            const int j = ((lane & 32) ? 16 : 0) + ((lane & 16) ? 8 : 0) + ((lane & 8) ? 4 : 0) + ((lane & 4) ? 2 : 0) + ((lane & 2) ? 1 : 0);
            if ((lane & 1) == 0) AL[(size_t)m * KL + 288 + j] = (bf16)f2bf(acc[0]);
        }
    }
    { float* DT = (float*)(ws + WS_OV + OV_DT); float* DA = (float*)(ws + WS_OV + OV_DA);
      for (int it = gw; it < (MH / 64) * 32; it += NGW) {
        const int ck = it >> 5, h = it & 31;
        const size_t m = (size_t)ck * 64 + lane;
        const float x = bf1(PR[m * N1P + DT_COL + h]) + a.in[I_DTB][l * 32 + h];
        const float dt = x > 20.f ? x : log1pf(__expf(x));
        float cs = -dt * __expf(a.in[I_ALOG][l * 32 + h]);
#pragma unroll
        for (int o = 1; o < 64; o <<= 1) { const float y = __shfl_up(cs, o); cs += (lane >= o) ? y : 0.f; }
        DT[m * 32 + h] = dt; DA[m * 32 + h] = cs;
      } }
}

__device__ __forceinline__ float sum8(float x) { x += dpp_mov<0xB1>(x); x += dpp_mov<0x4E>(x); x += dpp_mov<0x141>(x); return x; }
__device__ __forceinline__ void phase_rwkv_rec(const Ctx& c, KArgs& a, int l, int hb) {
    unsigned char* ws = a.ws;
    const bf16* PR = (const bf16*)(ws + WS_OV + OV_PR);
    const bf16* ELOG = (const bf16*)(ws + WS_OV + OV_ELOG);
    const bf16* ASIG = (const bf16*)(ws + WS_OV + OV_ASIG);
    const bf16* VS = l == 0 ? (const bf16*)(ws + WS_VF) + (size_t)hb * MH * D : (const bf16*)(ws + WS_OV + OV_VMIX);
    bf16* Y = (bf16*)(ws + WS_OV + OV_YA);
    const float* mu = a.in[I_MU] + (size_t)l * RW_PROJ;
    const float* k_k = a.in[I_KK] + (size_t)l * D; const float* k_a = a.in[I_KA] + (size_t)l * D;
    constexpr int CH = 32, NCH = T / CH;
    constexpr int ARRF = CH * 64;
    constexpr int BUFF = 5 * ARRF + CH * 16 + CH * 2;
    LAS float* ldsf = (LAS float*)c.lds;
    LAS float* yt = ldsf + 2 * BUFF;
    const int tid = c.tid, lane = c.lane;
    const bool is_prep = c.wave >= 4;
    const int ptid = tid - 256, tt = ptid >> 3, l8 = ptid & 7, pc = l8 * 8;
    const int rrow = c.wave * 4 + (lane >> 4), cc4 = (lane & 15) * 4;
    for (int unit = c.bid; unit < 256; unit += c.G) {
        const int b = unit >> 6, h = (unit >> 2) & 15, rq = unit & 3;
        const size_t m0 = (size_t)b * T;
        const int hc = h * 64 + pc;
        float mur[8], muk[8], kkc[8], kac[8];
        if (is_prep) {
#pragma unroll
            for (int e = 0; e < 8; ++e) { mur[e] = mu[hc + e]; muk[e] = mu[1024 + hc + e]; kkc[e] = k_k[hc + e]; kac[e] = k_a[hc + e]; }
        }
        float S[4] = {0.f, 0.f, 0.f, 0.f}, sa = 0.f;
#define RW_PREP(chunk, bufp) do { \
            const int t_ = (chunk) * CH + tt; const size_t mm = m0 + t_; const bf16* row = PR + mm * N1P + hc; \
            const v4u zr = (v4u){0u, 0u, 0u, 0u}; \
            const v4u qr = *(const v4u*)row, qk = *(const v4u*)(row + 1024); \
            const v4u qrp = t_ > 0 ? *(const v4u*)(row - N1P) : zr, qkp = t_ > 0 ? *(const v4u*)(row - N1P + 1024) : zr; \
            const v4u qkn = t_ + 1 < T ? *(const v4u*)(row + N1P + 1024) : zr; \
            const v4u qas = *(const v4u*)(ASIG + mm * D + hc), qel = *(const v4u*)(ELOG + mm * D + hc); \
            v4u qv = zr; if (l8 < 2) qv = *(const v4u*)(VS + mm * D + h * 64 + rq * 16 + l8 * 8); \
            float r_[8], rp_[8], k_[8], kp_[8], kn_[8], as_[8], el_[8]; \
            unpack8(qr, r_); unpack8(qrp, rp_); unpack8(qk, k_); unpack8(qkp, kp_); unpack8(qkn, kn_); unpack8(qas, as_); unpack8(qel, el_); \
            float ks_[8], kk_[8], kkn_[8], s1 = 0.f, s2 = 0.f; \
            _Pragma("unroll") for (int e = 0; e < 8; ++e) { ks_[e] = k_[e] + (kp_[e] - k_[e]) * muk[e]; const float kn1 = kn_[e] + (k_[e] - kn_[e]) * muk[e]; \
                kk_[e] = ks_[e] * kkc[e]; kkn_[e] = kn1 * kkc[e]; s1 += kk_[e] * kk_[e]; s2 += kkn_[e] * kkn_[e]; } \
            s1 = sum8(s1); s2 = sum8(s2); \
            const float i1 = rsqrtf(s1 + 1e-12f), i2 = (t_ + 1 < T) ? rsqrtf(s2 + 1e-12f) : 0.f; \
            float ow[8], ok[8], ob[8], orr[8], owa[8], c1 = 0.f, c2 = 0.f; \
            _Pragma("unroll") for (int e = 0; e < 8; ++e) { const float kn = kk_[e] * i1, an = -kkn_[e] * i2; \
                ow[e] = __expf(el_[e]); ok[e] = ks_[e] * (1.f + (as_[e] - 1.f) * kac[e]); ob[e] = kn * as_[e]; orr[e] = r_[e] + (rp_[e] - r_[e]) * mur[e]; \
                owa[e] = ow[e] * an; c1 += ob[e] * an; c2 += ok[e] * an; } \
            c1 = sum8(c1); c2 = sum8(c2); \
            LAS float* bp_ = (bufp) + tt * 64 + pc; \
            *(LAS f32x4*)(bp_) = (f32x4){ow[0], ow[1], ow[2], ow[3]}; *(LAS f32x4*)(bp_ + 4) = (f32x4){ow[4], ow[5], ow[6], ow[7]}; \
            *(LAS f32x4*)(bp_ + ARRF) = (f32x4){ok[0], ok[1], ok[2], ok[3]}; *(LAS f32x4*)(bp_ + ARRF + 4) = (f32x4){ok[4], ok[5], ok[6], ok[7]}; \
            *(LAS f32x4*)(bp_ + 2 * ARRF) = (f32x4){ob[0], ob[1], ob[2], ob[3]}; *(LAS f32x4*)(bp_ + 2 * ARRF + 4) = (f32x4){ob[4], ob[5], ob[6], ob[7]}; \
            *(LAS f32x4*)(bp_ + 3 * ARRF) = (f32x4){orr[0], orr[1], orr[2], orr[3]}; *(LAS f32x4*)(bp_ + 3 * ARRF + 4) = (f32x4){orr[4], orr[5], orr[6], orr[7]}; \
            *(LAS f32x4*)(bp_ + 4 * ARRF) = (f32x4){owa[0], owa[1], owa[2], owa[3]}; *(LAS f32x4*)(bp_ + 4 * ARRF + 4) = (f32x4){owa[4], owa[5], owa[6], owa[7]}; \
            if (l8 < 2) { float v_[8]; unpack8(qv, v_); LAS float* vp_ = (bufp) + 5 * ARRF + tt * 16 + l8 * 8; \
                *(LAS f32x4*)vp_ = (f32x4){v_[0], v_[1], v_[2], v_[3]}; *(LAS f32x4*)(vp_ + 4) = (f32x4){v_[4], v_[5], v_[6], v_[7]}; } \
            if (l8 == 0) { (bufp)[5 * ARRF + CH * 16 + tt * 2] = c1; (bufp)[5 * ARRF + CH * 16 + tt * 2 + 1] = c2; } } while (0)
#define RW_YSTORE(chunk) do { const LAS float* yp_ = yt + ((chunk) & 1) * CH * 16 + tt * 16 + l8 * 2; \
            *(unsigned*)(Y + (m0 + (size_t)(chunk) * CH + tt) * D + h * 64 + rq * 16 + l8 * 2) = pk2(yp_[0], yp_[1]); } while (0)
        if (is_prep) RW_PREP(0, ldsf);
        __syncthreads();
        for (int ch = 0; ch < NCH; ++ch) {
            if (is_prep) {
                if (ch + 1 < NCH) RW_PREP(ch + 1, ldsf + ((ch + 1) & 1) * BUFF);
                if (ch > 0) RW_YSTORE(ch - 1);
            } else {
                const LAS float* buf = ldsf + (ch & 1) * BUFF;
                LAS float* yw = yt + (ch & 1) * CH * 16;
                const int lane15 = lane & 15;
                f32x4 w4 = *(const LAS f32x4*)(buf + cc4), k4 = *(const LAS f32x4*)(buf + ARRF + cc4), b4 = *(const LAS f32x4*)(buf + 2 * ARRF + cc4);
                f32x4 r4 = *(const LAS f32x4*)(buf + 3 * ARRF + cc4), wa4 = *(const LAS f32x4*)(buf + 4 * ARRF + cc4);
                float v = buf[5 * ARRF + rrow]; f32x2 cc = *(const LAS f32x2*)(buf + 5 * ARRF + CH * 16);
#pragma unroll 1
                for (int t16 = 0; t16 < CH; t16 += 16) {
                    float ysave = 0.f;
#pragma unroll
                    for (int u = 0; u < 16; ++u) {
                        const int tn = (t16 + u + 1 < CH) ? t16 + u + 1 : t16 + u;
                        const f32x4 nw4 = *(const LAS f32x4*)(buf + tn * 64 + cc4), nk4 = *(const LAS f32x4*)(buf + ARRF + tn * 64 + cc4), nb4 = *(const LAS f32x4*)(buf + 2 * ARRF + tn * 64 + cc4);
                        const f32x4 nr4 = *(const LAS f32x4*)(buf + 3 * ARRF + tn * 64 + cc4), nwa4 = *(const LAS f32x4*)(buf + 4 * ARRF + tn * 64 + cc4);
                        const float nv = buf[5 * ARRF + tn * 16 + rrow]; const f32x2 ncc = *(const LAS f32x2*)(buf + 5 * ARRF + CH * 16 + tn * 2);
                        float d = S[0] * wa4[0]; d = __builtin_fmaf(S[1], wa4[1], d); d = __builtin_fmaf(S[2], wa4[2], d); d = __builtin_fmaf(S[3], wa4[3], d);
#pragma unroll
                        for (int e = 0; e < 4; ++e) { float tmp = S[e] * w4[e]; asm volatile("" : "+v"(tmp)); tmp = __builtin_fmaf(v, k4[e], tmp); S[e] = __builtin_fmaf(sa, b4[e], tmp); asm volatile("" : "+v"(S[e])); }
                        const float sa_next = __builtin_fmaf(v, cc.y, sa * cc.x);
                        float y = S[0] * r4[0]; y = __builtin_fmaf(S[1], r4[1], y); y = __builtin_fmaf(S[2], r4[2], y); y = __builtin_fmaf(S[3], r4[3], y);
                        d = sum16(d); y = sum16(y);
                        sa = d + sa_next;
                        ysave = (lane15 == u) ? y : ysave;
                        w4 = nw4; k4 = nk4; b4 = nb4; r4 = nr4; wa4 = nwa4; v = nv; cc = ncc;
                    }
                    yw[(t16 + lane15) * 16 + rrow] = ysave;
                }
            }
            __syncthreads();
        }
        if (is_prep) RW_YSTORE(NCH - 1);
        __syncthreads();
#undef RW_PREP
#undef RW_YSTORE
    }
}

constexpr int CK_TS = 72, CK_TB = 64 * CK_TS;
__device__ __forceinline__ void tr_a2(unsigned a, bf16x8& f0, bf16x8& f1) {
    s16x4 l0, h0, l1, h1;
    asm volatile("ds_read_b64_tr_b16 %0, %4\n\tds_read_b64_tr_b16 %1, %4 offset:576\n\tds_read_b64_tr_b16 %2, %4 offset:4608\n\tds_read_b64_tr_b16 %3, %4 offset:5184\n\ts_waitcnt lgkmcnt(0)"
                 : "=&v"(l0), "=&v"(h0), "=&v"(l1), "=&v"(h1) : "v"(a) : "memory");
    f0 = __builtin_shufflevector(l0, h0, 0, 1, 2, 3, 4, 5, 6, 7); f1 = __builtin_shufflevector(l1, h1, 0, 1, 2, 3, 4, 5, 6, 7);
}
__device__ __forceinline__ void tr_b4(unsigned a, bf16x8& f00, bf16x8& f01, bf16x8& f10, bf16x8& f11) {
    s16x4 l0, h0, l1, h1, l2, h2, l3, h3;
    asm volatile("ds_read_b64_tr_b16 %0, %8\n\tds_read_b64_tr_b16 %1, %8 offset:576\n\tds_read_b64_tr_b16 %2, %8 offset:4608\n\tds_read_b64_tr_b16 %3, %8 offset:5184\n\t"
                 "ds_read_b64_tr_b16 %4, %8 offset:32\n\tds_read_b64_tr_b16 %5, %8 offset:608\n\tds_read_b64_tr_b16 %6, %8 offset:4640\n\tds_read_b64_tr_b16 %7, %8 offset:5216\n\ts_waitcnt lgkmcnt(0)"
                 : "=&v"(l0), "=&v"(h0), "=&v"(l1), "=&v"(h1), "=&v"(l2), "=&v"(h2), "=&v"(l3), "=&v"(h3) : "v"(a) : "memory");
    f00 = __builtin_shufflevector(l0, h0, 0, 1, 2, 3, 4, 5, 6, 7); f01 = __builtin_shufflevector(l1, h1, 0, 1, 2, 3, 4, 5, 6, 7);
    f10 = __builtin_shufflevector(l2, h2, 0, 1, 2, 3, 4, 5, 6, 7); f11 = __builtin_shufflevector(l3, h3, 0, 1, 2, 3, 4, 5, 6, 7);
}
template <int PA, int QA, int MASK, int NINIT, int NPAIR, int POST>
__device__ __forceinline__ void mm64(LAS bf16* X, const LAS bf16* P, const LAS bf16* Q, const LAS bf16* P2, const LAS bf16* Q2, const LAS bf16* E1, const LAS bf16* E2,
                                     const LAS float* cscale, const LAS float* wc, int w, int lane) {
    const int r = lane & 15, q = lane >> 4, Ct = w >> 1, Rt0 = 2 * (w & 1);
    const int i16 = lane & 15, qq = i16 >> 2, p4 = i16 & 3;
    const int troff = ((8 * q + qq) * CK_TS + 4 * p4) * 2;
    f32x4 acc[2];
#pragma unroll
    for (int i = 0; i < 2; ++i) {
        const int R = 16 * (Rt0 + i) + r;
        if (NINIT == 0) acc[i] = (f32x4){0.f, 0.f, 0.f, 0.f};
        else { const v2u e1 = *(const LAS v2u*)(E1 + R * CK_TS + 16 * Ct + 4 * q); acc[i] = (f32x4){bflo(e1.x), bfhi(e1.x), bflo(e1.y), bfhi(e1.y)};
            if (NINIT == 2) { const v2u e2 = *(const LAS v2u*)(E2 + R * CK_TS + 16 * Ct + 4 * q); acc[i] += (f32x4){bflo(e2.x), bfhi(e2.x), bflo(e2.y), bfhi(e2.y)}; } }
    }
#pragma unroll
    for (int pr = 0; pr < NPAIR; ++pr) {
        const LAS bf16* Pp = pr == 0 ? P : P2; const LAS bf16* Qp = pr == 0 ? Q : Q2;
        bf16x8 af[2], bfr[2][2];
        if (PA == 0) {
#pragma unroll
            for (int i = 0; i < 2; ++i)
#pragma unroll
                for (int ks = 0; ks < 2; ++ks) bfr[i][ks] = *(const LAS bf16x8*)(Pp + (16 * (Rt0 + i) + r) * CK_TS + 32 * ks + 8 * q);
        }
        if (QA == 1) {
#pragma unroll
            for (int ks = 0; ks < 2; ++ks) af[ks] = *(const LAS bf16x8*)(Qp + (16 * Ct + r) * CK_TS + 32 * ks + 8 * q);
        } else tr_a2((unsigned)(size_t)Qp + (unsigned)(troff + 32 * Ct), af[0], af[1]);
        if (PA == 1) tr_b4((unsigned)(size_t)Pp + (unsigned)(troff + 32 * Rt0), bfr[0][0], bfr[0][1], bfr[1][0], bfr[1][1]);
#pragma unroll
        for (int ks = 0; ks < 2; ++ks)
#pragma unroll
            for (int i = 0; i < 2; ++i) acc[i] = __builtin_amdgcn_mfma_f32_16x16x32_bf16(af[ks], bfr[i][ks], acc[i], 0, 0, 0);
    }
#pragma unroll
    for (int i = 0; i < 2; ++i) {
        const int R = 16 * (Rt0 + i) + r;
        float v[4];
#pragma unroll
        for (int e = 0; e < 4; ++e) { const int C = 16 * Ct + 4 * q + e; float x = acc[i][e];
            if (MASK == 1) x = (C < R) ? x : 0.f;
            if (MASK == 2) x = (C <= R) ? x : 0.f;
            if (POST >= 1) x *= cscale[C];
            if (POST == 2) x += (C == R) ? wc[C] : 0.f;
            v[e] = x; }
        v2u o; o.x = pk2c(v[0], v[1]); o.y = pk2c(v[2], v[3]);
        *(LAS v2u*)(X + R * CK_TS + 16 * Ct + 4 * q) = o;
    }
}

template <int PA, int QA, int MASK, int NINIT, int NPAIR, int POST>
__device__ __forceinline__ void mm64h(LAS bf16* X, const LAS bf16* P, const LAS bf16* Q, const LAS bf16* P2, const LAS bf16* Q2, const LAS bf16* E1, const LAS bf16* E2,
                                      const LAS float* cscale, const LAS float* wc, int ws, int lane) {
    const int r = lane & 15, q = lane >> 4, Cb = ws >> 1, Rb = ws & 1;
    const int i16 = lane & 15, qq = i16 >> 2, p4 = i16 & 3;
    const int troff = ((8 * q + qq) * CK_TS + 4 * p4) * 2;
    f32x4 acc[2][2];
#pragma unroll
    for (int ci = 0; ci < 2; ++ci)
#pragma unroll
        for (int ri = 0; ri < 2; ++ri) {
            const int R = 16 * (2 * Rb + ri) + r, C0 = 16 * (2 * Cb + ci) + 4 * q;
            if (NINIT == 0) acc[ci][ri] = (f32x4){0.f, 0.f, 0.f, 0.f};
            else { const v2u e1 = *(const LAS v2u*)(E1 + R * CK_TS + C0); acc[ci][ri] = (f32x4){bflo(e1.x), bfhi(e1.x), bflo(e1.y), bfhi(e1.y)};
                if (NINIT == 2) { const v2u e2 = *(const LAS v2u*)(E2 + R * CK_TS + C0); acc[ci][ri] += (f32x4){bflo(e2.x), bfhi(e2.x), bflo(e2.y), bfhi(e2.y)}; } }
        }
#pragma unroll
    for (int pr = 0; pr < NPAIR; ++pr) {
        const LAS bf16* Pp = pr == 0 ? P : P2; const LAS bf16* Qp = pr == 0 ? Q : Q2;
        bf16x8 af[2][2], bfr[2][2];
        if (PA == 0) {
#pragma unroll
            for (int ri = 0; ri < 2; ++ri)
#pragma unroll
                for (int ks = 0; ks < 2; ++ks) bfr[ri][ks] = *(const LAS bf16x8*)(Pp + (16 * (2 * Rb + ri) + r) * CK_TS + 32 * ks + 8 * q);
        }
        if (QA == 1) {
#pragma unroll
            for (int ci = 0; ci < 2; ++ci)
#pragma unroll
                for (int ks = 0; ks < 2; ++ks) af[ci][ks] = *(const LAS bf16x8*)(Qp + (16 * (2 * Cb + ci) + r) * CK_TS + 32 * ks + 8 * q);
        } else tr_b4((unsigned)(size_t)Qp + (unsigned)(troff + 64 * Cb), af[0][0], af[0][1], af[1][0], af[1][1]);
        if (PA == 1) tr_b4((unsigned)(size_t)Pp + (unsigned)(troff + 64 * Rb), bfr[0][0], bfr[0][1], bfr[1][0], bfr[1][1]);
#pragma unroll
        for (int ks = 0; ks < 2; ++ks)
#pragma unroll
            for (int ci = 0; ci < 2; ++ci)
#pragma unroll
                for (int ri = 0; ri < 2; ++ri) acc[ci][ri] = __builtin_amdgcn_mfma_f32_16x16x32_bf16(af[ci][ks], bfr[ri][ks], acc[ci][ri], 0, 0, 0);
    }
#pragma unroll
    for (int ci = 0; ci < 2; ++ci)
#pragma unroll
        for (int ri = 0; ri < 2; ++ri) {
            const int R = 16 * (2 * Rb + ri) + r;
            float v[4];
#pragma unroll
            for (int e = 0; e < 4; ++e) { const int C = 16 * (2 * Cb + ci) + 4 * q + e; float x = acc[ci][ri][e];
                if (MASK == 1) x = (C < R) ? x : 0.f;
                if (MASK == 2) x = (C <= R) ? x : 0.f;
                if (POST >= 1) x *= cscale[C];
                if (POST == 2) x += (C == R) ? wc[C] : 0.f;
                v[e] = x; }
            v2u o; o.x = pk2c(v[0], v[1]); o.y = pk2c(v[2], v[3]);
            *(LAS v2u*)(X + R * CK_TS + 16 * (2 * Cb + ci) + 4 * q) = o;
        }
}

__device__ __forceinline__ void phase_rwkv_chunk_par(const Ctx& c, KArgs& a, int l, int hb) {
    unsigned char* ws = a.ws;
    bf16* PR = (bf16*)(ws + WS_OV + OV_PR);
    bf16* ELOG = (bf16*)(ws + WS_OV + OV_ELOG);
    const bf16* ASIG = (const bf16*)(ws + WS_OV + OV_ASIG);
    const bf16* VS = l == 0 ? (const bf16*)(ws + WS_VF) + (size_t)hb * MH * D : (const bf16*)(ws + WS_OV + OV_VMIX);
    bf16* Y = (bf16*)(ws + WS_OV + OV_YA);
    bf16* SLB = (bf16*)(ws + WS_OV + OV_AL);
    const float* mu = a.in[I_MU] + (size_t)l * RW_PROJ;
    const float* k_k = a.in[I_KK] + (size_t)l * D; const float* k_a = a.in[I_KA] + (size_t)l * D; const float* rk_ = a.in[I_RK] + (size_t)l * D;
    float* BON = (float*)(ws + WS_OV + OV_BON);
    LAS bf16* tile = (LAS bf16*)c.lds;
    enum { tA = 0, tR, tBt, tKt, tBh, tKh, tV, tNab, tNak, tNrb, tNrk, tM0, tM1, tP1, tX1, NT };
#define TL(i) (tile + (i) * CK_TB)
    LAS float* cscale = (LAS float*)(tile + NT * CK_TB);
    LAS float* wcv = cscale + 64;
    LAS float* SCR = (LAS float*)TL(tM0);
    LAS float* SEGT = SCR + 64 * 64;
    const int tid = c.tid, lane = c.lane, w = c.wave;
    const int tt = tid >> 3, l8 = tid & 7, pc = l8 * 8;
    v4u qr, qk, qrp, qkp, qas, qel, qv;
#define CK_LOAD(un) do { const int b_ = (un) >> 10, h_ = ((un) >> 6) & 15, ch_ = (un) & 63; const int t_ = ch_ * 64 + tt; \
        const size_t mm = (size_t)b_ * T + (size_t)t_; const bf16* row = PR + mm * N1P + h_ * 64 + pc; const v4u zr = (v4u){0u, 0u, 0u, 0u}; \
        qr = *(const v4u*)row; qk = *(const v4u*)(row + 1024); qrp = t_ > 0 ? *(const v4u*)(row - N1P) : zr; qkp = t_ > 0 ? *(const v4u*)(row - N1P + 1024) : zr; \
        qas = *(const v4u*)(ASIG + mm * D + h_ * 64 + pc); qel = *(const v4u*)(ELOG + mm * D + h_ * 64 + pc); qv = *(const v4u*)(VS + mm * D + h_ * 64 + pc); } while (0)
    if (c.bid < 4096) CK_LOAD(c.bid);
    for (int unit = c.bid; unit < 4096; unit += c.G) {
        const int b = unit >> 10, h = (unit >> 6) & 15, ch = unit & 63;
        const size_t m0 = (size_t)b * T + (size_t)ch * 64;
        const int hc = h * 64 + pc;
        for (int rep = 0; rep < (PROBE_DUP == 7 ? 2 : 1); ++rep) {
        if (PROBE_DUP == 7) { CK_LOAD(unit); }
        float r_[8], k_[8], as_[8], el_[8], v_[8], kk_[8], ks_[8];
        {
            float rp_[8], kp_[8];
            unpack8(qr, r_); unpack8(qrp, rp_); unpack8(qk, k_); unpack8(qkp, kp_); unpack8(qas, as_); unpack8(qel, el_); unpack8(qv, v_);
            if (PROBE_DUP != 7 && unit + c.G < 4096) CK_LOAD(unit + c.G);
            float s1 = 0.f;
#pragma unroll
            for (int e = 0; e < 8; ++e) { r_[e] = r_[e] + (rp_[e] - r_[e]) * mu[hc + e]; ks_[e] = k_[e] + (kp_[e] - k_[e]) * mu[1024 + hc + e]; kk_[e] = ks_[e] * k_k[hc + e]; s1 += kk_[e] * kk_[e]; }
            s1 = sum8(s1);
            const float i1 = rsqrtf(s1 + 1e-12f);
#pragma unroll
            for (int e = 0; e < 8; ++e) { kk_[e] *= i1; k_[e] = ks_[e] * (1.f + (as_[e] - 1.f) * k_a[hc + e]); }
            { float bn = 0.f;
#pragma unroll
              for (int e = 0; e < 8; ++e) bn += r_[e] * k_[e] * rk_[hc + e];
              bn = sum8(bn);
              if (l8 == 0) BON[(m0 + tt) * 16 + h] = bn; }
            *(LAS f32x4*)(SCR + tt * 64 + pc) = (f32x4){el_[0], el_[1], el_[2], el_[3]}; *(LAS f32x4*)(SCR + tt * 64 + pc + 4) = (f32x4){el_[4], el_[5], el_[6], el_[7]};
        }
        lds_barrier();
        {
            const int col = tid & 63, seg = tid >> 6; float s = 0.f;
#pragma unroll
            for (int i = 0; i < 8; ++i) { s += SCR[(8 * seg + i) * 64 + col]; SCR[(8 * seg + i) * 64 + col] = s; }
            SEGT[seg * 64 + col] = s;
        }
        lds_barrier();
        {
            const int col = tid & 63, seg = tid >> 6; float pre = 0.f;
#pragma unroll
            for (int s2 = 0; s2 < 7; ++s2) pre += (s2 < seg) ? SEGT[s2 * 64 + col] : 0.f;
#pragma unroll
            for (int i = 0; i < 8; ++i) SCR[(8 * seg + i) * 64 + col] += pre;
        }
        lds_barrier();
        {
            float L[8], Lr[8], Le[8];
            { const f32x4 x0 = *(const LAS f32x4*)(SCR + tt * 64 + pc), x1 = *(const LAS f32x4*)(SCR + tt * 64 + pc + 4);
              const f32x4 y0 = *(const LAS f32x4*)(SCR + 31 * 64 + pc), y1 = *(const LAS f32x4*)(SCR + 31 * 64 + pc + 4);
              const f32x4 z0 = *(const LAS f32x4*)(SCR + 63 * 64 + pc), z1 = *(const LAS f32x4*)(SCR + 63 * 64 + pc + 4);
#pragma unroll
              for (int e = 0; e < 4; ++e) { L[e] = x0[e]; L[4 + e] = x1[e]; Lr[e] = y0[e]; Lr[4 + e] = y1[e]; Le[e] = z0[e]; Le[4 + e] = z1[e]; } }
            float oA[8], oR[8], oBt[8], oKt[8], oBh[8], oKh[8];
#pragma unroll
            for (int e = 0; e < 8; ++e) {
                const float ea = __expf(L[e] - el_[e] - Lr[e]), er = __expf(L[e] - Lr[e]), eb = __expf(Lr[e] - L[e]), eh = __expf(Le[e] - L[e]);
                const float bb = kk_[e] * as_[e];
                oA[e] = -kk_[e] * ea; oR[e] = r_[e] * er; oBt[e] = bb * eb; oKt[e] = k_[e] * eb; oBh[e] = bb * eh; oKh[e] = k_[e] * eh;
            }
            const int o = tt * CK_TS + pc;
            *(LAS v4u*)(TL(tA) + o) = pack8(oA); *(LAS v4u*)(TL(tR) + o) = pack8(oR); *(LAS v4u*)(TL(tBt) + o) = pack8(oBt); *(LAS v4u*)(TL(tKt) + o) = pack8(oKt);
            *(LAS v4u*)(TL(tBh) + o) = pack8(oBh); *(LAS v4u*)(TL(tKh) + o) = pack8(oKh); *(LAS v4u*)(TL(tV) + o) = pack8(v_);
            if (tt == 0) {
#pragma unroll
                for (int e = 0; e < 8; ++e) { cscale[pc + e] = __expf(Lr[e]); wcv[pc + e] = __expf(Le[e]); }
            }
        }
        lds_barrier();
        const LAS bf16* Z = nullptr;
        const int wg_ = w >> 2, ws_ = w & 3;
        if (wg_ == 0) { mm64h<0, 1, 1, 0, 1, 0>(TL(tNab), TL(tA), TL(tBt), Z, Z, Z, Z, cscale, wcv, ws_, lane);
                        mm64h<0, 1, 1, 0, 1, 0>(TL(tNak), TL(tA), TL(tKt), Z, Z, Z, Z, cscale, wcv, ws_, lane); }
        else          { mm64h<0, 1, 2, 0, 1, 0>(TL(tNrb), TL(tR), TL(tBt), Z, Z, Z, Z, cscale, wcv, ws_, lane);
                        mm64h<0, 1, 2, 0, 1, 0>(TL(tNrk), TL(tR), TL(tKt), Z, Z, Z, Z, cscale, wcv, ws_, lane); }
        lds_barrier();
        if (wg_ == 0) mm64h<0, 0, 0, 0, 1, 0>(TL(tM0), TL(tNab), TL(tNab), Z, Z, Z, Z, cscale, wcv, ws_, lane);
        else          mm64h<0, 0, 0, 0, 1, 0>(TL(tX1), TL(tNak), TL(tV), Z, Z, Z, Z, cscale, wcv, ws_, lane);
        lds_barrier();
        if (wg_ == 0) mm64h<0, 0, 0, 2, 1, 0>(TL(tP1), TL(tNab), TL(tM0), Z, Z, TL(tNab), TL(tM0), cscale, wcv, ws_, lane);
        else          mm64h<0, 0, 0, 0, 1, 0>(TL(tM1), TL(tM0), TL(tM0), Z, Z, Z, Z, cscale, wcv, ws_, lane);
        lds_barrier();
        if (wg_ == 0) mm64h<0, 0, 0, 2, 1, 0>(TL(tNab), TL(tP1), TL(tM1), Z, Z, TL(tP1), TL(tM1), cscale, wcv, ws_, lane);
        else          mm64h<0, 0, 0, 0, 1, 0>(TL(tM0), TL(tM1), TL(tM1), Z, Z, Z, Z, cscale, wcv, ws_, lane);
        lds_barrier();
        if (wg_ == 0) mm64h<0, 0, 0, 2, 1, 0>(TL(tP1), TL(tNab), TL(tM0), Z, Z, TL(tNab), TL(tM0), cscale, wcv, ws_, lane);
        else          mm64h<0, 0, 0, 0, 1, 0>(TL(tM1), TL(tM0), TL(tM0), Z, Z, Z, Z, cscale, wcv, ws_, lane);
        lds_barrier();
        if (wg_ == 0) mm64h<0, 0, 0, 2, 1, 0>(TL(tNab), TL(tP1), TL(tM1), Z, Z, TL(tP1), TL(tM1), cscale, wcv, ws_, lane);
        else          mm64h<0, 0, 0, 0, 1, 0>(TL(tM0), TL(tM1), TL(tM1), Z, Z, Z, Z, cscale, wcv, ws_, lane);
        lds_barrier();
        mm64<0, 0, 0, 2, 1, 0>(TL(tP1), TL(tNab), TL(tM0), Z, Z, TL(tNab), TL(tM0), cscale, wcv, w, lane);
        lds_barrier();
        if (wg_ == 0) mm64h<0, 0, 0, 1, 1, 0>(TL(tBt), TL(tP1), TL(tA), Z, Z, TL(tA), Z, cscale, wcv, ws_, lane);
        else          mm64h<0, 0, 0, 1, 1, 0>(TL(tKt), TL(tP1), TL(tX1), Z, Z, TL(tX1), Z, cscale, wcv, ws_, lane);
        lds_barrier();
        if (wg_ == 0) { mm64h<0, 0, 0, 1, 1, 1>(TL(tM0), TL(tNrb), TL(tBt), Z, Z, TL(tR), Z, cscale, wcv, ws_, lane);
                        mm64h<0, 0, 0, 0, 2, 0>(TL(tM1), TL(tNrb), TL(tKt), TL(tNrk), TL(tV), Z, Z, cscale, wcv, ws_, lane); }
        else          { mm64h<1, 0, 0, 0, 1, 2>(TL(tNab), TL(tBh), TL(tBt), Z, Z, Z, Z, cscale, wcv, ws_, lane);
                        mm64h<1, 0, 0, 0, 2, 0>(TL(tX1), TL(tKt), TL(tBh), TL(tV), TL(tKh), Z, Z, cscale, wcv, ws_, lane); }
        lds_barrier();
        }
        {
            const size_t grow = m0 + tt;
            *(v4u*)(ELOG + grow * D + hc) = *(const LAS v4u*)(TL(tM0) + tt * CK_TS + pc);
            *(v4u*)(Y + grow * D + hc) = *(const LAS v4u*)(TL(tM1) + tt * CK_TS + pc);
            *(v4u*)(PR + grow * N1P + 2048 + hc) = *(const LAS v4u*)(TL(tNab) + tt * CK_TS + pc);
            *(v4u*)(SLB + grow * D + hc) = *(const LAS v4u*)(TL(tX1) + tt * CK_TS + pc);
        }
        lds_barrier();
    }
#undef TL
#undef CK_LOAD
}

struct SeqOps { v4u g0, g1, p0, p1; v2u sl, yl; };
__device__ __forceinline__ void phase_rwkv_chunk_seq(const Ctx& c, KArgs& a, const bool commit = true) {
    unsigned char* ws = a.ws;
    const bf16* PR = (const bf16*)(ws + WS_OV + OV_PR);
    const bf16* RP = (const bf16*)(ws + WS_OV + OV_ELOG);
    bf16* Y = (bf16*)(ws + WS_OV + OV_YA);
    const bf16* SLB = (const bf16*)(ws + WS_OV + OV_AL);
    LAS bf16* SL = (LAS bf16*)c.lds;
    const int tid = c.tid, lane = c.lane, w = c.wave, r = lane & 15, q = lane >> 4;
    constexpr int PF = 4;
    for (int unit = c.bid; unit < 256; unit += c.G) {
        const int b = unit >> 6, h = (unit >> 2) & 15, vq = unit & 3;
        for (int e = tid; e < 2 * 16 * CK_TS / 2; e += 512) ((LAS unsigned*)SL)[e] = 0u;
        __syncthreads();
        if (w < 4) {
            const size_t rowG = (size_t)b * T + 16 * w + r;
            const size_t rowS = (size_t)b * T + vq * 16 + r;
            SeqOps ops[PF];
#define SQ_LOAD(dst, chn) do { const size_t o_ = (size_t)(chn) * 64; \
                dst.g0 = *(const v4u*)(PR + (rowG + o_) * N1P + 2048 + h * 64 + 8 * q); dst.g1 = *(const v4u*)(PR + (rowG + o_) * N1P + 2048 + h * 64 + 32 + 8 * q); \
                dst.p0 = *(const v4u*)(RP + (rowG + o_) * D + h * 64 + 8 * q); dst.p1 = *(const v4u*)(RP + (rowG + o_) * D + h * 64 + 32 + 8 * q); \
                dst.sl = *(const v2u*)(SLB + (rowS + o_) * D + h * 64 + 16 * w + 4 * q); dst.yl = *(const v2u*)(Y + (rowG + o_) * D + h * 64 + vq * 16 + 4 * q); } while (0)
#pragma unroll
            for (int i = 0; i < PF; ++i) SQ_LOAD(ops[i], i);
            constexpr int UNR = 16;
            for (int ch0 = 0; ch0 < 64; ch0 += UNR) {
#pragma unroll
                for (int ii = 0; ii < UNR; ++ii) {
                    constexpr int dummy_ = 0; (void)dummy_;
                    const int i = ii % PF;
                    const int ch = ch0 + ii;
                    const SeqOps cur = ops[i];
                    if (ch + PF < 64) SQ_LOAD(ops[i], ch + PF);
                    const LAS bf16* Sc = SL + (i & 1) * 16 * CK_TS; LAS bf16* Sn = SL + ((i + 1) & 1) * 16 * CK_TS;
                    const bf16x8 s0 = *(const LAS bf16x8*)(Sc + r * CK_TS + 8 * q), s1 = *(const LAS bf16x8*)(Sc + r * CK_TS + 32 + 8 * q);
                    f32x4 accS = (f32x4){bflo(cur.sl.x), bfhi(cur.sl.x), bflo(cur.sl.y), bfhi(cur.sl.y)};
                    accS = __builtin_amdgcn_mfma_f32_16x16x32_bf16(__builtin_bit_cast(bf16x8, cur.g0), s0, accS, 0, 0, 0);
                    accS = __builtin_amdgcn_mfma_f32_16x16x32_bf16(__builtin_bit_cast(bf16x8, cur.g1), s1, accS, 0, 0, 0);
                    f32x4 accY = (f32x4){bflo(cur.yl.x), bfhi(cur.yl.x), bflo(cur.yl.y), bfhi(cur.yl.y)};
                    accY = __builtin_amdgcn_mfma_f32_16x16x32_bf16(s0, __builtin_bit_cast(bf16x8, cur.p0), accY, 0, 0, 0);
                    accY = __builtin_amdgcn_mfma_f32_16x16x32_bf16(s1, __builtin_bit_cast(bf16x8, cur.p1), accY, 0, 0, 0);
                    { v2u o; o.x = pk2c(accS[0], accS[1]); o.y = pk2c(accS[2], accS[3]); *(LAS v2u*)(Sn + r * CK_TS + 16 * w + 4 * q) = o; }
                    if (commit || accY[0] == 123456.789f) { v2u o; o.x = pk2c(accY[0], accY[1]); o.y = pk2c(accY[2], accY[3]); *(v2u*)(Y + (rowG + (size_t)ch * 64) * D + h * 64 + vq * 16 + 4 * q) = o; }
                    lds_barrier();
                }
            }
#undef SQ_LOAD
        } else {
            for (int ch = 0; ch < 64; ++ch) lds_barrier();
        }
        __syncthreads();
    }
}

__device__ __forceinline__ void phase_rwkv_post(const Ctx& c, KArgs& a, int l, int hb) {
    unsigned char* ws = a.ws;
    const bf16* GG = (const bf16*)(ws + WS_OV + OV_GG);
    const bf16* VS = l == 0 ? (const bf16*)(ws + WS_VF) + (size_t)hb * MH * D : (const bf16*)(ws + WS_OV + OV_VMIX);
    const float* BON = (const float*)(ws + WS_OV + OV_BON);
    bf16* Y = (bf16*)(ws + WS_OV + OV_YA);
    const int lane = c.lane, c0 = 16 * lane;
    float lw[16], lb[16];
#pragma unroll
    for (int e = 0; e < 16; ++e) { lw[e] = a.in[I_LNW][(size_t)l * D + c0 + e]; lb[e] = a.in[I_LNB][(size_t)l * D + c0 + e]; }
    const int gw = c.bid * 8 + c.wave, NGW = c.G * 8;
    for (int m = gw; m < MH; m += NGW) {
        float y[16], v[16], g[16], t8[8];
#define LD16(dst, ptr) do { unpack8(*(const v4u*)(ptr), t8); _Pragma("unroll") for (int e = 0; e < 8; ++e) dst[e] = t8[e]; unpack8(*(const v4u*)((ptr) + 8), t8); _Pragma("unroll") for (int e = 0; e < 8; ++e) dst[8 + e] = t8[e]; } while (0)
        LD16(y, Y + (size_t)m * D + c0); LD16(v, VS + (size_t)m * D + c0); LD16(g, GG + (size_t)m * D + c0);
#undef LD16
        const float bon = BON[(size_t)m * 16 + (lane >> 2)];
        float s1 = 0.f;
#pragma unroll
        for (int e = 0; e < 16; ++e) s1 += y[e];
        s1 = sum4(s1);
        const float mean = s1 * (1.f / 64.f);
        float s2 = 0.f;
#pragma unroll
        for (int e = 0; e < 16; ++e) { const float d = y[e] - mean; s2 += d * d; }
        s2 = sum4(s2);
        const float rstd = rsqrtf(s2 * (1.f / 64.f) + 64e-5f);
        float o[16];
#pragma unroll
        for (int e = 0; e < 16; ++e) o[e] = ((y[e] - mean) * rstd * lw[e] + lb[e] + bon * v[e]) * g[e];
        v4u o0, o1;
        o0.x = pk2(o[0], o[1]); o0.y = pk2(o[2], o[3]); o0.z = pk2(o[4], o[5]); o0.w = pk2(o[6], o[7]);
        o1.x = pk2(o[8], o[9]); o1.y = pk2(o[10], o[11]); o1.z = pk2(o[12], o[13]); o1.w = pk2(o[14], o[15]);
        *(v4u*)(Y + (size_t)m * D + c0) = o0; *(v4u*)(Y + (size_t)m * D + c0 + 8) = o1;
    }
}

__device__ __forceinline__ void phase_ssd_conv(const Ctx& c, KArgs& a, int l) {
    unsigned char* ws = a.ws;
    const bf16* PS = (const bf16*)(ws + WS_OV + OV_PS);
    bf16* XBC = (bf16*)(ws + WS_OV + OV_XBC);
    float* DT = (float*)(ws + WS_OV + OV_DT); float* DA = (float*)(ws + WS_OV + OV_DA);
    const float* cw = a.in[I_CW] + (size_t)l * 4 * 3072; const float* cb = a.in[I_CB] + (size_t)l * 3072;
    const int gw = c.bid * 8 + c.wave, NGW = c.G * 8, lane = c.lane;
    constexpr int RUN = 16, NRUN = MH / RUN;
    for (int it = gw; it < 2 * NRUN; it += NGW) {
        const int cb_ = 4 + (it & 1), run = it >> 1, ch0 = cb_ * 512 + lane * 8, m0 = run * RUN;
        float w[4][8], bias[8];
#pragma unroll
        for (int j = 0; j < 4; ++j)
#pragma unroll
            for (int e = 0; e < 8; ++e) w[j][e] = cw[j * 3072 + ch0 + e];
#pragma unroll
        for (int e = 0; e < 8; ++e) bias[e] = cb[ch0 + e];
        float x0[8], x1[8], x2[8], x3[8];
        const bf16* base = PS + (size_t)m0 * N2P + 2048 + ch0;
        const int t0 = m0 & (T - 1);
        if (t0 >= 3) { unpack8(*(const v4u*)(base - 3 * N2P), x0); unpack8(*(const v4u*)(base - 2 * N2P), x1); unpack8(*(const v4u*)(base - N2P), x2); }
        else {
#pragma unroll
            for (int e = 0; e < 8; ++e) { x0[e] = 0.f; x1[e] = 0.f; x2[e] = 0.f; }
        }
#pragma unroll 4
        for (int i = 0; i < RUN; ++i) {
            unpack8(*(const v4u*)(base + (size_t)i * N2P), x3);
            float o[8];
#pragma unroll
            for (int e = 0; e < 8; ++e) { const float y = bias[e] + x0[e] * w[0][e] + x1[e] * w[1][e] + x2[e] * w[2][e] + x3[e] * w[3][e]; o[e] = siluf_(y); x0[e] = x1[e]; x1[e] = x2[e]; x2[e] = x3[e]; }
            *(v4u*)(XBC + (size_t)(m0 + i) * 3072 + ch0) = pack8(o);
        }
    }
}

__device__ __forceinline__ void tr_bm2(unsigned a, bf16x8& f0, bf16x8& f1) {
    s16x4 l0, h0, l1, h1;
    asm volatile("ds_read_b64_tr_b16 %0, %4\n\tds_read_b64_tr_b16 %1, %4 offset:1088\n\tds_read_b64_tr_b16 %2, %4 offset:8704\n\tds_read_b64_tr_b16 %3, %4 offset:9792\n\ts_waitcnt lgkmcnt(0)"
                 : "=&v"(l0), "=&v"(h0), "=&v"(l1), "=&v"(h1) : "v"(a) : "memory");
    f0 = __builtin_shufflevector(l0, h0, 0, 1, 2, 3, 4, 5, 6, 7); f1 = __builtin_shufflevector(l1, h1, 0, 1, 2, 3, 4, 5, 6, 7);
}
__device__ __forceinline__ void tr_x2(unsigned a, bf16x8& f0, bf16x8& f1) {
    s16x4 l0, h0, l1, h1;
    asm volatile("ds_read_b64_tr_b16 %0, %4\n\tds_read_b64_tr_b16 %1, %4 offset:320\n\tds_read_b64_tr_b16 %2, %4 offset:2560\n\tds_read_b64_tr_b16 %3, %4 offset:2880\n\ts_waitcnt lgkmcnt(0)"
                 : "=&v"(l0), "=&v"(h0), "=&v"(l1), "=&v"(h1) : "v"(a) : "memory");
    f0 = __builtin_shufflevector(l0, h0, 0, 1, 2, 3, 4, 5, 6, 7); f1 = __builtin_shufflevector(l1, h1, 0, 1, 2, 3, 4, 5, 6, 7);
}
__device__ __forceinline__ void tr_x4(unsigned a, bf16x8& f00, bf16x8& f01, bf16x8& f10, bf16x8& f11) {
    s16x4 l0, h0, l1, h1, l2, h2, l3, h3;
    asm volatile("ds_read_b64_tr_b16 %0, %8\n\tds_read_b64_tr_b16 %1, %8 offset:320\n\tds_read_b64_tr_b16 %2, %8 offset:2560\n\tds_read_b64_tr_b16 %3, %8 offset:2880\n\t"
                 "ds_read_b64_tr_b16 %4, %8 offset:32\n\tds_read_b64_tr_b16 %5, %8 offset:352\n\tds_read_b64_tr_b16 %6, %8 offset:2592\n\tds_read_b64_tr_b16 %7, %8 offset:2912\n\ts_waitcnt lgkmcnt(0)"
                 : "=&v"(l0), "=&v"(h0), "=&v"(l1), "=&v"(h1), "=&v"(l2), "=&v"(h2), "=&v"(l3), "=&v"(h3) : "v"(a) : "memory");
    f00 = __builtin_shufflevector(l0, h0, 0, 1, 2, 3, 4, 5, 6, 7); f01 = __builtin_shufflevector(l1, h1, 0, 1, 2, 3, 4, 5, 6, 7);
    f10 = __builtin_shufflevector(l2, h2, 0, 1, 2, 3, 4, 5, 6, 7); f11 = __builtin_shufflevector(l3, h3, 0, 1, 2, 3, 4, 5, 6, 7);
}
__device__ __forceinline__ void phase_ssd_scan(const Ctx& c, KArgs& a, int l) {
    unsigned char* ws = a.ws;
    const bf16* PS = (const bf16*)(ws + WS_OV + OV_PS);
    bf16* XBC = (bf16*)(ws + WS_OV + OV_XBC);
    const float* cw = a.in[I_CW] + (size_t)l * 4 * 3072; const float* cb = a.in[I_CB] + (size_t)l * 3072;
    const float* DT = (const float*)(ws + WS_OV + OV_DT); const float* ACS = (const float*)(ws + WS_OV + OV_DA);
    constexpr int SC = 136, SM = 72, SX = 40;
    LAS bf16* Cm = (LAS bf16*)c.lds;
    LAS bf16* Bm = Cm + 64 * SC;
    LAS bf16* Xd = Bm + 64 * SC;
    LAS bf16* Xs = Xd + 64 * SX;
    LAS bf16* Xr = Xs + 64 * SX;
    LAS bf16* MtT = Xr + 64 * SX;
    LAS bf16* SL = MtT + 64 * SM;
    LAS float* acsL = (LAS float*)(SL + 32 * SC);
    const unsigned BmB = (unsigned)(size_t)Bm, XdB = (unsigned)(size_t)Xd, XsB = (unsigned)(size_t)Xs;
    const int tid = c.tid, lane = c.lane, w = c.wave, r = lane & 15, q = lane >> 4;
    const int sj = tid >> 3, sn = (tid & 7) * 16, sp = (tid & 7) * 4;
    const int trq = ((lane & 15) >> 2), trp = lane & 3;
    const unsigned troffB = (unsigned)(((8 * q + trq) * SC + 4 * trp) * 2), troffX = (unsigned)(((8 * q + trq) * SX + 4 * trp) * 2);
    for (int unit = c.bid; unit < 256; unit += c.G) {
        const int b = unit >> 6, h = (unit >> 1) & 31, ph = unit & 1, g = h >> 3;
        const size_t m0 = (size_t)b * T;
        f32x4 st[2] = {(f32x4){0.f, 0.f, 0.f, 0.f}, (f32x4){0.f, 0.f, 0.f, 0.f}};
        for (int e = tid; e < 32 * SC / 2; e += 512) ((LAS unsigned*)SL)[e] = 0u;
        v4u gB0, gB1, gC0, gC1; v2u gX0, gX1, gX2, gX3; float gacs, gacsE, gdt;
        const int chx = h * 64 + ph * 32 + sp; const float Dh = a.in[I_SD][l * 32 + h];
        float cwt[4][4], cbs[4];
#pragma unroll
        for (int e2 = 0; e2 < 4; ++e2) { cbs[e2] = cb[chx + e2];
#pragma unroll
            for (int j = 0; j < 4; ++j) cwt[j][e2] = cw[j * 3072 + chx + e2]; }
#define SS_LOAD(chunk) do { const size_t row = m0 + (size_t)(chunk) * 64 + sj; const bf16* xr = XBC + row * 3072; \
            gB0 = *(const v4u*)(xr + 2048 + g * 128 + sn); gB1 = *(const v4u*)(xr + 2048 + g * 128 + sn + 8); \
            gC0 = *(const v4u*)(xr + 2560 + g * 128 + sn); gC1 = *(const v4u*)(xr + 2560 + g * 128 + sn + 8); \
            { const int t_ = (chunk) * 64 + sj; const bf16* pr_ = PS + row * N2P + 2048 + chx; const v2u z2 = (v2u){0u, 0u}; \
              gX3 = *(const v2u*)pr_; gX2 = t_ >= 1 ? *(const v2u*)(pr_ - N2P) : z2; gX1 = t_ >= 2 ? *(const v2u*)(pr_ - 2 * N2P) : z2; gX0 = t_ >= 3 ? *(const v2u*)(pr_ - 3 * N2P) : z2; } \
            gacs = ACS[row * 32 + h]; gacsE = ACS[(m0 + (size_t)(chunk) * 64 + 63) * 32 + h]; gdt = DT[row * 32 + h]; } while (0)
#define SS_STAGE() do { \
            *(LAS v4u*)(Bm + sj * SC + sn) = gB0; *(LAS v4u*)(Bm + sj * SC + sn + 8) = gB1; *(LAS v4u*)(Cm + sj * SC + sn) = gC0; *(LAS v4u*)(Cm + sj * SC + sn + 8) = gC1; \
            const float sc_ = gdt * __expf(gacsE - gacs); \
            const float r0_[4] = {bflo(gX0.x), bfhi(gX0.x), bflo(gX0.y), bfhi(gX0.y)}, r1_[4] = {bflo(gX1.x), bfhi(gX1.x), bflo(gX1.y), bfhi(gX1.y)}; \
            const float r2_[4] = {bflo(gX2.x), bfhi(gX2.x), bflo(gX2.y), bfhi(gX2.y)}, r3_[4] = {bflo(gX3.x), bfhi(gX3.x), bflo(gX3.y), bfhi(gX3.y)}; \
            float xa_[4]; _Pragma("unroll") for (int e2 = 0; e2 < 4; ++e2) xa_[e2] = siluf_(cbs[e2] + r0_[e2] * cwt[0][e2] + r1_[e2] * cwt[1][e2] + r2_[e2] * cwt[2][e2] + r3_[e2] * cwt[3][e2]); \
            const float x0_ = xa_[0], x1_ = xa_[1], x2_ = xa_[2], x3_ = xa_[3]; \
            v2u o1_, o2_; o1_.x = pk2(x0_ * gdt, x1_ * gdt); o1_.y = pk2(x2_ * gdt, x3_ * gdt); o2_.x = pk2(x0_ * sc_, x1_ * sc_); o2_.y = pk2(x2_ * sc_, x3_ * sc_); \
            *(LAS v2u*)(Xd + sj * SX + sp) = o1_; *(LAS v2u*)(Xs + sj * SX + sp) = o2_; { v2u o3_; o3_.x = pk2(x0_, x1_); o3_.y = pk2(x2_, x3_); *(LAS v2u*)(Xr + sj * SX + sp) = o3_; } \
            if ((tid & 7) == 0) acsL[sj] = gacs; } while (0)
        SS_LOAD(0);
        SS_STAGE();
        __syncthreads();
        for (int ch = 0; ch < T / 64; ++ch) {
            if (ch + 1 < T / 64) SS_LOAD(ch + 1);
            {
                const int jt = w >> 1, it0 = 2 * (w & 1);
                f32x4 acc0 = (f32x4){0.f, 0.f, 0.f, 0.f}, acc1 = acc0;
                if (it0 + 1 >= jt) {
#pragma unroll
                    for (int ks = 0; ks < 4; ++ks) {
                        const bf16x8 af = *(const LAS bf16x8*)(Bm + (16 * jt + r) * SC + 32 * ks + 8 * q);
                        const bf16x8 b0 = *(const LAS bf16x8*)(Cm + (16 * it0 + r) * SC + 32 * ks + 8 * q);
                        const bf16x8 b1 = *(const LAS bf16x8*)(Cm + (16 * (it0 + 1) + r) * SC + 32 * ks + 8 * q);
                        acc0 = __builtin_amdgcn_mfma_f32_16x16x32_bf16(af, b0, acc0, 0, 0, 0);
                        acc1 = __builtin_amdgcn_mfma_f32_16x16x32_bf16(af, b1, acc1, 0, 0, 0);
                    }
                }
                const int i0 = 16 * it0 + r, i1 = i0 + 16;
                const float ai0 = acsL[i0], ai1 = acsL[i1];
                float m0v[4], m1v[4];
#pragma unroll
                for (int e = 0; e < 4; ++e) { const int j = 16 * jt + 4 * q + e; const float aj = acsL[j];
                    m0v[e] = (j <= i0) ? acc0[e] * __expf(ai0 - aj) : 0.f; m1v[e] = (j <= i1) ? acc1[e] * __expf(ai1 - aj) : 0.f; }
                { v2u o0, o1; o0.x = pk2(m0v[0], m0v[1]); o0.y = pk2(m0v[2], m0v[3]); o1.x = pk2(m1v[0], m1v[1]); o1.y = pk2(m1v[2], m1v[3]);
                  *(LAS v2u*)(MtT + i0 * SM + 16 * jt + 4 * q) = o0; *(LAS v2u*)(MtT + i1 * SM + 16 * jt + 4 * q) = o1; }
            }
            lds_barrier();
            {
                const int it = w >> 1, pt = w & 1;
                f32x4 accD = (f32x4){0.f, 0.f, 0.f, 0.f}, accO = accD;
                {
                    bf16x8 xb0, xb1; tr_x2(XdB + troffX + 32u * pt, xb0, xb1);
                    const bf16x8 af0 = *(const LAS bf16x8*)(MtT + (16 * it + r) * SM + 8 * q);
                    accD = __builtin_amdgcn_mfma_f32_16x16x32_bf16(af0, xb0, accD, 0, 0, 0);
                    if (it >= 2) {
                        const bf16x8 af1 = *(const LAS bf16x8*)(MtT + (16 * it + r) * SM + 32 + 8 * q);
                        accD = __builtin_amdgcn_mfma_f32_16x16x32_bf16(af1, xb1, accD, 0, 0, 0);
                    }
                }
#pragma unroll
                for (int ks = 0; ks < 4; ++ks) {
                    const bf16x8 af = *(const LAS bf16x8*)(Cm + (16 * it + r) * SC + 32 * ks + 8 * q);
                    const bf16x8 bf_ = *(const LAS bf16x8*)(SL + (16 * pt + r) * SC + 32 * ks + 8 * q);
                    accO = __builtin_amdgcn_mfma_f32_16x16x32_bf16(af, bf_, accO, 0, 0, 0);
                }
                const int p = 16 * pt + r;
#pragma unroll
                for (int e = 0; e < 4; ++e) { const int i = 16 * it + 4 * q + e; const float y = accD[e] + __expf(acsL[i]) * accO[e] + Dh * bf1(Xr[i * SX + p]);
                    XBC[(m0 + (size_t)ch * 64 + i) * 3072 + h * 64 + ph * 32 + p] = (bf16)f2bf(y); }
            }
            {
                const float dec = __expf(acsL[63]);
                bf16x8 a0, a1, bx[2][2];
                tr_bm2(BmB + troffB + 32u * w, a0, a1);
                tr_x4(XsB + troffX, bx[0][0], bx[0][1], bx[1][0], bx[1][1]);
#pragma unroll
                for (int pt = 0; pt < 2; ++pt) {
                    f32x4 s = st[pt] * dec;
                    s = __builtin_amdgcn_mfma_f32_16x16x32_bf16(a0, bx[pt][0], s, 0, 0, 0);
                    s = __builtin_amdgcn_mfma_f32_16x16x32_bf16(a1, bx[pt][1], s, 0, 0, 0);
                    st[pt] = s;
                }
            }
            lds_barrier();
#pragma unroll
            for (int pt = 0; pt < 2; ++pt) { v2u o; o.x = pk2c(st[pt][0], st[pt][1]); o.y = pk2c(st[pt][2], st[pt][3]);
                *(LAS v2u*)(SL + (16 * pt + r) * SC + 16 * w + 4 * q) = o; }
            if (ch + 1 < T / 64) SS_STAGE();
            lds_barrier();
        }
#undef SS_LOAD
#undef SS_STAGE
    }
}

__device__ __forceinline__ void phase_ssd_post(const Ctx& c, KArgs& a, int l) {
    unsigned char* ws = a.ws;
    bf16* PS = (bf16*)(ws + WS_OV + OV_PS);
    const bf16* XBC = (const bf16*)(ws + WS_OV + OV_XBC);
    const int lane = c.lane, c0 = 32 * lane;
    const float* ng = a.in[I_SNG] + (size_t)l * 2048 + c0;
    const int gw = c.bid * 8 + c.wave, NGW = c.G * 8;
    for (int m = gw; m < MH; m += NGW) {
        float y[32]; float ss = 0.f;
#pragma unroll
        for (int q = 0; q < 4; ++q) {
            float yy[8], zz[8];
            unpack8(*(const v4u*)(XBC + (size_t)m * 3072 + c0 + 8 * q), yy); unpack8(*(const v4u*)(PS + (size_t)m * N2P + c0 + 8 * q), zz);
#pragma unroll
            for (int e = 0; e < 8; ++e) { const float v = yy[e] * siluf_(zz[e]); y[8 * q + e] = v; ss += v * v; }
        }
        ss = sum16(ss);
        const float r = rsqrtf(ss * (1.f / 512.f) + 1e-6f);
#pragma unroll
        for (int q = 0; q < 4; ++q) {
            float o[8];
#pragma unroll
            for (int e = 0; e < 8; ++e) o[e] = y[8 * q + e] * r * ng[8 * q + e];
            *(v4u*)(PS + (size_t)m * N2P + 2048 + c0 + 8 * q) = pack8(o);
        }
    }
}

__device__ __forceinline__ void phase_peer_convert(const Ctx& c, KArgs& a, int l) {
    unsigned char* ws = a.ws;
    const int gw = c.bid * 8 + c.wave, NGW = c.G * 8, lane = c.lane;
    for (int it = gw; it < 2 * NEXP; it += NGW) {
        const int tb = it >= NEXP, e = it - tb * NEXP;
        const float* src_ = (tb ? a.in[I_PU] : a.in[I_PD]) + ((size_t)l * NEXP + e) * D + 16 * lane;
        const f32x4 x0 = *(const f32x4*)src_, x1 = *(const f32x4*)(src_ + 4), x2 = *(const f32x4*)(src_ + 8), x3 = *(const f32x4*)(src_ + 12);
        float am = fmaxf(fmaxf(fmaxf(fabsf(x0.x), fabsf(x0.y)), fmaxf(fabsf(x0.z), fabsf(x0.w))), fmaxf(fmaxf(fabsf(x1.x), fabsf(x1.y)), fmaxf(fabsf(x1.z), fabsf(x1.w))));
        am = fmaxf(am, fmaxf(fmaxf(fmaxf(fabsf(x2.x), fabsf(x2.y)), fmaxf(fabsf(x2.z), fabsf(x2.w))), fmaxf(fmaxf(fabsf(x3.x), fabsf(x3.y)), fmaxf(fabsf(x3.z), fabsf(x3.w)))));
#pragma unroll
        for (int o = 1; o < 64; o <<= 1) am = fmaxf(am, __shfl_xor(am, o));
        am = fmaxf(am, 1e-30f);
        const float s = 384.f / am;
        v4u q;
        int w;
        w = __builtin_amdgcn_cvt_pk_fp8_f32(x0.x * s, x0.y * s, 0, false); w = __builtin_amdgcn_cvt_pk_fp8_f32(x0.z * s, x0.w * s, w, true); q.x = (unsigned)w;
        w = __builtin_amdgcn_cvt_pk_fp8_f32(x1.x * s, x1.y * s, 0, false); w = __builtin_amdgcn_cvt_pk_fp8_f32(x1.z * s, x1.w * s, w, true); q.y = (unsigned)w;
        w = __builtin_amdgcn_cvt_pk_fp8_f32(x2.x * s, x2.y * s, 0, false); w = __builtin_amdgcn_cvt_pk_fp8_f32(x2.z * s, x2.w * s, w, true); q.z = (unsigned)w;
        w = __builtin_amdgcn_cvt_pk_fp8_f32(x3.x * s, x3.y * s, 0, false); w = __builtin_amdgcn_cvt_pk_fp8_f32(x3.z * s, x3.w * s, w, true); q.w = (unsigned)w;
        *(v4u*)(ws + WS_OV + (tb ? OV_UP : OV_DOWN) + (size_t)e * D + 16 * lane) = q;
        if (lane == 0) ((float*)(ws + WS_OV + OV_PSCALE))[it] = am * (1.f / 384.f);
    }
}

template <class TT> __device__ __forceinline__ void ce_desc(TT& a, TT& b) { const TT hi = a > b ? a : b, lo = a > b ? b : a; a = hi; b = lo; }
__device__ __forceinline__ void cef(float& a, float& b) { const float hi = fmaxf(a, b), lo = fminf(a, b); a = hi; b = lo; }
__device__ __forceinline__ void ced(double& a, double& b) { const double hi = fmax(a, b), lo = fmin(a, b); a = hi; b = lo; }
template <class TT, class CE> __device__ __forceinline__ void bitonic_sort16_desc(TT (&v)[16], CE ce) {
#pragma unroll
    for (int k = 2; k <= 16; k <<= 1)
#pragma unroll
        for (int j = k >> 1; j > 0; j >>= 1)
#pragma unroll
            for (int i = 0; i < 16; ++i) { const int p = i ^ j; if (p > i) { if ((i & k) == 0) ce(v[i], v[p]); else ce(v[p], v[i]); } }
}
template <class TT, class CE> __device__ __forceinline__ void bitonic_merge16_desc(TT (&v)[16], CE ce) {
#pragma unroll
    for (int j = 8; j > 0; j >>= 1)
#pragma unroll
        for (int i = 0; i < 16; ++i) { const int p = i ^ j; if (p > i) ce(v[i], v[p]); }
}
struct CEF { __device__ __forceinline__ void operator()(float& a, float& b) const { cef(a, b); } };
struct CED { __device__ __forceinline__ void operator()(double& a, double& b) const { ced(a, b); } };

__device__ __forceinline__ void top16_of_128(const bf16* p, float (&top)[16]) {
#pragma unroll
    for (int grp = 0; grp < 8; ++grp) {
        float cur[16];
        const v4u q0 = *(const v4u*)(p + grp * 16), q1 = *(const v4u*)(p + grp * 16 + 8);
        const unsigned w[8] = {q0.x, q0.y, q0.z, q0.w, q1.x, q1.y, q1.z, q1.w};
#pragma unroll
        for (int e = 0; e < 8; ++e) {
            const unsigned lo = w[e] << 16, hi = w[e] & 0xffff0000u;
            const unsigned i0 = grp * 16 + 2 * e, i1 = i0 + 1;
            cur[2 * e] = __builtin_bit_cast(float, lo | ((lo >> 31) ? i0 : (127u - i0)));
            cur[2 * e + 1] = __builtin_bit_cast(float, hi | ((hi >> 31) ? i1 : (127u - i1)));
        }
        bitonic_sort16_desc(cur, CEF());
        if (grp == 0) {
#pragma unroll
            for (int i = 0; i < 16; ++i) top[i] = cur[i];
        } else {
#pragma unroll
            for (int i = 0; i < 16; ++i) top[i] = fmaxf(top[i], cur[15 - i]);
            bitonic_merge16_desc(top, CEF());
        }
    }
}
__device__ __forceinline__ unsigned key_index(float k) { const unsigned u = __builtin_bit_cast(unsigned, k); const unsigned lo = u & 0x7fu; return (u >> 31) ? lo : 127u - lo; }
__device__ __forceinline__ float key_value(float k) { return __builtin_bit_cast(float, __builtin_bit_cast(unsigned, k) & 0xffff0000u); }

__device__ __forceinline__ void phase_peer_topk(const Ctx& c, KArgs& a) {
    unsigned char* ws = a.ws;
    const bf16* SC = (const bf16*)(ws + WS_OV + OV_SC);
    int* IDX = (int*)(ws + WS_OV + OV_IDX); float* GATE = (float*)(ws + WS_OV + OV_GATE);
    for (int it = c.bid * 512 + c.tid; it < M * 8; it += c.G * 512) {
        const bf16* p = SC + (size_t)it * 256;
        float t0[16], t1[16];
        top16_of_128(p, t0); top16_of_128(p + 128, t1);
        float v0[16], v1[16]; unsigned i0[16], i1[16];
#pragma unroll
        for (int i = 0; i < 16; ++i) { v0[i] = key_value(t0[i]); v1[i] = key_value(t1[i]); i0[i] = key_index(t0[i]); i1[i] = key_index(t1[i]); }
        double top[16];
        const double NEG = -1.0e300;
#pragma unroll
        for (int grp = 0; grp < 4; ++grp) {
            double cur[16];
#pragma unroll
            for (int s = 0; s < 16; ++s) cur[s] = NEG;
            int n = 0;
#pragma unroll
            for (int i = 0; i < 16; ++i)
#pragma unroll
                for (int j = 0; j < 16; ++j) if ((i + 1) * (j + 1) <= 16) {
                    if (n / 16 == grp) {
                        const double d = (double)(v0[i] + v1[j]);
                        const unsigned long long eid = (unsigned long long)(i0[i] * 128u + i1[j]);
                        const unsigned long long bits = __builtin_bit_cast(unsigned long long, d);
                        cur[n % 16] = __builtin_bit_cast(double, bits | ((bits >> 63) ? eid : (16383ull - eid)));
                    }
                    ++n;
                }
            bitonic_sort16_desc(cur, CED());
            if (grp == 0) {
#pragma unroll
                for (int i = 0; i < 16; ++i) top[i] = cur[i];
            } else {
#pragma unroll
                for (int i = 0; i < 16; ++i) top[i] = fmax(top[i], cur[15 - i]);
                bitonic_merge16_desc(top, CED());
            }
        }
        float sv[16]; int id[16];
#pragma unroll
        for (int i = 0; i < 16; ++i) { const unsigned long long bits = __builtin_bit_cast(unsigned long long, top[i]); const unsigned lo = (unsigned)(bits & 0x3fffull);
            id[i] = (int)((bits >> 63) ? lo : 16383u - lo); sv[i] = (float)top[i]; }
        float den = 0.f, ex[16];
#pragma unroll
        for (int i = 0; i < 16; ++i) { ex[i] = __expf(sv[i] - sv[0]); den += ex[i]; }
        const float inv = 1.f / den;
        int* io = IDX + (size_t)it * 16; float* go = GATE + (size_t)it * 16;
#pragma unroll
        for (int q = 0; q < 4; ++q) { *(int4*)(io + 4 * q) = make_int4(id[4 * q], id[4 * q + 1], id[4 * q + 2], id[4 * q + 3]);
            *(f32x4*)(go + 4 * q) = (f32x4){ex[4 * q] * inv, ex[4 * q + 1] * inv, ex[4 * q + 2] * inv, ex[4 * q + 3] * inv}; }
    }
}

__device__ __forceinline__ float gelu_tanh(float x) { const float u = 0.7978845608f * (x + 0.044715f * x * x * x); const float t = 1.f - 2.f / (1.f + __expf(2.f * u)); return 0.5f * x * (1.f + t); }
__device__ __forceinline__ void unpack16_fp8(const v4u& q, float (&o)[16]) {
    const unsigned w[4] = {q.x, q.y, q.z, q.w};
#pragma unroll
    for (int i = 0; i < 4; ++i) { const f32x2 lo = __builtin_amdgcn_cvt_pk_f32_fp8((int)w[i], false), hi = __builtin_amdgcn_cvt_pk_f32_fp8((int)w[i], true);
        o[4 * i] = lo.x; o[4 * i + 1] = lo.y; o[4 * i + 2] = hi.x; o[4 * i + 3] = hi.y; }
}
template <int FUSE> __device__ __forceinline__ void phase_peer_experts(const Ctx& c, KArgs& a, const float* gnext, const bool commit = true) {
    unsigned char* ws = a.ws;
    const bf16* U = (const bf16*)(ws + WS_U);
    const unsigned char* DN = ws + WS_OV + OV_DOWN; const unsigned char* UP = ws + WS_OV + OV_UP;
    const float* SCD = (const float*)(ws + WS_OV + OV_PSCALE); const float* SCU = SCD + NEXP;
    const int* IDX = (const int*)(ws + WS_OV + OV_IDX); const float* GATE = (const float*)(ws + WS_OV + OV_GATE);
    float* H = a.out;
    constexpr int TPW = 16;
    LAS float* wlw = (LAS float*)c.lds + c.wave * (TPW * 128);
    const int lane = c.lane;
    const int gw = c.bid * 8 + c.wave, NGW = c.G * 8;
    const int esel = ((lane & 32) ? 8 : 0) + ((lane & 16) ? 4 : 0) + ((lane & 8) ? 2 : 0) + ((lane & 4) ? 1 : 0);
    const f32x4 gn0 = *(const f32x4*)(gnext + lane * 16), gn1 = *(const f32x4*)(gnext + lane * 16 + 4), gn2 = *(const f32x4*)(gnext + lane * 16 + 8), gn3 = *(const f32x4*)(gnext + lane * 16 + 12);
    for (int m0 = gw; m0 < M; m0 += NGW * TPW) {
#pragma unroll 1
        for (int ti = 0; ti < TPW; ++ti) {
            const int m = m0 + ti * NGW; if (m >= M) break;
            LAS float* wl = wlw + ti * 128;
            float x[16];
            { float t8[8]; unpack8(*(const v4u*)(U + (size_t)m * D + lane * 16), t8);
#pragma unroll
              for (int e2 = 0; e2 < 8; ++e2) x[e2] = t8[e2];
              unpack8(*(const v4u*)(U + (size_t)m * D + lane * 16 + 8), t8);
#pragma unroll
              for (int e2 = 0; e2 < 8; ++e2) x[8 + e2] = t8[e2]; }
            const int id0 = IDX[(size_t)m * 128 + lane], id1 = IDX[(size_t)m * 128 + 64 + lane];
            const float g0 = GATE[(size_t)m * 128 + lane], g1 = GATE[(size_t)m * 128 + 64 + lane];
            const float sd0 = SCD[id0], sd1 = SCD[id1], su0 = SCU[id0], su1 = SCU[id1];
#pragma unroll 1
            for (int bt = 0; bt < 8; ++bt) {
                v4u rr[16];
#pragma unroll
                for (int k = 0; k < 16; ++k) {
                    const int ei = bt * 16 + k;
                    const int row = __builtin_amdgcn_readlane(ei < 64 ? id0 : id1, ei & 63);
                    rr[k] = *(const v4u*)(DN + (size_t)row * D + lane * 16);
                }
                float d[16];
#pragma unroll
                for (int k = 0; k < 16; ++k) { float f[16]; unpack16_fp8(rr[k], f); float s0 = 0.f, s1 = 0.f;
#pragma unroll
                    for (int q = 0; q < 8; ++q) { s0 += f[q] * x[q]; s1 += f[8 + q] * x[8 + q]; }
                    d[k] = s0 + s1; }
#pragma unroll
                for (int sft = 32, half = 8; sft >= 4; sft >>= 1, half >>= 1) {
                    const bool up = (lane & sft) != 0;
#pragma unroll
                    for (int i = 0; i < 8; ++i) if (i < half) { const float send = up ? d[i] : d[i + half]; const float keep = up ? d[i + half] : d[i]; d[i] = keep + __shfl_xor(send, sft); }
                }
                float r = d[0];
                r += __shfl_xor(r, 2); r += __shfl_xor(r, 1);
                if ((lane & 3) == 0) wl[bt * 16 + esel] = r;
            }
            asm volatile("s_waitcnt lgkmcnt(0)" ::: "memory");
            {
                const float w0 = g0 * gelu_tanh(wl[lane] * sd0) * su0, w1 = g1 * gelu_tanh(wl[64 + lane] * sd1) * su1;
                asm volatile("s_waitcnt lgkmcnt(0)" ::: "memory");
                wl[lane] = w0; wl[64 + lane] = w1;
                asm volatile("s_waitcnt lgkmcnt(0)" ::: "memory");
            }
        }
#pragma unroll 1
        for (int ti = 0; ti < TPW; ++ti) {
            const int m = m0 + ti * NGW; if (m >= M) break;
            const LAS float* wl = wlw + ti * 128;
            const int id0 = IDX[(size_t)m * 128 + lane], id1 = IDX[(size_t)m * 128 + 64 + lane];
            float acc[16];
#pragma unroll
            for (int q = 0; q < 16; ++q) acc[q] = 0.f;
#pragma unroll 1
            for (int bt = 0; bt < 8; ++bt) {
                v4u rr[16];
#pragma unroll
                for (int k = 0; k < 16; ++k) {
                    const int ei = bt * 16 + k;
                    const int row = __builtin_amdgcn_readlane(ei < 64 ? id0 : id1, ei & 63);
                    rr[k] = *(const v4u*)(UP + (size_t)row * D + lane * 16);
                }
#pragma unroll
                for (int k = 0; k < 16; ++k) {
                    const float w = wl[bt * 16 + k];
                    float f[16]; unpack16_fp8(rr[k], f);
#pragma unroll
                    for (int q = 0; q < 16; ++q) acc[q] += w * f[q];
                }
            }
            if (!commit && acc[0] != 123456.789f) continue;
            f32x4* hp = (f32x4*)(H + (size_t)m * D + lane * 16);
            f32x4 h0 = hp[0], h1 = hp[1], h2 = hp[2], h3 = hp[3];
            h0 += (f32x4){acc[0], acc[1], acc[2], acc[3]}; h1 += (f32x4){acc[4], acc[5], acc[6], acc[7]};
            h2 += (f32x4){acc[8], acc[9], acc[10], acc[11]}; h3 += (f32x4){acc[12], acc[13], acc[14], acc[15]};
            float ss = (h0.x * h0.x + h0.y * h0.y) + (h0.z * h0.z + h0.w * h0.w) + (h1.x * h1.x + h1.y * h1.y) + (h1.z * h1.z + h1.w * h1.w)
                     + (h2.x * h2.x + h2.y * h2.y) + (h2.z * h2.z + h2.w * h2.w) + (h3.x * h3.x + h3.y * h3.y) + (h3.z * h3.z + h3.w * h3.w);
            const float rn = rsqrtf(sum64(ss) * (1.f / D) + 1e-6f);
            const f32x4 n0 = h0 * rn * gn0, n1 = h1 * rn * gn1, n2 = h2 * rn * gn2, n3 = h3 * rn * gn3;
            if (FUSE == 0) {
                hp[0] = h0; hp[1] = h1; hp[2] = h2; hp[3] = h3;
                v4u u0, u1; u0.x = pk2(n0.x, n0.y); u0.y = pk2(n0.z, n0.w); u0.z = pk2(n1.x, n1.y); u0.w = pk2(n1.z, n1.w);
                u1.x = pk2(n2.x, n2.y); u1.y = pk2(n2.z, n2.w); u1.z = pk2(n3.x, n3.y); u1.w = pk2(n3.z, n3.w);
                bf16* up_ = (bf16*)(ws + WS_U) + (size_t)m * D + lane * 16;
                *(v4u*)up_ = u0; *(v4u*)(up_ + 8) = u1;
            } else { hp[0] = n0; hp[1] = n1; hp[2] = n2; hp[3] = n3; }
        }
    }
}

constexpr int PH_PER_HALF = 11, PH_PER_LAYER = 1 + 2 * PH_PER_HALF + 4, N_PHASES = 1 + DEPTH * PH_PER_LAYER;
__device__ __forceinline__ Ctx make_ctx() {
    extern __shared__ __attribute__((aligned(16))) unsigned char lds_raw[];
    Ctx c; int t = threadIdx.x; asm volatile("" : "+v"(t)); c.lds = (LAS unsigned char*)lds_raw; c.tid = t; c.lane = t & 63; c.wave = __builtin_amdgcn_readfirstlane(t >> 6); c.G = gridDim.x; c.bid = blockIdx.x; return c; }
__device__ __forceinline__ KArgs* kargs_fresh() { KArgs* p = (KArgs*)__builtin_amdgcn_kernarg_segment_ptr(); asm volatile("" : "+s"(p)); return p; }
#define PH_BEGIN(K) if (lo <= (K) && (K) < hi) { const Ctx c = make_ctx(); KArgs& args = *kargs_fresh(); unsigned char* ws = args.ws; (void)ws;
#define PH_END(K)   if ((K) + 1 < hi) xcd_barrier(bar); }

template <int L, int HB> __device__ __forceinline__ void half_pass(const XcdBarrier& bar, const int lo, const int hi) {
    constexpr int P0 = 1 + L * PH_PER_LAYER + 1 + HB * PH_PER_HALF;
#define WIN ((const bf16*)(ws + WS_WIN + L * WIN_L))
#define Uh ((const bf16*)(ws + WS_U) + (size_t)HB * MH * D)
    PH_BEGIN(P0 + 0) {
        pg8::Gemm g{Uh, WIN, MH, N1P, D, D, 0}; pg8::StaticOrder S; S.init(MH, N1P, c.G, c.bid);
        pg8::EpiRow8<FStoreBf16> E{{(bf16*)(ws + WS_OV + OV_PR), N1P}};
        pg8::gemm_phase(c.lds, g, S, E); if (PROBE_DUP == 5) pg8::gemm_phase(c.lds, g, S, E); } PH_END(P0 + 0)
    PH_BEGIN(P0 + 1) if (PROBE_DUP == 6) phase_rwkv_prep(c, args, L, HB); phase_rwkv_prep(c, args, L, HB); PH_END(P0 + 1)
    PH_BEGIN(P0 + 2) {
        constexpr int NL = L == 0 ? 3072 : 4096;
        pg8::Gemm g{(const bf16*)(ws + WS_OV + OV_AL), (const bf16*)(ws + WS_WLORA + L * WLORA_L), MH, NL, KL, KL, 1}; pg8::StaticOrder S; S.init(MH, NL, c.G, c.bid);
        EpiLora E{(bf16*)(ws + WS_OV + OV_ELOG), (bf16*)(ws + WS_OV + OV_ASIG), (bf16*)(ws + WS_OV + OV_GG), (bf16*)(ws + WS_OV + OV_VMIX),
                               (const bf16*)(ws + WS_VF) + (size_t)HB * MH * D, args.in[I_W0] + (size_t)L * D, args.in[I_A0] + (size_t)L * D, args.in[I_V0]};
        pg8::gemm_phase(c.lds, g, S, E); } PH_END(P0 + 2)
    PH_BEGIN(P0 + 3) phase_rwkv_chunk_par(c, args, L, HB); PH_END(P0 + 3)
    PH_BEGIN(P0 + 4) if (PROBE_DUP == 8) phase_rwkv_chunk_seq(c, args, false); phase_rwkv_chunk_seq(c, args); PH_END(P0 + 4)
    PH_BEGIN(P0 + 5) {
        phase_rwkv_post(c, args, L, HB); __syncthreads();
        pg8::Gemm g{Uh, WIN + (size_t)N1P * D, MH, N2P, D, D, 0}; pg8::StaticOrder S; S.init(MH, N2P, c.G, c.bid);
        pg8::EpiRow8<FStoreBf16> E{{(bf16*)(ws + WS_OV + OV_PS), N2P}};
        pg8::gemm_phase(c.lds, g, S, E); if (PROBE_DUP == 5) pg8::gemm_phase(c.lds, g, S, E); } PH_END(P0 + 5)
    PH_BEGIN(P0 + 6) if (PROBE_DUP == 6) phase_ssd_conv(c, args, L); phase_ssd_conv(c, args, L); PH_END(P0 + 6)
    PH_BEGIN(P0 + 7) phase_ssd_scan(c, args, L); PH_END(P0 + 7)
    PH_BEGIN(P0 + 8) phase_ssd_post(c, args, L); PH_END(P0 + 8)
    PH_BEGIN(P0 + 9) {
      { pg8::Gemm g{Uh, WIN + (size_t)(N1P + N2P) * D, MH, D, D, D, 0}; pg8::StaticOrder S; S.init(MH, D, c.G, c.bid);
        pg8::EpiRow8<FSigmoidBf16> E{{(bf16*)(ws + WS_OV + OV_GATES), 2048}};
        pg8::gemm_phase(c.lds, g, S, E); }
      { pg8::Gemm g{Uh, WIN + (size_t)(N1P + N2P + D) * D, MH, D, D, D, 0}; pg8::StaticOrder S; S.init(MH, D, c.G, c.bid);
        pg8::EpiRow8<FSigmoidBf16> E{{(bf16*)(ws + WS_OV + OV_GATES) + 1024, 2048}};
        pg8::gemm_phase(c.lds, g, S, E); }
      {
        pg8::Gemm g{(const bf16*)(ws + WS_OV + OV_YA), (const bf16*)(ws + WS_WA) + (size_t)L * D * D, MH, D, D, D, 0}; pg8::StaticOrder S; S.init(MH, D, c.G, c.bid);
        pg8::EpiRow8<FMixA> E{{(const bf16*)(ws + WS_OV + OV_GATES), (bf16*)(ws + WS_OV + OV_MIXED)}};
        pg8::gemm_phase(c.lds, g, S, E); }
      {
        pg8::Gemm g{(const bf16*)(ws + WS_OV + OV_PS) + 2048, (const bf16*)(ws + WS_WB) + (size_t)L * D * 2048, MH, D, 2048, N2P, 0}; pg8::StaticOrder S; S.init(MH, D, c.G, c.bid);
        pg8::EpiRow8<FMixB> E{{(const bf16*)(ws + WS_OV + OV_GATES), (bf16*)(ws + WS_OV + OV_MIXED)}};
        pg8::gemm_phase(c.lds, g, S, E); } } PH_END(P0 + 9)
    PH_BEGIN(P0 + 10) {
        pg8::Gemm g{(const bf16*)(ws + WS_OV + OV_MIXED), (const bf16*)(ws + WS_WO) + (size_t)L * D * D, MH, D, D, D, 0}; pg8::StaticOrder S; S.init(MH, D, c.G, c.bid);
        pg8::EpiRow8<FResid> E{{(L == 0 ? args.in[I_X] : (const float*)args.out) + (size_t)HB * MH * D, args.out + (size_t)HB * MH * D}};
        pg8::gemm_phase(c.lds, g, S, E); } PH_END(P0 + 10)
#undef WIN
#undef Uh
}

template <int L> __device__ __forceinline__ void layer_pass(const XcdBarrier& bar, const int lo, const int hi) {
    constexpr int P0 = 1 + L * PH_PER_LAYER, P1 = P0 + 1 + 2 * PH_PER_HALF;
    PH_BEGIN(P0) if (L == 0) phase_rmsnorm(c, args.in[I_X], args.in[I_NMG], (bf16*)(ws + WS_U), nullptr); PH_END(P0)
    half_pass<L, 0>(bar, lo, hi);
    half_pass<L, 1>(bar, lo, hi);
    PH_BEGIN(P1 + 0) phase_rmsnorm(c, args.out, args.in[I_NFG] + (size_t)L * D, (bf16*)(ws + WS_U), nullptr); phase_peer_convert(c, args, L); PH_END(P1 + 0)
    PH_BEGIN(P1 + 1) {
        pg8::Gemm g{(const bf16*)(ws + WS_U), (const bf16*)(ws + WS_WQK) + (size_t)L * 2048 * D, M, 2048, D, D, 0}; pg8::StaticOrder S; S.init(M, 2048, c.G, c.bid);
        pg8::EpiRow8<FStoreBf16> E{{(bf16*)(ws + WS_OV + OV_SC), 2048}};
        pg8::gemm_phase(c.lds, g, S, E); } PH_END(P1 + 1)
    PH_BEGIN(P1 + 2) if (PROBE_DUP == 4) phase_peer_topk(c, args); phase_peer_topk(c, args); PH_END(P1 + 2)
    PH_BEGIN(P1 + 3) phase_peer_experts<L == DEPTH - 1 ? 1 : 0>(c, args, L == DEPTH - 1 ? args.in[I_NFIN] : args.in[I_NMG] + (size_t)(L + 1) * D); PH_END(P1 + 3)
}

__global__ void __launch_bounds__(512, 2) mk_fwd(Args kargs_) {
    extern __shared__ __attribute__((aligned(16))) unsigned char lds_raw[];
    LAS unsigned char* lds0 = (LAS unsigned char*)lds_raw;
    unsigned char* ws0 = kargs_.ws;
    const int lo = kargs_.lo, hi = kargs_.hi;
    if (threadIdx.x < 4) ((LAS unsigned*)(lds0 + LDS_MISC))[threadIdx.x] = 0u;
    __syncthreads();
    XcdBarrier bar; bar.bar = (unsigned*)(ws0 + WS_CTL) + CW_BAR; bar.x = 0; bar.st = (volatile LAS unsigned*)(lds0 + LDS_MISC);
    if (hi - lo > 1) bar = xcd_barrier_post((unsigned*)(ws0 + WS_CTL) + CW_BAR, (volatile LAS unsigned*)(lds0 + LDS_MISC));
    PH_BEGIN(0) phase_prologue(c, args); PH_END(0)
    layer_pass<0>(bar, lo, hi);
    layer_pass<1>(bar, lo, hi);
}

extern "C" void kernel_launch(void* const* d_in, const int* in_sizes, int n_in, void* d_out, int out_size, void* d_ws, size_t ws_size, hipStream_t stream) {
    static int grid = 0;
    if (grid == 0) {
        if (n_in != 32 || out_size != M * D || ws_size < WS_END) { fprintf(stderr, "kernel_launch: unexpected problem (n_in %d, out %d, ws %zu < %zu)\n", n_in, out_size, ws_size, (size_t)WS_END); grid = -1; return; }
        int dev = 0, cus = 0, per_cu = 0;
        if (hipGetDevice(&dev) != hipSuccess || hipDeviceGetAttribute(&cus, hipDeviceAttributeMultiprocessorCount, dev) != hipSuccess) { grid = -1; return; }
        if (hipFuncSetAttribute((const void*)mk_fwd, hipFuncAttributeMaxDynamicSharedMemorySize, LDS_BYTES) != hipSuccess) { fprintf(stderr, "kernel_launch: hipFuncSetAttribute failed\n"); grid = -1; return; }
        if (hipOccupancyMaxActiveBlocksPerMultiprocessor(&per_cu, (const void*)mk_fwd, 512, LDS_BYTES) != hipSuccess || per_cu < 1) { fprintf(stderr, "kernel_launch: occupancy query says %d\n", per_cu); per_cu = 1; }
        (void)hipGetLastError();
        grid = cus;
    }
    if (grid < 0) return;
    (void)hipMemsetAsync((char*)d_ws + WS_CTL, 0, CTL_BYTES, stream);
    Args a{};
    for (int i = 0; i < 32; ++i) a.in[i] = (const float*)d_in[i];
    a.out = (float*)d_out; a.ws = (unsigned char*)d_ws;
#if MK_MULTI
    for (int p = 0; p < N_PHASES; ++p) { a.lo = p; a.hi = p + 1; hipLaunchKernelGGL(mk_fwd, dim3(grid), dim3(512), LDS_BYTES, stream, a); }
#else
    a.lo = 0; a.hi = N_PHASES;
    hipLaunchKernelGGL(mk_fwd, dim3(grid), dim3(512), LDS_BYTES, stream, a);
#endif
}
```

```cpp
#include <hip/hip_runtime.h>
#include <cstdio>
#include <cstdint>

#ifndef PROBE_DUP
#define PROBE_DUP 0
#endif
#ifndef MK_MULTI
#define MK_MULTI 0
#endif

#define GAS __attribute__((address_space(1)))
#define LAS __attribute__((address_space(3)))
typedef unsigned short bf16;
typedef unsigned v4u __attribute__((ext_vector_type(4)));
typedef unsigned v2u __attribute__((ext_vector_type(2)));
typedef float f32x4 __attribute__((ext_vector_type(4)));
typedef float f32x2 __attribute__((ext_vector_type(2)));
typedef short bf16x8 __attribute__((ext_vector_type(8)));
typedef __bf16 bf2_t __attribute__((ext_vector_type(2)));

constexpr int D = 1024, BATCH = 8, T = 4096, M = BATCH * T, MH = M / 2, DEPTH = 2;
constexpr int RW_PROJ = 3360, SSD_PROJ = 5152, IN_PROJ = 10560;
constexpr int N1P = 3584, N2P = 5120, N3P = 2048, NINP = N1P + N2P + N3P;
constexpr int DT_COL = RW_PROJ;
constexpr int KL = 384;
constexpr int NEXP = 16384;

constexpr size_t MiB = 1u << 20;
constexpr size_t WS_CTL = 0, CTL_BYTES = 1 * MiB;
constexpr size_t WS_WIN = 1 * MiB;
constexpr size_t WIN_L = (size_t)NINP * D * 2;
constexpr size_t WS_WA = 44 * MiB;
constexpr size_t WS_WB = 48 * MiB;
constexpr size_t WS_WO = 56 * MiB;
constexpr size_t WS_WQK = 60 * MiB;
constexpr size_t WS_WLORA = 68 * MiB;
constexpr size_t WLORA_L = (size_t)4096 * KL * 2;
constexpr size_t WS_U = 74 * MiB;
constexpr size_t WS_VF = 138 * MiB;
constexpr size_t WS_OV = 202 * MiB;
constexpr size_t OV_PR = 0, OV_ELOG = 112 * MiB, OV_ASIG = 144 * MiB, OV_GG = 176 * MiB, OV_VMIX = 208 * MiB, OV_AL = 240 * MiB, OV_YA = 272 * MiB;
constexpr size_t OV_PS = 0, OV_XBC = 168 * MiB, OV_DT = 305 * MiB, OV_DA = 307 * MiB;
constexpr size_t OV_GATES = 168 * MiB, OV_MIXED = 232 * MiB;
constexpr size_t OV_DOWN = 0, OV_UP = 32 * MiB, OV_PSCALE = 48 * MiB  , OV_SC = 64 * MiB, OV_IDX = 192 * MiB, OV_GATE = 208 * MiB;
constexpr size_t OV_BON = 304 * MiB;
constexpr size_t WS_END = WS_OV + 309 * MiB;
static_assert(WS_WIN + 2 * WIN_L <= WS_WA, "map");

constexpr int LDS_BYTES = 147456;
constexpr int LDS_MISC = 145408;
constexpr int CW_BAR = 4096;

__device__ __forceinline__ unsigned f2bf(float f) { unsigned u = __builtin_bit_cast(unsigned, f); return (u + 0x7fffu + ((u >> 16) & 1u)) >> 16; }
__device__ __forceinline__ unsigned pk2(float lo, float hi) { unsigned r; asm volatile("v_cvt_pk_bf16_f32 %0, %1, %2" : "=v"(r) : "v"(lo), "v"(hi)); return r; }
typedef __bf16 bf16x2_t __attribute__((ext_vector_type(2)));
__device__ __forceinline__ unsigned pk2c(float lo, float hi) { bf16x2_t v; v.x = (__bf16)lo; v.y = (__bf16)hi; return __builtin_bit_cast(unsigned, v); }
__device__ __forceinline__ float bflo(unsigned u) { return __builtin_bit_cast(float, u << 16); }
__device__ __forceinline__ float bfhi(unsigned u) { return __builtin_bit_cast(float, u & 0xffff0000u); }
__device__ __forceinline__ float bf1(bf16 u) { return __builtin_bit_cast(float, ((unsigned)u) << 16); }
__device__ __forceinline__ float sigmoidf_(float x) { return 1.f / (1.f + __expf(-x)); }
__device__ __forceinline__ float siluf_(float x) { return x / (1.f + __expf(-x)); }
template <int CTRL> __device__ __forceinline__ float dpp_mov(float x) { return __int_as_float(__builtin_amdgcn_update_dpp(0, __float_as_int(x), CTRL, 0xF, 0xF, true)); }
__device__ __forceinline__ float sum4(float x) { x += dpp_mov<0xB1>(x); x += dpp_mov<0x4E>(x); return x; }
__device__ __forceinline__ float sum16(float x) { x += dpp_mov<0xB1>(x); x += dpp_mov<0x4E>(x); x += dpp_mov<0x141>(x); x += dpp_mov<0x140>(x); return x; }
__device__ __forceinline__ float sum64(float x) { x = sum16(x); x += __shfl_xor(x, 16); x += __shfl_xor(x, 32); return x; }
__device__ __forceinline__ void unpack8(const v4u& q, float (&o)[8]) { o[0] = bflo(q.x); o[1] = bfhi(q.x); o[2] = bflo(q.y); o[3] = bfhi(q.y); o[4] = bflo(q.z); o[5] = bfhi(q.z); o[6] = bflo(q.w); o[7] = bfhi(q.w); }
__device__ __forceinline__ v4u pack8(const float (&o)[8]) { v4u q; q.x = pk2(o[0], o[1]); q.y = pk2(o[2], o[3]); q.z = pk2(o[4], o[5]); q.w = pk2(o[6], o[7]); return q; }

typedef short s16x4 __attribute__((ext_vector_type(4)));
__device__ __forceinline__ void lds_barrier() { asm volatile("s_waitcnt lgkmcnt(0)\n\ts_barrier" ::: "memory"); }
__device__ __forceinline__ bf16x8 tr_frag(unsigned base_bytes, int stride, int k0, int c0, int lane) {
    const int i16 = lane & 15, qq = i16 >> 2, p = i16 & 3, q = lane >> 4;
    const unsigned a0 = base_bytes + (unsigned)(((k0 + 8 * q + qq) * stride + c0 + 4 * p) * 2), a1 = a0 + (unsigned)(8 * stride);
    s16x4 lo, hi;
    asm volatile("ds_read_b64_tr_b16 %0, %2\n\tds_read_b64_tr_b16 %1, %3\n\ts_waitcnt lgkmcnt(0)" : "=&v"(lo), "=&v"(hi) : "v"(a0), "v"(a1) : "memory");
    return __builtin_shufflevector(lo, hi, 0, 1, 2, 3, 4, 5, 6, 7);
}

namespace pg8 {
constexpr int BM = 256, BK = 64, HALF = 128, HTB = HALF * BK * 2, STAGE_BYTES = 8 * HTB, NXCD = 8, WGM = 8;
__host__ __device__ __forceinline__ int lds_byte(int r, int c) { const int st = (r >> 4) * 2 + (c >> 5), rr = r & 15, cc = c & 31, ob = rr * 64 + cc * 2; return st * 1024 + (ob ^ (((ob >> 9) & 1) << 5)); }
__host__ __device__ __forceinline__ void stage_rc(int b, int& R, int& C) { const int st = b / 1024, sb = b % 1024, swz = sb ^ (((sb >> 9) & 1) << 5); R = (st >> 1) * 16 + swz / 64; C = (st & 1) * 32 + (swz % 64) / 2; }
__host__ __device__ __forceinline__ int perm32(int rho) { const int n = rho >> 4, i = rho & 15; return 8 * (i >> 2) + 4 * n + (i & 3); }
struct Unit { int pm, pn; };
struct Gemm { const bf16* A; const bf16* Bt; int M, N, K, lda; int kwin; };
__device__ __forceinline__ void unit_kwin(const Gemm& g, const Unit& u, int& k0t, int& ntl) { k0t = 0; ntl = g.K / BK; if (g.kwin) { const int blk = u.pn >> 2; if (blk < 2) { k0t = 0; ntl = 2; } else if (blk == 2) { k0t = 2; ntl = 4; } else { k0t = 4; ntl = 2; } } }
struct StaticOrder {
    int nM, nN, nwg, G, c;
    __device__ void init(int M_, int N_, int G_, int c_) { nM = M_ / BM; nN = N_ / BM; nwg = nM * nN; G = G_; c = c_; }
    __device__ bool next(int i, Unit& u) const {
        const long L = (long)i * G + c; if (L >= nwg) return false;
        int wgid = (int)L; { const int q = nwg / NXCD, r = nwg % NXCD, xcd = wgid % NXCD, off = wgid / NXCD; wgid = (xcd < r ? xcd * (q + 1) : r * (q + 1) + (xcd - r) * q) + off; }
        const int nig = WGM * nN, gid = wgid / nig, fm = gid * WGM, gsz = (nM - fm) < WGM ? (nM - fm) : WGM;
        u.pm = fm + ((wgid % nig) % gsz); u.pn = (wgid % nig) / gsz; return true;
    }
};
template <class F> struct EpiRow8 {
    static constexpr bool PERM = true;
    F f;
    __device__ __forceinline__ void operator()(const f32x4 (&acc)[2][2][4][2], const Unit& u, int wr, int wc, int fr, int fq) const {
        const int row0 = u.pm * BM + wr * 64 + fr, col0 = u.pn * BM + wc * 32 + 8 * fq;
#pragma unroll
        for (int g0 = 0; g0 < 16; g0 += F::GRP) {
            typename F::Tmp t[F::GRP];
#pragma unroll
            for (int j = 0; j < F::GRP; ++j) { const int i = g0 + j, ai = i >> 3, m = (i >> 1) & 3, bj = i & 1; f.load(row0 + ai * HALF + m * 16, col0 + bj * HALF, u.pn, t[j]); }
#pragma unroll
            for (int j = 0; j < F::GRP; ++j) { const int i = g0 + j, ai = i >> 3, m = (i >> 1) & 3, bj = i & 1; f.apply(row0 + ai * HALF + m * 16, col0 + bj * HALF, acc[ai][bj][m][0], acc[ai][bj][m][1], u.pn, t[j]); }
        }
    }
};


template <class Epi>
__device__ __forceinline__ void gemm_phase(LAS unsigned char* lds, const Gemm g, const StaticOrder& S, const Epi& E) {
    const int tid = threadIdx.x, wid = __builtin_amdgcn_readfirstlane(tid >> 6), lane = tid & 63, wr = wid >> 2, wc = wid & 3, fr = lane & 15, fq = lane >> 4;
    const int K = g.K, lda = g.lda;
    unsigned voffA[2], voffB[2];
#pragma unroll
    for (int i = 0; i < 2; ++i) { int R, C; stage_rc(tid * 16 + i * 8192, R, C); const int Rb = Epi::PERM ? ((R & ~31) + perm32(R & 31)) : R;
        voffA[i] = (unsigned)(R * lda + C) * 2u; voffB[i] = (unsigned)(Rb * K + C) * 2u; }
    const size_t kstep = (size_t)(BK * 2);
    const size_t hstepA = (size_t)HALF * lda * 2, hstepB = (size_t)HALF * K * 2;
    const size_t tstepA = 2 * hstepA, tstepB = 2 * hstepB;
    const unsigned ldsw = (unsigned)wid * 1024u;
    const int aoff = lds_byte(wr * 64 + fr, fq * 8), boff = lds_byte(wc * 32 + fr, fq * 8);
#define PG8_SA(b, h) (((b) * 2 + (h)) * HTB)
#define PG8_SB(b, h) ((4 + (b) * 2 + (h)) * HTB)
#define PG8_STAGE(bufoff, gbase, voff) do { _Pragma("unroll") for (int _i = 0; _i < 2; ++_i) \
        __builtin_amdgcn_global_load_lds((const unsigned*)((const char*)(gbase) + (voff)[_i]), (LAS unsigned*)(lds + (bufoff) + ldsw + _i * 8192), 16, 0, 0); } while (0)
#define PG8_LDA(dst, b, h) do { _Pragma("unroll") for (int m = 0; m < 4; ++m) _Pragma("unroll") for (int k = 0; k < 2; ++k) dst[m][k] = *(const LAS bf16x8*)(lds + PG8_SA(b, h) + aoff + m * 2048 + k * 1024); } while (0)
#define PG8_LDB(dst, b, h) do { _Pragma("unroll") for (int n = 0; n < 2; ++n) _Pragma("unroll") for (int k = 0; k < 2; ++k) dst[n][k] = *(const LAS bf16x8*)(lds + PG8_SB(b, h) + boff + n * 2048 + k * 1024); } while (0)
#define PG8_MMA(ai, bj, At, Bt) do { __builtin_amdgcn_s_setprio(1); _Pragma("unroll") for (int m = 0; m < 4; ++m) _Pragma("unroll") for (int n = 0; n < 2; ++n) _Pragma("unroll") for (int k = 0; k < 2; ++k) \
        acc[ai][bj][m][n] = __builtin_amdgcn_mfma_f32_16x16x32_bf16(Bt[n][k], At[m][k], acc[ai][bj][m][n], 0, 0, 0); __builtin_amdgcn_s_setprio(0); } while (0)
#define PG8_WAIT_V(n) asm volatile("s_waitcnt vmcnt(" #n ")" ::: "memory")
#define PG8_WAIT_L(n) asm volatile("s_waitcnt lgkmcnt(" #n ")" ::: "memory")
#define PG8_BAR __builtin_amdgcn_s_barrier()
#define PG8_SCHED __builtin_amdgcn_sched_barrier(0)
    Unit cur, nxt; int ui = 0;
    if (!S.next(0, cur)) return;
    f32x4 acc[2][2][4][2];
#pragma unroll
    for (int a = 0; a < 2; ++a)
#pragma unroll
        for (int b = 0; b < 2; ++b)
#pragma unroll
            for (int m = 0; m < 4; ++m)
#pragma unroll
                for (int n = 0; n < 2; ++n) acc[a][b][m][n] = (f32x4){0.f, 0.f, 0.f, 0.f};
    bf16x8 At[4][2], B0[2][2], B1[2][2];
    int k0c, nt; unit_kwin(g, cur, k0c, nt);
    const char* cA = (const char*)g.A + (size_t)cur.pm * tstepA + (size_t)k0c * kstep; const char* cB = (const char*)g.Bt + (size_t)cur.pn * tstepB + (size_t)k0c * kstep;
    PG8_STAGE(PG8_SB(0, 0), cB, voffB); PG8_STAGE(PG8_SA(0, 0), cA, voffA); PG8_STAGE(PG8_SB(0, 1), cB + hstepB, voffB); PG8_STAGE(PG8_SA(0, 1), cA + hstepA, voffA);
    if (wr == 1) PG8_BAR;
    PG8_WAIT_V(4); PG8_BAR;
    PG8_STAGE(PG8_SB(1, 0), cB + kstep, voffB); PG8_STAGE(PG8_SA(1, 0), cA + kstep, voffA); PG8_STAGE(PG8_SB(1, 1), cB + hstepB + kstep, voffB);
    PG8_WAIT_V(6); PG8_BAR;
    for (;;) {
        const bool has_next = S.next(ui + 1, nxt);
        int k0n = 0, ntn = nt; if (has_next) unit_kwin(g, nxt, k0n, ntn);
        const char* nA = has_next ? (const char*)g.A + (size_t)nxt.pm * tstepA + (size_t)k0n * kstep : cA; const char* nB = has_next ? (const char*)g.Bt + (size_t)nxt.pn * tstepB + (size_t)k0n * kstep : cB;
        for (int t = 0; t < nt; t += 2) {
            const bool last = (t == nt - 2);
            const char* a1 = cA + (size_t)(t + 1) * kstep;
            const char* a2 = last ? nA : cA + (size_t)(t + 2) * kstep; const char* b2 = last ? nB : cB + (size_t)(t + 2) * kstep;
            const char* a3 = a2 + kstep; const char* b3 = b2 + kstep;
            PG8_LDB(B0, 0, 0); PG8_SCHED; PG8_LDA(At, 0, 0); PG8_STAGE(PG8_SA(1, 1), a1 + hstepA, voffA);
            PG8_WAIT_L(8); PG8_BAR; PG8_WAIT_L(0); PG8_MMA(0, 0, At, B0); PG8_BAR; PG8_SCHED;
            PG8_LDB(B1, 0, 1); PG8_STAGE(PG8_SB(0, 0), b2, voffB);
            PG8_BAR; PG8_WAIT_L(0); PG8_MMA(0, 1, At, B1); PG8_BAR;
            PG8_LDA(At, 0, 1); PG8_STAGE(PG8_SA(0, 0), a2, voffA);
            PG8_BAR; PG8_WAIT_L(0); PG8_MMA(1, 0, At, B0); PG8_BAR; PG8_SCHED;
            PG8_STAGE(PG8_SB(0, 1), b2 + hstepB, voffB);
            PG8_WAIT_V(6); PG8_BAR; PG8_MMA(1, 1, At, B1); PG8_BAR;
            PG8_LDB(B0, 1, 0); PG8_SCHED; PG8_LDA(At, 1, 0); PG8_STAGE(PG8_SA(0, 1), a2 + hstepA, voffA);
            PG8_WAIT_L(8); PG8_BAR; PG8_WAIT_L(0); PG8_MMA(0, 0, At, B0); PG8_BAR; PG8_SCHED;
            PG8_LDB(B1, 1, 1); PG8_STAGE(PG8_SB(1, 0), b3, voffB);
            PG8_BAR; PG8_WAIT_L(0); PG8_MMA(0, 1, At, B1); PG8_BAR;
            PG8_LDA(At, 1, 1); PG8_STAGE(PG8_SA(1, 0), a3, voffA);
            PG8_BAR; PG8_WAIT_L(0); PG8_MMA(1, 0, At, B0); PG8_BAR; PG8_SCHED;
            PG8_STAGE(PG8_SB(1, 1), b3 + hstepB, voffB);
            PG8_WAIT_V(6); PG8_BAR; PG8_MMA(1, 1, At, B1); PG8_BAR;
        }
        E(acc, cur, wr, wc, fr, fq);
        if (!has_next) break;
#pragma unroll
        for (int a = 0; a < 2; ++a)
#pragma unroll
            for (int b = 0; b < 2; ++b)
#pragma unroll
                for (int m = 0; m < 4; ++m)
#pragma unroll
                    for (int n = 0; n < 2; ++n) acc[a][b][m][n] = (f32x4){0.f, 0.f, 0.f, 0.f};
        cur = nxt; cA = nA; cB = nB; nt = ntn; ++ui;
    }
    PG8_WAIT_V(0);
    if (wr == 0) PG8_BAR;
    PG8_BAR;
#undef PG8_SA
#undef PG8_SB
#undef PG8_STAGE
#undef PG8_LDA
#undef PG8_LDB
#undef PG8_MMA
#undef PG8_WAIT_V
#undef PG8_WAIT_L
#undef PG8_BAR
#undef PG8_SCHED
}
}

#define XB_TMO      128
#define XB_XCNT(j)  (256  + 64 * (j))
#define XB_XSUB(j)  (1280 + 64 * (j))
#define XB_XGEN(j)  (2304 + 64 * (j))
#define XB_TOP      3328
#define XB_TOPGEN   3392
#define XCD_BAR_WORDS 3456
#define XB_SPIN_CAP (1u << 18)
__device__ __forceinline__ unsigned xb_ld(unsigned* p)              { return __hip_atomic_load(p, __ATOMIC_RELAXED, __HIP_MEMORY_SCOPE_AGENT); }
__device__ __forceinline__ unsigned xb_add(unsigned* p, unsigned v) { return __hip_atomic_fetch_add(p, v, __ATOMIC_RELAXED, __HIP_MEMORY_SCOPE_AGENT); }
__device__ __forceinline__ unsigned xb_xcc_id() { return (unsigned)__builtin_amdgcn_s_getreg((3 << 11) | 20) & 0xFu; }
#define XB_SPIN(cond, bar) do { unsigned _sp = 0; while (cond) { __builtin_amdgcn_s_sleep(1); \
    if ((++_sp & 255u) == 0u) { if (xb_ld(&(bar)[XB_TMO])) break; if (_sp > XB_SPIN_CAP) { atomicAdd(&(bar)[XB_TMO], 1u); break; } } } } while (0)
struct XcdBarrier { unsigned* bar; unsigned x; volatile LAS unsigned* st; };
__device__ __forceinline__ XcdBarrier xcd_barrier_post(unsigned* bar, volatile LAS unsigned* st) {
    XcdBarrier b; b.bar = bar; b.x = xb_xcc_id(); b.st = st;
    if (threadIdx.x == 0) (void)xb_add(&bar[XB_XCNT(b.x)], 1u);
    return b;
}
__device__ __forceinline__ void xcd_barrier_complete(unsigned* bar, unsigned x, unsigned& nloc, unsigned& nx) {
    const unsigned G = gridDim.x * gridDim.y * gridDim.z;
    unsigned sum, cnt, mine, sp = 0u;
    for (;;) {
        sum = 0u; cnt = 0u; mine = 0u;
#pragma unroll
        for (unsigned j = 0; j < 16; ++j) { const unsigned c = xb_ld(&bar[XB_XCNT(j)]); sum += c; cnt += (c > 0u) ? 1u : 0u; mine = (j == x) ? c : mine; }
        if (sum == G) break;
        __builtin_amdgcn_s_sleep(1);
        if ((++sp & 255u) == 0u) { if (xb_ld(&bar[XB_TMO])) break; if (sp > XB_SPIN_CAP) { atomicAdd(&bar[XB_TMO], 1u); break; } }
    }
    nloc = mine > 0u ? mine : 1u; nx = cnt > 0u ? cnt : 1u;
}
__device__ __forceinline__ void xcd_barrier(const XcdBarrier& b) {
    asm volatile("s_waitcnt vmcnt(0)" ::: "memory");
    __syncthreads();
    if (threadIdx.x == 0) {
        unsigned* bar = b.bar;
        __builtin_amdgcn_s_waitcnt(0);
        unsigned nloc = b.st[0], nx = b.st[1];
        if (nloc == 0u) { xcd_barrier_complete(bar, b.x, nloc, nx); b.st[0] = nloc; b.st[1] = nx; }
        const unsigned old = xb_add(&bar[XB_XSUB(b.x)], 1u);
        const unsigned gen = old / nloc;
        if (old + 1u == (gen + 1u) * nloc) {
            __builtin_amdgcn_fence(__ATOMIC_RELEASE, "agent");
            asm volatile("s_waitcnt vmcnt(0)" ::: "memory");
            const unsigned og = xb_add(&bar[XB_TOP], 1u);
            const unsigned tg = og / nx;
            if (og + 1u == (tg + 1u) * nx) xb_add(&bar[XB_TOPGEN], 1u);
            else XB_SPIN(xb_ld(&bar[XB_TOPGEN]) == tg, bar);
            __builtin_amdgcn_fence(__ATOMIC_ACQUIRE, "agent");
            xb_add(&bar[XB_XGEN(b.x)], 1u);
            asm volatile("s_waitcnt vmcnt(0)" ::: "memory");
        } else {
            XB_SPIN(xb_ld(&bar[XB_XGEN(b.x)]) == gen, bar);
            __builtin_amdgcn_fence(__ATOMIC_ACQUIRE, "agent");
            asm volatile("s_waitcnt vmcnt(0)" ::: "memory");
        }
    }
    __syncthreads();
}

struct Args { const float* in[32]; float* out; unsigned char* ws; int lo, hi; };
typedef const Args __attribute__((address_space(4))) KArgs;
enum { I_X = 0, I_NMG, I_WIN, I_MU, I_W0, I_W2, I_A0, I_A2, I_G2, I_V0, I_V1, I_V2, I_KK, I_KA, I_RK, I_LNW, I_LNB, I_WRB, I_CW, I_CB, I_DTB, I_ALOG, I_SD, I_SNG, I_WSB, I_WOUT, I_NFG, I_WQ, I_SK, I_PD, I_PU, I_NFIN };

struct NoTmp {};
struct FStoreBf16 { bf16* O; int ldc; typedef NoTmp Tmp; static constexpr int GRP = 16;
    __device__ __forceinline__ void load(int, int, int, Tmp&) const {}
    __device__ __forceinline__ void apply(int row, int col, f32x4 v0, f32x4 v1, int, const Tmp&) const {
        v4u w; w.x = pk2(v0[0], v0[1]); w.y = pk2(v0[2], v0[3]); w.z = pk2(v1[0], v1[1]); w.w = pk2(v1[2], v1[3]);
        *(v4u*)(O + (size_t)row * ldc + col) = w; } };
struct FSigmoidBf16 { bf16* O; int ldc; typedef NoTmp Tmp; static constexpr int GRP = 16;
    __device__ __forceinline__ void load(int, int, int, Tmp&) const {}
    __device__ __forceinline__ void apply(int row, int col, f32x4 v0, f32x4 v1, int, const Tmp&) const {
        v4u w; w.x = pk2(sigmoidf_(v0[0]), sigmoidf_(v0[1])); w.y = pk2(sigmoidf_(v0[2]), sigmoidf_(v0[3])); w.z = pk2(sigmoidf_(v1[0]), sigmoidf_(v1[1])); w.w = pk2(sigmoidf_(v1[2]), sigmoidf_(v1[3]));
        *(v4u*)(O + (size_t)row * ldc + col) = w; } };
struct EpiLora {
    static constexpr bool PERM = true;
    bf16 *elog, *asig, *gg, *vmix; const bf16* vf; const float *w0, *a0, *v0;
    template <int BLK> __device__ __forceinline__ void run(const f32x4 (&acc)[2][2][4][2], int row0, int col0) const {
#pragma unroll
        for (int bj = 0; bj < 2; ++bj) {
            const int c = (col0 + bj * 128) & 1023;
            float bias[8];
            if (BLK == 0 || BLK == 1 || BLK == 3) { const float* bp = (BLK == 0 ? w0 : (BLK == 1 ? a0 : v0)) + c; const f32x4 b0 = *(const f32x4*)bp, b1 = *(const f32x4*)(bp + 4);
                bias[0] = b0[0]; bias[1] = b0[1]; bias[2] = b0[2]; bias[3] = b0[3]; bias[4] = b1[0]; bias[5] = b1[1]; bias[6] = b1[2]; bias[7] = b1[3]; }
#pragma unroll
            for (int ai = 0; ai < 2; ++ai) {
            v4u qvs[4], qvf[4];
            if (BLK == 3) {
#pragma unroll
                for (int i = 0; i < 4; ++i) { const size_t o = (size_t)(row0 + ai * 128 + i * 16) * D + c; qvs[i] = *(const v4u*)(vmix + o); qvf[i] = *(const v4u*)(vf + o); }
            }
#pragma unroll
                for (int m = 0; m < 4; ++m) {
                    const int row = row0 + ai * 128 + m * 16; const size_t o = (size_t)row * D + c;
                    const f32x4 v0_ = acc[ai][bj][m][0], v1_ = acc[ai][bj][m][1];
                    float a[8] = {v0_[0], v0_[1], v0_[2], v0_[3], v1_[0], v1_[1], v1_[2], v1_[3]};
                    if (BLK == 0) {
#pragma unroll
                        for (int e = 0; e < 8; ++e) a[e] = -0.6065306597f * sigmoidf_(bias[e] + a[e]);
                        *(v4u*)(elog + o) = pack8(a);
                    } else if (BLK == 1) {
#pragma unroll
                        for (int e = 0; e < 8; ++e) a[e] = sigmoidf_(bias[e] + a[e]);
                        *(v4u*)(asig + o) = pack8(a);
                    } else if (BLK == 2) {
                        *(v4u*)(gg + o) = pack8(a);
                    } else {
                        float vs[8], vfv[8]; unpack8(qvs[m], vs); unpack8(qvf[m], vfv);
#pragma unroll
                        for (int e = 0; e < 8; ++e) a[e] = vs[e] + (vfv[e] - vs[e]) * sigmoidf_(bias[e] + a[e]);
                        *(v4u*)(vmix + o) = pack8(a);
                    }
                }
            }
        }
    }
    __device__ __forceinline__ void operator()(const f32x4 (&acc)[2][2][4][2], const pg8::Unit& u, int wr, int wc, int fr, int fq) const {
        const int row0 = u.pm * 256 + wr * 64 + fr, col0 = u.pn * 256 + wc * 32 + 8 * fq;
        const int blk = u.pn >> 2;
        if (blk == 0) run<0>(acc, row0, col0); else if (blk == 1) run<1>(acc, row0, col0); else if (blk == 2) run<2>(acc, row0, col0); else run<3>(acc, row0, col0);
    }
};
struct FMixA { const bf16* gates; bf16* mixed;
    struct Tmp { v4u g; }; static constexpr int GRP = 8;
    __device__ __forceinline__ void load(int row, int col, int, Tmp& t) const { t.g = *(const v4u*)(gates + (size_t)row * 2048 + col); }
    __device__ __forceinline__ void apply(int row, int col, f32x4 v0, f32x4 v1, int, const Tmp& t) const {
        float g[8]; unpack8(t.g, g);
        float a[8] = {v0[0] * g[0], v0[1] * g[1], v0[2] * g[2], v0[3] * g[3], v1[0] * g[4], v1[1] * g[5], v1[2] * g[6], v1[3] * g[7]};
        *(v4u*)(mixed + (size_t)row * D + col) = pack8(a); } };
struct FMixB { const bf16* gates; bf16* mixed;
    struct Tmp { v4u g, mx; }; static constexpr int GRP = 8;
    __device__ __forceinline__ void load(int row, int col, int, Tmp& t) const { t.g = *(const v4u*)(gates + (size_t)row * 2048 + 1024 + col); t.mx = *(const v4u*)(mixed + (size_t)row * D + col); }
    __device__ __forceinline__ void apply(int row, int col, f32x4 v0, f32x4 v1, int, const Tmp& t) const {
        float g[8], mx[8]; unpack8(t.g, g); unpack8(t.mx, mx);
        float a[8] = {mx[0] + v0[0] * g[0], mx[1] + v0[1] * g[1], mx[2] + v0[2] * g[2], mx[3] + v0[3] * g[3], mx[4] + v1[0] * g[4], mx[5] + v1[1] * g[5], mx[6] + v1[2] * g[6], mx[7] + v1[3] * g[7]};
        *(v4u*)(mixed + (size_t)row * D + col) = pack8(a); } };
struct FResid { const float* base; float* h;
    struct Tmp { f32x4 a, b; }; static constexpr int GRP = 8;
    __device__ __forceinline__ void load(int row, int col, int, Tmp& t) const { const f32x4* s = (const f32x4*)(base + (size_t)row * D + col); t.a = s[0]; t.b = s[1]; }
    __device__ __forceinline__ void apply(int row, int col, f32x4 v0, f32x4 v1, int, const Tmp& t) const {
        f32x4* p = (f32x4*)(h + (size_t)row * D + col); p[0] = t.a + v0; p[1] = t.b + v1; } };

struct Ctx { int tid, lane, wave, G, bid; LAS unsigned char* lds; };

__device__ __forceinline__ void transpose_item(const float* W, int K, int N, bf16* WT, int row_off, LAS float* scr, int item, int lane) {
    const int nblk = N / 32, kb = item / nblk, nb = item % nblk, k0 = 64 * kb, n0 = 32 * nb;
#pragma unroll 8
    for (int i = 0; i < 32; ++i) { const int kk = 2 * i + (lane >> 5); scr[kk * 33 + (lane & 31)] = W[(size_t)(k0 + kk) * N + n0 + (lane & 31)]; }
    asm volatile("s_waitcnt lgkmcnt(0)" ::: "memory");
    const int c = lane & 7;
#pragma unroll
    for (int j = 0; j < 4; ++j) { const int n = (lane >> 3) + 8 * j; const LAS float* s = scr + (8 * c) * 33 + n;
        v4u o; o.x = pk2(s[0 * 33], s[1 * 33]); o.y = pk2(s[2 * 33], s[3 * 33]); o.z = pk2(s[4 * 33], s[5 * 33]); o.w = pk2(s[6 * 33], s[7 * 33]);
        *(v4u*)(WT + (size_t)(row_off + n0 + n) * K + k0 + 8 * c) = o; }
    asm volatile("s_waitcnt lgkmcnt(0)" ::: "memory");
}
__device__ __forceinline__ int winrow(int n) {
    if (n < RW_PROJ) return n;
    if (n < RW_PROJ + 5120) return N1P + (n - RW_PROJ);
    if (n < RW_PROJ + SSD_PROJ) return DT_COL + (n - RW_PROJ - 5120);
    return N1P + N2P + (n - RW_PROJ - SSD_PROJ); }

__device__ __forceinline__ void phase_prologue(const Ctx& c, KArgs& a) {
    unsigned char* ws = a.ws;
    LAS float* scr = (LAS float*)(c.lds + c.wave * 16384);
    const int gw = c.bid * 8 + c.wave, NGW = c.G * 8;
    constexpr int I_IN = 16 * (IN_PROJ / 32), I_A = 16 * 32, I_B = 32 * 32, I_O = 16 * 32, I_L = I_IN + I_A + I_B + I_O;
    for (int it = gw; it < 2 * I_L; it += NGW) {
        const int l = it / I_L; int r = it % I_L;
        if (r < I_IN) { const int nb = r % (IN_PROJ / 32); transpose_item(a.in[I_WIN] + (size_t)l * D * IN_PROJ, D, IN_PROJ, (bf16*)(ws + WS_WIN + l * WIN_L), winrow(nb * 32) - nb * 32, scr, r, c.lane); continue; } r -= I_IN;
        if (r < I_A) { transpose_item(a.in[I_WRB] + (size_t)l * D * D, D, D, (bf16*)(ws + WS_WA) + (size_t)l * D * D, 0, scr, r, c.lane); continue; } r -= I_A;
        if (r < I_B) { transpose_item(a.in[I_WSB] + (size_t)l * 2048 * D, 2048, D, (bf16*)(ws + WS_WB) + (size_t)l * D * 2048, 0, scr, r, c.lane); continue; } r -= I_B;
        transpose_item(a.in[I_WOUT] + (size_t)l * D * D, D, D, (bf16*)(ws + WS_WO) + (size_t)l * D * D, 0, scr, r, c.lane);
    }
    for (int it = c.bid * 512 + c.tid; it < 2 * 192 * 128; it += c.G * 512) {
        const int l = it / (192 * 128), r = (it / 128) % 192, q = it % 128;
        *(v4u*)((bf16*)(ws + WS_WIN + l * WIN_L) + (size_t)(DT_COL + 32 + r) * D + q * 8) = (v4u){0u, 0u, 0u, 0u};
    }
    for (int it = c.bid * 512 + c.tid; it < 2 * 4096 * KL; it += c.G * 512) {
        const int l = it / (4096 * KL), n = (it / KL) % 4096, k = it % KL; const int blk = n >> 10, cc = n & 1023;
        float v = 0.f;
        if (blk == 0) { if (k < 64) v = a.in[I_W2][((size_t)l * 64 + k) * D + cc]; }
        else if (blk == 1) { if (k >= 64 && k < 128) v = a.in[I_A2][((size_t)l * 64 + (k - 64)) * D + cc]; }
        else if (blk == 2) { if (k >= 128 && k < 288) v = a.in[I_G2][((size_t)l * 160 + (k - 128)) * D + cc]; }
        else { if (l == 1 && k >= 288 && k < 320) v = a.in[I_V2][(size_t)(k - 288) * D + cc]; }
        ((bf16*)(ws + WS_WLORA + l * WLORA_L))[(size_t)n * KL + k] = (bf16)f2bf(v);
    }
    __syncthreads();
    LAS float* wqL = (LAS float*)c.lds;
    LAS float* kyL = (LAS float*)(c.lds + 32768);
    for (int it = c.bid; it < 2 * 16 * 16; it += c.G) {
        const int l = it >> 8, hc = (it >> 4) & 15, k0 = (it & 15) * 64;
        const float* wq = a.in[I_WQ] + (size_t)l * D * 2048; const float* ky = a.in[I_SK] + ((size_t)l * 16 + hc) * 128 * 128;
        for (int e = c.tid; e < 64 * 128; e += 512) wqL[e] = wq[(size_t)(k0 + (e >> 7)) * 2048 + hc * 128 + (e & 127)];
        for (int e = c.tid; e < 128 * 128; e += 512) kyL[(e >> 7) * 129 + (e & 127)] = ky[e];
        __syncthreads();
        const int key = c.tid & 127, kg = c.tid >> 7;
        float acc[16];
#pragma unroll
        for (int i = 0; i < 16; ++i) acc[i] = 0.f;
        for (int d = 0; d < 128; ++d) { const float kv = kyL[key * 129 + d];
#pragma unroll
            for (int i = 0; i < 16; ++i) acc[i] += wqL[(kg * 16 + i) * 128 + d] * kv; }
        bf16* o = (bf16*)(ws + WS_WQK) + ((size_t)l * 2048 + hc * 128 + key) * D + k0 + kg * 16;
        v4u q0, q1; q0.x = pk2(acc[0], acc[1]); q0.y = pk2(acc[2], acc[3]); q0.z = pk2(acc[4], acc[5]); q0.w = pk2(acc[6], acc[7]);
        q1.x = pk2(acc[8], acc[9]); q1.y = pk2(acc[10], acc[11]); q1.z = pk2(acc[12], acc[13]); q1.w = pk2(acc[14], acc[15]);
        *(v4u*)o = q0; *(v4u*)(o + 8) = q1;
        __syncthreads();
    }
}

__device__ __forceinline__ void phase_rmsnorm(const Ctx& c, const float* src, const float* g, bf16* U, float* copy_to) {
    const int gw = c.bid * 8 + c.wave, NGW = c.G * 8;
    f32x4 gv[4];
#pragma unroll
    for (int j = 0; j < 4; ++j) gv[j] = *((const f32x4*)g + c.lane + 64 * j);
    f32x4 nv[4];
    if (gw < M) { const f32x4* xr0 = (const f32x4*)(src + (size_t)gw * D) + c.lane;
#pragma unroll
        for (int j = 0; j < 4; ++j) nv[j] = xr0[64 * j]; }
    for (int m = gw; m < M; m += NGW) {
        f32x4 v[4]; float s = 0.f;
#pragma unroll
        for (int j = 0; j < 4; ++j) { v[j] = nv[j]; s += (v[j].x * v[j].x + v[j].y * v[j].y) + (v[j].z * v[j].z + v[j].w * v[j].w); }
        if (m + NGW < M) { const f32x4* xn = (const f32x4*)(src + (size_t)(m + NGW) * D) + c.lane;
#pragma unroll
            for (int j = 0; j < 4; ++j) nv[j] = xn[64 * j]; }
        if (copy_to) { f32x4* cr = (f32x4*)(copy_to + (size_t)m * D) + c.lane;
#pragma unroll
            for (int j = 0; j < 4; ++j) cr[64 * j] = v[j]; }
        const float r = rsqrtf(sum64(s) * (1.f / D) + 1e-6f);
        v2u* o = (v2u*)(U + (size_t)m * D) + c.lane;
#pragma unroll
        for (int j = 0; j < 4; ++j) { v2u w; w.x = pk2(v[j].x * r * gv[j].x, v[j].y * r * gv[j].y); w.y = pk2(v[j].z * r * gv[j].z, v[j].w * r * gv[j].w); o[64 * j] = w; }
    }
}
__device__ __forceinline__ void phase_final(const Ctx& c, float* out, const float* g) {
    const int gw = c.bid * 8 + c.wave, NGW = c.G * 8;
    f32x4 gv[4];
#pragma unroll
    for (int j = 0; j < 4; ++j) gv[j] = *((const f32x4*)g + c.lane + 64 * j);
    for (int m = gw; m < M; m += NGW) {
        f32x4* xr = (f32x4*)(out + (size_t)m * D) + c.lane;
        f32x4 v[4]; float s = 0.f;
#pragma unroll
        for (int j = 0; j < 4; ++j) { v[j] = xr[64 * j]; s += (v[j].x * v[j].x + v[j].y * v[j].y) + (v[j].z * v[j].z + v[j].w * v[j].w); }
        const float r = rsqrtf(sum64(s) * (1.f / D) + 1e-6f);
#pragma unroll
        for (int j = 0; j < 4; ++j) xr[64 * j] = v[j] * r * gv[j];
    }
}

__device__ __forceinline__ void phase_rwkv_prep(const Ctx& c, KArgs& a, int l, int hb) {
    unsigned char* ws = a.ws;
    const bf16* PR = (const bf16*)(ws + WS_OV + OV_PR);
    bf16* AL = (bf16*)(ws + WS_OV + OV_AL);
    bf16* VS = l == 0 ? (bf16*)(ws + WS_VF) + (size_t)hb * MH * D : (bf16*)(ws + WS_OV + OV_VMIX);
    const float* mu = a.in[I_MU] + (size_t)l * RW_PROJ;
    LAS bf16* v1L = (LAS bf16*)c.lds;
    if (l == 1) {
        const float* v1 = a.in[I_V1];
        for (int e = c.tid; e < 1024 * 32; e += 512) { const int cc = e >> 5, j = e & 31; v1L[((cc & 15) * 64 + (cc >> 4)) * 40 + j] = (bf16)f2bf(v1[e]); }
        __syncthreads();
    }
    const int gw = c.bid * 8 + c.wave, NGW = c.G * 8, lane = c.lane;
    float muv[16], mul[8];
#pragma unroll
    for (int e = 0; e < 16; ++e) muv[e] = mu[2048 + 16 * lane + e];
#pragma unroll
    for (int e = 0; e < 8; ++e) mul[e] = lane < 36 ? mu[3072 + 8 * lane + e] : 0.f;
    const int per = (MH + NGW - 1) / NGW;
    const int mA = gw * per, mB = (mA + per < MH) ? mA + per : MH;
    v4u cq0, cq1, cql, pq0, pq1, pql;
    const v4u zz4 = (v4u){0u, 0u, 0u, 0u};
    const int lcol = lane < 36 ? 3072 + 8 * lane : 3072;
    if (mA < mB) {
        const bf16* row = PR + (size_t)mA * N1P;
        cq0 = *(const v4u*)(row + 2048 + 16 * lane); cq1 = *(const v4u*)(row + 2048 + 16 * lane + 8); cql = *(const v4u*)(row + lcol);
        if ((mA & (T - 1)) != 0) { pq0 = *(const v4u*)(row - N1P + 2048 + 16 * lane); pq1 = *(const v4u*)(row - N1P + 2048 + 16 * lane + 8); pql = *(const v4u*)(row - N1P + lcol); }
        else { pq0 = zz4; pq1 = zz4; pql = zz4; }
    }
    for (int m = mA; m < mB; ++m) {
        const v4u q0 = cq0, q1 = cq1, ql = cql;
        v4u r0 = pq0, r1 = pq1, rl = pql;
        if ((m & (T - 1)) == 0) { r0 = zz4; r1 = zz4; rl = zz4; }
        if (m + 1 < mB) { const bf16* nrow = PR + (size_t)(m + 1) * N1P; cq0 = *(const v4u*)(nrow + 2048 + 16 * lane); cq1 = *(const v4u*)(nrow + 2048 + 16 * lane + 8); cql = *(const v4u*)(nrow + lcol); }
        pq0 = q0; pq1 = q1; pql = ql;
        float vs[16];
        {
            float p[16], pp[16];
            float t8[8];
            unpack8(q0, t8);
#pragma unroll
            for (int e = 0; e < 8; ++e) p[e] = t8[e];
            unpack8(q1, t8);
#pragma unroll
            for (int e = 0; e < 8; ++e) p[8 + e] = t8[e];
            unpack8(r0, t8);
#pragma unroll
            for (int e = 0; e < 8; ++e) pp[e] = t8[e];
            unpack8(r1, t8);
#pragma unroll
            for (int e = 0; e < 8; ++e) pp[8 + e] = t8[e];
#pragma unroll
            for (int e = 0; e < 16; ++e) vs[e] = p[e] + (pp[e] - p[e]) * muv[e];
            v4u o0, o1;
            o0.x = pk2(vs[0], vs[1]); o0.y = pk2(vs[2], vs[3]); o0.z = pk2(vs[4], vs[5]); o0.w = pk2(vs[6], vs[7]);
            o1.x = pk2(vs[8], vs[9]); o1.y = pk2(vs[10], vs[11]); o1.z = pk2(vs[12], vs[13]); o1.w = pk2(vs[14], vs[15]);
            *(v4u*)(VS + (size_t)m * D + 16 * lane) = o0; *(v4u*)(VS + (size_t)m * D + 16 * lane + 8) = o1;
        }
        if (lane < 36) {
            float p[8], pp[8], s[8];
            unpack8(ql, p);
            unpack8(rl, pp);
#pragma unroll
            for (int e = 0; e < 8; ++e) { const float x = p[e] + (pp[e] - p[e]) * mul[e]; s[e] = lane < 8 ? tanhf(x) : (lane < 16 ? x : sigmoidf_(x)); }
            *(v4u*)(AL + (size_t)m * KL + 8 * lane) = pack8(s);
        } else if (lane < 48 && !(l == 1 && lane < 40)) {
            *(v4u*)(AL + (size_t)m * KL + 8 * lane) = (v4u){0u, 0u, 0u, 0u};
        }
        if (l == 1) {
            float acc[32];
#pragma unroll
            for (int j = 0; j < 32; ++j) acc[j] = 0.f;
#pragma unroll
            for (int i = 0; i < 16; ++i) {
                const LAS v4u* wp = (const LAS v4u*)(v1L + (i * 64 + lane) * 40);
#pragma unroll
                for (int q = 0; q < 4; ++q) { float w8[8]; const v4u wq_ = wp[q]; unpack8(wq_, w8);
#pragma unroll
                    for (int e = 0; e < 8; ++e) acc[q * 8 + e] += vs[i] * w8[e]; }
            }
#pragma unroll
            for (int s = 32, half = 16; s >= 2; s >>= 1, half >>= 1) {
                const bool up = (lane & s) != 0;
#pragma unroll
                for (int i = 0; i < 16; ++i) if (i < half) { const float send = up ? acc[i] : acc[i + half]; const float keep = up ? acc[i + half] : acc[i]; acc[i] = keep + __shfl_xor(send, s); }
            }
            acc[0] += __shfl_xor(acc[0], 1);
            const int j = ((lane & 32) ? 16 : 0) + ((lane & 16) ? 8 : 0) + ((lane & 8) ? 4 : 0) + ((lane & 4) ? 2 : 0) + ((lane & 2) ? 1 : 0);
            if ((lane & 1) == 0) AL[(size_t)m * KL + 288 + j] = (bf16)f2bf(acc[0]);
        }
    }
    { float* DT = (float*)(ws + WS_OV + OV_DT); float* DA = (float*)(ws + WS_OV + OV_DA);
      for (int it = gw; it < (MH / 64) * 32; it += NGW) {
        const int ck = it >> 5, h = it & 31;
        const size_t m = (size_t)ck * 64 + lane;
        const float x = bf1(PR[m * N1P + DT_COL + h]) + a.in[I_DTB][l * 32 + h];
        const float dt = x > 20.f ? x : log1pf(__expf(x));
        float cs = -dt * __expf(a.in[I_ALOG][l * 32 + h]);
#pragma unroll
        for (int o = 1; o < 64; o <<= 1) { const float y = __shfl_up(cs, o); cs += (lane >= o) ? y : 0.f; }
        DT[m * 32 + h] = dt; DA[m * 32 + h] = cs;
      } }
}

__device__ __forceinline__ float sum8(float x) { x += dpp_mov<0xB1>(x); x += dpp_mov<0x4E>(x); x += dpp_mov<0x141>(x); return x; }
__device__ __forceinline__ void phase_rwkv_rec(const Ctx& c, KArgs& a, int l, int hb) {
    unsigned char* ws = a.ws;
    const bf16* PR = (const bf16*)(ws + WS_OV + OV_PR);
    const bf16* ELOG = (const bf16*)(ws + WS_OV + OV_ELOG);
    const bf16* ASIG = (const bf16*)(ws + WS_OV + OV_ASIG);
    const bf16* VS = l == 0 ? (const bf16*)(ws + WS_VF) + (size_t)hb * MH * D : (const bf16*)(ws + WS_OV + OV_VMIX);
    bf16* Y = (bf16*)(ws + WS_OV + OV_YA);
    const float* mu = a.in[I_MU] + (size_t)l * RW_PROJ;
    const float* k_k = a.in[I_KK] + (size_t)l * D; const float* k_a = a.in[I_KA] + (size_t)l * D;
    constexpr int CH = 32, NCH = T / CH;
    constexpr int ARRF = CH * 64;
    constexpr int BUFF = 5 * ARRF + CH * 16 + CH * 2;
    LAS float* ldsf = (LAS float*)c.lds;
    LAS float* yt = ldsf + 2 * BUFF;
    const int tid = c.tid, lane = c.lane;
    const bool is_prep = c.wave >= 4;
    const int ptid = tid - 256, tt = ptid >> 3, l8 = ptid & 7, pc = l8 * 8;
    const int rrow = c.wave * 4 + (lane >> 4), cc4 = (lane & 15) * 4;
    for (int unit = c.bid; unit < 256; unit += c.G) {
        const int b = unit >> 6, h = (unit >> 2) & 15, rq = unit & 3;
        const size_t m0 = (size_t)b * T;
        const int hc = h * 64 + pc;
        float mur[8], muk[8], kkc[8], kac[8];
        if (is_prep) {
#pragma unroll
            for (int e = 0; e < 8; ++e) { mur[e] = mu[hc + e]; muk[e] = mu[1024 + hc + e]; kkc[e] = k_k[hc + e]; kac[e] = k_a[hc + e]; }
        }
        float S[4] = {0.f, 0.f, 0.f, 0.f}, sa = 0.f;
#define RW_PREP(chunk, bufp) do { \
            const int t_ = (chunk) * CH + tt; const size_t mm = m0 + t_; const bf16* row = PR + mm * N1P + hc; \
            const v4u zr = (v4u){0u, 0u, 0u, 0u}; \
            const v4u qr = *(const v4u*)row, qk = *(const v4u*)(row + 1024); \
            const v4u qrp = t_ > 0 ? *(const v4u*)(row - N1P) : zr, qkp = t_ > 0 ? *(const v4u*)(row - N1P + 1024) : zr; \
            const v4u qkn = t_ + 1 < T ? *(const v4u*)(row + N1P + 1024) : zr; \
            const v4u qas = *(const v4u*)(ASIG + mm * D + hc), qel = *(const v4u*)(ELOG + mm * D + hc); \
            v4u qv = zr; if (l8 < 2) qv = *(const v4u*)(VS + mm * D + h * 64 + rq * 16 + l8 * 8); \
            float r_[8], rp_[8], k_[8], kp_[8], kn_[8], as_[8], el_[8]; \
            unpack8(qr, r_); unpack8(qrp, rp_); unpack8(qk, k_); unpack8(qkp, kp_); unpack8(qkn, kn_); unpack8(qas, as_); unpack8(qel, el_); \
            float ks_[8], kk_[8], kkn_[8], s1 = 0.f, s2 = 0.f; \
            _Pragma("unroll") for (int e = 0; e < 8; ++e) { ks_[e] = k_[e] + (kp_[e] - k_[e]) * muk[e]; const float kn1 = kn_[e] + (k_[e] - kn_[e]) * muk[e]; \
                kk_[e] = ks_[e] * kkc[e]; kkn_[e] = kn1 * kkc[e]; s1 += kk_[e] * kk_[e]; s2 += kkn_[e] * kkn_[e]; } \
            s1 = sum8(s1); s2 = sum8(s2); \
            const float i1 = rsqrtf(s1 + 1e-12f), i2 = (t_ + 1 < T) ? rsqrtf(s2 + 1e-12f) : 0.f; \
            float ow[8], ok[8], ob[8], orr[8], owa[8], c1 = 0.f, c2 = 0.f; \
            _Pragma("unroll") for (int e = 0; e < 8; ++e) { const float kn = kk_[e] * i1, an = -kkn_[e] * i2; \
                ow[e] = __expf(el_[e]); ok[e] = ks_[e] * (1.f + (as_[e] - 1.f) * kac[e]); ob[e] = kn * as_[e]; orr[e] = r_[e] + (rp_[e] - r_[e]) * mur[e]; \
                owa[e] = ow[e] * an; c1 += ob[e] * an; c2 += ok[e] * an; } \
            c1 = sum8(c1); c2 = sum8(c2); \
            LAS float* bp_ = (bufp) + tt * 64 + pc; \
            *(LAS f32x4*)(bp_) = (f32x4){ow[0], ow[1], ow[2], ow[3]}; *(LAS f32x4*)(bp_ + 4) = (f32x4){ow[4], ow[5], ow[6], ow[7]}; \
            *(LAS f32x4*)(bp_ + ARRF) = (f32x4){ok[0], ok[1], ok[2], ok[3]}; *(LAS f32x4*)(bp_ + ARRF + 4) = (f32x4){ok[4], ok[5], ok[6], ok[7]}; \
            *(LAS f32x4*)(bp_ + 2 * ARRF) = (f32x4){ob[0], ob[1], ob[2], ob[3]}; *(LAS f32x4*)(bp_ + 2 * ARRF + 4) = (f32x4){ob[4], ob[5], ob[6], ob[7]}; \
            *(LAS f32x4*)(bp_ + 3 * ARRF) = (f32x4){orr[0], orr[1], orr[2], orr[3]}; *(LAS f32x4*)(bp_ + 3 * ARRF + 4) = (f32x4){orr[4], orr[5], orr[6], orr[7]}; \
            *(LAS f32x4*)(bp_ + 4 * ARRF) = (f32x4){owa[0], owa[1], owa[2], owa[3]}; *(LAS f32x4*)(bp_ + 4 * ARRF + 4) = (f32x4){owa[4], owa[5], owa[6], owa[7]}; \
            if (l8 < 2) { float v_[8]; unpack8(qv, v_); LAS float* vp_ = (bufp) + 5 * ARRF + tt * 16 + l8 * 8; \
                *(LAS f32x4*)vp_ = (f32x4){v_[0], v_[1], v_[2], v_[3]}; *(LAS f32x4*)(vp_ + 4) = (f32x4){v_[4], v_[5], v_[6], v_[7]}; } \
            if (l8 == 0) { (bufp)[5 * ARRF + CH * 16 + tt * 2] = c1; (bufp)[5 * ARRF + CH * 16 + tt * 2 + 1] = c2; } } while (0)
#define RW_YSTORE(chunk) do { const LAS float* yp_ = yt + ((chunk) & 1) * CH * 16 + tt * 16 + l8 * 2; \
            *(unsigned*)(Y + (m0 + (size_t)(chunk) * CH + tt) * D + h * 64 + rq * 16 + l8 * 2) = pk2(yp_[0], yp_[1]); } while (0)
        if (is_prep) RW_PREP(0, ldsf);
        __syncthreads();
        for (int ch = 0; ch < NCH; ++ch) {
            if (is_prep) {
                if (ch + 1 < NCH) RW_PREP(ch + 1, ldsf + ((ch + 1) & 1) * BUFF);
                if (ch > 0) RW_YSTORE(ch - 1);
            } else {
                const LAS float* buf = ldsf + (ch & 1) * BUFF;
                LAS float* yw = yt + (ch & 1) * CH * 16;
                const int lane15 = lane & 15;
                f32x4 w4 = *(const LAS f32x4*)(buf + cc4), k4 = *(const LAS f32x4*)(buf + ARRF + cc4), b4 = *(const LAS f32x4*)(buf + 2 * ARRF + cc4);
                f32x4 r4 = *(const LAS f32x4*)(buf + 3 * ARRF + cc4), wa4 = *(const LAS f32x4*)(buf + 4 * ARRF + cc4);
                float v = buf[5 * ARRF + rrow]; f32x2 cc = *(const LAS f32x2*)(buf + 5 * ARRF + CH * 16);
#pragma unroll 1
                for (int t16 = 0; t16 < CH; t16 += 16) {
                    float ysave = 0.f;
#pragma unroll
                    for (int u = 0; u < 16; ++u) {
                        const int tn = (t16 + u + 1 < CH) ? t16 + u + 1 : t16 + u;
                        const f32x4 nw4 = *(const LAS f32x4*)(buf + tn * 64 + cc4), nk4 = *(const LAS f32x4*)(buf + ARRF + tn * 64 + cc4), nb4 = *(const LAS f32x4*)(buf + 2 * ARRF + tn * 64 + cc4);
                        const f32x4 nr4 = *(const LAS f32x4*)(buf + 3 * ARRF + tn * 64 + cc4), nwa4 = *(const LAS f32x4*)(buf + 4 * ARRF + tn * 64 + cc4);
                        const float nv = buf[5 * ARRF + tn * 16 + rrow]; const f32x2 ncc = *(const LAS f32x2*)(buf + 5 * ARRF + CH * 16 + tn * 2);
                        float d = S[0] * wa4[0]; d = __builtin_fmaf(S[1], wa4[1], d); d = __builtin_fmaf(S[2], wa4[2], d); d = __builtin_fmaf(S[3], wa4[3], d);
#pragma unroll
                        for (int e = 0; e < 4; ++e) { float tmp = S[e] * w4[e]; asm volatile("" : "+v"(tmp)); tmp = __builtin_fmaf(v, k4[e], tmp); S[e] = __builtin_fmaf(sa, b4[e], tmp); asm volatile("" : "+v"(S[e])); }
                        const float sa_next = __builtin_fmaf(v, cc.y, sa * cc.x);
                        float y = S[0] * r4[0]; y = __builtin_fmaf(S[1], r4[1], y); y = __builtin_fmaf(S[2], r4[2], y); y = __builtin_fmaf(S[3], r4[3], y);
                        d = sum16(d); y = sum16(y);
                        sa = d + sa_next;
                        ysave = (lane15 == u) ? y : ysave;
                        w4 = nw4; k4 = nk4; b4 = nb4; r4 = nr4; wa4 = nwa4; v = nv; cc = ncc;
                    }
                    yw[(t16 + lane15) * 16 + rrow] = ysave;
                }
            }
            __syncthreads();
        }
        if (is_prep) RW_YSTORE(NCH - 1);
        __syncthreads();
#undef RW_PREP
#undef RW_YSTORE
    }
}

constexpr int CK_TS = 72, CK_TB = 64 * CK_TS;
__device__ __forceinline__ void tr_a2(unsigned a, bf16x8& f0, bf16x8& f1) {
    s16x4 l0, h0, l1, h1;
    asm volatile("ds_read_b64_tr_b16 %0, %4\n\tds_read_b64_tr_b16 %1, %4 offset:576\n\tds_read_b64_tr_b16 %2, %4 offset:4608\n\tds_read_b64_tr_b16 %3, %4 offset:5184\n\ts_waitcnt lgkmcnt(0)"
                 : "=&v"(l0), "=&v"(h0), "=&v"(l1), "=&v"(h1) : "v"(a) : "memory");
    f0 = __builtin_shufflevector(l0, h0, 0, 1, 2, 3, 4, 5, 6, 7); f1 = __builtin_shufflevector(l1, h1, 0, 1, 2, 3, 4, 5, 6, 7);
}
__device__ __forceinline__ void tr_b4(unsigned a, bf16x8& f00, bf16x8& f01, bf16x8& f10, bf16x8& f11) {
    s16x4 l0, h0, l1, h1, l2, h2, l3, h3;
    asm volatile("ds_read_b64_tr_b16 %0, %8\n\tds_read_b64_tr_b16 %1, %8 offset:576\n\tds_read_b64_tr_b16 %2, %8 offset:4608\n\tds_read_b64_tr_b16 %3, %8 offset:5184\n\t"
                 "ds_read_b64_tr_b16 %4, %8 offset:32\n\tds_read_b64_tr_b16 %5, %8 offset:608\n\tds_read_b64_tr_b16 %6, %8 offset:4640\n\tds_read_b64_tr_b16 %7, %8 offset:5216\n\ts_waitcnt lgkmcnt(0)"
                 : "=&v"(l0), "=&v"(h0), "=&v"(l1), "=&v"(h1), "=&v"(l2), "=&v"(h2), "=&v"(l3), "=&v"(h3) : "v"(a) : "memory");
    f00 = __builtin_shufflevector(l0, h0, 0, 1, 2, 3, 4, 5, 6, 7); f01 = __builtin_shufflevector(l1, h1, 0, 1, 2, 3, 4, 5, 6, 7);
    f10 = __builtin_shufflevector(l2, h2, 0, 1, 2, 3, 4, 5, 6, 7); f11 = __builtin_shufflevector(l3, h3, 0, 1, 2, 3, 4, 5, 6, 7);
}
template <int PA, int QA, int MASK, int NINIT, int NPAIR, int POST>
__device__ __forceinline__ void mm64(LAS bf16* X, const LAS bf16* P, const LAS bf16* Q, const LAS bf16* P2, const LAS bf16* Q2, const LAS bf16* E1, const LAS bf16* E2,
                                     const LAS float* cscale, const LAS float* wc, int w, int lane) {
    const int r = lane & 15, q = lane >> 4, Ct = w >> 1, Rt0 = 2 * (w & 1);
    const int i16 = lane & 15, qq = i16 >> 2, p4 = i16 & 3;
    const int troff = ((8 * q + qq) * CK_TS + 4 * p4) * 2;
    f32x4 acc[2];
#pragma unroll
    for (int i = 0; i < 2; ++i) {
        const int R = 16 * (Rt0 + i) + r;
        if (NINIT == 0) acc[i] = (f32x4){0.f, 0.f, 0.f, 0.f};
        else { const v2u e1 = *(const LAS v2u*)(E1 + R * CK_TS + 16 * Ct + 4 * q); acc[i] = (f32x4){bflo(e1.x), bfhi(e1.x), bflo(e1.y), bfhi(e1.y)};
            if (NINIT == 2) { const v2u e2 = *(const LAS v2u*)(E2 + R * CK_TS + 16 * Ct + 4 * q); acc[i] += (f32x4){bflo(e2.x), bfhi(e2.x), bflo(e2.y), bfhi(e2.y)}; } }
    }
#pragma unroll
    for (int pr = 0; pr < NPAIR; ++pr) {
        const LAS bf16* Pp = pr == 0 ? P : P2; const LAS bf16* Qp = pr == 0 ? Q : Q2;
        bf16x8 af[2], bfr[2][2];
        if (PA == 0) {
#pragma unroll
            for (int i = 0; i < 2; ++i)
#pragma unroll
                for (int ks = 0; ks < 2; ++ks) bfr[i][ks] = *(const LAS bf16x8*)(Pp + (16 * (Rt0 + i) + r) * CK_TS + 32 * ks + 8 * q);
        }
        if (QA == 1) {
#pragma unroll
            for (int ks = 0; ks < 2; ++ks) af[ks] = *(const LAS bf16x8*)(Qp + (16 * Ct + r) * CK_TS + 32 * ks + 8 * q);
        } else tr_a2((unsigned)(size_t)Qp + (unsigned)(troff + 32 * Ct), af[0], af[1]);
        if (PA == 1) tr_b4((unsigned)(size_t)Pp + (unsigned)(troff + 32 * Rt0), bfr[0][0], bfr[0][1], bfr[1][0], bfr[1][1]);
#pragma unroll
        for (int ks = 0; ks < 2; ++ks)
#pragma unroll
            for (int i = 0; i < 2; ++i) acc[i] = __builtin_amdgcn_mfma_f32_16x16x32_bf16(af[ks], bfr[i][ks], acc[i], 0, 0, 0);
    }
#pragma unroll
    for (int i = 0; i < 2; ++i) {
        const int R = 16 * (Rt0 + i) + r;
        float v[4];
#pragma unroll
        for (int e = 0; e < 4; ++e) { const int C = 16 * Ct + 4 * q + e; float x = acc[i][e];
            if (MASK == 1) x = (C < R) ? x : 0.f;
            if (MASK == 2) x = (C <= R) ? x : 0.f;
            if (POST >= 1) x *= cscale[C];
            if (POST == 2) x += (C == R) ? wc[C] : 0.f;
            v[e] = x; }
        v2u o; o.x = pk2c(v[0], v[1]); o.y = pk2c(v[2], v[3]);
        *(LAS v2u*)(X + R * CK_TS + 16 * Ct + 4 * q) = o;
    }
}

template <int PA, int QA, int MASK, int NINIT, int NPAIR, int POST>
__device__ __forceinline__ void mm64h(LAS bf16* X, const LAS bf16* P, const LAS bf16* Q, const LAS bf16* P2, const LAS bf16* Q2, const LAS bf16* E1, const LAS bf16* E2,
                                      const LAS float* cscale, const LAS float* wc, int ws, int lane) {
    const int r = lane & 15, q = lane >> 4, Cb = ws >> 1, Rb = ws & 1;
    const int i16 = lane & 15, qq = i16 >> 2, p4 = i16 & 3;
    const int troff = ((8 * q + qq) * CK_TS + 4 * p4) * 2;
    f32x4 acc[2][2];
#pragma unroll
    for (int ci = 0; ci < 2; ++ci)
#pragma unroll
        for (int ri = 0; ri < 2; ++ri) {
            const int R = 16 * (2 * Rb + ri) + r, C0 = 16 * (2 * Cb + ci) + 4 * q;
            if (NINIT == 0) acc[ci][ri] = (f32x4){0.f, 0.f, 0.f, 0.f};
            else { const v2u e1 = *(const LAS v2u*)(E1 + R * CK_TS + C0); acc[ci][ri] = (f32x4){bflo(e1.x), bfhi(e1.x), bflo(e1.y), bfhi(e1.y)};
                if (NINIT == 2) { const v2u e2 = *(const LAS v2u*)(E2 + R * CK_TS + C0); acc[ci][ri] += (f32x4){bflo(e2.x), bfhi(e2.x), bflo(e2.y), bfhi(e2.y)}; } }
        }
#pragma unroll
    for (int pr = 0; pr < NPAIR; ++pr) {
        const LAS bf16* Pp = pr == 0 ? P : P2; const LAS bf16* Qp = pr == 0 ? Q : Q2;
        bf16x8 af[2][2], bfr[2][2];
        if (PA == 0) {
#pragma unroll
            for (int ri = 0; ri < 2; ++ri)
#pragma unroll
                for (int ks = 0; ks < 2; ++ks) bfr[ri][ks] = *(const LAS bf16x8*)(Pp + (16 * (2 * Rb + ri) + r) * CK_TS + 32 * ks + 8 * q);
        }
        if (QA == 1) {
#pragma unroll
            for (int ci = 0; ci < 2; ++ci)
#pragma unroll
                for (int ks = 0; ks < 2; ++ks) af[ci][ks] = *(const LAS bf16x8*)(Qp + (16 * (2 * Cb + ci) + r) * CK_TS + 32 * ks + 8 * q);
        } else tr_b4((unsigned)(size_t)Qp + (unsigned)(troff + 64 * Cb), af[0][0], af[0][1], af[1][0], af[1][1]);
        if (PA == 1) tr_b4((unsigned)(size_t)Pp + (unsigned)(troff + 64 * Rb), bfr[0][0], bfr[0][1], bfr[1][0], bfr[1][1]);
#pragma unroll
        for (int ks = 0; ks < 2; ++ks)
#pragma unroll
            for (int ci = 0; ci < 2; ++ci)
#pragma unroll
                for (int ri = 0; ri < 2; ++ri) acc[ci][ri] = __builtin_amdgcn_mfma_f32_16x16x32_bf16(af[ci][ks], bfr[ri][ks], acc[ci][ri], 0, 0, 0);
    }
#pragma unroll
    for (int ci = 0; ci < 2; ++ci)
#pragma unroll
        for (int ri = 0; ri < 2; ++ri) {
            const int R = 16 * (2 * Rb + ri) + r;
            float v[4];
#pragma unroll
            for (int e = 0; e < 4; ++e) { const int C = 16 * (2 * Cb + ci) + 4 * q + e; float x = acc[ci][ri][e];
                if (MASK == 1) x = (C < R) ? x : 0.f;
                if (MASK == 2) x = (C <= R) ? x : 0.f;
                if (POST >= 1) x *= cscale[C];
                if (POST == 2) x += (C == R) ? wc[C] : 0.f;
                v[e] = x; }
            v2u o; o.x = pk2c(v[0], v[1]); o.y = pk2c(v[2], v[3]);
            *(LAS v2u*)(X + R * CK_TS + 16 * (2 * Cb + ci) + 4 * q) = o;
        }
}

__device__ __forceinline__ void phase_rwkv_chunk_par(const Ctx& c, KArgs& a, int l, int hb) {
    unsigned char* ws = a.ws;
    bf16* PR = (bf16*)(ws + WS_OV + OV_PR);
    bf16* ELOG = (bf16*)(ws + WS_OV + OV_ELOG);
    const bf16* ASIG = (const bf16*)(ws + WS_OV + OV_ASIG);
    const bf16* VS = l == 0 ? (const bf16*)(ws + WS_VF) + (size_t)hb * MH * D : (const bf16*)(ws + WS_OV + OV_VMIX);
    bf16* Y = (bf16*)(ws + WS_OV + OV_YA);
    bf16* SLB = (bf16*)(ws + WS_OV + OV_AL);
    const float* mu = a.in[I_MU] + (size_t)l * RW_PROJ;
    const float* k_k = a.in[I_KK] + (size_t)l * D; const float* k_a = a.in[I_KA] + (size_t)l * D; const float* rk_ = a.in[I_RK] + (size_t)l * D;
    float* BON = (float*)(ws + WS_OV + OV_BON);
    LAS bf16* tile = (LAS bf16*)c.lds;
    enum { tA = 0, tR, tBt, tKt, tBh, tKh, tV, tNab, tNak, tNrb, tNrk, tM0, tM1, tP1, tX1, NT };
#define TL(i) (tile + (i) * CK_TB)
    LAS float* cscale = (LAS float*)(tile + NT * CK_TB);
    LAS float* wcv = cscale + 64;
    LAS float* SCR = (LAS float*)TL(tM0);
    LAS float* SEGT = SCR + 64 * 64;
    const int tid = c.tid, lane = c.lane, w = c.wave;
    const int tt = tid >> 3, l8 = tid & 7, pc = l8 * 8;
    v4u qr, qk, qrp, qkp, qas, qel, qv;
#define CK_LOAD(un) do { const int b_ = (un) >> 10, h_ = ((un) >> 6) & 15, ch_ = (un) & 63; const int t_ = ch_ * 64 + tt; \
        const size_t mm = (size_t)b_ * T + (size_t)t_; const bf16* row = PR + mm * N1P + h_ * 64 + pc; const v4u zr = (v4u){0u, 0u, 0u, 0u}; \
        qr = *(const v4u*)row; qk = *(const v4u*)(row + 1024); qrp = t_ > 0 ? *(const v4u*)(row - N1P) : zr; qkp = t_ > 0 ? *(const v4u*)(row - N1P + 1024) : zr; \
        qas = *(const v4u*)(ASIG + mm * D + h_ * 64 + pc); qel = *(const v4u*)(ELOG + mm * D + h_ * 64 + pc); qv = *(const v4u*)(VS + mm * D + h_ * 64 + pc); } while (0)
    if (c.bid < 4096) CK_LOAD(c.bid);
    for (int unit = c.bid; unit < 4096; unit += c.G) {
        const int b = unit >> 10, h = (unit >> 6) & 15, ch = unit & 63;
        const size_t m0 = (size_t)b * T + (size_t)ch * 64;
        const int hc = h * 64 + pc;
        for (int rep = 0; rep < (PROBE_DUP == 7 ? 2 : 1); ++rep) {
        if (PROBE_DUP == 7) { CK_LOAD(unit); }
        float r_[8], k_[8], as_[8], el_[8], v_[8], kk_[8], ks_[8];
        {
            float rp_[8], kp_[8];
            unpack8(qr, r_); unpack8(qrp, rp_); unpack8(qk, k_); unpack8(qkp, kp_); unpack8(qas, as_); unpack8(qel, el_); unpack8(qv, v_);
            if (PROBE_DUP != 7 && unit + c.G < 4096) CK_LOAD(unit + c.G);
            float s1 = 0.f;
#pragma unroll
            for (int e = 0; e < 8; ++e) { r_[e] = r_[e] + (rp_[e] - r_[e]) * mu[hc + e]; ks_[e] = k_[e] + (kp_[e] - k_[e]) * mu[1024 + hc + e]; kk_[e] = ks_[e] * k_k[hc + e]; s1 += kk_[e] * kk_[e]; }
            s1 = sum8(s1);
            const float i1 = rsqrtf(s1 + 1e-12f);
#pragma unroll
            for (int e = 0; e < 8; ++e) { kk_[e] *= i1; k_[e] = ks_[e] * (1.f + (as_[e] - 1.f) * k_a[hc + e]); }
            { float bn = 0.f;
#pragma unroll
              for (int e = 0; e < 8; ++e) bn += r_[e] * k_[e] * rk_[hc + e];
              bn = sum8(bn);
              if (l8 == 0) BON[(m0 + tt) * 16 + h] = bn; }
            *(LAS f32x4*)(SCR + tt * 64 + pc) = (f32x4){el_[0], el_[1], el_[2], el_[3]}; *(LAS f32x4*)(SCR + tt * 64 + pc + 4) = (f32x4){el_[4], el_[5], el_[6], el_[7]};
        }
        lds_barrier();
        {
            const int col = tid & 63, seg = tid >> 6; float s = 0.f;
#pragma unroll
            for (int i = 0; i < 8; ++i) { s += SCR[(8 * seg + i) * 64 + col]; SCR[(8 * seg + i) * 64 + col] = s; }
            SEGT[seg * 64 + col] = s;
        }
        lds_barrier();
        {
            const int col = tid & 63, seg = tid >> 6; float pre = 0.f;
#pragma unroll
            for (int s2 = 0; s2 < 7; ++s2) pre += (s2 < seg) ? SEGT[s2 * 64 + col] : 0.f;
#pragma unroll
            for (int i = 0; i < 8; ++i) SCR[(8 * seg + i) * 64 + col] += pre;
        }
        lds_barrier();
        {
            float L[8], Lr[8], Le[8];
            { const f32x4 x0 = *(const LAS f32x4*)(SCR + tt * 64 + pc), x1 = *(const LAS f32x4*)(SCR + tt * 64 + pc + 4);
              const f32x4 y0 = *(const LAS f32x4*)(SCR + 31 * 64 + pc), y1 = *(const LAS f32x4*)(SCR + 31 * 64 + pc + 4);
              const f32x4 z0 = *(const LAS f32x4*)(SCR + 63 * 64 + pc), z1 = *(const LAS f32x4*)(SCR + 63 * 64 + pc + 4);
#pragma unroll
              for (int e = 0; e < 4; ++e) { L[e] = x0[e]; L[4 + e] = x1[e]; Lr[e] = y0[e]; Lr[4 + e] = y1[e]; Le[e] = z0[e]; Le[4 + e] = z1[e]; } }
            float oA[8], oR[8], oBt[8], oKt[8], oBh[8], oKh[8];
#pragma unroll
            for (int e = 0; e < 8; ++e) {
                const float ea = __expf(L[e] - el_[e] - Lr[e]), er = __expf(L[e] - Lr[e]), eb = __expf(Lr[e] - L[e]), eh = __expf(Le[e] - L[e]);
                const float bb = kk_[e] * as_[e];
                oA[e] = -kk_[e] * ea; oR[e] = r_[e] * er; oBt[e] = bb * eb; oKt[e] = k_[e] * eb; oBh[e] = bb * eh; oKh[e] = k_[e] * eh;
            }
            const int o = tt * CK_TS + pc;
            *(LAS v4u*)(TL(tA) + o) = pack8(oA); *(LAS v4u*)(TL(tR) + o) = pack8(oR); *(LAS v4u*)(TL(tBt) + o) = pack8(oBt); *(LAS v4u*)(TL(tKt) + o) = pack8(oKt);
            *(LAS v4u*)(TL(tBh) + o) = pack8(oBh); *(LAS v4u*)(TL(tKh) + o) = pack8(oKh); *(LAS v4u*)(TL(tV) + o) = pack8(v_);
            if (tt == 0) {
#pragma unroll
                for (int e = 0; e < 8; ++e) { cscale[pc + e] = __expf(Lr[e]); wcv[pc + e] = __expf(Le[e]); }
            }
        }
        lds_barrier();
        const LAS bf16* Z = nullptr;
        const int wg_ = w >> 2, ws_ = w & 3;
        if (wg_ == 0) { mm64h<0, 1, 1, 0, 1, 0>(TL(tNab), TL(tA), TL(tBt), Z, Z, Z, Z, cscale, wcv, ws_, lane);
                        mm64h<0, 1, 1, 0, 1, 0>(TL(tNak), TL(tA), TL(tKt), Z, Z, Z, Z, cscale, wcv, ws_, lane); }
        else          { mm64h<0, 1, 2, 0, 1, 0>(TL(tNrb), TL(tR), TL(tBt), Z, Z, Z, Z, cscale, wcv, ws_, lane);
                        mm64h<0, 1, 2, 0, 1, 0>(TL(tNrk), TL(tR), TL(tKt), Z, Z, Z, Z, cscale, wcv, ws_, lane); }
        lds_barrier();
        if (wg_ == 0) mm64h<0, 0, 0, 0, 1, 0>(TL(tM0), TL(tNab), TL(tNab), Z, Z, Z, Z, cscale, wcv, ws_, lane);
        else          mm64h<0, 0, 0, 0, 1, 0>(TL(tX1), TL(tNak), TL(tV), Z, Z, Z, Z, cscale, wcv, ws_, lane);
        lds_barrier();
        if (wg_ == 0) mm64h<0, 0, 0, 2, 1, 0>(TL(tP1), TL(tNab), TL(tM0), Z, Z, TL(tNab), TL(tM0), cscale, wcv, ws_, lane);
        else          mm64h<0, 0, 0, 0, 1, 0>(TL(tM1), TL(tM0), TL(tM0), Z, Z, Z, Z, cscale, wcv, ws_, lane);
        lds_barrier();
        if (wg_ == 0) mm64h<0, 0, 0, 2, 1, 0>(TL(tNab), TL(tP1), TL(tM1), Z, Z, TL(tP1), TL(tM1), cscale, wcv, ws_, lane);
        else          mm64h<0, 0, 0, 0, 1, 0>(TL(tM0), TL(tM1), TL(tM1), Z, Z, Z, Z, cscale, wcv, ws_, lane);
        lds_barrier();
        if (wg_ == 0) mm64h<0, 0, 0, 2, 1, 0>(TL(tP1), TL(tNab), TL(tM0), Z, Z, TL(tNab), TL(tM0), cscale, wcv, ws_, lane);
        else          mm64h<0, 0, 0, 0, 1, 0>(TL(tM1), TL(tM0), TL(tM0), Z, Z, Z, Z, cscale, wcv, ws_, lane);
        lds_barrier();
        if (wg_ == 0) mm64h<0, 0, 0, 2, 1, 0>(TL(tNab), TL(tP1), TL(tM1), Z, Z, TL(tP1), TL(tM1), cscale, wcv, ws_, lane);
        else          mm64h<0, 0, 0, 0, 1, 0>(TL(tM0), TL(tM1), TL(tM1), Z, Z, Z, Z, cscale, wcv, ws_, lane);
        lds_barrier();
        mm64<0, 0, 0, 2, 1, 0>(TL(tP1), TL(tNab), TL(tM0), Z, Z, TL(tNab), TL(tM0), cscale, wcv, w, lane);
        lds_barrier();
        if (wg_ == 0) mm64h<0, 0, 0, 1, 1, 0>(TL(tBt), TL(tP1), TL(tA), Z, Z, TL(tA), Z, cscale, wcv, ws_, lane);
        else          mm64h<0, 0, 0, 1, 1, 0>(TL(tKt), TL(tP1), TL(tX1), Z, Z, TL(tX1), Z, cscale, wcv, ws_, lane);
        lds_barrier();
        if (wg_ == 0) { mm64h<0, 0, 0, 1, 1, 1>(TL(tM0), TL(tNrb), TL(tBt), Z, Z, TL(tR), Z, cscale, wcv, ws_, lane);
                        mm64h<0, 0, 0, 0, 2, 0>(TL(tM1), TL(tNrb), TL(tKt), TL(tNrk), TL(tV), Z, Z, cscale, wcv, ws_, lane); }
        else          { mm64h<1, 0, 0, 0, 1, 2>(TL(tNab), TL(tBh), TL(tBt), Z, Z, Z, Z, cscale, wcv, ws_, lane);
                        mm64h<1, 0, 0, 0, 2, 0>(TL(tX1), TL(tKt), TL(tBh), TL(tV), TL(tKh), Z, Z, cscale, wcv, ws_, lane); }
        lds_barrier();
        }
        {
            const size_t grow = m0 + tt;
            *(v4u*)(ELOG + grow * D + hc) = *(const LAS v4u*)(TL(tM0) + tt * CK_TS + pc);
            *(v4u*)(Y + grow * D + hc) = *(const LAS v4u*)(TL(tM1) + tt * CK_TS + pc);
            *(v4u*)(PR + grow * N1P + 2048 + hc) = *(const LAS v4u*)(TL(tNab) + tt * CK_TS + pc);
            *(v4u*)(SLB + grow * D + hc) = *(const LAS v4u*)(TL(tX1) + tt * CK_TS + pc);
        }
        lds_barrier();
    }
#undef TL
#undef CK_LOAD
}

struct SeqOps { v4u g0, g1, p0, p1; v2u sl, yl; };
__device__ __forceinline__ void phase_rwkv_chunk_seq(const Ctx& c, KArgs& a, const bool commit = true) {
    unsigned char* ws = a.ws;
    const bf16* PR = (const bf16*)(ws + WS_OV + OV_PR);
    const bf16* RP = (const bf16*)(ws + WS_OV + OV_ELOG);
    bf16* Y = (bf16*)(ws + WS_OV + OV_YA);
    const bf16* SLB = (const bf16*)(ws + WS_OV + OV_AL);
    LAS bf16* SL = (LAS bf16*)c.lds;
    const int tid = c.tid, lane = c.lane, w = c.wave, r = lane & 15, q = lane >> 4;
    constexpr int PF = 4;
    for (int unit = c.bid; unit < 256; unit += c.G) {
        const int b = unit >> 6, h = (unit >> 2) & 15, vq = unit & 3;
        for (int e = tid; e < 2 * 16 * CK_TS / 2; e += 512) ((LAS unsigned*)SL)[e] = 0u;
        __syncthreads();
        if (w < 4) {
            const size_t rowG = (size_t)b * T + 16 * w + r;
            const size_t rowS = (size_t)b * T + vq * 16 + r;
            SeqOps ops[PF];
#define SQ_LOAD(dst, chn) do { const size_t o_ = (size_t)(chn) * 64; \
                dst.g0 = *(const v4u*)(PR + (rowG + o_) * N1P + 2048 + h * 64 + 8 * q); dst.g1 = *(const v4u*)(PR + (rowG + o_) * N1P + 2048 + h * 64 + 32 + 8 * q); \
                dst.p0 = *(const v4u*)(RP + (rowG + o_) * D + h * 64 + 8 * q); dst.p1 = *(const v4u*)(RP + (rowG + o_) * D + h * 64 + 32 + 8 * q); \
                dst.sl = *(const v2u*)(SLB + (rowS + o_) * D + h * 64 + 16 * w + 4 * q); dst.yl = *(const v2u*)(Y + (rowG + o_) * D + h * 64 + vq * 16 + 4 * q); } while (0)
#pragma unroll
            for (int i = 0; i < PF; ++i) SQ_LOAD(ops[i], i);
            for (int ch0 = 0; ch0 < 64; ch0 += PF) {
#pragma unroll
                for (int i = 0; i < PF; ++i) {
                    const int ch = ch0 + i;
                    const SeqOps cur = ops[i];
                    if (ch + PF < 64) SQ_LOAD(ops[i], ch + PF);
                    const LAS bf16* Sc = SL + (i & 1) * 16 * CK_TS; LAS bf16* Sn = SL + ((i + 1) & 1) * 16 * CK_TS;
                    const bf16x8 s0 = *(const LAS bf16x8*)(Sc + r * CK_TS + 8 * q), s1 = *(const LAS bf16x8*)(Sc + r * CK_TS + 32 + 8 * q);
                    f32x4 accS = (f32x4){bflo(cur.sl.x), bfhi(cur.sl.x), bflo(cur.sl.y), bfhi(cur.sl.y)};
                    accS = __builtin_amdgcn_mfma_f32_16x16x32_bf16(__builtin_bit_cast(bf16x8, cur.g0), s0, accS, 0, 0, 0);
                    accS = __builtin_amdgcn_mfma_f32_16x16x32_bf16(__builtin_bit_cast(bf16x8, cur.g1), s1, accS, 0, 0, 0);
                    f32x4 accY = (f32x4){bflo(cur.yl.x), bfhi(cur.yl.x), bflo(cur.yl.y), bfhi(cur.yl.y)};
                    accY = __builtin_amdgcn_mfma_f32_16x16x32_bf16(s0, __builtin_bit_cast(bf16x8, cur.p0), accY, 0, 0, 0);
                    accY = __builtin_amdgcn_mfma_f32_16x16x32_bf16(s1, __builtin_bit_cast(bf16x8, cur.p1), accY, 0, 0, 0);
                    { v2u o; o.x = pk2c(accS[0], accS[1]); o.y = pk2c(accS[2], accS[3]); *(LAS v2u*)(Sn + r * CK_TS + 16 * w + 4 * q) = o; }
                    if (commit || accY[0] == 123456.789f) { v2u o; o.x = pk2c(accY[0], accY[1]); o.y = pk2c(accY[2], accY[3]); *(v2u*)(Y + (rowG + (size_t)ch * 64) * D + h * 64 + vq * 16 + 4 * q) = o; }
                    lds_barrier();
                }
            }
#undef SQ_LOAD
        } else {
            for (int ch = 0; ch < 64; ++ch) lds_barrier();
        }
        __syncthreads();
    }
}

__device__ __forceinline__ void phase_rwkv_post(const Ctx& c, KArgs& a, int l, int hb) {
    unsigned char* ws = a.ws;
    const bf16* GG = (const bf16*)(ws + WS_OV + OV_GG);
    const bf16* VS = l == 0 ? (const bf16*)(ws + WS_VF) + (size_t)hb * MH * D : (const bf16*)(ws + WS_OV + OV_VMIX);
    const float* BON = (const float*)(ws + WS_OV + OV_BON);
    bf16* Y = (bf16*)(ws + WS_OV + OV_YA);
    const int lane = c.lane, c0 = 16 * lane;
    float lw[16], lb[16];
#pragma unroll
    for (int e = 0; e < 16; ++e) { lw[e] = a.in[I_LNW][(size_t)l * D + c0 + e]; lb[e] = a.in[I_LNB][(size_t)l * D + c0 + e]; }
    const int gw = c.bid * 8 + c.wave, NGW = c.G * 8;
    v4u ny0, ny1, nv0, nv1, ng0, ng1; float nbon = 0.f;
#define RP_LOAD(mm) do { ny0 = *(const v4u*)(Y + (size_t)(mm) * D + c0); ny1 = *(const v4u*)(Y + (size_t)(mm) * D + c0 + 8); nv0 = *(const v4u*)(VS + (size_t)(mm) * D + c0); nv1 = *(const v4u*)(VS + (size_t)(mm) * D + c0 + 8); \
        ng0 = *(const v4u*)(GG + (size_t)(mm) * D + c0); ng1 = *(const v4u*)(GG + (size_t)(mm) * D + c0 + 8); nbon = BON[(size_t)(mm) * 16 + (lane >> 2)]; } while (0)
    if (gw < MH) RP_LOAD(gw);
    for (int m = gw; m < MH; m += NGW) {
        float y[16], v[16], g[16], t8[8];
        const v4u cy0 = ny0, cy1 = ny1, cv0 = nv0, cv1 = nv1, cg0 = ng0, cg1 = ng1; const float bon = nbon;
        if (m + NGW < MH) RP_LOAD(m + NGW);
#define UP16(dst, qa, qb) do { unpack8(qa, t8); _Pragma("unroll") for (int e = 0; e < 8; ++e) dst[e] = t8[e]; unpack8(qb, t8); _Pragma("unroll") for (int e = 0; e < 8; ++e) dst[8 + e] = t8[e]; } while (0)
        UP16(y, cy0, cy1); UP16(v, cv0, cv1); UP16(g, cg0, cg1);
#undef UP16
        float s1 = 0.f;
#pragma unroll
        for (int e = 0; e < 16; ++e) s1 += y[e];
        s1 = sum4(s1);
        const float mean = s1 * (1.f / 64.f);
        float s2 = 0.f;
#pragma unroll
        for (int e = 0; e < 16; ++e) { const float d = y[e] - mean; s2 += d * d; }
        s2 = sum4(s2);
        const float rstd = rsqrtf(s2 * (1.f / 64.f) + 64e-5f);
        float o[16];
#pragma unroll
        for (int e = 0; e < 16; ++e) o[e] = ((y[e] - mean) * rstd * lw[e] + lb[e] + bon * v[e]) * g[e];
        v4u o0, o1;
        o0.x = pk2(o[0], o[1]); o0.y = pk2(o[2], o[3]); o0.z = pk2(o[4], o[5]); o0.w = pk2(o[6], o[7]);
        o1.x = pk2(o[8], o[9]); o1.y = pk2(o[10], o[11]); o1.z = pk2(o[12], o[13]); o1.w = pk2(o[14], o[15]);
        *(v4u*)(Y + (size_t)m * D + c0) = o0; *(v4u*)(Y + (size_t)m * D + c0 + 8) = o1;
    }
}

__device__ __forceinline__ void phase_ssd_conv(const Ctx& c, KArgs& a, int l) {
    unsigned char* ws = a.ws;
    const bf16* PS = (const bf16*)(ws + WS_OV + OV_PS);
    bf16* XBC = (bf16*)(ws + WS_OV + OV_XBC);
    float* DT = (float*)(ws + WS_OV + OV_DT); float* DA = (float*)(ws + WS_OV + OV_DA);
    const float* cw = a.in[I_CW] + (size_t)l * 4 * 3072; const float* cb = a.in[I_CB] + (size_t)l * 3072;
    const int gw = c.bid * 8 + c.wave, NGW = c.G * 8, lane = c.lane;
    constexpr int RUN = 16, NRUN = MH / RUN;
    for (int it = gw; it < 2 * NRUN; it += NGW) {
        const int cb_ = 4 + (it & 1), run = it >> 1, ch0 = cb_ * 512 + lane * 8, m0 = run * RUN;
        float w[4][8], bias[8];
#pragma unroll
        for (int j = 0; j < 4; ++j)
#pragma unroll
            for (int e = 0; e < 8; ++e) w[j][e] = cw[j * 3072 + ch0 + e];
#pragma unroll
        for (int e = 0; e < 8; ++e) bias[e] = cb[ch0 + e];
        float x0[8], x1[8], x2[8], x3[8];
        const bf16* base = PS + (size_t)m0 * N2P + 2048 + ch0;
        const int t0 = m0 & (T - 1);
        if (t0 >= 3) { unpack8(*(const v4u*)(base - 3 * N2P), x0); unpack8(*(const v4u*)(base - 2 * N2P), x1); unpack8(*(const v4u*)(base - N2P), x2); }
        else {
#pragma unroll
            for (int e = 0; e < 8; ++e) { x0[e] = 0.f; x1[e] = 0.f; x2[e] = 0.f; }
        }
        v4u nx = *(const v4u*)base;
#pragma unroll 4
        for (int i = 0; i < RUN; ++i) {
            unpack8(nx, x3);
            if (i + 1 < RUN) nx = *(const v4u*)(base + (size_t)(i + 1) * N2P);
            float o[8];
#pragma unroll
            for (int e = 0; e < 8; ++e) { const float y = bias[e] + x0[e] * w[0][e] + x1[e] * w[1][e] + x2[e] * w[2][e] + x3[e] * w[3][e]; o[e] = siluf_(y); x0[e] = x1[e]; x1[e] = x2[e]; x2[e] = x3[e]; }
            *(v4u*)(XBC + (size_t)(m0 + i) * 3072 + ch0) = pack8(o);
        }
    }
}

__device__ __forceinline__ void tr_bm2(unsigned a, bf16x8& f0, bf16x8& f1) {
    s16x4 l0, h0, l1, h1;
    asm volatile("ds_read_b64_tr_b16 %0, %4\n\tds_read_b64_tr_b16 %1, %4 offset:1088\n\tds_read_b64_tr_b16 %2, %4 offset:8704\n\tds_read_b64_tr_b16 %3, %4 offset:9792\n\ts_waitcnt lgkmcnt(0)"
                 : "=&v"(l0), "=&v"(h0), "=&v"(l1), "=&v"(h1) : "v"(a) : "memory");
    f0 = __builtin_shufflevector(l0, h0, 0, 1, 2, 3, 4, 5, 6, 7); f1 = __builtin_shufflevector(l1, h1, 0, 1, 2, 3, 4, 5, 6, 7);
}
__device__ __forceinline__ void tr_x2(unsigned a, bf16x8& f0, bf16x8& f1) {
    s16x4 l0, h0, l1, h1;
    asm volatile("ds_read_b64_tr_b16 %0, %4\n\tds_read_b64_tr_b16 %1, %4 offset:320\n\tds_read_b64_tr_b16 %2, %4 offset:2560\n\tds_read_b64_tr_b16 %3, %4 offset:2880\n\ts_waitcnt lgkmcnt(0)"
                 : "=&v"(l0), "=&v"(h0), "=&v"(l1), "=&v"(h1) : "v"(a) : "memory");
    f0 = __builtin_shufflevector(l0, h0, 0, 1, 2, 3, 4, 5, 6, 7); f1 = __builtin_shufflevector(l1, h1, 0, 1, 2, 3, 4, 5, 6, 7);
}
__device__ __forceinline__ void tr_x4(unsigned a, bf16x8& f00, bf16x8& f01, bf16x8& f10, bf16x8& f11) {
    s16x4 l0, h0, l1, h1, l2, h2, l3, h3;
    asm volatile("ds_read_b64_tr_b16 %0, %8\n\tds_read_b64_tr_b16 %1, %8 offset:320\n\tds_read_b64_tr_b16 %2, %8 offset:2560\n\tds_read_b64_tr_b16 %3, %8 offset:2880\n\t"
                 "ds_read_b64_tr_b16 %4, %8 offset:32\n\tds_read_b64_tr_b16 %5, %8 offset:352\n\tds_read_b64_tr_b16 %6, %8 offset:2592\n\tds_read_b64_tr_b16 %7, %8 offset:2912\n\ts_waitcnt lgkmcnt(0)"
                 : "=&v"(l0), "=&v"(h0), "=&v"(l1), "=&v"(h1), "=&v"(l2), "=&v"(h2), "=&v"(l3), "=&v"(h3) : "v"(a) : "memory");
    f00 = __builtin_shufflevector(l0, h0, 0, 1, 2, 3, 4, 5, 6, 7); f01 = __builtin_shufflevector(l1, h1, 0, 1, 2, 3, 4, 5, 6, 7);
    f10 = __builtin_shufflevector(l2, h2, 0, 1, 2, 3, 4, 5, 6, 7); f11 = __builtin_shufflevector(l3, h3, 0, 1, 2, 3, 4, 5, 6, 7);
}
__device__ __forceinline__ void phase_ssd_scan(const Ctx& c, KArgs& a, int l) {
    unsigned char* ws = a.ws;
    const bf16* PS = (const bf16*)(ws + WS_OV + OV_PS);
    bf16* XBC = (bf16*)(ws + WS_OV + OV_XBC);
    const float* cw = a.in[I_CW] + (size_t)l * 4 * 3072; const float* cb = a.in[I_CB] + (size_t)l * 3072;
    const float* DT = (const float*)(ws + WS_OV + OV_DT); const float* ACS = (const float*)(ws + WS_OV + OV_DA);
    constexpr int SC = 136, SM = 72, SX = 40;
    LAS bf16* Cm = (LAS bf16*)c.lds;
    LAS bf16* Bm = Cm + 64 * SC;
    LAS bf16* Xd = Bm + 64 * SC;
    LAS bf16* Xs = Xd + 64 * SX;
    LAS bf16* Xr = Xs + 64 * SX;
    LAS bf16* MtT = Xr + 64 * SX;
    LAS bf16* SL = MtT + 64 * SM;
    LAS float* acsL = (LAS float*)(SL + 32 * SC);
    const unsigned BmB = (unsigned)(size_t)Bm, XdB = (unsigned)(size_t)Xd, XsB = (unsigned)(size_t)Xs;
    const int tid = c.tid, lane = c.lane, w = c.wave, r = lane & 15, q = lane >> 4;
    const int sj = tid >> 3, sn = (tid & 7) * 16, sp = (tid & 7) * 4;
    const int trq = ((lane & 15) >> 2), trp = lane & 3;
    const unsigned troffB = (unsigned)(((8 * q + trq) * SC + 4 * trp) * 2), troffX = (unsigned)(((8 * q + trq) * SX + 4 * trp) * 2);
    for (int unit = c.bid; unit < 256; unit += c.G) {
        const int b = unit >> 6, h = (unit >> 1) & 31, ph = unit & 1, g = h >> 3;
        const size_t m0 = (size_t)b * T;
        f32x4 st[2] = {(f32x4){0.f, 0.f, 0.f, 0.f}, (f32x4){0.f, 0.f, 0.f, 0.f}};
        for (int e = tid; e < 32 * SC / 2; e += 512) ((LAS unsigned*)SL)[e] = 0u;
        v4u gB0, gB1, gC0, gC1; v2u gX0, gX1, gX2, gX3; float gacs, gacsE, gdt;
        const int chx = h * 64 + ph * 32 + sp; const float Dh = a.in[I_SD][l * 32 + h];
        float cwt[4][4], cbs[4];
#pragma unroll
        for (int e2 = 0; e2 < 4; ++e2) { cbs[e2] = cb[chx + e2];
#pragma unroll
            for (int j = 0; j < 4; ++j) cwt[j][e2] = cw[j * 3072 + chx + e2]; }
#define SS_LOAD(chunk) do { const size_t row = m0 + (size_t)(chunk) * 64 + sj; const bf16* xr = XBC + row * 3072; \
            gB0 = *(const v4u*)(xr + 2048 + g * 128 + sn); gB1 = *(const v4u*)(xr + 2048 + g * 128 + sn + 8); \
            gC0 = *(const v4u*)(xr + 2560 + g * 128 + sn); gC1 = *(const v4u*)(xr + 2560 + g * 128 + sn + 8); \
            { const int t_ = (chunk) * 64 + sj; const bf16* pr_ = PS + row * N2P + 2048 + chx; const v2u z2 = (v2u){0u, 0u}; \
              gX3 = *(const v2u*)pr_; gX2 = t_ >= 1 ? *(const v2u*)(pr_ - N2P) : z2; gX1 = t_ >= 2 ? *(const v2u*)(pr_ - 2 * N2P) : z2; gX0 = t_ >= 3 ? *(const v2u*)(pr_ - 3 * N2P) : z2; } \
            gacs = ACS[row * 32 + h]; gacsE = ACS[(m0 + (size_t)(chunk) * 64 + 63) * 32 + h]; gdt = DT[row * 32 + h]; } while (0)
#define SS_STAGE() do { \
            *(LAS v4u*)(Bm + sj * SC + sn) = gB0; *(LAS v4u*)(Bm + sj * SC + sn + 8) = gB1; *(LAS v4u*)(Cm + sj * SC + sn) = gC0; *(LAS v4u*)(Cm + sj * SC + sn + 8) = gC1; \
            const float sc_ = gdt * __expf(gacsE - gacs); \
            const float r0_[4] = {bflo(gX0.x), bfhi(gX0.x), bflo(gX0.y), bfhi(gX0.y)}, r1_[4] = {bflo(gX1.x), bfhi(gX1.x), bflo(gX1.y), bfhi(gX1.y)}; \
            const float r2_[4] = {bflo(gX2.x), bfhi(gX2.x), bflo(gX2.y), bfhi(gX2.y)}, r3_[4] = {bflo(gX3.x), bfhi(gX3.x), bflo(gX3.y), bfhi(gX3.y)}; \
            float xa_[4]; _Pragma("unroll") for (int e2 = 0; e2 < 4; ++e2) xa_[e2] = siluf_(cbs[e2] + r0_[e2] * cwt[0][e2] + r1_[e2] * cwt[1][e2] + r2_[e2] * cwt[2][e2] + r3_[e2] * cwt[3][e2]); \
            const float x0_ = xa_[0], x1_ = xa_[1], x2_ = xa_[2], x3_ = xa_[3]; \
            v2u o1_, o2_; o1_.x = pk2(x0_ * gdt, x1_ * gdt); o1_.y = pk2(x2_ * gdt, x3_ * gdt); o2_.x = pk2(x0_ * sc_, x1_ * sc_); o2_.y = pk2(x2_ * sc_, x3_ * sc_); \
            *(LAS v2u*)(Xd + sj * SX + sp) = o1_; *(LAS v2u*)(Xs + sj * SX + sp) = o2_; { v2u o3_; o3_.x = pk2(x0_, x1_); o3_.y = pk2(x2_, x3_); *(LAS v2u*)(Xr + sj * SX + sp) = o3_; } \
            if ((tid & 7) == 0) acsL[sj] = gacs; } while (0)
        SS_LOAD(0);
        SS_STAGE();
        __syncthreads();
        for (int ch = 0; ch < T / 64; ++ch) {
            if (ch + 1 < T / 64) SS_LOAD(ch + 1);
            {
                const int jt = w >> 1, it0 = 2 * (w & 1);
                f32x4 acc0 = (f32x4){0.f, 0.f, 0.f, 0.f}, acc1 = acc0;
                if (it0 + 1 >= jt) {
#pragma unroll
                    for (int ks = 0; ks < 4; ++ks) {
                        const bf16x8 af = *(const LAS bf16x8*)(Bm + (16 * jt + r) * SC + 32 * ks + 8 * q);
                        const bf16x8 b0 = *(const LAS bf16x8*)(Cm + (16 * it0 + r) * SC + 32 * ks + 8 * q);
                        const bf16x8 b1 = *(const LAS bf16x8*)(Cm + (16 * (it0 + 1) + r) * SC + 32 * ks + 8 * q);
                        acc0 = __builtin_amdgcn_mfma_f32_16x16x32_bf16(af, b0, acc0, 0, 0, 0);
                        acc1 = __builtin_amdgcn_mfma_f32_16x16x32_bf16(af, b1, acc1, 0, 0, 0);
                    }
                }
                const int i0 = 16 * it0 + r, i1 = i0 + 16;
                const float ai0 = acsL[i0], ai1 = acsL[i1];
                float m0v[4], m1v[4];
#pragma unroll
                for (int e = 0; e < 4; ++e) { const int j = 16 * jt + 4 * q + e; const float aj = acsL[j];
                    m0v[e] = (j <= i0) ? acc0[e] * __expf(ai0 - aj) : 0.f; m1v[e] = (j <= i1) ? acc1[e] * __expf(ai1 - aj) : 0.f; }
                { v2u o0, o1; o0.x = pk2(m0v[0], m0v[1]); o0.y = pk2(m0v[2], m0v[3]); o1.x = pk2(m1v[0], m1v[1]); o1.y = pk2(m1v[2], m1v[3]);
                  *(LAS v2u*)(MtT + i0 * SM + 16 * jt + 4 * q) = o0; *(LAS v2u*)(MtT + i1 * SM + 16 * jt + 4 * q) = o1; }
            }
            lds_barrier();
            {
                const int it = w >> 1, pt = w & 1;
                f32x4 accD = (f32x4){0.f, 0.f, 0.f, 0.f}, accO = accD;
                {
                    bf16x8 xb0, xb1; tr_x2(XdB + troffX + 32u * pt, xb0, xb1);
                    const bf16x8 af0 = *(const LAS bf16x8*)(MtT + (16 * it + r) * SM + 8 * q);
                    accD = __builtin_amdgcn_mfma_f32_16x16x32_bf16(af0, xb0, accD, 0, 0, 0);
                    if (it >= 2) {
                        const bf16x8 af1 = *(const LAS bf16x8*)(MtT + (16 * it + r) * SM + 32 + 8 * q);
                        accD = __builtin_amdgcn_mfma_f32_16x16x32_bf16(af1, xb1, accD, 0, 0, 0);
                    }
                }
#pragma unroll
                for (int ks = 0; ks < 4; ++ks) {
                    const bf16x8 af = *(const LAS bf16x8*)(Cm + (16 * it + r) * SC + 32 * ks + 8 * q);
                    const bf16x8 bf_ = *(const LAS bf16x8*)(SL + (16 * pt + r) * SC + 32 * ks + 8 * q);
                    accO = __builtin_amdgcn_mfma_f32_16x16x32_bf16(af, bf_, accO, 0, 0, 0);
                }
                const int p = 16 * pt + r;
#pragma unroll
                for (int e = 0; e < 4; ++e) { const int i = 16 * it + 4 * q + e; const float y = accD[e] + __expf(acsL[i]) * accO[e] + Dh * bf1(Xr[i * SX + p]);
                    XBC[(m0 + (size_t)ch * 64 + i) * 3072 + h * 64 + ph * 32 + p] = (bf16)f2bf(y); }
            }
            {
                const float dec = __expf(acsL[63]);
                bf16x8 a0, a1, bx[2][2];
                tr_bm2(BmB + troffB + 32u * w, a0, a1);
                tr_x4(XsB + troffX, bx[0][0], bx[0][1], bx[1][0], bx[1][1]);
#pragma unroll
                for (int pt = 0; pt < 2; ++pt) {
                    f32x4 s = st[pt] * dec;
                    s = __builtin_amdgcn_mfma_f32_16x16x32_bf16(a0, bx[pt][0], s, 0, 0, 0);
                    s = __builtin_amdgcn_mfma_f32_16x16x32_bf16(a1, bx[pt][1], s, 0, 0, 0);
                    st[pt] = s;
                }
            }
            lds_barrier();
#pragma unroll
            for (int pt = 0; pt < 2; ++pt) { v2u o; o.x = pk2c(st[pt][0], st[pt][1]); o.y = pk2c(st[pt][2], st[pt][3]);
                *(LAS v2u*)(SL + (16 * pt + r) * SC + 16 * w + 4 * q) = o; }
            if (ch + 1 < T / 64) SS_STAGE();
            lds_barrier();
        }
#undef SS_LOAD
#undef SS_STAGE
    }
}

__device__ __forceinline__ void phase_ssd_post(const Ctx& c, KArgs& a, int l) {
    unsigned char* ws = a.ws;
    bf16* PS = (bf16*)(ws + WS_OV + OV_PS);
    const bf16* XBC = (const bf16*)(ws + WS_OV + OV_XBC);
    const int lane = c.lane, c0 = 32 * lane;
    const float* ng = a.in[I_SNG] + (size_t)l * 2048 + c0;
    const int gw = c.bid * 8 + c.wave, NGW = c.G * 8;
    v4u nyy[4], nzz[4];
#define SP_LOAD(mm) do { _Pragma("unroll") for (int q = 0; q < 4; ++q) { nyy[q] = *(const v4u*)(XBC + (size_t)(mm) * 3072 + c0 + 8 * q); nzz[q] = *(const v4u*)(PS + (size_t)(mm) * N2P + c0 + 8 * q); } } while (0)
    if (gw < MH) SP_LOAD(gw);
    for (int m = gw; m < MH; m += NGW) {
        float y[32]; float ss = 0.f;
        v4u cyy[4], czz[4];
#pragma unroll
        for (int q = 0; q < 4; ++q) { cyy[q] = nyy[q]; czz[q] = nzz[q]; }
        if (m + NGW < MH) SP_LOAD(m + NGW);
#pragma unroll
        for (int q = 0; q < 4; ++q) {
            float yy[8], zz[8];
            unpack8(cyy[q], yy); unpack8(czz[q], zz);
#pragma unroll
            for (int e = 0; e < 8; ++e) { const float v = yy[e] * siluf_(zz[e]); y[8 * q + e] = v; ss += v * v; }
        }
        ss = sum16(ss);
        const float r = rsqrtf(ss * (1.f / 512.f) + 1e-6f);
#pragma unroll
        for (int q = 0; q < 4; ++q) {
            float o[8];
#pragma unroll
            for (int e = 0; e < 8; ++e) o[e] = y[8 * q + e] * r * ng[8 * q + e];
            *(v4u*)(PS + (size_t)m * N2P + 2048 + c0 + 8 * q) = pack8(o);
        }
    }
}

__device__ __forceinline__ void phase_peer_convert(const Ctx& c, KArgs& a, int l) {
    unsigned char* ws = a.ws;
    const int gw = c.bid * 8 + c.wave, NGW = c.G * 8, lane = c.lane;
    f32x4 n0, n1, n2, n3;
#define PC_LOAD(itt) do { const int tb_ = (itt) >= NEXP, e_ = (itt) - tb_ * NEXP; const float* s_ = (tb_ ? a.in[I_PU] : a.in[I_PD]) + ((size_t)l * NEXP + e_) * D + 16 * lane; \
        n0 = *(const f32x4*)s_; n1 = *(const f32x4*)(s_ + 4); n2 = *(const f32x4*)(s_ + 8); n3 = *(const f32x4*)(s_ + 12); } while (0)
    if (gw < 2 * NEXP) PC_LOAD(gw);
    for (int it = gw; it < 2 * NEXP; it += NGW) {
        const int tb = it >= NEXP, e = it - tb * NEXP;
        const f32x4 x0 = n0, x1 = n1, x2 = n2, x3 = n3;
        if (it + NGW < 2 * NEXP) PC_LOAD(it + NGW);
        float am = fmaxf(fmaxf(fmaxf(fabsf(x0.x), fabsf(x0.y)), fmaxf(fabsf(x0.z), fabsf(x0.w))), fmaxf(fmaxf(fabsf(x1.x), fabsf(x1.y)), fmaxf(fabsf(x1.z), fabsf(x1.w))));
        am = fmaxf(am, fmaxf(fmaxf(fmaxf(fabsf(x2.x), fabsf(x2.y)), fmaxf(fabsf(x2.z), fabsf(x2.w))), fmaxf(fmaxf(fabsf(x3.x), fabsf(x3.y)), fmaxf(fabsf(x3.z), fabsf(x3.w)))));
#pragma unroll
        for (int o = 1; o < 64; o <<= 1) am = fmaxf(am, __shfl_xor(am, o));
        am = fmaxf(am, 1e-30f);
        const float s = 384.f / am;
        v4u q;
        int w;
        w = __builtin_amdgcn_cvt_pk_fp8_f32(x0.x * s, x0.y * s, 0, false); w = __builtin_amdgcn_cvt_pk_fp8_f32(x0.z * s, x0.w * s, w, true); q.x = (unsigned)w;
        w = __builtin_amdgcn_cvt_pk_fp8_f32(x1.x * s, x1.y * s, 0, false); w = __builtin_amdgcn_cvt_pk_fp8_f32(x1.z * s, x1.w * s, w, true); q.y = (unsigned)w;
        w = __builtin_amdgcn_cvt_pk_fp8_f32(x2.x * s, x2.y * s, 0, false); w = __builtin_amdgcn_cvt_pk_fp8_f32(x2.z * s, x2.w * s, w, true); q.z = (unsigned)w;
        w = __builtin_amdgcn_cvt_pk_fp8_f32(x3.x * s, x3.y * s, 0, false); w = __builtin_amdgcn_cvt_pk_fp8_f32(x3.z * s, x3.w * s, w, true); q.w = (unsigned)w;
        *(v4u*)(ws + WS_OV + (tb ? OV_UP : OV_DOWN) + (size_t)e * D + 16 * lane) = q;
        if (lane == 0) ((float*)(ws + WS_OV + OV_PSCALE))[it] = am * (1.f / 384.f);
    }
}

template <class TT> __device__ __forceinline__ void ce_desc(TT& a, TT& b) { const TT hi = a > b ? a : b, lo = a > b ? b : a; a = hi; b = lo; }
__device__ __forceinline__ void cef(float& a, float& b) { const float hi = fmaxf(a, b), lo = fminf(a, b); a = hi; b = lo; }
__device__ __forceinline__ void ced(double& a, double& b) { const double hi = fmax(a, b), lo = fmin(a, b); a = hi; b = lo; }
template <class TT, class CE> __device__ __forceinline__ void bitonic_sort16_desc(TT (&v)[16], CE ce) {
#pragma unroll
    for (int k = 2; k <= 16; k <<= 1)
#pragma unroll
        for (int j = k >> 1; j > 0; j >>= 1)
#pragma unroll
            for (int i = 0; i < 16; ++i) { const int p = i ^ j; if (p > i) { if ((i & k) == 0) ce(v[i], v[p]); else ce(v[p], v[i]); } }
}
template <class TT, class CE> __device__ __forceinline__ void bitonic_merge16_desc(TT (&v)[16], CE ce) {
#pragma unroll
    for (int j = 8; j > 0; j >>= 1)
#pragma unroll
        for (int i = 0; i < 16; ++i) { const int p = i ^ j; if (p > i) ce(v[i], v[p]); }
}
struct CEF { __device__ __forceinline__ void operator()(float& a, float& b) const { cef(a, b); } };
struct CED { __device__ __forceinline__ void operator()(double& a, double& b) const { ced(a, b); } };

__device__ __forceinline__ void top16_of_128(const bf16* p, float (&top)[16]) {
#pragma unroll
    for (int grp = 0; grp < 8; ++grp) {
        float cur[16];
        const v4u q0 = *(const v4u*)(p + grp * 16), q1 = *(const v4u*)(p + grp * 16 + 8);
        const unsigned w[8] = {q0.x, q0.y, q0.z, q0.w, q1.x, q1.y, q1.z, q1.w};
#pragma unroll
        for (int e = 0; e < 8; ++e) {
            const unsigned lo = w[e] << 16, hi = w[e] & 0xffff0000u;
            const unsigned i0 = grp * 16 + 2 * e, i1 = i0 + 1;
            cur[2 * e] = __builtin_bit_cast(float, lo | ((lo >> 31) ? i0 : (127u - i0)));
            cur[2 * e + 1] = __builtin_bit_cast(float, hi | ((hi >> 31) ? i1 : (127u - i1)));
        }
        bitonic_sort16_desc(cur, CEF());
        if (grp == 0) {
#pragma unroll
            for (int i = 0; i < 16; ++i) top[i] = cur[i];
        } else {
#pragma unroll
            for (int i = 0; i < 16; ++i) top[i] = fmaxf(top[i], cur[15 - i]);
            bitonic_merge16_desc(top, CEF());
        }
    }
}
__device__ __forceinline__ unsigned key_index(float k) { const unsigned u = __builtin_bit_cast(unsigned, k); const unsigned lo = u & 0x7fu; return (u >> 31) ? lo : 127u - lo; }
__device__ __forceinline__ float key_value(float k) { return __builtin_bit_cast(float, __builtin_bit_cast(unsigned, k) & 0xffff0000u); }

__device__ __forceinline__ void phase_peer_topk(const Ctx& c, KArgs& a) {
    unsigned char* ws = a.ws;
    const bf16* SC = (const bf16*)(ws + WS_OV + OV_SC);
    int* IDX = (int*)(ws + WS_OV + OV_IDX); float* GATE = (float*)(ws + WS_OV + OV_GATE);
    for (int it = c.bid * 512 + c.tid; it < M * 8; it += c.G * 512) {
        const bf16* p = SC + (size_t)it * 256;
        float t0[16], t1[16];
        top16_of_128(p, t0); top16_of_128(p + 128, t1);
        float v0[16], v1[16]; unsigned i0[16], i1[16];
#pragma unroll
        for (int i = 0; i < 16; ++i) { v0[i] = key_value(t0[i]); v1[i] = key_value(t1[i]); i0[i] = key_index(t0[i]); i1[i] = key_index(t1[i]); }
        double top[16];
        const double NEG = -1.0e300;
#pragma unroll
        for (int grp = 0; grp < 4; ++grp) {
            double cur[16];
#pragma unroll
            for (int s = 0; s < 16; ++s) cur[s] = NEG;
            int n = 0;
#pragma unroll
            for (int i = 0; i < 16; ++i)
#pragma unroll
                for (int j = 0; j < 16; ++j) if ((i + 1) * (j + 1) <= 16) {
                    if (n / 16 == grp) {
                        const double d = (double)(v0[i] + v1[j]);
                        const unsigned long long eid = (unsigned long long)(i0[i] * 128u + i1[j]);
                        const unsigned long long bits = __builtin_bit_cast(unsigned long long, d);
                        cur[n % 16] = __builtin_bit_cast(double, bits | ((bits >> 63) ? eid : (16383ull - eid)));
                    }
                    ++n;
                }
            bitonic_sort16_desc(cur, CED());
            if (grp == 0) {
#pragma unroll
                for (int i = 0; i < 16; ++i) top[i] = cur[i];
            } else {
#pragma unroll
                for (int i = 0; i < 16; ++i) top[i] = fmax(top[i], cur[15 - i]);
                bitonic_merge16_desc(top, CED());
            }
        }
        float sv[16]; int id[16];
#pragma unroll
        for (int i = 0; i < 16; ++i) { const unsigned long long bits = __builtin_bit_cast(unsigned long long, top[i]); const unsigned lo = (unsigned)(bits & 0x3fffull);
            id[i] = (int)((bits >> 63) ? lo : 16383u - lo); sv[i] = (float)top[i]; }
        float den = 0.f, ex[16];
#pragma unroll
        for (int i = 0; i < 16; ++i) { ex[i] = __expf(sv[i] - sv[0]); den += ex[i]; }
        const float inv = 1.f / den;
        int* io = IDX + (size_t)it * 16; float* go = GATE + (size_t)it * 16;
#pragma unroll
        for (int q = 0; q < 4; ++q) { *(int4*)(io + 4 * q) = make_int4(id[4 * q], id[4 * q + 1], id[4 * q + 2], id[4 * q + 3]);
            *(f32x4*)(go + 4 * q) = (f32x4){ex[4 * q] * inv, ex[4 * q + 1] * inv, ex[4 * q + 2] * inv, ex[4 * q + 3] * inv}; }
    }
}

__device__ __forceinline__ float gelu_tanh(float x) { const float u = 0.7978845608f * (x + 0.044715f * x * x * x); const float t = 1.f - 2.f / (1.f + __expf(2.f * u)); return 0.5f * x * (1.f + t); }
__device__ __forceinline__ void unpack16_fp8(const v4u& q, float (&o)[16]) {
    const unsigned w[4] = {q.x, q.y, q.z, q.w};
#pragma unroll
    for (int i = 0; i < 4; ++i) { const f32x2 lo = __builtin_amdgcn_cvt_pk_f32_fp8((int)w[i], false), hi = __builtin_amdgcn_cvt_pk_f32_fp8((int)w[i], true);
        o[4 * i] = lo.x; o[4 * i + 1] = lo.y; o[4 * i + 2] = hi.x; o[4 * i + 3] = hi.y; }
}
template <int FUSE> __device__ __forceinline__ void phase_peer_experts(const Ctx& c, KArgs& a, const float* gnext, const bool commit = true) {
    unsigned char* ws = a.ws;
    const bf16* U = (const bf16*)(ws + WS_U);
    const unsigned char* DN = ws + WS_OV + OV_DOWN; const unsigned char* UP = ws + WS_OV + OV_UP;
    const float* SCD = (const float*)(ws + WS_OV + OV_PSCALE); const float* SCU = SCD + NEXP;
    const int* IDX = (const int*)(ws + WS_OV + OV_IDX); const float* GATE = (const float*)(ws + WS_OV + OV_GATE);
    float* H = a.out;
    constexpr int TPW = 16;
    LAS float* wlw = (LAS float*)c.lds + c.wave * (TPW * 128);
    const int lane = c.lane;
    const int gw = c.bid * 8 + c.wave, NGW = c.G * 8;
    const int esel = ((lane & 32) ? 8 : 0) + ((lane & 16) ? 4 : 0) + ((lane & 8) ? 2 : 0) + ((lane & 4) ? 1 : 0);
    const f32x4 gn0 = *(const f32x4*)(gnext + lane * 16), gn1 = *(const f32x4*)(gnext + lane * 16 + 4), gn2 = *(const f32x4*)(gnext + lane * 16 + 8), gn3 = *(const f32x4*)(gnext + lane * 16 + 12);
    for (int m0 = gw; m0 < M; m0 += NGW * TPW) {
#pragma unroll 1
        for (int ti = 0; ti < TPW; ++ti) {
            const int m = m0 + ti * NGW; if (m >= M) break;
            LAS float* wl = wlw + ti * 128;
            float x[16];
            { float t8[8]; unpack8(*(const v4u*)(U + (size_t)m * D + lane * 16), t8);
#pragma unroll
              for (int e2 = 0; e2 < 8; ++e2) x[e2] = t8[e2];
              unpack8(*(const v4u*)(U + (size_t)m * D + lane * 16 + 8), t8);
#pragma unroll
              for (int e2 = 0; e2 < 8; ++e2) x[8 + e2] = t8[e2]; }
            const int id0 = IDX[(size_t)m * 128 + lane], id1 = IDX[(size_t)m * 128 + 64 + lane];
            const float g0 = GATE[(size_t)m * 128 + lane], g1 = GATE[(size_t)m * 128 + 64 + lane];
            const float sd0 = SCD[id0], sd1 = SCD[id1], su0 = SCU[id0], su1 = SCU[id1];
#pragma unroll 1
            for (int bt = 0; bt < 8; ++bt) {
                v4u rr[16];
#pragma unroll
                for (int k = 0; k < 16; ++k) {
                    const int ei = bt * 16 + k;
                    const int row = __builtin_amdgcn_readlane(ei < 64 ? id0 : id1, ei & 63);
                    rr[k] = *(const v4u*)(DN + (size_t)row * D + lane * 16);
                }
                float d[16];
#pragma unroll
                for (int k = 0; k < 16; ++k) { float f[16]; unpack16_fp8(rr[k], f); float s0 = 0.f, s1 = 0.f;
#pragma unroll
                    for (int q = 0; q < 8; ++q) { s0 += f[q] * x[q]; s1 += f[8 + q] * x[8 + q]; }
                    d[k] = s0 + s1; }
#pragma unroll
                for (int sft = 32, half = 8; sft >= 4; sft >>= 1, half >>= 1) {
                    const bool up = (lane & sft) != 0;
#pragma unroll
                    for (int i = 0; i < 8; ++i) if (i < half) { const float send = up ? d[i] : d[i + half]; const float keep = up ? d[i + half] : d[i]; d[i] = keep + __shfl_xor(send, sft); }
                }
                float r = d[0];
                r += __shfl_xor(r, 2); r += __shfl_xor(r, 1);
                if ((lane & 3) == 0) wl[bt * 16 + esel] = r;
            }
            asm volatile("s_waitcnt lgkmcnt(0)" ::: "memory");
            {
                const float w0 = g0 * gelu_tanh(wl[lane] * sd0) * su0, w1 = g1 * gelu_tanh(wl[64 + lane] * sd1) * su1;
                asm volatile("s_waitcnt lgkmcnt(0)" ::: "memory");
                wl[lane] = w0; wl[64 + lane] = w1;
                asm volatile("s_waitcnt lgkmcnt(0)" ::: "memory");
            }
        }
#pragma unroll 1
        for (int ti = 0; ti < TPW; ++ti) {
            const int m = m0 + ti * NGW; if (m >= M) break;
            const LAS float* wl = wlw + ti * 128;
            const int id0 = IDX[(size_t)m * 128 + lane], id1 = IDX[(size_t)m * 128 + 64 + lane];
            float acc[16];
#pragma unroll
            for (int q = 0; q < 16; ++q) acc[q] = 0.f;
#pragma unroll 1
            for (int bt = 0; bt < 8; ++bt) {
                v4u rr[16];
#pragma unroll
                for (int k = 0; k < 16; ++k) {
                    const int ei = bt * 16 + k;
                    const int row = __builtin_amdgcn_readlane(ei < 64 ? id0 : id1, ei & 63);
                    rr[k] = *(const v4u*)(UP + (size_t)row * D + lane * 16);
                }
#pragma unroll
                for (int k = 0; k < 16; ++k) {
                    const float w = wl[bt * 16 + k];
                    float f[16]; unpack16_fp8(rr[k], f);
#pragma unroll
                    for (int q = 0; q < 16; ++q) acc[q] += w * f[q];
                }
            }
            if (!commit && acc[0] != 123456.789f) continue;
            f32x4* hp = (f32x4*)(H + (size_t)m * D + lane * 16);
            f32x4 h0 = hp[0], h1 = hp[1], h2 = hp[2], h3 = hp[3];
            h0 += (f32x4){acc[0], acc[1], acc[2], acc[3]}; h1 += (f32x4){acc[4], acc[5], acc[6], acc[7]};
            h2 += (f32x4){acc[8], acc[9], acc[10], acc[11]}; h3 += (f32x4){acc[12], acc[13], acc[14], acc[15]};
            float ss = (h0.x * h0.x + h0.y * h0.y) + (h0.z * h0.z + h0.w * h0.w) + (h1.x * h1.x + h1.y * h1.y) + (h1.z * h1.z + h1.w * h1.w)
                     + (h2.x * h2.x + h2.y * h2.y) + (h2.z * h2.z + h2.w * h2.w) + (h3.x * h3.x + h3.y * h3.y) + (h3.z * h3.z + h3.w * h3.w);
            const float rn = rsqrtf(sum64(ss) * (1.f / D) + 1e-6f);
            const f32x4 n0 = h0 * rn * gn0, n1 = h1 * rn * gn1, n2 = h2 * rn * gn2, n3 = h3 * rn * gn3;
            if (FUSE == 0) {
                hp[0] = h0; hp[1] = h1; hp[2] = h2; hp[3] = h3;
                v4u u0, u1; u0.x = pk2(n0.x, n0.y); u0.y = pk2(n0.z, n0.w); u0.z = pk2(n1.x, n1.y); u0.w = pk2(n1.z, n1.w);
                u1.x = pk2(n2.x, n2.y); u1.y = pk2(n2.z, n2.w); u1.z = pk2(n3.x, n3.y); u1.w = pk2(n3.z, n3.w);
                bf16* up_ = (bf16*)(ws + WS_U) + (size_t)m * D + lane * 16;
                *(v4u*)up_ = u0; *(v4u*)(up_ + 8) = u1;
            } else { hp[0] = n0; hp[1] = n1; hp[2] = n2; hp[3] = n3; }
        }
    }
}

constexpr int PH_PER_HALF = 11, PH_PER_LAYER = 1 + 2 * PH_PER_HALF + 4, N_PHASES = 1 + DEPTH * PH_PER_LAYER;
__device__ __forceinline__ Ctx make_ctx() {
    extern __shared__ __attribute__((aligned(16))) unsigned char lds_raw[];
    Ctx c; int t = threadIdx.x; asm volatile("" : "+v"(t)); c.lds = (LAS unsigned char*)lds_raw; c.tid = t; c.lane = t & 63; c.wave = __builtin_amdgcn_readfirstlane(t >> 6); c.G = gridDim.x; c.bid = blockIdx.x; return c; }
__device__ __forceinline__ KArgs* kargs_fresh() { KArgs* p = (KArgs*)__builtin_amdgcn_kernarg_segment_ptr(); asm volatile("" : "+s"(p)); return p; }
#define PH_BEGIN(K) if (lo <= (K) && (K) < hi) { const Ctx c = make_ctx(); KArgs& args = *kargs_fresh(); unsigned char* ws = args.ws; (void)ws;
#define PH_END(K)   if ((K) + 1 < hi) xcd_barrier(bar); }

template <int L, int HB> __device__ __forceinline__ void half_pass(const XcdBarrier& bar, const int lo, const int hi) {
    constexpr int P0 = 1 + L * PH_PER_LAYER + 1 + HB * PH_PER_HALF;
#define WIN ((const bf16*)(ws + WS_WIN + L * WIN_L))
#define Uh ((const bf16*)(ws + WS_U) + (size_t)HB * MH * D)
    PH_BEGIN(P0 + 0) {
        pg8::Gemm g{Uh, WIN, MH, N1P, D, D, 0}; pg8::StaticOrder S; S.init(MH, N1P, c.G, c.bid);
        pg8::EpiRow8<FStoreBf16> E{{(bf16*)(ws + WS_OV + OV_PR), N1P}};
        pg8::gemm_phase(c.lds, g, S, E); if (PROBE_DUP == 5) pg8::gemm_phase(c.lds, g, S, E); } PH_END(P0 + 0)
    PH_BEGIN(P0 + 1) if (PROBE_DUP == 6) phase_rwkv_prep(c, args, L, HB); phase_rwkv_prep(c, args, L, HB); PH_END(P0 + 1)
    PH_BEGIN(P0 + 2) {
        constexpr int NL = L == 0 ? 3072 : 4096;
        pg8::Gemm g{(const bf16*)(ws + WS_OV + OV_AL), (const bf16*)(ws + WS_WLORA + L * WLORA_L), MH, NL, KL, KL, 1}; pg8::StaticOrder S; S.init(MH, NL, c.G, c.bid);
        EpiLora E{(bf16*)(ws + WS_OV + OV_ELOG), (bf16*)(ws + WS_OV + OV_ASIG), (bf16*)(ws + WS_OV + OV_GG), (bf16*)(ws + WS_OV + OV_VMIX),
                               (const bf16*)(ws + WS_VF) + (size_t)HB * MH * D, args.in[I_W0] + (size_t)L * D, args.in[I_A0] + (size_t)L * D, args.in[I_V0]};
        pg8::gemm_phase(c.lds, g, S, E); } PH_END(P0 + 2)
    PH_BEGIN(P0 + 3) phase_rwkv_chunk_par(c, args, L, HB); PH_END(P0 + 3)
    PH_BEGIN(P0 + 4) if (PROBE_DUP == 8) phase_rwkv_chunk_seq(c, args, false); phase_rwkv_chunk_seq(c, args); PH_END(P0 + 4)
    PH_BEGIN(P0 + 5) {
        phase_rwkv_post(c, args, L, HB); __syncthreads();
        pg8::Gemm g{Uh, WIN + (size_t)N1P * D, MH, N2P, D, D, 0}; pg8::StaticOrder S; S.init(MH, N2P, c.G, c.bid);
        pg8::EpiRow8<FStoreBf16> E{{(bf16*)(ws + WS_OV + OV_PS), N2P}};
        pg8::gemm_phase(c.lds, g, S, E); if (PROBE_DUP == 5) pg8::gemm_phase(c.lds, g, S, E); } PH_END(P0 + 5)
    PH_BEGIN(P0 + 6) if (PROBE_DUP == 6) phase_ssd_conv(c, args, L); phase_ssd_conv(c, args, L); PH_END(P0 + 6)
    PH_BEGIN(P0 + 7) phase_ssd_scan(c, args, L); PH_END(P0 + 7)
    PH_BEGIN(P0 + 8) phase_ssd_post(c, args, L); PH_END(P0 + 8)
    PH_BEGIN(P0 + 9) {
      { pg8::Gemm g{Uh, WIN + (size_t)(N1P + N2P) * D, MH, D, D, D, 0}; pg8::StaticOrder S; S.init(MH, D, c.G, c.bid);
        pg8::EpiRow8<FSigmoidBf16> E{{(bf16*)(ws + WS_OV + OV_GATES), 2048}};
        pg8::gemm_phase(c.lds, g, S, E); }
      { pg8::Gemm g{Uh, WIN + (size_t)(N1P + N2P + D) * D, MH, D, D, D, 0}; pg8::StaticOrder S; S.init(MH, D, c.G, c.bid);
        pg8::EpiRow8<FSigmoidBf16> E{{(bf16*)(ws + WS_OV + OV_GATES) + 1024, 2048}};
        pg8::gemm_phase(c.lds, g, S, E); }
      {
        pg8::Gemm g{(const bf16*)(ws + WS_OV + OV_YA), (const bf16*)(ws + WS_WA) + (size_t)L * D * D, MH, D, D, D, 0}; pg8::StaticOrder S; S.init(MH, D, c.G, c.bid);
        pg8::EpiRow8<FMixA> E{{(const bf16*)(ws + WS_OV + OV_GATES), (bf16*)(ws + WS_OV + OV_MIXED)}};
        pg8::gemm_phase(c.lds, g, S, E); }
      {
        pg8::Gemm g{(const bf16*)(ws + WS_OV + OV_PS) + 2048, (const bf16*)(ws + WS_WB) + (size_t)L * D * 2048, MH, D, 2048, N2P, 0}; pg8::StaticOrder S; S.init(MH, D, c.G, c.bid);
        pg8::EpiRow8<FMixB> E{{(const bf16*)(ws + WS_OV + OV_GATES), (bf16*)(ws + WS_OV + OV_MIXED)}};
        pg8::gemm_phase(c.lds, g, S, E); } } PH_END(P0 + 9)
    PH_BEGIN(P0 + 10) {
        pg8::Gemm g{(const bf16*)(ws + WS_OV + OV_MIXED), (const bf16*)(ws + WS_WO) + (size_t)L * D * D, MH, D, D, D, 0}; pg8::StaticOrder S; S.init(MH, D, c.G, c.bid);
        pg8::EpiRow8<FResid> E{{(L == 0 ? args.in[I_X] : (const float*)args.out) + (size_t)HB * MH * D, args.out + (size_t)HB * MH * D}};
        pg8::gemm_phase(c.lds, g, S, E); } PH_END(P0 + 10)
#undef WIN
#undef Uh
}

template <int L> __device__ __forceinline__ void layer_pass(const XcdBarrier& bar, const int lo, const int hi) {
    constexpr int P0 = 1 + L * PH_PER_LAYER, P1 = P0 + 1 + 2 * PH_PER_HALF;
    PH_BEGIN(P0) if (L == 0) phase_rmsnorm(c, args.in[I_X], args.in[I_NMG], (bf16*)(ws + WS_U), nullptr); PH_END(P0)
    half_pass<L, 0>(bar, lo, hi);
    half_pass<L, 1>(bar, lo, hi);
    PH_BEGIN(P1 + 0) phase_rmsnorm(c, args.out, args.in[I_NFG] + (size_t)L * D, (bf16*)(ws + WS_U), nullptr); phase_peer_convert(c, args, L); PH_END(P1 + 0)
    PH_BEGIN(P1 + 1) {
        pg8::Gemm g{(const bf16*)(ws + WS_U), (const bf16*)(ws + WS_WQK) + (size_t)L * 2048 * D, M, 2048, D, D, 0}; pg8::StaticOrder S; S.init(M, 2048, c.G, c.bid);
        pg8::EpiRow8<FStoreBf16> E{{(bf16*)(ws + WS_OV + OV_SC), 2048}};
        pg8::gemm_phase(c.lds, g, S, E); } PH_END(P1 + 1)
    PH_BEGIN(P1 + 2) if (PROBE_DUP == 4) phase_peer_topk(c, args); phase_peer_topk(c, args); PH_END(P1 + 2)
    PH_BEGIN(P1 + 3) phase_peer_experts<L == DEPTH - 1 ? 1 : 0>(c, args, L == DEPTH - 1 ? args.in[I_NFIN] : args.in[I_NMG] + (size_t)(L + 1) * D); PH_END(P1 + 3)
}

__global__ void __launch_bounds__(512, 2) mk_fwd(Args kargs_) {
    extern __shared__ __attribute__((aligned(16))) unsigned char lds_raw[];
    LAS unsigned char* lds0 = (LAS unsigned char*)lds_raw;
    unsigned char* ws0 = kargs_.ws;
    const int lo = kargs_.lo, hi = kargs_.hi;
    if (threadIdx.x < 4) ((LAS unsigned*)(lds0 + LDS_MISC))[threadIdx.x] = 0u;
    __syncthreads();
    XcdBarrier bar; bar.bar = (unsigned*)(ws0 + WS_CTL) + CW_BAR; bar.x = 0; bar.st = (volatile LAS unsigned*)(lds0 + LDS_MISC);
    if (hi - lo > 1) bar = xcd_barrier_post((unsigned*)(ws0 + WS_CTL) + CW_BAR, (volatile LAS unsigned*)(lds0 + LDS_MISC));
    PH_BEGIN(0) phase_prologue(c, args); PH_END(0)
    layer_pass<0>(bar, lo, hi);
    layer_pass<1>(bar, lo, hi);
}

extern "C" void kernel_launch(void* const* d_in, const int* in_sizes, int n_in, void* d_out, int out_size, void* d_ws, size_t ws_size, hipStream_t stream) {
    static int grid = 0;
    if (grid == 0) {
        if (n_in != 32 || out_size != M * D || ws_size < WS_END) { fprintf(stderr, "kernel_launch: unexpected problem (n_in %d, out %d, ws %zu < %zu)\n", n_in, out_size, ws_size, (size_t)WS_END); grid = -1; return; }
        int dev = 0, cus = 0, per_cu = 0;
        if (hipGetDevice(&dev) != hipSuccess || hipDeviceGetAttribute(&cus, hipDeviceAttributeMultiprocessorCount, dev) != hipSuccess) { grid = -1; return; }
        if (hipFuncSetAttribute((const void*)mk_fwd, hipFuncAttributeMaxDynamicSharedMemorySize, LDS_BYTES) != hipSuccess) { fprintf(stderr, "kernel_launch: hipFuncSetAttribute failed\n"); grid = -1; return; }
        if (hipOccupancyMaxActiveBlocksPerMultiprocessor(&per_cu, (const void*)mk_fwd, 512, LDS_BYTES) != hipSuccess || per_cu < 1) { fprintf(stderr, "kernel_launch: occupancy query says %d\n", per_cu); per_cu = 1; }
        (void)hipGetLastError();
        grid = cus;
    }
    if (grid < 0) return;
    (void)hipMemsetAsync((char*)d_ws + WS_CTL, 0, CTL_BYTES, stream);
    Args a{};
    for (int i = 0; i < 32; ++i) a.in[i] = (const float*)d_in[i];
    a.out = (float*)d_out; a.ws = (unsigned char*)d_ws;
#if MK_MULTI
    for (int p = 0; p < N_PHASES; ++p) { a.lo = p; a.hi = p + 1; hipLaunchKernelGGL(mk_fwd, dim3(grid), dim3(512), LDS_BYTES, stream, a); }
#else
    a.lo = 0; a.hi = N_PHASES;
    hipLaunchKernelGGL(mk_fwd, dim3(grid), dim3(512), LDS_BYTES, stream, a);
#endif
}
```

```cpp
#include <hip/hip_runtime.h>
#include <cstdio>
#include <cstdint>

#ifndef PROBE_DUP
#define PROBE_DUP 0
#endif
#ifndef MK_MULTI
#define MK_MULTI 0
#endif

#define GAS __attribute__((address_space(1)))
#define LAS __attribute__((address_space(3)))
typedef unsigned short bf16;
typedef unsigned v4u __attribute__((ext_vector_type(4)));
typedef unsigned v2u __attribute__((ext_vector_type(2)));
typedef float f32x4 __attribute__((ext_vector_type(4)));
typedef float f32x2 __attribute__((ext_vector_type(2)));
typedef short bf16x8 __attribute__((ext_vector_type(8)));
typedef __bf16 bf2_t __attribute__((ext_vector_type(2)));

constexpr int D = 1024, BATCH = 8, T = 4096, M = BATCH * T, MH = M / 2, DEPTH = 2;
constexpr int RW_PROJ = 3360, SSD_PROJ = 5152, IN_PROJ = 10560;
constexpr int N1P = 3584, N2P = 5120, N3P = 2048, NINP = N1P + N2P + N3P;
constexpr int DT_COL = RW_PROJ;
constexpr int KL = 384;
constexpr int NEXP = 16384;
#ifndef PROBE_DOWN
#define PROBE_DOWN -1
#endif
constexpr int PEER_SLICE_SHIFT = 11, PEER_NSLICE = NEXP >> PEER_SLICE_SHIFT;
constexpr int CW_QUEUE = 8192;

constexpr size_t MiB = 1u << 20;
constexpr size_t WS_CTL = 0, CTL_BYTES = 1 * MiB;
constexpr size_t WS_WIN = 1 * MiB;
constexpr size_t WIN_L = (size_t)NINP * D * 2;
constexpr size_t WS_WA = 44 * MiB;
constexpr size_t WS_WB = 48 * MiB;
constexpr size_t WS_WO = 56 * MiB;
constexpr size_t WS_WQK = 60 * MiB;
constexpr size_t WS_WLORA = 68 * MiB;
constexpr size_t WLORA_L = (size_t)4096 * KL * 2;
constexpr size_t WS_U = 74 * MiB;
constexpr size_t WS_VF = 138 * MiB;
constexpr size_t WS_OV = 202 * MiB;
constexpr size_t OV_PR = 0, OV_ELOG = 112 * MiB, OV_ASIG = 144 * MiB, OV_GG = 176 * MiB, OV_VMIX = 208 * MiB, OV_AL = 240 * MiB, OV_YA = 272 * MiB;
constexpr size_t OV_PS = 0, OV_XBC = 168 * MiB, OV_DT = 305 * MiB, OV_DA = 307 * MiB;
constexpr size_t OV_GATES = 168 * MiB, OV_MIXED = 232 * MiB;
constexpr size_t OV_DOWN = 0, OV_UP = 32 * MiB, OV_PSCALE = 48 * MiB  , OV_SC = 64 * MiB, OV_IDX = 192 * MiB, OV_GATE = 208 * MiB, OV_POFF = 224 * MiB  , OV_ACT = 226 * MiB  , OV_U8 = 244 * MiB  , OV_XS = 276 * MiB  ;
constexpr size_t OV_BON = 304 * MiB;
constexpr size_t WS_END = WS_OV + 309 * MiB;
static_assert(WS_WIN + 2 * WIN_L <= WS_WA, "map");

constexpr int LDS_BYTES = 147456;
constexpr int LDS_MISC = 145408;
constexpr int CW_BAR = 4096;

__device__ __forceinline__ unsigned f2bf(float f) { unsigned u = __builtin_bit_cast(unsigned, f); return (u + 0x7fffu + ((u >> 16) & 1u)) >> 16; }
__device__ __forceinline__ unsigned pk2(float lo, float hi) { unsigned r; asm volatile("v_cvt_pk_bf16_f32 %0, %1, %2" : "=v"(r) : "v"(lo), "v"(hi)); return r; }
typedef __bf16 bf16x2_t __attribute__((ext_vector_type(2)));
__device__ __forceinline__ unsigned pk2c(float lo, float hi) { bf16x2_t v; v.x = (__bf16)lo; v.y = (__bf16)hi; return __builtin_bit_cast(unsigned, v); }
__device__ __forceinline__ float bflo(unsigned u) { return __builtin_bit_cast(float, u << 16); }
__device__ __forceinline__ float bfhi(unsigned u) { return __builtin_bit_cast(float, u & 0xffff0000u); }
__device__ __forceinline__ float bf1(bf16 u) { return __builtin_bit_cast(float, ((unsigned)u) << 16); }
__device__ __forceinline__ float sigmoidf_(float x) { return 1.f / (1.f + __expf(-x)); }
__device__ __forceinline__ float siluf_(float x) { return x / (1.f + __expf(-x)); }
template <int CTRL> __device__ __forceinline__ float dpp_mov(float x) { return __int_as_float(__builtin_amdgcn_update_dpp(0, __float_as_int(x), CTRL, 0xF, 0xF, true)); }
__device__ __forceinline__ float sum4(float x) { x += dpp_mov<0xB1>(x); x += dpp_mov<0x4E>(x); return x; }
__device__ __forceinline__ float sum16(float x) { x += dpp_mov<0xB1>(x); x += dpp_mov<0x4E>(x); x += dpp_mov<0x141>(x); x += dpp_mov<0x140>(x); return x; }
__device__ __forceinline__ float sum64(float x) { x = sum16(x); x += __shfl_xor(x, 16); x += __shfl_xor(x, 32); return x; }
__device__ __forceinline__ void unpack8(const v4u& q, float (&o)[8]) { o[0] = bflo(q.x); o[1] = bfhi(q.x); o[2] = bflo(q.y); o[3] = bfhi(q.y); o[4] = bflo(q.z); o[5] = bfhi(q.z); o[6] = bflo(q.w); o[7] = bfhi(q.w); }
__device__ __forceinline__ v4u pack8(const float (&o)[8]) { v4u q; q.x = pk2(o[0], o[1]); q.y = pk2(o[2], o[3]); q.z = pk2(o[4], o[5]); q.w = pk2(o[6], o[7]); return q; }

typedef short s16x4 __attribute__((ext_vector_type(4)));
__device__ __forceinline__ void lds_barrier() { asm volatile("s_waitcnt lgkmcnt(0)\n\ts_barrier" ::: "memory"); }
__device__ __forceinline__ bf16x8 tr_frag(unsigned base_bytes, int stride, int k0, int c0, int lane) {
    const int i16 = lane & 15, qq = i16 >> 2, p = i16 & 3, q = lane >> 4;
    const unsigned a0 = base_bytes + (unsigned)(((k0 + 8 * q + qq) * stride + c0 + 4 * p) * 2), a1 = a0 + (unsigned)(8 * stride);
    s16x4 lo, hi;
    asm volatile("ds_read_b64_tr_b16 %0, %2\n\tds_read_b64_tr_b16 %1, %3\n\ts_waitcnt lgkmcnt(0)" : "=&v"(lo), "=&v"(hi) : "v"(a0), "v"(a1) : "memory");
    return __builtin_shufflevector(lo, hi, 0, 1, 2, 3, 4, 5, 6, 7);
}

namespace pg8 {
constexpr int BM = 256, BK = 64, HALF = 128, HTB = HALF * BK * 2, STAGE_BYTES = 8 * HTB, NXCD = 8, WGM = 8;
__host__ __device__ __forceinline__ int lds_byte(int r, int c) { const int st = (r >> 4) * 2 + (c >> 5), rr = r & 15, cc = c & 31, ob = rr * 64 + cc * 2; return st * 1024 + (ob ^ (((ob >> 9) & 1) << 5)); }
__host__ __device__ __forceinline__ void stage_rc(int b, int& R, int& C) { const int st = b / 1024, sb = b % 1024, swz = sb ^ (((sb >> 9) & 1) << 5); R = (st >> 1) * 16 + swz / 64; C = (st & 1) * 32 + (swz % 64) / 2; }
__host__ __device__ __forceinline__ int perm32(int rho) { const int n = rho >> 4, i = rho & 15; return 8 * (i >> 2) + 4 * n + (i & 3); }
struct Unit { int pm, pn; };
struct Gemm { const bf16* A; const bf16* Bt; int M, N, K, lda; int kwin; };
__device__ __forceinline__ void unit_kwin(const Gemm& g, const Unit& u, int& k0t, int& ntl) { k0t = 0; ntl = g.K / BK; if (g.kwin) { const int blk = u.pn >> 2; if (blk < 2) { k0t = 0; ntl = 2; } else if (blk == 2) { k0t = 2; ntl = 4; } else { k0t = 4; ntl = 2; } } }
struct StaticOrder {
    int nM, nN, nwg, G, c;
    __device__ void init(int M_, int N_, int G_, int c_) { nM = M_ / BM; nN = N_ / BM; nwg = nM * nN; G = G_; c = c_; }
    __device__ bool next(int i, Unit& u) const {
        const long L = (long)i * G + c; if (L >= nwg) return false;
        int wgid = (int)L; { const int q = nwg / NXCD, r = nwg % NXCD, xcd = wgid % NXCD, off = wgid / NXCD; wgid = (xcd < r ? xcd * (q + 1) : r * (q + 1) + (xcd - r) * q) + off; }
        const int nig = WGM * nN, gid = wgid / nig, fm = gid * WGM, gsz = (nM - fm) < WGM ? (nM - fm) : WGM;
        u.pm = fm + ((wgid % nig) % gsz); u.pn = (wgid % nig) / gsz; return true;
    }
};
template <class F> struct EpiRow8 {
    static constexpr bool PERM = true;
    F f;
    __device__ __forceinline__ void operator()(const f32x4 (&acc)[2][2][4][2], const Unit& u, int wr, int wc, int fr, int fq) const {
        const int row0 = u.pm * BM + wr * 64 + fr, col0 = u.pn * BM + wc * 32 + 8 * fq;
#pragma unroll
        for (int g0 = 0; g0 < 16; g0 += F::GRP) {
            typename F::Tmp t[F::GRP];
#pragma unroll
            for (int j = 0; j < F::GRP; ++j) { const int i = g0 + j, ai = i >> 3, m = (i >> 1) & 3, bj = i & 1; f.load(row0 + ai * HALF + m * 16, col0 + bj * HALF, u.pn, t[j]); }
#pragma unroll
            for (int j = 0; j < F::GRP; ++j) { const int i = g0 + j, ai = i >> 3, m = (i >> 1) & 3, bj = i & 1; f.apply(row0 + ai * HALF + m * 16, col0 + bj * HALF, acc[ai][bj][m][0], acc[ai][bj][m][1], u.pn, t[j]); }
        }
    }
};


template <class Epi>
__device__ __forceinline__ void gemm_phase(LAS unsigned char* lds, const Gemm g, const StaticOrder& S, const Epi& E) {
    const int tid = threadIdx.x, wid = __builtin_amdgcn_readfirstlane(tid >> 6), lane = tid & 63, wr = wid >> 2, wc = wid & 3, fr = lane & 15, fq = lane >> 4;
    const int K = g.K, lda = g.lda;
    unsigned voffA[2], voffB[2];
#pragma unroll
    for (int i = 0; i < 2; ++i) { int R, C; stage_rc(tid * 16 + i * 8192, R, C); const int Rb = Epi::PERM ? ((R & ~31) + perm32(R & 31)) : R;
        voffA[i] = (unsigned)(R * lda + C) * 2u; voffB[i] = (unsigned)(Rb * K + C) * 2u; }
    const size_t kstep = (size_t)(BK * 2);
    const size_t hstepA = (size_t)HALF * lda * 2, hstepB = (size_t)HALF * K * 2;
    const size_t tstepA = 2 * hstepA, tstepB = 2 * hstepB;
    const unsigned ldsw = (unsigned)wid * 1024u;
    const int aoff = lds_byte(wr * 64 + fr, fq * 8), boff = lds_byte(wc * 32 + fr, fq * 8);
#define PG8_SA(b, h) (((b) * 2 + (h)) * HTB)
#define PG8_SB(b, h) ((4 + (b) * 2 + (h)) * HTB)
#define PG8_STAGE(bufoff, gbase, voff) do { _Pragma("unroll") for (int _i = 0; _i < 2; ++_i) \
        __builtin_amdgcn_global_load_lds((const unsigned*)((const char*)(gbase) + (voff)[_i]), (LAS unsigned*)(lds + (bufoff) + ldsw + _i * 8192), 16, 0, 0); } while (0)
#define PG8_LDA(dst, b, h) do { _Pragma("unroll") for (int m = 0; m < 4; ++m) _Pragma("unroll") for (int k = 0; k < 2; ++k) dst[m][k] = *(const LAS bf16x8*)(lds + PG8_SA(b, h) + aoff + m * 2048 + k * 1024); } while (0)
#define PG8_LDB(dst, b, h) do { _Pragma("unroll") for (int n = 0; n < 2; ++n) _Pragma("unroll") for (int k = 0; k < 2; ++k) dst[n][k] = *(const LAS bf16x8*)(lds + PG8_SB(b, h) + boff + n * 2048 + k * 1024); } while (0)
#define PG8_MMA(ai, bj, At, Bt) do { __builtin_amdgcn_s_setprio(1); _Pragma("unroll") for (int m = 0; m < 4; ++m) _Pragma("unroll") for (int n = 0; n < 2; ++n) _Pragma("unroll") for (int k = 0; k < 2; ++k) \
        acc[ai][bj][m][n] = __builtin_amdgcn_mfma_f32_16x16x32_bf16(Bt[n][k], At[m][k], acc[ai][bj][m][n], 0, 0, 0); __builtin_amdgcn_s_setprio(0); } while (0)
#define PG8_WAIT_V(n) asm volatile("s_waitcnt vmcnt(" #n ")" ::: "memory")
#define PG8_WAIT_L(n) asm volatile("s_waitcnt lgkmcnt(" #n ")" ::: "memory")
#define PG8_BAR __builtin_amdgcn_s_barrier()
#define PG8_SCHED __builtin_amdgcn_sched_barrier(0)
    Unit cur, nxt; int ui = 0;
    if (!S.next(0, cur)) return;
    f32x4 acc[2][2][4][2];
#pragma unroll
    for (int a = 0; a < 2; ++a)
#pragma unroll
        for (int b = 0; b < 2; ++b)
#pragma unroll
            for (int m = 0; m < 4; ++m)
#pragma unroll
                for (int n = 0; n < 2; ++n) acc[a][b][m][n] = (f32x4){0.f, 0.f, 0.f, 0.f};
    bf16x8 At[4][2], B0[2][2], B1[2][2];
    int k0c, nt; unit_kwin(g, cur, k0c, nt);
    const char* cA = (const char*)g.A + (size_t)cur.pm * tstepA + (size_t)k0c * kstep; const char* cB = (const char*)g.Bt + (size_t)cur.pn * tstepB + (size_t)k0c * kstep;
    PG8_STAGE(PG8_SB(0, 0), cB, voffB); PG8_STAGE(PG8_SA(0, 0), cA, voffA); PG8_STAGE(PG8_SB(0, 1), cB + hstepB, voffB); PG8_STAGE(PG8_SA(0, 1), cA + hstepA, voffA);
    if (wr == 1) PG8_BAR;
    PG8_WAIT_V(4); PG8_BAR;
    PG8_STAGE(PG8_SB(1, 0), cB + kstep, voffB); PG8_STAGE(PG8_SA(1, 0), cA + kstep, voffA); PG8_STAGE(PG8_SB(1, 1), cB + hstepB + kstep, voffB);
    PG8_WAIT_V(6); PG8_BAR;
    for (;;) {
        const bool has_next = S.next(ui + 1, nxt);
        int k0n = 0, ntn = nt; if (has_next) unit_kwin(g, nxt, k0n, ntn);
        const char* nA = has_next ? (const char*)g.A + (size_t)nxt.pm * tstepA + (size_t)k0n * kstep : cA; const char* nB = has_next ? (const char*)g.Bt + (size_t)nxt.pn * tstepB + (size_t)k0n * kstep : cB;
        for (int t = 0; t < nt; t += 2) {
            const bool last = (t == nt - 2);
            const char* a1 = cA + (size_t)(t + 1) * kstep;
            const char* a2 = last ? nA : cA + (size_t)(t + 2) * kstep; const char* b2 = last ? nB : cB + (size_t)(t + 2) * kstep;
            const char* a3 = a2 + kstep; const char* b3 = b2 + kstep;
            PG8_LDB(B0, 0, 0); PG8_SCHED; PG8_LDA(At, 0, 0); PG8_STAGE(PG8_SA(1, 1), a1 + hstepA, voffA);
            PG8_WAIT_L(8); PG8_BAR; PG8_WAIT_L(0); PG8_MMA(0, 0, At, B0); PG8_BAR; PG8_SCHED;
            PG8_LDB(B1, 0, 1); PG8_STAGE(PG8_SB(0, 0), b2, voffB);
            PG8_BAR; PG8_WAIT_L(0); PG8_MMA(0, 1, At, B1); PG8_BAR;
            PG8_LDA(At, 0, 1); PG8_STAGE(PG8_SA(0, 0), a2, voffA);
            PG8_BAR; PG8_WAIT_L(0); PG8_MMA(1, 0, At, B0); PG8_BAR; PG8_SCHED;
            PG8_STAGE(PG8_SB(0, 1), b2 + hstepB, voffB);
            PG8_WAIT_V(6); PG8_BAR; PG8_MMA(1, 1, At, B1); PG8_BAR;
            PG8_LDB(B0, 1, 0); PG8_SCHED; PG8_LDA(At, 1, 0); PG8_STAGE(PG8_SA(0, 1), a2 + hstepA, voffA);
            PG8_WAIT_L(8); PG8_BAR; PG8_WAIT_L(0); PG8_MMA(0, 0, At, B0); PG8_BAR; PG8_SCHED;
            PG8_LDB(B1, 1, 1); PG8_STAGE(PG8_SB(1, 0), b3, voffB);
            PG8_BAR; PG8_WAIT_L(0); PG8_MMA(0, 1, At, B1); PG8_BAR;
            PG8_LDA(At, 1, 1); PG8_STAGE(PG8_SA(1, 0), a3, voffA);
            PG8_BAR; PG8_WAIT_L(0); PG8_MMA(1, 0, At, B0); PG8_BAR; PG8_SCHED;
            PG8_STAGE(PG8_SB(1, 1), b3 + hstepB, voffB);
            PG8_WAIT_V(6); PG8_BAR; PG8_MMA(1, 1, At, B1); PG8_BAR;
        }
        E(acc, cur, wr, wc, fr, fq);
        if (!has_next) break;
#pragma unroll
        for (int a = 0; a < 2; ++a)
#pragma unroll
            for (int b = 0; b < 2; ++b)
#pragma unroll
                for (int m = 0; m < 4; ++m)
#pragma unroll
                    for (int n = 0; n < 2; ++n) acc[a][b][m][n] = (f32x4){0.f, 0.f, 0.f, 0.f};
        cur = nxt; cA = nA; cB = nB; nt = ntn; ++ui;
    }
    PG8_WAIT_V(0);
    if (wr == 0) PG8_BAR;
    PG8_BAR;
#undef PG8_SA
#undef PG8_SB
#undef PG8_STAGE
#undef PG8_LDA
#undef PG8_LDB
#undef PG8_MMA
#undef PG8_WAIT_V
#undef PG8_WAIT_L
#undef PG8_BAR
#undef PG8_SCHED
}
}

#define XB_TMO      128
#define XB_XCNT(j)  (256  + 64 * (j))
#define XB_XSUB(j)  (1280 + 64 * (j))
#define XB_XGEN(j)  (2304 + 64 * (j))
#define XB_TOP      3328
#define XB_TOPGEN   3392
#define XCD_BAR_WORDS 3456
#define XB_SPIN_CAP (1u << 18)
__device__ __forceinline__ unsigned xb_ld(unsigned* p)              { return __hip_atomic_load(p, __ATOMIC_RELAXED, __HIP_MEMORY_SCOPE_AGENT); }
__device__ __forceinline__ unsigned xb_add(unsigned* p, unsigned v) { return __hip_atomic_fetch_add(p, v, __ATOMIC_RELAXED, __HIP_MEMORY_SCOPE_AGENT); }
__device__ __forceinline__ unsigned xb_xcc_id() { return (unsigned)__builtin_amdgcn_s_getreg((3 << 11) | 20) & 0xFu; }
#define XB_SPIN(cond, bar) do { unsigned _sp = 0; while (cond) { __builtin_amdgcn_s_sleep(1); \
    if ((++_sp & 255u) == 0u) { if (xb_ld(&(bar)[XB_TMO])) break; if (_sp > XB_SPIN_CAP) { atomicAdd(&(bar)[XB_TMO], 1u); break; } } } } while (0)
struct XcdBarrier { unsigned* bar; unsigned x; volatile LAS unsigned* st; };
__device__ __forceinline__ XcdBarrier xcd_barrier_post(unsigned* bar, volatile LAS unsigned* st) {
    XcdBarrier b; b.bar = bar; b.x = xb_xcc_id(); b.st = st;
    if (threadIdx.x == 0) (void)xb_add(&bar[XB_XCNT(b.x)], 1u);
    return b;
}
__device__ __forceinline__ void xcd_barrier_complete(unsigned* bar, unsigned x, unsigned& nloc, unsigned& nx) {
    const unsigned G = gridDim.x * gridDim.y * gridDim.z;
    unsigned sum, cnt, mine, sp = 0u;
    for (;;) {
        sum = 0u; cnt = 0u; mine = 0u;
#pragma unroll
        for (unsigned j = 0; j < 16; ++j) { const unsigned c = xb_ld(&bar[XB_XCNT(j)]); sum += c; cnt += (c > 0u) ? 1u : 0u; mine = (j == x) ? c : mine; }
        if (sum == G) break;
        __builtin_amdgcn_s_sleep(1);
        if ((++sp & 255u) == 0u) { if (xb_ld(&bar[XB_TMO])) break; if (sp > XB_SPIN_CAP) { atomicAdd(&bar[XB_TMO], 1u); break; } }
    }
    nloc = mine > 0u ? mine : 1u; nx = cnt > 0u ? cnt : 1u;
}
__device__ __forceinline__ void xcd_barrier(const XcdBarrier& b) {
    asm volatile("s_waitcnt vmcnt(0)" ::: "memory");
    __syncthreads();
    if (threadIdx.x == 0) {
        unsigned* bar = b.bar;
        __builtin_amdgcn_s_waitcnt(0);
        unsigned nloc = b.st[0], nx = b.st[1];
        if (nloc == 0u) { xcd_barrier_complete(bar, b.x, nloc, nx); b.st[0] = nloc; b.st[1] = nx; }
        const unsigned old = xb_add(&bar[XB_XSUB(b.x)], 1u);
        const unsigned gen = old / nloc;
        if (old + 1u == (gen + 1u) * nloc) {
            __builtin_amdgcn_fence(__ATOMIC_RELEASE, "agent");
            asm volatile("s_waitcnt vmcnt(0)" ::: "memory");
            const unsigned og = xb_add(&bar[XB_TOP], 1u);
            const unsigned tg = og / nx;
            if (og + 1u == (tg + 1u) * nx) xb_add(&bar[XB_TOPGEN], 1u);
            else XB_SPIN(xb_ld(&bar[XB_TOPGEN]) == tg, bar);
            __builtin_amdgcn_fence(__ATOMIC_ACQUIRE, "agent");
            xb_add(&bar[XB_XGEN(b.x)], 1u);
            asm volatile("s_waitcnt vmcnt(0)" ::: "memory");
        } else {
            XB_SPIN(xb_ld(&bar[XB_XGEN(b.x)]) == gen, bar);
            __builtin_amdgcn_fence(__ATOMIC_ACQUIRE, "agent");
            asm volatile("s_waitcnt vmcnt(0)" ::: "memory");
        }
    }
    __syncthreads();
}

struct Args { const float* in[32]; float* out; unsigned char* ws; int lo, hi; };
typedef const Args __attribute__((address_space(4))) KArgs;
enum { I_X = 0, I_NMG, I_WIN, I_MU, I_W0, I_W2, I_A0, I_A2, I_G2, I_V0, I_V1, I_V2, I_KK, I_KA, I_RK, I_LNW, I_LNB, I_WRB, I_CW, I_CB, I_DTB, I_ALOG, I_SD, I_SNG, I_WSB, I_WOUT, I_NFG, I_WQ, I_SK, I_PD, I_PU, I_NFIN };

struct NoTmp {};
struct FStoreBf16 { bf16* O; int ldc; typedef NoTmp Tmp; static constexpr int GRP = 16;
    __device__ __forceinline__ void load(int, int, int, Tmp&) const {}
    __device__ __forceinline__ void apply(int row, int col, f32x4 v0, f32x4 v1, int, const Tmp&) const {
        v4u w; w.x = pk2(v0[0], v0[1]); w.y = pk2(v0[2], v0[3]); w.z = pk2(v1[0], v1[1]); w.w = pk2(v1[2], v1[3]);
        *(v4u*)(O + (size_t)row * ldc + col) = w; } };
struct FSigmoidBf16 { bf16* O; int ldc; typedef NoTmp Tmp; static constexpr int GRP = 16;
    __device__ __forceinline__ void load(int, int, int, Tmp&) const {}
    __device__ __forceinline__ void apply(int row, int col, f32x4 v0, f32x4 v1, int, const Tmp&) const {
        v4u w; w.x = pk2(sigmoidf_(v0[0]), sigmoidf_(v0[1])); w.y = pk2(sigmoidf_(v0[2]), sigmoidf_(v0[3])); w.z = pk2(sigmoidf_(v1[0]), sigmoidf_(v1[1])); w.w = pk2(sigmoidf_(v1[2]), sigmoidf_(v1[3]));
        *(v4u*)(O + (size_t)row * ldc + col) = w; } };
struct EpiLora {
    static constexpr bool PERM = true;
    bf16 *elog, *asig, *gg, *vmix; const bf16* vf; const float *w0, *a0, *v0;
    template <int BLK> __device__ __forceinline__ void run(const f32x4 (&acc)[2][2][4][2], int row0, int col0) const {
#pragma unroll
        for (int bj = 0; bj < 2; ++bj) {
            const int c = (col0 + bj * 128) & 1023;
            float bias[8];
            if (BLK == 0 || BLK == 1 || BLK == 3) { const float* bp = (BLK == 0 ? w0 : (BLK == 1 ? a0 : v0)) + c; const f32x4 b0 = *(const f32x4*)bp, b1 = *(const f32x4*)(bp + 4);
                bias[0] = b0[0]; bias[1] = b0[1]; bias[2] = b0[2]; bias[3] = b0[3]; bias[4] = b1[0]; bias[5] = b1[1]; bias[6] = b1[2]; bias[7] = b1[3]; }
#pragma unroll
            for (int ai = 0; ai < 2; ++ai) {
            v4u qvs[4], qvf[4];
            if (BLK == 3) {
#pragma unroll
                for (int i = 0; i < 4; ++i) { const size_t o = (size_t)(row0 + ai * 128 + i * 16) * D + c; qvs[i] = *(const v4u*)(vmix + o); qvf[i] = *(const v4u*)(vf + o); }
            }
#pragma unroll
                for (int m = 0; m < 4; ++m) {
                    const int row = row0 + ai * 128 + m * 16; const size_t o = (size_t)row * D + c;
                    const f32x4 v0_ = acc[ai][bj][m][0], v1_ = acc[ai][bj][m][1];
                    float a[8] = {v0_[0], v0_[1], v0_[2], v0_[3], v1_[0], v1_[1], v1_[2], v1_[3]};
                    if (BLK == 0) {
#pragma unroll
                        for (int e = 0; e < 8; ++e) a[e] = -0.6065306597f * sigmoidf_(bias[e] + a[e]);
                        *(v4u*)(elog + o) = pack8(a);
                    } else if (BLK == 1) {
#pragma unroll
                        for (int e = 0; e < 8; ++e) a[e] = sigmoidf_(bias[e] + a[e]);
                        *(v4u*)(asig + o) = pack8(a);
                    } else if (BLK == 2) {
                        *(v4u*)(gg + o) = pack8(a);
                    } else {
                        float vs[8], vfv[8]; unpack8(qvs[m], vs); unpack8(qvf[m], vfv);
#pragma unroll
                        for (int e = 0; e < 8; ++e) a[e] = vs[e] + (vfv[e] - vs[e]) * sigmoidf_(bias[e] + a[e]);
                        *(v4u*)(vmix + o) = pack8(a);
                    }
                }
            }
        }
    }
    __device__ __forceinline__ void operator()(const f32x4 (&acc)[2][2][4][2], const pg8::Unit& u, int wr, int wc, int fr, int fq) const {
        const int row0 = u.pm * 256 + wr * 64 + fr, col0 = u.pn * 256 + wc * 32 + 8 * fq;
        const int blk = u.pn >> 2;
        if (blk == 0) run<0>(acc, row0, col0); else if (blk == 1) run<1>(acc, row0, col0); else if (blk == 2) run<2>(acc, row0, col0); else run<3>(acc, row0, col0);
    }
};
struct FMixA { const bf16* gates; bf16* mixed;
    struct Tmp { v4u g; }; static constexpr int GRP = 8;
    __device__ __forceinline__ void load(int row, int col, int, Tmp& t) const { t.g = *(const v4u*)(gates + (size_t)row * 2048 + col); }
    __device__ __forceinline__ void apply(int row, int col, f32x4 v0, f32x4 v1, int, const Tmp& t) const {
        float g[8]; unpack8(t.g, g);
        float a[8] = {v0[0] * g[0], v0[1] * g[1], v0[2] * g[2], v0[3] * g[3], v1[0] * g[4], v1[1] * g[5], v1[2] * g[6], v1[3] * g[7]};
        *(v4u*)(mixed + (size_t)row * D + col) = pack8(a); } };
struct FMixB { const bf16* gates; bf16* mixed;
    struct Tmp { v4u g, mx; }; static constexpr int GRP = 8;
    __device__ __forceinline__ void load(int row, int col, int, Tmp& t) const { t.g = *(const v4u*)(gates + (size_t)row * 2048 + 1024 + col); t.mx = *(const v4u*)(mixed + (size_t)row * D + col); }
    __device__ __forceinline__ void apply(int row, int col, f32x4 v0, f32x4 v1, int, const Tmp& t) const {
        float g[8], mx[8]; unpack8(t.g, g); unpack8(t.mx, mx);
        float a[8] = {mx[0] + v0[0] * g[0], mx[1] + v0[1] * g[1], mx[2] + v0[2] * g[2], mx[3] + v0[3] * g[3], mx[4] + v1[0] * g[4], mx[5] + v1[1] * g[5], mx[6] + v1[2] * g[6], mx[7] + v1[3] * g[7]};
        *(v4u*)(mixed + (size_t)row * D + col) = pack8(a); } };
struct FResid { const float* base; float* h;
    struct Tmp { f32x4 a, b; }; static constexpr int GRP = 8;
    __device__ __forceinline__ void load(int row, int col, int, Tmp& t) const { const f32x4* s = (const f32x4*)(base + (size_t)row * D + col); t.a = s[0]; t.b = s[1]; }
    __device__ __forceinline__ void apply(int row, int col, f32x4 v0, f32x4 v1, int, const Tmp& t) const {
        f32x4* p = (f32x4*)(h + (size_t)row * D + col); p[0] = t.a + v0; p[1] = t.b + v1; } };

struct Ctx { int tid, lane, wave, G, bid; LAS unsigned char* lds; };

__device__ __forceinline__ void transpose_item(const float* W, int K, int N, bf16* WT, int row_off, LAS float* scr, int item, int lane) {
    const int nblk = N / 32, kb = item / nblk, nb = item % nblk, k0 = 64 * kb, n0 = 32 * nb;
#pragma unroll 8
    for (int i = 0; i < 32; ++i) { const int kk = 2 * i + (lane >> 5); scr[kk * 33 + (lane & 31)] = W[(size_t)(k0 + kk) * N + n0 + (lane & 31)]; }
    asm volatile("s_waitcnt lgkmcnt(0)" ::: "memory");
    const int c = lane & 7;
#pragma unroll
    for (int j = 0; j < 4; ++j) { const int n = (lane >> 3) + 8 * j; const LAS float* s = scr + (8 * c) * 33 + n;
        v4u o; o.x = pk2(s[0 * 33], s[1 * 33]); o.y = pk2(s[2 * 33], s[3 * 33]); o.z = pk2(s[4 * 33], s[5 * 33]); o.w = pk2(s[6 * 33], s[7 * 33]);
        *(v4u*)(WT + (size_t)(row_off + n0 + n) * K + k0 + 8 * c) = o; }
    asm volatile("s_waitcnt lgkmcnt(0)" ::: "memory");
}
__device__ __forceinline__ int winrow(int n) {
    if (n < RW_PROJ) return n;
    if (n < RW_PROJ + 5120) return N1P + (n - RW_PROJ);
    if (n < RW_PROJ + SSD_PROJ) return DT_COL + (n - RW_PROJ - 5120);
    return N1P + N2P + (n - RW_PROJ - SSD_PROJ); }

__device__ __forceinline__ void phase_prologue(const Ctx& c, KArgs& a) {
    unsigned char* ws = a.ws;
    LAS float* scr = (LAS float*)(c.lds + c.wave * 16384);
    const int gw = c.bid * 8 + c.wave, NGW = c.G * 8;
    constexpr int I_IN = 16 * (IN_PROJ / 32), I_A = 16 * 32, I_B = 32 * 32, I_O = 16 * 32, I_L = I_IN + I_A + I_B + I_O;
    for (int it = gw; it < 2 * I_L; it += NGW) {
        const int l = it / I_L; int r = it % I_L;
        if (r < I_IN) { const int nb = r % (IN_PROJ / 32); transpose_item(a.in[I_WIN] + (size_t)l * D * IN_PROJ, D, IN_PROJ, (bf16*)(ws + WS_WIN + l * WIN_L), winrow(nb * 32) - nb * 32, scr, r, c.lane); continue; } r -= I_IN;
        if (r < I_A) { transpose_item(a.in[I_WRB] + (size_t)l * D * D, D, D, (bf16*)(ws + WS_WA) + (size_t)l * D * D, 0, scr, r, c.lane); continue; } r -= I_A;
        if (r < I_B) { transpose_item(a.in[I_WSB] + (size_t)l * 2048 * D, 2048, D, (bf16*)(ws + WS_WB) + (size_t)l * D * 2048, 0, scr, r, c.lane); continue; } r -= I_B;
        transpose_item(a.in[I_WOUT] + (size_t)l * D * D, D, D, (bf16*)(ws + WS_WO) + (size_t)l * D * D, 0, scr, r, c.lane);
    }
    for (int it = c.bid * 512 + c.tid; it < 2 * 192 * 128; it += c.G * 512) {
        const int l = it / (192 * 128), r = (it / 128) % 192, q = it % 128;
        *(v4u*)((bf16*)(ws + WS_WIN + l * WIN_L) + (size_t)(DT_COL + 32 + r) * D + q * 8) = (v4u){0u, 0u, 0u, 0u};
    }
    for (int it = c.bid * 512 + c.tid; it < 2 * 4096 * KL; it += c.G * 512) {
        const int l = it / (4096 * KL), n = (it / KL) % 4096, k = it % KL; const int blk = n >> 10, cc = n & 1023;
        float v = 0.f;
        if (blk == 0) { if (k < 64) v = a.in[I_W2][((size_t)l * 64 + k) * D + cc]; }
        else if (blk == 1) { if (k >= 64 && k < 128) v = a.in[I_A2][((size_t)l * 64 + (k - 64)) * D + cc]; }
        else if (blk == 2) { if (k >= 128 && k < 288) v = a.in[I_G2][((size_t)l * 160 + (k - 128)) * D + cc]; }
        else { if (l == 1 && k >= 288 && k < 320) v = a.in[I_V2][(size_t)(k - 288) * D + cc]; }
        ((bf16*)(ws + WS_WLORA + l * WLORA_L))[(size_t)n * KL + k] = (bf16)f2bf(v);
    }
    __syncthreads();
    LAS float* wqL = (LAS float*)c.lds;
    LAS float* kyL = (LAS float*)(c.lds + 32768);
    for (int it = c.bid; it < 2 * 16 * 16; it += c.G) {
        const int l = it >> 8, hc = (it >> 4) & 15, k0 = (it & 15) * 64;
        const float* wq = a.in[I_WQ] + (size_t)l * D * 2048; const float* ky = a.in[I_SK] + ((size_t)l * 16 + hc) * 128 * 128;
        for (int e = c.tid; e < 64 * 128; e += 512) wqL[e] = wq[(size_t)(k0 + (e >> 7)) * 2048 + hc * 128 + (e & 127)];
        for (int e = c.tid; e < 128 * 128; e += 512) kyL[(e >> 7) * 129 + (e & 127)] = ky[e];
        __syncthreads();
        const int key = c.tid & 127, kg = c.tid >> 7;
        float acc[16];
#pragma unroll
        for (int i = 0; i < 16; ++i) acc[i] = 0.f;
        for (int d = 0; d < 128; ++d) { const float kv = kyL[key * 129 + d];
#pragma unroll
            for (int i = 0; i < 16; ++i) acc[i] += wqL[(kg * 16 + i) * 128 + d] * kv; }
        bf16* o = (bf16*)(ws + WS_WQK) + ((size_t)l * 2048 + hc * 128 + key) * D + k0 + kg * 16;
        v4u q0, q1; q0.x = pk2(acc[0], acc[1]); q0.y = pk2(acc[2], acc[3]); q0.z = pk2(acc[4], acc[5]); q0.w = pk2(acc[6], acc[7]);
        q1.x = pk2(acc[8], acc[9]); q1.y = pk2(acc[10], acc[11]); q1.z = pk2(acc[12], acc[13]); q1.w = pk2(acc[14], acc[15]);
        *(v4u*)o = q0; *(v4u*)(o + 8) = q1;
        __syncthreads();
    }
}

__device__ __forceinline__ void phase_rmsnorm(const Ctx& c, const float* src, const float* g, bf16* U, float* copy_to) {
    const int gw = c.bid * 8 + c.wave, NGW = c.G * 8;
    f32x4 gv[4];
#pragma unroll
    for (int j = 0; j < 4; ++j) gv[j] = *((const f32x4*)g + c.lane + 64 * j);
    f32x4 nv[4];
    if (gw < M) { const f32x4* xr0 = (const f32x4*)(src + (size_t)gw * D) + c.lane;
#pragma unroll
        for (int j = 0; j < 4; ++j) nv[j] = xr0[64 * j]; }
    for (int m = gw; m < M; m += NGW) {
        f32x4 v[4]; float s = 0.f;
#pragma unroll
        for (int j = 0; j < 4; ++j) { v[j] = nv[j]; s += (v[j].x * v[j].x + v[j].y * v[j].y) + (v[j].z * v[j].z + v[j].w * v[j].w); }
        if (m + NGW < M) { const f32x4* xn = (const f32x4*)(src + (size_t)(m + NGW) * D) + c.lane;
#pragma unroll
            for (int j = 0; j < 4; ++j) nv[j] = xn[64 * j]; }
        if (copy_to) { f32x4* cr = (f32x4*)(copy_to + (size_t)m * D) + c.lane;
#pragma unroll
            for (int j = 0; j < 4; ++j) cr[64 * j] = v[j]; }
        const float r = rsqrtf(sum64(s) * (1.f / D) + 1e-6f);
        v2u* o = (v2u*)(U + (size_t)m * D) + c.lane;
#pragma unroll
        for (int j = 0; j < 4; ++j) { v2u w; w.x = pk2(v[j].x * r * gv[j].x, v[j].y * r * gv[j].y); w.y = pk2(v[j].z * r * gv[j].z, v[j].w * r * gv[j].w); o[64 * j] = w; }
    }
}
__device__ __forceinline__ void phase_rmsnorm_q8(const Ctx& c, const float* src, const float* g, bf16* U, unsigned char* U8, float* XS) {
    const int gw = c.bid * 8 + c.wave, NGW = c.G * 8;
    f32x4 gv[4];
#pragma unroll
    for (int j = 0; j < 4; ++j) gv[j] = *((const f32x4*)g + c.lane + 64 * j);
    f32x4 nv[4];
    if (gw < M) { const f32x4* xr0 = (const f32x4*)(src + (size_t)gw * D) + c.lane;
#pragma unroll
        for (int j = 0; j < 4; ++j) nv[j] = xr0[64 * j]; }
    for (int m = gw; m < M; m += NGW) {
        f32x4 v[4]; float s = 0.f;
#pragma unroll
        for (int j = 0; j < 4; ++j) { v[j] = nv[j]; s += (v[j].x * v[j].x + v[j].y * v[j].y) + (v[j].z * v[j].z + v[j].w * v[j].w); }
        if (m + NGW < M) { const f32x4* xn = (const f32x4*)(src + (size_t)(m + NGW) * D) + c.lane;
#pragma unroll
            for (int j = 0; j < 4; ++j) nv[j] = xn[64 * j]; }
        const float r = rsqrtf(sum64(s) * (1.f / D) + 1e-6f);
        float am = 0.f;
#pragma unroll
        for (int j = 0; j < 4; ++j) { v[j] = v[j] * r * gv[j]; am = fmaxf(am, fmaxf(fmaxf(fabsf(v[j].x), fabsf(v[j].y)), fmaxf(fabsf(v[j].z), fabsf(v[j].w)))); }
#pragma unroll
        for (int o = 1; o < 64; o <<= 1) am = fmaxf(am, __shfl_xor(am, o));
        am = fmaxf(am, 1e-30f);
        const float qs = 384.f / am;
        v2u* o = (v2u*)(U + (size_t)m * D) + c.lane;
        unsigned* o8 = (unsigned*)(U8 + (size_t)m * D) + c.lane;
#pragma unroll
        for (int j = 0; j < 4; ++j) { v2u w; w.x = pk2(v[j].x, v[j].y); w.y = pk2(v[j].z, v[j].w); o[64 * j] = w;
            int w8 = __builtin_amdgcn_cvt_pk_fp8_f32(v[j].x * qs, v[j].y * qs, 0, false); w8 = __builtin_amdgcn_cvt_pk_fp8_f32(v[j].z * qs, v[j].w * qs, w8, true); o8[64 * j] = (unsigned)w8; }
        if (c.lane == 0) XS[m] = am * (1.f / 384.f);
    }
}
__device__ __forceinline__ void phase_final(const Ctx& c, float* out, const float* g) {
    const int gw = c.bid * 8 + c.wave, NGW = c.G * 8;
    f32x4 gv[4];
#pragma unroll
    for (int j = 0; j < 4; ++j) gv[j] = *((const f32x4*)g + c.lane + 64 * j);
    for (int m = gw; m < M; m += NGW) {
        f32x4* xr = (f32x4*)(out + (size_t)m * D) + c.lane;
        f32x4 v[4]; float s = 0.f;
#pragma unroll
        for (int j = 0; j < 4; ++j) { v[j] = xr[64 * j]; s += (v[j].x * v[j].x + v[j].y * v[j].y) + (v[j].z * v[j].z + v[j].w * v[j].w); }
        const float r = rsqrtf(sum64(s) * (1.f / D) + 1e-6f);
#pragma unroll
        for (int j = 0; j < 4; ++j) xr[64 * j] = v[j] * r * gv[j];
    }
}

__device__ __forceinline__ void phase_rwkv_prep(const Ctx& c, KArgs& a, int l, int hb) {
    unsigned char* ws = a.ws;
    const bf16* PR = (const bf16*)(ws + WS_OV + OV_PR);
    bf16* AL = (bf16*)(ws + WS_OV + OV_AL);
    bf16* VS = l == 0 ? (bf16*)(ws + WS_VF) + (size_t)hb * MH * D : (bf16*)(ws + WS_OV + OV_VMIX);
    const float* mu = a.in[I_MU] + (size_t)l * RW_PROJ;
    LAS bf16* v1L = (LAS bf16*)c.lds;
    if (l == 1) {
        const float* v1 = a.in[I_V1];
        for (int e = c.tid; e < 1024 * 32; e += 512) { const int cc = e >> 5, j = e & 31; v1L[((cc & 15) * 64 + (cc >> 4)) * 40 + j] = (bf16)f2bf(v1[e]); }
        __syncthreads();
    }
    const int gw = c.bid * 8 + c.wave, NGW = c.G * 8, lane = c.lane;
    float muv[16], mul[8];
#pragma unroll
    for (int e = 0; e < 16; ++e) muv[e] = mu[2048 + 16 * lane + e];
#pragma unroll
    for (int e = 0; e < 8; ++e) mul[e] = lane < 36 ? mu[3072 + 8 * lane + e] : 0.f;
    const int per = (MH + NGW - 1) / NGW;
    const int mA = gw * per, mB = (mA + per < MH) ? mA + per : MH;
    v4u cq0, cq1, cql, pq0, pq1, pql;
    const v4u zz4 = (v4u){0u, 0u, 0u, 0u};
    const int lcol = lane < 36 ? 3072 + 8 * lane : 3072;
    if (mA < mB) {
        const bf16* row = PR + (size_t)mA * N1P;
        cq0 = *(const v4u*)(row + 2048 + 16 * lane); cq1 = *(const v4u*)(row + 2048 + 16 * lane + 8); cql = *(const v4u*)(row + lcol);
        if ((mA & (T - 1)) != 0) { pq0 = *(const v4u*)(row - N1P + 2048 + 16 * lane); pq1 = *(const v4u*)(row - N1P + 2048 + 16 * lane + 8); pql = *(const v4u*)(row - N1P + lcol); }
        else { pq0 = zz4; pq1 = zz4; pql = zz4; }
    }
    for (int m = mA; m < mB; ++m) {
        const v4u q0 = cq0, q1 = cq1, ql = cql;
        v4u r0 = pq0, r1 = pq1, rl = pql;
        if ((m & (T - 1)) == 0) { r0 = zz4; r1 = zz4; rl = zz4; }
        if (m + 1 < mB) { const bf16* nrow = PR + (size_t)(m + 1) * N1P; cq0 = *(const v4u*)(nrow + 2048 + 16 * lane); cq1 = *(const v4u*)(nrow + 2048 + 16 * lane + 8); cql = *(const v4u*)(nrow + lcol); }
        pq0 = q0; pq1 = q1; pql = ql;
        float vs[16];
        {
            float p[16], pp[16];
            float t8[8];
            unpack8(q0, t8);
#pragma unroll
            for (int e = 0; e < 8; ++e) p[e] = t8[e];
            unpack8(q1, t8);
#pragma unroll
            for (int e = 0; e < 8; ++e) p[8 + e] = t8[e];
            unpack8(r0, t8);
#pragma unroll
            for (int e = 0; e < 8; ++e) pp[e] = t8[e];
            unpack8(r1, t8);
#pragma unroll
            for (int e = 0; e < 8; ++e) pp[8 + e] = t8[e];
#pragma unroll
            for (int e = 0; e < 16; ++e) vs[e] = p[e] + (pp[e] - p[e]) * muv[e];
            v4u o0, o1;
            o0.x = pk2(vs[0], vs[1]); o0.y = pk2(vs[2], vs[3]); o0.z = pk2(vs[4], vs[5]); o0.w = pk2(vs[6], vs[7]);
            o1.x = pk2(vs[8], vs[9]); o1.y = pk2(vs[10], vs[11]); o1.z = pk2(vs[12], vs[13]); o1.w = pk2(vs[14], vs[15]);
            *(v4u*)(VS + (size_t)m * D + 16 * lane) = o0; *(v4u*)(VS + (size_t)m * D + 16 * lane + 8) = o1;
        }
        if (lane < 36) {
            float p[8], pp[8], s[8];
            unpack8(ql, p);
            unpack8(rl, pp);
#pragma unroll
            for (int e = 0; e < 8; ++e) { const float x = p[e] + (pp[e] - p[e]) * mul[e]; s[e] = lane < 8 ? tanhf(x) : (lane < 16 ? x : sigmoidf_(x)); }
            *(v4u*)(AL + (size_t)m * KL + 8 * lane) = pack8(s);
        } else if (lane < 48 && !(l == 1 && lane < 40)) {
            *(v4u*)(AL + (size_t)m * KL + 8 * lane) = (v4u){0u, 0u, 0u, 0u};
        }
        if (l == 1) {
            float acc[32];
#pragma unroll
            for (int j = 0; j < 32; ++j) acc[j] = 0.f;
#pragma unroll
            for (int i = 0; i < 16; ++i) {
                const LAS v4u* wp = (const LAS v4u*)(v1L + (i * 64 + lane) * 40);
#pragma unroll
                for (int q = 0; q < 4; ++q) { float w8[8]; const v4u wq_ = wp[q]; unpack8(wq_, w8);
#pragma unroll
                    for (int e = 0; e < 8; ++e) acc[q * 8 + e] += vs[i] * w8[e]; }
            }
#pragma unroll
            for (int s = 32, half = 16; s >= 2; s >>= 1, half >>= 1) {
                const bool up = (lane & s) != 0;
#pragma unroll
                for (int i = 0; i < 16; ++i) if (i < half) { const float send = up ? acc[i] : acc[i + half]; const float keep = up ? acc[i + half] : acc[i]; acc[i] = keep + __shfl_xor(send, s); }
            }
            acc[0] += __shfl_xor(acc[0], 1);
            const int j = ((lane & 32) ? 16 : 0) + ((lane & 16) ? 8 : 0) + ((lane & 8) ? 4 : 0) + ((lane & 4) ? 2 : 0) + ((lane & 2) ? 1 : 0);
            if ((lane & 1) == 0) AL[(size_t)m * KL + 288 + j] = (bf16)f2bf(acc[0]);
        }
    }
    { float* DT = (float*)(ws + WS_OV + OV_DT); float* DA = (float*)(ws + WS_OV + OV_DA);
      for (int it = gw; it < (MH / 64) * 32; it += NGW) {
        const int ck = it >> 5, h = it & 31;
        const size_t m = (size_t)ck * 64 + lane;
        const float x = bf1(PR[m * N1P + DT_COL + h]) + a.in[I_DTB][l * 32 + h];
        const float dt = x > 20.f ? x : log1pf(__expf(x));
        float cs = -dt * __expf(a.in[I_ALOG][l * 32 + h]);
#pragma unroll
        for (int o = 1; o < 64; o <<= 1) { const float y = __shfl_up(cs, o); cs += (lane >= o) ? y : 0.f; }
        DT[m * 32 + h] = dt; DA[m * 32 + h] = cs;
      } }
}

__device__ __forceinline__ float sum8(float x) { x += dpp_mov<0xB1>(x); x += dpp_mov<0x4E>(x); x += dpp_mov<0x141>(x); return x; }
__device__ __forceinline__ void phase_rwkv_rec(const Ctx& c, KArgs& a, int l, int hb) {
    unsigned char* ws = a.ws;
    const bf16* PR = (const bf16*)(ws + WS_OV + OV_PR);
    const bf16* ELOG = (const bf16*)(ws + WS_OV + OV_ELOG);
    const bf16* ASIG = (const bf16*)(ws + WS_OV + OV_ASIG);
    const bf16* VS = l == 0 ? (const bf16*)(ws + WS_VF) + (size_t)hb * MH * D : (const bf16*)(ws + WS_OV + OV_VMIX);
    bf16* Y = (bf16*)(ws + WS_OV + OV_YA);
    const float* mu = a.in[I_MU] + (size_t)l * RW_PROJ;
    const float* k_k = a.in[I_KK] + (size_t)l * D; const float* k_a = a.in[I_KA] + (size_t)l * D;
    constexpr int CH = 32, NCH = T / CH;
    constexpr int ARRF = CH * 64;
    constexpr int BUFF = 5 * ARRF + CH * 16 + CH * 2;
    LAS float* ldsf = (LAS float*)c.lds;
    LAS float* yt = ldsf + 2 * BUFF;
    const int tid = c.tid, lane = c.lane;
    const bool is_prep = c.wave >= 4;
    const int ptid = tid - 256, tt = ptid >> 3, l8 = ptid & 7, pc = l8 * 8;
    const int rrow = c.wave * 4 + (lane >> 4), cc4 = (lane & 15) * 4;
    for (int unit = c.bid; unit < 256; unit += c.G) {
        const int b = unit >> 6, h = (unit >> 2) & 15, rq = unit & 3;
        const size_t m0 = (size_t)b * T;
        const int hc = h * 64 + pc;
        float mur[8], muk[8], kkc[8], kac[8];
        if (is_prep) {
#pragma unroll
            for (int e = 0; e < 8; ++e) { mur[e] = mu[hc + e]; muk[e] = mu[1024 + hc + e]; kkc[e] = k_k[hc + e]; kac[e] = k_a[hc + e]; }
        }
        float S[4] = {0.f, 0.f, 0.f, 0.f}, sa = 0.f;
#define RW_PREP(chunk, bufp) do { \
            const int t_ = (chunk) * CH + tt; const size_t mm = m0 + t_; const bf16* row = PR + mm * N1P + hc; \
            const v4u zr = (v4u){0u, 0u, 0u, 0u}; \
            const v4u qr = *(const v4u*)row, qk = *(const v4u*)(row + 1024); \
            const v4u qrp = t_ > 0 ? *(const v4u*)(row - N1P) : zr, qkp = t_ > 0 ? *(const v4u*)(row - N1P + 1024) : zr; \
            const v4u qkn = t_ + 1 < T ? *(const v4u*)(row + N1P + 1024) : zr; \
            const v4u qas = *(const v4u*)(ASIG + mm * D + hc), qel = *(const v4u*)(ELOG + mm * D + hc); \
            v4u qv = zr; if (l8 < 2) qv = *(const v4u*)(VS + mm * D + h * 64 + rq * 16 + l8 * 8); \
            float r_[8], rp_[8], k_[8], kp_[8], kn_[8], as_[8], el_[8]; \
            unpack8(qr, r_); unpack8(qrp, rp_); unpack8(qk, k_); unpack8(qkp, kp_); unpack8(qkn, kn_); unpack8(qas, as_); unpack8(qel, el_); \
            float ks_[8], kk_[8], kkn_[8], s1 = 0.f, s2 = 0.f; \
            _Pragma("unroll") for (int e = 0; e < 8; ++e) { ks_[e] = k_[e] + (kp_[e] - k_[e]) * muk[e]; const float kn1 = kn_[e] + (k_[e] - kn_[e]) * muk[e]; \
                kk_[e] = ks_[e] * kkc[e]; kkn_[e] = kn1 * kkc[e]; s1 += kk_[e] * kk_[e]; s2 += kkn_[e] * kkn_[e]; } \
            s1 = sum8(s1); s2 = sum8(s2); \
            const float i1 = rsqrtf(s1 + 1e-12f), i2 = (t_ + 1 < T) ? rsqrtf(s2 + 1e-12f) : 0.f; \
            float ow[8], ok[8], ob[8], orr[8], owa[8], c1 = 0.f, c2 = 0.f; \
            _Pragma("unroll") for (int e = 0; e < 8; ++e) { const float kn = kk_[e] * i1, an = -kkn_[e] * i2; \
                ow[e] = __expf(el_[e]); ok[e] = ks_[e] * (1.f + (as_[e] - 1.f) * kac[e]); ob[e] = kn * as_[e]; orr[e] = r_[e] + (rp_[e] - r_[e]) * mur[e]; \
                owa[e] = ow[e] * an; c1 += ob[e] * an; c2 += ok[e] * an; } \
            c1 = sum8(c1); c2 = sum8(c2); \
            LAS float* bp_ = (bufp) + tt * 64 + pc; \
            *(LAS f32x4*)(bp_) = (f32x4){ow[0], ow[1], ow[2], ow[3]}; *(LAS f32x4*)(bp_ + 4) = (f32x4){ow[4], ow[5], ow[6], ow[7]}; \
            *(LAS f32x4*)(bp_ + ARRF) = (f32x4){ok[0], ok[1], ok[2], ok[3]}; *(LAS f32x4*)(bp_ + ARRF + 4) = (f32x4){ok[4], ok[5], ok[6], ok[7]}; \
            *(LAS f32x4*)(bp_ + 2 * ARRF) = (f32x4){ob[0], ob[1], ob[2], ob[3]}; *(LAS f32x4*)(bp_ + 2 * ARRF + 4) = (f32x4){ob[4], ob[5], ob[6], ob[7]}; \
            *(LAS f32x4*)(bp_ + 3 * ARRF) = (f32x4){orr[0], orr[1], orr[2], orr[3]}; *(LAS f32x4*)(bp_ + 3 * ARRF + 4) = (f32x4){orr[4], orr[5], orr[6], orr[7]}; \
            *(LAS f32x4*)(bp_ + 4 * ARRF) = (f32x4){owa[0], owa[1], owa[2], owa[3]}; *(LAS f32x4*)(bp_ + 4 * ARRF + 4) = (f32x4){owa[4], owa[5], owa[6], owa[7]}; \
            if (l8 < 2) { float v_[8]; unpack8(qv, v_); LAS float* vp_ = (bufp) + 5 * ARRF + tt * 16 + l8 * 8; \
                *(LAS f32x4*)vp_ = (f32x4){v_[0], v_[1], v_[2], v_[3]}; *(LAS f32x4*)(vp_ + 4) = (f32x4){v_[4], v_[5], v_[6], v_[7]}; } \
            if (l8 == 0) { (bufp)[5 * ARRF + CH * 16 + tt * 2] = c1; (bufp)[5 * ARRF + CH * 16 + tt * 2 + 1] = c2; } } while (0)
#define RW_YSTORE(chunk) do { const LAS float* yp_ = yt + ((chunk) & 1) * CH * 16 + tt * 16 + l8 * 2; \
            *(unsigned*)(Y + (m0 + (size_t)(chunk) * CH + tt) * D + h * 64 + rq * 16 + l8 * 2) = pk2(yp_[0], yp_[1]); } while (0)
        if (is_prep) RW_PREP(0, ldsf);
        __syncthreads();
        for (int ch = 0; ch < NCH; ++ch) {
            if (is_prep) {
                if (ch + 1 < NCH) RW_PREP(ch + 1, ldsf + ((ch + 1) & 1) * BUFF);
                if (ch > 0) RW_YSTORE(ch - 1);
            } else {
                const LAS float* buf = ldsf + (ch & 1) * BUFF;
                LAS float* yw = yt + (ch & 1) * CH * 16;
                const int lane15 = lane & 15;
                f32x4 w4 = *(const LAS f32x4*)(buf + cc4), k4 = *(const LAS f32x4*)(buf + ARRF + cc4), b4 = *(const LAS f32x4*)(buf + 2 * ARRF + cc4);
                f32x4 r4 = *(const LAS f32x4*)(buf + 3 * ARRF + cc4), wa4 = *(const LAS f32x4*)(buf + 4 * ARRF + cc4);
                float v = buf[5 * ARRF + rrow]; f32x2 cc = *(const LAS f32x2*)(buf + 5 * ARRF + CH * 16);
#pragma unroll 1
                for (int t16 = 0; t16 < CH; t16 += 16) {
                    float ysave = 0.f;
#pragma unroll
                    for (int u = 0; u < 16; ++u) {
                        const int tn = (t16 + u + 1 < CH) ? t16 + u + 1 : t16 + u;
                        const f32x4 nw4 = *(const LAS f32x4*)(buf + tn * 64 + cc4), nk4 = *(const LAS f32x4*)(buf + ARRF + tn * 64 + cc4), nb4 = *(const LAS f32x4*)(buf + 2 * ARRF + tn * 64 + cc4);
                        const f32x4 nr4 = *(const LAS f32x4*)(buf + 3 * ARRF + tn * 64 + cc4), nwa4 = *(const LAS f32x4*)(buf + 4 * ARRF + tn * 64 + cc4);
                        const float nv = buf[5 * ARRF + tn * 16 + rrow]; const f32x2 ncc = *(const LAS f32x2*)(buf + 5 * ARRF + CH * 16 + tn * 2);
                        float d = S[0] * wa4[0]; d = __builtin_fmaf(S[1], wa4[1], d); d = __builtin_fmaf(S[2], wa4[2], d); d = __builtin_fmaf(S[3], wa4[3], d);
#pragma unroll
                        for (int e = 0; e < 4; ++e) { float tmp = S[e] * w4[e]; asm volatile("" : "+v"(tmp)); tmp = __builtin_fmaf(v, k4[e], tmp); S[e] = __builtin_fmaf(sa, b4[e], tmp); asm volatile("" : "+v"(S[e])); }
                        const float sa_next = __builtin_fmaf(v, cc.y, sa * cc.x);
                        float y = S[0] * r4[0]; y = __builtin_fmaf(S[1], r4[1], y); y = __builtin_fmaf(S[2], r4[2], y); y = __builtin_fmaf(S[3], r4[3], y);
                        d = sum16(d); y = sum16(y);
                        sa = d + sa_next;
                        ysave = (lane15 == u) ? y : ysave;
                        w4 = nw4; k4 = nk4; b4 = nb4; r4 = nr4; wa4 = nwa4; v = nv; cc = ncc;
                    }
                    yw[(t16 + lane15) * 16 + rrow] = ysave;
                }
            }
            __syncthreads();
        }
        if (is_prep) RW_YSTORE(NCH - 1);
        __syncthreads();
#undef RW_PREP
#undef RW_YSTORE
    }
}

constexpr int CK_TS = 72, CK_TB = 64 * CK_TS;
__device__ __forceinline__ void tr_a2(unsigned a, bf16x8& f0, bf16x8& f1) {
    s16x4 l0, h0, l1, h1;
    asm volatile("ds_read_b64_tr_b16 %0, %4\n\tds_read_b64_tr_b16 %1, %4 offset:576\n\tds_read_b64_tr_b16 %2, %4 offset:4608\n\tds_read_b64_tr_b16 %3, %4 offset:5184\n\ts_waitcnt lgkmcnt(0)"
                 : "=&v"(l0), "=&v"(h0), "=&v"(l1), "=&v"(h1) : "v"(a) : "memory");
    f0 = __builtin_shufflevector(l0, h0, 0, 1, 2, 3, 4, 5, 6, 7); f1 = __builtin_shufflevector(l1, h1, 0, 1, 2, 3, 4, 5, 6, 7);
}
__device__ __forceinline__ void tr_b4(unsigned a, bf16x8& f00, bf16x8& f01, bf16x8& f10, bf16x8& f11) {
    s16x4 l0, h0, l1, h1, l2, h2, l3, h3;
    asm volatile("ds_read_b64_tr_b16 %0, %8\n\tds_read_b64_tr_b16 %1, %8 offset:576\n\tds_read_b64_tr_b16 %2, %8 offset:4608\n\tds_read_b64_tr_b16 %3, %8 offset:5184\n\t"
                 "ds_read_b64_tr_b16 %4, %8 offset:32\n\tds_read_b64_tr_b16 %5, %8 offset:608\n\tds_read_b64_tr_b16 %6, %8 offset:4640\n\tds_read_b64_tr_b16 %7, %8 offset:5216\n\ts_waitcnt lgkmcnt(0)"
                 : "=&v"(l0), "=&v"(h0), "=&v"(l1), "=&v"(h1), "=&v"(l2), "=&v"(h2), "=&v"(l3), "=&v"(h3) : "v"(a) : "memory");
    f00 = __builtin_shufflevector(l0, h0, 0, 1, 2, 3, 4, 5, 6, 7); f01 = __builtin_shufflevector(l1, h1, 0, 1, 2, 3, 4, 5, 6, 7);
    f10 = __builtin_shufflevector(l2, h2, 0, 1, 2, 3, 4, 5, 6, 7); f11 = __builtin_shufflevector(l3, h3, 0, 1, 2, 3, 4, 5, 6, 7);
}
template <int PA, int QA, int MASK, int NINIT, int NPAIR, int POST>
__device__ __forceinline__ void mm64(LAS bf16* X, const LAS bf16* P, const LAS bf16* Q, const LAS bf16* P2, const LAS bf16* Q2, const LAS bf16* E1, const LAS bf16* E2,
                                     const LAS float* cscale, const LAS float* wc, int w, int lane) {
    const int r = lane & 15, q = lane >> 4, Ct = w >> 1, Rt0 = 2 * (w & 1);
    const int i16 = lane & 15, qq = i16 >> 2, p4 = i16 & 3;
    const int troff = ((8 * q + qq) * CK_TS + 4 * p4) * 2;
    f32x4 acc[2];
#pragma unroll
    for (int i = 0; i < 2; ++i) {
        const int R = 16 * (Rt0 + i) + r;
        if (NINIT == 0) acc[i] = (f32x4){0.f, 0.f, 0.f, 0.f};
        else { const v2u e1 = *(const LAS v2u*)(E1 + R * CK_TS + 16 * Ct + 4 * q); acc[i] = (f32x4){bflo(e1.x), bfhi(e1.x), bflo(e1.y), bfhi(e1.y)};
            if (NINIT == 2) { const v2u e2 = *(const LAS v2u*)(E2 + R * CK_TS + 16 * Ct + 4 * q); acc[i] += (f32x4){bflo(e2.x), bfhi(e2.x), bflo(e2.y), bfhi(e2.y)}; } }
    }
#pragma unroll
    for (int pr = 0; pr < NPAIR; ++pr) {
        const LAS bf16* Pp = pr == 0 ? P : P2; const LAS bf16* Qp = pr == 0 ? Q : Q2;
        bf16x8 af[2], bfr[2][2];
        if (PA == 0) {
#pragma unroll
            for (int i = 0; i < 2; ++i)
#pragma unroll
                for (int ks = 0; ks < 2; ++ks) bfr[i][ks] = *(const LAS bf16x8*)(Pp + (16 * (Rt0 + i) + r) * CK_TS + 32 * ks + 8 * q);
        }
        if (QA == 1) {
#pragma unroll
            for (int ks = 0; ks < 2; ++ks) af[ks] = *(const LAS bf16x8*)(Qp + (16 * Ct + r) * CK_TS + 32 * ks + 8 * q);
        } else tr_a2((unsigned)(size_t)Qp + (unsigned)(troff + 32 * Ct), af[0], af[1]);
        if (PA == 1) tr_b4((unsigned)(size_t)Pp + (unsigned)(troff + 32 * Rt0), bfr[0][0], bfr[0][1], bfr[1][0], bfr[1][1]);
#pragma unroll
        for (int ks = 0; ks < 2; ++ks)
#pragma unroll
            for (int i = 0; i < 2; ++i) acc[i] = __builtin_amdgcn_mfma_f32_16x16x32_bf16(af[ks], bfr[i][ks], acc[i], 0, 0, 0);
    }
#pragma unroll
    for (int i = 0; i < 2; ++i) {
        const int R = 16 * (Rt0 + i) + r;
        float v[4];
#pragma unroll
        for (int e = 0; e < 4; ++e) { const int C = 16 * Ct + 4 * q + e; float x = acc[i][e];
            if (MASK == 1) x = (C < R) ? x : 0.f;
            if (MASK == 2) x = (C <= R) ? x : 0.f;
            if (POST >= 1) x *= cscale[C];
            if (POST == 2) x += (C == R) ? wc[C] : 0.f;
            v[e] = x; }
        v2u o; o.x = pk2c(v[0], v[1]); o.y = pk2c(v[2], v[3]);
        *(LAS v2u*)(X + R * CK_TS + 16 * Ct + 4 * q) = o;
    }
}

template <int PA, int QA, int MASK, int NINIT, int NPAIR, int POST>
__device__ __forceinline__ void mm64h(LAS bf16* X, const LAS bf16* P, const LAS bf16* Q, const LAS bf16* P2, const LAS bf16* Q2, const LAS bf16* E1, const LAS bf16* E2,
                                      const LAS float* cscale, const LAS float* wc, int ws, int lane) {
    const int r = lane & 15, q = lane >> 4, Cb = ws >> 1, Rb = ws & 1;
    const int i16 = lane & 15, qq = i16 >> 2, p4 = i16 & 3;
    const int troff = ((8 * q + qq) * CK_TS + 4 * p4) * 2;
    f32x4 acc[2][2];
#pragma unroll
    for (int ci = 0; ci < 2; ++ci)
#pragma unroll
        for (int ri = 0; ri < 2; ++ri) {
            const int R = 16 * (2 * Rb + ri) + r, C0 = 16 * (2 * Cb + ci) + 4 * q;
            if (NINIT == 0) acc[ci][ri] = (f32x4){0.f, 0.f, 0.f, 0.f};
            else { const v2u e1 = *(const LAS v2u*)(E1 + R * CK_TS + C0); acc[ci][ri] = (f32x4){bflo(e1.x), bfhi(e1.x), bflo(e1.y), bfhi(e1.y)};
                if (NINIT == 2) { const v2u e2 = *(const LAS v2u*)(E2 + R * CK_TS + C0); acc[ci][ri] += (f32x4){bflo(e2.x), bfhi(e2.x), bflo(e2.y), bfhi(e2.y)}; } }
        }
#pragma unroll
    for (int pr = 0; pr < NPAIR; ++pr) {
        const LAS bf16* Pp = pr == 0 ? P : P2; const LAS bf16* Qp = pr == 0 ? Q : Q2;
        bf16x8 af[2][2], bfr[2][2];
        if (PA == 0) {
#pragma unroll
            for (int ri = 0; ri < 2; ++ri)
#pragma unroll
                for (int ks = 0; ks < 2; ++ks) bfr[ri][ks] = *(const LAS bf16x8*)(Pp + (16 * (2 * Rb + ri) + r) * CK_TS + 32 * ks + 8 * q);
        }
        if (QA == 1) {
#pragma unroll
            for (int ci = 0; ci < 2; ++ci)
#pragma unroll
                for (int ks = 0; ks < 2; ++ks) af[ci][ks] = *(const LAS bf16x8*)(Qp + (16 * (2 * Cb + ci) + r) * CK_TS + 32 * ks + 8 * q);
        } else tr_b4((unsigned)(size_t)Qp + (unsigned)(troff + 64 * Cb), af[0][0], af[0][1], af[1][0], af[1][1]);
        if (PA == 1) tr_b4((unsigned)(size_t)Pp + (unsigned)(troff + 64 * Rb), bfr[0][0], bfr[0][1], bfr[1][0], bfr[1][1]);
#pragma unroll
        for (int ks = 0; ks < 2; ++ks)
#pragma unroll
            for (int ci = 0; ci < 2; ++ci)
#pragma unroll
                for (int ri = 0; ri < 2; ++ri) acc[ci][ri] = __builtin_amdgcn_mfma_f32_16x16x32_bf16(af[ci][ks], bfr[ri][ks], acc[ci][ri], 0, 0, 0);
    }
#pragma unroll
    for (int ci = 0; ci < 2; ++ci)
#pragma unroll
        for (int ri = 0; ri < 2; ++ri) {
            const int R = 16 * (2 * Rb + ri) + r;
            float v[4];
#pragma unroll
            for (int e = 0; e < 4; ++e) { const int C = 16 * (2 * Cb + ci) + 4 * q + e; float x = acc[ci][ri][e];
                if (MASK == 1) x = (C < R) ? x : 0.f;
                if (MASK == 2) x = (C <= R) ? x : 0.f;
                if (POST >= 1) x *= cscale[C];
                if (POST == 2) x += (C == R) ? wc[C] : 0.f;
                v[e] = x; }
            v2u o; o.x = pk2c(v[0], v[1]); o.y = pk2c(v[2], v[3]);
            *(LAS v2u*)(X + R * CK_TS + 16 * (2 * Cb + ci) + 4 * q) = o;
        }
}

__device__ __forceinline__ void phase_rwkv_chunk_par(const Ctx& c, KArgs& a, int l, int hb) {
    unsigned char* ws = a.ws;
    bf16* PR = (bf16*)(ws + WS_OV + OV_PR);
    bf16* ELOG = (bf16*)(ws + WS_OV + OV_ELOG);
    const bf16* ASIG = (const bf16*)(ws + WS_OV + OV_ASIG);
    const bf16* VS = l == 0 ? (const bf16*)(ws + WS_VF) + (size_t)hb * MH * D : (const bf16*)(ws + WS_OV + OV_VMIX);
    bf16* Y = (bf16*)(ws + WS_OV + OV_YA);
    bf16* SLB = (bf16*)(ws + WS_OV + OV_AL);
    const float* mu = a.in[I_MU] + (size_t)l * RW_PROJ;
    const float* k_k = a.in[I_KK] + (size_t)l * D; const float* k_a = a.in[I_KA] + (size_t)l * D; const float* rk_ = a.in[I_RK] + (size_t)l * D;
    float* BON = (float*)(ws + WS_OV + OV_BON);
    LAS bf16* tile = (LAS bf16*)c.lds;
    enum { tA = 0, tR, tBt, tKt, tBh, tKh, tV, tNab, tNak, tNrb, tNrk, tM0, tM1, tP1, tX1, NT };
#define TL(i) (tile + (i) * CK_TB)
    LAS float* cscale = (LAS float*)(tile + NT * CK_TB);
    LAS float* wcv = cscale + 64;
    LAS float* SCR = (LAS float*)TL(tM0);
    LAS float* SEGT = SCR + 64 * 64;
    const int tid = c.tid, lane = c.lane, w = c.wave;
    const int tt = tid >> 3, l8 = tid & 7, pc = l8 * 8;
    v4u qr, qk, qrp, qkp, qas, qel, qv;
#define CK_LOAD(un) do { const int b_ = (un) >> 10, h_ = ((un) >> 6) & 15, ch_ = (un) & 63; const int t_ = ch_ * 64 + tt; \
        const size_t mm = (size_t)b_ * T + (size_t)t_; const bf16* row = PR + mm * N1P + h_ * 64 + pc; const v4u zr = (v4u){0u, 0u, 0u, 0u}; \
        qr = *(const v4u*)row; qk = *(const v4u*)(row + 1024); qrp = t_ > 0 ? *(const v4u*)(row - N1P) : zr; qkp = t_ > 0 ? *(const v4u*)(row - N1P + 1024) : zr; \
        qas = *(const v4u*)(ASIG + mm * D + h_ * 64 + pc); qel = *(const v4u*)(ELOG + mm * D + h_ * 64 + pc); qv = *(const v4u*)(VS + mm * D + h_ * 64 + pc); } while (0)
    if (c.bid < 4096) CK_LOAD(c.bid);
    for (int unit = c.bid; unit < 4096; unit += c.G) {
        const int b = unit >> 10, h = (unit >> 6) & 15, ch = unit & 63;
        const size_t m0 = (size_t)b * T + (size_t)ch * 64;
        const int hc = h * 64 + pc;
        for (int rep = 0; rep < (PROBE_DUP == 7 ? 2 : 1); ++rep) {
        if (PROBE_DUP == 7) { CK_LOAD(unit); }
        float r_[8], k_[8], as_[8], el_[8], v_[8], kk_[8], ks_[8];
        {
            float rp_[8], kp_[8];
            unpack8(qr, r_); unpack8(qrp, rp_); unpack8(qk, k_); unpack8(qkp, kp_); unpack8(qas, as_); unpack8(qel, el_); unpack8(qv, v_);
            if (PROBE_DUP != 7 && unit + c.G < 4096) CK_LOAD(unit + c.G);
            float s1 = 0.f;
#pragma unroll
            for (int e = 0; e < 8; ++e) { r_[e] = r_[e] + (rp_[e] - r_[e]) * mu[hc + e]; ks_[e] = k_[e] + (kp_[e] - k_[e]) * mu[1024 + hc + e]; kk_[e] = ks_[e] * k_k[hc + e]; s1 += kk_[e] * kk_[e]; }
            s1 = sum8(s1);
            const float i1 = rsqrtf(s1 + 1e-12f);
#pragma unroll
            for (int e = 0; e < 8; ++e) { kk_[e] *= i1; k_[e] = ks_[e] * (1.f + (as_[e] - 1.f) * k_a[hc + e]); }
            { float bn = 0.f;
#pragma unroll
              for (int e = 0; e < 8; ++e) bn += r_[e] * k_[e] * rk_[hc + e];
              bn = sum8(bn);
              if (l8 == 0) BON[(m0 + tt) * 16 + h] = bn; }
            *(LAS f32x4*)(SCR + tt * 64 + pc) = (f32x4){el_[0], el_[1], el_[2], el_[3]}; *(LAS f32x4*)(SCR + tt * 64 + pc + 4) = (f32x4){el_[4], el_[5], el_[6], el_[7]};
        }
        lds_barrier();
        {
            const int col = tid & 63, seg = tid >> 6; float s = 0.f;
#pragma unroll
            for (int i = 0; i < 8; ++i) { s += SCR[(8 * seg + i) * 64 + col]; SCR[(8 * seg + i) * 64 + col] = s; }
            SEGT[seg * 64 + col] = s;
        }
        lds_barrier();
        {
            const int col = tid & 63, seg = tid >> 6; float pre = 0.f;
#pragma unroll
            for (int s2 = 0; s2 < 7; ++s2) pre += (s2 < seg) ? SEGT[s2 * 64 + col] : 0.f;
#pragma unroll
            for (int i = 0; i < 8; ++i) SCR[(8 * seg + i) * 64 + col] += pre;
        }
        lds_barrier();
        {
            float L[8], Lr[8], Le[8];
            { const f32x4 x0 = *(const LAS f32x4*)(SCR + tt * 64 + pc), x1 = *(const LAS f32x4*)(SCR + tt * 64 + pc + 4);
              const f32x4 y0 = *(const LAS f32x4*)(SCR + 31 * 64 + pc), y1 = *(const LAS f32x4*)(SCR + 31 * 64 + pc + 4);
              const f32x4 z0 = *(const LAS f32x4*)(SCR + 63 * 64 + pc), z1 = *(const LAS f32x4*)(SCR + 63 * 64 + pc + 4);
#pragma unroll
              for (int e = 0; e < 4; ++e) { L[e] = x0[e]; L[4 + e] = x1[e]; Lr[e] = y0[e]; Lr[4 + e] = y1[e]; Le[e] = z0[e]; Le[4 + e] = z1[e]; } }
            float oA[8], oR[8], oBt[8], oKt[8], oBh[8], oKh[8];
#pragma unroll
            for (int e = 0; e < 8; ++e) {
                const float ea = __expf(L[e] - el_[e] - Lr[e]), er = __expf(L[e] - Lr[e]), eb = __expf(Lr[e] - L[e]), eh = __expf(Le[e] - L[e]);
                const float bb = kk_[e] * as_[e];
                oA[e] = -kk_[e] * ea; oR[e] = r_[e] * er; oBt[e] = bb * eb; oKt[e] = k_[e] * eb; oBh[e] = bb * eh; oKh[e] = k_[e] * eh;
            }
            const int o = tt * CK_TS + pc;
            *(LAS v4u*)(TL(tA) + o) = pack8(oA); *(LAS v4u*)(TL(tR) + o) = pack8(oR); *(LAS v4u*)(TL(tBt) + o) = pack8(oBt); *(LAS v4u*)(TL(tKt) + o) = pack8(oKt);
            *(LAS v4u*)(TL(tBh) + o) = pack8(oBh); *(LAS v4u*)(TL(tKh) + o) = pack8(oKh); *(LAS v4u*)(TL(tV) + o) = pack8(v_);
            if (tt == 0) {
#pragma unroll
                for (int e = 0; e < 8; ++e) { cscale[pc + e] = __expf(Lr[e]); wcv[pc + e] = __expf(Le[e]); }
            }
        }
        lds_barrier();
        const LAS bf16* Z = nullptr;
        const int wg_ = w >> 2, ws_ = w & 3;
        if (wg_ == 0) { mm64h<0, 1, 1, 0, 1, 0>(TL(tNab), TL(tA), TL(tBt), Z, Z, Z, Z, cscale, wcv, ws_, lane);
                        mm64h<0, 1, 1, 0, 1, 0>(TL(tNak), TL(tA), TL(tKt), Z, Z, Z, Z, cscale, wcv, ws_, lane); }
        else          { mm64h<0, 1, 2, 0, 1, 0>(TL(tNrb), TL(tR), TL(tBt), Z, Z, Z, Z, cscale, wcv, ws_, lane);
                        mm64h<0, 1, 2, 0, 1, 0>(TL(tNrk), TL(tR), TL(tKt), Z, Z, Z, Z, cscale, wcv, ws_, lane); }
        lds_barrier();
        if (wg_ == 0) mm64h<0, 0, 0, 0, 1, 0>(TL(tM0), TL(tNab), TL(tNab), Z, Z, Z, Z, cscale, wcv, ws_, lane);
        else          mm64h<0, 0, 0, 0, 1, 0>(TL(tX1), TL(tNak), TL(tV), Z, Z, Z, Z, cscale, wcv, ws_, lane);
        lds_barrier();
        if (wg_ == 0) mm64h<0, 0, 0, 2, 1, 0>(TL(tP1), TL(tNab), TL(tM0), Z, Z, TL(tNab), TL(tM0), cscale, wcv, ws_, lane);
        else          mm64h<0, 0, 0, 0, 1, 0>(TL(tM1), TL(tM0), TL(tM0), Z, Z, Z, Z, cscale, wcv, ws_, lane);
        lds_barrier();
        if (wg_ == 0) mm64h<0, 0, 0, 2, 1, 0>(TL(tNab), TL(tP1), TL(tM1), Z, Z, TL(tP1), TL(tM1), cscale, wcv, ws_, lane);
        else          mm64h<0, 0, 0, 0, 1, 0>(TL(tM0), TL(tM1), TL(tM1), Z, Z, Z, Z, cscale, wcv, ws_, lane);
        lds_barrier();
        if (wg_ == 0) mm64h<0, 0, 0, 2, 1, 0>(TL(tP1), TL(tNab), TL(tM0), Z, Z, TL(tNab), TL(tM0), cscale, wcv, ws_, lane);
        else          mm64h<0, 0, 0, 0, 1, 0>(TL(tM1), TL(tM0), TL(tM0), Z, Z, Z, Z, cscale, wcv, ws_, lane);
        lds_barrier();
        if (wg_ == 0) mm64h<0, 0, 0, 2, 1, 0>(TL(tNab), TL(tP1), TL(tM1), Z, Z, TL(tP1), TL(tM1), cscale, wcv, ws_, lane);
        else          mm64h<0, 0, 0, 0, 1, 0>(TL(tM0), TL(tM1), TL(tM1), Z, Z, Z, Z, cscale, wcv, ws_, lane);
        lds_barrier();
        mm64<0, 0, 0, 2, 1, 0>(TL(tP1), TL(tNab), TL(tM0), Z, Z, TL(tNab), TL(tM0), cscale, wcv, w, lane);
        lds_barrier();
        if (wg_ == 0) mm64h<0, 0, 0, 1, 1, 0>(TL(tBt), TL(tP1), TL(tA), Z, Z, TL(tA), Z, cscale, wcv, ws_, lane);
        else          mm64h<0, 0, 0, 1, 1, 0>(TL(tKt), TL(tP1), TL(tX1), Z, Z, TL(tX1), Z, cscale, wcv, ws_, lane);
        lds_barrier();
        if (wg_ == 0) { mm64h<0, 0, 0, 1, 1, 1>(TL(tM0), TL(tNrb), TL(tBt), Z, Z, TL(tR), Z, cscale, wcv, ws_, lane);
                        mm64h<0, 0, 0, 0, 2, 0>(TL(tM1), TL(tNrb), TL(tKt), TL(tNrk), TL(tV), Z, Z, cscale, wcv, ws_, lane); }
        else          { mm64h<1, 0, 0, 0, 1, 2>(TL(tNab), TL(tBh), TL(tBt), Z, Z, Z, Z, cscale, wcv, ws_, lane);
                        mm64h<1, 0, 0, 0, 2, 0>(TL(tX1), TL(tKt), TL(tBh), TL(tV), TL(tKh), Z, Z, cscale, wcv, ws_, lane); }
        lds_barrier();
        }
        {
            const size_t grow = m0 + tt;
            *(v4u*)(ELOG + grow * D + hc) = *(const LAS v4u*)(TL(tM0) + tt * CK_TS + pc);
            *(v4u*)(Y + grow * D + hc) = *(const LAS v4u*)(TL(tM1) + tt * CK_TS + pc);
            *(v4u*)(PR + grow * N1P + 2048 + hc) = *(const LAS v4u*)(TL(tNab) + tt * CK_TS + pc);
            *(v4u*)(SLB + grow * D + hc) = *(const LAS v4u*)(TL(tX1) + tt * CK_TS + pc);
        }
        lds_barrier();
    }
#undef TL
#undef CK_LOAD
}

struct SeqOps { v4u g0, g1, p0, p1; v2u sl, yl; };
__device__ __forceinline__ void phase_rwkv_chunk_seq(const Ctx& c, KArgs& a, const bool commit = true) {
    unsigned char* ws = a.ws;
    const bf16* PR = (const bf16*)(ws + WS_OV + OV_PR);
    const bf16* RP = (const bf16*)(ws + WS_OV + OV_ELOG);
    bf16* Y = (bf16*)(ws + WS_OV + OV_YA);
    const bf16* SLB = (const bf16*)(ws + WS_OV + OV_AL);
    LAS bf16* SL = (LAS bf16*)c.lds;
    const int tid = c.tid, lane = c.lane, w = c.wave, r = lane & 15, q = lane >> 4;
    constexpr int PF = 4;
    for (int unit = c.bid; unit < 256; unit += c.G) {
        const int b = unit >> 6, h = (unit >> 2) & 15, vq = unit & 3;
        for (int e = tid; e < 2 * 16 * CK_TS / 2; e += 512) ((LAS unsigned*)SL)[e] = 0u;
        __syncthreads();
        if (w < 4) {
            const size_t rowG = (size_t)b * T + 16 * w + r;
            const size_t rowS = (size_t)b * T + vq * 16 + r;
            SeqOps ops[PF];
#define SQ_LOAD(dst, chn) do { const size_t o_ = (size_t)(chn) * 64; \
                dst.g0 = *(const v4u*)(PR + (rowG + o_) * N1P + 2048 + h * 64 + 8 * q); dst.g1 = *(const v4u*)(PR + (rowG + o_) * N1P + 2048 + h * 64 + 32 + 8 * q); \
                dst.p0 = *(const v4u*)(RP + (rowG + o_) * D + h * 64 + 8 * q); dst.p1 = *(const v4u*)(RP + (rowG + o_) * D + h * 64 + 32 + 8 * q); \
                dst.sl = *(const v2u*)(SLB + (rowS + o_) * D + h * 64 + 16 * w + 4 * q); dst.yl = *(const v2u*)(Y + (rowG + o_) * D + h * 64 + vq * 16 + 4 * q); } while (0)
#pragma unroll
            for (int i = 0; i < PF; ++i) SQ_LOAD(ops[i], i);
            for (int ch0 = 0; ch0 < 64; ch0 += PF) {
#pragma unroll
                for (int i = 0; i < PF; ++i) {
                    const int ch = ch0 + i;
                    const SeqOps cur = ops[i];
                    if (ch + PF < 64) SQ_LOAD(ops[i], ch + PF);
                    const LAS bf16* Sc = SL + (i & 1) * 16 * CK_TS; LAS bf16* Sn = SL + ((i + 1) & 1) * 16 * CK_TS;
                    const bf16x8 s0 = *(const LAS bf16x8*)(Sc + r * CK_TS + 8 * q), s1 = *(const LAS bf16x8*)(Sc + r * CK_TS + 32 + 8 * q);
                    f32x4 accS = (f32x4){bflo(cur.sl.x), bfhi(cur.sl.x), bflo(cur.sl.y), bfhi(cur.sl.y)};
                    accS = __builtin_amdgcn_mfma_f32_16x16x32_bf16(__builtin_bit_cast(bf16x8, cur.g0), s0, accS, 0, 0, 0);
                    accS = __builtin_amdgcn_mfma_f32_16x16x32_bf16(__builtin_bit_cast(bf16x8, cur.g1), s1, accS, 0, 0, 0);
                    f32x4 accY = (f32x4){bflo(cur.yl.x), bfhi(cur.yl.x), bflo(cur.yl.y), bfhi(cur.yl.y)};
                    accY = __builtin_amdgcn_mfma_f32_16x16x32_bf16(s0, __builtin_bit_cast(bf16x8, cur.p0), accY, 0, 0, 0);
                    accY = __builtin_amdgcn_mfma_f32_16x16x32_bf16(s1, __builtin_bit_cast(bf16x8, cur.p1), accY, 0, 0, 0);
                    { v2u o; o.x = pk2c(accS[0], accS[1]); o.y = pk2c(accS[2], accS[3]); *(LAS v2u*)(Sn + r * CK_TS + 16 * w + 4 * q) = o; }
                    if (commit || accY[0] == 123456.789f) { v2u o; o.x = pk2c(accY[0], accY[1]); o.y = pk2c(accY[2], accY[3]); *(v2u*)(Y + (rowG + (size_t)ch * 64) * D + h * 64 + vq * 16 + 4 * q) = o; }
                    lds_barrier();
                }
            }
#undef SQ_LOAD
        } else {
            for (int ch = 0; ch < 64; ++ch) lds_barrier();
        }
        __syncthreads();
    }
}

__device__ __forceinline__ void phase_rwkv_post(const Ctx& c, KArgs& a, int l, int hb) {
    unsigned char* ws = a.ws;
    const bf16* GG = (const bf16*)(ws + WS_OV + OV_GG);
    const bf16* VS = l == 0 ? (const bf16*)(ws + WS_VF) + (size_t)hb * MH * D : (const bf16*)(ws + WS_OV + OV_VMIX);
    const float* BON = (const float*)(ws + WS_OV + OV_BON);
    bf16* Y = (bf16*)(ws + WS_OV + OV_YA);
    const int lane = c.lane, c0 = 16 * lane;
    float lw[16], lb[16];
#pragma unroll
    for (int e = 0; e < 16; ++e) { lw[e] = a.in[I_LNW][(size_t)l * D + c0 + e]; lb[e] = a.in[I_LNB][(size_t)l * D + c0 + e]; }
    const int gw = c.bid * 8 + c.wave, NGW = c.G * 8;
    v4u ny0, ny1, nv0, nv1, ng0, ng1; float nbon = 0.f;
#define RP_LOAD(mm) do { ny0 = *(const v4u*)(Y + (size_t)(mm) * D + c0); ny1 = *(const v4u*)(Y + (size_t)(mm) * D + c0 + 8); nv0 = *(const v4u*)(VS + (size_t)(mm) * D + c0); nv1 = *(const v4u*)(VS + (size_t)(mm) * D + c0 + 8); \
        ng0 = *(const v4u*)(GG + (size_t)(mm) * D + c0); ng1 = *(const v4u*)(GG + (size_t)(mm) * D + c0 + 8); nbon = BON[(size_t)(mm) * 16 + (lane >> 2)]; } while (0)
    if (gw < MH) RP_LOAD(gw);
    for (int m = gw; m < MH; m += NGW) {
        float y[16], v[16], g[16], t8[8];
        const v4u cy0 = ny0, cy1 = ny1, cv0 = nv0, cv1 = nv1, cg0 = ng0, cg1 = ng1; const float bon = nbon;
        if (m + NGW < MH) RP_LOAD(m + NGW);
#define UP16(dst, qa, qb) do { unpack8(qa, t8); _Pragma("unroll") for (int e = 0; e < 8; ++e) dst[e] = t8[e]; unpack8(qb, t8); _Pragma("unroll") for (int e = 0; e < 8; ++e) dst[8 + e] = t8[e]; } while (0)
        UP16(y, cy0, cy1); UP16(v, cv0, cv1); UP16(g, cg0, cg1);
#undef UP16
        float s1 = 0.f;
#pragma unroll
        for (int e = 0; e < 16; ++e) s1 += y[e];
        s1 = sum4(s1);
        const float mean = s1 * (1.f / 64.f);
        float s2 = 0.f;
#pragma unroll
        for (int e = 0; e < 16; ++e) { const float d = y[e] - mean; s2 += d * d; }
        s2 = sum4(s2);
        const float rstd = rsqrtf(s2 * (1.f / 64.f) + 64e-5f);
        float o[16];
#pragma unroll
        for (int e = 0; e < 16; ++e) o[e] = ((y[e] - mean) * rstd * lw[e] + lb[e] + bon * v[e]) * g[e];
        v4u o0, o1;
        o0.x = pk2(o[0], o[1]); o0.y = pk2(o[2], o[3]); o0.z = pk2(o[4], o[5]); o0.w = pk2(o[6], o[7]);
        o1.x = pk2(o[8], o[9]); o1.y = pk2(o[10], o[11]); o1.z = pk2(o[12], o[13]); o1.w = pk2(o[14], o[15]);
        *(v4u*)(Y + (size_t)m * D + c0) = o0; *(v4u*)(Y + (size_t)m * D + c0 + 8) = o1;
    }
}

__device__ __forceinline__ void phase_ssd_conv(const Ctx& c, KArgs& a, int l) {
    unsigned char* ws = a.ws;
    const bf16* PS = (const bf16*)(ws + WS_OV + OV_PS);
    bf16* XBC = (bf16*)(ws + WS_OV + OV_XBC);
    float* DT = (float*)(ws + WS_OV + OV_DT); float* DA = (float*)(ws + WS_OV + OV_DA);
    const float* cw = a.in[I_CW] + (size_t)l * 4 * 3072; const float* cb = a.in[I_CB] + (size_t)l * 3072;
    const int gw = c.bid * 8 + c.wave, NGW = c.G * 8, lane = c.lane;
    constexpr int RUN = 16, NRUN = MH / RUN;
    for (int it = gw; it < 2 * NRUN; it += NGW) {
        const int cb_ = 4 + (it & 1), run = it >> 1, ch0 = cb_ * 512 + lane * 8, m0 = run * RUN;
        float w[4][8], bias[8];
#pragma unroll
        for (int j = 0; j < 4; ++j)
#pragma unroll
            for (int e = 0; e < 8; ++e) w[j][e] = cw[j * 3072 + ch0 + e];
#pragma unroll
        for (int e = 0; e < 8; ++e) bias[e] = cb[ch0 + e];
        float x0[8], x1[8], x2[8], x3[8];
        const bf16* base = PS + (size_t)m0 * N2P + 2048 + ch0;
        const int t0 = m0 & (T - 1);
        if (t0 >= 3) { unpack8(*(const v4u*)(base - 3 * N2P), x0); unpack8(*(const v4u*)(base - 2 * N2P), x1); unpack8(*(const v4u*)(base - N2P), x2); }
        else {
#pragma unroll
            for (int e = 0; e < 8; ++e) { x0[e] = 0.f; x1[e] = 0.f; x2[e] = 0.f; }
        }
        v4u nx = *(const v4u*)base;
#pragma unroll 4
        for (int i = 0; i < RUN; ++i) {
            unpack8(nx, x3);
            if (i + 1 < RUN) nx = *(const v4u*)(base + (size_t)(i + 1) * N2P);
            float o[8];
#pragma unroll
            for (int e = 0; e < 8; ++e) { const float y = bias[e] + x0[e] * w[0][e] + x1[e] * w[1][e] + x2[e] * w[2][e] + x3[e] * w[3][e]; o[e] = siluf_(y); x0[e] = x1[e]; x1[e] = x2[e]; x2[e] = x3[e]; }
            *(v4u*)(XBC + (size_t)(m0 + i) * 3072 + ch0) = pack8(o);
        }
    }
}

__device__ __forceinline__ void tr_bm2(unsigned a, bf16x8& f0, bf16x8& f1) {
    s16x4 l0, h0, l1, h1;
    asm volatile("ds_read_b64_tr_b16 %0, %4\n\tds_read_b64_tr_b16 %1, %4 offset:1088\n\tds_read_b64_tr_b16 %2, %4 offset:8704\n\tds_read_b64_tr_b16 %3, %4 offset:9792\n\ts_waitcnt lgkmcnt(0)"
                 : "=&v"(l0), "=&v"(h0), "=&v"(l1), "=&v"(h1) : "v"(a) : "memory");
    f0 = __builtin_shufflevector(l0, h0, 0, 1, 2, 3, 4, 5, 6, 7); f1 = __builtin_shufflevector(l1, h1, 0, 1, 2, 3, 4, 5, 6, 7);
}
__device__ __forceinline__ void tr_x2(unsigned a, bf16x8& f0, bf16x8& f1) {
    s16x4 l0, h0, l1, h1;
    asm volatile("ds_read_b64_tr_b16 %0, %4\n\tds_read_b64_tr_b16 %1, %4 offset:320\n\tds_read_b64_tr_b16 %2, %4 offset:2560\n\tds_read_b64_tr_b16 %3, %4 offset:2880\n\ts_waitcnt lgkmcnt(0)"
                 : "=&v"(l0), "=&v"(h0), "=&v"(l1), "=&v"(h1) : "v"(a) : "memory");
    f0 = __builtin_shufflevector(l0, h0, 0, 1, 2, 3, 4, 5, 6, 7); f1 = __builtin_shufflevector(l1, h1, 0, 1, 2, 3, 4, 5, 6, 7);
}
__device__ __forceinline__ void tr_x4(unsigned a, bf16x8& f00, bf16x8& f01, bf16x8& f10, bf16x8& f11) {
    s16x4 l0, h0, l1, h1, l2, h2, l3, h3;
    asm volatile("ds_read_b64_tr_b16 %0, %8\n\tds_read_b64_tr_b16 %1, %8 offset:320\n\tds_read_b64_tr_b16 %2, %8 offset:2560\n\tds_read_b64_tr_b16 %3, %8 offset:2880\n\t"
                 "ds_read_b64_tr_b16 %4, %8 offset:32\n\tds_read_b64_tr_b16 %5, %8 offset:352\n\tds_read_b64_tr_b16 %6, %8 offset:2592\n\tds_read_b64_tr_b16 %7, %8 offset:2912\n\ts_waitcnt lgkmcnt(0)"
                 : "=&v"(l0), "=&v"(h0), "=&v"(l1), "=&v"(h1), "=&v"(l2), "=&v"(h2), "=&v"(l3), "=&v"(h3) : "v"(a) : "memory");
    f00 = __builtin_shufflevector(l0, h0, 0, 1, 2, 3, 4, 5, 6, 7); f01 = __builtin_shufflevector(l1, h1, 0, 1, 2, 3, 4, 5, 6, 7);
    f10 = __builtin_shufflevector(l2, h2, 0, 1, 2, 3, 4, 5, 6, 7); f11 = __builtin_shufflevector(l3, h3, 0, 1, 2, 3, 4, 5, 6, 7);
}
__device__ __forceinline__ void phase_ssd_scan(const Ctx& c, KArgs& a, int l) {
    unsigned char* ws = a.ws;
    const bf16* PS = (const bf16*)(ws + WS_OV + OV_PS);
    bf16* XBC = (bf16*)(ws + WS_OV + OV_XBC);
    const float* cw = a.in[I_CW] + (size_t)l * 4 * 3072; const float* cb = a.in[I_CB] + (size_t)l * 3072;
    const float* DT = (const float*)(ws + WS_OV + OV_DT); const float* ACS = (const float*)(ws + WS_OV + OV_DA);
    constexpr int SC = 136, SM = 72, SX = 40;
    LAS bf16* Cm = (LAS bf16*)c.lds;
    LAS bf16* Bm = Cm + 64 * SC;
    LAS bf16* Xd = Bm + 64 * SC;
    LAS bf16* Xs = Xd + 64 * SX;
    LAS bf16* Xr = Xs + 64 * SX;
    LAS bf16* MtT = Xr + 64 * SX;
    LAS bf16* SL = MtT + 64 * SM;
    LAS float* acsL = (LAS float*)(SL + 32 * SC);
    const unsigned BmB = (unsigned)(size_t)Bm, XdB = (unsigned)(size_t)Xd, XsB = (unsigned)(size_t)Xs;
    const int tid = c.tid, lane = c.lane, w = c.wave, r = lane & 15, q = lane >> 4;
    const int sj = tid >> 3, sn = (tid & 7) * 16, sp = (tid & 7) * 4;
    const int trq = ((lane & 15) >> 2), trp = lane & 3;
    const unsigned troffB = (unsigned)(((8 * q + trq) * SC + 4 * trp) * 2), troffX = (unsigned)(((8 * q + trq) * SX + 4 * trp) * 2);
    for (int unit = c.bid; unit < 256; unit += c.G) {
        const int b = unit >> 6, h = (unit >> 1) & 31, ph = unit & 1, g = h >> 3;
        const size_t m0 = (size_t)b * T;
        f32x4 st[2] = {(f32x4){0.f, 0.f, 0.f, 0.f}, (f32x4){0.f, 0.f, 0.f, 0.f}};
        for (int e = tid; e < 32 * SC / 2; e += 512) ((LAS unsigned*)SL)[e] = 0u;
        v4u gB0, gB1, gC0, gC1; v2u gX0, gX1, gX2, gX3; float gacs, gacsE, gdt;
        const int chx = h * 64 + ph * 32 + sp; const float Dh = a.in[I_SD][l * 32 + h];
        float cwt[4][4], cbs[4];
#pragma unroll
        for (int e2 = 0; e2 < 4; ++e2) { cbs[e2] = cb[chx + e2];
#pragma unroll
            for (int j = 0; j < 4; ++j) cwt[j][e2] = cw[j * 3072 + chx + e2]; }
#define SS_LOAD(chunk) do { const size_t row = m0 + (size_t)(chunk) * 64 + sj; const bf16* xr = XBC + row * 3072; \
            gB0 = *(const v4u*)(xr + 2048 + g * 128 + sn); gB1 = *(const v4u*)(xr + 2048 + g * 128 + sn + 8); \
            gC0 = *(const v4u*)(xr + 2560 + g * 128 + sn); gC1 = *(const v4u*)(xr + 2560 + g * 128 + sn + 8); \
            { const int t_ = (chunk) * 64 + sj; const bf16* pr_ = PS + row * N2P + 2048 + chx; const v2u z2 = (v2u){0u, 0u}; \
              gX3 = *(const v2u*)pr_; gX2 = t_ >= 1 ? *(const v2u*)(pr_ - N2P) : z2; gX1 = t_ >= 2 ? *(const v2u*)(pr_ - 2 * N2P) : z2; gX0 = t_ >= 3 ? *(const v2u*)(pr_ - 3 * N2P) : z2; } \
            gacs = ACS[row * 32 + h]; gacsE = ACS[(m0 + (size_t)(chunk) * 64 + 63) * 32 + h]; gdt = DT[row * 32 + h]; } while (0)
#define SS_STAGE() do { \
            *(LAS v4u*)(Bm + sj * SC + sn) = gB0; *(LAS v4u*)(Bm + sj * SC + sn + 8) = gB1; *(LAS v4u*)(Cm + sj * SC + sn) = gC0; *(LAS v4u*)(Cm + sj * SC + sn + 8) = gC1; \
            const float sc_ = gdt * __expf(gacsE - gacs); \
            const float r0_[4] = {bflo(gX0.x), bfhi(gX0.x), bflo(gX0.y), bfhi(gX0.y)}, r1_[4] = {bflo(gX1.x), bfhi(gX1.x), bflo(gX1.y), bfhi(gX1.y)}; \
            const float r2_[4] = {bflo(gX2.x), bfhi(gX2.x), bflo(gX2.y), bfhi(gX2.y)}, r3_[4] = {bflo(gX3.x), bfhi(gX3.x), bflo(gX3.y), bfhi(gX3.y)}; \
            float xa_[4]; _Pragma("unroll") for (int e2 = 0; e2 < 4; ++e2) xa_[e2] = siluf_(cbs[e2] + r0_[e2] * cwt[0][e2] + r1_[e2] * cwt[1][e2] + r2_[e2] * cwt[2][e2] + r3_[e2] * cwt[3][e2]); \
            const float x0_ = xa_[0], x1_ = xa_[1], x2_ = xa_[2], x3_ = xa_[3]; \
            v2u o1_, o2_; o1_.x = pk2(x0_ * gdt, x1_ * gdt); o1_.y = pk2(x2_ * gdt, x3_ * gdt); o2_.x = pk2(x0_ * sc_, x1_ * sc_); o2_.y = pk2(x2_ * sc_, x3_ * sc_); \
            *(LAS v2u*)(Xd + sj * SX + sp) = o1_; *(LAS v2u*)(Xs + sj * SX + sp) = o2_; { v2u o3_; o3_.x = pk2(x0_, x1_); o3_.y = pk2(x2_, x3_); *(LAS v2u*)(Xr + sj * SX + sp) = o3_; } \
            if ((tid & 7) == 0) acsL[sj] = gacs; } while (0)
        SS_LOAD(0);
        SS_STAGE();
        __syncthreads();
        for (int ch = 0; ch < T / 64; ++ch) {
            if (ch + 1 < T / 64) SS_LOAD(ch + 1);
            {
                const int jt = w >> 1, it0 = 2 * (w & 1);
                f32x4 acc0 = (f32x4){0.f, 0.f, 0.f, 0.f}, acc1 = acc0;
                if (it0 + 1 >= jt) {
#pragma unroll
                    for (int ks = 0; ks < 4; ++ks) {
                        const bf16x8 af = *(const LAS bf16x8*)(Bm + (16 * jt + r) * SC + 32 * ks + 8 * q);
                        const bf16x8 b0 = *(const LAS bf16x8*)(Cm + (16 * it0 + r) * SC + 32 * ks + 8 * q);
                        const bf16x8 b1 = *(const LAS bf16x8*)(Cm + (16 * (it0 + 1) + r) * SC + 32 * ks + 8 * q);
                        acc0 = __builtin_amdgcn_mfma_f32_16x16x32_bf16(af, b0, acc0, 0, 0, 0);
                        acc1 = __builtin_amdgcn_mfma_f32_16x16x32_bf16(af, b1, acc1, 0, 0, 0);
                    }
                }
                const int i0 = 16 * it0 + r, i1 = i0 + 16;
                const float ai0 = acsL[i0], ai1 = acsL[i1];
                float m0v[4], m1v[4];
#pragma unroll
                for (int e = 0; e < 4; ++e) { const int j = 16 * jt + 4 * q + e; const float aj = acsL[j];
                    m0v[e] = (j <= i0) ? acc0[e] * __expf(ai0 - aj) : 0.f; m1v[e] = (j <= i1) ? acc1[e] * __expf(ai1 - aj) : 0.f; }
                { v2u o0, o1; o0.x = pk2(m0v[0], m0v[1]); o0.y = pk2(m0v[2], m0v[3]); o1.x = pk2(m1v[0], m1v[1]); o1.y = pk2(m1v[2], m1v[3]);
                  *(LAS v2u*)(MtT + i0 * SM + 16 * jt + 4 * q) = o0; *(LAS v2u*)(MtT + i1 * SM + 16 * jt + 4 * q) = o1; }
            }
            lds_barrier();
            {
                const int it = w >> 1, pt = w & 1;
                f32x4 accD = (f32x4){0.f, 0.f, 0.f, 0.f}, accO = accD;
                {
                    bf16x8 xb0, xb1; tr_x2(XdB + troffX + 32u * pt, xb0, xb1);
                    const bf16x8 af0 = *(const LAS bf16x8*)(MtT + (16 * it + r) * SM + 8 * q);
                    accD = __builtin_amdgcn_mfma_f32_16x16x32_bf16(af0, xb0, accD, 0, 0, 0);
                    if (it >= 2) {
                        const bf16x8 af1 = *(const LAS bf16x8*)(MtT + (16 * it + r) * SM + 32 + 8 * q);
                        accD = __builtin_amdgcn_mfma_f32_16x16x32_bf16(af1, xb1, accD, 0, 0, 0);
                    }
                }
#pragma unroll
                for (int ks = 0; ks < 4; ++ks) {
                    const bf16x8 af = *(const LAS bf16x8*)(Cm + (16 * it + r) * SC + 32 * ks + 8 * q);
                    const bf16x8 bf_ = *(const LAS bf16x8*)(SL + (16 * pt + r) * SC + 32 * ks + 8 * q);
                    accO = __builtin_amdgcn_mfma_f32_16x16x32_bf16(af, bf_, accO, 0, 0, 0);
                }
                const int p = 16 * pt + r;
#pragma unroll
                for (int e = 0; e < 4; ++e) { const int i = 16 * it + 4 * q + e; const float y = accD[e] + __expf(acsL[i]) * accO[e] + Dh * bf1(Xr[i * SX + p]);
                    XBC[(m0 + (size_t)ch * 64 + i) * 3072 + h * 64 + ph * 32 + p] = (bf16)f2bf(y); }
            }
            {
                const float dec = __expf(acsL[63]);
                bf16x8 a0, a1, bx[2][2];
                tr_bm2(BmB + troffB + 32u * w, a0, a1);
                tr_x4(XsB + troffX, bx[0][0], bx[0][1], bx[1][0], bx[1][1]);
#pragma unroll
                for (int pt = 0; pt < 2; ++pt) {
                    f32x4 s = st[pt] * dec;
                    s = __builtin_amdgcn_mfma_f32_16x16x32_bf16(a0, bx[pt][0], s, 0, 0, 0);
                    s = __builtin_amdgcn_mfma_f32_16x16x32_bf16(a1, bx[pt][1], s, 0, 0, 0);
                    st[pt] = s;
                }
            }
            lds_barrier();
#pragma unroll
            for (int pt = 0; pt < 2; ++pt) { v2u o; o.x = pk2c(st[pt][0], st[pt][1]); o.y = pk2c(st[pt][2], st[pt][3]);
                *(LAS v2u*)(SL + (16 * pt + r) * SC + 16 * w + 4 * q) = o; }
            if (ch + 1 < T / 64) SS_STAGE();
            lds_barrier();
        }
#undef SS_LOAD
#undef SS_STAGE
    }
}

__device__ __forceinline__ void phase_ssd_post(const Ctx& c, KArgs& a, int l) {
    unsigned char* ws = a.ws;
    bf16* PS = (bf16*)(ws + WS_OV + OV_PS);
    const bf16* XBC = (const bf16*)(ws + WS_OV + OV_XBC);
    const int lane = c.lane, c0 = 32 * lane;
    const float* ng = a.in[I_SNG] + (size_t)l * 2048 + c0;
    const int gw = c.bid * 8 + c.wave, NGW = c.G * 8;
    v4u nyy[4], nzz[4];
#define SP_LOAD(mm) do { _Pragma("unroll") for (int q = 0; q < 4; ++q) { nyy[q] = *(const v4u*)(XBC + (size_t)(mm) * 3072 + c0 + 8 * q); nzz[q] = *(const v4u*)(PS + (size_t)(mm) * N2P + c0 + 8 * q); } } while (0)
    if (gw < MH) SP_LOAD(gw);
    for (int m = gw; m < MH; m += NGW) {
        float y[32]; float ss = 0.f;
        v4u cyy[4], czz[4];
#pragma unroll
        for (int q = 0; q < 4; ++q) { cyy[q] = nyy[q]; czz[q] = nzz[q]; }
        if (m + NGW < MH) SP_LOAD(m + NGW);
#pragma unroll
        for (int q = 0; q < 4; ++q) {
            float yy[8], zz[8];
            unpack8(cyy[q], yy); unpack8(czz[q], zz);
#pragma unroll
            for (int e = 0; e < 8; ++e) { const float v = yy[e] * siluf_(zz[e]); y[8 * q + e] = v; ss += v * v; }
        }
        ss = sum16(ss);
        const float r = rsqrtf(ss * (1.f / 512.f) + 1e-6f);
#pragma unroll
        for (int q = 0; q < 4; ++q) {
            float o[8];
#pragma unroll
            for (int e = 0; e < 8; ++e) o[e] = y[8 * q + e] * r * ng[8 * q + e];
            *(v4u*)(PS + (size_t)m * N2P + 2048 + c0 + 8 * q) = pack8(o);
        }
    }
}

__device__ __forceinline__ void phase_peer_convert(const Ctx& c, KArgs& a, int l) {
    unsigned char* ws = a.ws;
    const int gw = c.bid * 8 + c.wave, NGW = c.G * 8, lane = c.lane;
    f32x4 n0, n1, n2, n3;
#define PC_LOAD(itt) do { const int tb_ = (itt) >= NEXP, e_ = (itt) - tb_ * NEXP; const float* s_ = (tb_ ? a.in[I_PU] : a.in[I_PD]) + ((size_t)l * NEXP + e_) * D + 16 * lane; \
        n0 = *(const f32x4*)s_; n1 = *(const f32x4*)(s_ + 4); n2 = *(const f32x4*)(s_ + 8); n3 = *(const f32x4*)(s_ + 12); } while (0)
    if (gw < 2 * NEXP) PC_LOAD(gw);
    for (int it = gw; it < 2 * NEXP; it += NGW) {
        const int tb = it >= NEXP, e = it - tb * NEXP;
        const f32x4 x0 = n0, x1 = n1, x2 = n2, x3 = n3;
        if (it + NGW < 2 * NEXP) PC_LOAD(it + NGW);
        float am = fmaxf(fmaxf(fmaxf(fabsf(x0.x), fabsf(x0.y)), fmaxf(fabsf(x0.z), fabsf(x0.w))), fmaxf(fmaxf(fabsf(x1.x), fabsf(x1.y)), fmaxf(fabsf(x1.z), fabsf(x1.w))));
        am = fmaxf(am, fmaxf(fmaxf(fmaxf(fabsf(x2.x), fabsf(x2.y)), fmaxf(fabsf(x2.z), fabsf(x2.w))), fmaxf(fmaxf(fabsf(x3.x), fabsf(x3.y)), fmaxf(fabsf(x3.z), fabsf(x3.w)))));
#pragma unroll
        for (int o = 1; o < 64; o <<= 1) am = fmaxf(am, __shfl_xor(am, o));
        am = fmaxf(am, 1e-30f);
        const float s = 384.f / am;
        v4u q;
        int w;
        w = __builtin_amdgcn_cvt_pk_fp8_f32(x0.x * s, x0.y * s, 0, false); w = __builtin_amdgcn_cvt_pk_fp8_f32(x0.z * s, x0.w * s, w, true); q.x = (unsigned)w;
        w = __builtin_amdgcn_cvt_pk_fp8_f32(x1.x * s, x1.y * s, 0, false); w = __builtin_amdgcn_cvt_pk_fp8_f32(x1.z * s, x1.w * s, w, true); q.y = (unsigned)w;
        w = __builtin_amdgcn_cvt_pk_fp8_f32(x2.x * s, x2.y * s, 0, false); w = __builtin_amdgcn_cvt_pk_fp8_f32(x2.z * s, x2.w * s, w, true); q.z = (unsigned)w;
        w = __builtin_amdgcn_cvt_pk_fp8_f32(x3.x * s, x3.y * s, 0, false); w = __builtin_amdgcn_cvt_pk_fp8_f32(x3.z * s, x3.w * s, w, true); q.w = (unsigned)w;
        *(v4u*)(ws + WS_OV + (tb ? OV_UP : OV_DOWN) + (size_t)e * D + 16 * lane) = q;
        if (lane == 0) ((float*)(ws + WS_OV + OV_PSCALE))[it] = am * (1.f / 384.f);
    }
}

template <class TT> __device__ __forceinline__ void ce_desc(TT& a, TT& b) { const TT hi = a > b ? a : b, lo = a > b ? b : a; a = hi; b = lo; }
__device__ __forceinline__ void cef(float& a, float& b) { const float hi = fmaxf(a, b), lo = fminf(a, b); a = hi; b = lo; }
__device__ __forceinline__ void ced(double& a, double& b) { const double hi = fmax(a, b), lo = fmin(a, b); a = hi; b = lo; }
template <class TT, class CE> __device__ __forceinline__ void bitonic_sort16_desc(TT (&v)[16], CE ce) {
#pragma unroll
    for (int k = 2; k <= 16; k <<= 1)
#pragma unroll
        for (int j = k >> 1; j > 0; j >>= 1)
#pragma unroll
            for (int i = 0; i < 16; ++i) { const int p = i ^ j; if (p > i) { if ((i & k) == 0) ce(v[i], v[p]); else ce(v[p], v[i]); } }
}
template <class TT, class CE> __device__ __forceinline__ void bitonic_merge16_desc(TT (&v)[16], CE ce) {
#pragma unroll
    for (int j = 8; j > 0; j >>= 1)
#pragma unroll
        for (int i = 0; i < 16; ++i) { const int p = i ^ j; if (p > i) ce(v[i], v[p]); }
}
struct CEF { __device__ __forceinline__ void operator()(float& a, float& b) const { cef(a, b); } };
struct CED { __device__ __forceinline__ void operator()(double& a, double& b) const { ced(a, b); } };

__device__ __forceinline__ void top16_of_128(const bf16* p, float (&top)[16]) {
#pragma unroll
    for (int grp = 0; grp < 8; ++grp) {
        float cur[16];
        const v4u q0 = *(const v4u*)(p + grp * 16), q1 = *(const v4u*)(p + grp * 16 + 8);
        const unsigned w[8] = {q0.x, q0.y, q0.z, q0.w, q1.x, q1.y, q1.z, q1.w};
#pragma unroll
        for (int e = 0; e < 8; ++e) {
            const unsigned lo = w[e] << 16, hi = w[e] & 0xffff0000u;
            const unsigned i0 = grp * 16 + 2 * e, i1 = i0 + 1;
            cur[2 * e] = __builtin_bit_cast(float, lo | ((lo >> 31) ? i0 : (127u - i0)));
            cur[2 * e + 1] = __builtin_bit_cast(float, hi | ((hi >> 31) ? i1 : (127u - i1)));
        }
        bitonic_sort16_desc(cur, CEF());
        if (grp == 0) {
#pragma unroll
            for (int i = 0; i < 16; ++i) top[i] = cur[i];
        } else {
#pragma unroll
            for (int i = 0; i < 16; ++i) top[i] = fmaxf(top[i], cur[15 - i]);
            bitonic_merge16_desc(top, CEF());
        }
    }
}
__device__ __forceinline__ unsigned key_index(float k) { const unsigned u = __builtin_bit_cast(unsigned, k); const unsigned lo = u & 0x7fu; return (u >> 31) ? lo : 127u - lo; }
__device__ __forceinline__ float key_value(float k) { return __builtin_bit_cast(float, __builtin_bit_cast(unsigned, k) & 0xffff0000u); }

__device__ __forceinline__ void phase_peer_topk(const Ctx& c, KArgs& a) {
    unsigned char* ws = a.ws;
    const bf16* SC = (const bf16*)(ws + WS_OV + OV_SC);
    int* IDX = (int*)(ws + WS_OV + OV_IDX); float* GATE = (float*)(ws + WS_OV + OV_GATE);
    for (int it = c.bid * 512 + c.tid; it < M * 8; it += c.G * 512) {
        const bf16* p = SC + (size_t)it * 256;
        float t0[16], t1[16];
        top16_of_128(p, t0); top16_of_128(p + 128, t1);
        float v0[16], v1[16]; unsigned i0[16], i1[16];
#pragma unroll
        for (int i = 0; i < 16; ++i) { v0[i] = key_value(t0[i]); v1[i] = key_value(t1[i]); i0[i] = key_index(t0[i]); i1[i] = key_index(t1[i]); }
        double top[16];
        const double NEG = -1.0e300;
#pragma unroll
        for (int grp = 0; grp < 4; ++grp) {
            double cur[16];
#pragma unroll
            for (int s = 0; s < 16; ++s) cur[s] = NEG;
            int n = 0;
#pragma unroll
            for (int i = 0; i < 16; ++i)
#pragma unroll
                for (int j = 0; j < 16; ++j) if ((i + 1) * (j + 1) <= 16) {
                    if (n / 16 == grp) {
                        const double d = (double)(v0[i] + v1[j]);
                        const unsigned long long eid = (unsigned long long)(i0[i] * 128u + i1[j]);
                        const unsigned long long bits = __builtin_bit_cast(unsigned long long, d);
                        cur[n % 16] = __builtin_bit_cast(double, bits | ((bits >> 63) ? eid : (16383ull - eid)));
                    }
                    ++n;
                }
            bitonic_sort16_desc(cur, CED());
            if (grp == 0) {
#pragma unroll
                for (int i = 0; i < 16; ++i) top[i] = cur[i];
            } else {
#pragma unroll
                for (int i = 0; i < 16; ++i) top[i] = fmax(top[i], cur[15 - i]);
                bitonic_merge16_desc(top, CED());
            }
        }
        float sv[16]; int id[16];
#pragma unroll
        for (int i = 0; i < 16; ++i) { const unsigned long long bits = __builtin_bit_cast(unsigned long long, top[i]); const unsigned lo = (unsigned)(bits & 0x3fffull);
            id[i] = (int)((bits >> 63) ? lo : 16383u - lo); sv[i] = (float)top[i]; }
        float den = 0.f, ex[16];
#pragma unroll
        for (int i = 0; i < 16; ++i) { ex[i] = __expf(sv[i] - sv[0]); den += ex[i]; }
        const float inv = 1.f / den;
        unsigned cw[4] = {0u, 0u, 0u, 0u};
#pragma unroll
        for (int i = 0; i < 16; ++i) { const unsigned s = (unsigned)id[i] >> PEER_SLICE_SHIFT, inc = 1u << (8 * (s & 3)), ws_ = s >> 2;
            cw[0] += ws_ == 0 ? inc : 0u; cw[1] += ws_ == 1 ? inc : 0u; cw[2] += ws_ == 2 ? inc : 0u; cw[3] += ws_ == 3 ? inc : 0u; }
        unsigned lp[4], tot[4], st[4];
        const int l8 = c.lane & 7;
#pragma unroll
        for (int k = 0; k < 4; ++k) { unsigned v = cw[k];
#pragma unroll
            for (int o = 1; o < 8; o <<= 1) { const unsigned y = __shfl_up(v, o, 8); v += (l8 >= o) ? y : 0u; }
            tot[k] = __shfl(v, 7, 8); lp[k] = v - cw[k]; }
        {   unsigned carry = 0u;
#pragma unroll
            for (int k = 0; k < 4; ++k) { st[k] = tot[k] * 0x01010100u + carry * 0x01010101u; carry += (tot[k] * 0x01010101u) >> 24; } }
        unsigned run[4] = {st[0] + lp[0], st[1] + lp[1], st[2] + lp[2], st[3] + lp[3]};
        const size_t tok = (size_t)(it >> 3);
#pragma unroll
        for (int i = 0; i < 16; ++i) { const unsigned s = (unsigned)id[i] >> PEER_SLICE_SHIFT, sh = 8 * (s & 3), ws_ = s >> 2, inc = 1u << sh;
            const unsigned wsel = ws_ == 0 ? run[0] : (ws_ == 1 ? run[1] : (ws_ == 2 ? run[2] : run[3]));
            const unsigned pos = (wsel >> sh) & 0xffu;
            run[0] += ws_ == 0 ? inc : 0u; run[1] += ws_ == 1 ? inc : 0u; run[2] += ws_ == 2 ? inc : 0u; run[3] += ws_ == 3 ? inc : 0u;
            IDX[tok * 128 + pos] = id[i]; GATE[tok * 128 + pos] = ex[i] * inv; }
        if (l8 == 0) ((v4u*)(ws + WS_OV + OV_POFF))[tok] = (v4u){st[0], st[1], st[2], st[3]};
    }
}

__device__ __forceinline__ float gelu_tanh(float x) { const float u = 0.7978845608f * (x + 0.044715f * x * x * x); const float t = 1.f - 2.f / (1.f + __expf(2.f * u)); return 0.5f * x * (1.f + t); }
__device__ __forceinline__ void unpack16_fp8(const v4u& q, float (&o)[16]) {
    const unsigned w[4] = {q.x, q.y, q.z, q.w};
#pragma unroll
    for (int i = 0; i < 4; ++i) { const f32x2 lo = __builtin_amdgcn_cvt_pk_f32_fp8((int)w[i], false), hi = __builtin_amdgcn_cvt_pk_f32_fp8((int)w[i], true);
        o[4 * i] = lo.x; o[4 * i + 1] = lo.y; o[4 * i + 2] = hi.x; o[4 * i + 3] = hi.y; }
}
__device__ __forceinline__ int slice_start(unsigned o0, unsigned o1, unsigned o2, unsigned o3, int s) {
    const unsigned wsel = s < 4 ? o0 : (s < 8 ? o1 : (s < 12 ? o2 : o3));
    return s >= PEER_NSLICE ? 128 : (int)((wsel >> (8 * (s & 3))) & 0xffu);
}
template <int MODE> __device__ __forceinline__ void phase_peer_down(const Ctx& c, KArgs& a, int l, int qset) {
    unsigned char* ws = a.ws;
    const unsigned char* U8 = ws + WS_OV + OV_U8; const float* XS = (const float*)(ws + WS_OV + OV_XS);
    const unsigned char* DN = ws + WS_OV + OV_DOWN;
    const int* IDX = (const int*)(ws + WS_OV + OV_IDX);
    const v4u* POFF = (const v4u*)(ws + WS_OV + OV_POFF);
    float* ACT = (float*)(ws + WS_OV + (qset ? 278 * MiB : OV_ACT));
    unsigned* QC = (unsigned*)(ws + WS_CTL) + CW_QUEUE + (qset * 2 + l) * PEER_NSLICE * 64;
    constexpr int RS = 528;
    LAS unsigned char* wb = c.lds + c.wave * (8192 + 16 * RS);
    LAS unsigned* lpk = (LAS unsigned*)wb;
    LAS unsigned char* RB = wb + 8192;
    const int lane = c.lane, r16 = lane & 15, q = lane >> 4, hsel = lane >> 5, l32 = lane & 31;
    constexpr int NBLK = M / 16;
    const int s_home = MODE == 2 ? ((c.bid >> 3) & (PEER_NSLICE - 1)) : (int)(xb_xcc_id() & (PEER_NSLICE - 1));
#pragma unroll 1
    for (int step = 0; step < PEER_NSLICE; ++step) {
        const int s = (s_home + step) & (PEER_NSLICE - 1);
#pragma unroll 1
        for (;;) {
            unsigned blk = 0u;
            if (lane == 0) blk = __hip_atomic_fetch_add(QC + s * 64, 1u, __ATOMIC_RELAXED, __HIP_MEMORY_SCOPE_AGENT);
            blk = (unsigned)__builtin_amdgcn_readfirstlane((int)blk);
            if (blk >= (unsigned)NBLK) break;
            const size_t mb = (size_t)blk * 16;
            v4u xb[16];
            { const unsigned char* xp = U8 + (mb + r16) * D + 16 * q;
#pragma unroll
              for (int j = 0; j < 16; ++j) xb[j] = *(const v4u*)(xp + 64 * j); }
            const float xs = XS[mb + r16];
            int pav = 0, nv = 0;
            if (lane < 16) { const v4u po = POFF[mb + lane]; pav = slice_start(po.x, po.y, po.z, po.w, s); nv = slice_start(po.x, po.y, po.z, po.w, s + 1) - pav; }
            int incl = nv;
#pragma unroll
            for (int o = 1; o < 16; o <<= 1) { const int y = __shfl_up(incl, o, 16); incl += (r16 >= o) ? y : 0; }
            const int offv = incl - nv;
            const int P = __builtin_amdgcn_readlane(incl, 15);
#pragma unroll
            for (int ti = 0; ti < 16; ++ti) { const int pa = __builtin_amdgcn_readlane(pav, ti), n = __builtin_amdgcn_readlane(nv, ti), off = __builtin_amdgcn_readlane(offv, ti);
                if (lane < n) lpk[off + lane] = (unsigned)IDX[(mb + ti) * 128 + pa + lane] | ((unsigned)ti << 14) | ((unsigned)(pa + lane) << 18);
                if (n > 64) { if (lane + 64 < n) lpk[off + 64 + lane] = (unsigned)IDX[(mb + ti) * 128 + pa + 64 + lane] | ((unsigned)ti << 14) | ((unsigned)(pa + 64 + lane) << 18); } }
            asm volatile("s_waitcnt vmcnt(0) lgkmcnt(0)" ::: "memory");
            const int nb = (P + 15) >> 4;
#pragma unroll 1
            for (int b = 0; b < nb; ++b) {
                const v4u ia = *(const LAS v4u*)(lpk + b * 16 + 8 * hsel), ib = *(const LAS v4u*)(lpk + b * 16 + 8 * hsel + 4);
                const unsigned pw[8] = {ia.x, ia.y, ia.z, ia.w, ib.x, ib.y, ib.z, ib.w};
                v4u rr[16];
#pragma unroll
                for (int h = 0; h < 2; ++h)
#pragma unroll
                    for (int i = 0; i < 8; ++i) { const unsigned id = MODE == 1 ? (pw[i] & 63u) : (pw[i] & 16383u);
                        rr[8 * h + i] = *(const v4u*)(DN + (size_t)(id * 1024u + 512u * h + 16u * l32)); }
                const v4u mt = *(const LAS v4u*)(lpk + b * 16 + 4 * q);
                f32x4 acc0 = {0.f, 0.f, 0.f, 0.f}, acc1 = {0.f, 0.f, 0.f, 0.f};
#pragma unroll
                for (int h = 0; h < 2; ++h) {
#pragma unroll
                    for (int i = 0; i < 8; ++i) *(LAS v4u*)(RB + (8 * hsel + i) * RS + 16 * l32) = rr[8 * h + i];
#pragma unroll
                    for (int jj = 0; jj < 8; ++jj) {
                        const v4u av = *(const LAS v4u*)(RB + r16 * RS + 64 * jj + 16 * q);
                        const v4u bv = xb[8 * h + jj];
                        const long a0 = (long)(((unsigned long long)av.y << 32) | av.x), a1 = (long)(((unsigned long long)av.w << 32) | av.z);
                        const long b0 = (long)(((unsigned long long)bv.y << 32) | bv.x), b1 = (long)(((unsigned long long)bv.w << 32) | bv.z);
                        acc0 = __builtin_amdgcn_mfma_f32_16x16x32_fp8_fp8(a0, b0, acc0, 0, 0, 0);
                        acc1 = __builtin_amdgcn_mfma_f32_16x16x32_fp8_fp8(a1, b1, acc1, 0, 0, 0);
                    }
                }
                const f32x4 dv = (acc0 + acc1) * xs;
                const unsigned me[4] = {mt.x, mt.y, mt.z, mt.w};
                const float dd[4] = {dv.x, dv.y, dv.z, dv.w};
#pragma unroll
                for (int i = 0; i < 4; ++i) if (b * 16 + 4 * q + i < P && (int)((me[i] >> 14) & 15u) == r16) ACT[(mb + r16) * 128 + ((me[i] >> 18) & 127u)] = dd[i];
            }
        }
    }
}

template <int FUSE> __device__ __forceinline__ void phase_peer_experts(const Ctx& c, KArgs& a, const float* gnext, const bool commit = true) {
    unsigned char* ws = a.ws;
    const bf16* U = (const bf16*)(ws + WS_U);
    const unsigned char* DN = ws + WS_OV + OV_DOWN; const unsigned char* UP = ws + WS_OV + OV_UP;
    const float* SCD = (const float*)(ws + WS_OV + OV_PSCALE); const float* SCU = SCD + NEXP;
    const int* IDX = (const int*)(ws + WS_OV + OV_IDX); const float* GATE = (const float*)(ws + WS_OV + OV_GATE);
    const float* ACT = (const float*)(ws + WS_OV + OV_ACT);
    float* H = a.out;
    constexpr int TPW = 16;
    LAS float* wlw = (LAS float*)c.lds + c.wave * (TPW * 128);
    const int lane = c.lane;
    const int gw = c.bid * 8 + c.wave, NGW = c.G * 8;
    const int esel = ((lane & 32) ? 8 : 0) + ((lane & 16) ? 4 : 0) + ((lane & 8) ? 2 : 0) + ((lane & 4) ? 1 : 0);
    const f32x4 gn0 = *(const f32x4*)(gnext + lane * 16), gn1 = *(const f32x4*)(gnext + lane * 16 + 4), gn2 = *(const f32x4*)(gnext + lane * 16 + 8), gn3 = *(const f32x4*)(gnext + lane * 16 + 12);
    for (int m0 = gw; m0 < M; m0 += NGW * TPW) {
#pragma unroll 1
        for (int ti = 0; ti < TPW; ++ti) {
            const int m = m0 + ti * NGW; if (m >= M) break;
            LAS float* wl = wlw + ti * 128;
            const int id0 = IDX[(size_t)m * 128 + lane], id1 = IDX[(size_t)m * 128 + 64 + lane];
            const float g0 = GATE[(size_t)m * 128 + lane], g1 = GATE[(size_t)m * 128 + 64 + lane];
            const float a0 = ACT[(size_t)m * 128 + lane], a1 = ACT[(size_t)m * 128 + 64 + lane];
            wl[lane] = g0 * gelu_tanh(a0 * SCD[id0]) * SCU[id0]; wl[64 + lane] = g1 * gelu_tanh(a1 * SCD[id1]) * SCU[id1];
        }
        asm volatile("s_waitcnt lgkmcnt(0)" ::: "memory");
#pragma unroll 1
        for (int ti = 0; ti < TPW; ++ti) {
            const int m = m0 + ti * NGW; if (m >= M) break;
            const LAS float* wl = wlw + ti * 128;
            const int id0 = IDX[(size_t)m * 128 + lane], id1 = IDX[(size_t)m * 128 + 64 + lane];
            float acc[16];
#pragma unroll
            for (int q = 0; q < 16; ++q) acc[q] = 0.f;
#pragma unroll 1
            for (int bt = 0; bt < 8; ++bt) {
                v4u rr[16];
#pragma unroll
                for (int k = 0; k < 16; ++k) {
                    const int ei = bt * 16 + k;
                    const int row = __builtin_amdgcn_readlane(ei < 64 ? id0 : id1, ei & 63);
                    rr[k] = *(const v4u*)(UP + (size_t)row * D + lane * 16);
                }
#pragma unroll
                for (int k = 0; k < 16; ++k) {
                    const float w = wl[bt * 16 + k];
                    float f[16]; unpack16_fp8(rr[k], f);
#pragma unroll
                    for (int q = 0; q < 16; ++q) acc[q] += w * f[q];
                }
            }
            if (!commit && acc[0] != 123456.789f) continue;
            f32x4* hp = (f32x4*)(H + (size_t)m * D + lane * 16);
            f32x4 h0 = hp[0], h1 = hp[1], h2 = hp[2], h3 = hp[3];
            h0 += (f32x4){acc[0], acc[1], acc[2], acc[3]}; h1 += (f32x4){acc[4], acc[5], acc[6], acc[7]};
            h2 += (f32x4){acc[8], acc[9], acc[10], acc[11]}; h3 += (f32x4){acc[12], acc[13], acc[14], acc[15]};
            float ss = (h0.x * h0.x + h0.y * h0.y) + (h0.z * h0.z + h0.w * h0.w) + (h1.x * h1.x + h1.y * h1.y) + (h1.z * h1.z + h1.w * h1.w)
                     + (h2.x * h2.x + h2.y * h2.y) + (h2.z * h2.z + h2.w * h2.w) + (h3.x * h3.x + h3.y * h3.y) + (h3.z * h3.z + h3.w * h3.w);
            const float rn = rsqrtf(sum64(ss) * (1.f / D) + 1e-6f);
            const f32x4 n0 = h0 * rn * gn0, n1 = h1 * rn * gn1, n2 = h2 * rn * gn2, n3 = h3 * rn * gn3;
            if (FUSE == 0) {
                hp[0] = h0; hp[1] = h1; hp[2] = h2; hp[3] = h3;
                v4u u0, u1; u0.x = pk2(n0.x, n0.y); u0.y = pk2(n0.z, n0.w); u0.z = pk2(n1.x, n1.y); u0.w = pk2(n1.z, n1.w);
                u1.x = pk2(n2.x, n2.y); u1.y = pk2(n2.z, n2.w); u1.z = pk2(n3.x, n3.y); u1.w = pk2(n3.z, n3.w);
                bf16* up_ = (bf16*)(ws + WS_U) + (size_t)m * D + lane * 16;
                *(v4u*)up_ = u0; *(v4u*)(up_ + 8) = u1;
            } else { hp[0] = n0; hp[1] = n1; hp[2] = n2; hp[3] = n3; }
        }
    }
}

constexpr int PH_PER_HALF = 11, PH_PER_LAYER = 1 + 2 * PH_PER_HALF + 5, N_PHASES = 1 + DEPTH * PH_PER_LAYER;
__device__ __forceinline__ Ctx make_ctx() {
    extern __shared__ __attribute__((aligned(16))) unsigned char lds_raw[];
    Ctx c; int t = threadIdx.x; asm volatile("" : "+v"(t)); c.lds = (LAS unsigned char*)lds_raw; c.tid = t; c.lane = t & 63; c.wave = __builtin_amdgcn_readfirstlane(t >> 6); c.G = gridDim.x; c.bid = blockIdx.x; return c; }
__device__ __forceinline__ KArgs* kargs_fresh() { KArgs* p = (KArgs*)__builtin_amdgcn_kernarg_segment_ptr(); asm volatile("" : "+s"(p)); return p; }
#define PH_BEGIN(K) if (lo <= (K) && (K) < hi) { const Ctx c = make_ctx(); KArgs& args = *kargs_fresh(); unsigned char* ws = args.ws; (void)ws;
#define PH_END(K)   if ((K) + 1 < hi) xcd_barrier(bar); }

template <int L, int HB> __device__ __forceinline__ void half_pass(const XcdBarrier& bar, const int lo, const int hi) {
    constexpr int P0 = 1 + L * PH_PER_LAYER + 1 + HB * PH_PER_HALF;
#define WIN ((const bf16*)(ws + WS_WIN + L * WIN_L))
#define Uh ((const bf16*)(ws + WS_U) + (size_t)HB * MH * D)
    PH_BEGIN(P0 + 0) {
        pg8::Gemm g{Uh, WIN, MH, N1P, D, D, 0}; pg8::StaticOrder S; S.init(MH, N1P, c.G, c.bid);
        pg8::EpiRow8<FStoreBf16> E{{(bf16*)(ws + WS_OV + OV_PR), N1P}};
        pg8::gemm_phase(c.lds, g, S, E); if (PROBE_DUP == 5) pg8::gemm_phase(c.lds, g, S, E); } PH_END(P0 + 0)
    PH_BEGIN(P0 + 1) if (PROBE_DUP == 6) phase_rwkv_prep(c, args, L, HB); phase_rwkv_prep(c, args, L, HB); PH_END(P0 + 1)
    PH_BEGIN(P0 + 2) {
        constexpr int NL = L == 0 ? 3072 : 4096;
        pg8::Gemm g{(const bf16*)(ws + WS_OV + OV_AL), (const bf16*)(ws + WS_WLORA + L * WLORA_L), MH, NL, KL, KL, 1}; pg8::StaticOrder S; S.init(MH, NL, c.G, c.bid);
        EpiLora E{(bf16*)(ws + WS_OV + OV_ELOG), (bf16*)(ws + WS_OV + OV_ASIG), (bf16*)(ws + WS_OV + OV_GG), (bf16*)(ws + WS_OV + OV_VMIX),
                               (const bf16*)(ws + WS_VF) + (size_t)HB * MH * D, args.in[I_W0] + (size_t)L * D, args.in[I_A0] + (size_t)L * D, args.in[I_V0]};
        pg8::gemm_phase(c.lds, g, S, E); } PH_END(P0 + 2)
    PH_BEGIN(P0 + 3) phase_rwkv_chunk_par(c, args, L, HB); PH_END(P0 + 3)
    PH_BEGIN(P0 + 4) if (PROBE_DUP == 8) phase_rwkv_chunk_seq(c, args, false); phase_rwkv_chunk_seq(c, args); PH_END(P0 + 4)
    PH_BEGIN(P0 + 5) {
        phase_rwkv_post(c, args, L, HB); __syncthreads();
        pg8::Gemm g{Uh, WIN + (size_t)N1P * D, MH, N2P, D, D, 0}; pg8::StaticOrder S; S.init(MH, N2P, c.G, c.bid);
        pg8::EpiRow8<FStoreBf16> E{{(bf16*)(ws + WS_OV + OV_PS), N2P}};
        pg8::gemm_phase(c.lds, g, S, E); if (PROBE_DUP == 5) pg8::gemm_phase(c.lds, g, S, E); } PH_END(P0 + 5)
    PH_BEGIN(P0 + 6) if (PROBE_DUP == 6) phase_ssd_conv(c, args, L); phase_ssd_conv(c, args, L); PH_END(P0 + 6)
    PH_BEGIN(P0 + 7) phase_ssd_scan(c, args, L); PH_END(P0 + 7)
    PH_BEGIN(P0 + 8) phase_ssd_post(c, args, L); PH_END(P0 + 8)
    PH_BEGIN(P0 + 9) {
      { pg8::Gemm g{Uh, WIN + (size_t)(N1P + N2P) * D, MH, D, D, D, 0}; pg8::StaticOrder S; S.init(MH, D, c.G, c.bid);
        pg8::EpiRow8<FSigmoidBf16> E{{(bf16*)(ws + WS_OV + OV_GATES), 2048}};
        pg8::gemm_phase(c.lds, g, S, E); }
      { pg8::Gemm g{Uh, WIN + (size_t)(N1P + N2P + D) * D, MH, D, D, D, 0}; pg8::StaticOrder S; S.init(MH, D, c.G, c.bid);
        pg8::EpiRow8<FSigmoidBf16> E{{(bf16*)(ws + WS_OV + OV_GATES) + 1024, 2048}};
        pg8::gemm_phase(c.lds, g, S, E); }
      {
        pg8::Gemm g{(const bf16*)(ws + WS_OV + OV_YA), (const bf16*)(ws + WS_WA) + (size_t)L * D * D, MH, D, D, D, 0}; pg8::StaticOrder S; S.init(MH, D, c.G, c.bid);
        pg8::EpiRow8<FMixA> E{{(const bf16*)(ws + WS_OV + OV_GATES), (bf16*)(ws + WS_OV + OV_MIXED)}};
        pg8::gemm_phase(c.lds, g, S, E); }
      {
        pg8::Gemm g{(const bf16*)(ws + WS_OV + OV_PS) + 2048, (const bf16*)(ws + WS_WB) + (size_t)L * D * 2048, MH, D, 2048, N2P, 0}; pg8::StaticOrder S; S.init(MH, D, c.G, c.bid);
        pg8::EpiRow8<FMixB> E{{(const bf16*)(ws + WS_OV + OV_GATES), (bf16*)(ws + WS_OV + OV_MIXED)}};
        pg8::gemm_phase(c.lds, g, S, E); } } PH_END(P0 + 9)
    PH_BEGIN(P0 + 10) {
        pg8::Gemm g{(const bf16*)(ws + WS_OV + OV_MIXED), (const bf16*)(ws + WS_WO) + (size_t)L * D * D, MH, D, D, D, 0}; pg8::StaticOrder S; S.init(MH, D, c.G, c.bid);
        pg8::EpiRow8<FResid> E{{(L == 0 ? args.in[I_X] : (const float*)args.out) + (size_t)HB * MH * D, args.out + (size_t)HB * MH * D}};
        pg8::gemm_phase(c.lds, g, S, E); } PH_END(P0 + 10)
#undef WIN
#undef Uh
}

template <int L> __device__ __forceinline__ void layer_pass(const XcdBarrier& bar, const int lo, const int hi) {
    constexpr int P0 = 1 + L * PH_PER_LAYER, P1 = P0 + 1 + 2 * PH_PER_HALF;
    PH_BEGIN(P0) if (L == 0) phase_rmsnorm(c, args.in[I_X], args.in[I_NMG], (bf16*)(ws + WS_U), nullptr); PH_END(P0)
    half_pass<L, 0>(bar, lo, hi);
    half_pass<L, 1>(bar, lo, hi);
    PH_BEGIN(P1 + 0) phase_rmsnorm_q8(c, args.out, args.in[I_NFG] + (size_t)L * D, (bf16*)(ws + WS_U), ws + WS_OV + OV_U8, (float*)(ws + WS_OV + OV_XS)); phase_peer_convert(c, args, L); PH_END(P1 + 0)
    PH_BEGIN(P1 + 1) {
        pg8::Gemm g{(const bf16*)(ws + WS_U), (const bf16*)(ws + WS_WQK) + (size_t)L * 2048 * D, M, 2048, D, D, 0}; pg8::StaticOrder S; S.init(M, 2048, c.G, c.bid);
        pg8::EpiRow8<FStoreBf16> E{{(bf16*)(ws + WS_OV + OV_SC), 2048}};
        pg8::gemm_phase(c.lds, g, S, E); } PH_END(P1 + 1)
    PH_BEGIN(P1 + 2) if (PROBE_DUP == 4) phase_peer_topk(c, args); phase_peer_topk(c, args); PH_END(P1 + 2)
    PH_BEGIN(P1 + 3) phase_peer_down<0>(c, args, L, 0); if (PROBE_DOWN >= 0) phase_peer_down<PROBE_DOWN < 0 ? 0 : PROBE_DOWN>(c, args, L, 1); PH_END(P1 + 3)
    PH_BEGIN(P1 + 4) phase_peer_experts<L == DEPTH - 1 ? 1 : 0>(c, args, L == DEPTH - 1 ? args.in[I_NFIN] : args.in[I_NMG] + (size_t)(L + 1) * D); PH_END(P1 + 4)
}

__global__ void __launch_bounds__(512, 2) mk_fwd(Args kargs_) {
    extern __shared__ __attribute__((aligned(16))) unsigned char lds_raw[];
    LAS unsigned char* lds0 = (LAS unsigned char*)lds_raw;
    unsigned char* ws0 = kargs_.ws;
    const int lo = kargs_.lo, hi = kargs_.hi;
    if (threadIdx.x < 4) ((LAS unsigned*)(lds0 + LDS_MISC))[threadIdx.x] = 0u;
    __syncthreads();
    XcdBarrier bar; bar.bar = (unsigned*)(ws0 + WS_CTL) + CW_BAR; bar.x = 0; bar.st = (volatile LAS unsigned*)(lds0 + LDS_MISC);
    if (hi - lo > 1) bar = xcd_barrier_post((unsigned*)(ws0 + WS_CTL) + CW_BAR, (volatile LAS unsigned*)(lds0 + LDS_MISC));
    PH_BEGIN(0) phase_prologue(c, args); PH_END(0)
    layer_pass<0>(bar, lo, hi);
    layer_pass<1>(bar, lo, hi);
}

extern "C" void kernel_launch(void* const* d_in, const int* in_sizes, int n_in, void* d_out, int out_size, void* d_ws, size_t ws_size, hipStream_t stream) {
    static int grid = 0;
    if (grid == 0) {
        if (n_in != 32 || out_size != M * D || ws_size < WS_END) { fprintf(stderr, "kernel_launch: unexpected problem (n_in %d, out %d, ws %zu < %zu)\n", n_in, out_size, ws_size, (size_t)WS_END); grid = -1; return; }
        int dev = 0, cus = 0, per_cu = 0;
        if (hipGetDevice(&dev) != hipSuccess || hipDeviceGetAttribute(&cus, hipDeviceAttributeMultiprocessorCount, dev) != hipSuccess) { grid = -1; return; }
        if (hipFuncSetAttribute((const void*)mk_fwd, hipFuncAttributeMaxDynamicSharedMemorySize, LDS_BYTES) != hipSuccess) { fprintf(stderr, "kernel_launch: hipFuncSetAttribute failed\n"); grid = -1; return; }
        if (hipOccupancyMaxActiveBlocksPerMultiprocessor(&per_cu, (const void*)mk_fwd, 512, LDS_BYTES) != hipSuccess || per_cu < 1) { fprintf(stderr, "kernel_launch: occupancy query says %d\n", per_cu); per_cu = 1; }
        (void)hipGetLastError();
        grid = cus;
    }
    if (grid < 0) return;
    (void)hipMemsetAsync((char*)d_ws + WS_CTL, 0, CTL_BYTES, stream);
    Args a{};
    for (int i = 0; i < 32; ++i) a.in[i] = (const float*)d_in[i];
    a.out = (float*)d_out; a.ws = (unsigned char*)d_ws;
#if MK_MULTI
    for (int p = 0; p < N_PHASES; ++p) { a.lo = p; a.hi = p + 1; hipLaunchKernelGGL(mk_fwd, dim3(grid), dim3(512), LDS_BYTES, stream, a); }
#else
    a.lo = 0; a.hi = N_PHASES;
    hipLaunchKernelGGL(mk_fwd, dim3(grid), dim3(512), LDS_BYTES, stream, a);
#endif
}
```

```cpp
#include <hip/hip_runtime.h>
#include <cstdio>
#include <cstdint>

#ifndef PROBE_DUP
#define PROBE_DUP 0
#endif
#ifndef MK_MULTI
#define MK_MULTI 0
#endif

#define GAS __attribute__((address_space(1)))
#define LAS __attribute__((address_space(3)))
typedef unsigned short bf16;
typedef unsigned v4u __attribute__((ext_vector_type(4)));
typedef unsigned v2u __attribute__((ext_vector_type(2)));
typedef float f32x4 __attribute__((ext_vector_type(4)));
typedef float f32x2 __attribute__((ext_vector_type(2)));
typedef short bf16x8 __attribute__((ext_vector_type(8)));
typedef __bf16 bf2_t __attribute__((ext_vector_type(2)));

constexpr int D = 1024, BATCH = 8, T = 4096, M = BATCH * T, MH = M / 2, DEPTH = 2;
constexpr int RW_PROJ = 3360, SSD_PROJ = 5152, IN_PROJ = 10560;
constexpr int N1P = 3584, N2P = 5120, N3P = 2048, NINP = N1P + N2P + N3P;
constexpr int DT_COL = RW_PROJ;
constexpr int KL = 384;
constexpr int NEXP = 16384;
#ifndef PROBE_DOWN
#define PROBE_DOWN -1
#endif
constexpr int PEER_SLICE_SHIFT = 11, PEER_NSLICE = NEXP >> PEER_SLICE_SHIFT;
constexpr int CW_QUEUE = 8192;

constexpr size_t MiB = 1u << 20;
constexpr size_t WS_CTL = 0, CTL_BYTES = 1 * MiB;
constexpr size_t WS_WIN = 1 * MiB;
constexpr size_t WIN_L = (size_t)NINP * D * 2;
constexpr size_t WS_WA = 44 * MiB;
constexpr size_t WS_WB = 48 * MiB;
constexpr size_t WS_WO = 56 * MiB;
constexpr size_t WS_WQK = 60 * MiB;
constexpr size_t WS_WLORA = 68 * MiB;
constexpr size_t WLORA_L = (size_t)4096 * KL * 2;
constexpr size_t WS_U = 74 * MiB;
constexpr size_t WS_VF = 138 * MiB;
constexpr size_t WS_OV = 202 * MiB;
constexpr size_t OV_PR = 0, OV_ELOG = 112 * MiB, OV_ASIG = 144 * MiB, OV_GG = 176 * MiB, OV_VMIX = 208 * MiB, OV_AL = 240 * MiB, OV_YA = 272 * MiB;
constexpr size_t OV_PS = 0, OV_XBC = 168 * MiB, OV_DT = 305 * MiB, OV_DA = 307 * MiB;
constexpr size_t OV_GATES = 168 * MiB, OV_MIXED = 232 * MiB;
constexpr size_t OV_DOWN = 0, OV_UP = 32 * MiB, OV_PSCALE = 48 * MiB  , OV_SC = 64 * MiB, OV_IDX = 192 * MiB, OV_GATE = 208 * MiB, OV_POFF = 224 * MiB  , OV_ACT = 226 * MiB  , OV_U8 = 244 * MiB  , OV_XS = 276 * MiB  ;
constexpr size_t OV_BON = 304 * MiB;
constexpr size_t WS_END = WS_OV + 309 * MiB;
static_assert(WS_WIN + 2 * WIN_L <= WS_WA, "map");

constexpr int LDS_BYTES = 147456;
constexpr int LDS_MISC = 145408;
constexpr int CW_BAR = 4096;

__device__ __forceinline__ unsigned f2bf(float f) { unsigned u = __builtin_bit_cast(unsigned, f); return (u + 0x7fffu + ((u >> 16) & 1u)) >> 16; }
__device__ __forceinline__ unsigned pk2(float lo, float hi) { unsigned r; asm volatile("v_cvt_pk_bf16_f32 %0, %1, %2" : "=v"(r) : "v"(lo), "v"(hi)); return r; }
typedef __bf16 bf16x2_t __attribute__((ext_vector_type(2)));
__device__ __forceinline__ unsigned pk2c(float lo, float hi) { bf16x2_t v; v.x = (__bf16)lo; v.y = (__bf16)hi; return __builtin_bit_cast(unsigned, v); }
__device__ __forceinline__ float bflo(unsigned u) { return __builtin_bit_cast(float, u << 16); }
__device__ __forceinline__ float bfhi(unsigned u) { return __builtin_bit_cast(float, u & 0xffff0000u); }
__device__ __forceinline__ float bf1(bf16 u) { return __builtin_bit_cast(float, ((unsigned)u) << 16); }
__device__ __forceinline__ float sigmoidf_(float x) { return 1.f / (1.f + __expf(-x)); }
__device__ __forceinline__ float siluf_(float x) { return x / (1.f + __expf(-x)); }
template <int CTRL> __device__ __forceinline__ float dpp_mov(float x) { return __int_as_float(__builtin_amdgcn_update_dpp(0, __float_as_int(x), CTRL, 0xF, 0xF, true)); }
__device__ __forceinline__ float sum4(float x) { x += dpp_mov<0xB1>(x); x += dpp_mov<0x4E>(x); return x; }
__device__ __forceinline__ float sum16(float x) { x += dpp_mov<0xB1>(x); x += dpp_mov<0x4E>(x); x += dpp_mov<0x141>(x); x += dpp_mov<0x140>(x); return x; }
__device__ __forceinline__ float sum64(float x) { x = sum16(x); x += __shfl_xor(x, 16); x += __shfl_xor(x, 32); return x; }
__device__ __forceinline__ void unpack8(const v4u& q, float (&o)[8]) { o[0] = bflo(q.x); o[1] = bfhi(q.x); o[2] = bflo(q.y); o[3] = bfhi(q.y); o[4] = bflo(q.z); o[5] = bfhi(q.z); o[6] = bflo(q.w); o[7] = bfhi(q.w); }
__device__ __forceinline__ v4u pack8(const float (&o)[8]) { v4u q; q.x = pk2(o[0], o[1]); q.y = pk2(o[2], o[3]); q.z = pk2(o[4], o[5]); q.w = pk2(o[6], o[7]); return q; }

typedef short s16x4 __attribute__((ext_vector_type(4)));
__device__ __forceinline__ void lds_barrier() { asm volatile("s_waitcnt lgkmcnt(0)\n\ts_barrier" ::: "memory"); }
__device__ __forceinline__ bf16x8 tr_frag(unsigned base_bytes, int stride, int k0, int c0, int lane) {
    const int i16 = lane & 15, qq = i16 >> 2, p = i16 & 3, q = lane >> 4;
    const unsigned a0 = base_bytes + (unsigned)(((k0 + 8 * q + qq) * stride + c0 + 4 * p) * 2), a1 = a0 + (unsigned)(8 * stride);
    s16x4 lo, hi;
    asm volatile("ds_read_b64_tr_b16 %0, %2\n\tds_read_b64_tr_b16 %1, %3\n\ts_waitcnt lgkmcnt(0)" : "=&v"(lo), "=&v"(hi) : "v"(a0), "v"(a1) : "memory");
    return __builtin_shufflevector(lo, hi, 0, 1, 2, 3, 4, 5, 6, 7);
}

namespace pg8 {
constexpr int BM = 256, BK = 64, HALF = 128, HTB = HALF * BK * 2, STAGE_BYTES = 8 * HTB, NXCD = 8, WGM = 8;
__host__ __device__ __forceinline__ int lds_byte(int r, int c) { const int st = (r >> 4) * 2 + (c >> 5), rr = r & 15, cc = c & 31, ob = rr * 64 + cc * 2; return st * 1024 + (ob ^ (((ob >> 9) & 1) << 5)); }
__host__ __device__ __forceinline__ void stage_rc(int b, int& R, int& C) { const int st = b / 1024, sb = b % 1024, swz = sb ^ (((sb >> 9) & 1) << 5); R = (st >> 1) * 16 + swz / 64; C = (st & 1) * 32 + (swz % 64) / 2; }
__host__ __device__ __forceinline__ int perm32(int rho) { const int n = rho >> 4, i = rho & 15; return 8 * (i >> 2) + 4 * n + (i & 3); }
struct Unit { int pm, pn; };
struct Gemm { const bf16* A; const bf16* Bt; int M, N, K, lda; int kwin; };
__device__ __forceinline__ void unit_kwin(const Gemm& g, const Unit& u, int& k0t, int& ntl) { k0t = 0; ntl = g.K / BK; if (g.kwin) { const int blk = u.pn >> 2; if (blk < 2) { k0t = 0; ntl = 2; } else if (blk == 2) { k0t = 2; ntl = 4; } else { k0t = 4; ntl = 2; } } }
struct StaticOrder {
    int nM, nN, nwg, G, c;
    __device__ void init(int M_, int N_, int G_, int c_) { nM = M_ / BM; nN = N_ / BM; nwg = nM * nN; G = G_; c = c_; }
    __device__ bool next(int i, Unit& u) const {
        const long L = (long)i * G + c; if (L >= nwg) return false;
        int wgid = (int)L; { const int q = nwg / NXCD, r = nwg % NXCD, xcd = wgid % NXCD, off = wgid / NXCD; wgid = (xcd < r ? xcd * (q + 1) : r * (q + 1) + (xcd - r) * q) + off; }
        const int nig = WGM * nN, gid = wgid / nig, fm = gid * WGM, gsz = (nM - fm) < WGM ? (nM - fm) : WGM;
        u.pm = fm + ((wgid % nig) % gsz); u.pn = (wgid % nig) / gsz; return true;
    }
};
template <class F> struct EpiRow8 {
    static constexpr bool PERM = true;
    F f;
    __device__ __forceinline__ void operator()(const f32x4 (&acc)[2][2][4][2], const Unit& u, int wr, int wc, int fr, int fq) const {
        const int row0 = u.pm * BM + wr * 64 + fr, col0 = u.pn * BM + wc * 32 + 8 * fq;
#pragma unroll
        for (int g0 = 0; g0 < 16; g0 += F::GRP) {
            typename F::Tmp t[F::GRP];
#pragma unroll
            for (int j = 0; j < F::GRP; ++j) { const int i = g0 + j, ai = i >> 3, m = (i >> 1) & 3, bj = i & 1; f.load(row0 + ai * HALF + m * 16, col0 + bj * HALF, u.pn, t[j]); }
#pragma unroll
            for (int j = 0; j < F::GRP; ++j) { const int i = g0 + j, ai = i >> 3, m = (i >> 1) & 3, bj = i & 1; f.apply(row0 + ai * HALF + m * 16, col0 + bj * HALF, acc[ai][bj][m][0], acc[ai][bj][m][1], u.pn, t[j]); }
        }
    }
};


template <class Epi>
__device__ __forceinline__ void gemm_phase(LAS unsigned char* lds, const Gemm g, const StaticOrder& S, const Epi& E) {
    const int tid = threadIdx.x, wid = __builtin_amdgcn_readfirstlane(tid >> 6), lane = tid & 63, wr = wid >> 2, wc = wid & 3, fr = lane & 15, fq = lane >> 4;
    const int K = g.K, lda = g.lda;
    unsigned voffA[2], voffB[2];
#pragma unroll
    for (int i = 0; i < 2; ++i) { int R, C; stage_rc(tid * 16 + i * 8192, R, C); const int Rb = Epi::PERM ? ((R & ~31) + perm32(R & 31)) : R;
        voffA[i] = (unsigned)(R * lda + C) * 2u; voffB[i] = (unsigned)(Rb * K + C) * 2u; }
    const size_t kstep = (size_t)(BK * 2);
    const size_t hstepA = (size_t)HALF * lda * 2, hstepB = (size_t)HALF * K * 2;
    const size_t tstepA = 2 * hstepA, tstepB = 2 * hstepB;
    const unsigned ldsw = (unsigned)wid * 1024u;
    const int aoff = lds_byte(wr * 64 + fr, fq * 8), boff = lds_byte(wc * 32 + fr, fq * 8);
#define PG8_SA(b, h) (((b) * 2 + (h)) * HTB)
#define PG8_SB(b, h) ((4 + (b) * 2 + (h)) * HTB)
#define PG8_STAGE(bufoff, gbase, voff) do { _Pragma("unroll") for (int _i = 0; _i < 2; ++_i) \
        __builtin_amdgcn_global_load_lds((const unsigned*)((const char*)(gbase) + (voff)[_i]), (LAS unsigned*)(lds + (bufoff) + ldsw + _i * 8192), 16, 0, 0); } while (0)
#define PG8_LDA(dst, b, h) do { _Pragma("unroll") for (int m = 0; m < 4; ++m) _Pragma("unroll") for (int k = 0; k < 2; ++k) dst[m][k] = *(const LAS bf16x8*)(lds + PG8_SA(b, h) + aoff + m * 2048 + k * 1024); } while (0)
#define PG8_LDB(dst, b, h) do { _Pragma("unroll") for (int n = 0; n < 2; ++n) _Pragma("unroll") for (int k = 0; k < 2; ++k) dst[n][k] = *(const LAS bf16x8*)(lds + PG8_SB(b, h) + boff + n * 2048 + k * 1024); } while (0)
#define PG8_MMA(ai, bj, At, Bt) do { __builtin_amdgcn_s_setprio(1); _Pragma("unroll") for (int m = 0; m < 4; ++m) _Pragma("unroll") for (int n = 0; n < 2; ++n) _Pragma("unroll") for (int k = 0; k < 2; ++k) \
        acc[ai][bj][m][n] = __builtin_amdgcn_mfma_f32_16x16x32_bf16(Bt[n][k], At[m][k], acc[ai][bj][m][n], 0, 0, 0); __builtin_amdgcn_s_setprio(0); } while (0)
#define PG8_WAIT_V(n) asm volatile("s_waitcnt vmcnt(" #n ")" ::: "memory")
#define PG8_WAIT_L(n) asm volatile("s_waitcnt lgkmcnt(" #n ")" ::: "memory")
#define PG8_BAR __builtin_amdgcn_s_barrier()
#define PG8_SCHED __builtin_amdgcn_sched_barrier(0)
    Unit cur, nxt; int ui = 0;
    if (!S.next(0, cur)) return;
    f32x4 acc[2][2][4][2];
#pragma unroll
    for (int a = 0; a < 2; ++a)
#pragma unroll
        for (int b = 0; b < 2; ++b)
#pragma unroll
            for (int m = 0; m < 4; ++m)
#pragma unroll
                for (int n = 0; n < 2; ++n) acc[a][b][m][n] = (f32x4){0.f, 0.f, 0.f, 0.f};
    bf16x8 At[4][2], B0[2][2], B1[2][2];
    int k0c, nt; unit_kwin(g, cur, k0c, nt);
    const char* cA = (const char*)g.A + (size_t)cur.pm * tstepA + (size_t)k0c * kstep; const char* cB = (const char*)g.Bt + (size_t)cur.pn * tstepB + (size_t)k0c * kstep;
    PG8_STAGE(PG8_SB(0, 0), cB, voffB); PG8_STAGE(PG8_SA(0, 0), cA, voffA); PG8_STAGE(PG8_SB(0, 1), cB + hstepB, voffB); PG8_STAGE(PG8_SA(0, 1), cA + hstepA, voffA);
    if (wr == 1) PG8_BAR;
    PG8_WAIT_V(4); PG8_BAR;
    PG8_STAGE(PG8_SB(1, 0), cB + kstep, voffB); PG8_STAGE(PG8_SA(1, 0), cA + kstep, voffA); PG8_STAGE(PG8_SB(1, 1), cB + hstepB + kstep, voffB);
    PG8_WAIT_V(6); PG8_BAR;
    for (;;) {
        const bool has_next = S.next(ui + 1, nxt);
        int k0n = 0, ntn = nt; if (has_next) unit_kwin(g, nxt, k0n, ntn);
        const char* nA = has_next ? (const char*)g.A + (size_t)nxt.pm * tstepA + (size_t)k0n * kstep : cA; const char* nB = has_next ? (const char*)g.Bt + (size_t)nxt.pn * tstepB + (size_t)k0n * kstep : cB;
        for (int t = 0; t < nt; t += 2) {
            const bool last = (t == nt - 2);
            const char* a1 = cA + (size_t)(t + 1) * kstep;
            const char* a2 = last ? nA : cA + (size_t)(t + 2) * kstep; const char* b2 = last ? nB : cB + (size_t)(t + 2) * kstep;
            const char* a3 = a2 + kstep; const char* b3 = b2 + kstep;
            PG8_LDB(B0, 0, 0); PG8_SCHED; PG8_LDA(At, 0, 0); PG8_STAGE(PG8_SA(1, 1), a1 + hstepA, voffA);
            PG8_WAIT_L(8); PG8_BAR; PG8_WAIT_L(0); PG8_MMA(0, 0, At, B0); PG8_BAR; PG8_SCHED;
            PG8_LDB(B1, 0, 1); PG8_STAGE(PG8_SB(0, 0), b2, voffB);
            PG8_BAR; PG8_WAIT_L(0); PG8_MMA(0, 1, At, B1); PG8_BAR;
            PG8_LDA(At, 0, 1); PG8_STAGE(PG8_SA(0, 0), a2, voffA);
            PG8_BAR; PG8_WAIT_L(0); PG8_MMA(1, 0, At, B0); PG8_BAR; PG8_SCHED;
            PG8_STAGE(PG8_SB(0, 1), b2 + hstepB, voffB);
            PG8_WAIT_V(6); PG8_BAR; PG8_MMA(1, 1, At, B1); PG8_BAR;
            PG8_LDB(B0, 1, 0); PG8_SCHED; PG8_LDA(At, 1, 0); PG8_STAGE(PG8_SA(0, 1), a2 + hstepA, voffA);
            PG8_WAIT_L(8); PG8_BAR; PG8_WAIT_L(0); PG8_MMA(0, 0, At, B0); PG8_BAR; PG8_SCHED;
            PG8_LDB(B1, 1, 1); PG8_STAGE(PG8_SB(1, 0), b3, voffB);
            PG8_BAR; PG8_WAIT_L(0); PG8_MMA(0, 1, At, B1); PG8_BAR;
            PG8_LDA(At, 1, 1); PG8_STAGE(PG8_SA(1, 0), a3, voffA);
            PG8_BAR; PG8_WAIT_L(0); PG8_MMA(1, 0, At, B0); PG8_BAR; PG8_SCHED;
            PG8_STAGE(PG8_SB(1, 1), b3 + hstepB, voffB);
            PG8_WAIT_V(6); PG8_BAR; PG8_MMA(1, 1, At, B1); PG8_BAR;
        }
        E(acc, cur, wr, wc, fr, fq);
        if (!has_next) break;
#pragma unroll
        for (int a = 0; a < 2; ++a)
#pragma unroll
            for (int b = 0; b < 2; ++b)
#pragma unroll
                for (int m = 0; m < 4; ++m)
#pragma unroll
                    for (int n = 0; n < 2; ++n) acc[a][b][m][n] = (f32x4){0.f, 0.f, 0.f, 0.f};
        cur = nxt; cA = nA; cB = nB; nt = ntn; ++ui;
    }
    PG8_WAIT_V(0);
    if (wr == 0) PG8_BAR;
    PG8_BAR;
#undef PG8_SA
#undef PG8_SB
#undef PG8_STAGE
#undef PG8_LDA
#undef PG8_LDB
#undef PG8_MMA
#undef PG8_WAIT_V
#undef PG8_WAIT_L
#undef PG8_BAR
#undef PG8_SCHED
}
}

#define XB_TMO      128
#define XB_XCNT(j)  (256  + 64 * (j))
#define XB_XSUB(j)  (1280 + 64 * (j))
#define XB_XGEN(j)  (2304 + 64 * (j))
#define XB_TOP      3328
#define XB_TOPGEN   3392
#define XCD_BAR_WORDS 3456
#define XB_SPIN_CAP (1u << 18)
__device__ __forceinline__ unsigned xb_ld(unsigned* p)              { return __hip_atomic_load(p, __ATOMIC_RELAXED, __HIP_MEMORY_SCOPE_AGENT); }
__device__ __forceinline__ unsigned xb_add(unsigned* p, unsigned v) { return __hip_atomic_fetch_add(p, v, __ATOMIC_RELAXED, __HIP_MEMORY_SCOPE_AGENT); }
__device__ __forceinline__ unsigned xb_xcc_id() { return (unsigned)__builtin_amdgcn_s_getreg((3 << 11) | 20) & 0xFu; }
#define XB_SPIN(cond, bar) do { unsigned _sp = 0; while (cond) { __builtin_amdgcn_s_sleep(1); \
    if ((++_sp & 255u) == 0u) { if (xb_ld(&(bar)[XB_TMO])) break; if (_sp > XB_SPIN_CAP) { atomicAdd(&(bar)[XB_TMO], 1u); break; } } } } while (0)
struct XcdBarrier { unsigned* bar; unsigned x; volatile LAS unsigned* st; };
__device__ __forceinline__ XcdBarrier xcd_barrier_post(unsigned* bar, volatile LAS unsigned* st) {
    XcdBarrier b; b.bar = bar; b.x = xb_xcc_id(); b.st = st;
    if (threadIdx.x == 0) (void)xb_add(&bar[XB_XCNT(b.x)], 1u);
    return b;
}
__device__ __forceinline__ void xcd_barrier_complete(unsigned* bar, unsigned x, unsigned& nloc, unsigned& nx) {
    const unsigned G = gridDim.x * gridDim.y * gridDim.z;
    unsigned sum, cnt, mine, sp = 0u;
    for (;;) {
        sum = 0u; cnt = 0u; mine = 0u;
#pragma unroll
        for (unsigned j = 0; j < 16; ++j) { const unsigned c = xb_ld(&bar[XB_XCNT(j)]); sum += c; cnt += (c > 0u) ? 1u : 0u; mine = (j == x) ? c : mine; }
        if (sum == G) break;
        __builtin_amdgcn_s_sleep(1);
        if ((++sp & 255u) == 0u) { if (xb_ld(&bar[XB_TMO])) break; if (sp > XB_SPIN_CAP) { atomicAdd(&bar[XB_TMO], 1u); break; } }
    }
    nloc = mine > 0u ? mine : 1u; nx = cnt > 0u ? cnt : 1u;
}
__device__ __forceinline__ void xcd_barrier(const XcdBarrier& b) {
    asm volatile("s_waitcnt vmcnt(0)" ::: "memory");
    __syncthreads();
    if (threadIdx.x == 0) {
        unsigned* bar = b.bar;
        __builtin_amdgcn_s_waitcnt(0);
        unsigned nloc = b.st[0], nx = b.st[1];
        if (nloc == 0u) { xcd_barrier_complete(bar, b.x, nloc, nx); b.st[0] = nloc; b.st[1] = nx; }
        const unsigned old = xb_add(&bar[XB_XSUB(b.x)], 1u);
        const unsigned gen = old / nloc;
        if (old + 1u == (gen + 1u) * nloc) {
            __builtin_amdgcn_fence(__ATOMIC_RELEASE, "agent");
            asm volatile("s_waitcnt vmcnt(0)" ::: "memory");
            const unsigned og = xb_add(&bar[XB_TOP], 1u);
            const unsigned tg = og / nx;
            if (og + 1u == (tg + 1u) * nx) xb_add(&bar[XB_TOPGEN], 1u);
            else XB_SPIN(xb_ld(&bar[XB_TOPGEN]) == tg, bar);
            __builtin_amdgcn_fence(__ATOMIC_ACQUIRE, "agent");
            xb_add(&bar[XB_XGEN(b.x)], 1u);
            asm volatile("s_waitcnt vmcnt(0)" ::: "memory");
        } else {
            XB_SPIN(xb_ld(&bar[XB_XGEN(b.x)]) == gen, bar);
            __builtin_amdgcn_fence(__ATOMIC_ACQUIRE, "agent");
            asm volatile("s_waitcnt vmcnt(0)" ::: "memory");
        }
    }
    __syncthreads();
}

struct Args { const float* in[32]; float* out; unsigned char* ws; int lo, hi; };
typedef const Args __attribute__((address_space(4))) KArgs;
enum { I_X = 0, I_NMG, I_WIN, I_MU, I_W0, I_W2, I_A0, I_A2, I_G2, I_V0, I_V1, I_V2, I_KK, I_KA, I_RK, I_LNW, I_LNB, I_WRB, I_CW, I_CB, I_DTB, I_ALOG, I_SD, I_SNG, I_WSB, I_WOUT, I_NFG, I_WQ, I_SK, I_PD, I_PU, I_NFIN };

struct NoTmp {};
struct FStoreBf16 { bf16* O; int ldc; typedef NoTmp Tmp; static constexpr int GRP = 16;
    __device__ __forceinline__ void load(int, int, int, Tmp&) const {}
    __device__ __forceinline__ void apply(int row, int col, f32x4 v0, f32x4 v1, int, const Tmp&) const {
        v4u w; w.x = pk2(v0[0], v0[1]); w.y = pk2(v0[2], v0[3]); w.z = pk2(v1[0], v1[1]); w.w = pk2(v1[2], v1[3]);
        *(v4u*)(O + (size_t)row * ldc + col) = w; } };
struct FSigmoidBf16 { bf16* O; int ldc; typedef NoTmp Tmp; static constexpr int GRP = 16;
    __device__ __forceinline__ void load(int, int, int, Tmp&) const {}
    __device__ __forceinline__ void apply(int row, int col, f32x4 v0, f32x4 v1, int, const Tmp&) const {
        v4u w; w.x = pk2(sigmoidf_(v0[0]), sigmoidf_(v0[1])); w.y = pk2(sigmoidf_(v0[2]), sigmoidf_(v0[3])); w.z = pk2(sigmoidf_(v1[0]), sigmoidf_(v1[1])); w.w = pk2(sigmoidf_(v1[2]), sigmoidf_(v1[3]));
        *(v4u*)(O + (size_t)row * ldc + col) = w; } };
struct EpiLora {
    static constexpr bool PERM = true;
    bf16 *elog, *asig, *gg, *vmix; const bf16* vf; const float *w0, *a0, *v0;
    template <int BLK> __device__ __forceinline__ void run(const f32x4 (&acc)[2][2][4][2], int row0, int col0) const {
#pragma unroll
        for (int bj = 0; bj < 2; ++bj) {
            const int c = (col0 + bj * 128) & 1023;
            float bias[8];
            if (BLK == 0 || BLK == 1 || BLK == 3) { const float* bp = (BLK == 0 ? w0 : (BLK == 1 ? a0 : v0)) + c; const f32x4 b0 = *(const f32x4*)bp, b1 = *(const f32x4*)(bp + 4);
                bias[0] = b0[0]; bias[1] = b0[1]; bias[2] = b0[2]; bias[3] = b0[3]; bias[4] = b1[0]; bias[5] = b1[1]; bias[6] = b1[2]; bias[7] = b1[3]; }
#pragma unroll
            for (int ai = 0; ai < 2; ++ai) {
            v4u qvs[4], qvf[4];
            if (BLK == 3) {
#pragma unroll
                for (int i = 0; i < 4; ++i) { const size_t o = (size_t)(row0 + ai * 128 + i * 16) * D + c; qvs[i] = *(const v4u*)(vmix + o); qvf[i] = *(const v4u*)(vf + o); }
            }
#pragma unroll
                for (int m = 0; m < 4; ++m) {
                    const int row = row0 + ai * 128 + m * 16; const size_t o = (size_t)row * D + c;
                    const f32x4 v0_ = acc[ai][bj][m][0], v1_ = acc[ai][bj][m][1];
                    float a[8] = {v0_[0], v0_[1], v0_[2], v0_[3], v1_[0], v1_[1], v1_[2], v1_[3]};
                    if (BLK == 0) {
#pragma unroll
                        for (int e = 0; e < 8; ++e) a[e] = -0.6065306597f * sigmoidf_(bias[e] + a[e]);
                        *(v4u*)(elog + o) = pack8(a);
                    } else if (BLK == 1) {
#pragma unroll
                        for (int e = 0; e < 8; ++e) a[e] = sigmoidf_(bias[e] + a[e]);
                        *(v4u*)(asig + o) = pack8(a);
                    } else if (BLK == 2) {
                        *(v4u*)(gg + o) = pack8(a);
                    } else {
                        float vs[8], vfv[8]; unpack8(qvs[m], vs); unpack8(qvf[m], vfv);
#pragma unroll
                        for (int e = 0; e < 8; ++e) a[e] = vs[e] + (vfv[e] - vs[e]) * sigmoidf_(bias[e] + a[e]);
                        *(v4u*)(vmix + o) = pack8(a);
                    }
                }
            }
        }
    }
    __device__ __forceinline__ void operator()(const f32x4 (&acc)[2][2][4][2], const pg8::Unit& u, int wr, int wc, int fr, int fq) const {
        const int row0 = u.pm * 256 + wr * 64 + fr, col0 = u.pn * 256 + wc * 32 + 8 * fq;
        const int blk = u.pn >> 2;
        if (blk == 0) run<0>(acc, row0, col0); else if (blk == 1) run<1>(acc, row0, col0); else if (blk == 2) run<2>(acc, row0, col0); else run<3>(acc, row0, col0);
    }
};
struct FMixA { const bf16* gates; bf16* mixed;
    struct Tmp { v4u g; }; static constexpr int GRP = 8;
    __device__ __forceinline__ void load(int row, int col, int, Tmp& t) const { t.g = *(const v4u*)(gates + (size_t)row * 2048 + col); }
    __device__ __forceinline__ void apply(int row, int col, f32x4 v0, f32x4 v1, int, const Tmp& t) const {
        float g[8]; unpack8(t.g, g);
        float a[8] = {v0[0] * g[0], v0[1] * g[1], v0[2] * g[2], v0[3] * g[3], v1[0] * g[4], v1[1] * g[5], v1[2] * g[6], v1[3] * g[7]};
        *(v4u*)(mixed + (size_t)row * D + col) = pack8(a); } };
struct FMixB { const bf16* gates; bf16* mixed;
    struct Tmp { v4u g, mx; }; static constexpr int GRP = 8;
    __device__ __forceinline__ void load(int row, int col, int, Tmp& t) const { t.g = *(const v4u*)(gates + (size_t)row * 2048 + 1024 + col); t.mx = *(const v4u*)(mixed + (size_t)row * D + col); }
    __device__ __forceinline__ void apply(int row, int col, f32x4 v0, f32x4 v1, int, const Tmp& t) const {
        float g[8], mx[8]; unpack8(t.g, g); unpack8(t.mx, mx);
        float a[8] = {mx[0] + v0[0] * g[0], mx[1] + v0[1] * g[1], mx[2] + v0[2] * g[2], mx[3] + v0[3] * g[3], mx[4] + v1[0] * g[4], mx[5] + v1[1] * g[5], mx[6] + v1[2] * g[6], mx[7] + v1[3] * g[7]};
        *(v4u*)(mixed + (size_t)row * D + col) = pack8(a); } };
struct FResid { const float* base; float* h;
    struct Tmp { f32x4 a, b; }; static constexpr int GRP = 8;
    __device__ __forceinline__ void load(int row, int col, int, Tmp& t) const { const f32x4* s = (const f32x4*)(base + (size_t)row * D + col); t.a = s[0]; t.b = s[1]; }
    __device__ __forceinline__ void apply(int row, int col, f32x4 v0, f32x4 v1, int, const Tmp& t) const {
        f32x4* p = (f32x4*)(h + (size_t)row * D + col); p[0] = t.a + v0; p[1] = t.b + v1; } };

struct Ctx { int tid, lane, wave, G, bid; LAS unsigned char* lds; };

__device__ __forceinline__ void transpose_item(const float* W, int K, int N, bf16* WT, int row_off, LAS float* scr, int item, int lane) {
    const int nblk = N / 32, kb = item / nblk, nb = item % nblk, k0 = 64 * kb, n0 = 32 * nb;
#pragma unroll 8
    for (int i = 0; i < 32; ++i) { const int kk = 2 * i + (lane >> 5); scr[kk * 33 + (lane & 31)] = W[(size_t)(k0 + kk) * N + n0 + (lane & 31)]; }
    asm volatile("s_waitcnt lgkmcnt(0)" ::: "memory");
    const int c = lane & 7;
#pragma unroll
    for (int j = 0; j < 4; ++j) { const int n = (lane >> 3) + 8 * j; const LAS float* s = scr + (8 * c) * 33 + n;
        v4u o; o.x = pk2(s[0 * 33], s[1 * 33]); o.y = pk2(s[2 * 33], s[3 * 33]); o.z = pk2(s[4 * 33], s[5 * 33]); o.w = pk2(s[6 * 33], s[7 * 33]);
        *(v4u*)(WT + (size_t)(row_off + n0 + n) * K + k0 + 8 * c) = o; }
    asm volatile("s_waitcnt lgkmcnt(0)" ::: "memory");
}
__device__ __forceinline__ int winrow(int n) {
    if (n < RW_PROJ) return n;
    if (n < RW_PROJ + 5120) return N1P + (n - RW_PROJ);
    if (n < RW_PROJ + SSD_PROJ) return DT_COL + (n - RW_PROJ - 5120);
    return N1P + N2P + (n - RW_PROJ - SSD_PROJ); }

__device__ __forceinline__ void phase_prologue(const Ctx& c, KArgs& a) {
    unsigned char* ws = a.ws;
    LAS float* scr = (LAS float*)(c.lds + c.wave * 16384);
    const int gw = c.bid * 8 + c.wave, NGW = c.G * 8;
    constexpr int I_IN = 16 * (IN_PROJ / 32), I_A = 16 * 32, I_B = 32 * 32, I_O = 16 * 32, I_L = I_IN + I_A + I_B + I_O;
    for (int it = gw; it < 2 * I_L; it += NGW) {
        const int l = it / I_L; int r = it % I_L;
        if (r < I_IN) { const int nb = r % (IN_PROJ / 32); transpose_item(a.in[I_WIN] + (size_t)l * D * IN_PROJ, D, IN_PROJ, (bf16*)(ws + WS_WIN + l * WIN_L), winrow(nb * 32) - nb * 32, scr, r, c.lane); continue; } r -= I_IN;
        if (r < I_A) { transpose_item(a.in[I_WRB] + (size_t)l * D * D, D, D, (bf16*)(ws + WS_WA) + (size_t)l * D * D, 0, scr, r, c.lane); continue; } r -= I_A;
        if (r < I_B) { transpose_item(a.in[I_WSB] + (size_t)l * 2048 * D, 2048, D, (bf16*)(ws + WS_WB) + (size_t)l * D * 2048, 0, scr, r, c.lane); continue; } r -= I_B;
        transpose_item(a.in[I_WOUT] + (size_t)l * D * D, D, D, (bf16*)(ws + WS_WO) + (size_t)l * D * D, 0, scr, r, c.lane);
    }
    for (int it = c.bid * 512 + c.tid; it < 2 * 192 * 128; it += c.G * 512) {
        const int l = it / (192 * 128), r = (it / 128) % 192, q = it % 128;
        *(v4u*)((bf16*)(ws + WS_WIN + l * WIN_L) + (size_t)(DT_COL + 32 + r) * D + q * 8) = (v4u){0u, 0u, 0u, 0u};
    }
    for (int it = c.bid * 512 + c.tid; it < 2 * 4096 * KL; it += c.G * 512) {
        const int l = it / (4096 * KL), n = (it / KL) % 4096, k = it % KL; const int blk = n >> 10, cc = n & 1023;
        float v = 0.f;
        if (blk == 0) { if (k < 64) v = a.in[I_W2][((size_t)l * 64 + k) * D + cc]; }
        else if (blk == 1) { if (k >= 64 && k < 128) v = a.in[I_A2][((size_t)l * 64 + (k - 64)) * D + cc]; }
        else if (blk == 2) { if (k >= 128 && k < 288) v = a.in[I_G2][((size_t)l * 160 + (k - 128)) * D + cc]; }
        else { if (l == 1 && k >= 288 && k < 320) v = a.in[I_V2][(size_t)(k - 288) * D + cc]; }
        ((bf16*)(ws + WS_WLORA + l * WLORA_L))[(size_t)n * KL + k] = (bf16)f2bf(v);
    }
    __syncthreads();
    LAS float* wqL = (LAS float*)c.lds;
    LAS float* kyL = (LAS float*)(c.lds + 32768);
    for (int it = c.bid; it < 2 * 16 * 16; it += c.G) {
        const int l = it >> 8, hc = (it >> 4) & 15, k0 = (it & 15) * 64;
        const float* wq = a.in[I_WQ] + (size_t)l * D * 2048; const float* ky = a.in[I_SK] + ((size_t)l * 16 + hc) * 128 * 128;
        for (int e = c.tid; e < 64 * 128; e += 512) wqL[e] = wq[(size_t)(k0 + (e >> 7)) * 2048 + hc * 128 + (e & 127)];
        for (int e = c.tid; e < 128 * 128; e += 512) kyL[(e >> 7) * 129 + (e & 127)] = ky[e];
        __syncthreads();
        const int key = c.tid & 127, kg = c.tid >> 7;
        float acc[16];
#pragma unroll
        for (int i = 0; i < 16; ++i) acc[i] = 0.f;
        for (int d = 0; d < 128; ++d) { const float kv = kyL[key * 129 + d];
#pragma unroll
            for (int i = 0; i < 16; ++i) acc[i] += wqL[(kg * 16 + i) * 128 + d] * kv; }
        bf16* o = (bf16*)(ws + WS_WQK) + ((size_t)l * 2048 + hc * 128 + key) * D + k0 + kg * 16;
        v4u q0, q1; q0.x = pk2(acc[0], acc[1]); q0.y = pk2(acc[2], acc[3]); q0.z = pk2(acc[4], acc[5]); q0.w = pk2(acc[6], acc[7]);
        q1.x = pk2(acc[8], acc[9]); q1.y = pk2(acc[10], acc[11]); q1.z = pk2(acc[12], acc[13]); q1.w = pk2(acc[14], acc[15]);
        *(v4u*)o = q0; *(v4u*)(o + 8) = q1;
        __syncthreads();
    }
}

__device__ __forceinline__ void phase_rmsnorm(const Ctx& c, const float* src, const float* g, bf16* U, float* copy_to) {
    const int gw = c.bid * 8 + c.wave, NGW = c.G * 8;
    f32x4 gv[4];
#pragma unroll
    for (int j = 0; j < 4; ++j) gv[j] = *((const f32x4*)g + c.lane + 64 * j);
    f32x4 nv[4];
    if (gw < M) { const f32x4* xr0 = (const f32x4*)(src + (size_t)gw * D) + c.lane;
#pragma unroll
        for (int j = 0; j < 4; ++j) nv[j] = xr0[64 * j]; }
    for (int m = gw; m < M; m += NGW) {
        f32x4 v[4]; float s = 0.f;
#pragma unroll
        for (int j = 0; j < 4; ++j) { v[j] = nv[j]; s += (v[j].x * v[j].x + v[j].y * v[j].y) + (v[j].z * v[j].z + v[j].w * v[j].w); }
        if (m + NGW < M) { const f32x4* xn = (const f32x4*)(src + (size_t)(m + NGW) * D) + c.lane;
#pragma unroll
            for (int j = 0; j < 4; ++j) nv[j] = xn[64 * j]; }
        if (copy_to) { f32x4* cr = (f32x4*)(copy_to + (size_t)m * D) + c.lane;
#pragma unroll
            for (int j = 0; j < 4; ++j) cr[64 * j] = v[j]; }
        const float r = rsqrtf(sum64(s) * (1.f / D) + 1e-6f);
        v2u* o = (v2u*)(U + (size_t)m * D) + c.lane;
#pragma unroll
        for (int j = 0; j < 4; ++j) { v2u w; w.x = pk2(v[j].x * r * gv[j].x, v[j].y * r * gv[j].y); w.y = pk2(v[j].z * r * gv[j].z, v[j].w * r * gv[j].w); o[64 * j] = w; }
    }
}
__device__ __forceinline__ void phase_rmsnorm_q8(const Ctx& c, const float* src, const float* g, bf16* U, unsigned char* U8, float* XS) {
    const int gw = c.bid * 8 + c.wave, NGW = c.G * 8;
    f32x4 gv[4];
#pragma unroll
    for (int j = 0; j < 4; ++j) gv[j] = *((const f32x4*)g + c.lane + 64 * j);
    f32x4 nv[4];
    if (gw < M) { const f32x4* xr0 = (const f32x4*)(src + (size_t)gw * D) + c.lane;
#pragma unroll
        for (int j = 0; j < 4; ++j) nv[j] = xr0[64 * j]; }
    for (int m = gw; m < M; m += NGW) {
        f32x4 v[4]; float s = 0.f;
#pragma unroll
        for (int j = 0; j < 4; ++j) { v[j] = nv[j]; s += (v[j].x * v[j].x + v[j].y * v[j].y) + (v[j].z * v[j].z + v[j].w * v[j].w); }
        if (m + NGW < M) { const f32x4* xn = (const f32x4*)(src + (size_t)(m + NGW) * D) + c.lane;
#pragma unroll
            for (int j = 0; j < 4; ++j) nv[j] = xn[64 * j]; }
        const float r = rsqrtf(sum64(s) * (1.f / D) + 1e-6f);
        float am = 0.f;
#pragma unroll
        for (int j = 0; j < 4; ++j) { v[j] = v[j] * r * gv[j]; am = fmaxf(am, fmaxf(fmaxf(fabsf(v[j].x), fabsf(v[j].y)), fmaxf(fabsf(v[j].z), fabsf(v[j].w)))); }
#pragma unroll
        for (int o = 1; o < 64; o <<= 1) am = fmaxf(am, __shfl_xor(am, o));
        am = fmaxf(am, 1e-30f);
        const float qs = 384.f / am;
        v2u* o = (v2u*)(U + (size_t)m * D) + c.lane;
        unsigned* o8 = (unsigned*)(U8 + (size_t)m * D) + c.lane;
#pragma unroll
        for (int j = 0; j < 4; ++j) { v2u w; w.x = pk2(v[j].x, v[j].y); w.y = pk2(v[j].z, v[j].w); o[64 * j] = w;
            int w8 = __builtin_amdgcn_cvt_pk_fp8_f32(v[j].x * qs, v[j].y * qs, 0, false); w8 = __builtin_amdgcn_cvt_pk_fp8_f32(v[j].z * qs, v[j].w * qs, w8, true); o8[64 * j] = (unsigned)w8; }
        if (c.lane == 0) XS[m] = am * (1.f / 384.f);
    }
}
__device__ __forceinline__ void phase_final(const Ctx& c, float* out, const float* g) {
    const int gw = c.bid * 8 + c.wave, NGW = c.G * 8;
    f32x4 gv[4];
#pragma unroll
    for (int j = 0; j < 4; ++j) gv[j] = *((const f32x4*)g + c.lane + 64 * j);
    for (int m = gw; m < M; m += NGW) {
        f32x4* xr = (f32x4*)(out + (size_t)m * D) + c.lane;
        f32x4 v[4]; float s = 0.f;
#pragma unroll
        for (int j = 0; j < 4; ++j) { v[j] = xr[64 * j]; s += (v[j].x * v[j].x + v[j].y * v[j].y) + (v[j].z * v[j].z + v[j].w * v[j].w); }
        const float r = rsqrtf(sum64(s) * (1.f / D) + 1e-6f);
#pragma unroll
        for (int j = 0; j < 4; ++j) xr[64 * j] = v[j] * r * gv[j];
    }
}

__device__ __forceinline__ void phase_rwkv_prep(const Ctx& c, KArgs& a, int l, int hb) {
    unsigned char* ws = a.ws;
    const bf16* PR = (const bf16*)(ws + WS_OV + OV_PR);
    bf16* AL = (bf16*)(ws + WS_OV + OV_AL);
    bf16* VS = l == 0 ? (bf16*)(ws + WS_VF) + (size_t)hb * MH * D : (bf16*)(ws + WS_OV + OV_VMIX);
    const float* mu = a.in[I_MU] + (size_t)l * RW_PROJ;
    LAS bf16* v1L = (LAS bf16*)c.lds;
    if (l == 1) {
        const float* v1 = a.in[I_V1];
        for (int e = c.tid; e < 1024 * 32; e += 512) { const int cc = e >> 5, j = e & 31; v1L[((cc & 15) * 64 + (cc >> 4)) * 40 + j] = (bf16)f2bf(v1[e]); }
        __syncthreads();
    }
    const int gw = c.bid * 8 + c.wave, NGW = c.G * 8, lane = c.lane;
    float muv[16], mul[8];
#pragma unroll
    for (int e = 0; e < 16; ++e) muv[e] = mu[2048 + 16 * lane + e];
#pragma unroll
    for (int e = 0; e < 8; ++e) mul[e] = lane < 36 ? mu[3072 + 8 * lane + e] : 0.f;
    const int per = (MH + NGW - 1) / NGW;
    const int mA = gw * per, mB = (mA + per < MH) ? mA + per : MH;
    v4u cq0, cq1, cql, pq0, pq1, pql;
    const v4u zz4 = (v4u){0u, 0u, 0u, 0u};
    const int lcol = lane < 36 ? 3072 + 8 * lane : 3072;
    if (mA < mB) {
        const bf16* row = PR + (size_t)mA * N1P;
        cq0 = *(const v4u*)(row + 2048 + 16 * lane); cq1 = *(const v4u*)(row + 2048 + 16 * lane + 8); cql = *(const v4u*)(row + lcol);
        if ((mA & (T - 1)) != 0) { pq0 = *(const v4u*)(row - N1P + 2048 + 16 * lane); pq1 = *(const v4u*)(row - N1P + 2048 + 16 * lane + 8); pql = *(const v4u*)(row - N1P + lcol); }
        else { pq0 = zz4; pq1 = zz4; pql = zz4; }
    }
    for (int m = mA; m < mB; ++m) {
        const v4u q0 = cq0, q1 = cq1, ql = cql;
        v4u r0 = pq0, r1 = pq1, rl = pql;
        if ((m & (T - 1)) == 0) { r0 = zz4; r1 = zz4; rl = zz4; }
        if (m + 1 < mB) { const bf16* nrow = PR + (size_t)(m + 1) * N1P; cq0 = *(const v4u*)(nrow + 2048 + 16 * lane); cq1 = *(const v4u*)(nrow + 2048 + 16 * lane + 8); cql = *(const v4u*)(nrow + lcol); }
        pq0 = q0; pq1 = q1; pql = ql;
        float vs[16];
        {
            float p[16], pp[16];
            float t8[8];
            unpack8(q0, t8);
#pragma unroll
            for (int e = 0; e < 8; ++e) p[e] = t8[e];
            unpack8(q1, t8);
#pragma unroll
            for (int e = 0; e < 8; ++e) p[8 + e] = t8[e];
            unpack8(r0, t8);
#pragma unroll
            for (int e = 0; e < 8; ++e) pp[e] = t8[e];
            unpack8(r1, t8);
#pragma unroll
            for (int e = 0; e < 8; ++e) pp[8 + e] = t8[e];
#pragma unroll
            for (int e = 0; e < 16; ++e) vs[e] = p[e] + (pp[e] - p[e]) * muv[e];
            v4u o0, o1;
            o0.x = pk2(vs[0], vs[1]); o0.y = pk2(vs[2], vs[3]); o0.z = pk2(vs[4], vs[5]); o0.w = pk2(vs[6], vs[7]);
            o1.x = pk2(vs[8], vs[9]); o1.y = pk2(vs[10], vs[11]); o1.z = pk2(vs[12], vs[13]); o1.w = pk2(vs[14], vs[15]);
            *(v4u*)(VS + (size_t)m * D + 16 * lane) = o0; *(v4u*)(VS + (size_t)m * D + 16 * lane + 8) = o1;
        }
        if (lane < 36) {
            float p[8], pp[8], s[8];
            unpack8(ql, p);
            unpack8(rl, pp);
#pragma unroll
            for (int e = 0; e < 8; ++e) { const float x = p[e] + (pp[e] - p[e]) * mul[e]; s[e] = lane < 8 ? tanhf(x) : (lane < 16 ? x : sigmoidf_(x)); }
            *(v4u*)(AL + (size_t)m * KL + 8 * lane) = pack8(s);
        } else if (lane < 48 && !(l == 1 && lane < 40)) {
            *(v4u*)(AL + (size_t)m * KL + 8 * lane) = (v4u){0u, 0u, 0u, 0u};
        }
        if (l == 1) {
            float acc[32];
#pragma unroll
            for (int j = 0; j < 32; ++j) acc[j] = 0.f;
#pragma unroll
            for (int i = 0; i < 16; ++i) {
                const LAS v4u* wp = (const LAS v4u*)(v1L + (i * 64 + lane) * 40);
#pragma unroll
                for (int q = 0; q < 4; ++q) { float w8[8]; const v4u wq_ = wp[q]; unpack8(wq_, w8);
#pragma unroll
                    for (int e = 0; e < 8; ++e) acc[q * 8 + e] += vs[i] * w8[e]; }
            }
#pragma unroll
            for (int s = 32, half = 16; s >= 2; s >>= 1, half >>= 1) {
                const bool up = (lane & s) != 0;
#pragma unroll
                for (int i = 0; i < 16; ++i) if (i < half) { const float send = up ? acc[i] : acc[i + half]; const float keep = up ? acc[i + half] : acc[i]; acc[i] = keep + __shfl_xor(send, s); }
            }
            acc[0] += __shfl_xor(acc[0], 1);
            const int j = ((lane & 32) ? 16 : 0) + ((lane & 16) ? 8 : 0) + ((lane & 8) ? 4 : 0) + ((lane & 4) ? 2 : 0) + ((lane & 2) ? 1 : 0);
            if ((lane & 1) == 0) AL[(size_t)m * KL + 288 + j] = (bf16)f2bf(acc[0]);
        }
    }
    { float* DT = (float*)(ws + WS_OV + OV_DT); float* DA = (float*)(ws + WS_OV + OV_DA);
      for (int it = gw; it < (MH / 64) * 32; it += NGW) {
        const int ck = it >> 5, h = it & 31;
        const size_t m = (size_t)ck * 64 + lane;
        const float x = bf1(PR[m * N1P + DT_COL + h]) + a.in[I_DTB][l * 32 + h];
        const float dt = x > 20.f ? x : log1pf(__expf(x));
        float cs = -dt * __expf(a.in[I_ALOG][l * 32 + h]);
#pragma unroll
        for (int o = 1; o < 64; o <<= 1) { const float y = __shfl_up(cs, o); cs += (lane >= o) ? y : 0.f; }
        DT[m * 32 + h] = dt; DA[m * 32 + h] = cs;
      } }
}

__device__ __forceinline__ float sum8(float x) { x += dpp_mov<0xB1>(x); x += dpp_mov<0x4E>(x); x += dpp_mov<0x141>(x); return x; }
__device__ __forceinline__ void phase_rwkv_rec(const Ctx& c, KArgs& a, int l, int hb) {
    unsigned char* ws = a.ws;
    const bf16* PR = (const bf16*)(ws + WS_OV + OV_PR);
    const bf16* ELOG = (const bf16*)(ws + WS_OV + OV_ELOG);
    const bf16* ASIG = (const bf16*)(ws + WS_OV + OV_ASIG);
    const bf16* VS = l == 0 ? (const bf16*)(ws + WS_VF) + (size_t)hb * MH * D : (const bf16*)(ws + WS_OV + OV_VMIX);
    bf16* Y = (bf16*)(ws + WS_OV + OV_YA);
    const float* mu = a.in[I_MU] + (size_t)l * RW_PROJ;
    const float* k_k = a.in[I_KK] + (size_t)l * D; const float* k_a = a.in[I_KA] + (size_t)l * D;
    constexpr int CH = 32, NCH = T / CH;
    constexpr int ARRF = CH * 64;
    constexpr int BUFF = 5 * ARRF + CH * 16 + CH * 2;
    LAS float* ldsf = (LAS float*)c.lds;
    LAS float* yt = ldsf + 2 * BUFF;
    const int tid = c.tid, lane = c.lane;
    const bool is_prep = c.wave >= 4;
    const int ptid = tid - 256, tt = ptid >> 3, l8 = ptid & 7, pc = l8 * 8;
    const int rrow = c.wave * 4 + (lane >> 4), cc4 = (lane & 15) * 4;
    for (int unit = c.bid; unit < 256; unit += c.G) {
        const int b = unit >> 6, h = (unit >> 2) & 15, rq = unit & 3;
        const size_t m0 = (size_t)b * T;
        const int hc = h * 64 + pc;
        float mur[8], muk[8], kkc[8], kac[8];
        if (is_prep) {
#pragma unroll
            for (int e = 0; e < 8; ++e) { mur[e] = mu[hc + e]; muk[e] = mu[1024 + hc + e]; kkc[e] = k_k[hc + e]; kac[e] = k_a[hc + e]; }
        }
        float S[4] = {0.f, 0.f, 0.f, 0.f}, sa = 0.f;
#define RW_PREP(chunk, bufp) do { \
            const int t_ = (chunk) * CH + tt; const size_t mm = m0 + t_; const bf16* row = PR + mm * N1P + hc; \
            const v4u zr = (v4u){0u, 0u, 0u, 0u}; \
            const v4u qr = *(const v4u*)row, qk = *(const v4u*)(row + 1024); \
            const v4u qrp = t_ > 0 ? *(const v4u*)(row - N1P) : zr, qkp = t_ > 0 ? *(const v4u*)(row - N1P + 1024) : zr; \
            const v4u qkn = t_ + 1 < T ? *(const v4u*)(row + N1P + 1024) : zr; \
            const v4u qas = *(const v4u*)(ASIG + mm * D + hc), qel = *(const v4u*)(ELOG + mm * D + hc); \
            v4u qv = zr; if (l8 < 2) qv = *(const v4u*)(VS + mm * D + h * 64 + rq * 16 + l8 * 8); \
            float r_[8], rp_[8], k_[8], kp_[8], kn_[8], as_[8], el_[8]; \
            unpack8(qr, r_); unpack8(qrp, rp_); unpack8(qk, k_); unpack8(qkp, kp_); unpack8(qkn, kn_); unpack8(qas, as_); unpack8(qel, el_); \
            float ks_[8], kk_[8], kkn_[8], s1 = 0.f, s2 = 0.f; \
            _Pragma("unroll") for (int e = 0; e < 8; ++e) { ks_[e] = k_[e] + (kp_[e] - k_[e]) * muk[e]; const float kn1 = kn_[e] + (k_[e] - kn_[e]) * muk[e]; \
                kk_[e] = ks_[e] * kkc[e]; kkn_[e] = kn1 * kkc[e]; s1 += kk_[e] * kk_[e]; s2 += kkn_[e] * kkn_[e]; } \
            s1 = sum8(s1); s2 = sum8(s2); \
            const float i1 = rsqrtf(s1 + 1e-12f), i2 = (t_ + 1 < T) ? rsqrtf(s2 + 1e-12f) : 0.f; \
            float ow[8], ok[8], ob[8], orr[8], owa[8], c1 = 0.f, c2 = 0.f; \
            _Pragma("unroll") for (int e = 0; e < 8; ++e) { const float kn = kk_[e] * i1, an = -kkn_[e] * i2; \
                ow[e] = __expf(el_[e]); ok[e] = ks_[e] * (1.f + (as_[e] - 1.f) * kac[e]); ob[e] = kn * as_[e]; orr[e] = r_[e] + (rp_[e] - r_[e]) * mur[e]; \
                owa[e] = ow[e] * an; c1 += ob[e] * an; c2 += ok[e] * an; } \
            c1 = sum8(c1); c2 = sum8(c2); \
            LAS float* bp_ = (bufp) + tt * 64 + pc; \
            *(LAS f32x4*)(bp_) = (f32x4){ow[0], ow[1], ow[2], ow[3]}; *(LAS f32x4*)(bp_ + 4) = (f32x4){ow[4], ow[5], ow[6], ow[7]}; \
            *(LAS f32x4*)(bp_ + ARRF) = (f32x4){ok[0], ok[1], ok[2], ok[3]}; *(LAS f32x4*)(bp_ + ARRF + 4) = (f32x4){ok[4], ok[5], ok[6], ok[7]}; \
            *(LAS f32x4*)(bp_ + 2 * ARRF) = (f32x4){ob[0], ob[1], ob[2], ob[3]}; *(LAS f32x4*)(bp_ + 2 * ARRF + 4) = (f32x4){ob[4], ob[5], ob[6], ob[7]}; \
            *(LAS f32x4*)(bp_ + 3 * ARRF) = (f32x4){orr[0], orr[1], orr[2], orr[3]}; *(LAS f32x4*)(bp_ + 3 * ARRF + 4) = (f32x4){orr[4], orr[5], orr[6], orr[7]}; \
            *(LAS f32x4*)(bp_ + 4 * ARRF) = (f32x4){owa[0], owa[1], owa[2], owa[3]}; *(LAS f32x4*)(bp_ + 4 * ARRF + 4) = (f32x4){owa[4], owa[5], owa[6], owa[7]}; \
            if (l8 < 2) { float v_[8]; unpack8(qv, v_); LAS float* vp_ = (bufp) + 5 * ARRF + tt * 16 + l8 * 8; \
                *(LAS f32x4*)vp_ = (f32x4){v_[0], v_[1], v_[2], v_[3]}; *(LAS f32x4*)(vp_ + 4) = (f32x4){v_[4], v_[5], v_[6], v_[7]}; } \
            if (l8 == 0) { (bufp)[5 * ARRF + CH * 16 + tt * 2] = c1; (bufp)[5 * ARRF + CH * 16 + tt * 2 + 1] = c2; } } while (0)
#define RW_YSTORE(chunk) do { const LAS float* yp_ = yt + ((chunk) & 1) * CH * 16 + tt * 16 + l8 * 2; \
            *(unsigned*)(Y + (m0 + (size_t)(chunk) * CH + tt) * D + h * 64 + rq * 16 + l8 * 2) = pk2(yp_[0], yp_[1]); } while (0)
        if (is_prep) RW_PREP(0, ldsf);
        __syncthreads();
        for (int ch = 0; ch < NCH; ++ch) {
            if (is_prep) {
                if (ch + 1 < NCH) RW_PREP(ch + 1, ldsf + ((ch + 1) & 1) * BUFF);
                if (ch > 0) RW_YSTORE(ch - 1);
            } else {
                const LAS float* buf = ldsf + (ch & 1) * BUFF;
                LAS float* yw = yt + (ch & 1) * CH * 16;
                const int lane15 = lane & 15;
                f32x4 w4 = *(const LAS f32x4*)(buf + cc4), k4 = *(const LAS f32x4*)(buf + ARRF + cc4), b4 = *(const LAS f32x4*)(buf + 2 * ARRF + cc4);
                f32x4 r4 = *(const LAS f32x4*)(buf + 3 * ARRF + cc4), wa4 = *(const LAS f32x4*)(buf + 4 * ARRF + cc4);
                float v = buf[5 * ARRF + rrow]; f32x2 cc = *(const LAS f32x2*)(buf + 5 * ARRF + CH * 16);
#pragma unroll 1
                for (int t16 = 0; t16 < CH; t16 += 16) {
                    float ysave = 0.f;
#pragma unroll
                    for (int u = 0; u < 16; ++u) {
                        const int tn = (t16 + u + 1 < CH) ? t16 + u + 1 : t16 + u;
                        const f32x4 nw4 = *(const LAS f32x4*)(buf + tn * 64 + cc4), nk4 = *(const LAS f32x4*)(buf + ARRF + tn * 64 + cc4), nb4 = *(const LAS f32x4*)(buf + 2 * ARRF + tn * 64 + cc4);
                        const f32x4 nr4 = *(const LAS f32x4*)(buf + 3 * ARRF + tn * 64 + cc4), nwa4 = *(const LAS f32x4*)(buf + 4 * ARRF + tn * 64 + cc4);
                        const float nv = buf[5 * ARRF + tn * 16 + rrow]; const f32x2 ncc = *(const LAS f32x2*)(buf + 5 * ARRF + CH * 16 + tn * 2);
                        float d = S[0] * wa4[0]; d = __builtin_fmaf(S[1], wa4[1], d); d = __builtin_fmaf(S[2], wa4[2], d); d = __builtin_fmaf(S[3], wa4[3], d);
#pragma unroll
                        for (int e = 0; e < 4; ++e) { float tmp = S[e] * w4[e]; asm volatile("" : "+v"(tmp)); tmp = __builtin_fmaf(v, k4[e], tmp); S[e] = __builtin_fmaf(sa, b4[e], tmp); asm volatile("" : "+v"(S[e])); }
                        const float sa_next = __builtin_fmaf(v, cc.y, sa * cc.x);
                        float y = S[0] * r4[0]; y = __builtin_fmaf(S[1], r4[1], y); y = __builtin_fmaf(S[2], r4[2], y); y = __builtin_fmaf(S[3], r4[3], y);
                        d = sum16(d); y = sum16(y);
                        sa = d + sa_next;
                        ysave = (lane15 == u) ? y : ysave;
                        w4 = nw4; k4 = nk4; b4 = nb4; r4 = nr4; wa4 = nwa4; v = nv; cc = ncc;
                    }
                    yw[(t16 + lane15) * 16 + rrow] = ysave;
                }
            }
            __syncthreads();
        }
        if (is_prep) RW_YSTORE(NCH - 1);
        __syncthreads();
#undef RW_PREP
#undef RW_YSTORE
    }
}

constexpr int CK_TS = 72, CK_TB = 64 * CK_TS;
__device__ __forceinline__ void tr_a2(unsigned a, bf16x8& f0, bf16x8& f1) {
    s16x4 l0, h0, l1, h1;
    asm volatile("ds_read_b64_tr_b16 %0, %4\n\tds_read_b64_tr_b16 %1, %4 offset:576\n\tds_read_b64_tr_b16 %2, %4 offset:4608\n\tds_read_b64_tr_b16 %3, %4 offset:5184\n\ts_waitcnt lgkmcnt(0)"
                 : "=&v"(l0), "=&v"(h0), "=&v"(l1), "=&v"(h1) : "v"(a) : "memory");
    f0 = __builtin_shufflevector(l0, h0, 0, 1, 2, 3, 4, 5, 6, 7); f1 = __builtin_shufflevector(l1, h1, 0, 1, 2, 3, 4, 5, 6, 7);
}
__device__ __forceinline__ void tr_b4(unsigned a, bf16x8& f00, bf16x8& f01, bf16x8& f10, bf16x8& f11) {
    s16x4 l0, h0, l1, h1, l2, h2, l3, h3;
    asm volatile("ds_read_b64_tr_b16 %0, %8\n\tds_read_b64_tr_b16 %1, %8 offset:576\n\tds_read_b64_tr_b16 %2, %8 offset:4608\n\tds_read_b64_tr_b16 %3, %8 offset:5184\n\t"
                 "ds_read_b64_tr_b16 %4, %8 offset:32\n\tds_read_b64_tr_b16 %5, %8 offset:608\n\tds_read_b64_tr_b16 %6, %8 offset:4640\n\tds_read_b64_tr_b16 %7, %8 offset:5216\n\ts_waitcnt lgkmcnt(0)"
                 : "=&v"(l0), "=&v"(h0), "=&v"(l1), "=&v"(h1), "=&v"(l2), "=&v"(h2), "=&v"(l3), "=&v"(h3) : "v"(a) : "memory");
    f00 = __builtin_shufflevector(l0, h0, 0, 1, 2, 3, 4, 5, 6, 7); f01 = __builtin_shufflevector(l1, h1, 0, 1, 2, 3, 4, 5, 6, 7);
    f10 = __builtin_shufflevector(l2, h2, 0, 1, 2, 3, 4, 5, 6, 7); f11 = __builtin_shufflevector(l3, h3, 0, 1, 2, 3, 4, 5, 6, 7);
}
template <int PA, int QA, int MASK, int NINIT, int NPAIR, int POST>
__device__ __forceinline__ void mm64(LAS bf16* X, const LAS bf16* P, const LAS bf16* Q, const LAS bf16* P2, const LAS bf16* Q2, const LAS bf16* E1, const LAS bf16* E2,
                                     const LAS float* cscale, const LAS float* wc, int w, int lane) {
    const int r = lane & 15, q = lane >> 4, Ct = w >> 1, Rt0 = 2 * (w & 1);
    const int i16 = lane & 15, qq = i16 >> 2, p4 = i16 & 3;
    const int troff = ((8 * q + qq) * CK_TS + 4 * p4) * 2;
    f32x4 acc[2];
#pragma unroll
    for (int i = 0; i < 2; ++i) {
        const int R = 16 * (Rt0 + i) + r;
        if (NINIT == 0) acc[i] = (f32x4){0.f, 0.f, 0.f, 0.f};
        else { const v2u e1 = *(const LAS v2u*)(E1 + R * CK_TS + 16 * Ct + 4 * q); acc[i] = (f32x4){bflo(e1.x), bfhi(e1.x), bflo(e1.y), bfhi(e1.y)};
            if (NINIT == 2) { const v2u e2 = *(const LAS v2u*)(E2 + R * CK_TS + 16 * Ct + 4 * q); acc[i] += (f32x4){bflo(e2.x), bfhi(e2.x), bflo(e2.y), bfhi(e2.y)}; } }
    }
#pragma unroll
    for (int pr = 0; pr < NPAIR; ++pr) {
        const LAS bf16* Pp = pr == 0 ? P : P2; const LAS bf16* Qp = pr == 0 ? Q : Q2;
        bf16x8 af[2], bfr[2][2];
        if (PA == 0) {
#pragma unroll
            for (int i = 0; i < 2; ++i)
#pragma unroll
                for (int ks = 0; ks < 2; ++ks) bfr[i][ks] = *(const LAS bf16x8*)(Pp + (16 * (Rt0 + i) + r) * CK_TS + 32 * ks + 8 * q);
        }
        if (QA == 1) {
#pragma unroll
            for (int ks = 0; ks < 2; ++ks) af[ks] = *(const LAS bf16x8*)(Qp + (16 * Ct + r) * CK_TS + 32 * ks + 8 * q);
        } else tr_a2((unsigned)(size_t)Qp + (unsigned)(troff + 32 * Ct), af[0], af[1]);
        if (PA == 1) tr_b4((unsigned)(size_t)Pp + (unsigned)(troff + 32 * Rt0), bfr[0][0], bfr[0][1], bfr[1][0], bfr[1][1]);
#pragma unroll
        for (int ks = 0; ks < 2; ++ks)
#pragma unroll
            for (int i = 0; i < 2; ++i) acc[i] = __builtin_amdgcn_mfma_f32_16x16x32_bf16(af[ks], bfr[i][ks], acc[i], 0, 0, 0);
    }
#pragma unroll
    for (int i = 0; i < 2; ++i) {
        const int R = 16 * (Rt0 + i) + r;
        float v[4];
#pragma unroll
        for (int e = 0; e < 4; ++e) { const int C = 16 * Ct + 4 * q + e; float x = acc[i][e];
            if (MASK == 1) x = (C < R) ? x : 0.f;
            if (MASK == 2) x = (C <= R) ? x : 0.f;
            if (POST >= 1) x *= cscale[C];
            if (POST == 2) x += (C == R) ? wc[C] : 0.f;
            v[e] = x; }
        v2u o; o.x = pk2c(v[0], v[1]); o.y = pk2c(v[2], v[3]);
        *(LAS v2u*)(X + R * CK_TS + 16 * Ct + 4 * q) = o;
    }
}

template <int PA, int QA, int MASK, int NINIT, int NPAIR, int POST>
__device__ __forceinline__ void mm64h(LAS bf16* X, const LAS bf16* P, const LAS bf16* Q, const LAS bf16* P2, const LAS bf16* Q2, const LAS bf16* E1, const LAS bf16* E2,
                                      const LAS float* cscale, const LAS float* wc, int ws, int lane) {
    const int r = lane & 15, q = lane >> 4, Cb = ws >> 1, Rb = ws & 1;
    const int i16 = lane & 15, qq = i16 >> 2, p4 = i16 & 3;
    const int troff = ((8 * q + qq) * CK_TS + 4 * p4) * 2;
    f32x4 acc[2][2];
#pragma unroll
    for (int ci = 0; ci < 2; ++ci)
#pragma unroll
        for (int ri = 0; ri < 2; ++ri) {
            const int R = 16 * (2 * Rb + ri) + r, C0 = 16 * (2 * Cb + ci) + 4 * q;
            if (NINIT == 0) acc[ci][ri] = (f32x4){0.f, 0.f, 0.f, 0.f};
            else { const v2u e1 = *(const LAS v2u*)(E1 + R * CK_TS + C0); acc[ci][ri] = (f32x4){bflo(e1.x), bfhi(e1.x), bflo(e1.y), bfhi(e1.y)};
                if (NINIT == 2) { const v2u e2 = *(const LAS v2u*)(E2 + R * CK_TS + C0); acc[ci][ri] += (f32x4){bflo(e2.x), bfhi(e2.x), bflo(e2.y), bfhi(e2.y)}; } }
        }
#pragma unroll
    for (int pr = 0; pr < NPAIR; ++pr) {
        const LAS bf16* Pp = pr == 0 ? P : P2; const LAS bf16* Qp = pr == 0 ? Q : Q2;
        bf16x8 af[2][2], bfr[2][2];
        if (PA == 0) {
#pragma unroll
            for (int ri = 0; ri < 2; ++ri)
#pragma unroll
                for (int ks = 0; ks < 2; ++ks) bfr[ri][ks] = *(const LAS bf16x8*)(Pp + (16 * (2 * Rb + ri) + r) * CK_TS + 32 * ks + 8 * q);
        }
        if (QA == 1) {
#pragma unroll
            for (int ci = 0; ci < 2; ++ci)
#pragma unroll
                for (int ks = 0; ks < 2; ++ks) af[ci][ks] = *(const LAS bf16x8*)(Qp + (16 * (2 * Cb + ci) + r) * CK_TS + 32 * ks + 8 * q);
        } else tr_b4((unsigned)(size_t)Qp + (unsigned)(troff + 64 * Cb), af[0][0], af[0][1], af[1][0], af[1][1]);
        if (PA == 1) tr_b4((unsigned)(size_t)Pp + (unsigned)(troff + 64 * Rb), bfr[0][0], bfr[0][1], bfr[1][0], bfr[1][1]);
#pragma unroll
        for (int ks = 0; ks < 2; ++ks)
#pragma unroll
            for (int ci = 0; ci < 2; ++ci)
#pragma unroll
                for (int ri = 0; ri < 2; ++ri) acc[ci][ri] = __builtin_amdgcn_mfma_f32_16x16x32_bf16(af[ci][ks], bfr[ri][ks], acc[ci][ri], 0, 0, 0);
    }
#pragma unroll
    for (int ci = 0; ci < 2; ++ci)
#pragma unroll
        for (int ri = 0; ri < 2; ++ri) {
            const int R = 16 * (2 * Rb + ri) + r;
            float v[4];
#pragma unroll
            for (int e = 0; e < 4; ++e) { const int C = 16 * (2 * Cb + ci) + 4 * q + e; float x = acc[ci][ri][e];
                if (MASK == 1) x = (C < R) ? x : 0.f;
                if (MASK == 2) x = (C <= R) ? x : 0.f;
                if (POST >= 1) x *= cscale[C];
                if (POST == 2) x += (C == R) ? wc[C] : 0.f;
                v[e] = x; }
            v2u o; o.x = pk2c(v[0], v[1]); o.y = pk2c(v[2], v[3]);
            *(LAS v2u*)(X + R * CK_TS + 16 * (2 * Cb + ci) + 4 * q) = o;
        }
}

__device__ __forceinline__ void phase_rwkv_chunk_par(const Ctx& c, KArgs& a, int l, int hb) {
    unsigned char* ws = a.ws;
    bf16* PR = (bf16*)(ws + WS_OV + OV_PR);
    bf16* ELOG = (bf16*)(ws + WS_OV + OV_ELOG);
    const bf16* ASIG = (const bf16*)(ws + WS_OV + OV_ASIG);
    const bf16* VS = l == 0 ? (const bf16*)(ws + WS_VF) + (size_t)hb * MH * D : (const bf16*)(ws + WS_OV + OV_VMIX);
    bf16* Y = (bf16*)(ws + WS_OV + OV_YA);
    bf16* SLB = (bf16*)(ws + WS_OV + OV_AL);
    const float* mu = a.in[I_MU] + (size_t)l * RW_PROJ;
    const float* k_k = a.in[I_KK] + (size_t)l * D; const float* k_a = a.in[I_KA] + (size_t)l * D; const float* rk_ = a.in[I_RK] + (size_t)l * D;
    float* BON = (float*)(ws + WS_OV + OV_BON);
    LAS bf16* tile = (LAS bf16*)c.lds;
    enum { tA = 0, tR, tBt, tKt, tBh, tKh, tV, tNab, tNak, tNrb, tNrk, tM0, tM1, tP1, tX1, NT };
#define TL(i) (tile + (i) * CK_TB)
    LAS float* cscale = (LAS float*)(tile + NT * CK_TB);
    LAS float* wcv = cscale + 64;
    LAS float* SCR = (LAS float*)TL(tM0);
    LAS float* SEGT = SCR + 64 * 64;
    const int tid = c.tid, lane = c.lane, w = c.wave;
    const int tt = tid >> 3, l8 = tid & 7, pc = l8 * 8;
    v4u qr, qk, qrp, qkp, qas, qel, qv;
#define CK_LOAD(un) do { const int b_ = (un) >> 10, h_ = ((un) >> 6) & 15, ch_ = (un) & 63; const int t_ = ch_ * 64 + tt; \
        const size_t mm = (size_t)b_ * T + (size_t)t_; const bf16* row = PR + mm * N1P + h_ * 64 + pc; const v4u zr = (v4u){0u, 0u, 0u, 0u}; \
        qr = *(const v4u*)row; qk = *(const v4u*)(row + 1024); qrp = t_ > 0 ? *(const v4u*)(row - N1P) : zr; qkp = t_ > 0 ? *(const v4u*)(row - N1P + 1024) : zr; \
        qas = *(const v4u*)(ASIG + mm * D + h_ * 64 + pc); qel = *(const v4u*)(ELOG + mm * D + h_ * 64 + pc); qv = *(const v4u*)(VS + mm * D + h_ * 64 + pc); } while (0)
    if (c.bid < 4096) CK_LOAD(c.bid);
    for (int unit = c.bid; unit < 4096; unit += c.G) {
        const int b = unit >> 10, h = (unit >> 6) & 15, ch = unit & 63;
        const size_t m0 = (size_t)b * T + (size_t)ch * 64;
        const int hc = h * 64 + pc;
        for (int rep = 0; rep < (PROBE_DUP == 7 ? 2 : 1); ++rep) {
        if (PROBE_DUP == 7) { CK_LOAD(unit); }
        float r_[8], k_[8], as_[8], el_[8], v_[8], kk_[8], ks_[8];
        {
            float rp_[8], kp_[8];
            unpack8(qr, r_); unpack8(qrp, rp_); unpack8(qk, k_); unpack8(qkp, kp_); unpack8(qas, as_); unpack8(qel, el_); unpack8(qv, v_);
            if (PROBE_DUP != 7 && unit + c.G < 4096) CK_LOAD(unit + c.G);
            float s1 = 0.f;
#pragma unroll
            for (int e = 0; e < 8; ++e) { r_[e] = r_[e] + (rp_[e] - r_[e]) * mu[hc + e]; ks_[e] = k_[e] + (kp_[e] - k_[e]) * mu[1024 + hc + e]; kk_[e] = ks_[e] * k_k[hc + e]; s1 += kk_[e] * kk_[e]; }
            s1 = sum8(s1);
            const float i1 = rsqrtf(s1 + 1e-12f);
#pragma unroll
            for (int e = 0; e < 8; ++e) { kk_[e] *= i1; k_[e] = ks_[e] * (1.f + (as_[e] - 1.f) * k_a[hc + e]); }
            { float bn = 0.f;
#pragma unroll
              for (int e = 0; e < 8; ++e) bn += r_[e] * k_[e] * rk_[hc + e];
              bn = sum8(bn);
              if (l8 == 0) BON[(m0 + tt) * 16 + h] = bn; }
            *(LAS f32x4*)(SCR + tt * 64 + pc) = (f32x4){el_[0], el_[1], el_[2], el_[3]}; *(LAS f32x4*)(SCR + tt * 64 + pc + 4) = (f32x4){el_[4], el_[5], el_[6], el_[7]};
        }
        lds_barrier();
        {
            const int col = tid & 63, seg = tid >> 6; float s = 0.f;
#pragma unroll
            for (int i = 0; i < 8; ++i) { s += SCR[(8 * seg + i) * 64 + col]; SCR[(8 * seg + i) * 64 + col] = s; }
            SEGT[seg * 64 + col] = s;
        }
        lds_barrier();
        {
            const int col = tid & 63, seg = tid >> 6; float pre = 0.f;
#pragma unroll
            for (int s2 = 0; s2 < 7; ++s2) pre += (s2 < seg) ? SEGT[s2 * 64 + col] : 0.f;
#pragma unroll
            for (int i = 0; i < 8; ++i) SCR[(8 * seg + i) * 64 + col] += pre;
        }
        lds_barrier();
        {
            float L[8], Lr[8], Le[8];
            { const f32x4 x0 = *(const LAS f32x4*)(SCR + tt * 64 + pc), x1 = *(const LAS f32x4*)(SCR + tt * 64 + pc + 4);
              const f32x4 y0 = *(const LAS f32x4*)(SCR + 31 * 64 + pc), y1 = *(const LAS f32x4*)(SCR + 31 * 64 + pc + 4);
              const f32x4 z0 = *(const LAS f32x4*)(SCR + 63 * 64 + pc), z1 = *(const LAS f32x4*)(SCR + 63 * 64 + pc + 4);
#pragma unroll
              for (int e = 0; e < 4; ++e) { L[e] = x0[e]; L[4 + e] = x1[e]; Lr[e] = y0[e]; Lr[4 + e] = y1[e]; Le[e] = z0[e]; Le[4 + e] = z1[e]; } }
            float oA[8], oR[8], oBt[8], oKt[8], oBh[8], oKh[8];
#pragma unroll
            for (int e = 0; e < 8; ++e) {
                const float ea = __expf(L[e] - el_[e] - Lr[e]), er = __expf(L[e] - Lr[e]), eb = __expf(Lr[e] - L[e]), eh = __expf(Le[e] - L[e]);
                const float bb = kk_[e] * as_[e];
                oA[e] = -kk_[e] * ea; oR[e] = r_[e] * er; oBt[e] = bb * eb; oKt[e] = k_[e] * eb; oBh[e] = bb * eh; oKh[e] = k_[e] * eh;
            }
            const int o = tt * CK_TS + pc;
            *(LAS v4u*)(TL(tA) + o) = pack8(oA); *(LAS v4u*)(TL(tR) + o) = pack8(oR); *(LAS v4u*)(TL(tBt) + o) = pack8(oBt); *(LAS v4u*)(TL(tKt) + o) = pack8(oKt);
            *(LAS v4u*)(TL(tBh) + o) = pack8(oBh); *(LAS v4u*)(TL(tKh) + o) = pack8(oKh); *(LAS v4u*)(TL(tV) + o) = pack8(v_);
            if (tt == 0) {
#pragma unroll
                for (int e = 0; e < 8; ++e) { cscale[pc + e] = __expf(Lr[e]); wcv[pc + e] = __expf(Le[e]); }
            }
        }
        lds_barrier();
        const LAS bf16* Z = nullptr;
        const int wg_ = w >> 2, ws_ = w & 3;
        if (wg_ == 0) { mm64h<0, 1, 1, 0, 1, 0>(TL(tNab), TL(tA), TL(tBt), Z, Z, Z, Z, cscale, wcv, ws_, lane);
                        mm64h<0, 1, 1, 0, 1, 0>(TL(tNak), TL(tA), TL(tKt), Z, Z, Z, Z, cscale, wcv, ws_, lane); }
        else          { mm64h<0, 1, 2, 0, 1, 0>(TL(tNrb), TL(tR), TL(tBt), Z, Z, Z, Z, cscale, wcv, ws_, lane);
                        mm64h<0, 1, 2, 0, 1, 0>(TL(tNrk), TL(tR), TL(tKt), Z, Z, Z, Z, cscale, wcv, ws_, lane); }
        lds_barrier();
        if (wg_ == 0) mm64h<0, 0, 0, 0, 1, 0>(TL(tM0), TL(tNab), TL(tNab), Z, Z, Z, Z, cscale, wcv, ws_, lane);
        else          mm64h<0, 0, 0, 0, 1, 0>(TL(tX1), TL(tNak), TL(tV), Z, Z, Z, Z, cscale, wcv, ws_, lane);
        lds_barrier();
        if (wg_ == 0) mm64h<0, 0, 0, 2, 1, 0>(TL(tP1), TL(tNab), TL(tM0), Z, Z, TL(tNab), TL(tM0), cscale, wcv, ws_, lane);
        else          mm64h<0, 0, 0, 0, 1, 0>(TL(tM1), TL(tM0), TL(tM0), Z, Z, Z, Z, cscale, wcv, ws_, lane);
        lds_barrier();
        if (wg_ == 0) mm64h<0, 0, 0, 2, 1, 0>(TL(tNab), TL(tP1), TL(tM1), Z, Z, TL(tP1), TL(tM1), cscale, wcv, ws_, lane);
        else          mm64h<0, 0, 0, 0, 1, 0>(TL(tM0), TL(tM1), TL(tM1), Z, Z, Z, Z, cscale, wcv, ws_, lane);
        lds_barrier();
        if (wg_ == 0) mm64h<0, 0, 0, 2, 1, 0>(TL(tP1), TL(tNab), TL(tM0), Z, Z, TL(tNab), TL(tM0), cscale, wcv, ws_, lane);
        else          mm64h<0, 0, 0, 0, 1, 0>(TL(tM1), TL(tM0), TL(tM0), Z, Z, Z, Z, cscale, wcv, ws_, lane);
        lds_barrier();
        if (wg_ == 0) mm64h<0, 0, 0, 2, 1, 0>(TL(tNab), TL(tP1), TL(tM1), Z, Z, TL(tP1), TL(tM1), cscale, wcv, ws_, lane);
        else          mm64h<0, 0, 0, 0, 1, 0>(TL(tM0), TL(tM1), TL(tM1), Z, Z, Z, Z, cscale, wcv, ws_, lane);
        lds_barrier();
        mm64<0, 0, 0, 2, 1, 0>(TL(tP1), TL(tNab), TL(tM0), Z, Z, TL(tNab), TL(tM0), cscale, wcv, w, lane);
        lds_barrier();
        if (wg_ == 0) mm64h<0, 0, 0, 1, 1, 0>(TL(tBt), TL(tP1), TL(tA), Z, Z, TL(tA), Z, cscale, wcv, ws_, lane);
        else          mm64h<0, 0, 0, 1, 1, 0>(TL(tKt), TL(tP1), TL(tX1), Z, Z, TL(tX1), Z, cscale, wcv, ws_, lane);
        lds_barrier();
        if (wg_ == 0) { mm64h<0, 0, 0, 1, 1, 1>(TL(tM0), TL(tNrb), TL(tBt), Z, Z, TL(tR), Z, cscale, wcv, ws_, lane);
                        mm64h<0, 0, 0, 0, 2, 0>(TL(tM1), TL(tNrb), TL(tKt), TL(tNrk), TL(tV), Z, Z, cscale, wcv, ws_, lane); }
        else          { mm64h<1, 0, 0, 0, 1, 2>(TL(tNab), TL(tBh), TL(tBt), Z, Z, Z, Z, cscale, wcv, ws_, lane);
                        mm64h<1, 0, 0, 0, 2, 0>(TL(tX1), TL(tKt), TL(tBh), TL(tV), TL(tKh), Z, Z, cscale, wcv, ws_, lane); }
        lds_barrier();
        }
        {
            const size_t grow = m0 + tt;
            *(v4u*)(ELOG + grow * D + hc) = *(const LAS v4u*)(TL(tM0) + tt * CK_TS + pc);
            *(v4u*)(Y + grow * D + hc) = *(const LAS v4u*)(TL(tM1) + tt * CK_TS + pc);
            *(v4u*)(PR + grow * N1P + 2048 + hc) = *(const LAS v4u*)(TL(tNab) + tt * CK_TS + pc);
            *(v4u*)(SLB + grow * D + hc) = *(const LAS v4u*)(TL(tX1) + tt * CK_TS + pc);
        }
        lds_barrier();
    }
#undef TL
#undef CK_LOAD
}

struct SeqOps { v4u g0, g1, p0, p1; v2u sl, yl; };
__device__ __forceinline__ void phase_rwkv_chunk_seq(const Ctx& c, KArgs& a, const bool commit = true) {
    unsigned char* ws = a.ws;
    const bf16* PR = (const bf16*)(ws + WS_OV + OV_PR);
    const bf16* RP = (const bf16*)(ws + WS_OV + OV_ELOG);
    bf16* Y = (bf16*)(ws + WS_OV + OV_YA);
    const bf16* SLB = (const bf16*)(ws + WS_OV + OV_AL);
    LAS bf16* SL = (LAS bf16*)c.lds;
    const int tid = c.tid, lane = c.lane, w = c.wave, r = lane & 15, q = lane >> 4;
    constexpr int PF = 4;
    for (int unit = c.bid; unit < 256; unit += c.G) {
        const int b = unit >> 6, h = (unit >> 2) & 15, vq = unit & 3;
        for (int e = tid; e < 2 * 16 * CK_TS / 2; e += 512) ((LAS unsigned*)SL)[e] = 0u;
        __syncthreads();
        if (w < 4) {
            const size_t rowG = (size_t)b * T + 16 * w + r;
            const size_t rowS = (size_t)b * T + vq * 16 + r;
            SeqOps ops[PF];
#define SQ_LOAD(dst, chn) do { const size_t o_ = (size_t)(chn) * 64; \
                dst.g0 = *(const v4u*)(PR + (rowG + o_) * N1P + 2048 + h * 64 + 8 * q); dst.g1 = *(const v4u*)(PR + (rowG + o_) * N1P + 2048 + h * 64 + 32 + 8 * q); \
                dst.p0 = *(const v4u*)(RP + (rowG + o_) * D + h * 64 + 8 * q); dst.p1 = *(const v4u*)(RP + (rowG + o_) * D + h * 64 + 32 + 8 * q); \
                dst.sl = *(const v2u*)(SLB + (rowS + o_) * D + h * 64 + 16 * w + 4 * q); dst.yl = *(const v2u*)(Y + (rowG + o_) * D + h * 64 + vq * 16 + 4 * q); } while (0)
#pragma unroll
            for (int i = 0; i < PF; ++i) SQ_LOAD(ops[i], i);
            for (int ch0 = 0; ch0 < 64; ch0 += PF) {
#pragma unroll
                for (int i = 0; i < PF; ++i) {
                    const int ch = ch0 + i;
                    const SeqOps cur = ops[i];
                    if (ch + PF < 64) SQ_LOAD(ops[i], ch + PF);
                    const LAS bf16* Sc = SL + (i & 1) * 16 * CK_TS; LAS bf16* Sn = SL + ((i + 1) & 1) * 16 * CK_TS;
                    const bf16x8 s0 = *(const LAS bf16x8*)(Sc + r * CK_TS + 8 * q), s1 = *(const LAS bf16x8*)(Sc + r * CK_TS + 32 + 8 * q);
                    f32x4 accS = (f32x4){bflo(cur.sl.x), bfhi(cur.sl.x), bflo(cur.sl.y), bfhi(cur.sl.y)};
                    accS = __builtin_amdgcn_mfma_f32_16x16x32_bf16(__builtin_bit_cast(bf16x8, cur.g0), s0, accS, 0, 0, 0);
                    accS = __builtin_amdgcn_mfma_f32_16x16x32_bf16(__builtin_bit_cast(bf16x8, cur.g1), s1, accS, 0, 0, 0);
                    f32x4 accY = (f32x4){bflo(cur.yl.x), bfhi(cur.yl.x), bflo(cur.yl.y), bfhi(cur.yl.y)};
                    accY = __builtin_amdgcn_mfma_f32_16x16x32_bf16(s0, __builtin_bit_cast(bf16x8, cur.p0), accY, 0, 0, 0);
                    accY = __builtin_amdgcn_mfma_f32_16x16x32_bf16(s1, __builtin_bit_cast(bf16x8, cur.p1), accY, 0, 0, 0);
                    { v2u o; o.x = pk2c(accS[0], accS[1]); o.y = pk2c(accS[2], accS[3]); *(LAS v2u*)(Sn + r * CK_TS + 16 * w + 4 * q) = o; }
                    if (commit || accY[0] == 123456.789f) { v2u o; o.x = pk2c(accY[0], accY[1]); o.y = pk2c(accY[2], accY[3]); *(v2u*)(Y + (rowG + (size_t)ch * 64) * D + h * 64 + vq * 16 + 4 * q) = o; }
                    lds_barrier();
                }
            }
#undef SQ_LOAD
        } else {
            for (int ch = 0; ch < 64; ++ch) lds_barrier();
        }
        __syncthreads();
    }
}

__device__ __forceinline__ void phase_rwkv_post(const Ctx& c, KArgs& a, int l, int hb) {
    unsigned char* ws = a.ws;
    const bf16* GG = (const bf16*)(ws + WS_OV + OV_GG);
    const bf16* VS = l == 0 ? (const bf16*)(ws + WS_VF) + (size_t)hb * MH * D : (const bf16*)(ws + WS_OV + OV_VMIX);
    const float* BON = (const float*)(ws + WS_OV + OV_BON);
    bf16* Y = (bf16*)(ws + WS_OV + OV_YA);
    const int lane = c.lane, c0 = 16 * lane;
    float lw[16], lb[16];
#pragma unroll
    for (int e = 0; e < 16; ++e) { lw[e] = a.in[I_LNW][(size_t)l * D + c0 + e]; lb[e] = a.in[I_LNB][(size_t)l * D + c0 + e]; }
    const int gw = c.bid * 8 + c.wave, NGW = c.G * 8;
    v4u ny0, ny1, nv0, nv1, ng0, ng1; float nbon = 0.f;
#define RP_LOAD(mm) do { ny0 = *(const v4u*)(Y + (size_t)(mm) * D + c0); ny1 = *(const v4u*)(Y + (size_t)(mm) * D + c0 + 8); nv0 = *(const v4u*)(VS + (size_t)(mm) * D + c0); nv1 = *(const v4u*)(VS + (size_t)(mm) * D + c0 + 8); \
        ng0 = *(const v4u*)(GG + (size_t)(mm) * D + c0); ng1 = *(const v4u*)(GG + (size_t)(mm) * D + c0 + 8); nbon = BON[(size_t)(mm) * 16 + (lane >> 2)]; } while (0)
    if (gw < MH) RP_LOAD(gw);
    for (int m = gw; m < MH; m += NGW) {
        float y[16], v[16], g[16], t8[8];
        const v4u cy0 = ny0, cy1 = ny1, cv0 = nv0, cv1 = nv1, cg0 = ng0, cg1 = ng1; const float bon = nbon;
        if (m + NGW < MH) RP_LOAD(m + NGW);
#define UP16(dst, qa, qb) do { unpack8(qa, t8); _Pragma("unroll") for (int e = 0; e < 8; ++e) dst[e] = t8[e]; unpack8(qb, t8); _Pragma("unroll") for (int e = 0; e < 8; ++e) dst[8 + e] = t8[e]; } while (0)
        UP16(y, cy0, cy1); UP16(v, cv0, cv1); UP16(g, cg0, cg1);
#undef UP16
        float s1 = 0.f;
#pragma unroll
        for (int e = 0; e < 16; ++e) s1 += y[e];
        s1 = sum4(s1);
        const float mean = s1 * (1.f / 64.f);
        float s2 = 0.f;
#pragma unroll
        for (int e = 0; e < 16; ++e) { const float d = y[e] - mean; s2 += d * d; }
        s2 = sum4(s2);
        const float rstd = rsqrtf(s2 * (1.f / 64.f) + 64e-5f);
        float o[16];
#pragma unroll
        for (int e = 0; e < 16; ++e) o[e] = ((y[e] - mean) * rstd * lw[e] + lb[e] + bon * v[e]) * g[e];
        v4u o0, o1;
        o0.x = pk2(o[0], o[1]); o0.y = pk2(o[2], o[3]); o0.z = pk2(o[4], o[5]); o0.w = pk2(o[6], o[7]);
        o1.x = pk2(o[8], o[9]); o1.y = pk2(o[10], o[11]); o1.z = pk2(o[12], o[13]); o1.w = pk2(o[14], o[15]);
        *(v4u*)(Y + (size_t)m * D + c0) = o0; *(v4u*)(Y + (size_t)m * D + c0 + 8) = o1;
    }
}

__device__ __forceinline__ void phase_ssd_conv(const Ctx& c, KArgs& a, int l) {
    unsigned char* ws = a.ws;
    const bf16* PS = (const bf16*)(ws + WS_OV + OV_PS);
    bf16* XBC = (bf16*)(ws + WS_OV + OV_XBC);
    float* DT = (float*)(ws + WS_OV + OV_DT); float* DA = (float*)(ws + WS_OV + OV_DA);
    const float* cw = a.in[I_CW] + (size_t)l * 4 * 3072; const float* cb = a.in[I_CB] + (size_t)l * 3072;
    const int gw = c.bid * 8 + c.wave, NGW = c.G * 8, lane = c.lane;
    constexpr int RUN = 16, NRUN = MH / RUN;
    for (int it = gw; it < 2 * NRUN; it += NGW) {
        const int cb_ = 4 + (it & 1), run = it >> 1, ch0 = cb_ * 512 + lane * 8, m0 = run * RUN;
        float w[4][8], bias[8];
#pragma unroll
        for (int j = 0; j < 4; ++j)
#pragma unroll
            for (int e = 0; e < 8; ++e) w[j][e] = cw[j * 3072 + ch0 + e];
#pragma unroll
        for (int e = 0; e < 8; ++e) bias[e] = cb[ch0 + e];
        float x0[8], x1[8], x2[8], x3[8];
        const bf16* base = PS + (size_t)m0 * N2P + 2048 + ch0;
        const int t0 = m0 & (T - 1);
        if (t0 >= 3) { unpack8(*(const v4u*)(base - 3 * N2P), x0); unpack8(*(const v4u*)(base - 2 * N2P), x1); unpack8(*(const v4u*)(base - N2P), x2); }
        else {
#pragma unroll
            for (int e = 0; e < 8; ++e) { x0[e] = 0.f; x1[e] = 0.f; x2[e] = 0.f; }
        }
        v4u nx = *(const v4u*)base;
#pragma unroll 4
        for (int i = 0; i < RUN; ++i) {
            unpack8(nx, x3);
            if (i + 1 < RUN) nx = *(const v4u*)(base + (size_t)(i + 1) * N2P);
            float o[8];
#pragma unroll
            for (int e = 0; e < 8; ++e) { const float y = bias[e] + x0[e] * w[0][e] + x1[e] * w[1][e] + x2[e] * w[2][e] + x3[e] * w[3][e]; o[e] = siluf_(y); x0[e] = x1[e]; x1[e] = x2[e]; x2[e] = x3[e]; }
            *(v4u*)(XBC + (size_t)(m0 + i) * 3072 + ch0) = pack8(o);
        }
    }
}

__device__ __forceinline__ void tr_bm2(unsigned a, bf16x8& f0, bf16x8& f1) {
    s16x4 l0, h0, l1, h1;
    asm volatile("ds_read_b64_tr_b16 %0, %4\n\tds_read_b64_tr_b16 %1, %4 offset:1088\n\tds_read_b64_tr_b16 %2, %4 offset:8704\n\tds_read_b64_tr_b16 %3, %4 offset:9792\n\ts_waitcnt lgkmcnt(0)"
                 : "=&v"(l0), "=&v"(h0), "=&v"(l1), "=&v"(h1) : "v"(a) : "memory");
    f0 = __builtin_shufflevector(l0, h0, 0, 1, 2, 3, 4, 5, 6, 7); f1 = __builtin_shufflevector(l1, h1, 0, 1, 2, 3, 4, 5, 6, 7);
}
__device__ __forceinline__ void tr_x2(unsigned a, bf16x8& f0, bf16x8& f1) {
    s16x4 l0, h0, l1, h1;
    asm volatile("ds_read_b64_tr_b16 %0, %4\n\tds_read_b64_tr_b16 %1, %4 offset:320\n\tds_read_b64_tr_b16 %2, %4 offset:2560\n\tds_read_b64_tr_b16 %3, %4 offset:2880\n\ts_waitcnt lgkmcnt(0)"
                 : "=&v"(l0), "=&v"(h0), "=&v"(l1), "=&v"(h1) : "v"(a) : "memory");
    f0 = __builtin_shufflevector(l0, h0, 0, 1, 2, 3, 4, 5, 6, 7); f1 = __builtin_shufflevector(l1, h1, 0, 1, 2, 3, 4, 5, 6, 7);
}
__device__ __forceinline__ void tr_x4(unsigned a, bf16x8& f00, bf16x8& f01, bf16x8& f10, bf16x8& f11) {
    s16x4 l0, h0, l1, h1, l2, h2, l3, h3;
    asm volatile("ds_read_b64_tr_b16 %0, %8\n\tds_read_b64_tr_b16 %1, %8 offset:320\n\tds_read_b64_tr_b16 %2, %8 offset:2560\n\tds_read_b64_tr_b16 %3, %8 offset:2880\n\t"
                 "ds_read_b64_tr_b16 %4, %8 offset:32\n\tds_read_b64_tr_b16 %5, %8 offset:352\n\tds_read_b64_tr_b16 %6, %8 offset:2592\n\tds_read_b64_tr_b16 %7, %8 offset:2912\n\ts_waitcnt lgkmcnt(0)"
                 : "=&v"(l0), "=&v"(h0), "=&v"(l1), "=&v"(h1), "=&v"(l2), "=&v"(h2), "=&v"(l3), "=&v"(h3) : "v"(a) : "memory");
    f00 = __builtin_shufflevector(l0, h0, 0, 1, 2, 3, 4, 5, 6, 7); f01 = __builtin_shufflevector(l1, h1, 0, 1, 2, 3, 4, 5, 6, 7);
    f10 = __builtin_shufflevector(l2, h2, 0, 1, 2, 3, 4, 5, 6, 7); f11 = __builtin_shufflevector(l3, h3, 0, 1, 2, 3, 4, 5, 6, 7);
}
__device__ __forceinline__ void phase_ssd_scan(const Ctx& c, KArgs& a, int l) {
    unsigned char* ws = a.ws;
    const bf16* PS = (const bf16*)(ws + WS_OV + OV_PS);
    bf16* XBC = (bf16*)(ws + WS_OV + OV_XBC);
    const float* cw = a.in[I_CW] + (size_t)l * 4 * 3072; const float* cb = a.in[I_CB] + (size_t)l * 3072;
    const float* DT = (const float*)(ws + WS_OV + OV_DT); const float* ACS = (const float*)(ws + WS_OV + OV_DA);
    constexpr int SC = 136, SM = 72, SX = 40;
    LAS bf16* Cm = (LAS bf16*)c.lds;
    LAS bf16* Bm = Cm + 64 * SC;
    LAS bf16* Xd = Bm + 64 * SC;
    LAS bf16* Xs = Xd + 64 * SX;
    LAS bf16* Xr = Xs + 64 * SX;
    LAS bf16* MtT = Xr + 64 * SX;
    LAS bf16* SL = MtT + 64 * SM;
    LAS float* acsL = (LAS float*)(SL + 32 * SC);
    const unsigned BmB = (unsigned)(size_t)Bm, XdB = (unsigned)(size_t)Xd, XsB = (unsigned)(size_t)Xs;
    const int tid = c.tid, lane = c.lane, w = c.wave, r = lane & 15, q = lane >> 4;
    const int sj = tid >> 3, sn = (tid & 7) * 16, sp = (tid & 7) * 4;
    const int trq = ((lane & 15) >> 2), trp = lane & 3;
    const unsigned troffB = (unsigned)(((8 * q + trq) * SC + 4 * trp) * 2), troffX = (unsigned)(((8 * q + trq) * SX + 4 * trp) * 2);
    for (int unit = c.bid; unit < 256; unit += c.G) {
        const int b = unit >> 6, h = (unit >> 1) & 31, ph = unit & 1, g = h >> 3;
        const size_t m0 = (size_t)b * T;
        f32x4 st[2] = {(f32x4){0.f, 0.f, 0.f, 0.f}, (f32x4){0.f, 0.f, 0.f, 0.f}};
        for (int e = tid; e < 32 * SC / 2; e += 512) ((LAS unsigned*)SL)[e] = 0u;
        v4u gB0, gB1, gC0, gC1; v2u gX0, gX1, gX2, gX3; float gacs, gacsE, gdt;
        const int chx = h * 64 + ph * 32 + sp; const float Dh = a.in[I_SD][l * 32 + h];
        float cwt[4][4], cbs[4];
#pragma unroll
        for (int e2 = 0; e2 < 4; ++e2) { cbs[e2] = cb[chx + e2];
#pragma unroll
            for (int j = 0; j < 4; ++j) cwt[j][e2] = cw[j * 3072 + chx + e2]; }
#define SS_LOAD(chunk) do { const size_t row = m0 + (size_t)(chunk) * 64 + sj; const bf16* xr = XBC + row * 3072; \
            gB0 = *(const v4u*)(xr + 2048 + g * 128 + sn); gB1 = *(const v4u*)(xr + 2048 + g * 128 + sn + 8); \
            gC0 = *(const v4u*)(xr + 2560 + g * 128 + sn); gC1 = *(const v4u*)(xr + 2560 + g * 128 + sn + 8); \
            { const int t_ = (chunk) * 64 + sj; const bf16* pr_ = PS + row * N2P + 2048 + chx; const v2u z2 = (v2u){0u, 0u}; \
              gX3 = *(const v2u*)pr_; gX2 = t_ >= 1 ? *(const v2u*)(pr_ - N2P) : z2; gX1 = t_ >= 2 ? *(const v2u*)(pr_ - 2 * N2P) : z2; gX0 = t_ >= 3 ? *(const v2u*)(pr_ - 3 * N2P) : z2; } \
            gacs = ACS[row * 32 + h]; gacsE = ACS[(m0 + (size_t)(chunk) * 64 + 63) * 32 + h]; gdt = DT[row * 32 + h]; } while (0)
#define SS_STAGE() do { \
            *(LAS v4u*)(Bm + sj * SC + sn) = gB0; *(LAS v4u*)(Bm + sj * SC + sn + 8) = gB1; *(LAS v4u*)(Cm + sj * SC + sn) = gC0; *(LAS v4u*)(Cm + sj * SC + sn + 8) = gC1; \
            const float sc_ = gdt * __expf(gacsE - gacs); \
            const float r0_[4] = {bflo(gX0.x), bfhi(gX0.x), bflo(gX0.y), bfhi(gX0.y)}, r1_[4] = {bflo(gX1.x), bfhi(gX1.x), bflo(gX1.y), bfhi(gX1.y)}; \
            const float r2_[4] = {bflo(gX2.x), bfhi(gX2.x), bflo(gX2.y), bfhi(gX2.y)}, r3_[4] = {bflo(gX3.x), bfhi(gX3.x), bflo(gX3.y), bfhi(gX3.y)}; \
            float xa_[4]; _Pragma("unroll") for (int e2 = 0; e2 < 4; ++e2) xa_[e2] = siluf_(cbs[e2] + r0_[e2] * cwt[0][e2] + r1_[e2] * cwt[1][e2] + r2_[e2] * cwt[2][e2] + r3_[e2] * cwt[3][e2]); \
            const float x0_ = xa_[0], x1_ = xa_[1], x2_ = xa_[2], x3_ = xa_[3]; \
            v2u o1_, o2_; o1_.x = pk2(x0_ * gdt, x1_ * gdt); o1_.y = pk2(x2_ * gdt, x3_ * gdt); o2_.x = pk2(x0_ * sc_, x1_ * sc_); o2_.y = pk2(x2_ * sc_, x3_ * sc_); \
            *(LAS v2u*)(Xd + sj * SX + sp) = o1_; *(LAS v2u*)(Xs + sj * SX + sp) = o2_; { v2u o3_; o3_.x = pk2(x0_, x1_); o3_.y = pk2(x2_, x3_); *(LAS v2u*)(Xr + sj * SX + sp) = o3_; } \
            if ((tid & 7) == 0) acsL[sj] = gacs; } while (0)
        SS_LOAD(0);
        SS_STAGE();
        __syncthreads();
        for (int ch = 0; ch < T / 64; ++ch) {
            if (ch + 1 < T / 64) SS_LOAD(ch + 1);
            {
                const int jt = w >> 1, it0 = 2 * (w & 1);
                f32x4 acc0 = (f32x4){0.f, 0.f, 0.f, 0.f}, acc1 = acc0;
                if (it0 + 1 >= jt) {
#pragma unroll
                    for (int ks = 0; ks < 4; ++ks) {
                        const bf16x8 af = *(const LAS bf16x8*)(Bm + (16 * jt + r) * SC + 32 * ks + 8 * q);
                        const bf16x8 b0 = *(const LAS bf16x8*)(Cm + (16 * it0 + r) * SC + 32 * ks + 8 * q);
                        const bf16x8 b1 = *(const LAS bf16x8*)(Cm + (16 * (it0 + 1) + r) * SC + 32 * ks + 8 * q);
                        acc0 = __builtin_amdgcn_mfma_f32_16x16x32_bf16(af, b0, acc0, 0, 0, 0);
                        acc1 = __builtin_amdgcn_mfma_f32_16x16x32_bf16(af, b1, acc1, 0, 0, 0);
                    }
                }
                const int i0 = 16 * it0 + r, i1 = i0 + 16;
                const float ai0 = acsL[i0], ai1 = acsL[i1];
                float m0v[4], m1v[4];
#pragma unroll
                for (int e = 0; e < 4; ++e) { const int j = 16 * jt + 4 * q + e; const float aj = acsL[j];
                    m0v[e] = (j <= i0) ? acc0[e] * __expf(ai0 - aj) : 0.f; m1v[e] = (j <= i1) ? acc1[e] * __expf(ai1 - aj) : 0.f; }
                { v2u o0, o1; o0.x = pk2(m0v[0], m0v[1]); o0.y = pk2(m0v[2], m0v[3]); o1.x = pk2(m1v[0], m1v[1]); o1.y = pk2(m1v[2], m1v[3]);
                  *(LAS v2u*)(MtT + i0 * SM + 16 * jt + 4 * q) = o0; *(LAS v2u*)(MtT + i1 * SM + 16 * jt + 4 * q) = o1; }
            }
            lds_barrier();
            {
                const int it = w >> 1, pt = w & 1;
                f32x4 accD = (f32x4){0.f, 0.f, 0.f, 0.f}, accO = accD;
                {
                    bf16x8 xb0, xb1; tr_x2(XdB + troffX + 32u * pt, xb0, xb1);
                    const bf16x8 af0 = *(const LAS bf16x8*)(MtT + (16 * it + r) * SM + 8 * q);
                    accD = __builtin_amdgcn_mfma_f32_16x16x32_bf16(af0, xb0, accD, 0, 0, 0);
                    if (it >= 2) {
                        const bf16x8 af1 = *(const LAS bf16x8*)(MtT + (16 * it + r) * SM + 32 + 8 * q);
                        accD = __builtin_amdgcn_mfma_f32_16x16x32_bf16(af1, xb1, accD, 0, 0, 0);
                    }
                }
#pragma unroll
                for (int ks = 0; ks < 4; ++ks) {
                    const bf16x8 af = *(const LAS bf16x8*)(Cm + (16 * it + r) * SC + 32 * ks + 8 * q);
                    const bf16x8 bf_ = *(const LAS bf16x8*)(SL + (16 * pt + r) * SC + 32 * ks + 8 * q);
                    accO = __builtin_amdgcn_mfma_f32_16x16x32_bf16(af, bf_, accO, 0, 0, 0);
                }
                const int p = 16 * pt + r;
#pragma unroll
                for (int e = 0; e < 4; ++e) { const int i = 16 * it + 4 * q + e; const float y = accD[e] + __expf(acsL[i]) * accO[e] + Dh * bf1(Xr[i * SX + p]);
                    XBC[(m0 + (size_t)ch * 64 + i) * 3072 + h * 64 + ph * 32 + p] = (bf16)f2bf(y); }
            }
            {
                const float dec = __expf(acsL[63]);
                bf16x8 a0, a1, bx[2][2];
                tr_bm2(BmB + troffB + 32u * w, a0, a1);
                tr_x4(XsB + troffX, bx[0][0], bx[0][1], bx[1][0], bx[1][1]);
#pragma unroll
                for (int pt = 0; pt < 2; ++pt) {
                    f32x4 s = st[pt] * dec;
                    s = __builtin_amdgcn_mfma_f32_16x16x32_bf16(a0, bx[pt][0], s, 0, 0, 0);
                    s = __builtin_amdgcn_mfma_f32_16x16x32_bf16(a1, bx[pt][1], s, 0, 0, 0);
                    st[pt] = s;
                }
            }
            lds_barrier();
#pragma unroll
            for (int pt = 0; pt < 2; ++pt) { v2u o; o.x = pk2c(st[pt][0], st[pt][1]); o.y = pk2c(st[pt][2], st[pt][3]);
                *(LAS v2u*)(SL + (16 * pt + r) * SC + 16 * w + 4 * q) = o; }
            if (ch + 1 < T / 64) SS_STAGE();
            lds_barrier();
        }
#undef SS_LOAD
#undef SS_STAGE
    }
}

__device__ __forceinline__ void phase_ssd_post(const Ctx& c, KArgs& a, int l) {
    unsigned char* ws = a.ws;
    bf16* PS = (bf16*)(ws + WS_OV + OV_PS);
    const bf16* XBC = (const bf16*)(ws + WS_OV + OV_XBC);
    const int lane = c.lane, c0 = 32 * lane;
    const float* ng = a.in[I_SNG] + (size_t)l * 2048 + c0;
    const int gw = c.bid * 8 + c.wave, NGW = c.G * 8;
    v4u nyy[4], nzz[4];
#define SP_LOAD(mm) do { _Pragma("unroll") for (int q = 0; q < 4; ++q) { nyy[q] = *(const v4u*)(XBC + (size_t)(mm) * 3072 + c0 + 8 * q); nzz[q] = *(const v4u*)(PS + (size_t)(mm) * N2P + c0 + 8 * q); } } while (0)
    if (gw < MH) SP_LOAD(gw);
    for (int m = gw; m < MH; m += NGW) {
        float y[32]; float ss = 0.f;
        v4u cyy[4], czz[4];
#pragma unroll
        for (int q = 0; q < 4; ++q) { cyy[q] = nyy[q]; czz[q] = nzz[q]; }
        if (m + NGW < MH) SP_LOAD(m + NGW);
#pragma unroll
        for (int q = 0; q < 4; ++q) {
            float yy[8], zz[8];
            unpack8(cyy[q], yy); unpack8(czz[q], zz);
#pragma unroll
            for (int e = 0; e < 8; ++e) { const float v = yy[e] * siluf_(zz[e]); y[8 * q + e] = v; ss += v * v; }
        }
        ss = sum16(ss);
        const float r = rsqrtf(ss * (1.f / 512.f) + 1e-6f);
#pragma unroll
        for (int q = 0; q < 4; ++q) {
            float o[8];
#pragma unroll
            for (int e = 0; e < 8; ++e) o[e] = y[8 * q + e] * r * ng[8 * q + e];
            *(v4u*)(PS + (size_t)m * N2P + 2048 + c0 + 8 * q) = pack8(o);
        }
    }
}

__device__ __forceinline__ void phase_peer_convert(const Ctx& c, KArgs& a, int l) {
    unsigned char* ws = a.ws;
    const int gw = c.bid * 8 + c.wave, NGW = c.G * 8, lane = c.lane;
    f32x4 n0, n1, n2, n3;
#define PC_LOAD(itt) do { const int tb_ = (itt) >= NEXP, e_ = (itt) - tb_ * NEXP; const float* s_ = (tb_ ? a.in[I_PU] : a.in[I_PD]) + ((size_t)l * NEXP + e_) * D + 16 * lane; \
        n0 = *(const f32x4*)s_; n1 = *(const f32x4*)(s_ + 4); n2 = *(const f32x4*)(s_ + 8); n3 = *(const f32x4*)(s_ + 12); } while (0)
    if (gw < 2 * NEXP) PC_LOAD(gw);
    for (int it = gw; it < 2 * NEXP; it += NGW) {
        const int tb = it >= NEXP, e = it - tb * NEXP;
        const f32x4 x0 = n0, x1 = n1, x2 = n2, x3 = n3;
        if (it + NGW < 2 * NEXP) PC_LOAD(it + NGW);
        float am = fmaxf(fmaxf(fmaxf(fabsf(x0.x), fabsf(x0.y)), fmaxf(fabsf(x0.z), fabsf(x0.w))), fmaxf(fmaxf(fabsf(x1.x), fabsf(x1.y)), fmaxf(fabsf(x1.z), fabsf(x1.w))));
        am = fmaxf(am, fmaxf(fmaxf(fmaxf(fabsf(x2.x), fabsf(x2.y)), fmaxf(fabsf(x2.z), fabsf(x2.w))), fmaxf(fmaxf(fabsf(x3.x), fabsf(x3.y)), fmaxf(fabsf(x3.z), fabsf(x3.w)))));
#pragma unroll
        for (int o = 1; o < 64; o <<= 1) am = fmaxf(am, __shfl_xor(am, o));
        am = fmaxf(am, 1e-30f);
        const float s = 384.f / am;
        v4u q;
        int w;
        w = __builtin_amdgcn_cvt_pk_fp8_f32(x0.x * s, x0.y * s, 0, false); w = __builtin_amdgcn_cvt_pk_fp8_f32(x0.z * s, x0.w * s, w, true); q.x = (unsigned)w;
        w = __builtin_amdgcn_cvt_pk_fp8_f32(x1.x * s, x1.y * s, 0, false); w = __builtin_amdgcn_cvt_pk_fp8_f32(x1.z * s, x1.w * s, w, true); q.y = (unsigned)w;
        w = __builtin_amdgcn_cvt_pk_fp8_f32(x2.x * s, x2.y * s, 0, false); w = __builtin_amdgcn_cvt_pk_fp8_f32(x2.z * s, x2.w * s, w, true); q.z = (unsigned)w;
        w = __builtin_amdgcn_cvt_pk_fp8_f32(x3.x * s, x3.y * s, 0, false); w = __builtin_amdgcn_cvt_pk_fp8_f32(x3.z * s, x3.w * s, w, true); q.w = (unsigned)w;
        *(v4u*)(ws + WS_OV + (tb ? OV_UP : OV_DOWN) + (size_t)e * D + 16 * lane) = q;
        if (lane == 0) ((float*)(ws + WS_OV + OV_PSCALE))[it] = am * (1.f / 384.f);
    }
}

template <class TT> __device__ __forceinline__ void ce_desc(TT& a, TT& b) { const TT hi = a > b ? a : b, lo = a > b ? b : a; a = hi; b = lo; }
__device__ __forceinline__ void cef(float& a, float& b) { const float hi = fmaxf(a, b), lo = fminf(a, b); a = hi; b = lo; }
__device__ __forceinline__ void ced(double& a, double& b) { const double hi = fmax(a, b), lo = fmin(a, b); a = hi; b = lo; }
template <class TT, class CE> __device__ __forceinline__ void bitonic_sort16_desc(TT (&v)[16], CE ce) {
#pragma unroll
    for (int k = 2; k <= 16; k <<= 1)
#pragma unroll
        for (int j = k >> 1; j > 0; j >>= 1)
#pragma unroll
            for (int i = 0; i < 16; ++i) { const int p = i ^ j; if (p > i) { if ((i & k) == 0) ce(v[i], v[p]); else ce(v[p], v[i]); } }
}
template <class TT, class CE> __device__ __forceinline__ void bitonic_merge16_desc(TT (&v)[16], CE ce) {
#pragma unroll
    for (int j = 8; j > 0; j >>= 1)
#pragma unroll
        for (int i = 0; i < 16; ++i) { const int p = i ^ j; if (p > i) ce(v[i], v[p]); }
}
struct CEF { __device__ __forceinline__ void operator()(float& a, float& b) const { cef(a, b); } };
struct CED { __device__ __forceinline__ void operator()(double& a, double& b) const { ced(a, b); } };

__device__ __forceinline__ void top16_of_128(const bf16* p, float (&top)[16]) {
#pragma unroll
    for (int grp = 0; grp < 8; ++grp) {
        float cur[16];
        const v4u q0 = *(const v4u*)(p + grp * 16), q1 = *(const v4u*)(p + grp * 16 + 8);
        const unsigned w[8] = {q0.x, q0.y, q0.z, q0.w, q1.x, q1.y, q1.z, q1.w};
#pragma unroll
        for (int e = 0; e < 8; ++e) {
            const unsigned lo = w[e] << 16, hi = w[e] & 0xffff0000u;
            const unsigned i0 = grp * 16 + 2 * e, i1 = i0 + 1;
            cur[2 * e] = __builtin_bit_cast(float, lo | ((lo >> 31) ? i0 : (127u - i0)));
            cur[2 * e + 1] = __builtin_bit_cast(float, hi | ((hi >> 31) ? i1 : (127u - i1)));
        }
        bitonic_sort16_desc(cur, CEF());
        if (grp == 0) {
#pragma unroll
            for (int i = 0; i < 16; ++i) top[i] = cur[i];
        } else {
#pragma unroll
            for (int i = 0; i < 16; ++i) top[i] = fmaxf(top[i], cur[15 - i]);
            bitonic_merge16_desc(top, CEF());
        }
    }
}
__device__ __forceinline__ unsigned key_index(float k) { const unsigned u = __builtin_bit_cast(unsigned, k); const unsigned lo = u & 0x7fu; return (u >> 31) ? lo : 127u - lo; }
__device__ __forceinline__ float key_value(float k) { return __builtin_bit_cast(float, __builtin_bit_cast(unsigned, k) & 0xffff0000u); }

__device__ __forceinline__ void phase_peer_topk(const Ctx& c, KArgs& a) {
    unsigned char* ws = a.ws;
    const bf16* SC = (const bf16*)(ws + WS_OV + OV_SC);
    int* IDX = (int*)(ws + WS_OV + OV_IDX); float* GATE = (float*)(ws + WS_OV + OV_GATE);
    for (int it = c.bid * 512 + c.tid; it < M * 8; it += c.G * 512) {
        const bf16* p = SC + (size_t)it * 256;
        float t0[16], t1[16];
        top16_of_128(p, t0); top16_of_128(p + 128, t1);
        float v0[16], v1[16]; unsigned i0[16], i1[16];
#pragma unroll
        for (int i = 0; i < 16; ++i) { v0[i] = key_value(t0[i]); v1[i] = key_value(t1[i]); i0[i] = key_index(t0[i]); i1[i] = key_index(t1[i]); }
        double top[16];
        const double NEG = -1.0e300;
#pragma unroll
        for (int grp = 0; grp < 4; ++grp) {
            double cur[16];
#pragma unroll
            for (int s = 0; s < 16; ++s) cur[s] = NEG;
            int n = 0;
#pragma unroll
            for (int i = 0; i < 16; ++i)
#pragma unroll
                for (int j = 0; j < 16; ++j) if ((i + 1) * (j + 1) <= 16) {
                    if (n / 16 == grp) {
                        const double d = (double)(v0[i] + v1[j]);
                        const unsigned long long eid = (unsigned long long)(i0[i] * 128u + i1[j]);
                        const unsigned long long bits = __builtin_bit_cast(unsigned long long, d);
                        cur[n % 16] = __builtin_bit_cast(double, bits | ((bits >> 63) ? eid : (16383ull - eid)));
                    }
                    ++n;
                }
            bitonic_sort16_desc(cur, CED());
            if (grp == 0) {
#pragma unroll
                for (int i = 0; i < 16; ++i) top[i] = cur[i];
            } else {
#pragma unroll
                for (int i = 0; i < 16; ++i) top[i] = fmax(top[i], cur[15 - i]);
                bitonic_merge16_desc(top, CED());
            }
        }
        float sv[16]; int id[16];
#pragma unroll
        for (int i = 0; i < 16; ++i) { const unsigned long long bits = __builtin_bit_cast(unsigned long long, top[i]); const unsigned lo = (unsigned)(bits & 0x3fffull);
            id[i] = (int)((bits >> 63) ? lo : 16383u - lo); sv[i] = (float)top[i]; }
        float den = 0.f, ex[16];
#pragma unroll
        for (int i = 0; i < 16; ++i) { ex[i] = __expf(sv[i] - sv[0]); den += ex[i]; }
        const float inv = 1.f / den;
        unsigned cw[4] = {0u, 0u, 0u, 0u};
#pragma unroll
        for (int i = 0; i < 16; ++i) { const unsigned s = (unsigned)id[i] >> PEER_SLICE_SHIFT, inc = 1u << (8 * (s & 3)), ws_ = s >> 2;
            cw[0] += ws_ == 0 ? inc : 0u; cw[1] += ws_ == 1 ? inc : 0u; cw[2] += ws_ == 2 ? inc : 0u; cw[3] += ws_ == 3 ? inc : 0u; }
        unsigned lp[4], tot[4], st[4];
        const int l8 = c.lane & 7;
#pragma unroll
        for (int k = 0; k < 4; ++k) { unsigned v = cw[k];
#pragma unroll
            for (int o = 1; o < 8; o <<= 1) { const unsigned y = __shfl_up(v, o, 8); v += (l8 >= o) ? y : 0u; }
            tot[k] = __shfl(v, 7, 8); lp[k] = v - cw[k]; }
        {   unsigned carry = 0u;
#pragma unroll
            for (int k = 0; k < 4; ++k) { st[k] = tot[k] * 0x01010100u + carry * 0x01010101u; carry += (tot[k] * 0x01010101u) >> 24; } }
        unsigned run[4] = {st[0] + lp[0], st[1] + lp[1], st[2] + lp[2], st[3] + lp[3]};
        const size_t tok = (size_t)(it >> 3);
#pragma unroll
        for (int i = 0; i < 16; ++i) { const unsigned s = (unsigned)id[i] >> PEER_SLICE_SHIFT, sh = 8 * (s & 3), ws_ = s >> 2, inc = 1u << sh;
            const unsigned wsel = ws_ == 0 ? run[0] : (ws_ == 1 ? run[1] : (ws_ == 2 ? run[2] : run[3]));
            const unsigned pos = (wsel >> sh) & 0xffu;
            run[0] += ws_ == 0 ? inc : 0u; run[1] += ws_ == 1 ? inc : 0u; run[2] += ws_ == 2 ? inc : 0u; run[3] += ws_ == 3 ? inc : 0u;
            IDX[tok * 128 + pos] = id[i]; GATE[tok * 128 + pos] = ex[i] * inv; }
        if (l8 == 0) ((v4u*)(ws + WS_OV + OV_POFF))[tok] = (v4u){st[0], st[1], st[2], st[3]};
    }
}

__device__ __forceinline__ float gelu_tanh(float x) { const float u = 0.7978845608f * (x + 0.044715f * x * x * x); const float t = 1.f - 2.f / (1.f + __expf(2.f * u)); return 0.5f * x * (1.f + t); }
__device__ __forceinline__ void unpack16_fp8(const v4u& q, float (&o)[16]) {
    const unsigned w[4] = {q.x, q.y, q.z, q.w};
#pragma unroll
    for (int i = 0; i < 4; ++i) { const f32x2 lo = __builtin_amdgcn_cvt_pk_f32_fp8((int)w[i], false), hi = __builtin_amdgcn_cvt_pk_f32_fp8((int)w[i], true);
        o[4 * i] = lo.x; o[4 * i + 1] = lo.y; o[4 * i + 2] = hi.x; o[4 * i + 3] = hi.y; }
}
__device__ __forceinline__ int slice_start(unsigned o0, unsigned o1, unsigned o2, unsigned o3, int s) {
    const unsigned wsel = s < 4 ? o0 : (s < 8 ? o1 : (s < 12 ? o2 : o3));
    return s >= PEER_NSLICE ? 128 : (int)((wsel >> (8 * (s & 3))) & 0xffu);
}
template <int MODE> __device__ __forceinline__ void phase_peer_down(const Ctx& c, KArgs& a, int l, int qset) {
    unsigned char* ws = a.ws;
    const unsigned char* U8 = ws + WS_OV + OV_U8; const float* XS = (const float*)(ws + WS_OV + OV_XS);
    const unsigned char* DN = ws + WS_OV + OV_DOWN;
    const int* IDX = (const int*)(ws + WS_OV + OV_IDX);
    const v4u* POFF = (const v4u*)(ws + WS_OV + OV_POFF);
    float* ACT = (float*)(ws + WS_OV + (qset ? 278 * MiB : OV_ACT));
    unsigned* QC = (unsigned*)(ws + WS_CTL) + CW_QUEUE + (qset * 2 + l) * PEER_NSLICE * 64;
    constexpr int RS = 528;
    LAS unsigned char* wb = c.lds + c.wave * (8192 + 16 * RS);
    LAS unsigned* lpk = (LAS unsigned*)wb;
    LAS unsigned char* RB = wb + 8192;
    const int lane = c.lane, r16 = lane & 15, q = lane >> 4, hsel = lane >> 5, l32 = lane & 31;
    constexpr int NBLK = M / 16;
    const int s = c.bid & (PEER_NSLICE - 1);
    const int nrank = ((c.G - s + PEER_NSLICE - 1) >> 3) * 8, rank = (c.bid >> 3) * 8 + c.wave;
    {
#pragma unroll 1
        for (int blk = rank; blk < NBLK; blk += nrank) {
            const size_t mb = (size_t)blk * 16;
            v4u xb[16];
            { const unsigned char* xp = U8 + (mb + r16) * D + 16 * q;
#pragma unroll
              for (int j = 0; j < 16; ++j) xb[j] = *(const v4u*)(xp + 64 * j); }
            const float xs = XS[mb + r16];
            int pav = 0, nv = 0;
            if (lane < 16) { const v4u po = POFF[mb + lane]; pav = slice_start(po.x, po.y, po.z, po.w, s); nv = slice_start(po.x, po.y, po.z, po.w, s + 1) - pav; }
            int incl = nv;
#pragma unroll
            for (int o = 1; o < 16; o <<= 1) { const int y = __shfl_up(incl, o, 16); incl += (r16 >= o) ? y : 0; }
            const int offv = incl - nv;
            const int P = __builtin_amdgcn_readlane(incl, 15);
            {
                int idr[16];
#pragma unroll
                for (int ti = 0; ti < 16; ++ti) { const int pa = __builtin_amdgcn_readlane(pav, ti); const int e = pa + lane; idr[ti] = IDX[(mb + ti) * 128 + (e < 127 ? e : 127)]; }
#pragma unroll
                for (int ti = 0; ti < 16; ++ti) { const int pa = __builtin_amdgcn_readlane(pav, ti), n = __builtin_amdgcn_readlane(nv, ti), off = __builtin_amdgcn_readlane(offv, ti);
                    if (lane < n) lpk[off + lane] = (unsigned)idr[ti] | ((unsigned)ti << 14) | ((unsigned)(pa + lane) << 18); }
                if (__builtin_amdgcn_ballot_w64(nv > 64) != 0ull) {
#pragma unroll 1
                    for (int ti = 0; ti < 16; ++ti) { const int pa = __builtin_amdgcn_readlane(pav, ti), n = __builtin_amdgcn_readlane(nv, ti), off = __builtin_amdgcn_readlane(offv, ti);
                        if (lane + 64 < n) lpk[off + 64 + lane] = (unsigned)IDX[(mb + ti) * 128 + pa + 64 + lane] | ((unsigned)ti << 14) | ((unsigned)(pa + 64 + lane) << 18); }
                }
            }
            asm volatile("s_waitcnt vmcnt(0) lgkmcnt(0)" ::: "memory");
            const int nb = (P + 15) >> 4;
#define PD_IDS(PW, B) { const v4u ia = *(const LAS v4u*)(lpk + (B) * 16 + 8 * hsel), ib = *(const LAS v4u*)(lpk + (B) * 16 + 8 * hsel + 4); \
                PW[0] = ia.x; PW[1] = ia.y; PW[2] = ia.z; PW[3] = ia.w; PW[4] = ib.x; PW[5] = ib.y; PW[6] = ib.z; PW[7] = ib.w; }
#define PD_LOADH(PW, H) { _Pragma("unroll") for (int i = 0; i < 8; ++i) { const unsigned id = MODE == 1 ? (PW[i] & 63u) : (PW[i] & 16383u); \
                    rr[8 * (H) + i] = *(const v4u*)(DN + (size_t)(id * 1024u + 512u * (H) + 16u * l32)); } }
            if (nb > 0) {
                v4u rr[16];
                { unsigned pw[8]; PD_IDS(pw, 0) PD_LOADH(pw, 0) PD_LOADH(pw, 1) }
#pragma unroll 1
                for (int b = 0; b < nb; ++b) {
                    const int bn = b + 1 < nb ? b + 1 : b;
                    unsigned pwn[8]; PD_IDS(pwn, bn)
                    const v4u mt = *(const LAS v4u*)(lpk + b * 16 + 4 * q);
                    f32x4 acc0 = {0.f, 0.f, 0.f, 0.f}, acc1 = {0.f, 0.f, 0.f, 0.f};
#pragma unroll
                    for (int h = 0; h < 2; ++h) {
#pragma unroll
                        for (int i = 0; i < 8; ++i) *(LAS v4u*)(RB + (8 * hsel + i) * RS + 16 * l32) = rr[8 * h + i];
                        PD_LOADH(pwn, h)
#pragma unroll
                        for (int jj = 0; jj < 8; ++jj) {
                            const v4u av = *(const LAS v4u*)(RB + r16 * RS + 64 * jj + 16 * q);
                            const v4u bv = xb[8 * h + jj];
                            const long a0 = (long)(((unsigned long long)av.y << 32) | av.x), a1 = (long)(((unsigned long long)av.w << 32) | av.z);
                            const long b0 = (long)(((unsigned long long)bv.y << 32) | bv.x), b1 = (long)(((unsigned long long)bv.w << 32) | bv.z);
                            acc0 = __builtin_amdgcn_mfma_f32_16x16x32_fp8_fp8(a0, b0, acc0, 0, 0, 0);
                            acc1 = __builtin_amdgcn_mfma_f32_16x16x32_fp8_fp8(a1, b1, acc1, 0, 0, 0);
                        }
                    }
                    const f32x4 dv = (acc0 + acc1) * xs;
                    const unsigned me[4] = {mt.x, mt.y, mt.z, mt.w};
                    const float dd[4] = {dv.x, dv.y, dv.z, dv.w};
#pragma unroll
                    for (int i = 0; i < 4; ++i) if (b * 16 + 4 * q + i < P && (int)((me[i] >> 14) & 15u) == r16) lpk[b * 16 + 4 * q + i] = __builtin_bit_cast(unsigned, dd[i]);
                }
            }
#pragma unroll
            for (int ti = 0; ti < 16; ++ti) { const int pa = __builtin_amdgcn_readlane(pav, ti), n = __builtin_amdgcn_readlane(nv, ti), off = __builtin_amdgcn_readlane(offv, ti);
                if (lane < n) ACT[(mb + ti) * 128 + pa + lane] = __builtin_bit_cast(float, lpk[off + lane]); }
            if (__builtin_amdgcn_ballot_w64(nv > 64) != 0ull) {
#pragma unroll 1
                for (int ti = 0; ti < 16; ++ti) { const int pa = __builtin_amdgcn_readlane(pav, ti), n = __builtin_amdgcn_readlane(nv, ti), off = __builtin_amdgcn_readlane(offv, ti);
                    if (lane + 64 < n) ACT[(mb + ti) * 128 + pa + 64 + lane] = __builtin_bit_cast(float, lpk[off + 64 + lane]); }
            }
        }
    }
}

template <int FUSE> __device__ __forceinline__ void phase_peer_experts(const Ctx& c, KArgs& a, const float* gnext, const bool commit = true) {
    unsigned char* ws = a.ws;
    const bf16* U = (const bf16*)(ws + WS_U);
    const unsigned char* DN = ws + WS_OV + OV_DOWN; const unsigned char* UP = ws + WS_OV + OV_UP;
    const float* SCD = (const float*)(ws + WS_OV + OV_PSCALE); const float* SCU = SCD + NEXP;
    const int* IDX = (const int*)(ws + WS_OV + OV_IDX); const float* GATE = (const float*)(ws + WS_OV + OV_GATE);
    const float* ACT = (const float*)(ws + WS_OV + OV_ACT);
    float* H = a.out;
    constexpr int TPW = 16;
    LAS float* wlw = (LAS float*)c.lds + c.wave * (TPW * 128);
    const int lane = c.lane;
    const int gw = c.bid * 8 + c.wave, NGW = c.G * 8;
    const int esel = ((lane & 32) ? 8 : 0) + ((lane & 16) ? 4 : 0) + ((lane & 8) ? 2 : 0) + ((lane & 4) ? 1 : 0);
    const f32x4 gn0 = *(const f32x4*)(gnext + lane * 16), gn1 = *(const f32x4*)(gnext + lane * 16 + 4), gn2 = *(const f32x4*)(gnext + lane * 16 + 8), gn3 = *(const f32x4*)(gnext + lane * 16 + 12);
    for (int m0 = gw; m0 < M; m0 += NGW * TPW) {
#pragma unroll 1
        for (int ti = 0; ti < TPW; ++ti) {
            const int m = m0 + ti * NGW; if (m >= M) break;
            LAS float* wl = wlw + ti * 128;
            const int id0 = IDX[(size_t)m * 128 + lane], id1 = IDX[(size_t)m * 128 + 64 + lane];
            const float g0 = GATE[(size_t)m * 128 + lane], g1 = GATE[(size_t)m * 128 + 64 + lane];
            const float a0 = ACT[(size_t)m * 128 + lane], a1 = ACT[(size_t)m * 128 + 64 + lane];
            wl[lane] = g0 * gelu_tanh(a0 * SCD[id0]) * SCU[id0]; wl[64 + lane] = g1 * gelu_tanh(a1 * SCD[id1]) * SCU[id1];
        }
        asm volatile("s_waitcnt lgkmcnt(0)" ::: "memory");
#pragma unroll 1
        for (int ti = 0; ti < TPW; ++ti) {
            const int m = m0 + ti * NGW; if (m >= M) break;
            const LAS float* wl = wlw + ti * 128;
            const int id0 = IDX[(size_t)m * 128 + lane], id1 = IDX[(size_t)m * 128 + 64 + lane];
            float acc[16];
#pragma unroll
            for (int q = 0; q < 16; ++q) acc[q] = 0.f;
#pragma unroll 1
            for (int bt = 0; bt < 8; ++bt) {
                v4u rr[16];
#pragma unroll
                for (int k = 0; k < 16; ++k) {
                    const int ei = bt * 16 + k;
                    const int row = __builtin_amdgcn_readlane(ei < 64 ? id0 : id1, ei & 63);
                    rr[k] = *(const v4u*)(UP + (size_t)row * D + lane * 16);
                }
#pragma unroll
                for (int k = 0; k < 16; ++k) {
                    const float w = wl[bt * 16 + k];
                    float f[16]; unpack16_fp8(rr[k], f);
#pragma unroll
                    for (int q = 0; q < 16; ++q) acc[q] += w * f[q];
                }
            }
            if (!commit && acc[0] != 123456.789f) continue;
            f32x4* hp = (f32x4*)(H + (size_t)m * D + lane * 16);
            f32x4 h0 = hp[0], h1 = hp[1], h2 = hp[2], h3 = hp[3];
            h0 += (f32x4){acc[0], acc[1], acc[2], acc[3]}; h1 += (f32x4){acc[4], acc[5], acc[6], acc[7]};
            h2 += (f32x4){acc[8], acc[9], acc[10], acc[11]}; h3 += (f32x4){acc[12], acc[13], acc[14], acc[15]};
            float ss = (h0.x * h0.x + h0.y * h0.y) + (h0.z * h0.z + h0.w * h0.w) + (h1.x * h1.x + h1.y * h1.y) + (h1.z * h1.z + h1.w * h1.w)
                     + (h2.x * h2.x + h2.y * h2.y) + (h2.z * h2.z + h2.w * h2.w) + (h3.x * h3.x + h3.y * h3.y) + (h3.z * h3.z + h3.w * h3.w);
            const float rn = rsqrtf(sum64(ss) * (1.f / D) + 1e-6f);
            const f32x4 n0 = h0 * rn * gn0, n1 = h1 * rn * gn1, n2 = h2 * rn * gn2, n3 = h3 * rn * gn3;
            if (FUSE == 0) {
                hp[0] = h0; hp[1] = h1; hp[2] = h2; hp[3] = h3;
                v4u u0, u1; u0.x = pk2(n0.x, n0.y); u0.y = pk2(n0.z, n0.w); u0.z = pk2(n1.x, n1.y); u0.w = pk2(n1.z, n1.w);
                u1.x = pk2(n2.x, n2.y); u1.y = pk2(n2.z, n2.w); u1.z = pk2(n3.x, n3.y); u1.w = pk2(n3.z, n3.w);
                bf16* up_ = (bf16*)(ws + WS_U) + (size_t)m * D + lane * 16;
                *(v4u*)up_ = u0; *(v4u*)(up_ + 8) = u1;
            } else { hp[0] = n0; hp[1] = n1; hp[2] = n2; hp[3] = n3; }
        }
    }
}

constexpr int PH_PER_HALF = 11, PH_PER_LAYER = 1 + 2 * PH_PER_HALF + 5, N_PHASES = 1 + DEPTH * PH_PER_LAYER;
__device__ __forceinline__ Ctx make_ctx() {
    extern __shared__ __attribute__((aligned(16))) unsigned char lds_raw[];
    Ctx c; int t = threadIdx.x; asm volatile("" : "+v"(t)); c.lds = (LAS unsigned char*)lds_raw; c.tid = t; c.lane = t & 63; c.wave = __builtin_amdgcn_readfirstlane(t >> 6); c.G = gridDim.x; c.bid = blockIdx.x; return c; }
__device__ __forceinline__ KArgs* kargs_fresh() { KArgs* p = (KArgs*)__builtin_amdgcn_kernarg_segment_ptr(); asm volatile("" : "+s"(p)); return p; }
#define PH_BEGIN(K) if (lo <= (K) && (K) < hi) { const Ctx c = make_ctx(); KArgs& args = *kargs_fresh(); unsigned char* ws = args.ws; (void)ws;
#define PH_END(K)   if ((K) + 1 < hi) xcd_barrier(bar); }

template <int L, int HB> __device__ __forceinline__ void half_pass(const XcdBarrier& bar, const int lo, const int hi) {
    constexpr int P0 = 1 + L * PH_PER_LAYER + 1 + HB * PH_PER_HALF;
#define WIN ((const bf16*)(ws + WS_WIN + L * WIN_L))
#define Uh ((const bf16*)(ws + WS_U) + (size_t)HB * MH * D)
    PH_BEGIN(P0 + 0) {
        pg8::Gemm g{Uh, WIN, MH, N1P, D, D, 0}; pg8::StaticOrder S; S.init(MH, N1P, c.G, c.bid);
        pg8::EpiRow8<FStoreBf16> E{{(bf16*)(ws + WS_OV + OV_PR), N1P}};
        pg8::gemm_phase(c.lds, g, S, E); if (PROBE_DUP == 5) pg8::gemm_phase(c.lds, g, S, E); } PH_END(P0 + 0)
    PH_BEGIN(P0 + 1) if (PROBE_DUP == 6) phase_rwkv_prep(c, args, L, HB); phase_rwkv_prep(c, args, L, HB); PH_END(P0 + 1)
    PH_BEGIN(P0 + 2) {
        constexpr int NL = L == 0 ? 3072 : 4096;
        pg8::Gemm g{(const bf16*)(ws + WS_OV + OV_AL), (const bf16*)(ws + WS_WLORA + L * WLORA_L), MH, NL, KL, KL, 1}; pg8::StaticOrder S; S.init(MH, NL, c.G, c.bid);
        EpiLora E{(bf16*)(ws + WS_OV + OV_ELOG), (bf16*)(ws + WS_OV + OV_ASIG), (bf16*)(ws + WS_OV + OV_GG), (bf16*)(ws + WS_OV + OV_VMIX),
                               (const bf16*)(ws + WS_VF) + (size_t)HB * MH * D, args.in[I_W0] + (size_t)L * D, args.in[I_A0] + (size_t)L * D, args.in[I_V0]};
        pg8::gemm_phase(c.lds, g, S, E); } PH_END(P0 + 2)
    PH_BEGIN(P0 + 3) phase_rwkv_chunk_par(c, args, L, HB); PH_END(P0 + 3)
    PH_BEGIN(P0 + 4) if (PROBE_DUP == 8) phase_rwkv_chunk_seq(c, args, false); phase_rwkv_chunk_seq(c, args); PH_END(P0 + 4)
    PH_BEGIN(P0 + 5) {
        phase_rwkv_post(c, args, L, HB); __syncthreads();
        pg8::Gemm g{Uh, WIN + (size_t)N1P * D, MH, N2P, D, D, 0}; pg8::StaticOrder S; S.init(MH, N2P, c.G, c.bid);
        pg8::EpiRow8<FStoreBf16> E{{(bf16*)(ws + WS_OV + OV_PS), N2P}};
        pg8::gemm_phase(c.lds, g, S, E); if (PROBE_DUP == 5) pg8::gemm_phase(c.lds, g, S, E); } PH_END(P0 + 5)
    PH_BEGIN(P0 + 6) if (PROBE_DUP == 6) phase_ssd_conv(c, args, L); phase_ssd_conv(c, args, L); PH_END(P0 + 6)
    PH_BEGIN(P0 + 7) phase_ssd_scan(c, args, L); PH_END(P0 + 7)
    PH_BEGIN(P0 + 8) phase_ssd_post(c, args, L); PH_END(P0 + 8)
    PH_BEGIN(P0 + 9) {
      { pg8::Gemm g{Uh, WIN + (size_t)(N1P + N2P) * D, MH, D, D, D, 0}; pg8::StaticOrder S; S.init(MH, D, c.G, c.bid);
        pg8::EpiRow8<FSigmoidBf16> E{{(bf16*)(ws + WS_OV + OV_GATES), 2048}};
        pg8::gemm_phase(c.lds, g, S, E); }
      { pg8::Gemm g{Uh, WIN + (size_t)(N1P + N2P + D) * D, MH, D, D, D, 0}; pg8::StaticOrder S; S.init(MH, D, c.G, c.bid);
        pg8::EpiRow8<FSigmoidBf16> E{{(bf16*)(ws + WS_OV + OV_GATES) + 1024, 2048}};
        pg8::gemm_phase(c.lds, g, S, E); }
      {
        pg8::Gemm g{(const bf16*)(ws + WS_OV + OV_YA), (const bf16*)(ws + WS_WA) + (size_t)L * D * D, MH, D, D, D, 0}; pg8::StaticOrder S; S.init(MH, D, c.G, c.bid);
        pg8::EpiRow8<FMixA> E{{(const bf16*)(ws + WS_OV + OV_GATES), (bf16*)(ws + WS_OV + OV_MIXED)}};
        pg8::gemm_phase(c.lds, g, S, E); }
      {
        pg8::Gemm g{(const bf16*)(ws + WS_OV + OV_PS) + 2048, (const bf16*)(ws + WS_WB) + (size_t)L * D * 2048, MH, D, 2048, N2P, 0}; pg8::StaticOrder S; S.init(MH, D, c.G, c.bid);
        pg8::EpiRow8<FMixB> E{{(const bf16*)(ws + WS_OV + OV_GATES), (bf16*)(ws + WS_OV + OV_MIXED)}};
        pg8::gemm_phase(c.lds, g, S, E); } } PH_END(P0 + 9)
    PH_BEGIN(P0 + 10) {
        pg8::Gemm g{(const bf16*)(ws + WS_OV + OV_MIXED), (const bf16*)(ws + WS_WO) + (size_t)L * D * D, MH, D, D, D, 0}; pg8::StaticOrder S; S.init(MH, D, c.G, c.bid);
        pg8::EpiRow8<FResid> E{{(L == 0 ? args.in[I_X] : (const float*)args.out) + (size_t)HB * MH * D, args.out + (size_t)HB * MH * D}};
        pg8::gemm_phase(c.lds, g, S, E); } PH_END(P0 + 10)
#undef WIN
#undef Uh
}

template <int L> __device__ __forceinline__ void layer_pass(const XcdBarrier& bar, const int lo, const int hi) {
    constexpr int P0 = 1 + L * PH_PER_LAYER, P1 = P0 + 1 + 2 * PH_PER_HALF;
    PH_BEGIN(P0) if (L == 0) phase_rmsnorm(c, args.in[I_X], args.in[I_NMG], (bf16*)(ws + WS_U), nullptr); PH_END(P0)
    half_pass<L, 0>(bar, lo, hi);
    half_pass<L, 1>(bar, lo, hi);
    PH_BEGIN(P1 + 0) phase_rmsnorm_q8(c, args.out, args.in[I_NFG] + (size_t)L * D, (bf16*)(ws + WS_U), ws + WS_OV + OV_U8, (float*)(ws + WS_OV + OV_XS)); phase_peer_convert(c, args, L); PH_END(P1 + 0)
    PH_BEGIN(P1 + 1) {
        pg8::Gemm g{(const bf16*)(ws + WS_U), (const bf16*)(ws + WS_WQK) + (size_t)L * 2048 * D, M, 2048, D, D, 0}; pg8::StaticOrder S; S.init(M, 2048, c.G, c.bid);
        pg8::EpiRow8<FStoreBf16> E{{(bf16*)(ws + WS_OV + OV_SC), 2048}};
        pg8::gemm_phase(c.lds, g, S, E); } PH_END(P1 + 1)
    PH_BEGIN(P1 + 2) if (PROBE_DUP == 4) phase_peer_topk(c, args); phase_peer_topk(c, args); PH_END(P1 + 2)
    PH_BEGIN(P1 + 3) phase_peer_down<0>(c, args, L, 0); if (PROBE_DOWN >= 0) phase_peer_down<PROBE_DOWN < 0 ? 0 : PROBE_DOWN>(c, args, L, 1); PH_END(P1 + 3)
    PH_BEGIN(P1 + 4) phase_peer_experts<L == DEPTH - 1 ? 1 : 0>(c, args, L == DEPTH - 1 ? args.in[I_NFIN] : args.in[I_NMG] + (size_t)(L + 1) * D); PH_END(P1 + 4)
}

__global__ void __launch_bounds__(512, 2) mk_fwd(Args kargs_) {
    extern __shared__ __attribute__((aligned(16))) unsigned char lds_raw[];
    LAS unsigned char* lds0 = (LAS unsigned char*)lds_raw;
    unsigned char* ws0 = kargs_.ws;
    const int lo = kargs_.lo, hi = kargs_.hi;
    if (threadIdx.x < 4) ((LAS unsigned*)(lds0 + LDS_MISC))[threadIdx.x] = 0u;
    __syncthreads();
    XcdBarrier bar; bar.bar = (unsigned*)(ws0 + WS_CTL) + CW_BAR; bar.x = 0; bar.st = (volatile LAS unsigned*)(lds0 + LDS_MISC);
    if (hi - lo > 1) bar = xcd_barrier_post((unsigned*)(ws0 + WS_CTL) + CW_BAR, (volatile LAS unsigned*)(lds0 + LDS_MISC));
    PH_BEGIN(0) phase_prologue(c, args); PH_END(0)
    layer_pass<0>(bar, lo, hi);
    layer_pass<1>(bar, lo, hi);
}

extern "C" void kernel_launch(void* const* d_in, const int* in_sizes, int n_in, void* d_out, int out_size, void* d_ws, size_t ws_size, hipStream_t stream) {
    static int grid = 0;
    if (grid == 0) {
        if (n_in != 32 || out_size != M * D || ws_size < WS_END) { fprintf(stderr, "kernel_launch: unexpected problem (n_in %d, out %d, ws %zu < %zu)\n", n_in, out_size, ws_size, (size_t)WS_END); grid = -1; return; }
        int dev = 0, cus = 0, per_cu = 0;
        if (hipGetDevice(&dev) != hipSuccess || hipDeviceGetAttribute(&cus, hipDeviceAttributeMultiprocessorCount, dev) != hipSuccess) { grid = -1; return; }
        if (hipFuncSetAttribute((const void*)mk_fwd, hipFuncAttributeMaxDynamicSharedMemorySize, LDS_BYTES) != hipSuccess) { fprintf(stderr, "kernel_launch: hipFuncSetAttribute failed\n"); grid = -1; return; }
        if (hipOccupancyMaxActiveBlocksPerMultiprocessor(&per_cu, (const void*)mk_fwd, 512, LDS_BYTES) != hipSuccess || per_cu < 1) { fprintf(stderr, "kernel_launch: occupancy query says %d\n", per_cu); per_cu = 1; }
        (void)hipGetLastError();
        grid = cus;
    }
    if (grid < 0) return;
    (void)hipMemsetAsync((char*)d_ws + WS_CTL, 0, CTL_BYTES, stream);
    Args a{};
    for (int i = 0; i < 32; ++i) a.in[i] = (const float*)d_in[i];
    a.out = (float*)d_out; a.ws = (unsigned char*)d_ws;
#if MK_MULTI
    for (int p = 0; p < N_PHASES; ++p) { a.lo = p; a.hi = p + 1; hipLaunchKernelGGL(mk_fwd, dim3(grid), dim3(512), LDS_BYTES, stream, a); }
#else
    a.lo = 0; a.hi = N_PHASES;
    hipLaunchKernelGGL(mk_fwd, dim3(grid), dim3(512), LDS_BYTES, stream, a);
#endif
}
```

```cpp
#include <hip/hip_runtime.h>
#include <cstdio>
#include <cstdint>

#ifndef PROBE_DUP
#define PROBE_DUP 0
#endif
#ifndef MK_MULTI
#define MK_MULTI 0
#endif

#define GAS __attribute__((address_space(1)))
#define LAS __attribute__((address_space(3)))
typedef unsigned short bf16;
typedef unsigned v4u __attribute__((ext_vector_type(4)));
typedef unsigned v2u __attribute__((ext_vector_type(2)));
typedef float f32x4 __attribute__((ext_vector_type(4)));
typedef float f32x2 __attribute__((ext_vector_type(2)));
typedef short bf16x8 __attribute__((ext_vector_type(8)));
typedef __bf16 bf2_t __attribute__((ext_vector_type(2)));

constexpr int D = 1024, BATCH = 8, T = 4096, M = BATCH * T, MH = M / 2, DEPTH = 2;
constexpr int RW_PROJ = 3360, SSD_PROJ = 5152, IN_PROJ = 10560;
constexpr int N1P = 3584, N2P = 5120, N3P = 2048, NINP = N1P + N2P + N3P;
constexpr int DT_COL = RW_PROJ;
constexpr int KL = 384;
constexpr int NEXP = 16384;
#ifndef PROBE_DOWN
#define PROBE_DOWN -1
#endif
constexpr int PEER_SLICE_SHIFT = 11, PEER_NSLICE = NEXP >> PEER_SLICE_SHIFT;
constexpr int CW_QUEUE = 8192;

constexpr size_t MiB = 1u << 20;
constexpr size_t WS_CTL = 0, CTL_BYTES = 1 * MiB;
constexpr size_t WS_WIN = 1 * MiB;
constexpr size_t WIN_L = (size_t)NINP * D * 2;
constexpr size_t WS_WA = 44 * MiB;
constexpr size_t WS_WB = 48 * MiB;
constexpr size_t WS_WO = 56 * MiB;
constexpr size_t WS_WQK = 60 * MiB;
constexpr size_t WS_WLORA = 68 * MiB;
constexpr size_t WLORA_L = (size_t)4096 * KL * 2;
constexpr size_t WS_U = 74 * MiB;
constexpr size_t WS_VF = 138 * MiB;
constexpr size_t WS_OV = 202 * MiB;
constexpr size_t OV_PR = 0, OV_ELOG = 112 * MiB, OV_ASIG = 144 * MiB, OV_GG = 176 * MiB, OV_VMIX = 208 * MiB, OV_AL = 240 * MiB, OV_YA = 272 * MiB;
constexpr size_t OV_PS = 0, OV_XBC = 168 * MiB, OV_DT = 305 * MiB, OV_DA = 307 * MiB;
constexpr size_t OV_GATES = 168 * MiB, OV_MIXED = 232 * MiB;
constexpr size_t OV_DOWN = 0, OV_UP = 32 * MiB, OV_PSCALE = 48 * MiB  , OV_SC = 64 * MiB, OV_IDX = 192 * MiB, OV_GATE = 208 * MiB, OV_POFF = 224 * MiB  , OV_ACT = 226 * MiB  , OV_U8 = 244 * MiB  , OV_XS = 276 * MiB  ;
constexpr size_t OV_BON = 304 * MiB;
constexpr size_t WS_END = WS_OV + 309 * MiB;
static_assert(WS_WIN + 2 * WIN_L <= WS_WA, "map");

constexpr int LDS_BYTES = 147456;
constexpr int LDS_MISC = 145408;
constexpr int CW_BAR = 4096;

__device__ __forceinline__ unsigned f2bf(float f) { unsigned u = __builtin_bit_cast(unsigned, f); return (u + 0x7fffu + ((u >> 16) & 1u)) >> 16; }
__device__ __forceinline__ unsigned pk2(float lo, float hi) { unsigned r; asm volatile("v_cvt_pk_bf16_f32 %0, %1, %2" : "=v"(r) : "v"(lo), "v"(hi)); return r; }
typedef __bf16 bf16x2_t __attribute__((ext_vector_type(2)));
__device__ __forceinline__ unsigned pk2c(float lo, float hi) { bf16x2_t v; v.x = (__bf16)lo; v.y = (__bf16)hi; return __builtin_bit_cast(unsigned, v); }
__device__ __forceinline__ float bflo(unsigned u) { return __builtin_bit_cast(float, u << 16); }
__device__ __forceinline__ float bfhi(unsigned u) { return __builtin_bit_cast(float, u & 0xffff0000u); }
__device__ __forceinline__ float bf1(bf16 u) { return __builtin_bit_cast(float, ((unsigned)u) << 16); }
__device__ __forceinline__ float sigmoidf_(float x) { return 1.f / (1.f + __expf(-x)); }
__device__ __forceinline__ float siluf_(float x) { return x / (1.f + __expf(-x)); }
template <int CTRL> __device__ __forceinline__ float dpp_mov(float x) { return __int_as_float(__builtin_amdgcn_update_dpp(0, __float_as_int(x), CTRL, 0xF, 0xF, true)); }
__device__ __forceinline__ float sum4(float x) { x += dpp_mov<0xB1>(x); x += dpp_mov<0x4E>(x); return x; }
__device__ __forceinline__ float sum16(float x) { x += dpp_mov<0xB1>(x); x += dpp_mov<0x4E>(x); x += dpp_mov<0x141>(x); x += dpp_mov<0x140>(x); return x; }
__device__ __forceinline__ float sum64(float x) { x = sum16(x); x += __shfl_xor(x, 16); x += __shfl_xor(x, 32); return x; }
__device__ __forceinline__ void unpack8(const v4u& q, float (&o)[8]) { o[0] = bflo(q.x); o[1] = bfhi(q.x); o[2] = bflo(q.y); o[3] = bfhi(q.y); o[4] = bflo(q.z); o[5] = bfhi(q.z); o[6] = bflo(q.w); o[7] = bfhi(q.w); }
__device__ __forceinline__ v4u pack8(const float (&o)[8]) { v4u q; q.x = pk2(o[0], o[1]); q.y = pk2(o[2], o[3]); q.z = pk2(o[4], o[5]); q.w = pk2(o[6], o[7]); return q; }

typedef short s16x4 __attribute__((ext_vector_type(4)));
__device__ __forceinline__ void lds_barrier() { asm volatile("s_waitcnt lgkmcnt(0)\n\ts_barrier" ::: "memory"); }
__device__ __forceinline__ bf16x8 tr_frag(unsigned base_bytes, int stride, int k0, int c0, int lane) {
    const int i16 = lane & 15, qq = i16 >> 2, p = i16 & 3, q = lane >> 4;
    const unsigned a0 = base_bytes + (unsigned)(((k0 + 8 * q + qq) * stride + c0 + 4 * p) * 2), a1 = a0 + (unsigned)(8 * stride);
    s16x4 lo, hi;
    asm volatile("ds_read_b64_tr_b16 %0, %2\n\tds_read_b64_tr_b16 %1, %3\n\ts_waitcnt lgkmcnt(0)" : "=&v"(lo), "=&v"(hi) : "v"(a0), "v"(a1) : "memory");
    return __builtin_shufflevector(lo, hi, 0, 1, 2, 3, 4, 5, 6, 7);
}

namespace pg8 {
constexpr int BM = 256, BK = 64, HALF = 128, HTB = HALF * BK * 2, STAGE_BYTES = 8 * HTB, NXCD = 8, WGM = 8;
__host__ __device__ __forceinline__ int lds_byte(int r, int c) { const int st = (r >> 4) * 2 + (c >> 5), rr = r & 15, cc = c & 31, ob = rr * 64 + cc * 2; return st * 1024 + (ob ^ (((ob >> 9) & 1) << 5)); }
__host__ __device__ __forceinline__ void stage_rc(int b, int& R, int& C) { const int st = b / 1024, sb = b % 1024, swz = sb ^ (((sb >> 9) & 1) << 5); R = (st >> 1) * 16 + swz / 64; C = (st & 1) * 32 + (swz % 64) / 2; }
__host__ __device__ __forceinline__ int perm32(int rho) { const int n = rho >> 4, i = rho & 15; return 8 * (i >> 2) + 4 * n + (i & 3); }
struct Unit { int pm, pn; };
struct Gemm { const bf16* A; const bf16* Bt; int M, N, K, lda; int kwin; };
__device__ __forceinline__ void unit_kwin(const Gemm& g, const Unit& u, int& k0t, int& ntl) { k0t = 0; ntl = g.K / BK; if (g.kwin) { const int blk = u.pn >> 2; if (blk < 2) { k0t = 0; ntl = 2; } else if (blk == 2) { k0t = 2; ntl = 4; } else { k0t = 4; ntl = 2; } } }
struct StaticOrder {
    int nM, nN, nwg, G, c;
    __device__ void init(int M_, int N_, int G_, int c_) { nM = M_ / BM; nN = N_ / BM; nwg = nM * nN; G = G_; c = c_; }
    __device__ bool next(int i, Unit& u) const {
        const long L = (long)i * G + c; if (L >= nwg) return false;
        int wgid = (int)L; { const int q = nwg / NXCD, r = nwg % NXCD, xcd = wgid % NXCD, off = wgid / NXCD; wgid = (xcd < r ? xcd * (q + 1) : r * (q + 1) + (xcd - r) * q) + off; }
        const int nig = WGM * nN, gid = wgid / nig, fm = gid * WGM, gsz = (nM - fm) < WGM ? (nM - fm) : WGM;
        u.pm = fm + ((wgid % nig) % gsz); u.pn = (wgid % nig) / gsz; return true;
    }
};
template <class F> struct EpiRow8 {
    static constexpr bool PERM = true;
    F f;
    __device__ __forceinline__ void operator()(const f32x4 (&acc)[2][2][4][2], const Unit& u, int wr, int wc, int fr, int fq) const {
        const int row0 = u.pm * BM + wr * 64 + fr, col0 = u.pn * BM + wc * 32 + 8 * fq;
#pragma unroll
        for (int g0 = 0; g0 < 16; g0 += F::GRP) {
            typename F::Tmp t[F::GRP];
#pragma unroll
            for (int j = 0; j < F::GRP; ++j) { const int i = g0 + j, ai = i >> 3, m = (i >> 1) & 3, bj = i & 1; f.load(row0 + ai * HALF + m * 16, col0 + bj * HALF, u.pn, t[j]); }
#pragma unroll
            for (int j = 0; j < F::GRP; ++j) { const int i = g0 + j, ai = i >> 3, m = (i >> 1) & 3, bj = i & 1; f.apply(row0 + ai * HALF + m * 16, col0 + bj * HALF, acc[ai][bj][m][0], acc[ai][bj][m][1], u.pn, t[j]); }
        }
    }
};


template <class Epi>
__device__ __forceinline__ void gemm_phase(LAS unsigned char* lds, const Gemm g, const StaticOrder& S, const Epi& E) {
    const int tid = threadIdx.x, wid = __builtin_amdgcn_readfirstlane(tid >> 6), lane = tid & 63, wr = wid >> 2, wc = wid & 3, fr = lane & 15, fq = lane >> 4;
    const int K = g.K, lda = g.lda;
    unsigned voffA[2], voffB[2];
#pragma unroll
    for (int i = 0; i < 2; ++i) { int R, C; stage_rc(tid * 16 + i * 8192, R, C); const int Rb = Epi::PERM ? ((R & ~31) + perm32(R & 31)) : R;
        voffA[i] = (unsigned)(R * lda + C) * 2u; voffB[i] = (unsigned)(Rb * K + C) * 2u; }
    const size_t kstep = (size_t)(BK * 2);
    const size_t hstepA = (size_t)HALF * lda * 2, hstepB = (size_t)HALF * K * 2;
    const size_t tstepA = 2 * hstepA, tstepB = 2 * hstepB;
    const unsigned ldsw = (unsigned)wid * 1024u;
    const int aoff = lds_byte(wr * 64 + fr, fq * 8), boff = lds_byte(wc * 32 + fr, fq * 8);
#define PG8_SA(b, h) (((b) * 2 + (h)) * HTB)
#define PG8_SB(b, h) ((4 + (b) * 2 + (h)) * HTB)
#define PG8_STAGE(bufoff, gbase, voff) do { _Pragma("unroll") for (int _i = 0; _i < 2; ++_i) \
        __builtin_amdgcn_global_load_lds((const unsigned*)((const char*)(gbase) + (voff)[_i]), (LAS unsigned*)(lds + (bufoff) + ldsw + _i * 8192), 16, 0, 0); } while (0)
#define PG8_LDA(dst, b, h) do { _Pragma("unroll") for (int m = 0; m < 4; ++m) _Pragma("unroll") for (int k = 0; k < 2; ++k) dst[m][k] = *(const LAS bf16x8*)(lds + PG8_SA(b, h) + aoff + m * 2048 + k * 1024); } while (0)
#define PG8_LDB(dst, b, h) do { _Pragma("unroll") for (int n = 0; n < 2; ++n) _Pragma("unroll") for (int k = 0; k < 2; ++k) dst[n][k] = *(const LAS bf16x8*)(lds + PG8_SB(b, h) + boff + n * 2048 + k * 1024); } while (0)
#define PG8_MMA(ai, bj, At, Bt) do { __builtin_amdgcn_s_setprio(1); _Pragma("unroll") for (int m = 0; m < 4; ++m) _Pragma("unroll") for (int n = 0; n < 2; ++n) _Pragma("unroll") for (int k = 0; k < 2; ++k) \
        acc[ai][bj][m][n] = __builtin_amdgcn_mfma_f32_16x16x32_bf16(Bt[n][k], At[m][k], acc[ai][bj][m][n], 0, 0, 0); __builtin_amdgcn_s_setprio(0); } while (0)
#define PG8_WAIT_V(n) asm volatile("s_waitcnt vmcnt(" #n ")" ::: "memory")
#define PG8_WAIT_L(n) asm volatile("s_waitcnt lgkmcnt(" #n ")" ::: "memory")
#define PG8_BAR __builtin_amdgcn_s_barrier()
#define PG8_SCHED __builtin_amdgcn_sched_barrier(0)
    Unit cur, nxt; int ui = 0;
    if (!S.next(0, cur)) return;
    f32x4 acc[2][2][4][2];
#pragma unroll
    for (int a = 0; a < 2; ++a)
#pragma unroll
        for (int b = 0; b < 2; ++b)
#pragma unroll
            for (int m = 0; m < 4; ++m)
#pragma unroll
                for (int n = 0; n < 2; ++n) acc[a][b][m][n] = (f32x4){0.f, 0.f, 0.f, 0.f};
    bf16x8 At[4][2], B0[2][2], B1[2][2];
    int k0c, nt; unit_kwin(g, cur, k0c, nt);
    const char* cA = (const char*)g.A + (size_t)cur.pm * tstepA + (size_t)k0c * kstep; const char* cB = (const char*)g.Bt + (size_t)cur.pn * tstepB + (size_t)k0c * kstep;
    PG8_STAGE(PG8_SB(0, 0), cB, voffB); PG8_STAGE(PG8_SA(0, 0), cA, voffA); PG8_STAGE(PG8_SB(0, 1), cB + hstepB, voffB); PG8_STAGE(PG8_SA(0, 1), cA + hstepA, voffA);
    if (wr == 1) PG8_BAR;
    PG8_WAIT_V(4); PG8_BAR;
    PG8_STAGE(PG8_SB(1, 0), cB + kstep, voffB); PG8_STAGE(PG8_SA(1, 0), cA + kstep, voffA); PG8_STAGE(PG8_SB(1, 1), cB + hstepB + kstep, voffB);
    PG8_WAIT_V(6); PG8_BAR;
    for (;;) {
        const bool has_next = S.next(ui + 1, nxt);
        int k0n = 0, ntn = nt; if (has_next) unit_kwin(g, nxt, k0n, ntn);
        const char* nA = has_next ? (const char*)g.A + (size_t)nxt.pm * tstepA + (size_t)k0n * kstep : cA; const char* nB = has_next ? (const char*)g.Bt + (size_t)nxt.pn * tstepB + (size_t)k0n * kstep : cB;
        for (int t = 0; t < nt; t += 2) {
            const bool last = (t == nt - 2);
            const char* a1 = cA + (size_t)(t + 1) * kstep;
            const char* a2 = last ? nA : cA + (size_t)(t + 2) * kstep; const char* b2 = last ? nB : cB + (size_t)(t + 2) * kstep;
            const char* a3 = a2 + kstep; const char* b3 = b2 + kstep;
            PG8_LDB(B0, 0, 0); PG8_SCHED; PG8_LDA(At, 0, 0); PG8_STAGE(PG8_SA(1, 1), a1 + hstepA, voffA);
            PG8_WAIT_L(8); PG8_BAR; PG8_WAIT_L(0); PG8_MMA(0, 0, At, B0); PG8_BAR; PG8_SCHED;
            PG8_LDB(B1, 0, 1); PG8_STAGE(PG8_SB(0, 0), b2, voffB);
            PG8_BAR; PG8_WAIT_L(0); PG8_MMA(0, 1, At, B1); PG8_BAR;
            PG8_LDA(At, 0, 1); PG8_STAGE(PG8_SA(0, 0), a2, voffA);
            PG8_BAR; PG8_WAIT_L(0); PG8_MMA(1, 0, At, B0); PG8_BAR; PG8_SCHED;
            PG8_STAGE(PG8_SB(0, 1), b2 + hstepB, voffB);
            PG8_WAIT_V(6); PG8_BAR; PG8_MMA(1, 1, At, B1); PG8_BAR;
            PG8_LDB(B0, 1, 0); PG8_SCHED; PG8_LDA(At, 1, 0); PG8_STAGE(PG8_SA(0, 1), a2 + hstepA, voffA);
            PG8_WAIT_L(8); PG8_BAR; PG8_WAIT_L(0); PG8_MMA(0, 0, At, B0); PG8_BAR; PG8_SCHED;
            PG8_LDB(B1, 1, 1); PG8_STAGE(PG8_SB(1, 0), b3, voffB);
            PG8_BAR; PG8_WAIT_L(0); PG8_MMA(0, 1, At, B1); PG8_BAR;
            PG8_LDA(At, 1, 1); PG8_STAGE(PG8_SA(1, 0), a3, voffA);
            PG8_BAR; PG8_WAIT_L(0); PG8_MMA(1, 0, At, B0); PG8_BAR; PG8_SCHED;
            PG8_STAGE(PG8_SB(1, 1), b3 + hstepB, voffB);
            PG8_WAIT_V(6); PG8_BAR; PG8_MMA(1, 1, At, B1); PG8_BAR;
        }
        E(acc, cur, wr, wc, fr, fq);
        if (!has_next) break;
#pragma unroll
        for (int a = 0; a < 2; ++a)
#pragma unroll
            for (int b = 0; b < 2; ++b)
#pragma unroll
                for (int m = 0; m < 4; ++m)
#pragma unroll
                    for (int n = 0; n < 2; ++n) acc[a][b][m][n] = (f32x4){0.f, 0.f, 0.f, 0.f};
        cur = nxt; cA = nA; cB = nB; nt = ntn; ++ui;
    }
    PG8_WAIT_V(0);
    if (wr == 0) PG8_BAR;
    PG8_BAR;
#undef PG8_SA
#undef PG8_SB
#undef PG8_STAGE
#undef PG8_LDA
#undef PG8_LDB
#undef PG8_MMA
#undef PG8_WAIT_V
#undef PG8_WAIT_L
#undef PG8_BAR
#undef PG8_SCHED
}
}

#define XB_TMO      128
#define XB_XCNT(j)  (256  + 64 * (j))
#define XB_XSUB(j)  (1280 + 64 * (j))
#define XB_XGEN(j)  (2304 + 64 * (j))
#define XB_TOP      3328
#define XB_TOPGEN   3392
#define XCD_BAR_WORDS 3456
#define XB_SPIN_CAP (1u << 18)
__device__ __forceinline__ unsigned xb_ld(unsigned* p)              { return __hip_atomic_load(p, __ATOMIC_RELAXED, __HIP_MEMORY_SCOPE_AGENT); }
__device__ __forceinline__ unsigned xb_add(unsigned* p, unsigned v) { return __hip_atomic_fetch_add(p, v, __ATOMIC_RELAXED, __HIP_MEMORY_SCOPE_AGENT); }
__device__ __forceinline__ unsigned xb_xcc_id() { return (unsigned)__builtin_amdgcn_s_getreg((3 << 11) | 20) & 0xFu; }
#define XB_SPIN(cond, bar) do { unsigned _sp = 0; while (cond) { __builtin_amdgcn_s_sleep(1); \
    if ((++_sp & 255u) == 0u) { if (xb_ld(&(bar)[XB_TMO])) break; if (_sp > XB_SPIN_CAP) { atomicAdd(&(bar)[XB_TMO], 1u); break; } } } } while (0)
struct XcdBarrier { unsigned* bar; unsigned x; volatile LAS unsigned* st; };
__device__ __forceinline__ XcdBarrier xcd_barrier_post(unsigned* bar, volatile LAS unsigned* st) {
    XcdBarrier b; b.bar = bar; b.x = xb_xcc_id(); b.st = st;
    if (threadIdx.x == 0) (void)xb_add(&bar[XB_XCNT(b.x)], 1u);
    return b;
}
__device__ __forceinline__ void xcd_barrier_complete(unsigned* bar, unsigned x, unsigned& nloc, unsigned& nx) {
    const unsigned G = gridDim.x * gridDim.y * gridDim.z;
    unsigned sum, cnt, mine, sp = 0u;
    for (;;) {
        sum = 0u; cnt = 0u; mine = 0u;
#pragma unroll
        for (unsigned j = 0; j < 16; ++j) { const unsigned c = xb_ld(&bar[XB_XCNT(j)]); sum += c; cnt += (c > 0u) ? 1u : 0u; mine = (j == x) ? c : mine; }
        if (sum == G) break;
        __builtin_amdgcn_s_sleep(1);
        if ((++sp & 255u) == 0u) { if (xb_ld(&bar[XB_TMO])) break; if (sp > XB_SPIN_CAP) { atomicAdd(&bar[XB_TMO], 1u); break; } }
    }
    nloc = mine > 0u ? mine : 1u; nx = cnt > 0u ? cnt : 1u;
}
__device__ __forceinline__ void xcd_barrier(const XcdBarrier& b) {
    asm volatile("s_waitcnt vmcnt(0)" ::: "memory");
    __syncthreads();
    if (threadIdx.x == 0) {
        unsigned* bar = b.bar;
        __builtin_amdgcn_s_waitcnt(0);
        unsigned nloc = b.st[0], nx = b.st[1];
        if (nloc == 0u) { xcd_barrier_complete(bar, b.x, nloc, nx); b.st[0] = nloc; b.st[1] = nx; }
        const unsigned old = xb_add(&bar[XB_XSUB(b.x)], 1u);
        const unsigned gen = old / nloc;
        if (old + 1u == (gen + 1u) * nloc) {
            __builtin_amdgcn_fence(__ATOMIC_RELEASE, "agent");
            asm volatile("s_waitcnt vmcnt(0)" ::: "memory");
            const unsigned og = xb_add(&bar[XB_TOP], 1u);
            const unsigned tg = og / nx;
            if (og + 1u == (tg + 1u) * nx) xb_add(&bar[XB_TOPGEN], 1u);
            else XB_SPIN(xb_ld(&bar[XB_TOPGEN]) == tg, bar);
            __builtin_amdgcn_fence(__ATOMIC_ACQUIRE, "agent");
            xb_add(&bar[XB_XGEN(b.x)], 1u);
            asm volatile("s_waitcnt vmcnt(0)" ::: "memory");
        } else {
            XB_SPIN(xb_ld(&bar[XB_XGEN(b.x)]) == gen, bar);
            __builtin_amdgcn_fence(__ATOMIC_ACQUIRE, "agent");
            asm volatile("s_waitcnt vmcnt(0)" ::: "memory");
        }
    }
    __syncthreads();
}

struct Args { const float* in[32]; float* out; unsigned char* ws; int lo, hi; };
typedef const Args __attribute__((address_space(4))) KArgs;
enum { I_X = 0, I_NMG, I_WIN, I_MU, I_W0, I_W2, I_A0, I_A2, I_G2, I_V0, I_V1, I_V2, I_KK, I_KA, I_RK, I_LNW, I_LNB, I_WRB, I_CW, I_CB, I_DTB, I_ALOG, I_SD, I_SNG, I_WSB, I_WOUT, I_NFG, I_WQ, I_SK, I_PD, I_PU, I_NFIN };

struct NoTmp {};
struct FStoreBf16 { bf16* O; int ldc; typedef NoTmp Tmp; static constexpr int GRP = 16;
    __device__ __forceinline__ void load(int, int, int, Tmp&) const {}
    __device__ __forceinline__ void apply(int row, int col, f32x4 v0, f32x4 v1, int, const Tmp&) const {
        v4u w; w.x = pk2(v0[0], v0[1]); w.y = pk2(v0[2], v0[3]); w.z = pk2(v1[0], v1[1]); w.w = pk2(v1[2], v1[3]);
        *(v4u*)(O + (size_t)row * ldc + col) = w; } };
struct FSigmoidBf16 { bf16* O; int ldc; typedef NoTmp Tmp; static constexpr int GRP = 16;
    __device__ __forceinline__ void load(int, int, int, Tmp&) const {}
    __device__ __forceinline__ void apply(int row, int col, f32x4 v0, f32x4 v1, int, const Tmp&) const {
        v4u w; w.x = pk2(sigmoidf_(v0[0]), sigmoidf_(v0[1])); w.y = pk2(sigmoidf_(v0[2]), sigmoidf_(v0[3])); w.z = pk2(sigmoidf_(v1[0]), sigmoidf_(v1[1])); w.w = pk2(sigmoidf_(v1[2]), sigmoidf_(v1[3]));
        *(v4u*)(O + (size_t)row * ldc + col) = w; } };
struct EpiLora {
    static constexpr bool PERM = true;
    bf16 *elog, *asig, *gg, *vmix; const bf16* vf; const float *w0, *a0, *v0;
    template <int BLK> __device__ __forceinline__ void run(const f32x4 (&acc)[2][2][4][2], int row0, int col0) const {
#pragma unroll
        for (int bj = 0; bj < 2; ++bj) {
            const int c = (col0 + bj * 128) & 1023;
            float bias[8];
            if (BLK == 0 || BLK == 1 || BLK == 3) { const float* bp = (BLK == 0 ? w0 : (BLK == 1 ? a0 : v0)) + c; const f32x4 b0 = *(const f32x4*)bp, b1 = *(const f32x4*)(bp + 4);
                bias[0] = b0[0]; bias[1] = b0[1]; bias[2] = b0[2]; bias[3] = b0[3]; bias[4] = b1[0]; bias[5] = b1[1]; bias[6] = b1[2]; bias[7] = b1[3]; }
#pragma unroll
            for (int ai = 0; ai < 2; ++ai) {
            v4u qvs[4], qvf[4];
            if (BLK == 3) {
#pragma unroll
                for (int i = 0; i < 4; ++i) { const size_t o = (size_t)(row0 + ai * 128 + i * 16) * D + c; qvs[i] = *(const v4u*)(vmix + o); qvf[i] = *(const v4u*)(vf + o); }
            }
#pragma unroll
                for (int m = 0; m < 4; ++m) {
                    const int row = row0 + ai * 128 + m * 16; const size_t o = (size_t)row * D + c;
                    const f32x4 v0_ = acc[ai][bj][m][0], v1_ = acc[ai][bj][m][1];
                    float a[8] = {v0_[0], v0_[1], v0_[2], v0_[3], v1_[0], v1_[1], v1_[2], v1_[3]};
                    if (BLK == 0) {
#pragma unroll
                        for (int e = 0; e < 8; ++e) a[e] = -0.6065306597f * sigmoidf_(bias[e] + a[e]);
                        *(v4u*)(elog + o) = pack8(a);
                    } else if (BLK == 1) {
#pragma unroll
                        for (int e = 0; e < 8; ++e) a[e] = sigmoidf_(bias[e] + a[e]);
                        *(v4u*)(asig + o) = pack8(a);
                    } else if (BLK == 2) {
                        *(v4u*)(gg + o) = pack8(a);
                    } else {
                        float vs[8], vfv[8]; unpack8(qvs[m], vs); unpack8(qvf[m], vfv);
#pragma unroll
                        for (int e = 0; e < 8; ++e) a[e] = vs[e] + (vfv[e] - vs[e]) * sigmoidf_(bias[e] + a[e]);
                        *(v4u*)(vmix + o) = pack8(a);
                    }
                }
            }
        }
    }
    __device__ __forceinline__ void operator()(const f32x4 (&acc)[2][2][4][2], const pg8::Unit& u, int wr, int wc, int fr, int fq) const {
        const int row0 = u.pm * 256 + wr * 64 + fr, col0 = u.pn * 256 + wc * 32 + 8 * fq;
        const int blk = u.pn >> 2;
        if (blk == 0) run<0>(acc, row0, col0); else if (blk == 1) run<1>(acc, row0, col0); else if (blk == 2) run<2>(acc, row0, col0); else run<3>(acc, row0, col0);
    }
};
struct FMixA { const bf16* gates; bf16* mixed;
    struct Tmp { v4u g; }; static constexpr int GRP = 8;
    __device__ __forceinline__ void load(int row, int col, int, Tmp& t) const { t.g = *(const v4u*)(gates + (size_t)row * 2048 + col); }
    __device__ __forceinline__ void apply(int row, int col, f32x4 v0, f32x4 v1, int, const Tmp& t) const {
        float g[8]; unpack8(t.g, g);
        float a[8] = {v0[0] * g[0], v0[1] * g[1], v0[2] * g[2], v0[3] * g[3], v1[0] * g[4], v1[1] * g[5], v1[2] * g[6], v1[3] * g[7]};
        *(v4u*)(mixed + (size_t)row * D + col) = pack8(a); } };
struct FMixB { const bf16* gates; bf16* mixed;
    struct Tmp { v4u g, mx; }; static constexpr int GRP = 8;
    __device__ __forceinline__ void load(int row, int col, int, Tmp& t) const { t.g = *(const v4u*)(gates + (size_t)row * 2048 + 1024 + col); t.mx = *(const v4u*)(mixed + (size_t)row * D + col); }
    __device__ __forceinline__ void apply(int row, int col, f32x4 v0, f32x4 v1, int, const Tmp& t) const {
        float g[8], mx[8]; unpack8(t.g, g); unpack8(t.mx, mx);
        float a[8] = {mx[0] + v0[0] * g[0], mx[1] + v0[1] * g[1], mx[2] + v0[2] * g[2], mx[3] + v0[3] * g[3], mx[4] + v1[0] * g[4], mx[5] + v1[1] * g[5], mx[6] + v1[2] * g[6], mx[7] + v1[3] * g[7]};
        *(v4u*)(mixed + (size_t)row * D + col) = pack8(a); } };
struct FResid { const float* base; float* h;
    struct Tmp { f32x4 a, b; }; static constexpr int GRP = 8;
    __device__ __forceinline__ void load(int row, int col, int, Tmp& t) const { const f32x4* s = (const f32x4*)(base + (size_t)row * D + col); t.a = s[0]; t.b = s[1]; }
    __device__ __forceinline__ void apply(int row, int col, f32x4 v0, f32x4 v1, int, const Tmp& t) const {
        f32x4* p = (f32x4*)(h + (size_t)row * D + col); p[0] = t.a + v0; p[1] = t.b + v1; } };

struct Ctx { int tid, lane, wave, G, bid; LAS unsigned char* lds; };

__device__ __forceinline__ void transpose_item(const float* W, int K, int N, bf16* WT, int row_off, LAS float* scr, int item, int lane) {
    const int nblk = N / 32, kb = item / nblk, nb = item % nblk, k0 = 64 * kb, n0 = 32 * nb;
#pragma unroll 8
    for (int i = 0; i < 32; ++i) { const int kk = 2 * i + (lane >> 5); scr[kk * 33 + (lane & 31)] = W[(size_t)(k0 + kk) * N + n0 + (lane & 31)]; }
    asm volatile("s_waitcnt lgkmcnt(0)" ::: "memory");
    const int c = lane & 7;
#pragma unroll
    for (int j = 0; j < 4; ++j) { const int n = (lane >> 3) + 8 * j; const LAS float* s = scr + (8 * c) * 33 + n;
        v4u o; o.x = pk2(s[0 * 33], s[1 * 33]); o.y = pk2(s[2 * 33], s[3 * 33]); o.z = pk2(s[4 * 33], s[5 * 33]); o.w = pk2(s[6 * 33], s[7 * 33]);
        *(v4u*)(WT + (size_t)(row_off + n0 + n) * K + k0 + 8 * c) = o; }
    asm volatile("s_waitcnt lgkmcnt(0)" ::: "memory");
}
__device__ __forceinline__ int winrow(int n) {
    if (n < RW_PROJ) return n;
    if (n < RW_PROJ + 5120) return N1P + (n - RW_PROJ);
    if (n < RW_PROJ + SSD_PROJ) return DT_COL + (n - RW_PROJ - 5120);
    return N1P + N2P + (n - RW_PROJ - SSD_PROJ); }

__device__ __forceinline__ void phase_prologue(const Ctx& c, KArgs& a) {
    unsigned char* ws = a.ws;
    LAS float* scr = (LAS float*)(c.lds + c.wave * 16384);
    const int gw = c.bid * 8 + c.wave, NGW = c.G * 8;
    constexpr int I_IN = 16 * (IN_PROJ / 32), I_A = 16 * 32, I_B = 32 * 32, I_O = 16 * 32, I_L = I_IN + I_A + I_B + I_O;
    for (int it = gw; it < 2 * I_L; it += NGW) {
        const int l = it / I_L; int r = it % I_L;
        if (r < I_IN) { const int nb = r % (IN_PROJ / 32); transpose_item(a.in[I_WIN] + (size_t)l * D * IN_PROJ, D, IN_PROJ, (bf16*)(ws + WS_WIN + l * WIN_L), winrow(nb * 32) - nb * 32, scr, r, c.lane); continue; } r -= I_IN;
        if (r < I_A) { transpose_item(a.in[I_WRB] + (size_t)l * D * D, D, D, (bf16*)(ws + WS_WA) + (size_t)l * D * D, 0, scr, r, c.lane); continue; } r -= I_A;
        if (r < I_B) { transpose_item(a.in[I_WSB] + (size_t)l * 2048 * D, 2048, D, (bf16*)(ws + WS_WB) + (size_t)l * D * 2048, 0, scr, r, c.lane); continue; } r -= I_B;
        transpose_item(a.in[I_WOUT] + (size_t)l * D * D, D, D, (bf16*)(ws + WS_WO) + (size_t)l * D * D, 0, scr, r, c.lane);
    }
    for (int it = c.bid * 512 + c.tid; it < 2 * 192 * 128; it += c.G * 512) {
        const int l = it / (192 * 128), r = (it / 128) % 192, q = it % 128;
        *(v4u*)((bf16*)(ws + WS_WIN + l * WIN_L) + (size_t)(DT_COL + 32 + r) * D + q * 8) = (v4u){0u, 0u, 0u, 0u};
    }
    for (int it = c.bid * 512 + c.tid; it < 2 * 4096 * KL; it += c.G * 512) {
        const int l = it / (4096 * KL), n = (it / KL) % 4096, k = it % KL; const int blk = n >> 10, cc = n & 1023;
        float v = 0.f;
        if (blk == 0) { if (k < 64) v = a.in[I_W2][((size_t)l * 64 + k) * D + cc]; }
        else if (blk == 1) { if (k >= 64 && k < 128) v = a.in[I_A2][((size_t)l * 64 + (k - 64)) * D + cc]; }
        else if (blk == 2) { if (k >= 128 && k < 288) v = a.in[I_G2][((size_t)l * 160 + (k - 128)) * D + cc]; }
        else { if (l == 1 && k >= 288 && k < 320) v = a.in[I_V2][(size_t)(k - 288) * D + cc]; }
        ((bf16*)(ws + WS_WLORA + l * WLORA_L))[(size_t)n * KL + k] = (bf16)f2bf(v);
    }
    __syncthreads();
    LAS float* wqL = (LAS float*)c.lds;
    LAS float* kyL = (LAS float*)(c.lds + 32768);
    for (int it = c.bid; it < 2 * 16 * 16; it += c.G) {
        const int l = it >> 8, hc = (it >> 4) & 15, k0 = (it & 15) * 64;
        const float* wq = a.in[I_WQ] + (size_t)l * D * 2048; const float* ky = a.in[I_SK] + ((size_t)l * 16 + hc) * 128 * 128;
        for (int e = c.tid; e < 64 * 128; e += 512) wqL[e] = wq[(size_t)(k0 + (e >> 7)) * 2048 + hc * 128 + (e & 127)];
        for (int e = c.tid; e < 128 * 128; e += 512) kyL[(e >> 7) * 129 + (e & 127)] = ky[e];
        __syncthreads();
        const int key = c.tid & 127, kg = c.tid >> 7;
        float acc[16];
#pragma unroll
        for (int i = 0; i < 16; ++i) acc[i] = 0.f;
        for (int d = 0; d < 128; ++d) { const float kv = kyL[key * 129 + d];
#pragma unroll
            for (int i = 0; i < 16; ++i) acc[i] += wqL[(kg * 16 + i) * 128 + d] * kv; }
        bf16* o = (bf16*)(ws + WS_WQK) + ((size_t)l * 2048 + hc * 128 + key) * D + k0 + kg * 16;
        v4u q0, q1; q0.x = pk2(acc[0], acc[1]); q0.y = pk2(acc[2], acc[3]); q0.z = pk2(acc[4], acc[5]); q0.w = pk2(acc[6], acc[7]);
        q1.x = pk2(acc[8], acc[9]); q1.y = pk2(acc[10], acc[11]); q1.z = pk2(acc[12], acc[13]); q1.w = pk2(acc[14], acc[15]);
        *(v4u*)o = q0; *(v4u*)(o + 8) = q1;
        __syncthreads();
    }
}

__device__ __forceinline__ void phase_rmsnorm(const Ctx& c, const float* src, const float* g, bf16* U, float* copy_to) {
    const int gw = c.bid * 8 + c.wave, NGW = c.G * 8;
    f32x4 gv[4];
#pragma unroll
    for (int j = 0; j < 4; ++j) gv[j] = *((const f32x4*)g + c.lane + 64 * j);
    f32x4 nv[4];
    if (gw < M) { const f32x4* xr0 = (const f32x4*)(src + (size_t)gw * D) + c.lane;
#pragma unroll
        for (int j = 0; j < 4; ++j) nv[j] = xr0[64 * j]; }
    for (int m = gw; m < M; m += NGW) {
        f32x4 v[4]; float s = 0.f;
#pragma unroll
        for (int j = 0; j < 4; ++j) { v[j] = nv[j]; s += (v[j].x * v[j].x + v[j].y * v[j].y) + (v[j].z * v[j].z + v[j].w * v[j].w); }
        if (m + NGW < M) { const f32x4* xn = (const f32x4*)(src + (size_t)(m + NGW) * D) + c.lane;
#pragma unroll
            for (int j = 0; j < 4; ++j) nv[j] = xn[64 * j]; }
        if (copy_to) { f32x4* cr = (f32x4*)(copy_to + (size_t)m * D) + c.lane;
#pragma unroll
            for (int j = 0; j < 4; ++j) cr[64 * j] = v[j]; }
        const float r = rsqrtf(sum64(s) * (1.f / D) + 1e-6f);
        v2u* o = (v2u*)(U + (size_t)m * D) + c.lane;
#pragma unroll
        for (int j = 0; j < 4; ++j) { v2u w; w.x = pk2(v[j].x * r * gv[j].x, v[j].y * r * gv[j].y); w.y = pk2(v[j].z * r * gv[j].z, v[j].w * r * gv[j].w); o[64 * j] = w; }
    }
}
__device__ __forceinline__ void phase_rmsnorm_q8(const Ctx& c, const float* src, const float* g, bf16* U, unsigned char* U8, float* XS) {
    const int gw = c.bid * 8 + c.wave, NGW = c.G * 8;
    f32x4 gv[4];
#pragma unroll
    for (int j = 0; j < 4; ++j) gv[j] = *((const f32x4*)g + c.lane + 64 * j);
    f32x4 nv[4];
    if (gw < M) { const f32x4* xr0 = (const f32x4*)(src + (size_t)gw * D) + c.lane;
#pragma unroll
        for (int j = 0; j < 4; ++j) nv[j] = xr0[64 * j]; }
    for (int m = gw; m < M; m += NGW) {
        f32x4 v[4]; float s = 0.f;
#pragma unroll
        for (int j = 0; j < 4; ++j) { v[j] = nv[j]; s += (v[j].x * v[j].x + v[j].y * v[j].y) + (v[j].z * v[j].z + v[j].w * v[j].w); }
        if (m + NGW < M) { const f32x4* xn = (const f32x4*)(src + (size_t)(m + NGW) * D) + c.lane;
#pragma unroll
            for (int j = 0; j < 4; ++j) nv[j] = xn[64 * j]; }
        const float r = rsqrtf(sum64(s) * (1.f / D) + 1e-6f);
        float am = 0.f;
#pragma unroll
        for (int j = 0; j < 4; ++j) { v[j] = v[j] * r * gv[j]; am = fmaxf(am, fmaxf(fmaxf(fabsf(v[j].x), fabsf(v[j].y)), fmaxf(fabsf(v[j].z), fabsf(v[j].w)))); }
#pragma unroll
        for (int o = 1; o < 64; o <<= 1) am = fmaxf(am, __shfl_xor(am, o));
        am = fmaxf(am, 1e-30f);
        const float qs = 384.f / am;
        v2u* o = (v2u*)(U + (size_t)m * D) + c.lane;
        unsigned* o8 = (unsigned*)(U8 + (size_t)m * D) + c.lane;
#pragma unroll
        for (int j = 0; j < 4; ++j) { v2u w; w.x = pk2(v[j].x, v[j].y); w.y = pk2(v[j].z, v[j].w); o[64 * j] = w;
            int w8 = __builtin_amdgcn_cvt_pk_fp8_f32(v[j].x * qs, v[j].y * qs, 0, false); w8 = __builtin_amdgcn_cvt_pk_fp8_f32(v[j].z * qs, v[j].w * qs, w8, true); o8[64 * j] = (unsigned)w8; }
        if (c.lane == 0) XS[m] = am * (1.f / 384.f);
    }
}
__device__ __forceinline__ void phase_final(const Ctx& c, float* out, const float* g) {
    const int gw = c.bid * 8 + c.wave, NGW = c.G * 8;
    f32x4 gv[4];
#pragma unroll
    for (int j = 0; j < 4; ++j) gv[j] = *((const f32x4*)g + c.lane + 64 * j);
    for (int m = gw; m < M; m += NGW) {
        f32x4* xr = (f32x4*)(out + (size_t)m * D) + c.lane;
        f32x4 v[4]; float s = 0.f;
#pragma unroll
        for (int j = 0; j < 4; ++j) { v[j] = xr[64 * j]; s += (v[j].x * v[j].x + v[j].y * v[j].y) + (v[j].z * v[j].z + v[j].w * v[j].w); }
        const float r = rsqrtf(sum64(s) * (1.f / D) + 1e-6f);
#pragma unroll
        for (int j = 0; j < 4; ++j) xr[64 * j] = v[j] * r * gv[j];
    }
}

__device__ __forceinline__ void phase_rwkv_prep(const Ctx& c, KArgs& a, int l, int hb) {
    unsigned char* ws = a.ws;
    const bf16* PR = (const bf16*)(ws + WS_OV + OV_PR);
    bf16* AL = (bf16*)(ws + WS_OV + OV_AL);
    bf16* VS = l == 0 ? (bf16*)(ws + WS_VF) + (size_t)hb * MH * D : (bf16*)(ws + WS_OV + OV_VMIX);
    const float* mu = a.in[I_MU] + (size_t)l * RW_PROJ;
    LAS bf16* v1L = (LAS bf16*)c.lds;
    if (l == 1) {
        const float* v1 = a.in[I_V1];
        for (int e = c.tid; e < 1024 * 32; e += 512) { const int cc = e >> 5, j = e & 31; v1L[((cc & 15) * 64 + (cc >> 4)) * 40 + j] = (bf16)f2bf(v1[e]); }
        __syncthreads();
    }
    const int gw = c.bid * 8 + c.wave, NGW = c.G * 8, lane = c.lane;
    float muv[16], mul[8];
#pragma unroll
    for (int e = 0; e < 16; ++e) muv[e] = mu[2048 + 16 * lane + e];
#pragma unroll
    for (int e = 0; e < 8; ++e) mul[e] = lane < 36 ? mu[3072 + 8 * lane + e] : 0.f;
    const int per = (MH + NGW - 1) / NGW;
    const int mA = gw * per, mB = (mA + per < MH) ? mA + per : MH;
    v4u cq0, cq1, cql, pq0, pq1, pql;
    const v4u zz4 = (v4u){0u, 0u, 0u, 0u};
    const int lcol = lane < 36 ? 3072 + 8 * lane : 3072;
    if (mA < mB) {
        const bf16* row = PR + (size_t)mA * N1P;
        cq0 = *(const v4u*)(row + 2048 + 16 * lane); cq1 = *(const v4u*)(row + 2048 + 16 * lane + 8); cql = *(const v4u*)(row + lcol);
        if ((mA & (T - 1)) != 0) { pq0 = *(const v4u*)(row - N1P + 2048 + 16 * lane); pq1 = *(const v4u*)(row - N1P + 2048 + 16 * lane + 8); pql = *(const v4u*)(row - N1P + lcol); }
        else { pq0 = zz4; pq1 = zz4; pql = zz4; }
    }
    for (int m = mA; m < mB; ++m) {
        const v4u q0 = cq0, q1 = cq1, ql = cql;
        v4u r0 = pq0, r1 = pq1, rl = pql;
        if ((m & (T - 1)) == 0) { r0 = zz4; r1 = zz4; rl = zz4; }
        if (m + 1 < mB) { const bf16* nrow = PR + (size_t)(m + 1) * N1P; cq0 = *(const v4u*)(nrow + 2048 + 16 * lane); cq1 = *(const v4u*)(nrow + 2048 + 16 * lane + 8); cql = *(const v4u*)(nrow + lcol); }
        pq0 = q0; pq1 = q1; pql = ql;
        float vs[16];
        {
            float p[16], pp[16];
            float t8[8];
            unpack8(q0, t8);
#pragma unroll
            for (int e = 0; e < 8; ++e) p[e] = t8[e];
            unpack8(q1, t8);
#pragma unroll
            for (int e = 0; e < 8; ++e) p[8 + e] = t8[e];
            unpack8(r0, t8);
#pragma unroll
            for (int e = 0; e < 8; ++e) pp[e] = t8[e];
            unpack8(r1, t8);
#pragma unroll
            for (int e = 0; e < 8; ++e) pp[8 + e] = t8[e];
#pragma unroll
            for (int e = 0; e < 16; ++e) vs[e] = p[e] + (pp[e] - p[e]) * muv[e];
            v4u o0, o1;
            o0.x = pk2(vs[0], vs[1]); o0.y = pk2(vs[2], vs[3]); o0.z = pk2(vs[4], vs[5]); o0.w = pk2(vs[6], vs[7]);
            o1.x = pk2(vs[8], vs[9]); o1.y = pk2(vs[10], vs[11]); o1.z = pk2(vs[12], vs[13]); o1.w = pk2(vs[14], vs[15]);
            *(v4u*)(VS + (size_t)m * D + 16 * lane) = o0; *(v4u*)(VS + (size_t)m * D + 16 * lane + 8) = o1;
        }
        if (lane < 36) {
            float p[8], pp[8], s[8];
            unpack8(ql, p);
            unpack8(rl, pp);
#pragma unroll
            for (int e = 0; e < 8; ++e) { const float x = p[e] + (pp[e] - p[e]) * mul[e]; s[e] = lane < 8 ? tanhf(x) : (lane < 16 ? x : sigmoidf_(x)); }
            *(v4u*)(AL + (size_t)m * KL + 8 * lane) = pack8(s);
        } else if (lane < 48 && !(l == 1 && lane < 40)) {
            *(v4u*)(AL + (size_t)m * KL + 8 * lane) = (v4u){0u, 0u, 0u, 0u};
        }
        if (l == 1) {
            float acc[32];
#pragma unroll
            for (int j = 0; j < 32; ++j) acc[j] = 0.f;
#pragma unroll
            for (int i = 0; i < 16; ++i) {
                const LAS v4u* wp = (const LAS v4u*)(v1L + (i * 64 + lane) * 40);
#pragma unroll
                for (int q = 0; q < 4; ++q) { float w8[8]; const v4u wq_ = wp[q]; unpack8(wq_, w8);
#pragma unroll
                    for (int e = 0; e < 8; ++e) acc[q * 8 + e] += vs[i] * w8[e]; }
            }
#pragma unroll
            for (int s = 32, half = 16; s >= 2; s >>= 1, half >>= 1) {
                const bool up = (lane & s) != 0;
#pragma unroll
                for (int i = 0; i < 16; ++i) if (i < half) { const float send = up ? acc[i] : acc[i + half]; const float keep = up ? acc[i + half] : acc[i]; acc[i] = keep + __shfl_xor(send, s); }
            }
            acc[0] += __shfl_xor(acc[0], 1);
            const int j = ((lane & 32) ? 16 : 0) + ((lane & 16) ? 8 : 0) + ((lane & 8) ? 4 : 0) + ((lane & 4) ? 2 : 0) + ((lane & 2) ? 1 : 0);
            if ((lane & 1) == 0) AL[(size_t)m * KL + 288 + j] = (bf16)f2bf(acc[0]);
        }
    }
    { float* DT = (float*)(ws + WS_OV + OV_DT); float* DA = (float*)(ws + WS_OV + OV_DA);
      for (int it = gw; it < (MH / 64) * 32; it += NGW) {
        const int ck = it >> 5, h = it & 31;
        const size_t m = (size_t)ck * 64 + lane;
        const float x = bf1(PR[m * N1P + DT_COL + h]) + a.in[I_DTB][l * 32 + h];
        const float dt = x > 20.f ? x : log1pf(__expf(x));
        float cs = -dt * __expf(a.in[I_ALOG][l * 32 + h]);
#pragma unroll
        for (int o = 1; o < 64; o <<= 1) { const float y = __shfl_up(cs, o); cs += (lane >= o) ? y : 0.f; }
        DT[m * 32 + h] = dt; DA[m * 32 + h] = cs;
      } }
}

__device__ __forceinline__ float sum8(float x) { x += dpp_mov<0xB1>(x); x += dpp_mov<0x4E>(x); x += dpp_mov<0x141>(x); return x; }
__device__ __forceinline__ void phase_rwkv_rec(const Ctx& c, KArgs& a, int l, int hb) {
    unsigned char* ws = a.ws;
    const bf16* PR = (const bf16*)(ws + WS_OV + OV_PR);
    const bf16* ELOG = (const bf16*)(ws + WS_OV + OV_ELOG);
    const bf16* ASIG = (const bf16*)(ws + WS_OV + OV_ASIG);
    const bf16* VS = l == 0 ? (const bf16*)(ws + WS_VF) + (size_t)hb * MH * D : (const bf16*)(ws + WS_OV + OV_VMIX);
    bf16* Y = (bf16*)(ws + WS_OV + OV_YA);
    const float* mu = a.in[I_MU] + (size_t)l * RW_PROJ;
    const float* k_k = a.in[I_KK] + (size_t)l * D; const float* k_a = a.in[I_KA] + (size_t)l * D;
    constexpr int CH = 32, NCH = T / CH;
    constexpr int ARRF = CH * 64;
    constexpr int BUFF = 5 * ARRF + CH * 16 + CH * 2;
    LAS float* ldsf = (LAS float*)c.lds;
    LAS float* yt = ldsf + 2 * BUFF;
    const int tid = c.tid, lane = c.lane;
    const bool is_prep = c.wave >= 4;
    const int ptid = tid - 256, tt = ptid >> 3, l8 = ptid & 7, pc = l8 * 8;
    const int rrow = c.wave * 4 + (lane >> 4), cc4 = (lane & 15) * 4;
    for (int unit = c.bid; unit < 256; unit += c.G) {
        const int b = unit >> 6, h = (unit >> 2) & 15, rq = unit & 3;
        const size_t m0 = (size_t)b * T;
        const int hc = h * 64 + pc;
        float mur[8], muk[8], kkc[8], kac[8];
        if (is_prep) {
#pragma unroll
            for (int e = 0; e < 8; ++e) { mur[e] = mu[hc + e]; muk[e] = mu[1024 + hc + e]; kkc[e] = k_k[hc + e]; kac[e] = k_a[hc + e]; }
        }
        float S[4] = {0.f, 0.f, 0.f, 0.f}, sa = 0.f;
#define RW_PREP(chunk, bufp) do { \
            const int t_ = (chunk) * CH + tt; const size_t mm = m0 + t_; const bf16* row = PR + mm * N1P + hc; \
            const v4u zr = (v4u){0u, 0u, 0u, 0u}; \
            const v4u qr = *(const v4u*)row, qk = *(const v4u*)(row + 1024); \
            const v4u qrp = t_ > 0 ? *(const v4u*)(row - N1P) : zr, qkp = t_ > 0 ? *(const v4u*)(row - N1P + 1024) : zr; \
            const v4u qkn = t_ + 1 < T ? *(const v4u*)(row + N1P + 1024) : zr; \
            const v4u qas = *(const v4u*)(ASIG + mm * D + hc), qel = *(const v4u*)(ELOG + mm * D + hc); \
            v4u qv = zr; if (l8 < 2) qv = *(const v4u*)(VS + mm * D + h * 64 + rq * 16 + l8 * 8); \
            float r_[8], rp_[8], k_[8], kp_[8], kn_[8], as_[8], el_[8]; \
            unpack8(qr, r_); unpack8(qrp, rp_); unpack8(qk, k_); unpack8(qkp, kp_); unpack8(qkn, kn_); unpack8(qas, as_); unpack8(qel, el_); \
            float ks_[8], kk_[8], kkn_[8], s1 = 0.f, s2 = 0.f; \
            _Pragma("unroll") for (int e = 0; e < 8; ++e) { ks_[e] = k_[e] + (kp_[e] - k_[e]) * muk[e]; const float kn1 = kn_[e] + (k_[e] - kn_[e]) * muk[e]; \
                kk_[e] = ks_[e] * kkc[e]; kkn_[e] = kn1 * kkc[e]; s1 += kk_[e] * kk_[e]; s2 += kkn_[e] * kkn_[e]; } \
            s1 = sum8(s1); s2 = sum8(s2); \
            const float i1 = rsqrtf(s1 + 1e-12f), i2 = (t_ + 1 < T) ? rsqrtf(s2 + 1e-12f) : 0.f; \
            float ow[8], ok[8], ob[8], orr[8], owa[8], c1 = 0.f, c2 = 0.f; \
            _Pragma("unroll") for (int e = 0; e < 8; ++e) { const float kn = kk_[e] * i1, an = -kkn_[e] * i2; \
                ow[e] = __expf(el_[e]); ok[e] = ks_[e] * (1.f + (as_[e] - 1.f) * kac[e]); ob[e] = kn * as_[e]; orr[e] = r_[e] + (rp_[e] - r_[e]) * mur[e]; \
                owa[e] = ow[e] * an; c1 += ob[e] * an; c2 += ok[e] * an; } \
            c1 = sum8(c1); c2 = sum8(c2); \
            LAS float* bp_ = (bufp) + tt * 64 + pc; \
            *(LAS f32x4*)(bp_) = (f32x4){ow[0], ow[1], ow[2], ow[3]}; *(LAS f32x4*)(bp_ + 4) = (f32x4){ow[4], ow[5], ow[6], ow[7]}; \
            *(LAS f32x4*)(bp_ + ARRF) = (f32x4){ok[0], ok[1], ok[2], ok[3]}; *(LAS f32x4*)(bp_ + ARRF + 4) = (f32x4){ok[4], ok[5], ok[6], ok[7]}; \
            *(LAS f32x4*)(bp_ + 2 * ARRF) = (f32x4){ob[0], ob[1], ob[2], ob[3]}; *(LAS f32x4*)(bp_ + 2 * ARRF + 4) = (f32x4){ob[4], ob[5], ob[6], ob[7]}; \
            *(LAS f32x4*)(bp_ + 3 * ARRF) = (f32x4){orr[0], orr[1], orr[2], orr[3]}; *(LAS f32x4*)(bp_ + 3 * ARRF + 4) = (f32x4){orr[4], orr[5], orr[6], orr[7]}; \
            *(LAS f32x4*)(bp_ + 4 * ARRF) = (f32x4){owa[0], owa[1], owa[2], owa[3]}; *(LAS f32x4*)(bp_ + 4 * ARRF + 4) = (f32x4){owa[4], owa[5], owa[6], owa[7]}; \
            if (l8 < 2) { float v_[8]; unpack8(qv, v_); LAS float* vp_ = (bufp) + 5 * ARRF + tt * 16 + l8 * 8; \
                *(LAS f32x4*)vp_ = (f32x4){v_[0], v_[1], v_[2], v_[3]}; *(LAS f32x4*)(vp_ + 4) = (f32x4){v_[4], v_[5], v_[6], v_[7]}; } \
            if (l8 == 0) { (bufp)[5 * ARRF + CH * 16 + tt * 2] = c1; (bufp)[5 * ARRF + CH * 16 + tt * 2 + 1] = c2; } } while (0)
#define RW_YSTORE(chunk) do { const LAS float* yp_ = yt + ((chunk) & 1) * CH * 16 + tt * 16 + l8 * 2; \
            *(unsigned*)(Y + (m0 + (size_t)(chunk) * CH + tt) * D + h * 64 + rq * 16 + l8 * 2) = pk2(yp_[0], yp_[1]); } while (0)
        if (is_prep) RW_PREP(0, ldsf);
        __syncthreads();
        for (int ch = 0; ch < NCH; ++ch) {
            if (is_prep) {
                if (ch + 1 < NCH) RW_PREP(ch + 1, ldsf + ((ch + 1) & 1) * BUFF);
                if (ch > 0) RW_YSTORE(ch - 1);
            } else {
                const LAS float* buf = ldsf + (ch & 1) * BUFF;
                LAS float* yw = yt + (ch & 1) * CH * 16;
                const int lane15 = lane & 15;
                f32x4 w4 = *(const LAS f32x4*)(buf + cc4), k4 = *(const LAS f32x4*)(buf + ARRF + cc4), b4 = *(const LAS f32x4*)(buf + 2 * ARRF + cc4);
                f32x4 r4 = *(const LAS f32x4*)(buf + 3 * ARRF + cc4), wa4 = *(const LAS f32x4*)(buf + 4 * ARRF + cc4);
                float v = buf[5 * ARRF + rrow]; f32x2 cc = *(const LAS f32x2*)(buf + 5 * ARRF + CH * 16);
#pragma unroll 1
                for (int t16 = 0; t16 < CH; t16 += 16) {
                    float ysave = 0.f;
#pragma unroll
                    for (int u = 0; u < 16; ++u) {
                        const int tn = (t16 + u + 1 < CH) ? t16 + u + 1 : t16 + u;
                        const f32x4 nw4 = *(const LAS f32x4*)(buf + tn * 64 + cc4), nk4 = *(const LAS f32x4*)(buf + ARRF + tn * 64 + cc4), nb4 = *(const LAS f32x4*)(buf + 2 * ARRF + tn * 64 + cc4);
                        const f32x4 nr4 = *(const LAS f32x4*)(buf + 3 * ARRF + tn * 64 + cc4), nwa4 = *(const LAS f32x4*)(buf + 4 * ARRF + tn * 64 + cc4);
                        const float nv = buf[5 * ARRF + tn * 16 + rrow]; const f32x2 ncc = *(const LAS f32x2*)(buf + 5 * ARRF + CH * 16 + tn * 2);
                        float d = S[0] * wa4[0]; d = __builtin_fmaf(S[1], wa4[1], d); d = __builtin_fmaf(S[2], wa4[2], d); d = __builtin_fmaf(S[3], wa4[3], d);
#pragma unroll
                        for (int e = 0; e < 4; ++e) { float tmp = S[e] * w4[e]; asm volatile("" : "+v"(tmp)); tmp = __builtin_fmaf(v, k4[e], tmp); S[e] = __builtin_fmaf(sa, b4[e], tmp); asm volatile("" : "+v"(S[e])); }
                        const float sa_next = __builtin_fmaf(v, cc.y, sa * cc.x);
                        float y = S[0] * r4[0]; y = __builtin_fmaf(S[1], r4[1], y); y = __builtin_fmaf(S[2], r4[2], y); y = __builtin_fmaf(S[3], r4[3], y);
                        d = sum16(d); y = sum16(y);
                        sa = d + sa_next;
                        ysave = (lane15 == u) ? y : ysave;
                        w4 = nw4; k4 = nk4; b4 = nb4; r4 = nr4; wa4 = nwa4; v = nv; cc = ncc;
                    }
                    yw[(t16 + lane15) * 16 + rrow] = ysave;
                }
            }
            __syncthreads();
        }
        if (is_prep) RW_YSTORE(NCH - 1);
        __syncthreads();
#undef RW_PREP
#undef RW_YSTORE
    }
}

constexpr int CK_TS = 72, CK_TB = 64 * CK_TS;
__device__ __forceinline__ void tr_a2(unsigned a, bf16x8& f0, bf16x8& f1) {
    s16x4 l0, h0, l1, h1;
    asm volatile("ds_read_b64_tr_b16 %0, %4\n\tds_read_b64_tr_b16 %1, %4 offset:576\n\tds_read_b64_tr_b16 %2, %4 offset:4608\n\tds_read_b64_tr_b16 %3, %4 offset:5184\n\ts_waitcnt lgkmcnt(0)"
                 : "=&v"(l0), "=&v"(h0), "=&v"(l1), "=&v"(h1) : "v"(a) : "memory");
    f0 = __builtin_shufflevector(l0, h0, 0, 1, 2, 3, 4, 5, 6, 7); f1 = __builtin_shufflevector(l1, h1, 0, 1, 2, 3, 4, 5, 6, 7);
}
__device__ __forceinline__ void tr_b4(unsigned a, bf16x8& f00, bf16x8& f01, bf16x8& f10, bf16x8& f11) {
    s16x4 l0, h0, l1, h1, l2, h2, l3, h3;
    asm volatile("ds_read_b64_tr_b16 %0, %8\n\tds_read_b64_tr_b16 %1, %8 offset:576\n\tds_read_b64_tr_b16 %2, %8 offset:4608\n\tds_read_b64_tr_b16 %3, %8 offset:5184\n\t"
                 "ds_read_b64_tr_b16 %4, %8 offset:32\n\tds_read_b64_tr_b16 %5, %8 offset:608\n\tds_read_b64_tr_b16 %6, %8 offset:4640\n\tds_read_b64_tr_b16 %7, %8 offset:5216\n\ts_waitcnt lgkmcnt(0)"
                 : "=&v"(l0), "=&v"(h0), "=&v"(l1), "=&v"(h1), "=&v"(l2), "=&v"(h2), "=&v"(l3), "=&v"(h3) : "v"(a) : "memory");
    f00 = __builtin_shufflevector(l0, h0, 0, 1, 2, 3, 4, 5, 6, 7); f01 = __builtin_shufflevector(l1, h1, 0, 1, 2, 3, 4, 5, 6, 7);
    f10 = __builtin_shufflevector(l2, h2, 0, 1, 2, 3, 4, 5, 6, 7); f11 = __builtin_shufflevector(l3, h3, 0, 1, 2, 3, 4, 5, 6, 7);
}
template <int PA, int QA, int MASK, int NINIT, int NPAIR, int POST>
__device__ __forceinline__ void mm64(LAS bf16* X, const LAS bf16* P, const LAS bf16* Q, const LAS bf16* P2, const LAS bf16* Q2, const LAS bf16* E1, const LAS bf16* E2,
                                     const LAS float* cscale, const LAS float* wc, int w, int lane) {
    const int r = lane & 15, q = lane >> 4, Ct = w >> 1, Rt0 = 2 * (w & 1);
    const int i16 = lane & 15, qq = i16 >> 2, p4 = i16 & 3;
    const int troff = ((8 * q + qq) * CK_TS + 4 * p4) * 2;
    f32x4 acc[2];
#pragma unroll
    for (int i = 0; i < 2; ++i) {
        const int R = 16 * (Rt0 + i) + r;
        if (NINIT == 0) acc[i] = (f32x4){0.f, 0.f, 0.f, 0.f};
        else { const v2u e1 = *(const LAS v2u*)(E1 + R * CK_TS + 16 * Ct + 4 * q); acc[i] = (f32x4){bflo(e1.x), bfhi(e1.x), bflo(e1.y), bfhi(e1.y)};
            if (NINIT == 2) { const v2u e2 = *(const LAS v2u*)(E2 + R * CK_TS + 16 * Ct + 4 * q); acc[i] += (f32x4){bflo(e2.x), bfhi(e2.x), bflo(e2.y), bfhi(e2.y)}; } }
    }
#pragma unroll
    for (int pr = 0; pr < NPAIR; ++pr) {
        const LAS bf16* Pp = pr == 0 ? P : P2; const LAS bf16* Qp = pr == 0 ? Q : Q2;
        bf16x8 af[2], bfr[2][2];
        if (PA == 0) {
#pragma unroll
            for (int i = 0; i < 2; ++i)
#pragma unroll
                for (int ks = 0; ks < 2; ++ks) bfr[i][ks] = *(const LAS bf16x8*)(Pp + (16 * (Rt0 + i) + r) * CK_TS + 32 * ks + 8 * q);
        }
        if (QA == 1) {
#pragma unroll
            for (int ks = 0; ks < 2; ++ks) af[ks] = *(const LAS bf16x8*)(Qp + (16 * Ct + r) * CK_TS + 32 * ks + 8 * q);
        } else tr_a2((unsigned)(size_t)Qp + (unsigned)(troff + 32 * Ct), af[0], af[1]);
        if (PA == 1) tr_b4((unsigned)(size_t)Pp + (unsigned)(troff + 32 * Rt0), bfr[0][0], bfr[0][1], bfr[1][0], bfr[1][1]);
#pragma unroll
        for (int ks = 0; ks < 2; ++ks)
#pragma unroll
            for (int i = 0; i < 2; ++i) acc[i] = __builtin_amdgcn_mfma_f32_16x16x32_bf16(af[ks], bfr[i][ks], acc[i], 0, 0, 0);
    }
#pragma unroll
    for (int i = 0; i < 2; ++i) {
        const int R = 16 * (Rt0 + i) + r;
        float v[4];
#pragma unroll
        for (int e = 0; e < 4; ++e) { const int C = 16 * Ct + 4 * q + e; float x = acc[i][e];
            if (MASK == 1) x = (C < R) ? x : 0.f;
            if (MASK == 2) x = (C <= R) ? x : 0.f;
            if (POST >= 1) x *= cscale[C];
            if (POST == 2) x += (C == R) ? wc[C] : 0.f;
            v[e] = x; }
        v2u o; o.x = pk2c(v[0], v[1]); o.y = pk2c(v[2], v[3]);
        *(LAS v2u*)(X + R * CK_TS + 16 * Ct + 4 * q) = o;
    }
}

template <int PA, int QA, int MASK, int NINIT, int NPAIR, int POST>
__device__ __forceinline__ void mm64h(LAS bf16* X, const LAS bf16* P, const LAS bf16* Q, const LAS bf16* P2, const LAS bf16* Q2, const LAS bf16* E1, const LAS bf16* E2,
                                      const LAS float* cscale, const LAS float* wc, int ws, int lane) {
    const int r = lane & 15, q = lane >> 4, Cb = ws >> 1, Rb = ws & 1;
    const int i16 = lane & 15, qq = i16 >> 2, p4 = i16 & 3;
    const int troff = ((8 * q + qq) * CK_TS + 4 * p4) * 2;
    f32x4 acc[2][2];
#pragma unroll
    for (int ci = 0; ci < 2; ++ci)
#pragma unroll
        for (int ri = 0; ri < 2; ++ri) {
            const int R = 16 * (2 * Rb + ri) + r, C0 = 16 * (2 * Cb + ci) + 4 * q;
            if (NINIT == 0) acc[ci][ri] = (f32x4){0.f, 0.f, 0.f, 0.f};
            else { const v2u e1 = *(const LAS v2u*)(E1 + R * CK_TS + C0); acc[ci][ri] = (f32x4){bflo(e1.x), bfhi(e1.x), bflo(e1.y), bfhi(e1.y)};
                if (NINIT == 2) { const v2u e2 = *(const LAS v2u*)(E2 + R * CK_TS + C0); acc[ci][ri] += (f32x4){bflo(e2.x), bfhi(e2.x), bflo(e2.y), bfhi(e2.y)}; } }
        }
#pragma unroll
    for (int pr = 0; pr < NPAIR; ++pr) {
        const LAS bf16* Pp = pr == 0 ? P : P2; const LAS bf16* Qp = pr == 0 ? Q : Q2;
        bf16x8 af[2][2], bfr[2][2];
        if (PA == 0) {
#pragma unroll
            for (int ri = 0; ri < 2; ++ri)
#pragma unroll
                for (int ks = 0; ks < 2; ++ks) bfr[ri][ks] = *(const LAS bf16x8*)(Pp + (16 * (2 * Rb + ri) + r) * CK_TS + 32 * ks + 8 * q);
        }
        if (QA == 1) {
#pragma unroll
            for (int ci = 0; ci < 2; ++ci)
#pragma unroll
                for (int ks = 0; ks < 2; ++ks) af[ci][ks] = *(const LAS bf16x8*)(Qp + (16 * (2 * Cb + ci) + r) * CK_TS + 32 * ks + 8 * q);
        } else tr_b4((unsigned)(size_t)Qp + (unsigned)(troff + 64 * Cb), af[0][0], af[0][1], af[1][0], af[1][1]);
        if (PA == 1) tr_b4((unsigned)(size_t)Pp + (unsigned)(troff + 64 * Rb), bfr[0][0], bfr[0][1], bfr[1][0], bfr[1][1]);
#pragma unroll
        for (int ks = 0; ks < 2; ++ks)
#pragma unroll
            for (int ci = 0; ci < 2; ++ci)
#pragma unroll
                for (int ri = 0; ri < 2; ++ri) acc[ci][ri] = __builtin_amdgcn_mfma_f32_16x16x32_bf16(af[ci][ks], bfr[ri][ks], acc[ci][ri], 0, 0, 0);
    }
#pragma unroll
    for (int ci = 0; ci < 2; ++ci)
#pragma unroll
        for (int ri = 0; ri < 2; ++ri) {
            const int R = 16 * (2 * Rb + ri) + r;
            float v[4];
#pragma unroll
            for (int e = 0; e < 4; ++e) { const int C = 16 * (2 * Cb + ci) + 4 * q + e; float x = acc[ci][ri][e];
                if (MASK == 1) x = (C < R) ? x : 0.f;
                if (MASK == 2) x = (C <= R) ? x : 0.f;
                if (POST >= 1) x *= cscale[C];
                if (POST == 2) x += (C == R) ? wc[C] : 0.f;
                v[e] = x; }
            v2u o; o.x = pk2c(v[0], v[1]); o.y = pk2c(v[2], v[3]);
            *(LAS v2u*)(X + R * CK_TS + 16 * (2 * Cb + ci) + 4 * q) = o;
        }
}

__device__ __forceinline__ void phase_rwkv_chunk_par(const Ctx& c, KArgs& a, int l, int hb) {
    unsigned char* ws = a.ws;
    bf16* PR = (bf16*)(ws + WS_OV + OV_PR);
    bf16* ELOG = (bf16*)(ws + WS_OV + OV_ELOG);
    const bf16* ASIG = (const bf16*)(ws + WS_OV + OV_ASIG);
    const bf16* VS = l == 0 ? (const bf16*)(ws + WS_VF) + (size_t)hb * MH * D : (const bf16*)(ws + WS_OV + OV_VMIX);
    bf16* Y = (bf16*)(ws + WS_OV + OV_YA);
    bf16* SLB = (bf16*)(ws + WS_OV + OV_AL);
    const float* mu = a.in[I_MU] + (size_t)l * RW_PROJ;
    const float* k_k = a.in[I_KK] + (size_t)l * D; const float* k_a = a.in[I_KA] + (size_t)l * D; const float* rk_ = a.in[I_RK] + (size_t)l * D;
    float* BON = (float*)(ws + WS_OV + OV_BON);
    LAS bf16* tile = (LAS bf16*)c.lds;
    enum { tA = 0, tR, tBt, tKt, tBh, tKh, tV, tNab, tNak, tNrb, tNrk, tM0, tM1, tP1, tX1, NT };
#define TL(i) (tile + (i) * CK_TB)
    LAS float* cscale = (LAS float*)(tile + NT * CK_TB);
    LAS float* wcv = cscale + 64;
    LAS float* SCR = (LAS float*)TL(tM0);
    LAS float* SEGT = SCR + 64 * 64;
    const int tid = c.tid, lane = c.lane, w = c.wave;
    const int tt = tid >> 3, l8 = tid & 7, pc = l8 * 8;
    v4u qr, qk, qrp, qkp, qas, qel, qv;
#define CK_LOAD(un) do { const int b_ = (un) >> 10, h_ = ((un) >> 6) & 15, ch_ = (un) & 63; const int t_ = ch_ * 64 + tt; \
        const size_t mm = (size_t)b_ * T + (size_t)t_; const bf16* row = PR + mm * N1P + h_ * 64 + pc; const v4u zr = (v4u){0u, 0u, 0u, 0u}; \
        qr = *(const v4u*)row; qk = *(const v4u*)(row + 1024); qrp = t_ > 0 ? *(const v4u*)(row - N1P) : zr; qkp = t_ > 0 ? *(const v4u*)(row - N1P + 1024) : zr; \
        qas = *(const v4u*)(ASIG + mm * D + h_ * 64 + pc); qel = *(const v4u*)(ELOG + mm * D + h_ * 64 + pc); qv = *(const v4u*)(VS + mm * D + h_ * 64 + pc); } while (0)
    if (c.bid < 4096) CK_LOAD(c.bid);
    for (int unit = c.bid; unit < 4096; unit += c.G) {
        const int b = unit >> 10, h = (unit >> 6) & 15, ch = unit & 63;
        const size_t m0 = (size_t)b * T + (size_t)ch * 64;
        const int hc = h * 64 + pc;
        for (int rep = 0; rep < (PROBE_DUP == 7 ? 2 : 1); ++rep) {
        if (PROBE_DUP == 7) { CK_LOAD(unit); }
        float r_[8], k_[8], as_[8], el_[8], v_[8], kk_[8], ks_[8];
        {
            float rp_[8], kp_[8];
            unpack8(qr, r_); unpack8(qrp, rp_); unpack8(qk, k_); unpack8(qkp, kp_); unpack8(qas, as_); unpack8(qel, el_); unpack8(qv, v_);
            if (PROBE_DUP != 7 && unit + c.G < 4096) CK_LOAD(unit + c.G);
            float s1 = 0.f;
#pragma unroll
            for (int e = 0; e < 8; ++e) { r_[e] = r_[e] + (rp_[e] - r_[e]) * mu[hc + e]; ks_[e] = k_[e] + (kp_[e] - k_[e]) * mu[1024 + hc + e]; kk_[e] = ks_[e] * k_k[hc + e]; s1 += kk_[e] * kk_[e]; }
            s1 = sum8(s1);
            const float i1 = rsqrtf(s1 + 1e-12f);
#pragma unroll
            for (int e = 0; e < 8; ++e) { kk_[e] *= i1; k_[e] = ks_[e] * (1.f + (as_[e] - 1.f) * k_a[hc + e]); }
            { float bn = 0.f;
#pragma unroll
              for (int e = 0; e < 8; ++e) bn += r_[e] * k_[e] * rk_[hc + e];
              bn = sum8(bn);
              if (l8 == 0) BON[(m0 + tt) * 16 + h] = bn; }
            *(LAS f32x4*)(SCR + tt * 64 + pc) = (f32x4){el_[0], el_[1], el_[2], el_[3]}; *(LAS f32x4*)(SCR + tt * 64 + pc + 4) = (f32x4){el_[4], el_[5], el_[6], el_[7]};
        }
        lds_barrier();
        {
            const int col = tid & 63, seg = tid >> 6; float s = 0.f;
#pragma unroll
            for (int i = 0; i < 8; ++i) { s += SCR[(8 * seg + i) * 64 + col]; SCR[(8 * seg + i) * 64 + col] = s; }
            SEGT[seg * 64 + col] = s;
        }
        lds_barrier();
        {
            const int col = tid & 63, seg = tid >> 6; float pre = 0.f;
#pragma unroll
            for (int s2 = 0; s2 < 7; ++s2) pre += (s2 < seg) ? SEGT[s2 * 64 + col] : 0.f;
#pragma unroll
            for (int i = 0; i < 8; ++i) SCR[(8 * seg + i) * 64 + col] += pre;
        }
        lds_barrier();
        {
            float L[8], Lr[8], Le[8];
            { const f32x4 x0 = *(const LAS f32x4*)(SCR + tt * 64 + pc), x1 = *(const LAS f32x4*)(SCR + tt * 64 + pc + 4);
              const f32x4 y0 = *(const LAS f32x4*)(SCR + 31 * 64 + pc), y1 = *(const LAS f32x4*)(SCR + 31 * 64 + pc + 4);
              const f32x4 z0 = *(const LAS f32x4*)(SCR + 63 * 64 + pc), z1 = *(const LAS f32x4*)(SCR + 63 * 64 + pc + 4);
#pragma unroll
              for (int e = 0; e < 4; ++e) { L[e] = x0[e]; L[4 + e] = x1[e]; Lr[e] = y0[e]; Lr[4 + e] = y1[e]; Le[e] = z0[e]; Le[4 + e] = z1[e]; } }
            float oA[8], oR[8], oBt[8], oKt[8], oBh[8], oKh[8];
#pragma unroll
            for (int e = 0; e < 8; ++e) {
                const float ea = __expf(L[e] - el_[e] - Lr[e]), er = __expf(L[e] - Lr[e]), eb = __expf(Lr[e] - L[e]), eh = __expf(Le[e] - L[e]);
                const float bb = kk_[e] * as_[e];
                oA[e] = -kk_[e] * ea; oR[e] = r_[e] * er; oBt[e] = bb * eb; oKt[e] = k_[e] * eb; oBh[e] = bb * eh; oKh[e] = k_[e] * eh;
            }
            const int o = tt * CK_TS + pc;
            *(LAS v4u*)(TL(tA) + o) = pack8(oA); *(LAS v4u*)(TL(tR) + o) = pack8(oR); *(LAS v4u*)(TL(tBt) + o) = pack8(oBt); *(LAS v4u*)(TL(tKt) + o) = pack8(oKt);
            *(LAS v4u*)(TL(tBh) + o) = pack8(oBh); *(LAS v4u*)(TL(tKh) + o) = pack8(oKh); *(LAS v4u*)(TL(tV) + o) = pack8(v_);
            if (tt == 0) {
#pragma unroll
                for (int e = 0; e < 8; ++e) { cscale[pc + e] = __expf(Lr[e]); wcv[pc + e] = __expf(Le[e]); }
            }
        }
        lds_barrier();
        const LAS bf16* Z = nullptr;
        const int wg_ = w >> 2, ws_ = w & 3;
        if (wg_ == 0) { mm64h<0, 1, 1, 0, 1, 0>(TL(tNab), TL(tA), TL(tBt), Z, Z, Z, Z, cscale, wcv, ws_, lane);
                        mm64h<0, 1, 1, 0, 1, 0>(TL(tNak), TL(tA), TL(tKt), Z, Z, Z, Z, cscale, wcv, ws_, lane); }
        else          { mm64h<0, 1, 2, 0, 1, 0>(TL(tNrb), TL(tR), TL(tBt), Z, Z, Z, Z, cscale, wcv, ws_, lane);
                        mm64h<0, 1, 2, 0, 1, 0>(TL(tNrk), TL(tR), TL(tKt), Z, Z, Z, Z, cscale, wcv, ws_, lane); }
        lds_barrier();
        if (wg_ == 0) mm64h<0, 0, 0, 0, 1, 0>(TL(tM0), TL(tNab), TL(tNab), Z, Z, Z, Z, cscale, wcv, ws_, lane);
        else          mm64h<0, 0, 0, 0, 1, 0>(TL(tX1), TL(tNak), TL(tV), Z, Z, Z, Z, cscale, wcv, ws_, lane);
        lds_barrier();
        if (wg_ == 0) mm64h<0, 0, 0, 2, 1, 0>(TL(tP1), TL(tNab), TL(tM0), Z, Z, TL(tNab), TL(tM0), cscale, wcv, ws_, lane);
        else          mm64h<0, 0, 0, 0, 1, 0>(TL(tM1), TL(tM0), TL(tM0), Z, Z, Z, Z, cscale, wcv, ws_, lane);
        lds_barrier();
        if (wg_ == 0) mm64h<0, 0, 0, 2, 1, 0>(TL(tNab), TL(tP1), TL(tM1), Z, Z, TL(tP1), TL(tM1), cscale, wcv, ws_, lane);
        else          mm64h<0, 0, 0, 0, 1, 0>(TL(tM0), TL(tM1), TL(tM1), Z, Z, Z, Z, cscale, wcv, ws_, lane);
        lds_barrier();
        if (wg_ == 0) mm64h<0, 0, 0, 2, 1, 0>(TL(tP1), TL(tNab), TL(tM0), Z, Z, TL(tNab), TL(tM0), cscale, wcv, ws_, lane);
        else          mm64h<0, 0, 0, 0, 1, 0>(TL(tM1), TL(tM0), TL(tM0), Z, Z, Z, Z, cscale, wcv, ws_, lane);
        lds_barrier();
        if (wg_ == 0) mm64h<0, 0, 0, 2, 1, 0>(TL(tNab), TL(tP1), TL(tM1), Z, Z, TL(tP1), TL(tM1), cscale, wcv, ws_, lane);
        else          mm64h<0, 0, 0, 0, 1, 0>(TL(tM0), TL(tM1), TL(tM1), Z, Z, Z, Z, cscale, wcv, ws_, lane);
        lds_barrier();
        mm64<0, 0, 0, 2, 1, 0>(TL(tP1), TL(tNab), TL(tM0), Z, Z, TL(tNab), TL(tM0), cscale, wcv, w, lane);
        lds_barrier();
        if (wg_ == 0) mm64h<0, 0, 0, 1, 1, 0>(TL(tBt), TL(tP1), TL(tA), Z, Z, TL(tA), Z, cscale, wcv, ws_, lane);
        else          mm64h<0, 0, 0, 1, 1, 0>(TL(tKt), TL(tP1), TL(tX1), Z, Z, TL(tX1), Z, cscale, wcv, ws_, lane);
        lds_barrier();
        if (wg_ == 0) { mm64h<0, 0, 0, 1, 1, 1>(TL(tM0), TL(tNrb), TL(tBt), Z, Z, TL(tR), Z, cscale, wcv, ws_, lane);
                        mm64h<0, 0, 0, 0, 2, 0>(TL(tM1), TL(tNrb), TL(tKt), TL(tNrk), TL(tV), Z, Z, cscale, wcv, ws_, lane); }
        else          { mm64h<1, 0, 0, 0, 1, 2>(TL(tNab), TL(tBh), TL(tBt), Z, Z, Z, Z, cscale, wcv, ws_, lane);
                        mm64h<1, 0, 0, 0, 2, 0>(TL(tX1), TL(tKt), TL(tBh), TL(tV), TL(tKh), Z, Z, cscale, wcv, ws_, lane); }
        lds_barrier();
        }
        {
            const size_t grow = m0 + tt;
            *(v4u*)(ELOG + grow * D + hc) = *(const LAS v4u*)(TL(tM0) + tt * CK_TS + pc);
            *(v4u*)(Y + grow * D + hc) = *(const LAS v4u*)(TL(tM1) + tt * CK_TS + pc);
            *(v4u*)(PR + grow * N1P + 2048 + hc) = *(const LAS v4u*)(TL(tNab) + tt * CK_TS + pc);
            *(v4u*)(SLB + grow * D + hc) = *(const LAS v4u*)(TL(tX1) + tt * CK_TS + pc);
        }
        lds_barrier();
    }
#undef TL
#undef CK_LOAD
}

struct SeqOps { v4u g0, g1, p0, p1; v2u sl, yl; };
__device__ __forceinline__ void phase_rwkv_chunk_seq(const Ctx& c, KArgs& a, const bool commit = true) {
    unsigned char* ws = a.ws;
    const bf16* PR = (const bf16*)(ws + WS_OV + OV_PR);
    const bf16* RP = (const bf16*)(ws + WS_OV + OV_ELOG);
    bf16* Y = (bf16*)(ws + WS_OV + OV_YA);
    const bf16* SLB = (const bf16*)(ws + WS_OV + OV_AL);
    LAS bf16* SL = (LAS bf16*)c.lds;
    const int tid = c.tid, lane = c.lane, w = c.wave, r = lane & 15, q = lane >> 4;
    constexpr int PF = 4;
    for (int unit = c.bid; unit < 256; unit += c.G) {
        const int b = unit >> 6, h = (unit >> 2) & 15, vq = unit & 3;
        for (int e = tid; e < 2 * 16 * CK_TS / 2; e += 512) ((LAS unsigned*)SL)[e] = 0u;
        __syncthreads();
        if (w < 4) {
            const size_t rowG = (size_t)b * T + 16 * w + r;
            const size_t rowS = (size_t)b * T + vq * 16 + r;
            SeqOps ops[PF];
#define SQ_LOAD(dst, chn) do { const size_t o_ = (size_t)(chn) * 64; \
                dst.g0 = *(const v4u*)(PR + (rowG + o_) * N1P + 2048 + h * 64 + 8 * q); dst.g1 = *(const v4u*)(PR + (rowG + o_) * N1P + 2048 + h * 64 + 32 + 8 * q); \
                dst.p0 = *(const v4u*)(RP + (rowG + o_) * D + h * 64 + 8 * q); dst.p1 = *(const v4u*)(RP + (rowG + o_) * D + h * 64 + 32 + 8 * q); \
                dst.sl = *(const v2u*)(SLB + (rowS + o_) * D + h * 64 + 16 * w + 4 * q); dst.yl = *(const v2u*)(Y + (rowG + o_) * D + h * 64 + vq * 16 + 4 * q); } while (0)
#pragma unroll
            for (int i = 0; i < PF; ++i) SQ_LOAD(ops[i], i);
            for (int ch0 = 0; ch0 < 64; ch0 += PF) {
#pragma unroll
                for (int i = 0; i < PF; ++i) {
                    const int ch = ch0 + i;
                    const SeqOps cur = ops[i];
                    if (ch + PF < 64) SQ_LOAD(ops[i], ch + PF);
                    const LAS bf16* Sc = SL + (i & 1) * 16 * CK_TS; LAS bf16* Sn = SL + ((i + 1) & 1) * 16 * CK_TS;
                    const bf16x8 s0 = *(const LAS bf16x8*)(Sc + r * CK_TS + 8 * q), s1 = *(const LAS bf16x8*)(Sc + r * CK_TS + 32 + 8 * q);
                    f32x4 accS = (f32x4){bflo(cur.sl.x), bfhi(cur.sl.x), bflo(cur.sl.y), bfhi(cur.sl.y)};
                    accS = __builtin_amdgcn_mfma_f32_16x16x32_bf16(__builtin_bit_cast(bf16x8, cur.g0), s0, accS, 0, 0, 0);
                    accS = __builtin_amdgcn_mfma_f32_16x16x32_bf16(__builtin_bit_cast(bf16x8, cur.g1), s1, accS, 0, 0, 0);
                    f32x4 accY = (f32x4){bflo(cur.yl.x), bfhi(cur.yl.x), bflo(cur.yl.y), bfhi(cur.yl.y)};
                    accY = __builtin_amdgcn_mfma_f32_16x16x32_bf16(s0, __builtin_bit_cast(bf16x8, cur.p0), accY, 0, 0, 0);
                    accY = __builtin_amdgcn_mfma_f32_16x16x32_bf16(s1, __builtin_bit_cast(bf16x8, cur.p1), accY, 0, 0, 0);
                    { v2u o; o.x = pk2c(accS[0], accS[1]); o.y = pk2c(accS[2], accS[3]); *(LAS v2u*)(Sn + r * CK_TS + 16 * w + 4 * q) = o; }
                    if (commit || accY[0] == 123456.789f) { v2u o; o.x = pk2c(accY[0], accY[1]); o.y = pk2c(accY[2], accY[3]); *(v2u*)(Y + (rowG + (size_t)ch * 64) * D + h * 64 + vq * 16 + 4 * q) = o; }
                    lds_barrier();
                }
            }
#undef SQ_LOAD
        } else {
            for (int ch = 0; ch < 64; ++ch) lds_barrier();
        }
        __syncthreads();
    }
}

__device__ __forceinline__ void phase_rwkv_post(const Ctx& c, KArgs& a, int l, int hb) {
    unsigned char* ws = a.ws;
    const bf16* GG = (const bf16*)(ws + WS_OV + OV_GG);
    const bf16* VS = l == 0 ? (const bf16*)(ws + WS_VF) + (size_t)hb * MH * D : (const bf16*)(ws + WS_OV + OV_VMIX);
    const float* BON = (const float*)(ws + WS_OV + OV_BON);
    bf16* Y = (bf16*)(ws + WS_OV + OV_YA);
    const int lane = c.lane, c0 = 16 * lane;
    float lw[16], lb[16];
#pragma unroll
    for (int e = 0; e < 16; ++e) { lw[e] = a.in[I_LNW][(size_t)l * D + c0 + e]; lb[e] = a.in[I_LNB][(size_t)l * D + c0 + e]; }
    const int gw = c.bid * 8 + c.wave, NGW = c.G * 8;
    v4u ny0, ny1, nv0, nv1, ng0, ng1; float nbon = 0.f;
#define RP_LOAD(mm) do { ny0 = *(const v4u*)(Y + (size_t)(mm) * D + c0); ny1 = *(const v4u*)(Y + (size_t)(mm) * D + c0 + 8); nv0 = *(const v4u*)(VS + (size_t)(mm) * D + c0); nv1 = *(const v4u*)(VS + (size_t)(mm) * D + c0 + 8); \
        ng0 = *(const v4u*)(GG + (size_t)(mm) * D + c0); ng1 = *(const v4u*)(GG + (size_t)(mm) * D + c0 + 8); nbon = BON[(size_t)(mm) * 16 + (lane >> 2)]; } while (0)
    if (gw < MH) RP_LOAD(gw);
    for (int m = gw; m < MH; m += NGW) {
        float y[16], v[16], g[16], t8[8];
        const v4u cy0 = ny0, cy1 = ny1, cv0 = nv0, cv1 = nv1, cg0 = ng0, cg1 = ng1; const float bon = nbon;
        if (m + NGW < MH) RP_LOAD(m + NGW);
#define UP16(dst, qa, qb) do { unpack8(qa, t8); _Pragma("unroll") for (int e = 0; e < 8; ++e) dst[e] = t8[e]; unpack8(qb, t8); _Pragma("unroll") for (int e = 0; e < 8; ++e) dst[8 + e] = t8[e]; } while (0)
        UP16(y, cy0, cy1); UP16(v, cv0, cv1); UP16(g, cg0, cg1);
#undef UP16
        float s1 = 0.f;
#pragma unroll
        for (int e = 0; e < 16; ++e) s1 += y[e];
        s1 = sum4(s1);
        const float mean = s1 * (1.f / 64.f);
        float s2 = 0.f;
#pragma unroll
        for (int e = 0; e < 16; ++e) { const float d = y[e] - mean; s2 += d * d; }
        s2 = sum4(s2);
        const float rstd = rsqrtf(s2 * (1.f / 64.f) + 64e-5f);
        float o[16];
#pragma unroll
        for (int e = 0; e < 16; ++e) o[e] = ((y[e] - mean) * rstd * lw[e] + lb[e] + bon * v[e]) * g[e];
        v4u o0, o1;
        o0.x = pk2(o[0], o[1]); o0.y = pk2(o[2], o[3]); o0.z = pk2(o[4], o[5]); o0.w = pk2(o[6], o[7]);
        o1.x = pk2(o[8], o[9]); o1.y = pk2(o[10], o[11]); o1.z = pk2(o[12], o[13]); o1.w = pk2(o[14], o[15]);
        *(v4u*)(Y + (size_t)m * D + c0) = o0; *(v4u*)(Y + (size_t)m * D + c0 + 8) = o1;
    }
}

__device__ __forceinline__ void phase_ssd_conv(const Ctx& c, KArgs& a, int l) {
    unsigned char* ws = a.ws;
    const bf16* PS = (const bf16*)(ws + WS_OV + OV_PS);
    bf16* XBC = (bf16*)(ws + WS_OV + OV_XBC);
    float* DT = (float*)(ws + WS_OV + OV_DT); float* DA = (float*)(ws + WS_OV + OV_DA);
    const float* cw = a.in[I_CW] + (size_t)l * 4 * 3072; const float* cb = a.in[I_CB] + (size_t)l * 3072;
    const int gw = c.bid * 8 + c.wave, NGW = c.G * 8, lane = c.lane;
    constexpr int RUN = 16, NRUN = MH / RUN;
    for (int it = gw; it < 2 * NRUN; it += NGW) {
        const int cb_ = 4 + (it & 1), run = it >> 1, ch0 = cb_ * 512 + lane * 8, m0 = run * RUN;
        float w[4][8], bias[8];
#pragma unroll
        for (int j = 0; j < 4; ++j)
#pragma unroll
            for (int e = 0; e < 8; ++e) w[j][e] = cw[j * 3072 + ch0 + e];
#pragma unroll
        for (int e = 0; e < 8; ++e) bias[e] = cb[ch0 + e];
        float x0[8], x1[8], x2[8], x3[8];
        const bf16* base = PS + (size_t)m0 * N2P + 2048 + ch0;
        const int t0 = m0 & (T - 1);
        if (t0 >= 3) { unpack8(*(const v4u*)(base - 3 * N2P), x0); unpack8(*(const v4u*)(base - 2 * N2P), x1); unpack8(*(const v4u*)(base - N2P), x2); }
        else {
#pragma unroll
            for (int e = 0; e < 8; ++e) { x0[e] = 0.f; x1[e] = 0.f; x2[e] = 0.f; }
        }
        v4u nx = *(const v4u*)base;
#pragma unroll 4
        for (int i = 0; i < RUN; ++i) {
            unpack8(nx, x3);
            if (i + 1 < RUN) nx = *(const v4u*)(base + (size_t)(i + 1) * N2P);
            float o[8];
#pragma unroll
            for (int e = 0; e < 8; ++e) { const float y = bias[e] + x0[e] * w[0][e] + x1[e] * w[1][e] + x2[e] * w[2][e] + x3[e] * w[3][e]; o[e] = siluf_(y); x0[e] = x1[e]; x1[e] = x2[e]; x2[e] = x3[e]; }
            *(v4u*)(XBC + (size_t)(m0 + i) * 3072 + ch0) = pack8(o);
        }
    }
}

__device__ __forceinline__ void tr_bm2(unsigned a, bf16x8& f0, bf16x8& f1) {
    s16x4 l0, h0, l1, h1;
    asm volatile("ds_read_b64_tr_b16 %0, %4\n\tds_read_b64_tr_b16 %1, %4 offset:1088\n\tds_read_b64_tr_b16 %2, %4 offset:8704\n\tds_read_b64_tr_b16 %3, %4 offset:9792\n\ts_waitcnt lgkmcnt(0)"
                 : "=&v"(l0), "=&v"(h0), "=&v"(l1), "=&v"(h1) : "v"(a) : "memory");
    f0 = __builtin_shufflevector(l0, h0, 0, 1, 2, 3, 4, 5, 6, 7); f1 = __builtin_shufflevector(l1, h1, 0, 1, 2, 3, 4, 5, 6, 7);
}
__device__ __forceinline__ void tr_x2(unsigned a, bf16x8& f0, bf16x8& f1) {
    s16x4 l0, h0, l1, h1;
    asm volatile("ds_read_b64_tr_b16 %0, %4\n\tds_read_b64_tr_b16 %1, %4 offset:320\n\tds_read_b64_tr_b16 %2, %4 offset:2560\n\tds_read_b64_tr_b16 %3, %4 offset:2880\n\ts_waitcnt lgkmcnt(0)"
                 : "=&v"(l0), "=&v"(h0), "=&v"(l1), "=&v"(h1) : "v"(a) : "memory");
    f0 = __builtin_shufflevector(l0, h0, 0, 1, 2, 3, 4, 5, 6, 7); f1 = __builtin_shufflevector(l1, h1, 0, 1, 2, 3, 4, 5, 6, 7);
}
__device__ __forceinline__ void tr_x4(unsigned a, bf16x8& f00, bf16x8& f01, bf16x8& f10, bf16x8& f11) {
    s16x4 l0, h0, l1, h1, l2, h2, l3, h3;
    asm volatile("ds_read_b64_tr_b16 %0, %8\n\tds_read_b64_tr_b16 %1, %8 offset:320\n\tds_read_b64_tr_b16 %2, %8 offset:2560\n\tds_read_b64_tr_b16 %3, %8 offset:2880\n\t"
                 "ds_read_b64_tr_b16 %4, %8 offset:32\n\tds_read_b64_tr_b16 %5, %8 offset:352\n\tds_read_b64_tr_b16 %6, %8 offset:2592\n\tds_read_b64_tr_b16 %7, %8 offset:2912\n\ts_waitcnt lgkmcnt(0)"
                 : "=&v"(l0), "=&v"(h0), "=&v"(l1), "=&v"(h1), "=&v"(l2), "=&v"(h2), "=&v"(l3), "=&v"(h3) : "v"(a) : "memory");
    f00 = __builtin_shufflevector(l0, h0, 0, 1, 2, 3, 4, 5, 6, 7); f01 = __builtin_shufflevector(l1, h1, 0, 1, 2, 3, 4, 5, 6, 7);
    f10 = __builtin_shufflevector(l2, h2, 0, 1, 2, 3, 4, 5, 6, 7); f11 = __builtin_shufflevector(l3, h3, 0, 1, 2, 3, 4, 5, 6, 7);
}
__device__ __forceinline__ void phase_ssd_scan(const Ctx& c, KArgs& a, int l) {
    unsigned char* ws = a.ws;
    const bf16* PS = (const bf16*)(ws + WS_OV + OV_PS);
    bf16* XBC = (bf16*)(ws + WS_OV + OV_XBC);
    const float* cw = a.in[I_CW] + (size_t)l * 4 * 3072; const float* cb = a.in[I_CB] + (size_t)l * 3072;
    const float* DT = (const float*)(ws + WS_OV + OV_DT); const float* ACS = (const float*)(ws + WS_OV + OV_DA);
    constexpr int SC = 136, SM = 72, SX = 40;
    LAS bf16* Cm = (LAS bf16*)c.lds;
    LAS bf16* Bm = Cm + 64 * SC;
    LAS bf16* Xd = Bm + 64 * SC;
    LAS bf16* Xs = Xd + 64 * SX;
    LAS bf16* Xr = Xs + 64 * SX;
    LAS bf16* MtT = Xr + 64 * SX;
    LAS bf16* SL = MtT + 64 * SM;
    LAS float* acsL = (LAS float*)(SL + 32 * SC);
    const unsigned BmB = (unsigned)(size_t)Bm, XdB = (unsigned)(size_t)Xd, XsB = (unsigned)(size_t)Xs;
    const int tid = c.tid, lane = c.lane, w = c.wave, r = lane & 15, q = lane >> 4;
    const int sj = tid >> 3, sn = (tid & 7) * 16, sp = (tid & 7) * 4;
    const int trq = ((lane & 15) >> 2), trp = lane & 3;
    const unsigned troffB = (unsigned)(((8 * q + trq) * SC + 4 * trp) * 2), troffX = (unsigned)(((8 * q + trq) * SX + 4 * trp) * 2);
    for (int unit = c.bid; unit < 256; unit += c.G) {
        const int b = unit >> 6, h = (unit >> 1) & 31, ph = unit & 1, g = h >> 3;
        const size_t m0 = (size_t)b * T;
        f32x4 st[2] = {(f32x4){0.f, 0.f, 0.f, 0.f}, (f32x4){0.f, 0.f, 0.f, 0.f}};
        for (int e = tid; e < 32 * SC / 2; e += 512) ((LAS unsigned*)SL)[e] = 0u;
        v4u gB0, gB1, gC0, gC1; v2u gX0, gX1, gX2, gX3; float gacs, gacsE, gdt;
        const int chx = h * 64 + ph * 32 + sp; const float Dh = a.in[I_SD][l * 32 + h];
        float cwt[4][4], cbs[4];
#pragma unroll
        for (int e2 = 0; e2 < 4; ++e2) { cbs[e2] = cb[chx + e2];
#pragma unroll
            for (int j = 0; j < 4; ++j) cwt[j][e2] = cw[j * 3072 + chx + e2]; }
#define SS_LOAD(chunk) do { const size_t row = m0 + (size_t)(chunk) * 64 + sj; const bf16* xr = XBC + row * 3072; \
            gB0 = *(const v4u*)(xr + 2048 + g * 128 + sn); gB1 = *(const v4u*)(xr + 2048 + g * 128 + sn + 8); \
            gC0 = *(const v4u*)(xr + 2560 + g * 128 + sn); gC1 = *(const v4u*)(xr + 2560 + g * 128 + sn + 8); \
            { const int t_ = (chunk) * 64 + sj; const bf16* pr_ = PS + row * N2P + 2048 + chx; const v2u z2 = (v2u){0u, 0u}; \
              gX3 = *(const v2u*)pr_; gX2 = t_ >= 1 ? *(const v2u*)(pr_ - N2P) : z2; gX1 = t_ >= 2 ? *(const v2u*)(pr_ - 2 * N2P) : z2; gX0 = t_ >= 3 ? *(const v2u*)(pr_ - 3 * N2P) : z2; } \
            gacs = ACS[row * 32 + h]; gacsE = ACS[(m0 + (size_t)(chunk) * 64 + 63) * 32 + h]; gdt = DT[row * 32 + h]; } while (0)
#define SS_STAGE() do { \
            *(LAS v4u*)(Bm + sj * SC + sn) = gB0; *(LAS v4u*)(Bm + sj * SC + sn + 8) = gB1; *(LAS v4u*)(Cm + sj * SC + sn) = gC0; *(LAS v4u*)(Cm + sj * SC + sn + 8) = gC1; \
            const float sc_ = gdt * __expf(gacsE - gacs); \
            const float r0_[4] = {bflo(gX0.x), bfhi(gX0.x), bflo(gX0.y), bfhi(gX0.y)}, r1_[4] = {bflo(gX1.x), bfhi(gX1.x), bflo(gX1.y), bfhi(gX1.y)}; \
            const float r2_[4] = {bflo(gX2.x), bfhi(gX2.x), bflo(gX2.y), bfhi(gX2.y)}, r3_[4] = {bflo(gX3.x), bfhi(gX3.x), bflo(gX3.y), bfhi(gX3.y)}; \
            float xa_[4]; _Pragma("unroll") for (int e2 = 0; e2 < 4; ++e2) xa_[e2] = siluf_(cbs[e2] + r0_[e2] * cwt[0][e2] + r1_[e2] * cwt[1][e2] + r2_[e2] * cwt[2][e2] + r3_[e2] * cwt[3][e2]); \
            const float x0_ = xa_[0], x1_ = xa_[1], x2_ = xa_[2], x3_ = xa_[3]; \
            v2u o1_, o2_; o1_.x = pk2(x0_ * gdt, x1_ * gdt); o1_.y = pk2(x2_ * gdt, x3_ * gdt); o2_.x = pk2(x0_ * sc_, x1_ * sc_); o2_.y = pk2(x2_ * sc_, x3_ * sc_); \
            *(LAS v2u*)(Xd + sj * SX + sp) = o1_; *(LAS v2u*)(Xs + sj * SX + sp) = o2_; { v2u o3_; o3_.x = pk2(x0_, x1_); o3_.y = pk2(x2_, x3_); *(LAS v2u*)(Xr + sj * SX + sp) = o3_; } \
            if ((tid & 7) == 0) acsL[sj] = gacs; } while (0)
        SS_LOAD(0);
        SS_STAGE();
        __syncthreads();
        for (int ch = 0; ch < T / 64; ++ch) {
            if (ch + 1 < T / 64) SS_LOAD(ch + 1);
            {
                const int jt = w >> 1, it0 = 2 * (w & 1);
                f32x4 acc0 = (f32x4){0.f, 0.f, 0.f, 0.f}, acc1 = acc0;
                if (it0 + 1 >= jt) {
#pragma unroll
                    for (int ks = 0; ks < 4; ++ks) {
                        const bf16x8 af = *(const LAS bf16x8*)(Bm + (16 * jt + r) * SC + 32 * ks + 8 * q);
                        const bf16x8 b0 = *(const LAS bf16x8*)(Cm + (16 * it0 + r) * SC + 32 * ks + 8 * q);
                        const bf16x8 b1 = *(const LAS bf16x8*)(Cm + (16 * (it0 + 1) + r) * SC + 32 * ks + 8 * q);
                        acc0 = __builtin_amdgcn_mfma_f32_16x16x32_bf16(af, b0, acc0, 0, 0, 0);
                        acc1 = __builtin_amdgcn_mfma_f32_16x16x32_bf16(af, b1, acc1, 0, 0, 0);
                    }
                }
                const int i0 = 16 * it0 + r, i1 = i0 + 16;
                const float ai0 = acsL[i0], ai1 = acsL[i1];
                float m0v[4], m1v[4];
#pragma unroll
                for (int e = 0; e < 4; ++e) { const int j = 16 * jt + 4 * q + e; const float aj = acsL[j];
                    m0v[e] = (j <= i0) ? acc0[e] * __expf(ai0 - aj) : 0.f; m1v[e] = (j <= i1) ? acc1[e] * __expf(ai1 - aj) : 0.f; }
                { v2u o0, o1; o0.x = pk2(m0v[0], m0v[1]); o0.y = pk2(m0v[2], m0v[3]); o1.x = pk2(m1v[0], m1v[1]); o1.y = pk2(m1v[2], m1v[3]);
                  *(LAS v2u*)(MtT + i0 * SM + 16 * jt + 4 * q) = o0; *(LAS v2u*)(MtT + i1 * SM + 16 * jt + 4 * q) = o1; }
            }
            lds_barrier();
            {
                const int it = w >> 1, pt = w & 1;
                f32x4 accD = (f32x4){0.f, 0.f, 0.f, 0.f}, accO = accD;
                {
                    bf16x8 xb0, xb1; tr_x2(XdB + troffX + 32u * pt, xb0, xb1);
                    const bf16x8 af0 = *(const LAS bf16x8*)(MtT + (16 * it + r) * SM + 8 * q);
                    accD = __builtin_amdgcn_mfma_f32_16x16x32_bf16(af0, xb0, accD, 0, 0, 0);
                    if (it >= 2) {
                        const bf16x8 af1 = *(const LAS bf16x8*)(MtT + (16 * it + r) * SM + 32 + 8 * q);
                        accD = __builtin_amdgcn_mfma_f32_16x16x32_bf16(af1, xb1, accD, 0, 0, 0);
                    }
                }
#pragma unroll
                for (int ks = 0; ks < 4; ++ks) {
                    const bf16x8 af = *(const LAS bf16x8*)(Cm + (16 * it + r) * SC + 32 * ks + 8 * q);
                    const bf16x8 bf_ = *(const LAS bf16x8*)(SL + (16 * pt + r) * SC + 32 * ks + 8 * q);
                    accO = __builtin_amdgcn_mfma_f32_16x16x32_bf16(af, bf_, accO, 0, 0, 0);
                }
                const int p = 16 * pt + r;
#pragma unroll
                for (int e = 0; e < 4; ++e) { const int i = 16 * it + 4 * q + e; const float y = accD[e] + __expf(acsL[i]) * accO[e] + Dh * bf1(Xr[i * SX + p]);
                    XBC[(m0 + (size_t)ch * 64 + i) * 3072 + h * 64 + ph * 32 + p] = (bf16)f2bf(y); }
            }
            {
                const float dec = __expf(acsL[63]);
                bf16x8 a0, a1, bx[2][2];
                tr_bm2(BmB + troffB + 32u * w, a0, a1);
                tr_x4(XsB + troffX, bx[0][0], bx[0][1], bx[1][0], bx[1][1]);
#pragma unroll
                for (int pt = 0; pt < 2; ++pt) {
                    f32x4 s = st[pt] * dec;
                    s = __builtin_amdgcn_mfma_f32_16x16x32_bf16(a0, bx[pt][0], s, 0, 0, 0);
                    s = __builtin_amdgcn_mfma_f32_16x16x32_bf16(a1, bx[pt][1], s, 0, 0, 0);
                    st[pt] = s;
                }
            }
            lds_barrier();
#pragma unroll
            for (int pt = 0; pt < 2; ++pt) { v2u o; o.x = pk2c(st[pt][0], st[pt][1]); o.y = pk2c(st[pt][2], st[pt][3]);
                *(LAS v2u*)(SL + (16 * pt + r) * SC + 16 * w + 4 * q) = o; }
            if (ch + 1 < T / 64) SS_STAGE();
            lds_barrier();
        }
#undef SS_LOAD
#undef SS_STAGE
    }
}

__device__ __forceinline__ void phase_ssd_post(const Ctx& c, KArgs& a, int l) {
    unsigned char* ws = a.ws;
    bf16* PS = (bf16*)(ws + WS_OV + OV_PS);
    const bf16* XBC = (const bf16*)(ws + WS_OV + OV_XBC);
    const int lane = c.lane, c0 = 32 * lane;
    const float* ng = a.in[I_SNG] + (size_t)l * 2048 + c0;
    const int gw = c.bid * 8 + c.wave, NGW = c.G * 8;
    v4u nyy[4], nzz[4];
#define SP_LOAD(mm) do { _Pragma("unroll") for (int q = 0; q < 4; ++q) { nyy[q] = *(const v4u*)(XBC + (size_t)(mm) * 3072 + c0 + 8 * q); nzz[q] = *(const v4u*)(PS + (size_t)(mm) * N2P + c0 + 8 * q); } } while (0)
    if (gw < MH) SP_LOAD(gw);
    for (int m = gw; m < MH; m += NGW) {
        float y[32]; float ss = 0.f;
        v4u cyy[4], czz[4];
#pragma unroll
        for (int q = 0; q < 4; ++q) { cyy[q] = nyy[q]; czz[q] = nzz[q]; }
        if (m + NGW < MH) SP_LOAD(m + NGW);
#pragma unroll
        for (int q = 0; q < 4; ++q) {
            float yy[8], zz[8];
            unpack8(cyy[q], yy); unpack8(czz[q], zz);
#pragma unroll
            for (int e = 0; e < 8; ++e) { const float v = yy[e] * siluf_(zz[e]); y[8 * q + e] = v; ss += v * v; }
        }
        ss = sum16(ss);
        const float r = rsqrtf(ss * (1.f / 512.f) + 1e-6f);
#pragma unroll
        for (int q = 0; q < 4; ++q) {
            float o[8];
#pragma unroll
            for (int e = 0; e < 8; ++e) o[e] = y[8 * q + e] * r * ng[8 * q + e];
            *(v4u*)(PS + (size_t)m * N2P + 2048 + c0 + 8 * q) = pack8(o);
        }
    }
}

__device__ __forceinline__ void phase_peer_convert(const Ctx& c, KArgs& a, int l) {
    unsigned char* ws = a.ws;
    const int gw = c.bid * 8 + c.wave, NGW = c.G * 8, lane = c.lane;
    f32x4 n0, n1, n2, n3;
#define PC_LOAD(itt) do { const int tb_ = (itt) >= NEXP, e_ = (itt) - tb_ * NEXP; const float* s_ = (tb_ ? a.in[I_PU] : a.in[I_PD]) + ((size_t)l * NEXP + e_) * D + 16 * lane; \
        n0 = *(const f32x4*)s_; n1 = *(const f32x4*)(s_ + 4); n2 = *(const f32x4*)(s_ + 8); n3 = *(const f32x4*)(s_ + 12); } while (0)
    if (gw < 2 * NEXP) PC_LOAD(gw);
    for (int it = gw; it < 2 * NEXP; it += NGW) {
        const int tb = it >= NEXP, e = it - tb * NEXP;
        const f32x4 x0 = n0, x1 = n1, x2 = n2, x3 = n3;
        if (it + NGW < 2 * NEXP) PC_LOAD(it + NGW);
        float am = fmaxf(fmaxf(fmaxf(fabsf(x0.x), fabsf(x0.y)), fmaxf(fabsf(x0.z), fabsf(x0.w))), fmaxf(fmaxf(fabsf(x1.x), fabsf(x1.y)), fmaxf(fabsf(x1.z), fabsf(x1.w))));
        am = fmaxf(am, fmaxf(fmaxf(fmaxf(fabsf(x2.x), fabsf(x2.y)), fmaxf(fabsf(x2.z), fabsf(x2.w))), fmaxf(fmaxf(fabsf(x3.x), fabsf(x3.y)), fmaxf(fabsf(x3.z), fabsf(x3.w)))));
#pragma unroll
        for (int o = 1; o < 64; o <<= 1) am = fmaxf(am, __shfl_xor(am, o));
        am = fmaxf(am, 1e-30f);
        const float s = 384.f / am;
        v4u q;
        int w;
        w = __builtin_amdgcn_cvt_pk_fp8_f32(x0.x * s, x0.y * s, 0, false); w = __builtin_amdgcn_cvt_pk_fp8_f32(x0.z * s, x0.w * s, w, true); q.x = (unsigned)w;
        w = __builtin_amdgcn_cvt_pk_fp8_f32(x1.x * s, x1.y * s, 0, false); w = __builtin_amdgcn_cvt_pk_fp8_f32(x1.z * s, x1.w * s, w, true); q.y = (unsigned)w;
        w = __builtin_amdgcn_cvt_pk_fp8_f32(x2.x * s, x2.y * s, 0, false); w = __builtin_amdgcn_cvt_pk_fp8_f32(x2.z * s, x2.w * s, w, true); q.z = (unsigned)w;
        w = __builtin_amdgcn_cvt_pk_fp8_f32(x3.x * s, x3.y * s, 0, false); w = __builtin_amdgcn_cvt_pk_fp8_f32(x3.z * s, x3.w * s, w, true); q.w = (unsigned)w;
        *(v4u*)(ws + WS_OV + (tb ? OV_UP : OV_DOWN) + (size_t)e * D + 16 * lane) = q;
        if (lane == 0) ((float*)(ws + WS_OV + OV_PSCALE))[it] = am * (1.f / 384.f);
    }
}

template <class TT> __device__ __forceinline__ void ce_desc(TT& a, TT& b) { const TT hi = a > b ? a : b, lo = a > b ? b : a; a = hi; b = lo; }
__device__ __forceinline__ void cef(float& a, float& b) { const float hi = fmaxf(a, b), lo = fminf(a, b); a = hi; b = lo; }
__device__ __forceinline__ void ced(double& a, double& b) { const double hi = fmax(a, b), lo = fmin(a, b); a = hi; b = lo; }
template <class TT, class CE> __device__ __forceinline__ void bitonic_sort16_desc(TT (&v)[16], CE ce) {
#pragma unroll
    for (int k = 2; k <= 16; k <<= 1)
#pragma unroll
        for (int j = k >> 1; j > 0; j >>= 1)
#pragma unroll
            for (int i = 0; i < 16; ++i) { const int p = i ^ j; if (p > i) { if ((i & k) == 0) ce(v[i], v[p]); else ce(v[p], v[i]); } }
}
template <class TT, class CE> __device__ __forceinline__ void bitonic_merge16_desc(TT (&v)[16], CE ce) {
#pragma unroll
    for (int j = 8; j > 0; j >>= 1)
#pragma unroll
        for (int i = 0; i < 16; ++i) { const int p = i ^ j; if (p > i) ce(v[i], v[p]); }
}
struct CEF { __device__ __forceinline__ void operator()(float& a, float& b) const { cef(a, b); } };
struct CED { __device__ __forceinline__ void operator()(double& a, double& b) const { ced(a, b); } };

__device__ __forceinline__ void top16_of_128(const bf16* p, float (&top)[16]) {
#pragma unroll
    for (int grp = 0; grp < 8; ++grp) {
        float cur[16];
        const v4u q0 = *(const v4u*)(p + grp * 16), q1 = *(const v4u*)(p + grp * 16 + 8);
        const unsigned w[8] = {q0.x, q0.y, q0.z, q0.w, q1.x, q1.y, q1.z, q1.w};
#pragma unroll
        for (int e = 0; e < 8; ++e) {
            const unsigned lo = w[e] << 16, hi = w[e] & 0xffff0000u;
            const unsigned i0 = grp * 16 + 2 * e, i1 = i0 + 1;
            cur[2 * e] = __builtin_bit_cast(float, lo | ((lo >> 31) ? i0 : (127u - i0)));
            cur[2 * e + 1] = __builtin_bit_cast(float, hi | ((hi >> 31) ? i1 : (127u - i1)));
        }
        bitonic_sort16_desc(cur, CEF());
        if (grp == 0) {
#pragma unroll
            for (int i = 0; i < 16; ++i) top[i] = cur[i];
        } else {
#pragma unroll
            for (int i = 0; i < 16; ++i) top[i] = fmaxf(top[i], cur[15 - i]);
            bitonic_merge16_desc(top, CEF());
        }
    }
}
__device__ __forceinline__ unsigned key_index(float k) { const unsigned u = __builtin_bit_cast(unsigned, k); const unsigned lo = u & 0x7fu; return (u >> 31) ? lo : 127u - lo; }
__device__ __forceinline__ float key_value(float k) { return __builtin_bit_cast(float, __builtin_bit_cast(unsigned, k) & 0xffff0000u); }

__device__ __forceinline__ void phase_peer_topk(const Ctx& c, KArgs& a) {
    unsigned char* ws = a.ws;
    const bf16* SC = (const bf16*)(ws + WS_OV + OV_SC);
    int* IDX = (int*)(ws + WS_OV + OV_IDX); float* GATE = (float*)(ws + WS_OV + OV_GATE);
    for (int it = c.bid * 512 + c.tid; it < M * 8; it += c.G * 512) {
        const bf16* p = SC + (size_t)it * 256;
        float t0[16], t1[16];
        top16_of_128(p, t0); top16_of_128(p + 128, t1);
        float v0[16], v1[16]; unsigned i0[16], i1[16];
#pragma unroll
        for (int i = 0; i < 16; ++i) { v0[i] = key_value(t0[i]); v1[i] = key_value(t1[i]); i0[i] = key_index(t0[i]); i1[i] = key_index(t1[i]); }
        double top[16];
        const double NEG = -1.0e300;
#pragma unroll
        for (int grp = 0; grp < 4; ++grp) {
            double cur[16];
#pragma unroll
            for (int s = 0; s < 16; ++s) cur[s] = NEG;
            int n = 0;
#pragma unroll
            for (int i = 0; i < 16; ++i)
#pragma unroll
                for (int j = 0; j < 16; ++j) if ((i + 1) * (j + 1) <= 16) {
                    if (n / 16 == grp) {
                        const double d = (double)(v0[i] + v1[j]);
                        const unsigned long long eid = (unsigned long long)(i0[i] * 128u + i1[j]);
                        const unsigned long long bits = __builtin_bit_cast(unsigned long long, d);
                        cur[n % 16] = __builtin_bit_cast(double, bits | ((bits >> 63) ? eid : (16383ull - eid)));
                    }
                    ++n;
                }
            bitonic_sort16_desc(cur, CED());
            if (grp == 0) {
#pragma unroll
                for (int i = 0; i < 16; ++i) top[i] = cur[i];
            } else {
#pragma unroll
                for (int i = 0; i < 16; ++i) top[i] = fmax(top[i], cur[15 - i]);
                bitonic_merge16_desc(top, CED());
            }
        }
        float sv[16]; int id[16];
#pragma unroll
        for (int i = 0; i < 16; ++i) { const unsigned long long bits = __builtin_bit_cast(unsigned long long, top[i]); const unsigned lo = (unsigned)(bits & 0x3fffull);
            id[i] = (int)((bits >> 63) ? lo : 16383u - lo); sv[i] = (float)top[i]; }
        float den = 0.f, ex[16];
#pragma unroll
        for (int i = 0; i < 16; ++i) { ex[i] = __expf(sv[i] - sv[0]); den += ex[i]; }
        const float inv = 1.f / den;
        unsigned cw[4] = {0u, 0u, 0u, 0u};
#pragma unroll
        for (int i = 0; i < 16; ++i) { const unsigned s = (unsigned)id[i] >> PEER_SLICE_SHIFT, inc = 1u << (8 * (s & 3)), ws_ = s >> 2;
            cw[0] += ws_ == 0 ? inc : 0u; cw[1] += ws_ == 1 ? inc : 0u; cw[2] += ws_ == 2 ? inc : 0u; cw[3] += ws_ == 3 ? inc : 0u; }
        unsigned lp[4], tot[4], st[4];
        const int l8 = c.lane & 7;
#pragma unroll
        for (int k = 0; k < 4; ++k) { unsigned v = cw[k];
#pragma unroll
            for (int o = 1; o < 8; o <<= 1) { const unsigned y = __shfl_up(v, o, 8); v += (l8 >= o) ? y : 0u; }
            tot[k] = __shfl(v, 7, 8); lp[k] = v - cw[k]; }
        {   unsigned carry = 0u;
#pragma unroll
            for (int k = 0; k < 4; ++k) { st[k] = tot[k] * 0x01010100u + carry * 0x01010101u; carry += (tot[k] * 0x01010101u) >> 24; } }
        unsigned run[4] = {st[0] + lp[0], st[1] + lp[1], st[2] + lp[2], st[3] + lp[3]};
        const size_t tok = (size_t)(it >> 3);
#pragma unroll
        for (int i = 0; i < 16; ++i) { const unsigned s = (unsigned)id[i] >> PEER_SLICE_SHIFT, sh = 8 * (s & 3), ws_ = s >> 2, inc = 1u << sh;
            const unsigned wsel = ws_ == 0 ? run[0] : (ws_ == 1 ? run[1] : (ws_ == 2 ? run[2] : run[3]));
            const unsigned pos = (wsel >> sh) & 0xffu;
            run[0] += ws_ == 0 ? inc : 0u; run[1] += ws_ == 1 ? inc : 0u; run[2] += ws_ == 2 ? inc : 0u; run[3] += ws_ == 3 ? inc : 0u;
            IDX[tok * 128 + pos] = id[i]; GATE[tok * 128 + pos] = ex[i] * inv; }
        if (l8 == 0) ((v4u*)(ws + WS_OV + OV_POFF))[tok] = (v4u){st[0], st[1], st[2], st[3]};
    }
}

__device__ __forceinline__ float gelu_tanh(float x) { const float u = 0.7978845608f * (x + 0.044715f * x * x * x); const float t = 1.f - 2.f / (1.f + __expf(2.f * u)); return 0.5f * x * (1.f + t); }
__device__ __forceinline__ void unpack16_fp8(const v4u& q, float (&o)[16]) {
    const unsigned w[4] = {q.x, q.y, q.z, q.w};
#pragma unroll
    for (int i = 0; i < 4; ++i) { const f32x2 lo = __builtin_amdgcn_cvt_pk_f32_fp8((int)w[i], false), hi = __builtin_amdgcn_cvt_pk_f32_fp8((int)w[i], true);
        o[4 * i] = lo.x; o[4 * i + 1] = lo.y; o[4 * i + 2] = hi.x; o[4 * i + 3] = hi.y; }
}
__device__ __forceinline__ int slice_start(unsigned o0, unsigned o1, unsigned o2, unsigned o3, int s) {
    const unsigned wsel = s < 4 ? o0 : (s < 8 ? o1 : (s < 12 ? o2 : o3));
    return s >= PEER_NSLICE ? 128 : (int)((wsel >> (8 * (s & 3))) & 0xffu);
}
template <int MODE> __device__ __forceinline__ void phase_peer_down(const Ctx& c, KArgs& a, int l, int qset) {
    unsigned char* ws = a.ws;
    const unsigned char* U8 = ws + WS_OV + OV_U8; const float* XS = (const float*)(ws + WS_OV + OV_XS);
    const unsigned char* DN = ws + WS_OV + OV_DOWN;
    const int* IDX = (const int*)(ws + WS_OV + OV_IDX);
    const v4u* POFF = (const v4u*)(ws + WS_OV + OV_POFF);
    float* ACT = (float*)(ws + WS_OV + (qset ? 278 * MiB : OV_ACT));
    unsigned* QC = (unsigned*)(ws + WS_CTL) + CW_QUEUE + (qset * 2 + l) * PEER_NSLICE * 64;
    constexpr int RS = 528;
    LAS unsigned char* wb = c.lds + c.wave * (8192 + 16 * RS);
    LAS unsigned* lpk = (LAS unsigned*)wb;
    LAS unsigned char* RB = wb + 8192;
    const int lane = c.lane, r16 = lane & 15, q = lane >> 4, hsel = lane >> 5, l32 = lane & 31;
    constexpr int NBLK = M / 16;
    const int s = c.bid & (PEER_NSLICE - 1);
    const int nrank = ((c.G - s + PEER_NSLICE - 1) >> 3) * 8, rank = (c.bid >> 3) * 8 + c.wave;
    {
#pragma unroll 1
        for (int blk = rank; blk < NBLK; blk += nrank) {
            const size_t mb = (size_t)blk * 16;
            v4u xb[16];
            { const unsigned char* xp = U8 + (mb + r16) * D + 16 * q;
#pragma unroll
              for (int j = 0; j < 16; ++j) xb[j] = *(const v4u*)(xp + 64 * j); }
            const float xs = XS[mb + r16];
            int pav = 0, nv = 0;
            if (lane < 16) { const v4u po = POFF[mb + lane]; pav = slice_start(po.x, po.y, po.z, po.w, s); nv = slice_start(po.x, po.y, po.z, po.w, s + 1) - pav; }
            int incl = nv;
#pragma unroll
            for (int o = 1; o < 16; o <<= 1) { const int y = __shfl_up(incl, o, 16); incl += (r16 >= o) ? y : 0; }
            const int offv = incl - nv;
            const int P = __builtin_amdgcn_readlane(incl, 15);
            {
                int idr[16];
#pragma unroll
                for (int ti = 0; ti < 16; ++ti) { const int pa = __builtin_amdgcn_readlane(pav, ti); const int e = pa + lane; idr[ti] = IDX[(mb + ti) * 128 + (e < 127 ? e : 127)]; }
#pragma unroll
                for (int ti = 0; ti < 16; ++ti) { const int pa = __builtin_amdgcn_readlane(pav, ti), n = __builtin_amdgcn_readlane(nv, ti), off = __builtin_amdgcn_readlane(offv, ti);
                    if (lane < n) lpk[off + lane] = (unsigned)idr[ti] | ((unsigned)ti << 14) | ((unsigned)(pa + lane) << 18); }
                if (__builtin_amdgcn_ballot_w64(nv > 64) != 0ull) {
#pragma unroll 1
                    for (int ti = 0; ti < 16; ++ti) { const int pa = __builtin_amdgcn_readlane(pav, ti), n = __builtin_amdgcn_readlane(nv, ti), off = __builtin_amdgcn_readlane(offv, ti);
                        if (lane + 64 < n) lpk[off + 64 + lane] = (unsigned)IDX[(mb + ti) * 128 + pa + 64 + lane] | ((unsigned)ti << 14) | ((unsigned)(pa + 64 + lane) << 18); }
                }
            }
            asm volatile("s_waitcnt vmcnt(0) lgkmcnt(0)" ::: "memory");
            const int nb = (P + 15) >> 4;
#define PD_IDS(PW, B) { const v4u ia = *(const LAS v4u*)(lpk + (B) * 16 + 8 * hsel), ib = *(const LAS v4u*)(lpk + (B) * 16 + 8 * hsel + 4); \
                PW[0] = ia.x; PW[1] = ia.y; PW[2] = ia.z; PW[3] = ia.w; PW[4] = ib.x; PW[5] = ib.y; PW[6] = ib.z; PW[7] = ib.w; }
#define PD_LOADH(PW, H) { _Pragma("unroll") for (int i = 0; i < 8; ++i) { const unsigned id = MODE == 1 ? (PW[i] & 63u) : (PW[i] & 16383u); \
                    rr[8 * (H) + i] = *(const v4u*)(DN + (size_t)(id * 1024u + 512u * (H) + 16u * l32)); } }
            if (nb > 0) {
                v4u rr[16];
                { unsigned pw[8]; PD_IDS(pw, 0) PD_LOADH(pw, 0) PD_LOADH(pw, 1) }
#pragma unroll 1
                for (int b = 0; b < nb; ++b) {
                    const int bn = b + 1 < nb ? b + 1 : b;
                    unsigned pwn[8]; PD_IDS(pwn, bn)
                    const v4u mt = *(const LAS v4u*)(lpk + b * 16 + 4 * q);
                    f32x4 acc0 = {0.f, 0.f, 0.f, 0.f}, acc1 = {0.f, 0.f, 0.f, 0.f};
#pragma unroll
                    for (int h = 0; h < 2; ++h) {
#pragma unroll
                        for (int i = 0; i < 8; ++i) *(LAS v4u*)(RB + (8 * hsel + i) * RS + 16 * l32) = rr[8 * h + i];
                        PD_LOADH(pwn, h)
#pragma unroll
                        for (int jj = 0; jj < 8; ++jj) {
                            const v4u av = *(const LAS v4u*)(RB + r16 * RS + 64 * jj + 16 * q);
                            const v4u bv = xb[8 * h + jj];
                            const long a0 = (long)(((unsigned long long)av.y << 32) | av.x), a1 = (long)(((unsigned long long)av.w << 32) | av.z);
                            const long b0 = (long)(((unsigned long long)bv.y << 32) | bv.x), b1 = (long)(((unsigned long long)bv.w << 32) | bv.z);
                            acc0 = __builtin_amdgcn_mfma_f32_16x16x32_fp8_fp8(a0, b0, acc0, 0, 0, 0);
                            acc1 = __builtin_amdgcn_mfma_f32_16x16x32_fp8_fp8(a1, b1, acc1, 0, 0, 0);
                        }
                    }
                    const f32x4 dv = (acc0 + acc1) * xs;
                    const unsigned me[4] = {mt.x, mt.y, mt.z, mt.w};
                    const float dd[4] = {dv.x, dv.y, dv.z, dv.w};
#pragma unroll
                    for (int i = 0; i < 4; ++i) if (b * 16 + 4 * q + i < P && (int)((me[i] >> 14) & 15u) == r16) lpk[b * 16 + 4 * q + i] = __builtin_bit_cast(unsigned, dd[i]);
                }
            }
#pragma unroll
            for (int ti = 0; ti < 16; ++ti) { const int pa = __builtin_amdgcn_readlane(pav, ti), n = __builtin_amdgcn_readlane(nv, ti), off = __builtin_amdgcn_readlane(offv, ti);
                if (lane < n) ACT[(mb + ti) * 128 + pa + lane] = __builtin_bit_cast(float, lpk[off + lane]); }
            if (__builtin_amdgcn_ballot_w64(nv > 64) != 0ull) {
#pragma unroll 1
                for (int ti = 0; ti < 16; ++ti) { const int pa = __builtin_amdgcn_readlane(pav, ti), n = __builtin_amdgcn_readlane(nv, ti), off = __builtin_amdgcn_readlane(offv, ti);
                    if (lane + 64 < n) ACT[(mb + ti) * 128 + pa + 64 + lane] = __builtin_bit_cast(float, lpk[off + 64 + lane]); }
            }
        }
    }
}

template <int FUSE> __device__ __forceinline__ void phase_peer_experts(const Ctx& c, KArgs& a, const float* gnext, const bool commit = true) {
    unsigned char* ws = a.ws;
    const unsigned char* UP = ws + WS_OV + OV_UP;
    const float* SCD = (const float*)(ws + WS_OV + OV_PSCALE); const float* SCU = SCD + NEXP;
    const int* IDX = (const int*)(ws + WS_OV + OV_IDX); const float* GATE = (const float*)(ws + WS_OV + OV_GATE);
    const float* ACT = (const float*)(ws + WS_OV + OV_ACT);
    float* H = a.out;
    constexpr int TPW = 16;
    LAS float* wlw = (LAS float*)c.lds + c.wave * (2 * TPW * 128);
    LAS int* idw = (LAS int*)(wlw + TPW * 128);
    const int lane = c.lane, g8 = lane >> 3, c8 = lane & 7;
    const int gw = c.bid * 8 + c.wave, NGW = c.G * 8;
    const f32x4 gn0 = *(const f32x4*)(gnext + lane * 16), gn1 = *(const f32x4*)(gnext + lane * 16 + 4), gn2 = *(const f32x4*)(gnext + lane * 16 + 8), gn3 = *(const f32x4*)(gnext + lane * 16 + 12);
    for (int m0 = gw; m0 < M; m0 += NGW * TPW) {
#pragma unroll 1
        for (int ti = 0; ti < TPW; ++ti) {
            const int m = m0 + ti * NGW;
            float w0 = 0.f, w1 = 0.f; int id0 = 0, id1 = 0;
            if (m < M) {
                id0 = IDX[(size_t)m * 128 + lane]; id1 = IDX[(size_t)m * 128 + 64 + lane];
                const float g0 = GATE[(size_t)m * 128 + lane], g1 = GATE[(size_t)m * 128 + 64 + lane];
                const float a0 = ACT[(size_t)m * 128 + lane], a1 = ACT[(size_t)m * 128 + 64 + lane];
                w0 = g0 * gelu_tanh(a0 * SCD[id0]) * SCU[id0]; w1 = g1 * gelu_tanh(a1 * SCD[id1]) * SCU[id1];
            }
            wlw[ti * 128 + lane] = w0; wlw[ti * 128 + 64 + lane] = w1; idw[ti * 128 + lane] = id0; idw[ti * 128 + 64 + lane] = id1;
        }
        asm volatile("s_waitcnt lgkmcnt(0)" ::: "memory");
        float ssq[2] = {0.f, 0.f};
#pragma unroll 1
        for (int cq = 0; cq < 8; ++cq) {
            const unsigned char* UPc = UP + 128 * cq;
#pragma unroll
            for (int tg = 0; tg < 2; ++tg) {
                const int ti = tg * 8 + g8, m = m0 + ti * NGW;
                const LAS float* wl = wlw + ti * 128; const LAS int* il = idw + ti * 128;
                float acc[16];
#pragma unroll
                for (int q = 0; q < 16; ++q) acc[q] = 0.f;
#pragma unroll 1
                for (int bt = 0; bt < 8; ++bt) {
                    int idv[16]; float wv[16];
#pragma unroll
                    for (int k4 = 0; k4 < 4; ++k4) { const v4u iv = *(const LAS v4u*)(il + bt * 16 + 4 * k4); const f32x4 wq = *(const LAS f32x4*)(wl + bt * 16 + 4 * k4);
                        idv[4 * k4] = (int)iv.x; idv[4 * k4 + 1] = (int)iv.y; idv[4 * k4 + 2] = (int)iv.z; idv[4 * k4 + 3] = (int)iv.w;
                        wv[4 * k4] = wq.x; wv[4 * k4 + 1] = wq.y; wv[4 * k4 + 2] = wq.z; wv[4 * k4 + 3] = wq.w; }
                    v4u rr[16];
#pragma unroll
                    for (int k = 0; k < 16; ++k) rr[k] = *(const v4u*)(UPc + (size_t)((unsigned)idv[k] * 1024u + 16u * c8));
#pragma unroll
                    for (int k = 0; k < 16; ++k) {
                        float f[16]; unpack16_fp8(rr[k], f);
#pragma unroll
                        for (int q = 0; q < 16; ++q) acc[q] += wv[k] * f[q];
                    }
                }
                if (!commit && acc[0] != 123456.789f) continue;
                if (m < M) {
                    f32x4* hp = (f32x4*)(H + (size_t)m * D + 128 * cq + 16 * c8);
                    f32x4 h0 = hp[0], h1 = hp[1], h2 = hp[2], h3 = hp[3];
                    h0 += (f32x4){acc[0], acc[1], acc[2], acc[3]}; h1 += (f32x4){acc[4], acc[5], acc[6], acc[7]};
                    h2 += (f32x4){acc[8], acc[9], acc[10], acc[11]}; h3 += (f32x4){acc[12], acc[13], acc[14], acc[15]};
                    hp[0] = h0; hp[1] = h1; hp[2] = h2; hp[3] = h3;
                    ssq[tg] += (h0.x * h0.x + h0.y * h0.y) + (h0.z * h0.z + h0.w * h0.w) + (h1.x * h1.x + h1.y * h1.y) + (h1.z * h1.z + h1.w * h1.w)
                             + (h2.x * h2.x + h2.y * h2.y) + (h2.z * h2.z + h2.w * h2.w) + (h3.x * h3.x + h3.y * h3.y) + (h3.z * h3.z + h3.w * h3.w);
                }
            }
        }
        if (!commit) continue;
#pragma unroll
        for (int tg = 0; tg < 2; ++tg) { float s = ssq[tg]; s += __shfl_xor(s, 1); s += __shfl_xor(s, 2); s += __shfl_xor(s, 4); ssq[tg] = s; }
        asm volatile("s_waitcnt vmcnt(0)" ::: "memory");
#pragma unroll
        for (int tg = 0; tg < 2; ++tg)
#pragma unroll 1
            for (int g = 0; g < 8; ++g) {
                const int ti = tg * 8 + g, m = m0 + ti * NGW; if (m >= M) continue;
                const float ss = __builtin_bit_cast(float, __builtin_amdgcn_readlane(__builtin_bit_cast(int, ssq[tg]), g * 8));
                const float rn = rsqrtf(ss * (1.f / D) + 1e-6f);
                f32x4* hp = (f32x4*)(H + (size_t)m * D + lane * 16);
                const f32x4 h0 = hp[0], h1 = hp[1], h2 = hp[2], h3 = hp[3];
                const f32x4 n0 = h0 * rn * gn0, n1 = h1 * rn * gn1, n2 = h2 * rn * gn2, n3 = h3 * rn * gn3;
                if (FUSE == 0) {
                    v4u u0, u1; u0.x = pk2(n0.x, n0.y); u0.y = pk2(n0.z, n0.w); u0.z = pk2(n1.x, n1.y); u0.w = pk2(n1.z, n1.w);
                    u1.x = pk2(n2.x, n2.y); u1.y = pk2(n2.z, n2.w); u1.z = pk2(n3.x, n3.y); u1.w = pk2(n3.z, n3.w);
                    bf16* up_ = (bf16*)(ws + WS_U) + (size_t)m * D + lane * 16;
                    *(v4u*)up_ = u0; *(v4u*)(up_ + 8) = u1;
                } else { hp[0] = n0; hp[1] = n1; hp[2] = n2; hp[3] = n3; }
            }
    }
}

constexpr int PH_PER_HALF = 11, PH_PER_LAYER = 1 + 2 * PH_PER_HALF + 5, N_PHASES = 1 + DEPTH * PH_PER_LAYER;
__device__ __forceinline__ Ctx make_ctx() {
    extern __shared__ __attribute__((aligned(16))) unsigned char lds_raw[];
    Ctx c; int t = threadIdx.x; asm volatile("" : "+v"(t)); c.lds = (LAS unsigned char*)lds_raw; c.tid = t; c.lane = t & 63; c.wave = __builtin_amdgcn_readfirstlane(t >> 6); c.G = gridDim.x; c.bid = blockIdx.x; return c; }
__device__ __forceinline__ KArgs* kargs_fresh() { KArgs* p = (KArgs*)__builtin_amdgcn_kernarg_segment_ptr(); asm volatile("" : "+s"(p)); return p; }
#define PH_BEGIN(K) if (lo <= (K) && (K) < hi) { const Ctx c = make_ctx(); KArgs& args = *kargs_fresh(); unsigned char* ws = args.ws; (void)ws;
#define PH_END(K)   if ((K) + 1 < hi) xcd_barrier(bar); }

template <int L, int HB> __device__ __forceinline__ void half_pass(const XcdBarrier& bar, const int lo, const int hi) {
    constexpr int P0 = 1 + L * PH_PER_LAYER + 1 + HB * PH_PER_HALF;
#define WIN ((const bf16*)(ws + WS_WIN + L * WIN_L))
#define Uh ((const bf16*)(ws + WS_U) + (size_t)HB * MH * D)
    PH_BEGIN(P0 + 0) {
        pg8::Gemm g{Uh, WIN, MH, N1P, D, D, 0}; pg8::StaticOrder S; S.init(MH, N1P, c.G, c.bid);
        pg8::EpiRow8<FStoreBf16> E{{(bf16*)(ws + WS_OV + OV_PR), N1P}};
        pg8::gemm_phase(c.lds, g, S, E); if (PROBE_DUP == 5) pg8::gemm_phase(c.lds, g, S, E); } PH_END(P0 + 0)
    PH_BEGIN(P0 + 1) if (PROBE_DUP == 6) phase_rwkv_prep(c, args, L, HB); phase_rwkv_prep(c, args, L, HB); PH_END(P0 + 1)
    PH_BEGIN(P0 + 2) {
        constexpr int NL = L == 0 ? 3072 : 4096;
        pg8::Gemm g{(const bf16*)(ws + WS_OV + OV_AL), (const bf16*)(ws + WS_WLORA + L * WLORA_L), MH, NL, KL, KL, 1}; pg8::StaticOrder S; S.init(MH, NL, c.G, c.bid);
        EpiLora E{(bf16*)(ws + WS_OV + OV_ELOG), (bf16*)(ws + WS_OV + OV_ASIG), (bf16*)(ws + WS_OV + OV_GG), (bf16*)(ws + WS_OV + OV_VMIX),
                               (const bf16*)(ws + WS_VF) + (size_t)HB * MH * D, args.in[I_W0] + (size_t)L * D, args.in[I_A0] + (size_t)L * D, args.in[I_V0]};
        pg8::gemm_phase(c.lds, g, S, E); } PH_END(P0 + 2)
    PH_BEGIN(P0 + 3) phase_rwkv_chunk_par(c, args, L, HB); PH_END(P0 + 3)
    PH_BEGIN(P0 + 4) if (PROBE_DUP == 8) phase_rwkv_chunk_seq(c, args, false); phase_rwkv_chunk_seq(c, args); PH_END(P0 + 4)
    PH_BEGIN(P0 + 5) {
        phase_rwkv_post(c, args, L, HB); __syncthreads();
        pg8::Gemm g{Uh, WIN + (size_t)N1P * D, MH, N2P, D, D, 0}; pg8::StaticOrder S; S.init(MH, N2P, c.G, c.bid);
        pg8::EpiRow8<FStoreBf16> E{{(bf16*)(ws + WS_OV + OV_PS), N2P}};
        pg8::gemm_phase(c.lds, g, S, E); if (PROBE_DUP == 5) pg8::gemm_phase(c.lds, g, S, E); } PH_END(P0 + 5)
    PH_BEGIN(P0 + 6) if (PROBE_DUP == 6) phase_ssd_conv(c, args, L); phase_ssd_conv(c, args, L); PH_END(P0 + 6)
    PH_BEGIN(P0 + 7) phase_ssd_scan(c, args, L); PH_END(P0 + 7)
    PH_BEGIN(P0 + 8) phase_ssd_post(c, args, L); PH_END(P0 + 8)
    PH_BEGIN(P0 + 9) {
      { pg8::Gemm g{Uh, WIN + (size_t)(N1P + N2P) * D, MH, D, D, D, 0}; pg8::StaticOrder S; S.init(MH, D, c.G, c.bid);
        pg8::EpiRow8<FSigmoidBf16> E{{(bf16*)(ws + WS_OV + OV_GATES), 2048}};
        pg8::gemm_phase(c.lds, g, S, E); }
      { pg8::Gemm g{Uh, WIN + (size_t)(N1P + N2P + D) * D, MH, D, D, D, 0}; pg8::StaticOrder S; S.init(MH, D, c.G, c.bid);
        pg8::EpiRow8<FSigmoidBf16> E{{(bf16*)(ws + WS_OV + OV_GATES) + 1024, 2048}};
        pg8::gemm_phase(c.lds, g, S, E); }
      {
        pg8::Gemm g{(const bf16*)(ws + WS_OV + OV_YA), (const bf16*)(ws + WS_WA) + (size_t)L * D * D, MH, D, D, D, 0}; pg8::StaticOrder S; S.init(MH, D, c.G, c.bid);
        pg8::EpiRow8<FMixA> E{{(const bf16*)(ws + WS_OV + OV_GATES), (bf16*)(ws + WS_OV + OV_MIXED)}};
        pg8::gemm_phase(c.lds, g, S, E); }
      {
        pg8::Gemm g{(const bf16*)(ws + WS_OV + OV_PS) + 2048, (const bf16*)(ws + WS_WB) + (size_t)L * D * 2048, MH, D, 2048, N2P, 0}; pg8::StaticOrder S; S.init(MH, D, c.G, c.bid);
        pg8::EpiRow8<FMixB> E{{(const bf16*)(ws + WS_OV + OV_GATES), (bf16*)(ws + WS_OV + OV_MIXED)}};
        pg8::gemm_phase(c.lds, g, S, E); } } PH_END(P0 + 9)
    PH_BEGIN(P0 + 10) {
        pg8::Gemm g{(const bf16*)(ws + WS_OV + OV_MIXED), (const bf16*)(ws + WS_WO) + (size_t)L * D * D, MH, D, D, D, 0}; pg8::StaticOrder S; S.init(MH, D, c.G, c.bid);
        pg8::EpiRow8<FResid> E{{(L == 0 ? args.in[I_X] : (const float*)args.out) + (size_t)HB * MH * D, args.out + (size_t)HB * MH * D}};
        pg8::gemm_phase(c.lds, g, S, E); } PH_END(P0 + 10)
#undef WIN
#undef Uh
}

template <int L> __device__ __forceinline__ void layer_pass(const XcdBarrier& bar, const int lo, const int hi) {
    constexpr int P0 = 1 + L * PH_PER_LAYER, P1 = P0 + 1 + 2 * PH_PER_HALF;
    PH_BEGIN(P0) if (L == 0) phase_rmsnorm(c, args.in[I_X], args.in[I_NMG], (bf16*)(ws + WS_U), nullptr); PH_END(P0)
    half_pass<L, 0>(bar, lo, hi);
    half_pass<L, 1>(bar, lo, hi);
    PH_BEGIN(P1 + 0) phase_rmsnorm_q8(c, args.out, args.in[I_NFG] + (size_t)L * D, (bf16*)(ws + WS_U), ws + WS_OV + OV_U8, (float*)(ws + WS_OV + OV_XS)); phase_peer_convert(c, args, L); PH_END(P1 + 0)
    PH_BEGIN(P1 + 1) {
        pg8::Gemm g{(const bf16*)(ws + WS_U), (const bf16*)(ws + WS_WQK) + (size_t)L * 2048 * D, M, 2048, D, D, 0}; pg8::StaticOrder S; S.init(M, 2048, c.G, c.bid);
        pg8::EpiRow8<FStoreBf16> E{{(bf16*)(ws + WS_OV + OV_SC), 2048}};
        pg8::gemm_phase(c.lds, g, S, E); } PH_END(P1 + 1)
    PH_BEGIN(P1 + 2) if (PROBE_DUP == 4) phase_peer_topk(c, args); phase_peer_topk(c, args); PH_END(P1 + 2)
    PH_BEGIN(P1 + 3) phase_peer_down<0>(c, args, L, 0); if (PROBE_DOWN >= 0) phase_peer_down<PROBE_DOWN < 0 ? 0 : PROBE_DOWN>(c, args, L, 1); PH_END(P1 + 3)
    PH_BEGIN(P1 + 4) phase_peer_experts<L == DEPTH - 1 ? 1 : 0>(c, args, L == DEPTH - 1 ? args.in[I_NFIN] : args.in[I_NMG] + (size_t)(L + 1) * D); PH_END(P1 + 4)
}

__global__ void __launch_bounds__(512, 2) mk_fwd(Args kargs_) {
    extern __shared__ __attribute__((aligned(16))) unsigned char lds_raw[];
    LAS unsigned char* lds0 = (LAS unsigned char*)lds_raw;
    unsigned char* ws0 = kargs_.ws;
    const int lo = kargs_.lo, hi = kargs_.hi;
    if (threadIdx.x < 4) ((LAS unsigned*)(lds0 + LDS_MISC))[threadIdx.x] = 0u;
    __syncthreads();
    XcdBarrier bar; bar.bar = (unsigned*)(ws0 + WS_CTL) + CW_BAR; bar.x = 0; bar.st = (volatile LAS unsigned*)(lds0 + LDS_MISC);
    if (hi - lo > 1) bar = xcd_barrier_post((unsigned*)(ws0 + WS_CTL) + CW_BAR, (volatile LAS unsigned*)(lds0 + LDS_MISC));
    PH_BEGIN(0) phase_prologue(c, args); PH_END(0)
    layer_pass<0>(bar, lo, hi);
    layer_pass<1>(bar, lo, hi);
}

extern "C" void kernel_launch(void* const* d_in, const int* in_sizes, int n_in, void* d_out, int out_size, void* d_ws, size_t ws_size, hipStream_t stream) {
    static int grid = 0;
    if (grid == 0) {
        if (n_in != 32 || out_size != M * D || ws_size < WS_END) { fprintf(stderr, "kernel_launch: unexpected problem (n_in %d, out %d, ws %zu < %zu)\n", n_in, out_size, ws_size, (size_t)WS_END); grid = -1; return; }
        int dev = 0, cus = 0, per_cu = 0;
        if (hipGetDevice(&dev) != hipSuccess || hipDeviceGetAttribute(&cus, hipDeviceAttributeMultiprocessorCount, dev) != hipSuccess) { grid = -1; return; }
        if (hipFuncSetAttribute((const void*)mk_fwd, hipFuncAttributeMaxDynamicSharedMemorySize, LDS_BYTES) != hipSuccess) { fprintf(stderr, "kernel_launch: hipFuncSetAttribute failed\n"); grid = -1; return; }
        if (hipOccupancyMaxActiveBlocksPerMultiprocessor(&per_cu, (const void*)mk_fwd, 512, LDS_BYTES) != hipSuccess || per_cu < 1) { fprintf(stderr, "kernel_launch: occupancy query says %d\n", per_cu); per_cu = 1; }
        (void)hipGetLastError();
        grid = cus;
    }
    if (grid < 0) return;
    (void)hipMemsetAsync((char*)d_ws + WS_CTL, 0, CTL_BYTES, stream);
    Args a{};
    for (int i = 0; i < 32; ++i) a.in[i] = (const float*)d_in[i];
    a.out = (float*)d_out; a.ws = (unsigned char*)d_ws;
#if MK_MULTI
    for (int p = 0; p < N_PHASES; ++p) { a.lo = p; a.hi = p + 1; hipLaunchKernelGGL(mk_fwd, dim3(grid), dim3(512), LDS_BYTES, stream, a); }
#else
    a.lo = 0; a.hi = N_PHASES;
    hipLaunchKernelGGL(mk_fwd, dim3(grid), dim3(512), LDS_BYTES, stream, a);
#endif
}
```

```cpp
#include <hip/hip_runtime.h>
#include <cstdio>
#include <cstdint>

#ifndef PROBE_DUP
#define PROBE_DUP 0
#endif
#ifndef MK_MULTI
#define MK_MULTI 0
#endif

#define GAS __attribute__((address_space(1)))
#define LAS __attribute__((address_space(3)))
typedef unsigned short bf16;
typedef unsigned v4u __attribute__((ext_vector_type(4)));
typedef unsigned v2u __attribute__((ext_vector_type(2)));
typedef float f32x4 __attribute__((ext_vector_type(4)));
typedef float f32x2 __attribute__((ext_vector_type(2)));
typedef short bf16x8 __attribute__((ext_vector_type(8)));
typedef __bf16 bf2_t __attribute__((ext_vector_type(2)));

constexpr int D = 1024, BATCH = 8, T = 4096, M = BATCH * T, MH = M / 2, DEPTH = 2;
constexpr int RW_PROJ = 3360, SSD_PROJ = 5152, IN_PROJ = 10560;
constexpr int N1P = 3584, N2P = 5120, N3P = 2048, NINP = N1P + N2P + N3P;
constexpr int DT_COL = RW_PROJ;
constexpr int KL = 384;
constexpr int NEXP = 16384;
#ifndef PROBE_DOWN
#define PROBE_DOWN -1
#endif
constexpr int PEER_SLICE_SHIFT = 11, PEER_NSLICE = NEXP >> PEER_SLICE_SHIFT;
constexpr int CW_QUEUE = 8192;

constexpr size_t MiB = 1u << 20;
constexpr size_t WS_CTL = 0, CTL_BYTES = 1 * MiB;
constexpr size_t WS_WIN = 1 * MiB;
constexpr size_t WIN_L = (size_t)NINP * D * 2;
constexpr size_t WS_WA = 44 * MiB;
constexpr size_t WS_WB = 48 * MiB;
constexpr size_t WS_WO = 56 * MiB;
constexpr size_t WS_WQK = 60 * MiB;
constexpr size_t WS_WLORA = 68 * MiB;
constexpr size_t WLORA_L = (size_t)4096 * KL * 2;
constexpr size_t WS_U = 74 * MiB;
constexpr size_t WS_VF = 138 * MiB;
constexpr size_t WS_OV = 202 * MiB;
constexpr size_t OV_PR = 0, OV_ELOG = 112 * MiB, OV_ASIG = 144 * MiB, OV_GG = 176 * MiB, OV_VMIX = 208 * MiB, OV_AL = 240 * MiB, OV_YA = 272 * MiB;
constexpr size_t OV_PS = 0, OV_XBC = 168 * MiB, OV_DT = 305 * MiB, OV_DA = 307 * MiB;
constexpr size_t OV_GATES = 168 * MiB, OV_MIXED = 232 * MiB;
constexpr size_t OV_DOWN = 0, OV_UP = 32 * MiB, OV_PSCALE = 48 * MiB  , OV_SC = 64 * MiB, OV_IDX = 192 * MiB, OV_GATE = 208 * MiB, OV_POFF = 224 * MiB  , OV_ACT = 226 * MiB  , OV_U8 = 244 * MiB  , OV_XS = 276 * MiB  ;
constexpr size_t OV_BON = 304 * MiB;
constexpr size_t WS_END = WS_OV + 309 * MiB;
static_assert(WS_WIN + 2 * WIN_L <= WS_WA, "map");

constexpr int LDS_BYTES = 147456;
constexpr int LDS_MISC = 145408;
constexpr int CW_BAR = 4096;

__device__ __forceinline__ unsigned f2bf(float f) { unsigned u = __builtin_bit_cast(unsigned, f); return (u + 0x7fffu + ((u >> 16) & 1u)) >> 16; }
__device__ __forceinline__ unsigned pk2(float lo, float hi) { unsigned r; asm volatile("v_cvt_pk_bf16_f32 %0, %1, %2" : "=v"(r) : "v"(lo), "v"(hi)); return r; }
typedef __bf16 bf16x2_t __attribute__((ext_vector_type(2)));
__device__ __forceinline__ unsigned pk2c(float lo, float hi) { bf16x2_t v; v.x = (__bf16)lo; v.y = (__bf16)hi; return __builtin_bit_cast(unsigned, v); }
__device__ __forceinline__ float bflo(unsigned u) { return __builtin_bit_cast(float, u << 16); }
__device__ __forceinline__ float bfhi(unsigned u) { return __builtin_bit_cast(float, u & 0xffff0000u); }
__device__ __forceinline__ float bf1(bf16 u) { return __builtin_bit_cast(float, ((unsigned)u) << 16); }
__device__ __forceinline__ float sigmoidf_(float x) { return 1.f / (1.f + __expf(-x)); }
__device__ __forceinline__ float siluf_(float x) { return x / (1.f + __expf(-x)); }
template <int CTRL> __device__ __forceinline__ float dpp_mov(float x) { return __int_as_float(__builtin_amdgcn_update_dpp(0, __float_as_int(x), CTRL, 0xF, 0xF, true)); }
__device__ __forceinline__ float sum4(float x) { x += dpp_mov<0xB1>(x); x += dpp_mov<0x4E>(x); return x; }
__device__ __forceinline__ float sum16(float x) { x += dpp_mov<0xB1>(x); x += dpp_mov<0x4E>(x); x += dpp_mov<0x141>(x); x += dpp_mov<0x140>(x); return x; }
__device__ __forceinline__ float sum64(float x) { x = sum16(x); x += __shfl_xor(x, 16); x += __shfl_xor(x, 32); return x; }
__device__ __forceinline__ void unpack8(const v4u& q, float (&o)[8]) { o[0] = bflo(q.x); o[1] = bfhi(q.x); o[2] = bflo(q.y); o[3] = bfhi(q.y); o[4] = bflo(q.z); o[5] = bfhi(q.z); o[6] = bflo(q.w); o[7] = bfhi(q.w); }
__device__ __forceinline__ v4u pack8(const float (&o)[8]) { v4u q; q.x = pk2(o[0], o[1]); q.y = pk2(o[2], o[3]); q.z = pk2(o[4], o[5]); q.w = pk2(o[6], o[7]); return q; }

typedef short s16x4 __attribute__((ext_vector_type(4)));
__device__ __forceinline__ void lds_barrier() { asm volatile("s_waitcnt lgkmcnt(0)\n\ts_barrier" ::: "memory"); }
__device__ __forceinline__ bf16x8 tr_frag(unsigned base_bytes, int stride, int k0, int c0, int lane) {
    const int i16 = lane & 15, qq = i16 >> 2, p = i16 & 3, q = lane >> 4;
    const unsigned a0 = base_bytes + (unsigned)(((k0 + 8 * q + qq) * stride + c0 + 4 * p) * 2), a1 = a0 + (unsigned)(8 * stride);
    s16x4 lo, hi;
    asm volatile("ds_read_b64_tr_b16 %0, %2\n\tds_read_b64_tr_b16 %1, %3\n\ts_waitcnt lgkmcnt(0)" : "=&v"(lo), "=&v"(hi) : "v"(a0), "v"(a1) : "memory");
    return __builtin_shufflevector(lo, hi, 0, 1, 2, 3, 4, 5, 6, 7);
}

namespace pg8 {
constexpr int BM = 256, BK = 64, HALF = 128, HTB = HALF * BK * 2, STAGE_BYTES = 8 * HTB, NXCD = 8, WGM = 8;
__host__ __device__ __forceinline__ int lds_byte(int r, int c) { const int st = (r >> 4) * 2 + (c >> 5), rr = r & 15, cc = c & 31, ob = rr * 64 + cc * 2; return st * 1024 + (ob ^ (((ob >> 9) & 1) << 5)); }
__host__ __device__ __forceinline__ void stage_rc(int b, int& R, int& C) { const int st = b / 1024, sb = b % 1024, swz = sb ^ (((sb >> 9) & 1) << 5); R = (st >> 1) * 16 + swz / 64; C = (st & 1) * 32 + (swz % 64) / 2; }
__host__ __device__ __forceinline__ int perm32(int rho) { const int n = rho >> 4, i = rho & 15; return 8 * (i >> 2) + 4 * n + (i & 3); }
struct Unit { int pm, pn; };
struct Gemm { const bf16* A; const bf16* Bt; int M, N, K, lda; int kwin; };
__device__ __forceinline__ void unit_kwin(const Gemm& g, const Unit& u, int& k0t, int& ntl) { k0t = 0; ntl = g.K / BK; if (g.kwin) { const int blk = u.pn >> 2; if (blk < 2) { k0t = 0; ntl = 2; } else if (blk == 2) { k0t = 2; ntl = 4; } else { k0t = 4; ntl = 2; } } }
struct StaticOrder {
    int nM, nN, nwg, G, c;
    __device__ void init(int M_, int N_, int G_, int c_) { nM = M_ / BM; nN = N_ / BM; nwg = nM * nN; G = G_; c = c_; }
    __device__ bool next(int i, Unit& u) const {
        const long L = (long)i * G + c; if (L >= nwg) return false;
        int wgid = (int)L; { const int q = nwg / NXCD, r = nwg % NXCD, xcd = wgid % NXCD, off = wgid / NXCD; wgid = (xcd < r ? xcd * (q + 1) : r * (q + 1) + (xcd - r) * q) + off; }
        const int nig = WGM * nN, gid = wgid / nig, fm = gid * WGM, gsz = (nM - fm) < WGM ? (nM - fm) : WGM;
        u.pm = fm + ((wgid % nig) % gsz); u.pn = (wgid % nig) / gsz; return true;
    }
};
template <class F> struct EpiRow8 {
    static constexpr bool PERM = true;
    F f;
    __device__ __forceinline__ void operator()(const f32x4 (&acc)[2][2][4][2], const Unit& u, int wr, int wc, int fr, int fq) const {
        const int row0 = u.pm * BM + wr * 64 + fr, col0 = u.pn * BM + wc * 32 + 8 * fq;
#pragma unroll
        for (int g0 = 0; g0 < 16; g0 += F::GRP) {
            typename F::Tmp t[F::GRP];
#pragma unroll
            for (int j = 0; j < F::GRP; ++j) { const int i = g0 + j, ai = i >> 3, m = (i >> 1) & 3, bj = i & 1; f.load(row0 + ai * HALF + m * 16, col0 + bj * HALF, u.pn, t[j]); }
#pragma unroll
            for (int j = 0; j < F::GRP; ++j) { const int i = g0 + j, ai = i >> 3, m = (i >> 1) & 3, bj = i & 1; f.apply(row0 + ai * HALF + m * 16, col0 + bj * HALF, acc[ai][bj][m][0], acc[ai][bj][m][1], u.pn, t[j]); }
        }
    }
};


template <class Epi>
__device__ __forceinline__ void gemm_phase(LAS unsigned char* lds, const Gemm g, const StaticOrder& S, const Epi& E) {
    const int tid = threadIdx.x, wid = __builtin_amdgcn_readfirstlane(tid >> 6), lane = tid & 63, wr = wid >> 2, wc = wid & 3, fr = lane & 15, fq = lane >> 4;
    const int K = g.K, lda = g.lda;
    unsigned voffA[2], voffB[2];
#pragma unroll
    for (int i = 0; i < 2; ++i) { int R, C; stage_rc(tid * 16 + i * 8192, R, C); const int Rb = Epi::PERM ? ((R & ~31) + perm32(R & 31)) : R;
        voffA[i] = (unsigned)(R * lda + C) * 2u; voffB[i] = (unsigned)(Rb * K + C) * 2u; }
    const size_t kstep = (size_t)(BK * 2);
    const size_t hstepA = (size_t)HALF * lda * 2, hstepB = (size_t)HALF * K * 2;
    const size_t tstepA = 2 * hstepA, tstepB = 2 * hstepB;
    const unsigned ldsw = (unsigned)wid * 1024u;
    const int aoff = lds_byte(wr * 64 + fr, fq * 8), boff = lds_byte(wc * 32 + fr, fq * 8);
#define PG8_SA(b, h) (((b) * 2 + (h)) * HTB)
#define PG8_SB(b, h) ((4 + (b) * 2 + (h)) * HTB)
#define PG8_STAGE(bufoff, gbase, voff) do { _Pragma("unroll") for (int _i = 0; _i < 2; ++_i) \
        __builtin_amdgcn_global_load_lds((const unsigned*)((const char*)(gbase) + (voff)[_i]), (LAS unsigned*)(lds + (bufoff) + ldsw + _i * 8192), 16, 0, 0); } while (0)
#define PG8_LDA(dst, b, h) do { _Pragma("unroll") for (int m = 0; m < 4; ++m) _Pragma("unroll") for (int k = 0; k < 2; ++k) dst[m][k] = *(const LAS bf16x8*)(lds + PG8_SA(b, h) + aoff + m * 2048 + k * 1024); } while (0)
#define PG8_LDB(dst, b, h) do { _Pragma("unroll") for (int n = 0; n < 2; ++n) _Pragma("unroll") for (int k = 0; k < 2; ++k) dst[n][k] = *(const LAS bf16x8*)(lds + PG8_SB(b, h) + boff + n * 2048 + k * 1024); } while (0)
#define PG8_MMA(ai, bj, At, Bt) do { __builtin_amdgcn_s_setprio(1); _Pragma("unroll") for (int m = 0; m < 4; ++m) _Pragma("unroll") for (int n = 0; n < 2; ++n) _Pragma("unroll") for (int k = 0; k < 2; ++k) \
        acc[ai][bj][m][n] = __builtin_amdgcn_mfma_f32_16x16x32_bf16(Bt[n][k], At[m][k], acc[ai][bj][m][n], 0, 0, 0); __builtin_amdgcn_s_setprio(0); } while (0)
#define PG8_WAIT_V(n) asm volatile("s_waitcnt vmcnt(" #n ")" ::: "memory")
#define PG8_WAIT_L(n) asm volatile("s_waitcnt lgkmcnt(" #n ")" ::: "memory")
#define PG8_BAR __builtin_amdgcn_s_barrier()
#define PG8_SCHED __builtin_amdgcn_sched_barrier(0)
    Unit cur, nxt; int ui = 0;
    if (!S.next(0, cur)) return;
    f32x4 acc[2][2][4][2];
#pragma unroll
    for (int a = 0; a < 2; ++a)
#pragma unroll
        for (int b = 0; b < 2; ++b)
#pragma unroll
            for (int m = 0; m < 4; ++m)
#pragma unroll
                for (int n = 0; n < 2; ++n) acc[a][b][m][n] = (f32x4){0.f, 0.f, 0.f, 0.f};
    bf16x8 At[4][2], B0[2][2], B1[2][2];
    int k0c, nt; unit_kwin(g, cur, k0c, nt);
    const char* cA = (const char*)g.A + (size_t)cur.pm * tstepA + (size_t)k0c * kstep; const char* cB = (const char*)g.Bt + (size_t)cur.pn * tstepB + (size_t)k0c * kstep;
    PG8_STAGE(PG8_SB(0, 0), cB, voffB); PG8_STAGE(PG8_SA(0, 0), cA, voffA); PG8_STAGE(PG8_SB(0, 1), cB + hstepB, voffB); PG8_STAGE(PG8_SA(0, 1), cA + hstepA, voffA);
    if (wr == 1) PG8_BAR;
    PG8_WAIT_V(4); PG8_BAR;
    PG8_STAGE(PG8_SB(1, 0), cB + kstep, voffB); PG8_STAGE(PG8_SA(1, 0), cA + kstep, voffA); PG8_STAGE(PG8_SB(1, 1), cB + hstepB + kstep, voffB);
    PG8_WAIT_V(6); PG8_BAR;
    for (;;) {
        const bool has_next = S.next(ui + 1, nxt);
        int k0n = 0, ntn = nt; if (has_next) unit_kwin(g, nxt, k0n, ntn);
        const char* nA = has_next ? (const char*)g.A + (size_t)nxt.pm * tstepA + (size_t)k0n * kstep : cA; const char* nB = has_next ? (const char*)g.Bt + (size_t)nxt.pn * tstepB + (size_t)k0n * kstep : cB;
        for (int t = 0; t < nt; t += 2) {
            const bool last = (t == nt - 2);
            const char* a1 = cA + (size_t)(t + 1) * kstep;
            const char* a2 = last ? nA : cA + (size_t)(t + 2) * kstep; const char* b2 = last ? nB : cB + (size_t)(t + 2) * kstep;
            const char* a3 = a2 + kstep; const char* b3 = b2 + kstep;
            PG8_LDB(B0, 0, 0); PG8_SCHED; PG8_LDA(At, 0, 0); PG8_STAGE(PG8_SA(1, 1), a1 + hstepA, voffA);
            PG8_WAIT_L(8); PG8_BAR; PG8_WAIT_L(0); PG8_MMA(0, 0, At, B0); PG8_BAR; PG8_SCHED;
            PG8_LDB(B1, 0, 1); PG8_STAGE(PG8_SB(0, 0), b2, voffB);
            PG8_BAR; PG8_WAIT_L(0); PG8_MMA(0, 1, At, B1); PG8_BAR;
            PG8_LDA(At, 0, 1); PG8_STAGE(PG8_SA(0, 0), a2, voffA);
            PG8_BAR; PG8_WAIT_L(0); PG8_MMA(1, 0, At, B0); PG8_BAR; PG8_SCHED;
            PG8_STAGE(PG8_SB(0, 1), b2 + hstepB, voffB);
            PG8_WAIT_V(6); PG8_BAR; PG8_MMA(1, 1, At, B1); PG8_BAR;
            PG8_LDB(B0, 1, 0); PG8_SCHED; PG8_LDA(At, 1, 0); PG8_STAGE(PG8_SA(0, 1), a2 + hstepA, voffA);
            PG8_WAIT_L(8); PG8_BAR; PG8_WAIT_L(0); PG8_MMA(0, 0, At, B0); PG8_BAR; PG8_SCHED;
            PG8_LDB(B1, 1, 1); PG8_STAGE(PG8_SB(1, 0), b3, voffB);
            PG8_BAR; PG8_WAIT_L(0); PG8_MMA(0, 1, At, B1); PG8_BAR;
            PG8_LDA(At, 1, 1); PG8_STAGE(PG8_SA(1, 0), a3, voffA);
            PG8_BAR; PG8_WAIT_L(0); PG8_MMA(1, 0, At, B0); PG8_BAR; PG8_SCHED;
            PG8_STAGE(PG8_SB(1, 1), b3 + hstepB, voffB);
            PG8_WAIT_V(6); PG8_BAR; PG8_MMA(1, 1, At, B1); PG8_BAR;
        }
        E(acc, cur, wr, wc, fr, fq);
        if (!has_next) break;
#pragma unroll
        for (int a = 0; a < 2; ++a)
#pragma unroll
            for (int b = 0; b < 2; ++b)
#pragma unroll
                for (int m = 0; m < 4; ++m)
#pragma unroll
                    for (int n = 0; n < 2; ++n) acc[a][b][m][n] = (f32x4){0.f, 0.f, 0.f, 0.f};
        cur = nxt; cA = nA; cB = nB; nt = ntn; ++ui;
    }
    PG8_WAIT_V(0);
    if (wr == 0) PG8_BAR;
    PG8_BAR;
#undef PG8_SA
#undef PG8_SB
#undef PG8_STAGE
#undef PG8_LDA
#undef PG8_LDB
#undef PG8_MMA
#undef PG8_WAIT_V
#undef PG8_WAIT_L
#undef PG8_BAR
#undef PG8_SCHED
}
}

#define XB_TMO      128
#define XB_XCNT(j)  (256  + 64 * (j))
#define XB_XSUB(j)  (1280 + 64 * (j))
#define XB_XGEN(j)  (2304 + 64 * (j))
#define XB_TOP      3328
#define XB_TOPGEN   3392
#define XCD_BAR_WORDS 3456
#define XB_SPIN_CAP (1u << 18)
__device__ __forceinline__ unsigned xb_ld(unsigned* p)              { return __hip_atomic_load(p, __ATOMIC_RELAXED, __HIP_MEMORY_SCOPE_AGENT); }
__device__ __forceinline__ unsigned xb_add(unsigned* p, unsigned v) { return __hip_atomic_fetch_add(p, v, __ATOMIC_RELAXED, __HIP_MEMORY_SCOPE_AGENT); }
__device__ __forceinline__ unsigned xb_xcc_id() { return (unsigned)__builtin_amdgcn_s_getreg((3 << 11) | 20) & 0xFu; }
#define XB_SPIN(cond, bar) do { unsigned _sp = 0; while (cond) { __builtin_amdgcn_s_sleep(1); \
    if ((++_sp & 255u) == 0u) { if (xb_ld(&(bar)[XB_TMO])) break; if (_sp > XB_SPIN_CAP) { atomicAdd(&(bar)[XB_TMO], 1u); break; } } } } while (0)
struct XcdBarrier { unsigned* bar; unsigned x; volatile LAS unsigned* st; };
__device__ __forceinline__ XcdBarrier xcd_barrier_post(unsigned* bar, volatile LAS unsigned* st) {
    XcdBarrier b; b.bar = bar; b.x = xb_xcc_id(); b.st = st;
    if (threadIdx.x == 0) (void)xb_add(&bar[XB_XCNT(b.x)], 1u);
    return b;
}
__device__ __forceinline__ void xcd_barrier_complete(unsigned* bar, unsigned x, unsigned& nloc, unsigned& nx) {
    const unsigned G = gridDim.x * gridDim.y * gridDim.z;
    unsigned sum, cnt, mine, sp = 0u;
    for (;;) {
        sum = 0u; cnt = 0u; mine = 0u;
#pragma unroll
        for (unsigned j = 0; j < 16; ++j) { const unsigned c = xb_ld(&bar[XB_XCNT(j)]); sum += c; cnt += (c > 0u) ? 1u : 0u; mine = (j == x) ? c : mine; }
        if (sum == G) break;
        __builtin_amdgcn_s_sleep(1);
        if ((++sp & 255u) == 0u) { if (xb_ld(&bar[XB_TMO])) break; if (sp > XB_SPIN_CAP) { atomicAdd(&bar[XB_TMO], 1u); break; } }
    }
    nloc = mine > 0u ? mine : 1u; nx = cnt > 0u ? cnt : 1u;
}
__device__ __forceinline__ void xcd_barrier(const XcdBarrier& b) {
    asm volatile("s_waitcnt vmcnt(0)" ::: "memory");
    __syncthreads();
    if (threadIdx.x == 0) {
        unsigned* bar = b.bar;
        __builtin_amdgcn_s_waitcnt(0);
        unsigned nloc = b.st[0], nx = b.st[1];
        if (nloc == 0u) { xcd_barrier_complete(bar, b.x, nloc, nx); b.st[0] = nloc; b.st[1] = nx; }
        const unsigned old = xb_add(&bar[XB_XSUB(b.x)], 1u);
        const unsigned gen = old / nloc;
        if (old + 1u == (gen + 1u) * nloc) {
            __builtin_amdgcn_fence(__ATOMIC_RELEASE, "agent");
            asm volatile("s_waitcnt vmcnt(0)" ::: "memory");
            const unsigned og = xb_add(&bar[XB_TOP], 1u);
            const unsigned tg = og / nx;
            if (og + 1u == (tg + 1u) * nx) xb_add(&bar[XB_TOPGEN], 1u);
            else XB_SPIN(xb_ld(&bar[XB_TOPGEN]) == tg, bar);
            __builtin_amdgcn_fence(__ATOMIC_ACQUIRE, "agent");
            xb_add(&bar[XB_XGEN(b.x)], 1u);
            asm volatile("s_waitcnt vmcnt(0)" ::: "memory");
        } else {
            XB_SPIN(xb_ld(&bar[XB_XGEN(b.x)]) == gen, bar);
            __builtin_amdgcn_fence(__ATOMIC_ACQUIRE, "agent");
            asm volatile("s_waitcnt vmcnt(0)" ::: "memory");
        }
    }
    __syncthreads();
}

struct Args { const float* in[32]; float* out; unsigned char* ws; int lo, hi; };
typedef const Args __attribute__((address_space(4))) KArgs;
enum { I_X = 0, I_NMG, I_WIN, I_MU, I_W0, I_W2, I_A0, I_A2, I_G2, I_V0, I_V1, I_V2, I_KK, I_KA, I_RK, I_LNW, I_LNB, I_WRB, I_CW, I_CB, I_DTB, I_ALOG, I_SD, I_SNG, I_WSB, I_WOUT, I_NFG, I_WQ, I_SK, I_PD, I_PU, I_NFIN };

struct NoTmp {};
struct FStoreBf16 { bf16* O; int ldc; typedef NoTmp Tmp; static constexpr int GRP = 16;
    __device__ __forceinline__ void load(int, int, int, Tmp&) const {}
    __device__ __forceinline__ void apply(int row, int col, f32x4 v0, f32x4 v1, int, const Tmp&) const {
        v4u w; w.x = pk2(v0[0], v0[1]); w.y = pk2(v0[2], v0[3]); w.z = pk2(v1[0], v1[1]); w.w = pk2(v1[2], v1[3]);
        *(v4u*)(O + (size_t)row * ldc + col) = w; } };
struct FSigmoidBf16 { bf16* O; int ldc; typedef NoTmp Tmp; static constexpr int GRP = 16;
    __device__ __forceinline__ void load(int, int, int, Tmp&) const {}
    __device__ __forceinline__ void apply(int row, int col, f32x4 v0, f32x4 v1, int, const Tmp&) const {
        v4u w; w.x = pk2(sigmoidf_(v0[0]), sigmoidf_(v0[1])); w.y = pk2(sigmoidf_(v0[2]), sigmoidf_(v0[3])); w.z = pk2(sigmoidf_(v1[0]), sigmoidf_(v1[1])); w.w = pk2(sigmoidf_(v1[2]), sigmoidf_(v1[3]));
        *(v4u*)(O + (size_t)row * ldc + col) = w; } };
struct EpiLora {
    static constexpr bool PERM = true;
    bf16 *elog, *asig, *gg, *vmix; const bf16* vf; const float *w0, *a0, *v0;
    template <int BLK> __device__ __forceinline__ void run(const f32x4 (&acc)[2][2][4][2], int row0, int col0) const {
#pragma unroll
        for (int bj = 0; bj < 2; ++bj) {
            const int c = (col0 + bj * 128) & 1023;
            float bias[8];
            if (BLK == 0 || BLK == 1 || BLK == 3) { const float* bp = (BLK == 0 ? w0 : (BLK == 1 ? a0 : v0)) + c; const f32x4 b0 = *(const f32x4*)bp, b1 = *(const f32x4*)(bp + 4);
                bias[0] = b0[0]; bias[1] = b0[1]; bias[2] = b0[2]; bias[3] = b0[3]; bias[4] = b1[0]; bias[5] = b1[1]; bias[6] = b1[2]; bias[7] = b1[3]; }
#pragma unroll
            for (int ai = 0; ai < 2; ++ai) {
            v4u qvs[4], qvf[4];
            if (BLK == 3) {
#pragma unroll
                for (int i = 0; i < 4; ++i) { const size_t o = (size_t)(row0 + ai * 128 + i * 16) * D + c; qvs[i] = *(const v4u*)(vmix + o); qvf[i] = *(const v4u*)(vf + o); }
            }
#pragma unroll
                for (int m = 0; m < 4; ++m) {
                    const int row = row0 + ai * 128 + m * 16; const size_t o = (size_t)row * D + c;
                    const f32x4 v0_ = acc[ai][bj][m][0], v1_ = acc[ai][bj][m][1];
                    float a[8] = {v0_[0], v0_[1], v0_[2], v0_[3], v1_[0], v1_[1], v1_[2], v1_[3]};
                    if (BLK == 0) {
#pragma unroll
                        for (int e = 0; e < 8; ++e) a[e] = -0.6065306597f * sigmoidf_(bias[e] + a[e]);
                        *(v4u*)(elog + o) = pack8(a);
                    } else if (BLK == 1) {
#pragma unroll
                        for (int e = 0; e < 8; ++e) a[e] = sigmoidf_(bias[e] + a[e]);
                        *(v4u*)(asig + o) = pack8(a);
                    } else if (BLK == 2) {
                        *(v4u*)(gg + o) = pack8(a);
                    } else {
                        float vs[8], vfv[8]; unpack8(qvs[m], vs); unpack8(qvf[m], vfv);
#pragma unroll
                        for (int e = 0; e < 8; ++e) a[e] = vs[e] + (vfv[e] - vs[e]) * sigmoidf_(bias[e] + a[e]);
                        *(v4u*)(vmix + o) = pack8(a);
                    }
                }
            }
        }
    }
    __device__ __forceinline__ void operator()(const f32x4 (&acc)[2][2][4][2], const pg8::Unit& u, int wr, int wc, int fr, int fq) const {
        const int row0 = u.pm * 256 + wr * 64 + fr, col0 = u.pn * 256 + wc * 32 + 8 * fq;
        const int blk = u.pn >> 2;
        if (blk == 0) run<0>(acc, row0, col0); else if (blk == 1) run<1>(acc, row0, col0); else if (blk == 2) run<2>(acc, row0, col0); else run<3>(acc, row0, col0);
    }
};
struct FMixA { const bf16* gates; bf16* mixed;
    struct Tmp { v4u g; }; static constexpr int GRP = 8;
    __device__ __forceinline__ void load(int row, int col, int, Tmp& t) const { t.g = *(const v4u*)(gates + (size_t)row * 2048 + col); }
    __device__ __forceinline__ void apply(int row, int col, f32x4 v0, f32x4 v1, int, const Tmp& t) const {
        float g[8]; unpack8(t.g, g);
        float a[8] = {v0[0] * g[0], v0[1] * g[1], v0[2] * g[2], v0[3] * g[3], v1[0] * g[4], v1[1] * g[5], v1[2] * g[6], v1[3] * g[7]};
        *(v4u*)(mixed + (size_t)row * D + col) = pack8(a); } };
struct FMixB { const bf16* gates; bf16* mixed;
    struct Tmp { v4u g, mx; }; static constexpr int GRP = 8;
    __device__ __forceinline__ void load(int row, int col, int, Tmp& t) const { t.g = *(const v4u*)(gates + (size_t)row * 2048 + 1024 + col); t.mx = *(const v4u*)(mixed + (size_t)row * D + col); }
    __device__ __forceinline__ void apply(int row, int col, f32x4 v0, f32x4 v1, int, const Tmp& t) const {
        float g[8], mx[8]; unpack8(t.g, g); unpack8(t.mx, mx);
        float a[8] = {mx[0] + v0[0] * g[0], mx[1] + v0[1] * g[1], mx[2] + v0[2] * g[2], mx[3] + v0[3] * g[3], mx[4] + v1[0] * g[4], mx[5] + v1[1] * g[5], mx[6] + v1[2] * g[6], mx[7] + v1[3] * g[7]};
        *(v4u*)(mixed + (size_t)row * D + col) = pack8(a); } };
struct FResid { const float* base; float* h;
    struct Tmp { f32x4 a, b; }; static constexpr int GRP = 8;
    __device__ __forceinline__ void load(int row, int col, int, Tmp& t) const { const f32x4* s = (const f32x4*)(base + (size_t)row * D + col); t.a = s[0]; t.b = s[1]; }
    __device__ __forceinline__ void apply(int row, int col, f32x4 v0, f32x4 v1, int, const Tmp& t) const {
        f32x4* p = (f32x4*)(h + (size_t)row * D + col); p[0] = t.a + v0; p[1] = t.b + v1; } };

struct Ctx { int tid, lane, wave, G, bid; LAS unsigned char* lds; };

__device__ __forceinline__ void transpose_item(const float* W, int K, int N, bf16* WT, int row_off, LAS float* scr, int item, int lane) {
    const int nblk = N / 32, kb = item / nblk, nb = item % nblk, k0 = 64 * kb, n0 = 32 * nb;
#pragma unroll 8
    for (int i = 0; i < 32; ++i) { const int kk = 2 * i + (lane >> 5); scr[kk * 33 + (lane & 31)] = W[(size_t)(k0 + kk) * N + n0 + (lane & 31)]; }
    asm volatile("s_waitcnt lgkmcnt(0)" ::: "memory");
    const int c = lane & 7;
#pragma unroll
    for (int j = 0; j < 4; ++j) { const int n = (lane >> 3) + 8 * j; const LAS float* s = scr + (8 * c) * 33 + n;
        v4u o; o.x = pk2(s[0 * 33], s[1 * 33]); o.y = pk2(s[2 * 33], s[3 * 33]); o.z = pk2(s[4 * 33], s[5 * 33]); o.w = pk2(s[6 * 33], s[7 * 33]);
        *(v4u*)(WT + (size_t)(row_off + n0 + n) * K + k0 + 8 * c) = o; }
    asm volatile("s_waitcnt lgkmcnt(0)" ::: "memory");
}
__device__ __forceinline__ int winrow(int n) {
    if (n < RW_PROJ) return n;
    if (n < RW_PROJ + 5120) return N1P + (n - RW_PROJ);
    if (n < RW_PROJ + SSD_PROJ) return DT_COL + (n - RW_PROJ - 5120);
    return N1P + N2P + (n - RW_PROJ - SSD_PROJ); }

__device__ __forceinline__ void phase_prologue(const Ctx& c, KArgs& a) {
    unsigned char* ws = a.ws;
    LAS float* scr = (LAS float*)(c.lds + c.wave * 16384);
    const int gw = c.bid * 8 + c.wave, NGW = c.G * 8;
    constexpr int I_IN = 16 * (IN_PROJ / 32), I_A = 16 * 32, I_B = 32 * 32, I_O = 16 * 32, I_L = I_IN + I_A + I_B + I_O;
    for (int it = gw; it < 2 * I_L; it += NGW) {
        const int l = it / I_L; int r = it % I_L;
        if (r < I_IN) { const int nb = r % (IN_PROJ / 32); transpose_item(a.in[I_WIN] + (size_t)l * D * IN_PROJ, D, IN_PROJ, (bf16*)(ws + WS_WIN + l * WIN_L), winrow(nb * 32) - nb * 32, scr, r, c.lane); continue; } r -= I_IN;
        if (r < I_A) { transpose_item(a.in[I_WRB] + (size_t)l * D * D, D, D, (bf16*)(ws + WS_WA) + (size_t)l * D * D, 0, scr, r, c.lane); continue; } r -= I_A;
        if (r < I_B) { transpose_item(a.in[I_WSB] + (size_t)l * 2048 * D, 2048, D, (bf16*)(ws + WS_WB) + (size_t)l * D * 2048, 0, scr, r, c.lane); continue; } r -= I_B;
        transpose_item(a.in[I_WOUT] + (size_t)l * D * D, D, D, (bf16*)(ws + WS_WO) + (size_t)l * D * D, 0, scr, r, c.lane);
    }
    for (int it = c.bid * 512 + c.tid; it < 2 * 192 * 128; it += c.G * 512) {
        const int l = it / (192 * 128), r = (it / 128) % 192, q = it % 128;
        *(v4u*)((bf16*)(ws + WS_WIN + l * WIN_L) + (size_t)(DT_COL + 32 + r) * D + q * 8) = (v4u){0u, 0u, 0u, 0u};
    }
    for (int it = c.bid * 512 + c.tid; it < 2 * 4096 * KL; it += c.G * 512) {
        const int l = it / (4096 * KL), n = (it / KL) % 4096, k = it % KL; const int blk = n >> 10, cc = n & 1023;
        float v = 0.f;
        if (blk == 0) { if (k < 64) v = a.in[I_W2][((size_t)l * 64 + k) * D + cc]; }
        else if (blk == 1) { if (k >= 64 && k < 128) v = a.in[I_A2][((size_t)l * 64 + (k - 64)) * D + cc]; }
        else if (blk == 2) { if (k >= 128 && k < 288) v = a.in[I_G2][((size_t)l * 160 + (k - 128)) * D + cc]; }
        else { if (l == 1 && k >= 288 && k < 320) v = a.in[I_V2][(size_t)(k - 288) * D + cc]; }
        ((bf16*)(ws + WS_WLORA + l * WLORA_L))[(size_t)n * KL + k] = (bf16)f2bf(v);
    }
    __syncthreads();
    LAS float* wqL = (LAS float*)c.lds;
    LAS float* kyL = (LAS float*)(c.lds + 32768);
    for (int it = c.bid; it < 2 * 16 * 16; it += c.G) {
        const int l = it >> 8, hc = (it >> 4) & 15, k0 = (it & 15) * 64;
        const float* wq = a.in[I_WQ] + (size_t)l * D * 2048; const float* ky = a.in[I_SK] + ((size_t)l * 16 + hc) * 128 * 128;
        for (int e = c.tid; e < 64 * 128; e += 512) wqL[e] = wq[(size_t)(k0 + (e >> 7)) * 2048 + hc * 128 + (e & 127)];
        for (int e = c.tid; e < 128 * 128; e += 512) kyL[(e >> 7) * 129 + (e & 127)] = ky[e];
        __syncthreads();
        const int key = c.tid & 127, kg = c.tid >> 7;
        float acc[16];
#pragma unroll
        for (int i = 0; i < 16; ++i) acc[i] = 0.f;
        for (int d = 0; d < 128; ++d) { const float kv = kyL[key * 129 + d];
#pragma unroll
            for (int i = 0; i < 16; ++i) acc[i] += wqL[(kg * 16 + i) * 128 + d] * kv; }
        bf16* o = (bf16*)(ws + WS_WQK) + ((size_t)l * 2048 + hc * 128 + key) * D + k0 + kg * 16;
        v4u q0, q1; q0.x = pk2(acc[0], acc[1]); q0.y = pk2(acc[2], acc[3]); q0.z = pk2(acc[4], acc[5]); q0.w = pk2(acc[6], acc[7]);
        q1.x = pk2(acc[8], acc[9]); q1.y = pk2(acc[10], acc[11]); q1.z = pk2(acc[12], acc[13]); q1.w = pk2(acc[14], acc[15]);
        *(v4u*)o = q0; *(v4u*)(o + 8) = q1;
        __syncthreads();
    }
}

__device__ __forceinline__ void phase_rmsnorm(const Ctx& c, const float* src, const float* g, bf16* U, float* copy_to) {
    const int gw = c.bid * 8 + c.wave, NGW = c.G * 8;
    f32x4 gv[4];
#pragma unroll
    for (int j = 0; j < 4; ++j) gv[j] = *((const f32x4*)g + c.lane + 64 * j);
    f32x4 nv[4];
    if (gw < M) { const f32x4* xr0 = (const f32x4*)(src + (size_t)gw * D) + c.lane;
#pragma unroll
        for (int j = 0; j < 4; ++j) nv[j] = xr0[64 * j]; }
    for (int m = gw; m < M; m += NGW) {
        f32x4 v[4]; float s = 0.f;
#pragma unroll
        for (int j = 0; j < 4; ++j) { v[j] = nv[j]; s += (v[j].x * v[j].x + v[j].y * v[j].y) + (v[j].z * v[j].z + v[j].w * v[j].w); }
        if (m + NGW < M) { const f32x4* xn = (const f32x4*)(src + (size_t)(m + NGW) * D) + c.lane;
#pragma unroll
            for (int j = 0; j < 4; ++j) nv[j] = xn[64 * j]; }
        if (copy_to) { f32x4* cr = (f32x4*)(copy_to + (size_t)m * D) + c.lane;
#pragma unroll
            for (int j = 0; j < 4; ++j) cr[64 * j] = v[j]; }
        const float r = rsqrtf(sum64(s) * (1.f / D) + 1e-6f);
        v2u* o = (v2u*)(U + (size_t)m * D) + c.lane;
#pragma unroll
        for (int j = 0; j < 4; ++j) { v2u w; w.x = pk2(v[j].x * r * gv[j].x, v[j].y * r * gv[j].y); w.y = pk2(v[j].z * r * gv[j].z, v[j].w * r * gv[j].w); o[64 * j] = w; }
    }
}
__device__ __forceinline__ void phase_rmsnorm_q8(const Ctx& c, const float* src, const float* g, bf16* U, unsigned char* U8, float* XS) {
    const int gw = c.bid * 8 + c.wave, NGW = c.G * 8;
    f32x4 gv[4];
#pragma unroll
    for (int j = 0; j < 4; ++j) gv[j] = *((const f32x4*)g + c.lane + 64 * j);
    f32x4 nv[4];
    if (gw < M) { const f32x4* xr0 = (const f32x4*)(src + (size_t)gw * D) + c.lane;
#pragma unroll
        for (int j = 0; j < 4; ++j) nv[j] = xr0[64 * j]; }
    for (int m = gw; m < M; m += NGW) {
        f32x4 v[4]; float s = 0.f;
#pragma unroll
        for (int j = 0; j < 4; ++j) { v[j] = nv[j]; s += (v[j].x * v[j].x + v[j].y * v[j].y) + (v[j].z * v[j].z + v[j].w * v[j].w); }
        if (m + NGW < M) { const f32x4* xn = (const f32x4*)(src + (size_t)(m + NGW) * D) + c.lane;
#pragma unroll
            for (int j = 0; j < 4; ++j) nv[j] = xn[64 * j]; }
        const float r = rsqrtf(sum64(s) * (1.f / D) + 1e-6f);
        float am = 0.f;
#pragma unroll
        for (int j = 0; j < 4; ++j) { v[j] = v[j] * r * gv[j]; am = fmaxf(am, fmaxf(fmaxf(fabsf(v[j].x), fabsf(v[j].y)), fmaxf(fabsf(v[j].z), fabsf(v[j].w)))); }
#pragma unroll
        for (int o = 1; o < 64; o <<= 1) am = fmaxf(am, __shfl_xor(am, o));
        am = fmaxf(am, 1e-30f);
        const float qs = 384.f / am;
        v2u* o = (v2u*)(U + (size_t)m * D) + c.lane;
        unsigned* o8 = (unsigned*)(U8 + (size_t)m * D) + c.lane;
#pragma unroll
        for (int j = 0; j < 4; ++j) { v2u w; w.x = pk2(v[j].x, v[j].y); w.y = pk2(v[j].z, v[j].w); o[64 * j] = w;
            int w8 = __builtin_amdgcn_cvt_pk_fp8_f32(v[j].x * qs, v[j].y * qs, 0, false); w8 = __builtin_amdgcn_cvt_pk_fp8_f32(v[j].z * qs, v[j].w * qs, w8, true); o8[64 * j] = (unsigned)w8; }
        if (c.lane == 0) XS[m] = am * (1.f / 384.f);
    }
}
__device__ __forceinline__ void phase_final(const Ctx& c, float* out, const float* g) {
    const int gw = c.bid * 8 + c.wave, NGW = c.G * 8;
    f32x4 gv[4];
#pragma unroll
    for (int j = 0; j < 4; ++j) gv[j] = *((const f32x4*)g + c.lane + 64 * j);
    for (int m = gw; m < M; m += NGW) {
        f32x4* xr = (f32x4*)(out + (size_t)m * D) + c.lane;
        f32x4 v[4]; float s = 0.f;
#pragma unroll
        for (int j = 0; j < 4; ++j) { v[j] = xr[64 * j]; s += (v[j].x * v[j].x + v[j].y * v[j].y) + (v[j].z * v[j].z + v[j].w * v[j].w); }
        const float r = rsqrtf(sum64(s) * (1.f / D) + 1e-6f);
#pragma unroll
        for (int j = 0; j < 4; ++j) xr[64 * j] = v[j] * r * gv[j];
    }
}

__device__ __forceinline__ void phase_rwkv_prep(const Ctx& c, KArgs& a, int l, int hb) {
    unsigned char* ws = a.ws;
    const bf16* PR = (const bf16*)(ws + WS_OV + OV_PR);
    bf16* AL = (bf16*)(ws + WS_OV + OV_AL);
    bf16* VS = l == 0 ? (bf16*)(ws + WS_VF) + (size_t)hb * MH * D : (bf16*)(ws + WS_OV + OV_VMIX);
    const float* mu = a.in[I_MU] + (size_t)l * RW_PROJ;
    LAS bf16* v1L = (LAS bf16*)c.lds;
    if (l == 1) {
        const float* v1 = a.in[I_V1];
        for (int e = c.tid; e < 1024 * 32; e += 512) { const int cc = e >> 5, j = e & 31; v1L[((cc & 15) * 64 + (cc >> 4)) * 40 + j] = (bf16)f2bf(v1[e]); }
        __syncthreads();
    }
    const int gw = c.bid * 8 + c.wave, NGW = c.G * 8, lane = c.lane;
    float muv[16], mul[8];
#pragma unroll
    for (int e = 0; e < 16; ++e) muv[e] = mu[2048 + 16 * lane + e];
#pragma unroll
    for (int e = 0; e < 8; ++e) mul[e] = lane < 36 ? mu[3072 + 8 * lane + e] : 0.f;
    const int per = (MH + NGW - 1) / NGW;
    const int mA = gw * per, mB = (mA + per < MH) ? mA + per : MH;
    v4u cq0, cq1, cql, pq0, pq1, pql;
    const v4u zz4 = (v4u){0u, 0u, 0u, 0u};
    const int lcol = lane < 36 ? 3072 + 8 * lane : 3072;
    if (mA < mB) {
        const bf16* row = PR + (size_t)mA * N1P;
        cq0 = *(const v4u*)(row + 2048 + 16 * lane); cq1 = *(const v4u*)(row + 2048 + 16 * lane + 8); cql = *(const v4u*)(row + lcol);
        if ((mA & (T - 1)) != 0) { pq0 = *(const v4u*)(row - N1P + 2048 + 16 * lane); pq1 = *(const v4u*)(row - N1P + 2048 + 16 * lane + 8); pql = *(const v4u*)(row - N1P + lcol); }
        else { pq0 = zz4; pq1 = zz4; pql = zz4; }
    }
    for (int m = mA; m < mB; ++m) {
        const v4u q0 = cq0, q1 = cq1, ql = cql;
        v4u r0 = pq0, r1 = pq1, rl = pql;
        if ((m & (T - 1)) == 0) { r0 = zz4; r1 = zz4; rl = zz4; }
        if (m + 1 < mB) { const bf16* nrow = PR + (size_t)(m + 1) * N1P; cq0 = *(const v4u*)(nrow + 2048 + 16 * lane); cq1 = *(const v4u*)(nrow + 2048 + 16 * lane + 8); cql = *(const v4u*)(nrow + lcol); }
        pq0 = q0; pq1 = q1; pql = ql;
        float vs[16];
        {
            float p[16], pp[16];
            float t8[8];
            unpack8(q0, t8);
#pragma unroll
            for (int e = 0; e < 8; ++e) p[e] = t8[e];
            unpack8(q1, t8);
#pragma unroll
            for (int e = 0; e < 8; ++e) p[8 + e] = t8[e];
            unpack8(r0, t8);
#pragma unroll
            for (int e = 0; e < 8; ++e) pp[e] = t8[e];
            unpack8(r1, t8);
#pragma unroll
            for (int e = 0; e < 8; ++e) pp[8 + e] = t8[e];
#pragma unroll
            for (int e = 0; e < 16; ++e) vs[e] = p[e] + (pp[e] - p[e]) * muv[e];
            v4u o0, o1;
            o0.x = pk2(vs[0], vs[1]); o0.y = pk2(vs[2], vs[3]); o0.z = pk2(vs[4], vs[5]); o0.w = pk2(vs[6], vs[7]);
            o1.x = pk2(vs[8], vs[9]); o1.y = pk2(vs[10], vs[11]); o1.z = pk2(vs[12], vs[13]); o1.w = pk2(vs[14], vs[15]);
            *(v4u*)(VS + (size_t)m * D + 16 * lane) = o0; *(v4u*)(VS + (size_t)m * D + 16 * lane + 8) = o1;
        }
        if (lane < 36) {
            float p[8], pp[8], s[8];
            unpack8(ql, p);
            unpack8(rl, pp);
#pragma unroll
            for (int e = 0; e < 8; ++e) { const float x = p[e] + (pp[e] - p[e]) * mul[e]; s[e] = lane < 8 ? tanhf(x) : (lane < 16 ? x : sigmoidf_(x)); }
            *(v4u*)(AL + (size_t)m * KL + 8 * lane) = pack8(s);
        } else if (lane < 48 && !(l == 1 && lane < 40)) {
            *(v4u*)(AL + (size_t)m * KL + 8 * lane) = (v4u){0u, 0u, 0u, 0u};
        }
        if (l == 1) {
            float acc[32];
#pragma unroll
            for (int j = 0; j < 32; ++j) acc[j] = 0.f;
#pragma unroll
            for (int i = 0; i < 16; ++i) {
                const LAS v4u* wp = (const LAS v4u*)(v1L + (i * 64 + lane) * 40);
#pragma unroll
                for (int q = 0; q < 4; ++q) { float w8[8]; const v4u wq_ = wp[q]; unpack8(wq_, w8);
#pragma unroll
                    for (int e = 0; e < 8; ++e) acc[q * 8 + e] += vs[i] * w8[e]; }
            }
#pragma unroll
            for (int s = 32, half = 16; s >= 2; s >>= 1, half >>= 1) {
                const bool up = (lane & s) != 0;
#pragma unroll
                for (int i = 0; i < 16; ++i) if (i < half) { const float send = up ? acc[i] : acc[i + half]; const float keep = up ? acc[i + half] : acc[i]; acc[i] = keep + __shfl_xor(send, s); }
            }
            acc[0] += __shfl_xor(acc[0], 1);
            const int j = ((lane & 32) ? 16 : 0) + ((lane & 16) ? 8 : 0) + ((lane & 8) ? 4 : 0) + ((lane & 4) ? 2 : 0) + ((lane & 2) ? 1 : 0);
            if ((lane & 1) == 0) AL[(size_t)m * KL + 288 + j] = (bf16)f2bf(acc[0]);
        }
    }
    { float* DT = (float*)(ws + WS_OV + OV_DT); float* DA = (float*)(ws + WS_OV + OV_DA);
      for (int it = gw; it < (MH / 64) * 32; it += NGW) {
        const int ck = it >> 5, h = it & 31;
        const size_t m = (size_t)ck * 64 + lane;
        const float x = bf1(PR[m * N1P + DT_COL + h]) + a.in[I_DTB][l * 32 + h];
        const float dt = x > 20.f ? x : log1pf(__expf(x));
        float cs = -dt * __expf(a.in[I_ALOG][l * 32 + h]);
#pragma unroll
        for (int o = 1; o < 64; o <<= 1) { const float y = __shfl_up(cs, o); cs += (lane >= o) ? y : 0.f; }
        DT[m * 32 + h] = dt; DA[m * 32 + h] = cs;
      } }
}

__device__ __forceinline__ float sum8(float x) { x += dpp_mov<0xB1>(x); x += dpp_mov<0x4E>(x); x += dpp_mov<0x141>(x); return x; }
__device__ __forceinline__ void phase_rwkv_rec(const Ctx& c, KArgs& a, int l, int hb) {
    unsigned char* ws = a.ws;
    const bf16* PR = (const bf16*)(ws + WS_OV + OV_PR);
    const bf16* ELOG = (const bf16*)(ws + WS_OV + OV_ELOG);
    const bf16* ASIG = (const bf16*)(ws + WS_OV + OV_ASIG);
    const bf16* VS = l == 0 ? (const bf16*)(ws + WS_VF) + (size_t)hb * MH * D : (const bf16*)(ws + WS_OV + OV_VMIX);
    bf16* Y = (bf16*)(ws + WS_OV + OV_YA);
    const float* mu = a.in[I_MU] + (size_t)l * RW_PROJ;
    const float* k_k = a.in[I_KK] + (size_t)l * D; const float* k_a = a.in[I_KA] + (size_t)l * D;
    constexpr int CH = 32, NCH = T / CH;
    constexpr int ARRF = CH * 64;
    constexpr int BUFF = 5 * ARRF + CH * 16 + CH * 2;
    LAS float* ldsf = (LAS float*)c.lds;
    LAS float* yt = ldsf + 2 * BUFF;
    const int tid = c.tid, lane = c.lane;
    const bool is_prep = c.wave >= 4;
    const int ptid = tid - 256, tt = ptid >> 3, l8 = ptid & 7, pc = l8 * 8;
    const int rrow = c.wave * 4 + (lane >> 4), cc4 = (lane & 15) * 4;
    for (int unit = c.bid; unit < 256; unit += c.G) {
        const int b = unit >> 6, h = (unit >> 2) & 15, rq = unit & 3;
        const size_t m0 = (size_t)b * T;
        const int hc = h * 64 + pc;
        float mur[8], muk[8], kkc[8], kac[8];
        if (is_prep) {
#pragma unroll
            for (int e = 0; e < 8; ++e) { mur[e] = mu[hc + e]; muk[e] = mu[1024 + hc + e]; kkc[e] = k_k[hc + e]; kac[e] = k_a[hc + e]; }
        }
        float S[4] = {0.f, 0.f, 0.f, 0.f}, sa = 0.f;
#define RW_PREP(chunk, bufp) do { \
            const int t_ = (chunk) * CH + tt; const size_t mm = m0 + t_; const bf16* row = PR + mm * N1P + hc; \
            const v4u zr = (v4u){0u, 0u, 0u, 0u}; \
            const v4u qr = *(const v4u*)row, qk = *(const v4u*)(row + 1024); \
            const v4u qrp = t_ > 0 ? *(const v4u*)(row - N1P) : zr, qkp = t_ > 0 ? *(const v4u*)(row - N1P + 1024) : zr; \
            const v4u qkn = t_ + 1 < T ? *(const v4u*)(row + N1P + 1024) : zr; \
            const v4u qas = *(const v4u*)(ASIG + mm * D + hc), qel = *(const v4u*)(ELOG + mm * D + hc); \
            v4u qv = zr; if (l8 < 2) qv = *(const v4u*)(VS + mm * D + h * 64 + rq * 16 + l8 * 8); \
            float r_[8], rp_[8], k_[8], kp_[8], kn_[8], as_[8], el_[8]; \
            unpack8(qr, r_); unpack8(qrp, rp_); unpack8(qk, k_); unpack8(qkp, kp_); unpack8(qkn, kn_); unpack8(qas, as_); unpack8(qel, el_); \
            float ks_[8], kk_[8], kkn_[8], s1 = 0.f, s2 = 0.f; \
            _Pragma("unroll") for (int e = 0; e < 8; ++e) { ks_[e] = k_[e] + (kp_[e] - k_[e]) * muk[e]; const float kn1 = kn_[e] + (k_[e] - kn_[e]) * muk[e]; \
                kk_[e] = ks_[e] * kkc[e]; kkn_[e] = kn1 * kkc[e]; s1 += kk_[e] * kk_[e]; s2 += kkn_[e] * kkn_[e]; } \
            s1 = sum8(s1); s2 = sum8(s2); \
            const float i1 = rsqrtf(s1 + 1e-12f), i2 = (t_ + 1 < T) ? rsqrtf(s2 + 1e-12f) : 0.f; \
            float ow[8], ok[8], ob[8], orr[8], owa[8], c1 = 0.f, c2 = 0.f; \
            _Pragma("unroll") for (int e = 0; e < 8; ++e) { const float kn = kk_[e] * i1, an = -kkn_[e] * i2; \
                ow[e] = __expf(el_[e]); ok[e] = ks_[e] * (1.f + (as_[e] - 1.f) * kac[e]); ob[e] = kn * as_[e]; orr[e] = r_[e] + (rp_[e] - r_[e]) * mur[e]; \
                owa[e] = ow[e] * an; c1 += ob[e] * an; c2 += ok[e] * an; } \
            c1 = sum8(c1); c2 = sum8(c2); \
            LAS float* bp_ = (bufp) + tt * 64 + pc; \
            *(LAS f32x4*)(bp_) = (f32x4){ow[0], ow[1], ow[2], ow[3]}; *(LAS f32x4*)(bp_ + 4) = (f32x4){ow[4], ow[5], ow[6], ow[7]}; \
            *(LAS f32x4*)(bp_ + ARRF) = (f32x4){ok[0], ok[1], ok[2], ok[3]}; *(LAS f32x4*)(bp_ + ARRF + 4) = (f32x4){ok[4], ok[5], ok[6], ok[7]}; \
            *(LAS f32x4*)(bp_ + 2 * ARRF) = (f32x4){ob[0], ob[1], ob[2], ob[3]}; *(LAS f32x4*)(bp_ + 2 * ARRF + 4) = (f32x4){ob[4], ob[5], ob[6], ob[7]}; \
            *(LAS f32x4*)(bp_ + 3 * ARRF) = (f32x4){orr[0], orr[1], orr[2], orr[3]}; *(LAS f32x4*)(bp_ + 3 * ARRF + 4) = (f32x4){orr[4], orr[5], orr[6], orr[7]}; \
            *(LAS f32x4*)(bp_ + 4 * ARRF) = (f32x4){owa[0], owa[1], owa[2], owa[3]}; *(LAS f32x4*)(bp_ + 4 * ARRF + 4) = (f32x4){owa[4], owa[5], owa[6], owa[7]}; \
            if (l8 < 2) { float v_[8]; unpack8(qv, v_); LAS float* vp_ = (bufp) + 5 * ARRF + tt * 16 + l8 * 8; \
                *(LAS f32x4*)vp_ = (f32x4){v_[0], v_[1], v_[2], v_[3]}; *(LAS f32x4*)(vp_ + 4) = (f32x4){v_[4], v_[5], v_[6], v_[7]}; } \
            if (l8 == 0) { (bufp)[5 * ARRF + CH * 16 + tt * 2] = c1; (bufp)[5 * ARRF + CH * 16 + tt * 2 + 1] = c2; } } while (0)
#define RW_YSTORE(chunk) do { const LAS float* yp_ = yt + ((chunk) & 1) * CH * 16 + tt * 16 + l8 * 2; \
            *(unsigned*)(Y + (m0 + (size_t)(chunk) * CH + tt) * D + h * 64 + rq * 16 + l8 * 2) = pk2(yp_[0], yp_[1]); } while (0)
        if (is_prep) RW_PREP(0, ldsf);
        __syncthreads();
        for (int ch = 0; ch < NCH; ++ch) {
            if (is_prep) {
                if (ch + 1 < NCH) RW_PREP(ch + 1, ldsf + ((ch + 1) & 1) * BUFF);
                if (ch > 0) RW_YSTORE(ch - 1);
            } else {
                const LAS float* buf = ldsf + (ch & 1) * BUFF;
                LAS float* yw = yt + (ch & 1) * CH * 16;
                const int lane15 = lane & 15;
                f32x4 w4 = *(const LAS f32x4*)(buf + cc4), k4 = *(const LAS f32x4*)(buf + ARRF + cc4), b4 = *(const LAS f32x4*)(buf + 2 * ARRF + cc4);
                f32x4 r4 = *(const LAS f32x4*)(buf + 3 * ARRF + cc4), wa4 = *(const LAS f32x4*)(buf + 4 * ARRF + cc4);
                float v = buf[5 * ARRF + rrow]; f32x2 cc = *(const LAS f32x2*)(buf + 5 * ARRF + CH * 16);
#pragma unroll 1
                for (int t16 = 0; t16 < CH; t16 += 16) {
                    float ysave = 0.f;
#pragma unroll
                    for (int u = 0; u < 16; ++u) {
                        const int tn = (t16 + u + 1 < CH) ? t16 + u + 1 : t16 + u;
                        const f32x4 nw4 = *(const LAS f32x4*)(buf + tn * 64 + cc4), nk4 = *(const LAS f32x4*)(buf + ARRF + tn * 64 + cc4), nb4 = *(const LAS f32x4*)(buf + 2 * ARRF + tn * 64 + cc4);
                        const f32x4 nr4 = *(const LAS f32x4*)(buf + 3 * ARRF + tn * 64 + cc4), nwa4 = *(const LAS f32x4*)(buf + 4 * ARRF + tn * 64 + cc4);
                        const float nv = buf[5 * ARRF + tn * 16 + rrow]; const f32x2 ncc = *(const LAS f32x2*)(buf + 5 * ARRF + CH * 16 + tn * 2);
                        float d = S[0] * wa4[0]; d = __builtin_fmaf(S[1], wa4[1], d); d = __builtin_fmaf(S[2], wa4[2], d); d = __builtin_fmaf(S[3], wa4[3], d);
#pragma unroll
                        for (int e = 0; e < 4; ++e) { float tmp = S[e] * w4[e]; asm volatile("" : "+v"(tmp)); tmp = __builtin_fmaf(v, k4[e], tmp); S[e] = __builtin_fmaf(sa, b4[e], tmp); asm volatile("" : "+v"(S[e])); }
                        const float sa_next = __builtin_fmaf(v, cc.y, sa * cc.x);
                        float y = S[0] * r4[0]; y = __builtin_fmaf(S[1], r4[1], y); y = __builtin_fmaf(S[2], r4[2], y); y = __builtin_fmaf(S[3], r4[3], y);
                        d = sum16(d); y = sum16(y);
                        sa = d + sa_next;
                        ysave = (lane15 == u) ? y : ysave;
                        w4 = nw4; k4 = nk4; b4 = nb4; r4 = nr4; wa4 = nwa4; v = nv; cc = ncc;
                    }
                    yw[(t16 + lane15) * 16 + rrow] = ysave;
                }
            }
            __syncthreads();
        }
        if (is_prep) RW_YSTORE(NCH - 1);
        __syncthreads();
#undef RW_PREP
#undef RW_YSTORE
    }
}

constexpr int CK_TS = 72, CK_TB = 64 * CK_TS;
__device__ __forceinline__ void tr_a2(unsigned a, bf16x8& f0, bf16x8& f1) {
    s16x4 l0, h0, l1, h1;
    asm volatile("ds_read_b64_tr_b16 %0, %4\n\tds_read_b64_tr_b16 %1, %4 offset:576\n\tds_read_b64_tr_b16 %2, %4 offset:4608\n\tds_read_b64_tr_b16 %3, %4 offset:5184\n\ts_waitcnt lgkmcnt(0)"
                 : "=&v"(l0), "=&v"(h0), "=&v"(l1), "=&v"(h1) : "v"(a) : "memory");
    f0 = __builtin_shufflevector(l0, h0, 0, 1, 2, 3, 4, 5, 6, 7); f1 = __builtin_shufflevector(l1, h1, 0, 1, 2, 3, 4, 5, 6, 7);
}
__device__ __forceinline__ void tr_b4(unsigned a, bf16x8& f00, bf16x8& f01, bf16x8& f10, bf16x8& f11) {
    s16x4 l0, h0, l1, h1, l2, h2, l3, h3;
    asm volatile("ds_read_b64_tr_b16 %0, %8\n\tds_read_b64_tr_b16 %1, %8 offset:576\n\tds_read_b64_tr_b16 %2, %8 offset:4608\n\tds_read_b64_tr_b16 %3, %8 offset:5184\n\t"
                 "ds_read_b64_tr_b16 %4, %8 offset:32\n\tds_read_b64_tr_b16 %5, %8 offset:608\n\tds_read_b64_tr_b16 %6, %8 offset:4640\n\tds_read_b64_tr_b16 %7, %8 offset:5216\n\ts_waitcnt lgkmcnt(0)"
                 : "=&v"(l0), "=&v"(h0), "=&v"(l1), "=&v"(h1), "=&v"(l2), "=&v"(h2), "=&v"(l3), "=&v"(h3) : "v"(a) : "memory");
    f00 = __builtin_shufflevector(l0, h0, 0, 1, 2, 3, 4, 5, 6, 7); f01 = __builtin_shufflevector(l1, h1, 0, 1, 2, 3, 4, 5, 6, 7);
    f10 = __builtin_shufflevector(l2, h2, 0, 1, 2, 3, 4, 5, 6, 7); f11 = __builtin_shufflevector(l3, h3, 0, 1, 2, 3, 4, 5, 6, 7);
}
template <int PA, int QA, int MASK, int NINIT, int NPAIR, int POST>
__device__ __forceinline__ void mm64(LAS bf16* X, const LAS bf16* P, const LAS bf16* Q, const LAS bf16* P2, const LAS bf16* Q2, const LAS bf16* E1, const LAS bf16* E2,
                                     const LAS float* cscale, const LAS float* wc, int w, int lane) {
    const int r = lane & 15, q = lane >> 4, Ct = w >> 1, Rt0 = 2 * (w & 1);
    const int i16 = lane & 15, qq = i16 >> 2, p4 = i16 & 3;
    const int troff = ((8 * q + qq) * CK_TS + 4 * p4) * 2;
    f32x4 acc[2];
#pragma unroll
    for (int i = 0; i < 2; ++i) {
        const int R = 16 * (Rt0 + i) + r;
        if (NINIT == 0) acc[i] = (f32x4){0.f, 0.f, 0.f, 0.f};
        else { const v2u e1 = *(const LAS v2u*)(E1 + R * CK_TS + 16 * Ct + 4 * q); acc[i] = (f32x4){bflo(e1.x), bfhi(e1.x), bflo(e1.y), bfhi(e1.y)};
            if (NINIT == 2) { const v2u e2 = *(const LAS v2u*)(E2 + R * CK_TS + 16 * Ct + 4 * q); acc[i] += (f32x4){bflo(e2.x), bfhi(e2.x), bflo(e2.y), bfhi(e2.y)}; } }
    }
#pragma unroll
    for (int pr = 0; pr < NPAIR; ++pr) {
        const LAS bf16* Pp = pr == 0 ? P : P2; const LAS bf16* Qp = pr == 0 ? Q : Q2;
        bf16x8 af[2], bfr[2][2];
        if (PA == 0) {
#pragma unroll
            for (int i = 0; i < 2; ++i)
#pragma unroll
                for (int ks = 0; ks < 2; ++ks) bfr[i][ks] = *(const LAS bf16x8*)(Pp + (16 * (Rt0 + i) + r) * CK_TS + 32 * ks + 8 * q);
        }
        if (QA == 1) {
#pragma unroll
            for (int ks = 0; ks < 2; ++ks) af[ks] = *(const LAS bf16x8*)(Qp + (16 * Ct + r) * CK_TS + 32 * ks + 8 * q);
        } else tr_a2((unsigned)(size_t)Qp + (unsigned)(troff + 32 * Ct), af[0], af[1]);
        if (PA == 1) tr_b4((unsigned)(size_t)Pp + (unsigned)(troff + 32 * Rt0), bfr[0][0], bfr[0][1], bfr[1][0], bfr[1][1]);
#pragma unroll
        for (int ks = 0; ks < 2; ++ks)
#pragma unroll
            for (int i = 0; i < 2; ++i) acc[i] = __builtin_amdgcn_mfma_f32_16x16x32_bf16(af[ks], bfr[i][ks], acc[i], 0, 0, 0);
    }
#pragma unroll
    for (int i = 0; i < 2; ++i) {
        const int R = 16 * (Rt0 + i) + r;
        float v[4];
#pragma unroll
        for (int e = 0; e < 4; ++e) { const int C = 16 * Ct + 4 * q + e; float x = acc[i][e];
            if (MASK == 1) x = (C < R) ? x : 0.f;
            if (MASK == 2) x = (C <= R) ? x : 0.f;
            if (POST >= 1) x *= cscale[C];
            if (POST == 2) x += (C == R) ? wc[C] : 0.f;
            v[e] = x; }
        v2u o; o.x = pk2c(v[0], v[1]); o.y = pk2c(v[2], v[3]);
        *(LAS v2u*)(X + R * CK_TS + 16 * Ct + 4 * q) = o;
    }
}

template <int PA, int QA, int MASK, int NINIT, int NPAIR, int POST>
__device__ __forceinline__ void mm64h(LAS bf16* X, const LAS bf16* P, const LAS bf16* Q, const LAS bf16* P2, const LAS bf16* Q2, const LAS bf16* E1, const LAS bf16* E2,
                                      const LAS float* cscale, const LAS float* wc, int ws, int lane) {
    const int r = lane & 15, q = lane >> 4, Cb = ws >> 1, Rb = ws & 1;
    const int i16 = lane & 15, qq = i16 >> 2, p4 = i16 & 3;
    const int troff = ((8 * q + qq) * CK_TS + 4 * p4) * 2;
    f32x4 acc[2][2];
#pragma unroll
    for (int ci = 0; ci < 2; ++ci)
#pragma unroll
        for (int ri = 0; ri < 2; ++ri) {
            const int R = 16 * (2 * Rb + ri) + r, C0 = 16 * (2 * Cb + ci) + 4 * q;
            if (NINIT == 0) acc[ci][ri] = (f32x4){0.f, 0.f, 0.f, 0.f};
            else { const v2u e1 = *(const LAS v2u*)(E1 + R * CK_TS + C0); acc[ci][ri] = (f32x4){bflo(e1.x), bfhi(e1.x), bflo(e1.y), bfhi(e1.y)};
                if (NINIT == 2) { const v2u e2 = *(const LAS v2u*)(E2 + R * CK_TS + C0); acc[ci][ri] += (f32x4){bflo(e2.x), bfhi(e2.x), bflo(e2.y), bfhi(e2.y)}; } }
        }
#pragma unroll
    for (int pr = 0; pr < NPAIR; ++pr) {
        const LAS bf16* Pp = pr == 0 ? P : P2; const LAS bf16* Qp = pr == 0 ? Q : Q2;
        bf16x8 af[2][2], bfr[2][2];
        if (PA == 0) {
#pragma unroll
            for (int ri = 0; ri < 2; ++ri)
#pragma unroll
                for (int ks = 0; ks < 2; ++ks) bfr[ri][ks] = *(const LAS bf16x8*)(Pp + (16 * (2 * Rb + ri) + r) * CK_TS + 32 * ks + 8 * q);
        }
        if (QA == 1) {
#pragma unroll
            for (int ci = 0; ci < 2; ++ci)
#pragma unroll
                for (int ks = 0; ks < 2; ++ks) af[ci][ks] = *(const LAS bf16x8*)(Qp + (16 * (2 * Cb + ci) + r) * CK_TS + 32 * ks + 8 * q);
        } else tr_b4((unsigned)(size_t)Qp + (unsigned)(troff + 64 * Cb), af[0][0], af[0][1], af[1][0], af[1][1]);
        if (PA == 1) tr_b4((unsigned)(size_t)Pp + (unsigned)(troff + 64 * Rb), bfr[0][0], bfr[0][1], bfr[1][0], bfr[1][1]);
#pragma unroll
        for (int ks = 0; ks < 2; ++ks)
#pragma unroll
            for (int ci = 0; ci < 2; ++ci)
#pragma unroll
                for (int ri = 0; ri < 2; ++ri) acc[ci][ri] = __builtin_amdgcn_mfma_f32_16x16x32_bf16(af[ci][ks], bfr[ri][ks], acc[ci][ri], 0, 0, 0);
    }
#pragma unroll
    for (int ci = 0; ci < 2; ++ci)
#pragma unroll
        for (int ri = 0; ri < 2; ++ri) {
            const int R = 16 * (2 * Rb + ri) + r;
            float v[4];
#pragma unroll
            for (int e = 0; e < 4; ++e) { const int C = 16 * (2 * Cb + ci) + 4 * q + e; float x = acc[ci][ri][e];
                if (MASK == 1) x = (C < R) ? x : 0.f;
                if (MASK == 2) x = (C <= R) ? x : 0.f;
                if (POST >= 1) x *= cscale[C];
                if (POST == 2) x += (C == R) ? wc[C] : 0.f;
                v[e] = x; }
            v2u o; o.x = pk2c(v[0], v[1]); o.y = pk2c(v[2], v[3]);
            *(LAS v2u*)(X + R * CK_TS + 16 * (2 * Cb + ci) + 4 * q) = o;
        }
}

__device__ __forceinline__ void phase_rwkv_chunk_par(const Ctx& c, KArgs& a, int l, int hb) {
    unsigned char* ws = a.ws;
    bf16* PR = (bf16*)(ws + WS_OV + OV_PR);
    bf16* ELOG = (bf16*)(ws + WS_OV + OV_ELOG);
    const bf16* ASIG = (const bf16*)(ws + WS_OV + OV_ASIG);
    const bf16* VS = l == 0 ? (const bf16*)(ws + WS_VF) + (size_t)hb * MH * D : (const bf16*)(ws + WS_OV + OV_VMIX);
    bf16* Y = (bf16*)(ws + WS_OV + OV_YA);
    bf16* SLB = (bf16*)(ws + WS_OV + OV_AL);
    const float* mu = a.in[I_MU] + (size_t)l * RW_PROJ;
    const float* k_k = a.in[I_KK] + (size_t)l * D; const float* k_a = a.in[I_KA] + (size_t)l * D; const float* rk_ = a.in[I_RK] + (size_t)l * D;
    float* BON = (float*)(ws + WS_OV + OV_BON);
    LAS bf16* tile = (LAS bf16*)c.lds;
    enum { tA = 0, tR, tBt, tKt, tBh, tKh, tV, tNab, tNak, tNrb, tNrk, tM0, tM1, tP1, tX1, NT };
#define TL(i) (tile + (i) * CK_TB)
    LAS float* cscale = (LAS float*)(tile + NT * CK_TB);
    LAS float* wcv = cscale + 64;
    LAS float* SCR = (LAS float*)TL(tM0);
    LAS float* SEGT = SCR + 64 * 64;
    const int tid = c.tid, lane = c.lane, w = c.wave;
    const int tt = tid >> 3, l8 = tid & 7, pc = l8 * 8;
    v4u qr, qk, qrp, qkp, qas, qel, qv;
#define CK_LOAD(un) do { const int b_ = (un) >> 10, h_ = ((un) >> 6) & 15, ch_ = (un) & 63; const int t_ = ch_ * 64 + tt; \
        const size_t mm = (size_t)b_ * T + (size_t)t_; const bf16* row = PR + mm * N1P + h_ * 64 + pc; const v4u zr = (v4u){0u, 0u, 0u, 0u}; \
        qr = *(const v4u*)row; qk = *(const v4u*)(row + 1024); qrp = t_ > 0 ? *(const v4u*)(row - N1P) : zr; qkp = t_ > 0 ? *(const v4u*)(row - N1P + 1024) : zr; \
        qas = *(const v4u*)(ASIG + mm * D + h_ * 64 + pc); qel = *(const v4u*)(ELOG + mm * D + h_ * 64 + pc); qv = *(const v4u*)(VS + mm * D + h_ * 64 + pc); } while (0)
    if (c.bid < 4096) CK_LOAD(c.bid);
    for (int unit = c.bid; unit < 4096; unit += c.G) {
        const int b = unit >> 10, h = (unit >> 6) & 15, ch = unit & 63;
        const size_t m0 = (size_t)b * T + (size_t)ch * 64;
        const int hc = h * 64 + pc;
        for (int rep = 0; rep < (PROBE_DUP == 7 ? 2 : 1); ++rep) {
        if (PROBE_DUP == 7) { CK_LOAD(unit); }
        float r_[8], k_[8], as_[8], el_[8], v_[8], kk_[8], ks_[8];
        {
            float rp_[8], kp_[8];
            unpack8(qr, r_); unpack8(qrp, rp_); unpack8(qk, k_); unpack8(qkp, kp_); unpack8(qas, as_); unpack8(qel, el_); unpack8(qv, v_);
            if (PROBE_DUP != 7 && unit + c.G < 4096) CK_LOAD(unit + c.G);
            float s1 = 0.f;
#pragma unroll
            for (int e = 0; e < 8; ++e) { r_[e] = r_[e] + (rp_[e] - r_[e]) * mu[hc + e]; ks_[e] = k_[e] + (kp_[e] - k_[e]) * mu[1024 + hc + e]; kk_[e] = ks_[e] * k_k[hc + e]; s1 += kk_[e] * kk_[e]; }
            s1 = sum8(s1);
            const float i1 = rsqrtf(s1 + 1e-12f);
#pragma unroll
            for (int e = 0; e < 8; ++e) { kk_[e] *= i1; k_[e] = ks_[e] * (1.f + (as_[e] - 1.f) * k_a[hc + e]); }
            { float bn = 0.f;
#pragma unroll
              for (int e = 0; e < 8; ++e) bn += r_[e] * k_[e] * rk_[hc + e];
              bn = sum8(bn);
              if (l8 == 0) BON[(m0 + tt) * 16 + h] = bn; }
            *(LAS f32x4*)(SCR + tt * 64 + pc) = (f32x4){el_[0], el_[1], el_[2], el_[3]}; *(LAS f32x4*)(SCR + tt * 64 + pc + 4) = (f32x4){el_[4], el_[5], el_[6], el_[7]};
        }
        lds_barrier();
        {
            const int col = tid & 63, seg = tid >> 6; float s = 0.f;
#pragma unroll
            for (int i = 0; i < 8; ++i) { s += SCR[(8 * seg + i) * 64 + col]; SCR[(8 * seg + i) * 64 + col] = s; }
            SEGT[seg * 64 + col] = s;
        }
        lds_barrier();
        {
            const int col = tid & 63, seg = tid >> 6; float pre = 0.f;
#pragma unroll
            for (int s2 = 0; s2 < 7; ++s2) pre += (s2 < seg) ? SEGT[s2 * 64 + col] : 0.f;
#pragma unroll
            for (int i = 0; i < 8; ++i) SCR[(8 * seg + i) * 64 + col] += pre;
        }
        lds_barrier();
        {
            float L[8], Lr[8], Le[8];
            { const f32x4 x0 = *(const LAS f32x4*)(SCR + tt * 64 + pc), x1 = *(const LAS f32x4*)(SCR + tt * 64 + pc + 4);
              const f32x4 y0 = *(const LAS f32x4*)(SCR + 31 * 64 + pc), y1 = *(const LAS f32x4*)(SCR + 31 * 64 + pc + 4);
              const f32x4 z0 = *(const LAS f32x4*)(SCR + 63 * 64 + pc), z1 = *(const LAS f32x4*)(SCR + 63 * 64 + pc + 4);
#pragma unroll
              for (int e = 0; e < 4; ++e) { L[e] = x0[e]; L[4 + e] = x1[e]; Lr[e] = y0[e]; Lr[4 + e] = y1[e]; Le[e] = z0[e]; Le[4 + e] = z1[e]; } }
            float oA[8], oR[8], oBt[8], oKt[8], oBh[8], oKh[8];
#pragma unroll
            for (int e = 0; e < 8; ++e) {
                const float ea = __expf(L[e] - el_[e] - Lr[e]), er = __expf(L[e] - Lr[e]), eb = __expf(Lr[e] - L[e]), eh = __expf(Le[e] - L[e]);
                const float bb = kk_[e] * as_[e];
                oA[e] = -kk_[e] * ea; oR[e] = r_[e] * er; oBt[e] = bb * eb; oKt[e] = k_[e] * eb; oBh[e] = bb * eh; oKh[e] = k_[e] * eh;
            }
            const int o = tt * CK_TS + pc;
            *(LAS v4u*)(TL(tA) + o) = pack8(oA); *(LAS v4u*)(TL(tR) + o) = pack8(oR); *(LAS v4u*)(TL(tBt) + o) = pack8(oBt); *(LAS v4u*)(TL(tKt) + o) = pack8(oKt);
            *(LAS v4u*)(TL(tBh) + o) = pack8(oBh); *(LAS v4u*)(TL(tKh) + o) = pack8(oKh); *(LAS v4u*)(TL(tV) + o) = pack8(v_);
            if (tt == 0) {
#pragma unroll
                for (int e = 0; e < 8; ++e) { cscale[pc + e] = __expf(Lr[e]); wcv[pc + e] = __expf(Le[e]); }
            }
        }
        lds_barrier();
        const LAS bf16* Z = nullptr;
        const int wg_ = w >> 2, ws_ = w & 3;
        if (wg_ == 0) { mm64h<0, 1, 1, 0, 1, 0>(TL(tNab), TL(tA), TL(tBt), Z, Z, Z, Z, cscale, wcv, ws_, lane);
                        mm64h<0, 1, 1, 0, 1, 0>(TL(tNak), TL(tA), TL(tKt), Z, Z, Z, Z, cscale, wcv, ws_, lane); }
        else          { mm64h<0, 1, 2, 0, 1, 0>(TL(tNrb), TL(tR), TL(tBt), Z, Z, Z, Z, cscale, wcv, ws_, lane);
                        mm64h<0, 1, 2, 0, 1, 0>(TL(tNrk), TL(tR), TL(tKt), Z, Z, Z, Z, cscale, wcv, ws_, lane); }
        lds_barrier();
        if (wg_ == 0) mm64h<0, 0, 0, 0, 1, 0>(TL(tM0), TL(tNab), TL(tNab), Z, Z, Z, Z, cscale, wcv, ws_, lane);
        else          mm64h<0, 0, 0, 0, 1, 0>(TL(tX1), TL(tNak), TL(tV), Z, Z, Z, Z, cscale, wcv, ws_, lane);
        lds_barrier();
        if (wg_ == 0) mm64h<0, 0, 0, 2, 1, 0>(TL(tP1), TL(tNab), TL(tM0), Z, Z, TL(tNab), TL(tM0), cscale, wcv, ws_, lane);
        else          mm64h<0, 0, 0, 0, 1, 0>(TL(tM1), TL(tM0), TL(tM0), Z, Z, Z, Z, cscale, wcv, ws_, lane);
        lds_barrier();
        if (wg_ == 0) mm64h<0, 0, 0, 2, 1, 0>(TL(tNab), TL(tP1), TL(tM1), Z, Z, TL(tP1), TL(tM1), cscale, wcv, ws_, lane);
        else          mm64h<0, 0, 0, 0, 1, 0>(TL(tM0), TL(tM1), TL(tM1), Z, Z, Z, Z, cscale, wcv, ws_, lane);
        lds_barrier();
        if (wg_ == 0) mm64h<0, 0, 0, 2, 1, 0>(TL(tP1), TL(tNab), TL(tM0), Z, Z, TL(tNab), TL(tM0), cscale, wcv, ws_, lane);
        else          mm64h<0, 0, 0, 0, 1, 0>(TL(tM1), TL(tM0), TL(tM0), Z, Z, Z, Z, cscale, wcv, ws_, lane);
        lds_barrier();
        if (wg_ == 0) mm64h<0, 0, 0, 2, 1, 0>(TL(tNab), TL(tP1), TL(tM1), Z, Z, TL(tP1), TL(tM1), cscale, wcv, ws_, lane);
        else          mm64h<0, 0, 0, 0, 1, 0>(TL(tM0), TL(tM1), TL(tM1), Z, Z, Z, Z, cscale, wcv, ws_, lane);
        lds_barrier();
        mm64<0, 0, 0, 2, 1, 0>(TL(tP1), TL(tNab), TL(tM0), Z, Z, TL(tNab), TL(tM0), cscale, wcv, w, lane);
        lds_barrier();
        if (wg_ == 0) mm64h<0, 0, 0, 1, 1, 0>(TL(tBt), TL(tP1), TL(tA), Z, Z, TL(tA), Z, cscale, wcv, ws_, lane);
        else          mm64h<0, 0, 0, 1, 1, 0>(TL(tKt), TL(tP1), TL(tX1), Z, Z, TL(tX1), Z, cscale, wcv, ws_, lane);
        lds_barrier();
        if (wg_ == 0) { mm64h<0, 0, 0, 1, 1, 1>(TL(tM0), TL(tNrb), TL(tBt), Z, Z, TL(tR), Z, cscale, wcv, ws_, lane);
                        mm64h<0, 0, 0, 0, 2, 0>(TL(tM1), TL(tNrb), TL(tKt), TL(tNrk), TL(tV), Z, Z, cscale, wcv, ws_, lane); }
        else          { mm64h<1, 0, 0, 0, 1, 2>(TL(tNab), TL(tBh), TL(tBt), Z, Z, Z, Z, cscale, wcv, ws_, lane);
                        mm64h<1, 0, 0, 0, 2, 0>(TL(tX1), TL(tKt), TL(tBh), TL(tV), TL(tKh), Z, Z, cscale, wcv, ws_, lane); }
        lds_barrier();
        }
        {
            const size_t grow = m0 + tt;
            *(v4u*)(ELOG + grow * D + hc) = *(const LAS v4u*)(TL(tM0) + tt * CK_TS + pc);
            *(v4u*)(Y + grow * D + hc) = *(const LAS v4u*)(TL(tM1) + tt * CK_TS + pc);
            *(v4u*)(PR + grow * N1P + 2048 + hc) = *(const LAS v4u*)(TL(tNab) + tt * CK_TS + pc);
            *(v4u*)(SLB + grow * D + hc) = *(const LAS v4u*)(TL(tX1) + tt * CK_TS + pc);
        }
        lds_barrier();
    }
#undef TL
#undef CK_LOAD
}

struct SeqOps { v4u g0, g1, p0, p1; v2u sl, yl; };
__device__ __forceinline__ void phase_rwkv_chunk_seq(const Ctx& c, KArgs& a, const bool commit = true) {
    unsigned char* ws = a.ws;
    const bf16* PR = (const bf16*)(ws + WS_OV + OV_PR);
    const bf16* RP = (const bf16*)(ws + WS_OV + OV_ELOG);
    bf16* Y = (bf16*)(ws + WS_OV + OV_YA);
    const bf16* SLB = (const bf16*)(ws + WS_OV + OV_AL);
    LAS bf16* SL = (LAS bf16*)c.lds;
    const int tid = c.tid, lane = c.lane, w = c.wave, r = lane & 15, q = lane >> 4;
    constexpr int PF = 4;
    for (int unit = c.bid; unit < 256; unit += c.G) {
        const int b = unit >> 6, h = (unit >> 2) & 15, vq = unit & 3;
        for (int e = tid; e < 2 * 16 * CK_TS / 2; e += 512) ((LAS unsigned*)SL)[e] = 0u;
        __syncthreads();
        if (w < 4) {
            const size_t rowG = (size_t)b * T + 16 * w + r;
            const size_t rowS = (size_t)b * T + vq * 16 + r;
            SeqOps ops[PF];
#define SQ_LOAD(dst, chn) do { const size_t o_ = (size_t)(chn) * 64; \
                dst.g0 = *(const v4u*)(PR + (rowG + o_) * N1P + 2048 + h * 64 + 8 * q); dst.g1 = *(const v4u*)(PR + (rowG + o_) * N1P + 2048 + h * 64 + 32 + 8 * q); \
                dst.p0 = *(const v4u*)(RP + (rowG + o_) * D + h * 64 + 8 * q); dst.p1 = *(const v4u*)(RP + (rowG + o_) * D + h * 64 + 32 + 8 * q); \
                dst.sl = *(const v2u*)(SLB + (rowS + o_) * D + h * 64 + 16 * w + 4 * q); dst.yl = *(const v2u*)(Y + (rowG + o_) * D + h * 64 + vq * 16 + 4 * q); } while (0)
#pragma unroll
            for (int i = 0; i < PF; ++i) SQ_LOAD(ops[i], i);
            for (int ch0 = 0; ch0 < 64; ch0 += PF) {
#pragma unroll
                for (int i = 0; i < PF; ++i) {
                    const int ch = ch0 + i;
                    const SeqOps cur = ops[i];
                    if (ch + PF < 64) SQ_LOAD(ops[i], ch + PF);
                    const LAS bf16* Sc = SL + (i & 1) * 16 * CK_TS; LAS bf16* Sn = SL + ((i + 1) & 1) * 16 * CK_TS;
                    const bf16x8 s0 = *(const LAS bf16x8*)(Sc + r * CK_TS + 8 * q), s1 = *(const LAS bf16x8*)(Sc + r * CK_TS + 32 + 8 * q);
                    f32x4 accS = (f32x4){bflo(cur.sl.x), bfhi(cur.sl.x), bflo(cur.sl.y), bfhi(cur.sl.y)};
                    accS = __builtin_amdgcn_mfma_f32_16x16x32_bf16(__builtin_bit_cast(bf16x8, cur.g0), s0, accS, 0, 0, 0);
                    accS = __builtin_amdgcn_mfma_f32_16x16x32_bf16(__builtin_bit_cast(bf16x8, cur.g1), s1, accS, 0, 0, 0);
                    f32x4 accY = (f32x4){bflo(cur.yl.x), bfhi(cur.yl.x), bflo(cur.yl.y), bfhi(cur.yl.y)};
                    accY = __builtin_amdgcn_mfma_f32_16x16x32_bf16(s0, __builtin_bit_cast(bf16x8, cur.p0), accY, 0, 0, 0);
                    accY = __builtin_amdgcn_mfma_f32_16x16x32_bf16(s1, __builtin_bit_cast(bf16x8, cur.p1), accY, 0, 0, 0);
                    { v2u o; o.x = pk2c(accS[0], accS[1]); o.y = pk2c(accS[2], accS[3]); *(LAS v2u*)(Sn + r * CK_TS + 16 * w + 4 * q) = o; }
                    if (commit || accY[0] == 123456.789f) { v2u o; o.x = pk2c(accY[0], accY[1]); o.y = pk2c(accY[2], accY[3]); *(v2u*)(Y + (rowG + (size_t)ch * 64) * D + h * 64 + vq * 16 + 4 * q) = o; }
                    lds_barrier();
                }
            }
#undef SQ_LOAD
        } else {
            for (int ch = 0; ch < 64; ++ch) lds_barrier();
        }
        __syncthreads();
    }
}

__device__ __forceinline__ void phase_rwkv_post(const Ctx& c, KArgs& a, int l, int hb) {
    unsigned char* ws = a.ws;
    const bf16* GG = (const bf16*)(ws + WS_OV + OV_GG);
    const bf16* VS = l == 0 ? (const bf16*)(ws + WS_VF) + (size_t)hb * MH * D : (const bf16*)(ws + WS_OV + OV_VMIX);
    const float* BON = (const float*)(ws + WS_OV + OV_BON);
    bf16* Y = (bf16*)(ws + WS_OV + OV_YA);
    const int lane = c.lane, c0 = 16 * lane;
    float lw[16], lb[16];
#pragma unroll
    for (int e = 0; e < 16; ++e) { lw[e] = a.in[I_LNW][(size_t)l * D + c0 + e]; lb[e] = a.in[I_LNB][(size_t)l * D + c0 + e]; }
    const int gw = c.bid * 8 + c.wave, NGW = c.G * 8;
    v4u ny0, ny1, nv0, nv1, ng0, ng1; float nbon = 0.f;
#define RP_LOAD(mm) do { ny0 = *(const v4u*)(Y + (size_t)(mm) * D + c0); ny1 = *(const v4u*)(Y + (size_t)(mm) * D + c0 + 8); nv0 = *(const v4u*)(VS + (size_t)(mm) * D + c0); nv1 = *(const v4u*)(VS + (size_t)(mm) * D + c0 + 8); \
        ng0 = *(const v4u*)(GG + (size_t)(mm) * D + c0); ng1 = *(const v4u*)(GG + (size_t)(mm) * D + c0 + 8); nbon = BON[(size_t)(mm) * 16 + (lane >> 2)]; } while (0)
    if (gw < MH) RP_LOAD(gw);
    for (int m = gw; m < MH; m += NGW) {
        float y[16], v[16], g[16], t8[8];
        const v4u cy0 = ny0, cy1 = ny1, cv0 = nv0, cv1 = nv1, cg0 = ng0, cg1 = ng1; const float bon = nbon;
        if (m + NGW < MH) RP_LOAD(m + NGW);
#define UP16(dst, qa, qb) do { unpack8(qa, t8); _Pragma("unroll") for (int e = 0; e < 8; ++e) dst[e] = t8[e]; unpack8(qb, t8); _Pragma("unroll") for (int e = 0; e < 8; ++e) dst[8 + e] = t8[e]; } while (0)
        UP16(y, cy0, cy1); UP16(v, cv0, cv1); UP16(g, cg0, cg1);
#undef UP16
        float s1 = 0.f;
#pragma unroll
        for (int e = 0; e < 16; ++e) s1 += y[e];
        s1 = sum4(s1);
        const float mean = s1 * (1.f / 64.f);
        float s2 = 0.f;
#pragma unroll
        for (int e = 0; e < 16; ++e) { const float d = y[e] - mean; s2 += d * d; }
        s2 = sum4(s2);
        const float rstd = rsqrtf(s2 * (1.f / 64.f) + 64e-5f);
        float o[16];
#pragma unroll
        for (int e = 0; e < 16; ++e) o[e] = ((y[e] - mean) * rstd * lw[e] + lb[e] + bon * v[e]) * g[e];
        v4u o0, o1;
        o0.x = pk2(o[0], o[1]); o0.y = pk2(o[2], o[3]); o0.z = pk2(o[4], o[5]); o0.w = pk2(o[6], o[7]);
        o1.x = pk2(o[8], o[9]); o1.y = pk2(o[10], o[11]); o1.z = pk2(o[12], o[13]); o1.w = pk2(o[14], o[15]);
        *(v4u*)(Y + (size_t)m * D + c0) = o0; *(v4u*)(Y + (size_t)m * D + c0 + 8) = o1;
    }
}

__device__ __forceinline__ void phase_ssd_conv(const Ctx& c, KArgs& a, int l) {
    unsigned char* ws = a.ws;
    const bf16* PS = (const bf16*)(ws + WS_OV + OV_PS);
    bf16* XBC = (bf16*)(ws + WS_OV + OV_XBC);
    float* DT = (float*)(ws + WS_OV + OV_DT); float* DA = (float*)(ws + WS_OV + OV_DA);
    const float* cw = a.in[I_CW] + (size_t)l * 4 * 3072; const float* cb = a.in[I_CB] + (size_t)l * 3072;
    const int gw = c.bid * 8 + c.wave, NGW = c.G * 8, lane = c.lane;
    constexpr int RUN = 16, NRUN = MH / RUN;
    for (int it = gw; it < 2 * NRUN; it += NGW) {
        const int cb_ = 4 + (it & 1), run = it >> 1, ch0 = cb_ * 512 + lane * 8, m0 = run * RUN;
        float w[4][8], bias[8];
#pragma unroll
        for (int j = 0; j < 4; ++j)
#pragma unroll
            for (int e = 0; e < 8; ++e) w[j][e] = cw[j * 3072 + ch0 + e];
#pragma unroll
        for (int e = 0; e < 8; ++e) bias[e] = cb[ch0 + e];
        float x0[8], x1[8], x2[8], x3[8];
        const bf16* base = PS + (size_t)m0 * N2P + 2048 + ch0;
        const int t0 = m0 & (T - 1);
        if (t0 >= 3) { unpack8(*(const v4u*)(base - 3 * N2P), x0); unpack8(*(const v4u*)(base - 2 * N2P), x1); unpack8(*(const v4u*)(base - N2P), x2); }
        else {
#pragma unroll
            for (int e = 0; e < 8; ++e) { x0[e] = 0.f; x1[e] = 0.f; x2[e] = 0.f; }
        }
        v4u nx = *(const v4u*)base;
#pragma unroll 4
        for (int i = 0; i < RUN; ++i) {
            unpack8(nx, x3);
            if (i + 1 < RUN) nx = *(const v4u*)(base + (size_t)(i + 1) * N2P);
            float o[8];
#pragma unroll
            for (int e = 0; e < 8; ++e) { const float y = bias[e] + x0[e] * w[0][e] + x1[e] * w[1][e] + x2[e] * w[2][e] + x3[e] * w[3][e]; o[e] = siluf_(y); x0[e] = x1[e]; x1[e] = x2[e]; x2[e] = x3[e]; }
            *(v4u*)(XBC + (size_t)(m0 + i) * 3072 + ch0) = pack8(o);
        }
    }
}

__device__ __forceinline__ void tr_bm2(unsigned a, bf16x8& f0, bf16x8& f1) {
    s16x4 l0, h0, l1, h1;
    asm volatile("ds_read_b64_tr_b16 %0, %4\n\tds_read_b64_tr_b16 %1, %4 offset:1088\n\tds_read_b64_tr_b16 %2, %4 offset:8704\n\tds_read_b64_tr_b16 %3, %4 offset:9792\n\ts_waitcnt lgkmcnt(0)"
                 : "=&v"(l0), "=&v"(h0), "=&v"(l1), "=&v"(h1) : "v"(a) : "memory");
    f0 = __builtin_shufflevector(l0, h0, 0, 1, 2, 3, 4, 5, 6, 7); f1 = __builtin_shufflevector(l1, h1, 0, 1, 2, 3, 4, 5, 6, 7);
}
__device__ __forceinline__ void tr_x2(unsigned a, bf16x8& f0, bf16x8& f1) {
    s16x4 l0, h0, l1, h1;
    asm volatile("ds_read_b64_tr_b16 %0, %4\n\tds_read_b64_tr_b16 %1, %4 offset:320\n\tds_read_b64_tr_b16 %2, %4 offset:2560\n\tds_read_b64_tr_b16 %3, %4 offset:2880\n\ts_waitcnt lgkmcnt(0)"
                 : "=&v"(l0), "=&v"(h0), "=&v"(l1), "=&v"(h1) : "v"(a) : "memory");
    f0 = __builtin_shufflevector(l0, h0, 0, 1, 2, 3, 4, 5, 6, 7); f1 = __builtin_shufflevector(l1, h1, 0, 1, 2, 3, 4, 5, 6, 7);
}
__device__ __forceinline__ void tr_x4(unsigned a, bf16x8& f00, bf16x8& f01, bf16x8& f10, bf16x8& f11) {
    s16x4 l0, h0, l1, h1, l2, h2, l3, h3;
    asm volatile("ds_read_b64_tr_b16 %0, %8\n\tds_read_b64_tr_b16 %1, %8 offset:320\n\tds_read_b64_tr_b16 %2, %8 offset:2560\n\tds_read_b64_tr_b16 %3, %8 offset:2880\n\t"
                 "ds_read_b64_tr_b16 %4, %8 offset:32\n\tds_read_b64_tr_b16 %5, %8 offset:352\n\tds_read_b64_tr_b16 %6, %8 offset:2592\n\tds_read_b64_tr_b16 %7, %8 offset:2912\n\ts_waitcnt lgkmcnt(0)"
                 : "=&v"(l0), "=&v"(h0), "=&v"(l1), "=&v"(h1), "=&v"(l2), "=&v"(h2), "=&v"(l3), "=&v"(h3) : "v"(a) : "memory");
    f00 = __builtin_shufflevector(l0, h0, 0, 1, 2, 3, 4, 5, 6, 7); f01 = __builtin_shufflevector(l1, h1, 0, 1, 2, 3, 4, 5, 6, 7);
    f10 = __builtin_shufflevector(l2, h2, 0, 1, 2, 3, 4, 5, 6, 7); f11 = __builtin_shufflevector(l3, h3, 0, 1, 2, 3, 4, 5, 6, 7);
}
__device__ __forceinline__ void phase_ssd_scan(const Ctx& c, KArgs& a, int l) {
    unsigned char* ws = a.ws;
    const bf16* PS = (const bf16*)(ws + WS_OV + OV_PS);
    bf16* XBC = (bf16*)(ws + WS_OV + OV_XBC);
    const float* cw = a.in[I_CW] + (size_t)l * 4 * 3072; const float* cb = a.in[I_CB] + (size_t)l * 3072;
    const float* DT = (const float*)(ws + WS_OV + OV_DT); const float* ACS = (const float*)(ws + WS_OV + OV_DA);
    constexpr int SC = 136, SM = 72, SX = 40;
    LAS bf16* Cm = (LAS bf16*)c.lds;
    LAS bf16* Bm = Cm + 64 * SC;
    LAS bf16* Xd = Bm + 64 * SC;
    LAS bf16* Xs = Xd + 64 * SX;
    LAS bf16* Xr = Xs + 64 * SX;
    LAS bf16* MtT = Xr + 64 * SX;
    LAS bf16* SL = MtT + 64 * SM;
    LAS float* acsL = (LAS float*)(SL + 32 * SC);
    const unsigned BmB = (unsigned)(size_t)Bm, XdB = (unsigned)(size_t)Xd, XsB = (unsigned)(size_t)Xs;
    const int tid = c.tid, lane = c.lane, w = c.wave, r = lane & 15, q = lane >> 4;
    const int sj = tid >> 3, sn = (tid & 7) * 16, sp = (tid & 7) * 4;
    const int trq = ((lane & 15) >> 2), trp = lane & 3;
    const unsigned troffB = (unsigned)(((8 * q + trq) * SC + 4 * trp) * 2), troffX = (unsigned)(((8 * q + trq) * SX + 4 * trp) * 2);
    for (int unit = c.bid; unit < 256; unit += c.G) {
        const int b = unit >> 6, h = (unit >> 1) & 31, ph = unit & 1, g = h >> 3;
        const size_t m0 = (size_t)b * T;
        f32x4 st[2] = {(f32x4){0.f, 0.f, 0.f, 0.f}, (f32x4){0.f, 0.f, 0.f, 0.f}};
        for (int e = tid; e < 32 * SC / 2; e += 512) ((LAS unsigned*)SL)[e] = 0u;
        v4u gB0, gB1, gC0, gC1; v2u gX0, gX1, gX2, gX3; float gacs, gacsE, gdt;
        const int chx = h * 64 + ph * 32 + sp; const float Dh = a.in[I_SD][l * 32 + h];
        float cwt[4][4], cbs[4];
#pragma unroll
        for (int e2 = 0; e2 < 4; ++e2) { cbs[e2] = cb[chx + e2];
#pragma unroll
            for (int j = 0; j < 4; ++j) cwt[j][e2] = cw[j * 3072 + chx + e2]; }
#define SS_LOAD(chunk) do { const size_t row = m0 + (size_t)(chunk) * 64 + sj; const bf16* xr = XBC + row * 3072; \
            gB0 = *(const v4u*)(xr + 2048 + g * 128 + sn); gB1 = *(const v4u*)(xr + 2048 + g * 128 + sn + 8); \
            gC0 = *(const v4u*)(xr + 2560 + g * 128 + sn); gC1 = *(const v4u*)(xr + 2560 + g * 128 + sn + 8); \
            { const int t_ = (chunk) * 64 + sj; const bf16* pr_ = PS + row * N2P + 2048 + chx; const v2u z2 = (v2u){0u, 0u}; \
              gX3 = *(const v2u*)pr_; gX2 = t_ >= 1 ? *(const v2u*)(pr_ - N2P) : z2; gX1 = t_ >= 2 ? *(const v2u*)(pr_ - 2 * N2P) : z2; gX0 = t_ >= 3 ? *(const v2u*)(pr_ - 3 * N2P) : z2; } \
            gacs = ACS[row * 32 + h]; gacsE = ACS[(m0 + (size_t)(chunk) * 64 + 63) * 32 + h]; gdt = DT[row * 32 + h]; } while (0)
#define SS_STAGE() do { \
            *(LAS v4u*)(Bm + sj * SC + sn) = gB0; *(LAS v4u*)(Bm + sj * SC + sn + 8) = gB1; *(LAS v4u*)(Cm + sj * SC + sn) = gC0; *(LAS v4u*)(Cm + sj * SC + sn + 8) = gC1; \
            const float sc_ = gdt * __expf(gacsE - gacs); \
            const float r0_[4] = {bflo(gX0.x), bfhi(gX0.x), bflo(gX0.y), bfhi(gX0.y)}, r1_[4] = {bflo(gX1.x), bfhi(gX1.x), bflo(gX1.y), bfhi(gX1.y)}; \
            const float r2_[4] = {bflo(gX2.x), bfhi(gX2.x), bflo(gX2.y), bfhi(gX2.y)}, r3_[4] = {bflo(gX3.x), bfhi(gX3.x), bflo(gX3.y), bfhi(gX3.y)}; \
            float xa_[4]; _Pragma("unroll") for (int e2 = 0; e2 < 4; ++e2) xa_[e2] = siluf_(cbs[e2] + r0_[e2] * cwt[0][e2] + r1_[e2] * cwt[1][e2] + r2_[e2] * cwt[2][e2] + r3_[e2] * cwt[3][e2]); \
            const float x0_ = xa_[0], x1_ = xa_[1], x2_ = xa_[2], x3_ = xa_[3]; \
            v2u o1_, o2_; o1_.x = pk2(x0_ * gdt, x1_ * gdt); o1_.y = pk2(x2_ * gdt, x3_ * gdt); o2_.x = pk2(x0_ * sc_, x1_ * sc_); o2_.y = pk2(x2_ * sc_, x3_ * sc_); \
            *(LAS v2u*)(Xd + sj * SX + sp) = o1_; *(LAS v2u*)(Xs + sj * SX + sp) = o2_; { v2u o3_; o3_.x = pk2(x0_, x1_); o3_.y = pk2(x2_, x3_); *(LAS v2u*)(Xr + sj * SX + sp) = o3_; } \
            if ((tid & 7) == 0) acsL[sj] = gacs; } while (0)
        SS_LOAD(0);
        SS_STAGE();
        __syncthreads();
        for (int ch = 0; ch < T / 64; ++ch) {
            if (ch + 1 < T / 64) SS_LOAD(ch + 1);
            {
                const int jt = w >> 1, it0 = 2 * (w & 1);
                f32x4 acc0 = (f32x4){0.f, 0.f, 0.f, 0.f}, acc1 = acc0;
                if (it0 + 1 >= jt) {
#pragma unroll
                    for (int ks = 0; ks < 4; ++ks) {
                        const bf16x8 af = *(const LAS bf16x8*)(Bm + (16 * jt + r) * SC + 32 * ks + 8 * q);
                        const bf16x8 b0 = *(const LAS bf16x8*)(Cm + (16 * it0 + r) * SC + 32 * ks + 8 * q);
                        const bf16x8 b1 = *(const LAS bf16x8*)(Cm + (16 * (it0 + 1) + r) * SC + 32 * ks + 8 * q);
                        acc0 = __builtin_amdgcn_mfma_f32_16x16x32_bf16(af, b0, acc0, 0, 0, 0);
                        acc1 = __builtin_amdgcn_mfma_f32_16x16x32_bf16(af, b1, acc1, 0, 0, 0);
                    }
                }
                const int i0 = 16 * it0 + r, i1 = i0 + 16;
                const float ai0 = acsL[i0], ai1 = acsL[i1];
                float m0v[4], m1v[4];
#pragma unroll
                for (int e = 0; e < 4; ++e) { const int j = 16 * jt + 4 * q + e; const float aj = acsL[j];
                    m0v[e] = (j <= i0) ? acc0[e] * __expf(ai0 - aj) : 0.f; m1v[e] = (j <= i1) ? acc1[e] * __expf(ai1 - aj) : 0.f; }
                { v2u o0, o1; o0.x = pk2(m0v[0], m0v[1]); o0.y = pk2(m0v[2], m0v[3]); o1.x = pk2(m1v[0], m1v[1]); o1.y = pk2(m1v[2], m1v[3]);
                  *(LAS v2u*)(MtT + i0 * SM + 16 * jt + 4 * q) = o0; *(LAS v2u*)(MtT + i1 * SM + 16 * jt + 4 * q) = o1; }
            }
            lds_barrier();
            {
                const int it = w >> 1, pt = w & 1;
                f32x4 accD = (f32x4){0.f, 0.f, 0.f, 0.f}, accO = accD;
                {
                    bf16x8 xb0, xb1; tr_x2(XdB + troffX + 32u * pt, xb0, xb1);
                    const bf16x8 af0 = *(const LAS bf16x8*)(MtT + (16 * it + r) * SM + 8 * q);
                    accD = __builtin_amdgcn_mfma_f32_16x16x32_bf16(af0, xb0, accD, 0, 0, 0);
                    if (it >= 2) {
                        const bf16x8 af1 = *(const LAS bf16x8*)(MtT + (16 * it + r) * SM + 32 + 8 * q);
                        accD = __builtin_amdgcn_mfma_f32_16x16x32_bf16(af1, xb1, accD, 0, 0, 0);
                    }
                }
#pragma unroll
                for (int ks = 0; ks < 4; ++ks) {
                    const bf16x8 af = *(const LAS bf16x8*)(Cm + (16 * it + r) * SC + 32 * ks + 8 * q);
                    const bf16x8 bf_ = *(const LAS bf16x8*)(SL + (16 * pt + r) * SC + 32 * ks + 8 * q);
                    accO = __builtin_amdgcn_mfma_f32_16x16x32_bf16(af, bf_, accO, 0, 0, 0);
                }
                const int p = 16 * pt + r;
#pragma unroll
                for (int e = 0; e < 4; ++e) { const int i = 16 * it + 4 * q + e; const float y = accD[e] + __expf(acsL[i]) * accO[e] + Dh * bf1(Xr[i * SX + p]);
                    XBC[(m0 + (size_t)ch * 64 + i) * 3072 + h * 64 + ph * 32 + p] = (bf16)f2bf(y); }
            }
            {
                const float dec = __expf(acsL[63]);
                bf16x8 a0, a1, bx[2][2];
                tr_bm2(BmB + troffB + 32u * w, a0, a1);
                tr_x4(XsB + troffX, bx[0][0], bx[0][1], bx[1][0], bx[1][1]);
#pragma unroll
                for (int pt = 0; pt < 2; ++pt) {
                    f32x4 s = st[pt] * dec;
                    s = __builtin_amdgcn_mfma_f32_16x16x32_bf16(a0, bx[pt][0], s, 0, 0, 0);
                    s = __builtin_amdgcn_mfma_f32_16x16x32_bf16(a1, bx[pt][1], s, 0, 0, 0);
                    st[pt] = s;
                }
            }
            lds_barrier();
#pragma unroll
            for (int pt = 0; pt < 2; ++pt) { v2u o; o.x = pk2c(st[pt][0], st[pt][1]); o.y = pk2c(st[pt][2], st[pt][3]);
                *(LAS v2u*)(SL + (16 * pt + r) * SC + 16 * w + 4 * q) = o; }
            if (ch + 1 < T / 64) SS_STAGE();
            lds_barrier();
        }
#undef SS_LOAD
#undef SS_STAGE
    }
}

__device__ __forceinline__ void phase_ssd_post(const Ctx& c, KArgs& a, int l) {
    unsigned char* ws = a.ws;
    bf16* PS = (bf16*)(ws + WS_OV + OV_PS);
    const bf16* XBC = (const bf16*)(ws + WS_OV + OV_XBC);
    const int lane = c.lane, c0 = 32 * lane;
    const float* ng = a.in[I_SNG] + (size_t)l * 2048 + c0;
    const int gw = c.bid * 8 + c.wave, NGW = c.G * 8;
    v4u nyy[4], nzz[4];
#define SP_LOAD(mm) do { _Pragma("unroll") for (int q = 0; q < 4; ++q) { nyy[q] = *(const v4u*)(XBC + (size_t)(mm) * 3072 + c0 + 8 * q); nzz[q] = *(const v4u*)(PS + (size_t)(mm) * N2P + c0 + 8 * q); } } while (0)
    if (gw < MH) SP_LOAD(gw);
    for (int m = gw; m < MH; m += NGW) {
        float y[32]; float ss = 0.f;
        v4u cyy[4], czz[4];
#pragma unroll
        for (int q = 0; q < 4; ++q) { cyy[q] = nyy[q]; czz[q] = nzz[q]; }
        if (m + NGW < MH) SP_LOAD(m + NGW);
#pragma unroll
        for (int q = 0; q < 4; ++q) {
            float yy[8], zz[8];
            unpack8(cyy[q], yy); unpack8(czz[q], zz);
#pragma unroll
            for (int e = 0; e < 8; ++e) { const float v = yy[e] * siluf_(zz[e]); y[8 * q + e] = v; ss += v * v; }
        }
        ss = sum16(ss);
        const float r = rsqrtf(ss * (1.f / 512.f) + 1e-6f);
#pragma unroll
        for (int q = 0; q < 4; ++q) {
            float o[8];
#pragma unroll
            for (int e = 0; e < 8; ++e) o[e] = y[8 * q + e] * r * ng[8 * q + e];
            *(v4u*)(PS + (size_t)m * N2P + 2048 + c0 + 8 * q) = pack8(o);
        }
    }
}

__device__ __forceinline__ void phase_peer_convert(const Ctx& c, KArgs& a, int l) {
    unsigned char* ws = a.ws;
    const int gw = c.bid * 8 + c.wave, NGW = c.G * 8, lane = c.lane;
    f32x4 n0, n1, n2, n3;
#define PC_LOAD(itt) do { const int tb_ = (itt) >= NEXP, e_ = (itt) - tb_ * NEXP; const float* s_ = (tb_ ? a.in[I_PU] : a.in[I_PD]) + ((size_t)l * NEXP + e_) * D + 16 * lane; \
        n0 = *(const f32x4*)s_; n1 = *(const f32x4*)(s_ + 4); n2 = *(const f32x4*)(s_ + 8); n3 = *(const f32x4*)(s_ + 12); } while (0)
    if (gw < 2 * NEXP) PC_LOAD(gw);
    for (int it = gw; it < 2 * NEXP; it += NGW) {
        const int tb = it >= NEXP, e = it - tb * NEXP;
        const f32x4 x0 = n0, x1 = n1, x2 = n2, x3 = n3;
        if (it + NGW < 2 * NEXP) PC_LOAD(it + NGW);
        float am = fmaxf(fmaxf(fmaxf(fabsf(x0.x), fabsf(x0.y)), fmaxf(fabsf(x0.z), fabsf(x0.w))), fmaxf(fmaxf(fabsf(x1.x), fabsf(x1.y)), fmaxf(fabsf(x1.z), fabsf(x1.w))));
        am = fmaxf(am, fmaxf(fmaxf(fmaxf(fabsf(x2.x), fabsf(x2.y)), fmaxf(fabsf(x2.z), fabsf(x2.w))), fmaxf(fmaxf(fabsf(x3.x), fabsf(x3.y)), fmaxf(fabsf(x3.z), fabsf(x3.w)))));
#pragma unroll
        for (int o = 1; o < 64; o <<= 1) am = fmaxf(am, __shfl_xor(am, o));
        am = fmaxf(am, 1e-30f);
        const float s = 384.f / am;
        v4u q;
        int w;
        w = __builtin_amdgcn_cvt_pk_fp8_f32(x0.x * s, x0.y * s, 0, false); w = __builtin_amdgcn_cvt_pk_fp8_f32(x0.z * s, x0.w * s, w, true); q.x = (unsigned)w;
        w = __builtin_amdgcn_cvt_pk_fp8_f32(x1.x * s, x1.y * s, 0, false); w = __builtin_amdgcn_cvt_pk_fp8_f32(x1.z * s, x1.w * s, w, true); q.y = (unsigned)w;
        w = __builtin_amdgcn_cvt_pk_fp8_f32(x2.x * s, x2.y * s, 0, false); w = __builtin_amdgcn_cvt_pk_fp8_f32(x2.z * s, x2.w * s, w, true); q.z = (unsigned)w;
        w = __builtin_amdgcn_cvt_pk_fp8_f32(x3.x * s, x3.y * s, 0, false); w = __builtin_amdgcn_cvt_pk_fp8_f32(x3.z * s, x3.w * s, w, true); q.w = (unsigned)w;
        *(v4u*)(ws + WS_OV + (tb ? OV_UP : OV_DOWN) + (size_t)e * D + 16 * lane) = q;
        if (lane == 0) ((float*)(ws + WS_OV + OV_PSCALE))[it] = am * (1.f / 384.f);
    }
}

template <class TT> __device__ __forceinline__ void ce_desc(TT& a, TT& b) { const TT hi = a > b ? a : b, lo = a > b ? b : a; a = hi; b = lo; }
__device__ __forceinline__ void cef(float& a, float& b) { const float hi = fmaxf(a, b), lo = fminf(a, b); a = hi; b = lo; }
__device__ __forceinline__ void ced(double& a, double& b) { const double hi = fmax(a, b), lo = fmin(a, b); a = hi; b = lo; }
template <class TT, class CE> __device__ __forceinline__ void bitonic_sort16_desc(TT (&v)[16], CE ce) {
#pragma unroll
    for (int k = 2; k <= 16; k <<= 1)
#pragma unroll
        for (int j = k >> 1; j > 0; j >>= 1)
#pragma unroll
            for (int i = 0; i < 16; ++i) { const int p = i ^ j; if (p > i) { if ((i & k) == 0) ce(v[i], v[p]); else ce(v[p], v[i]); } }
}
template <class TT, class CE> __device__ __forceinline__ void bitonic_merge16_desc(TT (&v)[16], CE ce) {
#pragma unroll
    for (int j = 8; j > 0; j >>= 1)
#pragma unroll
        for (int i = 0; i < 16; ++i) { const int p = i ^ j; if (p > i) ce(v[i], v[p]); }
}
struct CEF { __device__ __forceinline__ void operator()(float& a, float& b) const { cef(a, b); } };
struct CED { __device__ __forceinline__ void operator()(double& a, double& b) const { ced(a, b); } };

__device__ __forceinline__ void top16_of_128(const bf16* p, float (&top)[16]) {
#pragma unroll
    for (int grp = 0; grp < 8; ++grp) {
        float cur[16];
        const v4u q0 = *(const v4u*)(p + grp * 16), q1 = *(const v4u*)(p + grp * 16 + 8);
        const unsigned w[8] = {q0.x, q0.y, q0.z, q0.w, q1.x, q1.y, q1.z, q1.w};
#pragma unroll
        for (int e = 0; e < 8; ++e) {
            const unsigned lo = w[e] << 16, hi = w[e] & 0xffff0000u;
            const unsigned i0 = grp * 16 + 2 * e, i1 = i0 + 1;
            cur[2 * e] = __builtin_bit_cast(float, lo | ((lo >> 31) ? i0 : (127u - i0)));
            cur[2 * e + 1] = __builtin_bit_cast(float, hi | ((hi >> 31) ? i1 : (127u - i1)));
        }
        bitonic_sort16_desc(cur, CEF());
        if (grp == 0) {
#pragma unroll
            for (int i = 0; i < 16; ++i) top[i] = cur[i];
        } else {
#pragma unroll
            for (int i = 0; i < 16; ++i) top[i] = fmaxf(top[i], cur[15 - i]);
            bitonic_merge16_desc(top, CEF());
        }
    }
}
__device__ __forceinline__ unsigned key_index(float k) { const unsigned u = __builtin_bit_cast(unsigned, k); const unsigned lo = u & 0x7fu; return (u >> 31) ? lo : 127u - lo; }
__device__ __forceinline__ float key_value(float k) { return __builtin_bit_cast(float, __builtin_bit_cast(unsigned, k) & 0xffff0000u); }

__device__ __forceinline__ void phase_peer_topk(const Ctx& c, KArgs& a) {
    unsigned char* ws = a.ws;
    const bf16* SC = (const bf16*)(ws + WS_OV + OV_SC);
    int* IDX = (int*)(ws + WS_OV + OV_IDX); float* GATE = (float*)(ws + WS_OV + OV_GATE);
    for (int it = c.bid * 512 + c.tid; it < M * 8; it += c.G * 512) {
        const bf16* p = SC + (size_t)it * 256;
        float t0[16], t1[16];
        top16_of_128(p, t0); top16_of_128(p + 128, t1);
        float v0[16], v1[16]; unsigned i0[16], i1[16];
#pragma unroll
        for (int i = 0; i < 16; ++i) { v0[i] = key_value(t0[i]); v1[i] = key_value(t1[i]); i0[i] = key_index(t0[i]); i1[i] = key_index(t1[i]); }
        double top[16];
        const double NEG = -1.0e300;
#pragma unroll
        for (int grp = 0; grp < 4; ++grp) {
            double cur[16];
#pragma unroll
            for (int s = 0; s < 16; ++s) cur[s] = NEG;
            int n = 0;
#pragma unroll
            for (int i = 0; i < 16; ++i)
#pragma unroll
                for (int j = 0; j < 16; ++j) if ((i + 1) * (j + 1) <= 16) {
                    if (n / 16 == grp) {
                        const double d = (double)(v0[i] + v1[j]);
                        const unsigned long long eid = (unsigned long long)(i0[i] * 128u + i1[j]);
                        const unsigned long long bits = __builtin_bit_cast(unsigned long long, d);
                        cur[n % 16] = __builtin_bit_cast(double, bits | ((bits >> 63) ? eid : (16383ull - eid)));
                    }
                    ++n;
                }
            bitonic_sort16_desc(cur, CED());
            if (grp == 0) {
#pragma unroll
                for (int i = 0; i < 16; ++i) top[i] = cur[i];
            } else {
#pragma unroll
                for (int i = 0; i < 16; ++i) top[i] = fmax(top[i], cur[15 - i]);
                bitonic_merge16_desc(top, CED());
            }
        }
        float sv[16]; int id[16];
#pragma unroll
        for (int i = 0; i < 16; ++i) { const unsigned long long bits = __builtin_bit_cast(unsigned long long, top[i]); const unsigned lo = (unsigned)(bits & 0x3fffull);
            id[i] = (int)((bits >> 63) ? lo : 16383u - lo); sv[i] = (float)top[i]; }
        float den = 0.f, ex[16];
#pragma unroll
        for (int i = 0; i < 16; ++i) { ex[i] = __expf(sv[i] - sv[0]); den += ex[i]; }
        const float inv = 1.f / den;
        unsigned cw[4] = {0u, 0u, 0u, 0u};
#pragma unroll
        for (int i = 0; i < 16; ++i) { const unsigned s = (unsigned)id[i] >> PEER_SLICE_SHIFT, inc = 1u << (8 * (s & 3)), ws_ = s >> 2;
            cw[0] += ws_ == 0 ? inc : 0u; cw[1] += ws_ == 1 ? inc : 0u; cw[2] += ws_ == 2 ? inc : 0u; cw[3] += ws_ == 3 ? inc : 0u; }
        unsigned lp[4], tot[4], st[4];
        const int l8 = c.lane & 7;
#pragma unroll
        for (int k = 0; k < 4; ++k) { unsigned v = cw[k];
#pragma unroll
            for (int o = 1; o < 8; o <<= 1) { const unsigned y = __shfl_up(v, o, 8); v += (l8 >= o) ? y : 0u; }
            tot[k] = __shfl(v, 7, 8); lp[k] = v - cw[k]; }
        {   unsigned carry = 0u;
#pragma unroll
            for (int k = 0; k < 4; ++k) { st[k] = tot[k] * 0x01010100u + carry * 0x01010101u; carry += (tot[k] * 0x01010101u) >> 24; } }
        unsigned run[4] = {st[0] + lp[0], st[1] + lp[1], st[2] + lp[2], st[3] + lp[3]};
        const size_t tok = (size_t)(it >> 3);
#pragma unroll
        for (int i = 0; i < 16; ++i) { const unsigned s = (unsigned)id[i] >> PEER_SLICE_SHIFT, sh = 8 * (s & 3), ws_ = s >> 2, inc = 1u << sh;
            const unsigned wsel = ws_ == 0 ? run[0] : (ws_ == 1 ? run[1] : (ws_ == 2 ? run[2] : run[3]));
            const unsigned pos = (wsel >> sh) & 0xffu;
            run[0] += ws_ == 0 ? inc : 0u; run[1] += ws_ == 1 ? inc : 0u; run[2] += ws_ == 2 ? inc : 0u; run[3] += ws_ == 3 ? inc : 0u;
            IDX[tok * 128 + pos] = id[i]; GATE[tok * 128 + pos] = ex[i] * inv; }
        if (l8 == 0) ((v4u*)(ws + WS_OV + OV_POFF))[tok] = (v4u){st[0], st[1], st[2], st[3]};
    }
}

__device__ __forceinline__ float gelu_tanh(float x) { const float u = 0.7978845608f * (x + 0.044715f * x * x * x); const float t = 1.f - 2.f / (1.f + __expf(2.f * u)); return 0.5f * x * (1.f + t); }
__device__ __forceinline__ void unpack16_fp8(const v4u& q, float (&o)[16]) {
    const unsigned w[4] = {q.x, q.y, q.z, q.w};
#pragma unroll
    for (int i = 0; i < 4; ++i) { const f32x2 lo = __builtin_amdgcn_cvt_pk_f32_fp8((int)w[i], false), hi = __builtin_amdgcn_cvt_pk_f32_fp8((int)w[i], true);
        o[4 * i] = lo.x; o[4 * i + 1] = lo.y; o[4 * i + 2] = hi.x; o[4 * i + 3] = hi.y; }
}
__device__ __forceinline__ int slice_start(unsigned o0, unsigned o1, unsigned o2, unsigned o3, int s) {
    const unsigned wsel = s < 4 ? o0 : (s < 8 ? o1 : (s < 12 ? o2 : o3));
    return s >= PEER_NSLICE ? 128 : (int)((wsel >> (8 * (s & 3))) & 0xffu);
}
template <int MODE> __device__ __forceinline__ void phase_peer_down(const Ctx& c, KArgs& a, int l, int qset) {
    unsigned char* ws = a.ws;
    const unsigned char* U8 = ws + WS_OV + OV_U8; const float* XS = (const float*)(ws + WS_OV + OV_XS);
    const unsigned char* DN = ws + WS_OV + OV_DOWN;
    const int* IDX = (const int*)(ws + WS_OV + OV_IDX);
    const v4u* POFF = (const v4u*)(ws + WS_OV + OV_POFF);
    float* ACT = (float*)(ws + WS_OV + (qset ? 278 * MiB : OV_ACT));
    unsigned* QC = (unsigned*)(ws + WS_CTL) + CW_QUEUE + (qset * 2 + l) * PEER_NSLICE * 64;
    constexpr int RS = 528;
    LAS unsigned char* wb = c.lds + c.wave * (8192 + 16 * RS);
    LAS unsigned* lpk = (LAS unsigned*)wb;
    LAS unsigned char* RB = wb + 8192;
    const int lane = c.lane, r16 = lane & 15, q = lane >> 4, hsel = lane >> 5, l32 = lane & 31;
    constexpr int NBLK = M / 16;
    const int s = c.bid & (PEER_NSLICE - 1);
    const int nrank = ((c.G - s + PEER_NSLICE - 1) >> 3) * 8, rank = (c.bid >> 3) * 8 + c.wave;
    {
#pragma unroll 1
        for (int blk = rank; blk < NBLK; blk += nrank) {
            const size_t mb = (size_t)blk * 16;
            v4u xb[16];
            { const unsigned char* xp = U8 + (mb + r16) * D + 16 * q;
#pragma unroll
              for (int j = 0; j < 16; ++j) xb[j] = *(const v4u*)(xp + 64 * j); }
            const float xs = XS[mb + r16];
            int pav = 0, nv = 0;
            if (lane < 16) { const v4u po = POFF[mb + lane]; pav = slice_start(po.x, po.y, po.z, po.w, s); nv = slice_start(po.x, po.y, po.z, po.w, s + 1) - pav; }
            int incl = nv;
#pragma unroll
            for (int o = 1; o < 16; o <<= 1) { const int y = __shfl_up(incl, o, 16); incl += (r16 >= o) ? y : 0; }
            const int offv = incl - nv;
            const int P = __builtin_amdgcn_readlane(incl, 15);
            {
                int idr[16];
#pragma unroll
                for (int ti = 0; ti < 16; ++ti) { const int pa = __builtin_amdgcn_readlane(pav, ti); const int e = pa + lane; idr[ti] = IDX[(mb + ti) * 128 + (e < 127 ? e : 127)]; }
#pragma unroll
                for (int ti = 0; ti < 16; ++ti) { const int pa = __builtin_amdgcn_readlane(pav, ti), n = __builtin_amdgcn_readlane(nv, ti), off = __builtin_amdgcn_readlane(offv, ti);
                    if (lane < n) lpk[off + lane] = (unsigned)idr[ti] | ((unsigned)ti << 14) | ((unsigned)(pa + lane) << 18); }
                if (__builtin_amdgcn_ballot_w64(nv > 64) != 0ull) {
#pragma unroll 1
                    for (int ti = 0; ti < 16; ++ti) { const int pa = __builtin_amdgcn_readlane(pav, ti), n = __builtin_amdgcn_readlane(nv, ti), off = __builtin_amdgcn_readlane(offv, ti);
                        if (lane + 64 < n) lpk[off + 64 + lane] = (unsigned)IDX[(mb + ti) * 128 + pa + 64 + lane] | ((unsigned)ti << 14) | ((unsigned)(pa + 64 + lane) << 18); }
                }
            }
            asm volatile("s_waitcnt vmcnt(0) lgkmcnt(0)" ::: "memory");
            const int nb = (P + 15) >> 4;
#define PD_IDS(PW, B) { const v4u ia = *(const LAS v4u*)(lpk + (B) * 16 + 8 * hsel), ib = *(const LAS v4u*)(lpk + (B) * 16 + 8 * hsel + 4); \
                PW[0] = ia.x; PW[1] = ia.y; PW[2] = ia.z; PW[3] = ia.w; PW[4] = ib.x; PW[5] = ib.y; PW[6] = ib.z; PW[7] = ib.w; }
#define PD_LOADH(PW, H) { _Pragma("unroll") for (int i = 0; i < 8; ++i) { const unsigned id = MODE == 1 ? (PW[i] & 63u) : (PW[i] & 16383u); \
                    rr[8 * (H) + i] = *(const v4u*)(DN + (size_t)(id * 1024u + 512u * (H) + 16u * l32)); } }
            if (nb > 0) {
                v4u rr[16];
                { unsigned pw[8]; PD_IDS(pw, 0) PD_LOADH(pw, 0) PD_LOADH(pw, 1) }
#pragma unroll 1
                for (int b = 0; b < nb; ++b) {
                    const int bn = b + 1 < nb ? b + 1 : b;
                    unsigned pwn[8]; PD_IDS(pwn, bn)
                    const v4u mt = *(const LAS v4u*)(lpk + b * 16 + 4 * q);
                    f32x4 acc0 = {0.f, 0.f, 0.f, 0.f}, acc1 = {0.f, 0.f, 0.f, 0.f};
#pragma unroll
                    for (int h = 0; h < 2; ++h) {
#pragma unroll
                        for (int i = 0; i < 8; ++i) *(LAS v4u*)(RB + (8 * hsel + i) * RS + 16 * l32) = rr[8 * h + i];
                        PD_LOADH(pwn, h)
#pragma unroll
                        for (int jj = 0; jj < 8; ++jj) {
                            const v4u av = *(const LAS v4u*)(RB + r16 * RS + 64 * jj + 16 * q);
                            const v4u bv = xb[8 * h + jj];
                            const long a0 = (long)(((unsigned long long)av.y << 32) | av.x), a1 = (long)(((unsigned long long)av.w << 32) | av.z);
                            const long b0 = (long)(((unsigned long long)bv.y << 32) | bv.x), b1 = (long)(((unsigned long long)bv.w << 32) | bv.z);
                            acc0 = __builtin_amdgcn_mfma_f32_16x16x32_fp8_fp8(a0, b0, acc0, 0, 0, 0);
                            acc1 = __builtin_amdgcn_mfma_f32_16x16x32_fp8_fp8(a1, b1, acc1, 0, 0, 0);
                        }
                    }
                    const f32x4 dv = (acc0 + acc1) * xs;
                    const unsigned me[4] = {mt.x, mt.y, mt.z, mt.w};
                    const float dd[4] = {dv.x, dv.y, dv.z, dv.w};
#pragma unroll
                    for (int i = 0; i < 4; ++i) if (b * 16 + 4 * q + i < P && (int)((me[i] >> 14) & 15u) == r16) lpk[b * 16 + 4 * q + i] = __builtin_bit_cast(unsigned, dd[i]);
                }
            }
#pragma unroll
            for (int ti = 0; ti < 16; ++ti) { const int pa = __builtin_amdgcn_readlane(pav, ti), n = __builtin_amdgcn_readlane(nv, ti), off = __builtin_amdgcn_readlane(offv, ti);
                if (lane < n) ACT[(mb + ti) * 128 + pa + lane] = __builtin_bit_cast(float, lpk[off + lane]); }
            if (__builtin_amdgcn_ballot_w64(nv > 64) != 0ull) {
#pragma unroll 1
                for (int ti = 0; ti < 16; ++ti) { const int pa = __builtin_amdgcn_readlane(pav, ti), n = __builtin_amdgcn_readlane(nv, ti), off = __builtin_amdgcn_readlane(offv, ti);
                    if (lane + 64 < n) ACT[(mb + ti) * 128 + pa + 64 + lane] = __builtin_bit_cast(float, lpk[off + 64 + lane]); }
            }
        }
    }
}

template <int FUSE> __device__ __forceinline__ void phase_peer_experts(const Ctx& c, KArgs& a, const float* gnext, const bool commit = true) {
    unsigned char* ws = a.ws;
    const unsigned char* UP = ws + WS_OV + OV_UP;
    const float* SCD = (const float*)(ws + WS_OV + OV_PSCALE); const float* SCU = SCD + NEXP;
    const int* IDX = (const int*)(ws + WS_OV + OV_IDX); const float* GATE = (const float*)(ws + WS_OV + OV_GATE);
    const float* ACT = (const float*)(ws + WS_OV + OV_ACT);
    float* H = a.out;
    constexpr int TPW = 16, RS = 144;
    LAS unsigned char* wb = c.lds + c.wave * 16384;
    LAS int* idw = (LAS int*)wb;
    LAS unsigned char* wq8 = wb + 8192;
    LAS unsigned char* tile = wb + 10240;
    LAS float* swl = (LAS float*)(wb + 10240 + 32 * RS);
    const int lane = c.lane, r16 = lane & 15, q = lane >> 4, g8 = lane >> 3, c8 = lane & 7;
    const int gw = c.bid * 8 + c.wave, NGW = c.G * 8;
    const unsigned tr_addr = (unsigned)(size_t)(tile + (8 * q + (r16 >> 1)) * RS + 8 * (r16 & 1));
    for (int m0 = gw; m0 < M; m0 += NGW * TPW) {
#pragma unroll 1
        for (int ti = 0; ti < TPW; ++ti) {
            const int m = m0 + ti * NGW;
            float w0 = 0.f, w1 = 0.f; int id0 = 0, id1 = 0;
            if (m < M) {
                id0 = IDX[(size_t)m * 128 + lane]; id1 = IDX[(size_t)m * 128 + 64 + lane];
                const float g0 = GATE[(size_t)m * 128 + lane], g1 = GATE[(size_t)m * 128 + 64 + lane];
                const float a0 = ACT[(size_t)m * 128 + lane], a1 = ACT[(size_t)m * 128 + 64 + lane];
                w0 = g0 * gelu_tanh(a0 * SCD[id0]) * SCU[id0]; w1 = g1 * gelu_tanh(a1 * SCD[id1]) * SCU[id1];
            }
            float am = fmaxf(fabsf(w0), fabsf(w1));
#pragma unroll
            for (int o = 1; o < 64; o <<= 1) am = fmaxf(am, __shfl_xor(am, o));
            am = fmaxf(am, 1e-30f);
            const float qs = 384.f / am;
            const int pk = __builtin_amdgcn_cvt_pk_fp8_f32(w0 * qs, w1 * qs, 0, false);
            wq8[ti * 128 + lane] = (unsigned char)(pk & 0xff); wq8[ti * 128 + 64 + lane] = (unsigned char)((pk >> 8) & 0xff);
            idw[ti * 128 + lane] = id0; idw[ti * 128 + 64 + lane] = id1;
            if (lane == 0) swl[ti] = am * (1.f / 384.f);
        }
        asm volatile("s_waitcnt lgkmcnt(0)" ::: "memory");
        const f32x4 iscv = *(const LAS f32x4*)(swl + 4 * q);
        const float isc[4] = {iscv.x, iscv.y, iscv.z, iscv.w};
        float ssq[4] = {0.f, 0.f, 0.f, 0.f};
#define UPM_W(T4) { _Pragma("unroll") for (int i = 0; i < 4; ++i) *(LAS v4u*)(tile + (4 * g8 + i) * RS + 16 * c8) = rr[4 * (T4) + i]; }
#define UPM_LK(T4, TIN) { if ((TIN) < TPW) { const v4u i4 = *(const LAS v4u*)(idw + (TIN) * 128 + 32 * (T4) + 4 * g8); \
            rr[4 * (T4) + 0] = *(const v4u*)(UPc + (size_t)(i4.x * 1024u)); rr[4 * (T4) + 1] = *(const v4u*)(UPc + (size_t)(i4.y * 1024u)); \
            rr[4 * (T4) + 2] = *(const v4u*)(UPc + (size_t)(i4.z * 1024u)); rr[4 * (T4) + 3] = *(const v4u*)(UPc + (size_t)(i4.w * 1024u)); } }
#define UPM_R(B) asm volatile("ds_read_b64_tr_b8 %0, %8\n\tds_read_b64_tr_b8 %1, %8 offset:16\n\tds_read_b64_tr_b8 %2, %8 offset:32\n\tds_read_b64_tr_b8 %3, %8 offset:48\n\t" \
                         "ds_read_b64_tr_b8 %4, %8 offset:64\n\tds_read_b64_tr_b8 %5, %8 offset:80\n\tds_read_b64_tr_b8 %6, %8 offset:96\n\tds_read_b64_tr_b8 %7, %8 offset:112" \
                         : "=&v"(B[0]), "=&v"(B[1]), "=&v"(B[2]), "=&v"(B[3]), "=&v"(B[4]), "=&v"(B[5]), "=&v"(B[6]), "=&v"(B[7]) : "v"(tr_addr) : "memory")
#define UPM_WAIT(B) asm volatile("s_waitcnt lgkmcnt(0)" : "+v"(B[0]), "+v"(B[1]), "+v"(B[2]), "+v"(B[3]), "+v"(B[4]), "+v"(B[5]), "+v"(B[6]), "+v"(B[7]) :: "memory")
#define UPM_M(B, TI, T4) { v2u wa = *(const LAS v2u*)(wq8 + (TI) * 128 + 32 * (T4) + 8 * q); if (r16 != (TI)) { wa.x = 0u; wa.y = 0u; } \
            const long wal = (long)(((unsigned long long)wa.y << 32) | wa.x); \
            _Pragma("unroll") for (int ct = 0; ct < 8; ++ct) acc[ct] = __builtin_amdgcn_mfma_f32_16x16x32_fp8_fp8(wal, B[ct], acc[ct], 0, 0, 0); }
#define UPM_STEP(BC, BN, J, T4W, TINW, T4M) { if (s0 + (J) + 1 < 4 * TPW) UPM_R(BN); if (s0 + (J) + 2 < 4 * TPW) { UPM_W(T4W) UPM_LK(T4W, TINW) } UPM_M(BC, ti, T4M) UPM_WAIT(BN); }
#pragma unroll 1
        for (int cq = 0; cq < 8; ++cq) {
            const unsigned char* UPc = UP + 128 * cq + 16 * c8;
            f32x4 acc[8];
#pragma unroll
            for (int ct = 0; ct < 8; ++ct) acc[ct] = (f32x4){0.f, 0.f, 0.f, 0.f};
            {
                v4u rr[16]; long bA[8], bB[8];
                UPM_LK(0, 0) UPM_LK(1, 0) UPM_LK(2, 0) UPM_LK(3, 0)
                UPM_W(0) UPM_LK(0, 1) UPM_R(bA); UPM_WAIT(bA); UPM_W(1) UPM_LK(1, 1)
#pragma unroll 1
                for (int ti = 0; ti < TPW; ++ti) {
                    const int s0 = 4 * ti;
                    UPM_STEP(bA, bB, 0, 2, ti + 1, 0)
                    UPM_STEP(bB, bA, 1, 3, ti + 1, 1)
                    UPM_STEP(bA, bB, 2, 0, ti + 2, 2)
                    UPM_STEP(bB, bA, 3, 1, ti + 2, 3)
                }
            }
            if (!commit) { if (acc[0].x != 123456.789f) continue; }
            {
                float hv[4][8];
#pragma unroll
                for (int i = 0; i < 4; ++i) { const int m = m0 + (4 * q + i) * NGW; const float* hp = H + (size_t)(m < M ? m : 0) * D + 128 * cq + r16;
#pragma unroll
                    for (int ct = 0; ct < 8; ++ct) hv[i][ct] = hp[16 * ct]; }
#pragma unroll
                for (int i = 0; i < 4; ++i) { const int m = m0 + (4 * q + i) * NGW; float* hp = H + (size_t)(m < M ? m : 0) * D + 128 * cq + r16;
#pragma unroll
                    for (int ct = 0; ct < 8; ++ct) { const float d = i == 0 ? acc[ct].x : (i == 1 ? acc[ct].y : (i == 2 ? acc[ct].z : acc[ct].w)); hv[i][ct] += d * isc[i]; ssq[i] += hv[i][ct] * hv[i][ct]; }
                    if (m < M) {
#pragma unroll
                        for (int ct = 0; ct < 8; ++ct) hp[16 * ct] = hv[i][ct]; } }
            }
        }
        if (!commit) continue;
#pragma unroll
        for (int i = 0; i < 4; ++i) { float s = ssq[i]; s += __shfl_xor(s, 1); s += __shfl_xor(s, 2); s += __shfl_xor(s, 4); s += __shfl_xor(s, 8); ssq[i] = s; }
        asm volatile("s_waitcnt vmcnt(0)" ::: "memory");
        const f32x4 gn0 = *(const f32x4*)(gnext + lane * 16), gn1 = *(const f32x4*)(gnext + lane * 16 + 4), gn2 = *(const f32x4*)(gnext + lane * 16 + 8), gn3 = *(const f32x4*)(gnext + lane * 16 + 12);
#pragma unroll
        for (int i = 0; i < 4; ++i)
#pragma unroll 1
            for (int qv = 0; qv < 4; ++qv) {
                const int ti = 4 * qv + i, m = m0 + ti * NGW; if (m >= M) continue;
                const float ss = __builtin_bit_cast(float, __builtin_amdgcn_readlane(__builtin_bit_cast(int, ssq[i]), qv * 16));
                const float rn = rsqrtf(ss * (1.f / D) + 1e-6f);
                f32x4* hp = (f32x4*)(H + (size_t)m * D + lane * 16);
                const f32x4 h0 = hp[0], h1 = hp[1], h2 = hp[2], h3 = hp[3];
                const f32x4 n0 = h0 * rn * gn0, n1 = h1 * rn * gn1, n2 = h2 * rn * gn2, n3 = h3 * rn * gn3;
                if (FUSE == 0) {
                    v4u u0, u1; u0.x = pk2(n0.x, n0.y); u0.y = pk2(n0.z, n0.w); u0.z = pk2(n1.x, n1.y); u0.w = pk2(n1.z, n1.w);
                    u1.x = pk2(n2.x, n2.y); u1.y = pk2(n2.z, n2.w); u1.z = pk2(n3.x, n3.y); u1.w = pk2(n3.z, n3.w);
                    bf16* up_ = (bf16*)(ws + WS_U) + (size_t)m * D + lane * 16;
                    *(v4u*)up_ = u0; *(v4u*)(up_ + 8) = u1;
                } else { hp[0] = n0; hp[1] = n1; hp[2] = n2; hp[3] = n3; }
            }
    }
}

constexpr int PH_PER_HALF = 11, PH_PER_LAYER = 1 + 2 * PH_PER_HALF + 5, N_PHASES = 1 + DEPTH * PH_PER_LAYER;
__device__ __forceinline__ Ctx make_ctx() {
    extern __shared__ __attribute__((aligned(16))) unsigned char lds_raw[];
    Ctx c; int t = threadIdx.x; asm volatile("" : "+v"(t)); c.lds = (LAS unsigned char*)lds_raw; c.tid = t; c.lane = t & 63; c.wave = __builtin_amdgcn_readfirstlane(t >> 6); c.G = gridDim.x; c.bid = blockIdx.x; return c; }
__device__ __forceinline__ KArgs* kargs_fresh() { KArgs* p = (KArgs*)__builtin_amdgcn_kernarg_segment_ptr(); asm volatile("" : "+s"(p)); return p; }
#define PH_BEGIN(K) if (lo <= (K) && (K) < hi) { const Ctx c = make_ctx(); KArgs& args = *kargs_fresh(); unsigned char* ws = args.ws; (void)ws;
#define PH_END(K)   if ((K) + 1 < hi) xcd_barrier(bar); }

template <int L, int HB> __device__ __forceinline__ void half_pass(const XcdBarrier& bar, const int lo, const int hi) {
    constexpr int P0 = 1 + L * PH_PER_LAYER + 1 + HB * PH_PER_HALF;
#define WIN ((const bf16*)(ws + WS_WIN + L * WIN_L))
#define Uh ((const bf16*)(ws + WS_U) + (size_t)HB * MH * D)
    PH_BEGIN(P0 + 0) {
        pg8::Gemm g{Uh, WIN, MH, N1P, D, D, 0}; pg8::StaticOrder S; S.init(MH, N1P, c.G, c.bid);
        pg8::EpiRow8<FStoreBf16> E{{(bf16*)(ws + WS_OV + OV_PR), N1P}};
        pg8::gemm_phase(c.lds, g, S, E); if (PROBE_DUP == 5) pg8::gemm_phase(c.lds, g, S, E); } PH_END(P0 + 0)
    PH_BEGIN(P0 + 1) if (PROBE_DUP == 6) phase_rwkv_prep(c, args, L, HB); phase_rwkv_prep(c, args, L, HB); PH_END(P0 + 1)
    PH_BEGIN(P0 + 2) {
        constexpr int NL = L == 0 ? 3072 : 4096;
        pg8::Gemm g{(const bf16*)(ws + WS_OV + OV_AL), (const bf16*)(ws + WS_WLORA + L * WLORA_L), MH, NL, KL, KL, 1}; pg8::StaticOrder S; S.init(MH, NL, c.G, c.bid);
        EpiLora E{(bf16*)(ws + WS_OV + OV_ELOG), (bf16*)(ws + WS_OV + OV_ASIG), (bf16*)(ws + WS_OV + OV_GG), (bf16*)(ws + WS_OV + OV_VMIX),
                               (const bf16*)(ws + WS_VF) + (size_t)HB * MH * D, args.in[I_W0] + (size_t)L * D, args.in[I_A0] + (size_t)L * D, args.in[I_V0]};
        pg8::gemm_phase(c.lds, g, S, E); } PH_END(P0 + 2)
    PH_BEGIN(P0 + 3) phase_rwkv_chunk_par(c, args, L, HB); PH_END(P0 + 3)
    PH_BEGIN(P0 + 4) if (PROBE_DUP == 8) phase_rwkv_chunk_seq(c, args, false); phase_rwkv_chunk_seq(c, args); PH_END(P0 + 4)
    PH_BEGIN(P0 + 5) {
        phase_rwkv_post(c, args, L, HB); __syncthreads();
        pg8::Gemm g{Uh, WIN + (size_t)N1P * D, MH, N2P, D, D, 0}; pg8::StaticOrder S; S.init(MH, N2P, c.G, c.bid);
        pg8::EpiRow8<FStoreBf16> E{{(bf16*)(ws + WS_OV + OV_PS), N2P}};
        pg8::gemm_phase(c.lds, g, S, E); if (PROBE_DUP == 5) pg8::gemm_phase(c.lds, g, S, E); } PH_END(P0 + 5)
    PH_BEGIN(P0 + 6) if (PROBE_DUP == 6) phase_ssd_conv(c, args, L); phase_ssd_conv(c, args, L); PH_END(P0 + 6)
    PH_BEGIN(P0 + 7) phase_ssd_scan(c, args, L); PH_END(P0 + 7)
    PH_BEGIN(P0 + 8) phase_ssd_post(c, args, L); PH_END(P0 + 8)
    PH_BEGIN(P0 + 9) {
      { pg8::Gemm g{Uh, WIN + (size_t)(N1P + N2P) * D, MH, D, D, D, 0}; pg8::StaticOrder S; S.init(MH, D, c.G, c.bid);
        pg8::EpiRow8<FSigmoidBf16> E{{(bf16*)(ws + WS_OV + OV_GATES), 2048}};
        pg8::gemm_phase(c.lds, g, S, E); }
      { pg8::Gemm g{Uh, WIN + (size_t)(N1P + N2P + D) * D, MH, D, D, D, 0}; pg8::StaticOrder S; S.init(MH, D, c.G, c.bid);
        pg8::EpiRow8<FSigmoidBf16> E{{(bf16*)(ws + WS_OV + OV_GATES) + 1024, 2048}};
        pg8::gemm_phase(c.lds, g, S, E); }
      {
        pg8::Gemm g{(const bf16*)(ws + WS_OV + OV_YA), (const bf16*)(ws + WS_WA) + (size_t)L * D * D, MH, D, D, D, 0}; pg8::StaticOrder S; S.init(MH, D, c.G, c.bid);
        pg8::EpiRow8<FMixA> E{{(const bf16*)(ws + WS_OV + OV_GATES), (bf16*)(ws + WS_OV + OV_MIXED)}};
        pg8::gemm_phase(c.lds, g, S, E); }
      {
        pg8::Gemm g{(const bf16*)(ws + WS_OV + OV_PS) + 2048, (const bf16*)(ws + WS_WB) + (size_t)L * D * 2048, MH, D, 2048, N2P, 0}; pg8::StaticOrder S; S.init(MH, D, c.G, c.bid);
        pg8::EpiRow8<FMixB> E{{(const bf16*)(ws + WS_OV + OV_GATES), (bf16*)(ws + WS_OV + OV_MIXED)}};
        pg8::gemm_phase(c.lds, g, S, E); } } PH_END(P0 + 9)
    PH_BEGIN(P0 + 10) {
        pg8::Gemm g{(const bf16*)(ws + WS_OV + OV_MIXED), (const bf16*)(ws + WS_WO) + (size_t)L * D * D, MH, D, D, D, 0}; pg8::StaticOrder S; S.init(MH, D, c.G, c.bid);
        pg8::EpiRow8<FResid> E{{(L == 0 ? args.in[I_X] : (const float*)args.out) + (size_t)HB * MH * D, args.out + (size_t)HB * MH * D}};
        pg8::gemm_phase(c.lds, g, S, E); } PH_END(P0 + 10)
#undef WIN
#undef Uh
}

template <int L> __device__ __forceinline__ void layer_pass(const XcdBarrier& bar, const int lo, const int hi) {
    constexpr int P0 = 1 + L * PH_PER_LAYER, P1 = P0 + 1 + 2 * PH_PER_HALF;
    PH_BEGIN(P0) if (L == 0) phase_rmsnorm(c, args.in[I_X], args.in[I_NMG], (bf16*)(ws + WS_U), nullptr); PH_END(P0)
    half_pass<L, 0>(bar, lo, hi);
    half_pass<L, 1>(bar, lo, hi);
    PH_BEGIN(P1 + 0) phase_rmsnorm_q8(c, args.out, args.in[I_NFG] + (size_t)L * D, (bf16*)(ws + WS_U), ws + WS_OV + OV_U8, (float*)(ws + WS_OV + OV_XS)); phase_peer_convert(c, args, L); PH_END(P1 + 0)
    PH_BEGIN(P1 + 1) {
        pg8::Gemm g{(const bf16*)(ws + WS_U), (const bf16*)(ws + WS_WQK) + (size_t)L * 2048 * D, M, 2048, D, D, 0}; pg8::StaticOrder S; S.init(M, 2048, c.G, c.bid);
        pg8::EpiRow8<FStoreBf16> E{{(bf16*)(ws + WS_OV + OV_SC), 2048}};
        pg8::gemm_phase(c.lds, g, S, E); } PH_END(P1 + 1)
    PH_BEGIN(P1 + 2) if (PROBE_DUP == 4) phase_peer_topk(c, args); phase_peer_topk(c, args); PH_END(P1 + 2)
    PH_BEGIN(P1 + 3) phase_peer_down<0>(c, args, L, 0); if (PROBE_DOWN >= 0) phase_peer_down<PROBE_DOWN < 0 ? 0 : PROBE_DOWN>(c, args, L, 1); PH_END(P1 + 3)
    PH_BEGIN(P1 + 4) phase_peer_experts<L == DEPTH - 1 ? 1 : 0>(c, args, L == DEPTH - 1 ? args.in[I_NFIN] : args.in[I_NMG] + (size_t)(L + 1) * D); PH_END(P1 + 4)
}

__global__ void __launch_bounds__(512, 2) mk_fwd(Args kargs_) {
    extern __shared__ __attribute__((aligned(16))) unsigned char lds_raw[];
    LAS unsigned char* lds0 = (LAS unsigned char*)lds_raw;
    unsigned char* ws0 = kargs_.ws;
    const int lo = kargs_.lo, hi = kargs_.hi;
    if (threadIdx.x < 4) ((LAS unsigned*)(lds0 + LDS_MISC))[threadIdx.x] = 0u;
    __syncthreads();
    XcdBarrier bar; bar.bar = (unsigned*)(ws0 + WS_CTL) + CW_BAR; bar.x = 0; bar.st = (volatile LAS unsigned*)(lds0 + LDS_MISC);
    if (hi - lo > 1) bar = xcd_barrier_post((unsigned*)(ws0 + WS_CTL) + CW_BAR, (volatile LAS unsigned*)(lds0 + LDS_MISC));
    PH_BEGIN(0) phase_prologue(c, args); PH_END(0)
    layer_pass<0>(bar, lo, hi);
    layer_pass<1>(bar, lo, hi);
}

extern "C" void kernel_launch(void* const* d_in, const int* in_sizes, int n_in, void* d_out, int out_size, void* d_ws, size_t ws_size, hipStream_t stream) {
    static int grid = 0;
    if (grid == 0) {
        if (n_in != 32 || out_size != M * D || ws_size < WS_END) { fprintf(stderr, "kernel_launch: unexpected problem (n_in %d, out %d, ws %zu < %zu)\n", n_in, out_size, ws_size, (size_t)WS_END); grid = -1; return; }
        int dev = 0, cus = 0, per_cu = 0;
        if (hipGetDevice(&dev) != hipSuccess || hipDeviceGetAttribute(&cus, hipDeviceAttributeMultiprocessorCount, dev) != hipSuccess) { grid = -1; return; }
        if (hipFuncSetAttribute((const void*)mk_fwd, hipFuncAttributeMaxDynamicSharedMemorySize, LDS_BYTES) != hipSuccess) { fprintf(stderr, "kernel_launch: hipFuncSetAttribute failed\n"); grid = -1; return; }
        if (hipOccupancyMaxActiveBlocksPerMultiprocessor(&per_cu, (const void*)mk_fwd, 512, LDS_BYTES) != hipSuccess || per_cu < 1) { fprintf(stderr, "kernel_launch: occupancy query says %d\n", per_cu); per_cu = 1; }
        (void)hipGetLastError();
        grid = cus;
    }
    if (grid < 0) return;
    (void)hipMemsetAsync((char*)d_ws + WS_CTL, 0, CTL_BYTES, stream);
    Args a{};
    for (int i = 0; i < 32; ++i) a.in[i] = (const float*)d_in[i];
    a.out = (float*)d_out; a.ws = (unsigned char*)d_ws;
#if MK_MULTI
    for (int p = 0; p < N_PHASES; ++p) { a.lo = p; a.hi = p + 1; hipLaunchKernelGGL(mk_fwd, dim3(grid), dim3(512), LDS_BYTES, stream, a); }
#else
    a.lo = 0; a.hi = N_PHASES;
    hipLaunchKernelGGL(mk_fwd, dim3(grid), dim3(512), LDS_BYTES, stream, a);
#endif
}
```

```cpp
#include <hip/hip_runtime.h>
#include <cstdio>
#include <cstdint>

#ifndef PROBE_DUP
#define PROBE_DUP 0
#endif
#ifndef MK_MULTI
#define MK_MULTI 0
#endif

#define GAS __attribute__((address_space(1)))
#define LAS __attribute__((address_space(3)))
typedef unsigned short bf16;
typedef unsigned v4u __attribute__((ext_vector_type(4)));
typedef unsigned v2u __attribute__((ext_vector_type(2)));
typedef float f32x4 __attribute__((ext_vector_type(4)));
typedef float f32x2 __attribute__((ext_vector_type(2)));
typedef short bf16x8 __attribute__((ext_vector_type(8)));
typedef __bf16 bf2_t __attribute__((ext_vector_type(2)));

constexpr int D = 1024, BATCH = 8, T = 4096, M = BATCH * T, MH = M / 2, DEPTH = 2;
constexpr int RW_PROJ = 3360, SSD_PROJ = 5152, IN_PROJ = 10560;
constexpr int N1P = 3584, N2P = 5120, N3P = 2048, NINP = N1P + N2P + N3P;
constexpr int DT_COL = RW_PROJ;
constexpr int KL = 384;
constexpr int NEXP = 16384;
#ifndef PROBE_DOWN
#define PROBE_DOWN -1
#endif
constexpr int PEER_SLICE_SHIFT = 11, PEER_NSLICE = NEXP >> PEER_SLICE_SHIFT;
constexpr int CW_WMAX = 12288, CW_WSC = 12304;
constexpr int CW_QUEUE = 8192;

constexpr size_t MiB = 1u << 20;
constexpr size_t WS_CTL = 0, CTL_BYTES = 1 * MiB;
constexpr size_t WS_WIN = 1 * MiB;
constexpr size_t WIN_L = (size_t)NINP * D * 2;
constexpr size_t WIN8_L = (size_t)NINP * D;
constexpr size_t U8IN_XS = 33 * MiB;
constexpr size_t WS_WA = 44 * MiB;
constexpr size_t WS_WB = 48 * MiB;
constexpr size_t WS_WO = 56 * MiB;
constexpr size_t WS_WQK = 60 * MiB;
constexpr size_t WS_WLORA = 68 * MiB;
constexpr size_t WLORA_L = (size_t)4096 * KL * 2;
constexpr size_t WS_U = 74 * MiB;
constexpr size_t WS_VF = 138 * MiB;
constexpr size_t WS_OV = 202 * MiB;
constexpr size_t OV_PR = 0, OV_ELOG = 112 * MiB, OV_ASIG = 144 * MiB, OV_GG = 176 * MiB, OV_VMIX = 208 * MiB, OV_AL = 240 * MiB, OV_YA = 272 * MiB;
constexpr size_t OV_PS = 0, OV_XBC = 168 * MiB, OV_DT = 305 * MiB, OV_DA = 307 * MiB;
constexpr size_t OV_GATES = 168 * MiB, OV_MIXED = 232 * MiB;
constexpr size_t OV_DOWN = 0, OV_UP = 32 * MiB, OV_PSCALE = 48 * MiB  , OV_SC = 64 * MiB, OV_IDX = 192 * MiB, OV_GATE = 208 * MiB, OV_POFF = 224 * MiB  , OV_ACT = 226 * MiB  , OV_U8 = 244 * MiB  , OV_XS = 276 * MiB  ;
constexpr size_t OV_BON = 304 * MiB;
constexpr size_t WS_END = WS_OV + 309 * MiB;
static_assert(WS_WIN + 2 * WIN_L <= WS_WA, "map");

constexpr int LDS_BYTES = 147456;
constexpr int LDS_MISC = 145408;
constexpr int CW_BAR = 4096;

__device__ __forceinline__ unsigned f2bf(float f) { unsigned u = __builtin_bit_cast(unsigned, f); return (u + 0x7fffu + ((u >> 16) & 1u)) >> 16; }
__device__ __forceinline__ unsigned pk2(float lo, float hi) { unsigned r; asm volatile("v_cvt_pk_bf16_f32 %0, %1, %2" : "=v"(r) : "v"(lo), "v"(hi)); return r; }
typedef __bf16 bf16x2_t __attribute__((ext_vector_type(2)));
__device__ __forceinline__ unsigned pk2c(float lo, float hi) { bf16x2_t v; v.x = (__bf16)lo; v.y = (__bf16)hi; return __builtin_bit_cast(unsigned, v); }
__device__ __forceinline__ float bflo(unsigned u) { return __builtin_bit_cast(float, u << 16); }
__device__ __forceinline__ float bfhi(unsigned u) { return __builtin_bit_cast(float, u & 0xffff0000u); }
__device__ __forceinline__ float bf1(bf16 u) { return __builtin_bit_cast(float, ((unsigned)u) << 16); }
__device__ __forceinline__ float sigmoidf_(float x) { return 1.f / (1.f + __expf(-x)); }
__device__ __forceinline__ float siluf_(float x) { return x / (1.f + __expf(-x)); }
template <int CTRL> __device__ __forceinline__ float dpp_mov(float x) { return __int_as_float(__builtin_amdgcn_update_dpp(0, __float_as_int(x), CTRL, 0xF, 0xF, true)); }
__device__ __forceinline__ float sum4(float x) { x += dpp_mov<0xB1>(x); x += dpp_mov<0x4E>(x); return x; }
__device__ __forceinline__ float sum16(float x) { x += dpp_mov<0xB1>(x); x += dpp_mov<0x4E>(x); x += dpp_mov<0x141>(x); x += dpp_mov<0x140>(x); return x; }
__device__ __forceinline__ float sum64(float x) { x = sum16(x); x += __shfl_xor(x, 16); x += __shfl_xor(x, 32); return x; }
__device__ __forceinline__ void unpack8(const v4u& q, float (&o)[8]) { o[0] = bflo(q.x); o[1] = bfhi(q.x); o[2] = bflo(q.y); o[3] = bfhi(q.y); o[4] = bflo(q.z); o[5] = bfhi(q.z); o[6] = bflo(q.w); o[7] = bfhi(q.w); }
__device__ __forceinline__ v4u pack8(const float (&o)[8]) { v4u q; q.x = pk2(o[0], o[1]); q.y = pk2(o[2], o[3]); q.z = pk2(o[4], o[5]); q.w = pk2(o[6], o[7]); return q; }

typedef short s16x4 __attribute__((ext_vector_type(4)));
__device__ __forceinline__ void lds_barrier() { asm volatile("s_waitcnt lgkmcnt(0)\n\ts_barrier" ::: "memory"); }
__device__ __forceinline__ bf16x8 tr_frag(unsigned base_bytes, int stride, int k0, int c0, int lane) {
    const int i16 = lane & 15, qq = i16 >> 2, p = i16 & 3, q = lane >> 4;
    const unsigned a0 = base_bytes + (unsigned)(((k0 + 8 * q + qq) * stride + c0 + 4 * p) * 2), a1 = a0 + (unsigned)(8 * stride);
    s16x4 lo, hi;
    asm volatile("ds_read_b64_tr_b16 %0, %2\n\tds_read_b64_tr_b16 %1, %3\n\ts_waitcnt lgkmcnt(0)" : "=&v"(lo), "=&v"(hi) : "v"(a0), "v"(a1) : "memory");
    return __builtin_shufflevector(lo, hi, 0, 1, 2, 3, 4, 5, 6, 7);
}

namespace pg8 {
typedef int i32x4_t __attribute__((ext_vector_type(4)));
constexpr int BM = 256, BK = 64, HALF = 128, HTB = HALF * BK * 2, STAGE_BYTES = 8 * HTB, NXCD = 8, WGM = 8;
__host__ __device__ __forceinline__ int lds_byte(int r, int c) { const int st = (r >> 4) * 2 + (c >> 5), rr = r & 15, cc = c & 31, ob = rr * 64 + cc * 2; return st * 1024 + (ob ^ (((ob >> 9) & 1) << 5)); }
__host__ __device__ __forceinline__ void stage_rc(int b, int& R, int& C) { const int st = b / 1024, sb = b % 1024, swz = sb ^ (((sb >> 9) & 1) << 5); R = (st >> 1) * 16 + swz / 64; C = (st & 1) * 32 + (swz % 64) / 2; }
__host__ __device__ __forceinline__ int perm32(int rho) { const int n = rho >> 4, i = rho & 15; return 8 * (i >> 2) + 4 * n + (i & 3); }
struct Unit { int pm, pn; };
struct Gemm { const bf16* A; const bf16* Bt; int M, N, K, lda; int kwin; };
__device__ __forceinline__ void unit_kwin(const Gemm& g, const Unit& u, int& k0t, int& ntl) { k0t = 0; ntl = g.K / BK; if (g.kwin) { const int blk = u.pn >> 2; if (blk < 2) { k0t = 0; ntl = 2; } else if (blk == 2) { k0t = 2; ntl = 4; } else { k0t = 4; ntl = 2; } } }
struct StaticOrder {
    int nM, nN, nwg, G, c;
    __device__ void init(int M_, int N_, int G_, int c_) { nM = M_ / BM; nN = N_ / BM; nwg = nM * nN; G = G_; c = c_; }
    __device__ bool next(int i, Unit& u) const {
        const long L = (long)i * G + c; if (L >= nwg) return false;
        int wgid = (int)L; { const int q = nwg / NXCD, r = nwg % NXCD, xcd = wgid % NXCD, off = wgid / NXCD; wgid = (xcd < r ? xcd * (q + 1) : r * (q + 1) + (xcd - r) * q) + off; }
        const int nig = WGM * nN, gid = wgid / nig, fm = gid * WGM, gsz = (nM - fm) < WGM ? (nM - fm) : WGM;
        u.pm = fm + ((wgid % nig) % gsz); u.pn = (wgid % nig) / gsz; return true;
    }
};
template <class F> struct EpiRow8 {
    static constexpr bool PERM = true;
    F f;
    __device__ __forceinline__ void operator()(const f32x4 (&acc)[2][2][4][2], const Unit& u, int wr, int wc, int fr, int fq) const {
        const int row0 = u.pm * BM + wr * 64 + fr, col0 = u.pn * BM + wc * 32 + 8 * fq;
#pragma unroll
        for (int g0 = 0; g0 < 16; g0 += F::GRP) {
            typename F::Tmp t[F::GRP];
#pragma unroll
            for (int j = 0; j < F::GRP; ++j) { const int i = g0 + j, ai = i >> 3, m = (i >> 1) & 3, bj = i & 1; f.load(row0 + ai * HALF + m * 16, col0 + bj * HALF, u.pn, t[j]); }
#pragma unroll
            for (int j = 0; j < F::GRP; ++j) { const int i = g0 + j, ai = i >> 3, m = (i >> 1) & 3, bj = i & 1; f.apply(row0 + ai * HALF + m * 16, col0 + bj * HALF, acc[ai][bj][m][0], acc[ai][bj][m][1], u.pn, t[j]); }
        }
    }
};


typedef int i32x8 __attribute__((ext_vector_type(8)));
template <class E> struct epi_f8 { static constexpr bool v = false; };
struct FragB16 { bf16x8 k[2]; };
template <bool F8> struct FragT { typedef FragB16 T; };
template <> struct FragT<true> { typedef i32x8 T; };
__device__ __forceinline__ void ld_frag(FragB16& d, const LAS unsigned char* p) { d.k[0] = *(const LAS bf16x8*)p; d.k[1] = *(const LAS bf16x8*)(p + 1024); }
__device__ __forceinline__ void ld_frag(i32x8& d, const LAS unsigned char* p) { const i32x4_t lo = *(const LAS i32x4_t*)p, hi = *(const LAS i32x4_t*)(p + 1024); d = __builtin_shufflevector(lo, hi, 0, 1, 2, 3, 4, 5, 6, 7); }
__device__ __forceinline__ void mma_frag(f32x4& acc, const FragB16& b, const FragB16& a) { acc = __builtin_amdgcn_mfma_f32_16x16x32_bf16(b.k[0], a.k[0], acc, 0, 0, 0); acc = __builtin_amdgcn_mfma_f32_16x16x32_bf16(b.k[1], a.k[1], acc, 0, 0, 0); }
__device__ __forceinline__ void lda_group(FragB16 (&At)[4], const LAS unsigned char* ab) {
#pragma unroll
    for (int m = 0; m < 4; ++m) ld_frag(At[m], ab + m * 2048); }
__device__ __forceinline__ void lda_group(i32x8 (&)[4], const LAS unsigned char*) {}
__device__ __forceinline__ void mma_frag(f32x4& acc, const i32x8& b, const i32x8& a);
__device__ __forceinline__ void mma_frag(f32x4& acc, const FragB16& b, const FragB16& a);
__device__ __forceinline__ void mma_group(f32x4 (&acc)[4][2], const FragB16 (&At)[4], const FragB16 (&Bt)[2], const LAS unsigned char*) {
#pragma unroll
    for (int m = 0; m < 4; ++m)
#pragma unroll
        for (int n = 0; n < 2; ++n) mma_frag(acc[m][n], Bt[n], At[m]); }
__device__ __forceinline__ void mma_group(f32x4 (&acc)[4][2], const i32x8 (&)[4], const i32x8 (&Bt)[2], const LAS unsigned char* ab) {
    i32x8 a0, a1;
    ld_frag(a0, ab); ld_frag(a1, ab + 2048);
    mma_frag(acc[0][0], Bt[0], a0); mma_frag(acc[0][1], Bt[1], a0);
    ld_frag(a0, ab + 2 * 2048);
    mma_frag(acc[1][0], Bt[0], a1); mma_frag(acc[1][1], Bt[1], a1);
    ld_frag(a1, ab + 3 * 2048);
    mma_frag(acc[2][0], Bt[0], a0); mma_frag(acc[2][1], Bt[1], a0);
    mma_frag(acc[3][0], Bt[0], a1); mma_frag(acc[3][1], Bt[1], a1); }
__device__ __forceinline__ void mma_frag(f32x4& acc, const i32x8& b, const i32x8& a) { acc = __builtin_amdgcn_mfma_scale_f32_16x16x128_f8f6f4(b, a, acc, 0, 0, 0, 0x7f7f7f7f, 0, 0x7f7f7f7f); }
template <class Epi>
__device__ __forceinline__ void gemm_phase(LAS unsigned char* lds, const Gemm g, const StaticOrder& S, const Epi& E) {
    const int tid = threadIdx.x, wid = __builtin_amdgcn_readfirstlane(tid >> 6), lane = tid & 63, wr = wid >> 2, wc = wid & 3, fr = lane & 15, fq = lane >> 4;
    const int K = g.K, lda = g.lda;
    unsigned voffA, voffB;
    { int R, C; stage_rc(tid * 16, R, C); const int Rb = Epi::PERM ? ((R & ~31) + perm32(R & 31)) : R;
      voffA = (unsigned)(R * lda + C) * 2u; voffB = (unsigned)(Rb * K + C) * 2u; }
    const size_t voffA_step = (size_t)64 * lda * 2, voffB_step = (size_t)64 * K * 2;
    const size_t kstep = (size_t)(BK * 2);
    const size_t hstepA = (size_t)HALF * lda * 2, hstepB = (size_t)HALF * K * 2;
    const size_t tstepA = 2 * hstepA, tstepB = 2 * hstepB;
    const unsigned ldsw = (unsigned)wid * 1024u;
    const int aoff = lds_byte(wr * 64 + fr, fq * 8), boff = lds_byte(wc * 32 + fr, fq * 8);
#define PG8_SA(b, h) (((b) * 2 + (h)) * HTB)
#define PG8_SB(b, h) ((4 + (b) * 2 + (h)) * HTB)
#define PG8_STAGE(bufoff, gbase, voff) do { _Pragma("unroll") for (int _i = 0; _i < 2; ++_i) \
        __builtin_amdgcn_global_load_lds((const unsigned*)((const char*)(gbase) + _i * voff##_step + (voff)), (LAS unsigned*)(lds + (bufoff) + ldsw + _i * 8192), 16, 0, 0); } while (0)
#define PG8_LDA(dst, b, h) lda_group(dst, lds + PG8_SA(b, h) + aoff)
#define PG8_LDB(dst, b, h) do { _Pragma("unroll") for (int n = 0; n < 2; ++n) ld_frag(dst[n], lds + PG8_SB(b, h) + boff + n * 2048); } while (0)
#define PG8_MMA(b, ai, bj, At, Bt) do { __builtin_amdgcn_s_setprio(1); mma_group(acc[ai][bj], At, Bt, lds + PG8_SA(b, ai) + aoff); __builtin_amdgcn_s_setprio(0); } while (0)
#define PG8_WAIT_V(n) asm volatile("s_waitcnt vmcnt(" #n ")" ::: "memory")
#define PG8_WAIT_L(n) asm volatile("s_waitcnt lgkmcnt(" #n ")" ::: "memory")
#define PG8_BAR __builtin_amdgcn_s_barrier()
#define PG8_SCHED __builtin_amdgcn_sched_barrier(0)
    Unit cur, nxt; int ui = 0;
    if (!S.next(0, cur)) return;
    f32x4 acc[2][2][4][2];
#pragma unroll
    for (int a = 0; a < 2; ++a)
#pragma unroll
        for (int b = 0; b < 2; ++b)
#pragma unroll
            for (int m = 0; m < 4; ++m)
#pragma unroll
                for (int n = 0; n < 2; ++n) acc[a][b][m][n] = (f32x4){0.f, 0.f, 0.f, 0.f};
    typename FragT<epi_f8<Epi>::v>::T At[4], B0[2], B1[2];
    int k0c, nt; unit_kwin(g, cur, k0c, nt);
    const char* cA = (const char*)g.A + (size_t)cur.pm * tstepA + (size_t)k0c * kstep; const char* cB = (const char*)g.Bt + (size_t)cur.pn * tstepB + (size_t)k0c * kstep;
    PG8_STAGE(PG8_SB(0, 0), cB, voffB); PG8_STAGE(PG8_SA(0, 0), cA, voffA); PG8_STAGE(PG8_SB(0, 1), cB + hstepB, voffB); PG8_STAGE(PG8_SA(0, 1), cA + hstepA, voffA);
    if (wr == 1) PG8_BAR;
    PG8_WAIT_V(4); PG8_BAR;
    PG8_STAGE(PG8_SB(1, 0), cB + kstep, voffB); PG8_STAGE(PG8_SA(1, 0), cA + kstep, voffA); PG8_STAGE(PG8_SB(1, 1), cB + hstepB + kstep, voffB);
    PG8_WAIT_V(6); PG8_BAR;
    for (;;) {
        const bool has_next = S.next(ui + 1, nxt);
        int k0n = 0, ntn = nt; if (has_next) unit_kwin(g, nxt, k0n, ntn);
        const char* nA = has_next ? (const char*)g.A + (size_t)nxt.pm * tstepA + (size_t)k0n * kstep : cA; const char* nB = has_next ? (const char*)g.Bt + (size_t)nxt.pn * tstepB + (size_t)k0n * kstep : cB;
        for (int t = 0; t < nt; t += 2) {
            const bool last = (t == nt - 2);
            const char* a1 = cA + (size_t)(t + 1) * kstep;
            const char* a2 = last ? nA : cA + (size_t)(t + 2) * kstep; const char* b2 = last ? nB : cB + (size_t)(t + 2) * kstep;
            const char* a3 = a2 + kstep; const char* b3 = b2 + kstep;
            PG8_LDB(B0, 0, 0); PG8_SCHED; PG8_LDA(At, 0, 0); PG8_STAGE(PG8_SA(1, 1), a1 + hstepA, voffA);
            PG8_WAIT_L(8); PG8_BAR; PG8_WAIT_L(0); PG8_MMA(0, 0, 0, At, B0); PG8_BAR; PG8_SCHED;
            PG8_LDB(B1, 0, 1); PG8_STAGE(PG8_SB(0, 0), b2, voffB);
            PG8_BAR; PG8_WAIT_L(0); PG8_MMA(0, 0, 1, At, B1); PG8_BAR;
            PG8_LDA(At, 0, 1); PG8_STAGE(PG8_SA(0, 0), a2, voffA);
            PG8_BAR; PG8_WAIT_L(0); PG8_MMA(0, 1, 0, At, B0); PG8_BAR; PG8_SCHED;
            PG8_STAGE(PG8_SB(0, 1), b2 + hstepB, voffB);
            PG8_WAIT_V(6); PG8_BAR; PG8_MMA(0, 1, 1, At, B1); PG8_BAR;
            PG8_LDB(B0, 1, 0); PG8_SCHED; PG8_LDA(At, 1, 0); PG8_STAGE(PG8_SA(0, 1), a2 + hstepA, voffA);
            PG8_WAIT_L(8); PG8_BAR; PG8_WAIT_L(0); PG8_MMA(1, 0, 0, At, B0); PG8_BAR; PG8_SCHED;
            PG8_LDB(B1, 1, 1); PG8_STAGE(PG8_SB(1, 0), b3, voffB);
            PG8_BAR; PG8_WAIT_L(0); PG8_MMA(1, 0, 1, At, B1); PG8_BAR;
            PG8_LDA(At, 1, 1); PG8_STAGE(PG8_SA(1, 0), a3, voffA);
            PG8_BAR; PG8_WAIT_L(0); PG8_MMA(1, 1, 0, At, B0); PG8_BAR; PG8_SCHED;
            PG8_STAGE(PG8_SB(1, 1), b3 + hstepB, voffB);
            PG8_WAIT_V(6); PG8_BAR; PG8_MMA(1, 1, 1, At, B1); PG8_BAR;
        }
        E(acc, cur, wr, wc, fr, fq);
        if (!has_next) break;
#pragma unroll
        for (int a = 0; a < 2; ++a)
#pragma unroll
            for (int b = 0; b < 2; ++b)
#pragma unroll
                for (int m = 0; m < 4; ++m)
#pragma unroll
                    for (int n = 0; n < 2; ++n) acc[a][b][m][n] = (f32x4){0.f, 0.f, 0.f, 0.f};
        cur = nxt; cA = nA; cB = nB; nt = ntn; ++ui;
    }
    PG8_WAIT_V(0);
    if (wr == 0) PG8_BAR;
    PG8_BAR;
#undef PG8_SA
#undef PG8_SB
#undef PG8_STAGE
#undef PG8_LDA
#undef PG8_LDB
#undef PG8_MMA
#undef PG8_WAIT_V
#undef PG8_WAIT_L
#undef PG8_BAR
#undef PG8_SCHED
}
}

#define XB_TMO      128
#define XB_XCNT(j)  (256  + 64 * (j))
#define XB_XSUB(j)  (1280 + 64 * (j))
#define XB_XGEN(j)  (2304 + 64 * (j))
#define XB_TOP      3328
#define XB_TOPGEN   3392
#define XCD_BAR_WORDS 3456
#define XB_SPIN_CAP (1u << 18)
__device__ __forceinline__ unsigned xb_ld(unsigned* p)              { return __hip_atomic_load(p, __ATOMIC_RELAXED, __HIP_MEMORY_SCOPE_AGENT); }
__device__ __forceinline__ unsigned xb_add(unsigned* p, unsigned v) { return __hip_atomic_fetch_add(p, v, __ATOMIC_RELAXED, __HIP_MEMORY_SCOPE_AGENT); }
__device__ __forceinline__ unsigned xb_xcc_id() { return (unsigned)__builtin_amdgcn_s_getreg((3 << 11) | 20) & 0xFu; }
#define XB_SPIN(cond, bar) do { unsigned _sp = 0; while (cond) { __builtin_amdgcn_s_sleep(1); \
    if ((++_sp & 255u) == 0u) { if (xb_ld(&(bar)[XB_TMO])) break; if (_sp > XB_SPIN_CAP) { atomicAdd(&(bar)[XB_TMO], 1u); break; } } } } while (0)
struct XcdBarrier { unsigned* bar; unsigned x; volatile LAS unsigned* st; };
__device__ __forceinline__ XcdBarrier xcd_barrier_post(unsigned* bar, volatile LAS unsigned* st) {
    XcdBarrier b; b.bar = bar; b.x = xb_xcc_id(); b.st = st;
    if (threadIdx.x == 0) (void)xb_add(&bar[XB_XCNT(b.x)], 1u);
    return b;
}
__device__ __forceinline__ void xcd_barrier_complete(unsigned* bar, unsigned x, unsigned& nloc, unsigned& nx) {
    const unsigned G = gridDim.x * gridDim.y * gridDim.z;
    unsigned sum, cnt, mine, sp = 0u;
    for (;;) {
        sum = 0u; cnt = 0u; mine = 0u;
#pragma unroll
        for (unsigned j = 0; j < 16; ++j) { const unsigned c = xb_ld(&bar[XB_XCNT(j)]); sum += c; cnt += (c > 0u) ? 1u : 0u; mine = (j == x) ? c : mine; }
        if (sum == G) break;
        __builtin_amdgcn_s_sleep(1);
        if ((++sp & 255u) == 0u) { if (xb_ld(&bar[XB_TMO])) break; if (sp > XB_SPIN_CAP) { atomicAdd(&bar[XB_TMO], 1u); break; } }
    }
    nloc = mine > 0u ? mine : 1u; nx = cnt > 0u ? cnt : 1u;
}
__device__ __forceinline__ void xcd_barrier(const XcdBarrier& b) {
    asm volatile("s_waitcnt vmcnt(0)" ::: "memory");
    __syncthreads();
    if (threadIdx.x == 0) {
        unsigned* bar = b.bar;
        __builtin_amdgcn_s_waitcnt(0);
        unsigned nloc = b.st[0], nx = b.st[1];
        if (nloc == 0u) { xcd_barrier_complete(bar, b.x, nloc, nx); b.st[0] = nloc; b.st[1] = nx; }
        const unsigned old = xb_add(&bar[XB_XSUB(b.x)], 1u);
        const unsigned gen = old / nloc;
        if (old + 1u == (gen + 1u) * nloc) {
            __builtin_amdgcn_fence(__ATOMIC_RELEASE, "agent");
            asm volatile("s_waitcnt vmcnt(0)" ::: "memory");
            const unsigned og = xb_add(&bar[XB_TOP], 1u);
            const unsigned tg = og / nx;
            if (og + 1u == (tg + 1u) * nx) xb_add(&bar[XB_TOPGEN], 1u);
            else XB_SPIN(xb_ld(&bar[XB_TOPGEN]) == tg, bar);
            __builtin_amdgcn_fence(__ATOMIC_ACQUIRE, "agent");
            xb_add(&bar[XB_XGEN(b.x)], 1u);
            asm volatile("s_waitcnt vmcnt(0)" ::: "memory");
        } else {
            XB_SPIN(xb_ld(&bar[XB_XGEN(b.x)]) == gen, bar);
            __builtin_amdgcn_fence(__ATOMIC_ACQUIRE, "agent");
            asm volatile("s_waitcnt vmcnt(0)" ::: "memory");
        }
    }
    __syncthreads();
}

struct Args { const float* in[32]; float* out; unsigned char* ws; int lo, hi; };
typedef const Args __attribute__((address_space(4))) KArgs;
enum { I_X = 0, I_NMG, I_WIN, I_MU, I_W0, I_W2, I_A0, I_A2, I_G2, I_V0, I_V1, I_V2, I_KK, I_KA, I_RK, I_LNW, I_LNB, I_WRB, I_CW, I_CB, I_DTB, I_ALOG, I_SD, I_SNG, I_WSB, I_WOUT, I_NFG, I_WQ, I_SK, I_PD, I_PU, I_NFIN };

struct NoTmp {};
struct FStoreBf16 { bf16* O; int ldc; typedef NoTmp Tmp; static constexpr int GRP = 16;
    __device__ __forceinline__ void load(int, int, int, Tmp&) const {}
    __device__ __forceinline__ void apply(int row, int col, f32x4 v0, f32x4 v1, int, const Tmp&) const {
        v4u w; w.x = pk2(v0[0], v0[1]); w.y = pk2(v0[2], v0[3]); w.z = pk2(v1[0], v1[1]); w.w = pk2(v1[2], v1[3]);
        *(v4u*)(O + (size_t)row * ldc + col) = w; } };
struct FSigmoidBf16 { bf16* O; int ldc; typedef NoTmp Tmp; static constexpr int GRP = 16;
    __device__ __forceinline__ void load(int, int, int, Tmp&) const {}
    __device__ __forceinline__ void apply(int row, int col, f32x4 v0, f32x4 v1, int, const Tmp&) const {
        v4u w; w.x = pk2(sigmoidf_(v0[0]), sigmoidf_(v0[1])); w.y = pk2(sigmoidf_(v0[2]), sigmoidf_(v0[3])); w.z = pk2(sigmoidf_(v1[0]), sigmoidf_(v1[1])); w.w = pk2(sigmoidf_(v1[2]), sigmoidf_(v1[3]));
        *(v4u*)(O + (size_t)row * ldc + col) = w; } };
struct FStoreBf16S { bf16* O; int ldc; const float* xs; const float* wsc; typedef float Tmp; static constexpr int GRP = 4;
    __device__ __forceinline__ void load(int row, int, int, Tmp& t) const { t = xs[row] * wsc[0]; }
    __device__ __forceinline__ void apply(int row, int col, f32x4 v0, f32x4 v1, int, const Tmp& t) const {
        v0 *= t; v1 *= t;
        v4u w; w.x = pk2c(v0[0], v0[1]); w.y = pk2c(v0[2], v0[3]); w.z = pk2c(v1[0], v1[1]); w.w = pk2c(v1[2], v1[3]);
        *(v4u*)(O + (size_t)row * ldc + col) = w; } };
struct FSigmoidBf16S { bf16* O; int ldc; const float* xs; const float* wsc; typedef float Tmp; static constexpr int GRP = 4;
    __device__ __forceinline__ void load(int row, int, int, Tmp& t) const { t = xs[row] * wsc[0]; }
    __device__ __forceinline__ void apply(int row, int col, f32x4 v0, f32x4 v1, int, const Tmp& t) const {
        v0 *= t; v1 *= t;
        v4u w; w.x = pk2c(sigmoidf_(v0[0]), sigmoidf_(v0[1])); w.y = pk2c(sigmoidf_(v0[2]), sigmoidf_(v0[3])); w.z = pk2c(sigmoidf_(v1[0]), sigmoidf_(v1[1])); w.w = pk2c(sigmoidf_(v1[2]), sigmoidf_(v1[3]));
        *(v4u*)(O + (size_t)row * ldc + col) = w; } };
namespace pg8 { template <> struct epi_f8<EpiRow8<FStoreBf16S>> { static constexpr bool v = true; }; template <> struct epi_f8<EpiRow8<FSigmoidBf16S>> { static constexpr bool v = true; }; }
struct EpiLora {
    static constexpr bool PERM = true;
    bf16 *elog, *asig, *gg, *vmix; const bf16* vf; const float *w0, *a0, *v0;
    template <int BLK> __device__ __forceinline__ void run(const f32x4 (&acc)[2][2][4][2], int row0, int col0) const {
#pragma unroll
        for (int bj = 0; bj < 2; ++bj) {
            const int c = (col0 + bj * 128) & 1023;
            float bias[8];
            if (BLK == 0 || BLK == 1 || BLK == 3) { const float* bp = (BLK == 0 ? w0 : (BLK == 1 ? a0 : v0)) + c; const f32x4 b0 = *(const f32x4*)bp, b1 = *(const f32x4*)(bp + 4);
                bias[0] = b0[0]; bias[1] = b0[1]; bias[2] = b0[2]; bias[3] = b0[3]; bias[4] = b1[0]; bias[5] = b1[1]; bias[6] = b1[2]; bias[7] = b1[3]; }
#pragma unroll
            for (int ai = 0; ai < 2; ++ai) {
            v4u qvs[4], qvf[4];
            if (BLK == 3) {
#pragma unroll
                for (int i = 0; i < 4; ++i) { const size_t o = (size_t)(row0 + ai * 128 + i * 16) * D + c; qvs[i] = *(const v4u*)(vmix + o); qvf[i] = *(const v4u*)(vf + o); }
            }
#pragma unroll
                for (int m = 0; m < 4; ++m) {
                    const int row = row0 + ai * 128 + m * 16; const size_t o = (size_t)row * D + c;
                    const f32x4 v0_ = acc[ai][bj][m][0], v1_ = acc[ai][bj][m][1];
                    float a[8] = {v0_[0], v0_[1], v0_[2], v0_[3], v1_[0], v1_[1], v1_[2], v1_[3]};
                    if (BLK == 0) {
#pragma unroll
                        for (int e = 0; e < 8; ++e) a[e] = -0.6065306597f * sigmoidf_(bias[e] + a[e]);
                        *(v4u*)(elog + o) = pack8(a);
                    } else if (BLK == 1) {
#pragma unroll
                        for (int e = 0; e < 8; ++e) a[e] = sigmoidf_(bias[e] + a[e]);
                        *(v4u*)(asig + o) = pack8(a);
                    } else if (BLK == 2) {
                        *(v4u*)(gg + o) = pack8(a);
                    } else {
                        float vs[8], vfv[8]; unpack8(qvs[m], vs); unpack8(qvf[m], vfv);
#pragma unroll
                        for (int e = 0; e < 8; ++e) a[e] = vs[e] + (vfv[e] - vs[e]) * sigmoidf_(bias[e] + a[e]);
                        *(v4u*)(vmix + o) = pack8(a);
                    }
                }
            }
        }
    }
    __device__ __forceinline__ void operator()(const f32x4 (&acc)[2][2][4][2], const pg8::Unit& u, int wr, int wc, int fr, int fq) const {
        const int row0 = u.pm * 256 + wr * 64 + fr, col0 = u.pn * 256 + wc * 32 + 8 * fq;
        const int blk = u.pn >> 2;
        if (blk == 0) run<0>(acc, row0, col0); else if (blk == 1) run<1>(acc, row0, col0); else if (blk == 2) run<2>(acc, row0, col0); else run<3>(acc, row0, col0);
    }
};
struct FMixA { const bf16* gates; bf16* mixed;
    struct Tmp { v4u g; }; static constexpr int GRP = 8;
    __device__ __forceinline__ void load(int row, int col, int, Tmp& t) const { t.g = *(const v4u*)(gates + (size_t)row * 2048 + col); }
    __device__ __forceinline__ void apply(int row, int col, f32x4 v0, f32x4 v1, int, const Tmp& t) const {
        float g[8]; unpack8(t.g, g);
        float a[8] = {v0[0] * g[0], v0[1] * g[1], v0[2] * g[2], v0[3] * g[3], v1[0] * g[4], v1[1] * g[5], v1[2] * g[6], v1[3] * g[7]};
        *(v4u*)(mixed + (size_t)row * D + col) = pack8(a); } };
struct FMixB { const bf16* gates; bf16* mixed;
    struct Tmp { v4u g, mx; }; static constexpr int GRP = 8;
    __device__ __forceinline__ void load(int row, int col, int, Tmp& t) const { t.g = *(const v4u*)(gates + (size_t)row * 2048 + 1024 + col); t.mx = *(const v4u*)(mixed + (size_t)row * D + col); }
    __device__ __forceinline__ void apply(int row, int col, f32x4 v0, f32x4 v1, int, const Tmp& t) const {
        float g[8], mx[8]; unpack8(t.g, g); unpack8(t.mx, mx);
        float a[8] = {mx[0] + v0[0] * g[0], mx[1] + v0[1] * g[1], mx[2] + v0[2] * g[2], mx[3] + v0[3] * g[3], mx[4] + v1[0] * g[4], mx[5] + v1[1] * g[5], mx[6] + v1[2] * g[6], mx[7] + v1[3] * g[7]};
        *(v4u*)(mixed + (size_t)row * D + col) = pack8(a); } };
struct FResid { const float* base; float* h;
    struct Tmp { f32x4 a, b; }; static constexpr int GRP = 8;
    __device__ __forceinline__ void load(int row, int col, int, Tmp& t) const { const f32x4* s = (const f32x4*)(base + (size_t)row * D + col); t.a = s[0]; t.b = s[1]; }
    __device__ __forceinline__ void apply(int row, int col, f32x4 v0, f32x4 v1, int, const Tmp& t) const {
        f32x4* p = (f32x4*)(h + (size_t)row * D + col); p[0] = t.a + v0; p[1] = t.b + v1; } };

struct Ctx { int tid, lane, wave, G, bid; LAS unsigned char* lds; };

__device__ __forceinline__ void transpose_item(const float* W, int K, int N, bf16* WT, int row_off, LAS float* scr, int item, int lane) {
    const int nblk = N / 32, kb = item / nblk, nb = item % nblk, k0 = 64 * kb, n0 = 32 * nb;
#pragma unroll 8
    for (int i = 0; i < 32; ++i) { const int kk = 2 * i + (lane >> 5); scr[kk * 33 + (lane & 31)] = W[(size_t)(k0 + kk) * N + n0 + (lane & 31)]; }
    asm volatile("s_waitcnt lgkmcnt(0)" ::: "memory");
    const int c = lane & 7;
#pragma unroll
    for (int j = 0; j < 4; ++j) { const int n = (lane >> 3) + 8 * j; const LAS float* s = scr + (8 * c) * 33 + n;
        v4u o; o.x = pk2(s[0 * 33], s[1 * 33]); o.y = pk2(s[2 * 33], s[3 * 33]); o.z = pk2(s[4 * 33], s[5 * 33]); o.w = pk2(s[6 * 33], s[7 * 33]);
        *(v4u*)(WT + (size_t)(row_off + n0 + n) * K + k0 + 8 * c) = o; }
    asm volatile("s_waitcnt lgkmcnt(0)" ::: "memory");
}
__device__ __forceinline__ void transpose_item8(const float* W, int K, int N, unsigned char* WT, int row_off, LAS float* scr, int item, int lane, float qs) {
    const int nblk = N / 32, kb = item / nblk, nb = item % nblk, k0 = 64 * kb, n0 = 32 * nb;
#pragma unroll 8
    for (int i = 0; i < 32; ++i) { const int kk = 2 * i + (lane >> 5); scr[kk * 33 + (lane & 31)] = W[(size_t)(k0 + kk) * N + n0 + (lane & 31)]; }
    asm volatile("s_waitcnt lgkmcnt(0)" ::: "memory");
    const int c = lane & 7;
#pragma unroll
    for (int j = 0; j < 4; ++j) { const int n = (lane >> 3) + 8 * j; const LAS float* s = scr + (8 * c) * 33 + n;
        int w0 = __builtin_amdgcn_cvt_pk_fp8_f32(s[0 * 33] * qs, s[1 * 33] * qs, 0, false); w0 = __builtin_amdgcn_cvt_pk_fp8_f32(s[2 * 33] * qs, s[3 * 33] * qs, w0, true);
        int w1 = __builtin_amdgcn_cvt_pk_fp8_f32(s[4 * 33] * qs, s[5 * 33] * qs, 0, false); w1 = __builtin_amdgcn_cvt_pk_fp8_f32(s[6 * 33] * qs, s[7 * 33] * qs, w1, true);
        v2u o; o.x = (unsigned)w0; o.y = (unsigned)w1;
        *(v2u*)(WT + (size_t)(row_off + n0 + n) * K + k0 + 8 * c) = o; }
    asm volatile("s_waitcnt lgkmcnt(0)" ::: "memory");
}
__device__ __forceinline__ void phase_winmax(const Ctx& c, KArgs& a) {
    unsigned* CT = (unsigned*)(a.ws + WS_CTL);
#pragma unroll 1
    for (int l = 0; l < 2; ++l) {
        const f32x4* W = (const f32x4*)(a.in[I_WIN] + (size_t)l * D * IN_PROJ);
        float am = 0.f;
        for (int i = c.bid * 512 + c.tid; i < D * IN_PROJ / 4; i += c.G * 512) { const f32x4 v = W[i]; am = fmaxf(am, fmaxf(fmaxf(fabsf(v.x), fabsf(v.y)), fmaxf(fabsf(v.z), fabsf(v.w)))); }
#pragma unroll
        for (int o = 1; o < 64; o <<= 1) am = fmaxf(am, __shfl_xor(am, o));
        if (c.lane == 0) __hip_atomic_fetch_max(CT + CW_WMAX + l, __builtin_bit_cast(unsigned, am), __ATOMIC_RELAXED, __HIP_MEMORY_SCOPE_AGENT);
    }
}
__device__ __forceinline__ int winrow(int n) {
    if (n < RW_PROJ) return n;
    if (n < RW_PROJ + 5120) return N1P + (n - RW_PROJ);
    if (n < RW_PROJ + SSD_PROJ) return DT_COL + (n - RW_PROJ - 5120);
    return N1P + N2P + (n - RW_PROJ - SSD_PROJ); }

__device__ __forceinline__ void phase_prologue(const Ctx& c, KArgs& a) {
    unsigned char* ws = a.ws;
    LAS float* scr = (LAS float*)(c.lds + c.wave * 16384);
    const int gw = c.bid * 8 + c.wave, NGW = c.G * 8;
    constexpr int I_IN = 16 * (IN_PROJ / 32), I_A = 16 * 32, I_B = 32 * 32, I_O = 16 * 32, I_L = I_IN + I_A + I_B + I_O;
    for (int it = gw; it < 2 * I_L; it += NGW) {
        const int l = it / I_L; int r = it % I_L;
        if (r < I_IN) { const int nb = r % (IN_PROJ / 32); const float am = fmaxf(__builtin_bit_cast(float, __hip_atomic_load((const unsigned*)(ws + WS_CTL) + CW_WMAX + l, __ATOMIC_RELAXED, __HIP_MEMORY_SCOPE_AGENT)), 1e-30f);
            transpose_item8(a.in[I_WIN] + (size_t)l * D * IN_PROJ, D, IN_PROJ, ws + WS_WIN + l * WIN8_L, winrow(nb * 32) - nb * 32, scr, r, c.lane, 384.f / am); continue; } r -= I_IN;
        if (r < I_A) { transpose_item(a.in[I_WRB] + (size_t)l * D * D, D, D, (bf16*)(ws + WS_WA) + (size_t)l * D * D, 0, scr, r, c.lane); continue; } r -= I_A;
        if (r < I_B) { transpose_item(a.in[I_WSB] + (size_t)l * 2048 * D, 2048, D, (bf16*)(ws + WS_WB) + (size_t)l * D * 2048, 0, scr, r, c.lane); continue; } r -= I_B;
        transpose_item(a.in[I_WOUT] + (size_t)l * D * D, D, D, (bf16*)(ws + WS_WO) + (size_t)l * D * D, 0, scr, r, c.lane);
    }
    for (int it = c.bid * 512 + c.tid; it < 2 * 192 * 64; it += c.G * 512) {
        const int l = it / (192 * 64), r = (it / 64) % 192, q = it % 64;
        *(v4u*)(ws + WS_WIN + l * WIN8_L + (size_t)(DT_COL + 32 + r) * D + q * 16) = (v4u){0u, 0u, 0u, 0u};
    }
    if (c.bid == 0 && c.tid < 2) ((float*)(ws + WS_CTL))[CW_WSC + c.tid] = fmaxf(__builtin_bit_cast(float, __hip_atomic_load((const unsigned*)(ws + WS_CTL) + CW_WMAX + c.tid, __ATOMIC_RELAXED, __HIP_MEMORY_SCOPE_AGENT)), 1e-30f) * (1.f / 384.f);
    for (int it = c.bid * 512 + c.tid; it < 2 * 4096 * KL; it += c.G * 512) {
        const int l = it / (4096 * KL), n = (it / KL) % 4096, k = it % KL; const int blk = n >> 10, cc = n & 1023;
        float v = 0.f;
        if (blk == 0) { if (k < 64) v = a.in[I_W2][((size_t)l * 64 + k) * D + cc]; }
        else if (blk == 1) { if (k >= 64 && k < 128) v = a.in[I_A2][((size_t)l * 64 + (k - 64)) * D + cc]; }
        else if (blk == 2) { if (k >= 128 && k < 288) v = a.in[I_G2][((size_t)l * 160 + (k - 128)) * D + cc]; }
        else { if (l == 1 && k >= 288 && k < 320) v = a.in[I_V2][(size_t)(k - 288) * D + cc]; }
        ((bf16*)(ws + WS_WLORA + l * WLORA_L))[(size_t)n * KL + k] = (bf16)f2bf(v);
    }
    __syncthreads();
    LAS float* wqL = (LAS float*)c.lds;
    LAS float* kyL = (LAS float*)(c.lds + 32768);
    for (int it = c.bid; it < 2 * 16 * 16; it += c.G) {
        const int l = it >> 8, hc = (it >> 4) & 15, k0 = (it & 15) * 64;
        const float* wq = a.in[I_WQ] + (size_t)l * D * 2048; const float* ky = a.in[I_SK] + ((size_t)l * 16 + hc) * 128 * 128;
        for (int e = c.tid; e < 64 * 128; e += 512) wqL[e] = wq[(size_t)(k0 + (e >> 7)) * 2048 + hc * 128 + (e & 127)];
        for (int e = c.tid; e < 128 * 128; e += 512) kyL[(e >> 7) * 129 + (e & 127)] = ky[e];
        __syncthreads();
        const int key = c.tid & 127, kg = c.tid >> 7;
        float acc[16];
#pragma unroll
        for (int i = 0; i < 16; ++i) acc[i] = 0.f;
        for (int d = 0; d < 128; ++d) { const float kv = kyL[key * 129 + d];
#pragma unroll
            for (int i = 0; i < 16; ++i) acc[i] += wqL[(kg * 16 + i) * 128 + d] * kv; }
        bf16* o = (bf16*)(ws + WS_WQK) + ((size_t)l * 2048 + hc * 128 + key) * D + k0 + kg * 16;
        v4u q0, q1; q0.x = pk2(acc[0], acc[1]); q0.y = pk2(acc[2], acc[3]); q0.z = pk2(acc[4], acc[5]); q0.w = pk2(acc[6], acc[7]);
        q1.x = pk2(acc[8], acc[9]); q1.y = pk2(acc[10], acc[11]); q1.z = pk2(acc[12], acc[13]); q1.w = pk2(acc[14], acc[15]);
        *(v4u*)o = q0; *(v4u*)(o + 8) = q1;
        __syncthreads();
    }
}

__device__ __forceinline__ void phase_rmsnorm(const Ctx& c, const float* src, const float* g, bf16* U, float* copy_to) {
    const int gw = c.bid * 8 + c.wave, NGW = c.G * 8;
    f32x4 gv[4];
#pragma unroll
    for (int j = 0; j < 4; ++j) gv[j] = *((const f32x4*)g + c.lane + 64 * j);
    f32x4 nv[4];
    if (gw < M) { const f32x4* xr0 = (const f32x4*)(src + (size_t)gw * D) + c.lane;
#pragma unroll
        for (int j = 0; j < 4; ++j) nv[j] = xr0[64 * j]; }
    for (int m = gw; m < M; m += NGW) {
        f32x4 v[4]; float s = 0.f;
#pragma unroll
        for (int j = 0; j < 4; ++j) { v[j] = nv[j]; s += (v[j].x * v[j].x + v[j].y * v[j].y) + (v[j].z * v[j].z + v[j].w * v[j].w); }
        if (m + NGW < M) { const f32x4* xn = (const f32x4*)(src + (size_t)(m + NGW) * D) + c.lane;
#pragma unroll
            for (int j = 0; j < 4; ++j) nv[j] = xn[64 * j]; }
        if (copy_to) { f32x4* cr = (f32x4*)(copy_to + (size_t)m * D) + c.lane;
#pragma unroll
            for (int j = 0; j < 4; ++j) cr[64 * j] = v[j]; }
        const float r = rsqrtf(sum64(s) * (1.f / D) + 1e-6f);
        v2u* o = (v2u*)(U + (size_t)m * D) + c.lane;
#pragma unroll
        for (int j = 0; j < 4; ++j) { v2u w; w.x = pk2(v[j].x * r * gv[j].x, v[j].y * r * gv[j].y); w.y = pk2(v[j].z * r * gv[j].z, v[j].w * r * gv[j].w); o[64 * j] = w; }
    }
}
__device__ __forceinline__ void phase_rmsnorm_q8(const Ctx& c, const float* src, const float* g, bf16* U, unsigned char* U8, float* XS) {
    const int gw = c.bid * 8 + c.wave, NGW = c.G * 8;
    f32x4 gv[4];
#pragma unroll
    for (int j = 0; j < 4; ++j) gv[j] = *((const f32x4*)g + c.lane + 64 * j);
    f32x4 nv[4];
    if (gw < M) { const f32x4* xr0 = (const f32x4*)(src + (size_t)gw * D) + c.lane;
#pragma unroll
        for (int j = 0; j < 4; ++j) nv[j] = xr0[64 * j]; }
    for (int m = gw; m < M; m += NGW) {
        f32x4 v[4]; float s = 0.f;
#pragma unroll
        for (int j = 0; j < 4; ++j) { v[j] = nv[j]; s += (v[j].x * v[j].x + v[j].y * v[j].y) + (v[j].z * v[j].z + v[j].w * v[j].w); }
        if (m + NGW < M) { const f32x4* xn = (const f32x4*)(src + (size_t)(m + NGW) * D) + c.lane;
#pragma unroll
            for (int j = 0; j < 4; ++j) nv[j] = xn[64 * j]; }
        const float r = rsqrtf(sum64(s) * (1.f / D) + 1e-6f);
        float am = 0.f;
#pragma unroll
        for (int j = 0; j < 4; ++j) { v[j] = v[j] * r * gv[j]; am = fmaxf(am, fmaxf(fmaxf(fabsf(v[j].x), fabsf(v[j].y)), fmaxf(fabsf(v[j].z), fabsf(v[j].w)))); }
#pragma unroll
        for (int o = 1; o < 64; o <<= 1) am = fmaxf(am, __shfl_xor(am, o));
        am = fmaxf(am, 1e-30f);
        const float qs = 384.f / am;
        v2u* o = (v2u*)(U + (size_t)m * D) + c.lane;
        unsigned* o8 = (unsigned*)(U8 + (size_t)m * D) + c.lane;
#pragma unroll
        for (int j = 0; j < 4; ++j) { if (U) { v2u w; w.x = pk2(v[j].x, v[j].y); w.y = pk2(v[j].z, v[j].w); o[64 * j] = w; }
            int w8 = __builtin_amdgcn_cvt_pk_fp8_f32(v[j].x * qs, v[j].y * qs, 0, false); w8 = __builtin_amdgcn_cvt_pk_fp8_f32(v[j].z * qs, v[j].w * qs, w8, true); o8[64 * j] = (unsigned)w8; }
        if (c.lane == 0) XS[m] = am * (1.f / 384.f);
    }
}
__device__ __forceinline__ void phase_final(const Ctx& c, float* out, const float* g) {
    const int gw = c.bid * 8 + c.wave, NGW = c.G * 8;
    f32x4 gv[4];
#pragma unroll
    for (int j = 0; j < 4; ++j) gv[j] = *((const f32x4*)g + c.lane + 64 * j);
    for (int m = gw; m < M; m += NGW) {
        f32x4* xr = (f32x4*)(out + (size_t)m * D) + c.lane;
        f32x4 v[4]; float s = 0.f;
#pragma unroll
        for (int j = 0; j < 4; ++j) { v[j] = xr[64 * j]; s += (v[j].x * v[j].x + v[j].y * v[j].y) + (v[j].z * v[j].z + v[j].w * v[j].w); }
        const float r = rsqrtf(sum64(s) * (1.f / D) + 1e-6f);
#pragma unroll
        for (int j = 0; j < 4; ++j) xr[64 * j] = v[j] * r * gv[j];
    }
}

__device__ __forceinline__ void phase_rwkv_prep(const Ctx& c, KArgs& a, int l, int hb) {
    unsigned char* ws = a.ws;
    const bf16* PR = (const bf16*)(ws + WS_OV + OV_PR);
    bf16* AL = (bf16*)(ws + WS_OV + OV_AL);
    bf16* VS = l == 0 ? (bf16*)(ws + WS_VF) + (size_t)hb * MH * D : (bf16*)(ws + WS_OV + OV_VMIX);
    const float* mu = a.in[I_MU] + (size_t)l * RW_PROJ;
    LAS bf16* v1L = (LAS bf16*)c.lds;
    if (l == 1) {
        const float* v1 = a.in[I_V1];
        for (int e = c.tid; e < 1024 * 32; e += 512) { const int cc = e >> 5, j = e & 31; v1L[((cc & 15) * 64 + (cc >> 4)) * 40 + j] = (bf16)f2bf(v1[e]); }
        __syncthreads();
    }
    const int gw = c.bid * 8 + c.wave, NGW = c.G * 8, lane = c.lane;
    float muv[16], mul[8];
#pragma unroll
    for (int e = 0; e < 16; ++e) muv[e] = mu[2048 + 16 * lane + e];
#pragma unroll
    for (int e = 0; e < 8; ++e) mul[e] = lane < 36 ? mu[3072 + 8 * lane + e] : 0.f;
    const int per = (MH + NGW - 1) / NGW;
    const int mA = gw * per, mB = (mA + per < MH) ? mA + per : MH;
    v4u cq0, cq1, cql, pq0, pq1, pql;
    const v4u zz4 = (v4u){0u, 0u, 0u, 0u};
    const int lcol = lane < 36 ? 3072 + 8 * lane : 3072;
    if (mA < mB) {
        const bf16* row = PR + (size_t)mA * N1P;
        cq0 = *(const v4u*)(row + 2048 + 16 * lane); cq1 = *(const v4u*)(row + 2048 + 16 * lane + 8); cql = *(const v4u*)(row + lcol);
        if ((mA & (T - 1)) != 0) { pq0 = *(const v4u*)(row - N1P + 2048 + 16 * lane); pq1 = *(const v4u*)(row - N1P + 2048 + 16 * lane + 8); pql = *(const v4u*)(row - N1P + lcol); }
        else { pq0 = zz4; pq1 = zz4; pql = zz4; }
    }
    for (int m = mA; m < mB; ++m) {
        const v4u q0 = cq0, q1 = cq1, ql = cql;
        v4u r0 = pq0, r1 = pq1, rl = pql;
        if ((m & (T - 1)) == 0) { r0 = zz4; r1 = zz4; rl = zz4; }
        if (m + 1 < mB) { const bf16* nrow = PR + (size_t)(m + 1) * N1P; cq0 = *(const v4u*)(nrow + 2048 + 16 * lane); cq1 = *(const v4u*)(nrow + 2048 + 16 * lane + 8); cql = *(const v4u*)(nrow + lcol); }
        pq0 = q0; pq1 = q1; pql = ql;
        float vs[16];
        {
            float p[16], pp[16];
            float t8[8];
            unpack8(q0, t8);
#pragma unroll
            for (int e = 0; e < 8; ++e) p[e] = t8[e];
            unpack8(q1, t8);
#pragma unroll
            for (int e = 0; e < 8; ++e) p[8 + e] = t8[e];
            unpack8(r0, t8);
#pragma unroll
            for (int e = 0; e < 8; ++e) pp[e] = t8[e];
            unpack8(r1, t8);
#pragma unroll
            for (int e = 0; e < 8; ++e) pp[8 + e] = t8[e];
#pragma unroll
            for (int e = 0; e < 16; ++e) vs[e] = p[e] + (pp[e] - p[e]) * muv[e];
            v4u o0, o1;
            o0.x = pk2(vs[0], vs[1]); o0.y = pk2(vs[2], vs[3]); o0.z = pk2(vs[4], vs[5]); o0.w = pk2(vs[6], vs[7]);
            o1.x = pk2(vs[8], vs[9]); o1.y = pk2(vs[10], vs[11]); o1.z = pk2(vs[12], vs[13]); o1.w = pk2(vs[14], vs[15]);
            *(v4u*)(VS + (size_t)m * D + 16 * lane) = o0; *(v4u*)(VS + (size_t)m * D + 16 * lane + 8) = o1;
        }
        if (lane < 36) {
            float p[8], pp[8], s[8];
            unpack8(ql, p);
            unpack8(rl, pp);
#pragma unroll
            for (int e = 0; e < 8; ++e) { const float x = p[e] + (pp[e] - p[e]) * mul[e]; s[e] = lane < 8 ? tanhf(x) : (lane < 16 ? x : sigmoidf_(x)); }
            *(v4u*)(AL + (size_t)m * KL + 8 * lane) = pack8(s);
        } else if (lane < 48 && !(l == 1 && lane < 40)) {
            *(v4u*)(AL + (size_t)m * KL + 8 * lane) = (v4u){0u, 0u, 0u, 0u};
        }
        if (l == 1) {
            float acc[32];
#pragma unroll
            for (int j = 0; j < 32; ++j) acc[j] = 0.f;
#pragma unroll
            for (int i = 0; i < 16; ++i) {
                const LAS v4u* wp = (const LAS v4u*)(v1L + (i * 64 + lane) * 40);
#pragma unroll
                for (int q = 0; q < 4; ++q) { float w8[8]; const v4u wq_ = wp[q]; unpack8(wq_, w8);
#pragma unroll
                    for (int e = 0; e < 8; ++e) acc[q * 8 + e] += vs[i] * w8[e]; }
            }
#pragma unroll
            for (int s = 32, half = 16; s >= 2; s >>= 1, half >>= 1) {
                const bool up = (lane & s) != 0;
#pragma unroll
                for (int i = 0; i < 16; ++i) if (i < half) { const float send = up ? acc[i] : acc[i + half]; const float keep = up ? acc[i + half] : acc[i]; acc[i] = keep + __shfl_xor(send, s); }
            }
            acc[0] += __shfl_xor(acc[0], 1);
            const int j = ((lane & 32) ? 16 : 0) + ((lane & 16) ? 8 : 0) + ((lane & 8) ? 4 : 0) + ((lane & 4) ? 2 : 0) + ((lane & 2) ? 1 : 0);
            if ((lane & 1) == 0) AL[(size_t)m * KL + 288 + j] = (bf16)f2bf(acc[0]);
        }
    }
    { float* DT = (float*)(ws + WS_OV + OV_DT); float* DA = (float*)(ws + WS_OV + OV_DA);
      for (int it = gw; it < (MH / 64) * 32; it += NGW) {
        const int ck = it >> 5, h = it & 31;
        const size_t m = (size_t)ck * 64 + lane;
        const float x = bf1(PR[m * N1P + DT_COL + h]) + a.in[I_DTB][l * 32 + h];
        const float dt = x > 20.f ? x : log1pf(__expf(x));
        float cs = -dt * __expf(a.in[I_ALOG][l * 32 + h]);
#pragma unroll
        for (int o = 1; o < 64; o <<= 1) { const float y = __shfl_up(cs, o); cs += (lane >= o) ? y : 0.f; }
        DT[m * 32 + h] = dt; DA[m * 32 + h] = cs;
      } }
}

__device__ __forceinline__ float sum8(float x) { x += dpp_mov<0xB1>(x); x += dpp_mov<0x4E>(x); x += dpp_mov<0x141>(x); return x; }
__device__ __forceinline__ void phase_rwkv_rec(const Ctx& c, KArgs& a, int l, int hb) {
    unsigned char* ws = a.ws;
    const bf16* PR = (const bf16*)(ws + WS_OV + OV_PR);
    const bf16* ELOG = (const bf16*)(ws + WS_OV + OV_ELOG);
    const bf16* ASIG = (const bf16*)(ws + WS_OV + OV_ASIG);
    const bf16* VS = l == 0 ? (const bf16*)(ws + WS_VF) + (size_t)hb * MH * D : (const bf16*)(ws + WS_OV + OV_VMIX);
    bf16* Y = (bf16*)(ws + WS_OV + OV_YA);
    const float* mu = a.in[I_MU] + (size_t)l * RW_PROJ;
    const float* k_k = a.in[I_KK] + (size_t)l * D; const float* k_a = a.in[I_KA] + (size_t)l * D;
    constexpr int CH = 32, NCH = T / CH;
    constexpr int ARRF = CH * 64;
    constexpr int BUFF = 5 * ARRF + CH * 16 + CH * 2;
    LAS float* ldsf = (LAS float*)c.lds;
    LAS float* yt = ldsf + 2 * BUFF;
    const int tid = c.tid, lane = c.lane;
    const bool is_prep = c.wave >= 4;
    const int ptid = tid - 256, tt = ptid >> 3, l8 = ptid & 7, pc = l8 * 8;
    const int rrow = c.wave * 4 + (lane >> 4), cc4 = (lane & 15) * 4;
    for (int unit = c.bid; unit < 256; unit += c.G) {
        const int b = unit >> 6, h = (unit >> 2) & 15, rq = unit & 3;
        const size_t m0 = (size_t)b * T;
        const int hc = h * 64 + pc;
        float mur[8], muk[8], kkc[8], kac[8];
        if (is_prep) {
#pragma unroll
            for (int e = 0; e < 8; ++e) { mur[e] = mu[hc + e]; muk[e] = mu[1024 + hc + e]; kkc[e] = k_k[hc + e]; kac[e] = k_a[hc + e]; }
        }
        float S[4] = {0.f, 0.f, 0.f, 0.f}, sa = 0.f;
#define RW_PREP(chunk, bufp) do { \
            const int t_ = (chunk) * CH + tt; const size_t mm = m0 + t_; const bf16* row = PR + mm * N1P + hc; \
            const v4u zr = (v4u){0u, 0u, 0u, 0u}; \
            const v4u qr = *(const v4u*)row, qk = *(const v4u*)(row + 1024); \
            const v4u qrp = t_ > 0 ? *(const v4u*)(row - N1P) : zr, qkp = t_ > 0 ? *(const v4u*)(row - N1P + 1024) : zr; \
            const v4u qkn = t_ + 1 < T ? *(const v4u*)(row + N1P + 1024) : zr; \
            const v4u qas = *(const v4u*)(ASIG + mm * D + hc), qel = *(const v4u*)(ELOG + mm * D + hc); \
            v4u qv = zr; if (l8 < 2) qv = *(const v4u*)(VS + mm * D + h * 64 + rq * 16 + l8 * 8); \
            float r_[8], rp_[8], k_[8], kp_[8], kn_[8], as_[8], el_[8]; \
            unpack8(qr, r_); unpack8(qrp, rp_); unpack8(qk, k_); unpack8(qkp, kp_); unpack8(qkn, kn_); unpack8(qas, as_); unpack8(qel, el_); \
            float ks_[8], kk_[8], kkn_[8], s1 = 0.f, s2 = 0.f; \
            _Pragma("unroll") for (int e = 0; e < 8; ++e) { ks_[e] = k_[e] + (kp_[e] - k_[e]) * muk[e]; const float kn1 = kn_[e] + (k_[e] - kn_[e]) * muk[e]; \
                kk_[e] = ks_[e] * kkc[e]; kkn_[e] = kn1 * kkc[e]; s1 += kk_[e] * kk_[e]; s2 += kkn_[e] * kkn_[e]; } \
            s1 = sum8(s1); s2 = sum8(s2); \
            const float i1 = rsqrtf(s1 + 1e-12f), i2 = (t_ + 1 < T) ? rsqrtf(s2 + 1e-12f) : 0.f; \
            float ow[8], ok[8], ob[8], orr[8], owa[8], c1 = 0.f, c2 = 0.f; \
            _Pragma("unroll") for (int e = 0; e < 8; ++e) { const float kn = kk_[e] * i1, an = -kkn_[e] * i2; \
                ow[e] = __expf(el_[e]); ok[e] = ks_[e] * (1.f + (as_[e] - 1.f) * kac[e]); ob[e] = kn * as_[e]; orr[e] = r_[e] + (rp_[e] - r_[e]) * mur[e]; \
                owa[e] = ow[e] * an; c1 += ob[e] * an; c2 += ok[e] * an; } \
            c1 = sum8(c1); c2 = sum8(c2); \
            LAS float* bp_ = (bufp) + tt * 64 + pc; \
            *(LAS f32x4*)(bp_) = (f32x4){ow[0], ow[1], ow[2], ow[3]}; *(LAS f32x4*)(bp_ + 4) = (f32x4){ow[4], ow[5], ow[6], ow[7]}; \
            *(LAS f32x4*)(bp_ + ARRF) = (f32x4){ok[0], ok[1], ok[2], ok[3]}; *(LAS f32x4*)(bp_ + ARRF + 4) = (f32x4){ok[4], ok[5], ok[6], ok[7]}; \
            *(LAS f32x4*)(bp_ + 2 * ARRF) = (f32x4){ob[0], ob[1], ob[2], ob[3]}; *(LAS f32x4*)(bp_ + 2 * ARRF + 4) = (f32x4){ob[4], ob[5], ob[6], ob[7]}; \
            *(LAS f32x4*)(bp_ + 3 * ARRF) = (f32x4){orr[0], orr[1], orr[2], orr[3]}; *(LAS f32x4*)(bp_ + 3 * ARRF + 4) = (f32x4){orr[4], orr[5], orr[6], orr[7]}; \
            *(LAS f32x4*)(bp_ + 4 * ARRF) = (f32x4){owa[0], owa[1], owa[2], owa[3]}; *(LAS f32x4*)(bp_ + 4 * ARRF + 4) = (f32x4){owa[4], owa[5], owa[6], owa[7]}; \
            if (l8 < 2) { float v_[8]; unpack8(qv, v_); LAS float* vp_ = (bufp) + 5 * ARRF + tt * 16 + l8 * 8; \
                *(LAS f32x4*)vp_ = (f32x4){v_[0], v_[1], v_[2], v_[3]}; *(LAS f32x4*)(vp_ + 4) = (f32x4){v_[4], v_[5], v_[6], v_[7]}; } \
            if (l8 == 0) { (bufp)[5 * ARRF + CH * 16 + tt * 2] = c1; (bufp)[5 * ARRF + CH * 16 + tt * 2 + 1] = c2; } } while (0)
#define RW_YSTORE(chunk) do { const LAS float* yp_ = yt + ((chunk) & 1) * CH * 16 + tt * 16 + l8 * 2; \
            *(unsigned*)(Y + (m0 + (size_t)(chunk) * CH + tt) * D + h * 64 + rq * 16 + l8 * 2) = pk2(yp_[0], yp_[1]); } while (0)
        if (is_prep) RW_PREP(0, ldsf);
        __syncthreads();
        for (int ch = 0; ch < NCH; ++ch) {
            if (is_prep) {
                if (ch + 1 < NCH) RW_PREP(ch + 1, ldsf + ((ch + 1) & 1) * BUFF);
                if (ch > 0) RW_YSTORE(ch - 1);
            } else {
                const LAS float* buf = ldsf + (ch & 1) * BUFF;
                LAS float* yw = yt + (ch & 1) * CH * 16;
                const int lane15 = lane & 15;
                f32x4 w4 = *(const LAS f32x4*)(buf + cc4), k4 = *(const LAS f32x4*)(buf + ARRF + cc4), b4 = *(const LAS f32x4*)(buf + 2 * ARRF + cc4);
                f32x4 r4 = *(const LAS f32x4*)(buf + 3 * ARRF + cc4), wa4 = *(const LAS f32x4*)(buf + 4 * ARRF + cc4);
                float v = buf[5 * ARRF + rrow]; f32x2 cc = *(const LAS f32x2*)(buf + 5 * ARRF + CH * 16);
#pragma unroll 1
                for (int t16 = 0; t16 < CH; t16 += 16) {
                    float ysave = 0.f;
#pragma unroll
                    for (int u = 0; u < 16; ++u) {
                        const int tn = (t16 + u + 1 < CH) ? t16 + u + 1 : t16 + u;
                        const f32x4 nw4 = *(const LAS f32x4*)(buf + tn * 64 + cc4), nk4 = *(const LAS f32x4*)(buf + ARRF + tn * 64 + cc4), nb4 = *(const LAS f32x4*)(buf + 2 * ARRF + tn * 64 + cc4);
                        const f32x4 nr4 = *(const LAS f32x4*)(buf + 3 * ARRF + tn * 64 + cc4), nwa4 = *(const LAS f32x4*)(buf + 4 * ARRF + tn * 64 + cc4);
                        const float nv = buf[5 * ARRF + tn * 16 + rrow]; const f32x2 ncc = *(const LAS f32x2*)(buf + 5 * ARRF + CH * 16 + tn * 2);
                        float d = S[0] * wa4[0]; d = __builtin_fmaf(S[1], wa4[1], d); d = __builtin_fmaf(S[2], wa4[2], d); d = __builtin_fmaf(S[3], wa4[3], d);
#pragma unroll
                        for (int e = 0; e < 4; ++e) { float tmp = S[e] * w4[e]; asm volatile("" : "+v"(tmp)); tmp = __builtin_fmaf(v, k4[e], tmp); S[e] = __builtin_fmaf(sa, b4[e], tmp); asm volatile("" : "+v"(S[e])); }
                        const float sa_next = __builtin_fmaf(v, cc.y, sa * cc.x);
                        float y = S[0] * r4[0]; y = __builtin_fmaf(S[1], r4[1], y); y = __builtin_fmaf(S[2], r4[2], y); y = __builtin_fmaf(S[3], r4[3], y);
                        d = sum16(d); y = sum16(y);
                        sa = d + sa_next;
                        ysave = (lane15 == u) ? y : ysave;
                        w4 = nw4; k4 = nk4; b4 = nb4; r4 = nr4; wa4 = nwa4; v = nv; cc = ncc;
                    }
                    yw[(t16 + lane15) * 16 + rrow] = ysave;
                }
            }
            __syncthreads();
        }
        if (is_prep) RW_YSTORE(NCH - 1);
        __syncthreads();
#undef RW_PREP
#undef RW_YSTORE
    }
}

constexpr int CK_TS = 72, CK_TB = 64 * CK_TS;
__device__ __forceinline__ void tr_a2(unsigned a, bf16x8& f0, bf16x8& f1) {
    s16x4 l0, h0, l1, h1;
    asm volatile("ds_read_b64_tr_b16 %0, %4\n\tds_read_b64_tr_b16 %1, %4 offset:576\n\tds_read_b64_tr_b16 %2, %4 offset:4608\n\tds_read_b64_tr_b16 %3, %4 offset:5184\n\ts_waitcnt lgkmcnt(0)"
                 : "=&v"(l0), "=&v"(h0), "=&v"(l1), "=&v"(h1) : "v"(a) : "memory");
    f0 = __builtin_shufflevector(l0, h0, 0, 1, 2, 3, 4, 5, 6, 7); f1 = __builtin_shufflevector(l1, h1, 0, 1, 2, 3, 4, 5, 6, 7);
}
__device__ __forceinline__ void tr_b4(unsigned a, bf16x8& f00, bf16x8& f01, bf16x8& f10, bf16x8& f11) {
    s16x4 l0, h0, l1, h1, l2, h2, l3, h3;
    asm volatile("ds_read_b64_tr_b16 %0, %8\n\tds_read_b64_tr_b16 %1, %8 offset:576\n\tds_read_b64_tr_b16 %2, %8 offset:4608\n\tds_read_b64_tr_b16 %3, %8 offset:5184\n\t"
                 "ds_read_b64_tr_b16 %4, %8 offset:32\n\tds_read_b64_tr_b16 %5, %8 offset:608\n\tds_read_b64_tr_b16 %6, %8 offset:4640\n\tds_read_b64_tr_b16 %7, %8 offset:5216\n\ts_waitcnt lgkmcnt(0)"
                 : "=&v"(l0), "=&v"(h0), "=&v"(l1), "=&v"(h1), "=&v"(l2), "=&v"(h2), "=&v"(l3), "=&v"(h3) : "v"(a) : "memory");
    f00 = __builtin_shufflevector(l0, h0, 0, 1, 2, 3, 4, 5, 6, 7); f01 = __builtin_shufflevector(l1, h1, 0, 1, 2, 3, 4, 5, 6, 7);
    f10 = __builtin_shufflevector(l2, h2, 0, 1, 2, 3, 4, 5, 6, 7); f11 = __builtin_shufflevector(l3, h3, 0, 1, 2, 3, 4, 5, 6, 7);
}
template <int PA, int QA, int MASK, int NINIT, int NPAIR, int POST>
__device__ __forceinline__ void mm64(LAS bf16* X, const LAS bf16* P, const LAS bf16* Q, const LAS bf16* P2, const LAS bf16* Q2, const LAS bf16* E1, const LAS bf16* E2,
                                     const LAS float* cscale, const LAS float* wc, int w, int lane) {
    const int r = lane & 15, q = lane >> 4, Ct = w >> 1, Rt0 = 2 * (w & 1);
    const int i16 = lane & 15, qq = i16 >> 2, p4 = i16 & 3;
    const int troff = ((8 * q + qq) * CK_TS + 4 * p4) * 2;
    f32x4 acc[2];
#pragma unroll
    for (int i = 0; i < 2; ++i) {
        const int R = 16 * (Rt0 + i) + r;
        if (NINIT == 0) acc[i] = (f32x4){0.f, 0.f, 0.f, 0.f};
        else { const v2u e1 = *(const LAS v2u*)(E1 + R * CK_TS + 16 * Ct + 4 * q); acc[i] = (f32x4){bflo(e1.x), bfhi(e1.x), bflo(e1.y), bfhi(e1.y)};
            if (NINIT == 2) { const v2u e2 = *(const LAS v2u*)(E2 + R * CK_TS + 16 * Ct + 4 * q); acc[i] += (f32x4){bflo(e2.x), bfhi(e2.x), bflo(e2.y), bfhi(e2.y)}; } }
    }
#pragma unroll
    for (int pr = 0; pr < NPAIR; ++pr) {
        const LAS bf16* Pp = pr == 0 ? P : P2; const LAS bf16* Qp = pr == 0 ? Q : Q2;
        bf16x8 af[2], bfr[2][2];
        if (PA == 0) {
#pragma unroll
            for (int i = 0; i < 2; ++i)
#pragma unroll
                for (int ks = 0; ks < 2; ++ks) bfr[i][ks] = *(const LAS bf16x8*)(Pp + (16 * (Rt0 + i) + r) * CK_TS + 32 * ks + 8 * q);
        }
        if (QA == 1) {
#pragma unroll
            for (int ks = 0; ks < 2; ++ks) af[ks] = *(const LAS bf16x8*)(Qp + (16 * Ct + r) * CK_TS + 32 * ks + 8 * q);
        } else tr_a2((unsigned)(size_t)Qp + (unsigned)(troff + 32 * Ct), af[0], af[1]);
        if (PA == 1) tr_b4((unsigned)(size_t)Pp + (unsigned)(troff + 32 * Rt0), bfr[0][0], bfr[0][1], bfr[1][0], bfr[1][1]);
#pragma unroll
        for (int ks = 0; ks < 2; ++ks)
#pragma unroll
            for (int i = 0; i < 2; ++i) acc[i] = __builtin_amdgcn_mfma_f32_16x16x32_bf16(af[ks], bfr[i][ks], acc[i], 0, 0, 0);
    }
#pragma unroll
    for (int i = 0; i < 2; ++i) {
        const int R = 16 * (Rt0 + i) + r;
        float v[4];
#pragma unroll
        for (int e = 0; e < 4; ++e) { const int C = 16 * Ct + 4 * q + e; float x = acc[i][e];
            if (MASK == 1) x = (C < R) ? x : 0.f;
            if (MASK == 2) x = (C <= R) ? x : 0.f;
            if (POST >= 1) x *= cscale[C];
            if (POST == 2) x += (C == R) ? wc[C] : 0.f;
            v[e] = x; }
        v2u o; o.x = pk2c(v[0], v[1]); o.y = pk2c(v[2], v[3]);
        *(LAS v2u*)(X + R * CK_TS + 16 * Ct + 4 * q) = o;
    }
}

template <int PA, int QA, int MASK, int NINIT, int NPAIR, int POST>
__device__ __forceinline__ void mm64h(LAS bf16* X, const LAS bf16* P, const LAS bf16* Q, const LAS bf16* P2, const LAS bf16* Q2, const LAS bf16* E1, const LAS bf16* E2,
                                      const LAS float* cscale, const LAS float* wc, int ws, int lane) {
    const int r = lane & 15, q = lane >> 4, Cb = ws >> 1, Rb = ws & 1;
    const int i16 = lane & 15, qq = i16 >> 2, p4 = i16 & 3;
    const int troff = ((8 * q + qq) * CK_TS + 4 * p4) * 2;
    f32x4 acc[2][2];
#pragma unroll
    for (int ci = 0; ci < 2; ++ci)
#pragma unroll
        for (int ri = 0; ri < 2; ++ri) {
            const int R = 16 * (2 * Rb + ri) + r, C0 = 16 * (2 * Cb + ci) + 4 * q;
            if (NINIT == 0) acc[ci][ri] = (f32x4){0.f, 0.f, 0.f, 0.f};
            else { const v2u e1 = *(const LAS v2u*)(E1 + R * CK_TS + C0); acc[ci][ri] = (f32x4){bflo(e1.x), bfhi(e1.x), bflo(e1.y), bfhi(e1.y)};
                if (NINIT == 2) { const v2u e2 = *(const LAS v2u*)(E2 + R * CK_TS + C0); acc[ci][ri] += (f32x4){bflo(e2.x), bfhi(e2.x), bflo(e2.y), bfhi(e2.y)}; } }
        }
#pragma unroll
    for (int pr = 0; pr < NPAIR; ++pr) {
        const LAS bf16* Pp = pr == 0 ? P : P2; const LAS bf16* Qp = pr == 0 ? Q : Q2;
        bf16x8 af[2][2], bfr[2][2];
        if (PA == 0) {
#pragma unroll
            for (int ri = 0; ri < 2; ++ri)
#pragma unroll
                for (int ks = 0; ks < 2; ++ks) bfr[ri][ks] = *(const LAS bf16x8*)(Pp + (16 * (2 * Rb + ri) + r) * CK_TS + 32 * ks + 8 * q);
        }
        if (QA == 1) {
#pragma unroll
            for (int ci = 0; ci < 2; ++ci)
#pragma unroll
                for (int ks = 0; ks < 2; ++ks) af[ci][ks] = *(const LAS bf16x8*)(Qp + (16 * (2 * Cb + ci) + r) * CK_TS + 32 * ks + 8 * q);
        } else tr_b4((unsigned)(size_t)Qp + (unsigned)(troff + 64 * Cb), af[0][0], af[0][1], af[1][0], af[1][1]);
        if (PA == 1) tr_b4((unsigned)(size_t)Pp + (unsigned)(troff + 64 * Rb), bfr[0][0], bfr[0][1], bfr[1][0], bfr[1][1]);
#pragma unroll
        for (int ks = 0; ks < 2; ++ks)
#pragma unroll
            for (int ci = 0; ci < 2; ++ci)
#pragma unroll
                for (int ri = 0; ri < 2; ++ri) acc[ci][ri] = __builtin_amdgcn_mfma_f32_16x16x32_bf16(af[ci][ks], bfr[ri][ks], acc[ci][ri], 0, 0, 0);
    }
#pragma unroll
    for (int ci = 0; ci < 2; ++ci)
#pragma unroll
        for (int ri = 0; ri < 2; ++ri) {
            const int R = 16 * (2 * Rb + ri) + r;
            float v[4];
#pragma unroll
            for (int e = 0; e < 4; ++e) { const int C = 16 * (2 * Cb + ci) + 4 * q + e; float x = acc[ci][ri][e];
                if (MASK == 1) x = (C < R) ? x : 0.f;
                if (MASK == 2) x = (C <= R) ? x : 0.f;
                if (POST >= 1) x *= cscale[C];
                if (POST == 2) x += (C == R) ? wc[C] : 0.f;
                v[e] = x; }
            v2u o; o.x = pk2c(v[0], v[1]); o.y = pk2c(v[2], v[3]);
            *(LAS v2u*)(X + R * CK_TS + 16 * (2 * Cb + ci) + 4 * q) = o;
        }
}

__device__ __forceinline__ void phase_rwkv_chunk_par(const Ctx& c, KArgs& a, int l, int hb) {
    unsigned char* ws = a.ws;
    bf16* PR = (bf16*)(ws + WS_OV + OV_PR);
    bf16* ELOG = (bf16*)(ws + WS_OV + OV_ELOG);
    const bf16* ASIG = (const bf16*)(ws + WS_OV + OV_ASIG);
    const bf16* VS = l == 0 ? (const bf16*)(ws + WS_VF) + (size_t)hb * MH * D : (const bf16*)(ws + WS_OV + OV_VMIX);
    bf16* Y = (bf16*)(ws + WS_OV + OV_YA);
    bf16* SLB = (bf16*)(ws + WS_OV + OV_AL);
    const float* mu = a.in[I_MU] + (size_t)l * RW_PROJ;
    const float* k_k = a.in[I_KK] + (size_t)l * D; const float* k_a = a.in[I_KA] + (size_t)l * D; const float* rk_ = a.in[I_RK] + (size_t)l * D;
    float* BON = (float*)(ws + WS_OV + OV_BON);
    LAS bf16* tile = (LAS bf16*)c.lds;
    enum { tA = 0, tR, tBt, tKt, tBh, tKh, tV, tNab, tNak, tNrb, tNrk, tM0, tM1, tP1, tX1, NT };
#define TL(i) (tile + (i) * CK_TB)
    LAS float* cscale = (LAS float*)(tile + NT * CK_TB);
    LAS float* wcv = cscale + 64;
    LAS float* SCR = (LAS float*)TL(tM0);
    LAS float* SEGT = SCR + 64 * 64;
    const int tid = c.tid, lane = c.lane, w = c.wave;
    const int tt = tid >> 3, l8 = tid & 7, pc = l8 * 8;
    v4u qr, qk, qrp, qkp, qas, qel, qv;
#define CK_LOAD(un) do { const int b_ = (un) >> 10, h_ = ((un) >> 6) & 15, ch_ = (un) & 63; const int t_ = ch_ * 64 + tt; \
        const size_t mm = (size_t)b_ * T + (size_t)t_; const bf16* row = PR + mm * N1P + h_ * 64 + pc; const v4u zr = (v4u){0u, 0u, 0u, 0u}; \
        qr = *(const v4u*)row; qk = *(const v4u*)(row + 1024); qrp = t_ > 0 ? *(const v4u*)(row - N1P) : zr; qkp = t_ > 0 ? *(const v4u*)(row - N1P + 1024) : zr; \
        qas = *(const v4u*)(ASIG + mm * D + h_ * 64 + pc); qel = *(const v4u*)(ELOG + mm * D + h_ * 64 + pc); qv = *(const v4u*)(VS + mm * D + h_ * 64 + pc); } while (0)
    if (c.bid < 4096) CK_LOAD(c.bid);
    for (int unit = c.bid; unit < 4096; unit += c.G) {
        const int b = unit >> 10, h = (unit >> 6) & 15, ch = unit & 63;
        const size_t m0 = (size_t)b * T + (size_t)ch * 64;
        const int hc = h * 64 + pc;
        for (int rep = 0; rep < (PROBE_DUP == 7 ? 2 : 1); ++rep) {
        if (PROBE_DUP == 7) { CK_LOAD(unit); }
        float r_[8], k_[8], as_[8], el_[8], v_[8], kk_[8], ks_[8];
        {
            float rp_[8], kp_[8];
            unpack8(qr, r_); unpack8(qrp, rp_); unpack8(qk, k_); unpack8(qkp, kp_); unpack8(qas, as_); unpack8(qel, el_); unpack8(qv, v_);
            if (PROBE_DUP != 7 && unit + c.G < 4096) CK_LOAD(unit + c.G);
            float s1 = 0.f;
#pragma unroll
            for (int e = 0; e < 8; ++e) { r_[e] = r_[e] + (rp_[e] - r_[e]) * mu[hc + e]; ks_[e] = k_[e] + (kp_[e] - k_[e]) * mu[1024 + hc + e]; kk_[e] = ks_[e] * k_k[hc + e]; s1 += kk_[e] * kk_[e]; }
            s1 = sum8(s1);
            const float i1 = rsqrtf(s1 + 1e-12f);
#pragma unroll
            for (int e = 0; e < 8; ++e) { kk_[e] *= i1; k_[e] = ks_[e] * (1.f + (as_[e] - 1.f) * k_a[hc + e]); }
            { float bn = 0.f;
#pragma unroll
              for (int e = 0; e < 8; ++e) bn += r_[e] * k_[e] * rk_[hc + e];
              bn = sum8(bn);
              if (l8 == 0) BON[(m0 + tt) * 16 + h] = bn; }
            *(LAS f32x4*)(SCR + tt * 64 + pc) = (f32x4){el_[0], el_[1], el_[2], el_[3]}; *(LAS f32x4*)(SCR + tt * 64 + pc + 4) = (f32x4){el_[4], el_[5], el_[6], el_[7]};
        }
        lds_barrier();
        {
            const int col = tid & 63, seg = tid >> 6; float s = 0.f;
#pragma unroll
            for (int i = 0; i < 8; ++i) { s += SCR[(8 * seg + i) * 64 + col]; SCR[(8 * seg + i) * 64 + col] = s; }
            SEGT[seg * 64 + col] = s;
        }
        lds_barrier();
        {
            const int col = tid & 63, seg = tid >> 6; float pre = 0.f;
#pragma unroll
            for (int s2 = 0; s2 < 7; ++s2) pre += (s2 < seg) ? SEGT[s2 * 64 + col] : 0.f;
#pragma unroll
            for (int i = 0; i < 8; ++i) SCR[(8 * seg + i) * 64 + col] += pre;
        }
        lds_barrier();
        {
            float L[8], Lr[8], Le[8];
            { const f32x4 x0 = *(const LAS f32x4*)(SCR + tt * 64 + pc), x1 = *(const LAS f32x4*)(SCR + tt * 64 + pc + 4);
              const f32x4 y0 = *(const LAS f32x4*)(SCR + 31 * 64 + pc), y1 = *(const LAS f32x4*)(SCR + 31 * 64 + pc + 4);
              const f32x4 z0 = *(const LAS f32x4*)(SCR + 63 * 64 + pc), z1 = *(const LAS f32x4*)(SCR + 63 * 64 + pc + 4);
#pragma unroll
              for (int e = 0; e < 4; ++e) { L[e] = x0[e]; L[4 + e] = x1[e]; Lr[e] = y0[e]; Lr[4 + e] = y1[e]; Le[e] = z0[e]; Le[4 + e] = z1[e]; } }
            float oA[8], oR[8], oBt[8], oKt[8], oBh[8], oKh[8];
#pragma unroll
            for (int e = 0; e < 8; ++e) {
                const float ea = __expf(L[e] - el_[e] - Lr[e]), er = __expf(L[e] - Lr[e]), eb = __expf(Lr[e] - L[e]), eh = __expf(Le[e] - L[e]);
                const float bb = kk_[e] * as_[e];
                oA[e] = -kk_[e] * ea; oR[e] = r_[e] * er; oBt[e] = bb * eb; oKt[e] = k_[e] * eb; oBh[e] = bb * eh; oKh[e] = k_[e] * eh;
            }
            const int o = tt * CK_TS + pc;
            *(LAS v4u*)(TL(tA) + o) = pack8(oA); *(LAS v4u*)(TL(tR) + o) = pack8(oR); *(LAS v4u*)(TL(tBt) + o) = pack8(oBt); *(LAS v4u*)(TL(tKt) + o) = pack8(oKt);
            *(LAS v4u*)(TL(tBh) + o) = pack8(oBh); *(LAS v4u*)(TL(tKh) + o) = pack8(oKh); *(LAS v4u*)(TL(tV) + o) = pack8(v_);
            if (tt == 0) {
#pragma unroll
                for (int e = 0; e < 8; ++e) { cscale[pc + e] = __expf(Lr[e]); wcv[pc + e] = __expf(Le[e]); }
            }
        }
        lds_barrier();
        const LAS bf16* Z = nullptr;
        const int wg_ = w >> 2, ws_ = w & 3;
        if (wg_ == 0) { mm64h<0, 1, 1, 0, 1, 0>(TL(tNab), TL(tA), TL(tBt), Z, Z, Z, Z, cscale, wcv, ws_, lane);
                        mm64h<0, 1, 1, 0, 1, 0>(TL(tNak), TL(tA), TL(tKt), Z, Z, Z, Z, cscale, wcv, ws_, lane); }
        else          { mm64h<0, 1, 2, 0, 1, 0>(TL(tNrb), TL(tR), TL(tBt), Z, Z, Z, Z, cscale, wcv, ws_, lane);
                        mm64h<0, 1, 2, 0, 1, 0>(TL(tNrk), TL(tR), TL(tKt), Z, Z, Z, Z, cscale, wcv, ws_, lane); }
        lds_barrier();
        if (wg_ == 0) mm64h<0, 0, 0, 0, 1, 0>(TL(tM0), TL(tNab), TL(tNab), Z, Z, Z, Z, cscale, wcv, ws_, lane);
        else          mm64h<0, 0, 0, 0, 1, 0>(TL(tX1), TL(tNak), TL(tV), Z, Z, Z, Z, cscale, wcv, ws_, lane);
        lds_barrier();
        if (wg_ == 0) mm64h<0, 0, 0, 2, 1, 0>(TL(tP1), TL(tNab), TL(tM0), Z, Z, TL(tNab), TL(tM0), cscale, wcv, ws_, lane);
        else          mm64h<0, 0, 0, 0, 1, 0>(TL(tM1), TL(tM0), TL(tM0), Z, Z, Z, Z, cscale, wcv, ws_, lane);
        lds_barrier();
        if (wg_ == 0) mm64h<0, 0, 0, 2, 1, 0>(TL(tNab), TL(tP1), TL(tM1), Z, Z, TL(tP1), TL(tM1), cscale, wcv, ws_, lane);
        else          mm64h<0, 0, 0, 0, 1, 0>(TL(tM0), TL(tM1), TL(tM1), Z, Z, Z, Z, cscale, wcv, ws_, lane);
        lds_barrier();
        if (wg_ == 0) mm64h<0, 0, 0, 2, 1, 0>(TL(tP1), TL(tNab), TL(tM0), Z, Z, TL(tNab), TL(tM0), cscale, wcv, ws_, lane);
        else          mm64h<0, 0, 0, 0, 1, 0>(TL(tM1), TL(tM0), TL(tM0), Z, Z, Z, Z, cscale, wcv, ws_, lane);
        lds_barrier();
        if (wg_ == 0) mm64h<0, 0, 0, 2, 1, 0>(TL(tNab), TL(tP1), TL(tM1), Z, Z, TL(tP1), TL(tM1), cscale, wcv, ws_, lane);
        else          mm64h<0, 0, 0, 0, 1, 0>(TL(tM0), TL(tM1), TL(tM1), Z, Z, Z, Z, cscale, wcv, ws_, lane);
        lds_barrier();
        mm64<0, 0, 0, 2, 1, 0>(TL(tP1), TL(tNab), TL(tM0), Z, Z, TL(tNab), TL(tM0), cscale, wcv, w, lane);
        lds_barrier();
        if (wg_ == 0) mm64h<0, 0, 0, 1, 1, 0>(TL(tBt), TL(tP1), TL(tA), Z, Z, TL(tA), Z, cscale, wcv, ws_, lane);
        else          mm64h<0, 0, 0, 1, 1, 0>(TL(tKt), TL(tP1), TL(tX1), Z, Z, TL(tX1), Z, cscale, wcv, ws_, lane);
        lds_barrier();
        if (wg_ == 0) { mm64h<0, 0, 0, 1, 1, 1>(TL(tM0), TL(tNrb), TL(tBt), Z, Z, TL(tR), Z, cscale, wcv, ws_, lane);
                        mm64h<0, 0, 0, 0, 2, 0>(TL(tM1), TL(tNrb), TL(tKt), TL(tNrk), TL(tV), Z, Z, cscale, wcv, ws_, lane); }
        else          { mm64h<1, 0, 0, 0, 1, 2>(TL(tNab), TL(tBh), TL(tBt), Z, Z, Z, Z, cscale, wcv, ws_, lane);
                        mm64h<1, 0, 0, 0, 2, 0>(TL(tX1), TL(tKt), TL(tBh), TL(tV), TL(tKh), Z, Z, cscale, wcv, ws_, lane); }
        lds_barrier();
        }
        {
            const size_t grow = m0 + tt;
            *(v4u*)(ELOG + grow * D + hc) = *(const LAS v4u*)(TL(tM0) + tt * CK_TS + pc);
            *(v4u*)(Y + grow * D + hc) = *(const LAS v4u*)(TL(tM1) + tt * CK_TS + pc);
            *(v4u*)(PR + grow * N1P + 2048 + hc) = *(const LAS v4u*)(TL(tNab) + tt * CK_TS + pc);
            *(v4u*)(SLB + grow * D + hc) = *(const LAS v4u*)(TL(tX1) + tt * CK_TS + pc);
        }
        lds_barrier();
    }
#undef TL
#undef CK_LOAD
}

struct SeqOps { v4u g0, g1, p0, p1; v2u sl, yl; };
__device__ __forceinline__ void phase_rwkv_chunk_seq(const Ctx& c, KArgs& a, const bool commit = true) {
    unsigned char* ws = a.ws;
    const bf16* PR = (const bf16*)(ws + WS_OV + OV_PR);
    const bf16* RP = (const bf16*)(ws + WS_OV + OV_ELOG);
    bf16* Y = (bf16*)(ws + WS_OV + OV_YA);
    const bf16* SLB = (const bf16*)(ws + WS_OV + OV_AL);
    LAS bf16* SL = (LAS bf16*)c.lds;
    const int tid = c.tid, lane = c.lane, w = c.wave, r = lane & 15, q = lane >> 4;
    constexpr int PF = 4;
    for (int unit = c.bid; unit < 256; unit += c.G) {
        const int b = unit >> 6, h = (unit >> 2) & 15, vq = unit & 3;
        for (int e = tid; e < 2 * 16 * CK_TS / 2; e += 512) ((LAS unsigned*)SL)[e] = 0u;
        __syncthreads();
        if (w < 4) {
            const size_t rowG = (size_t)b * T + 16 * w + r;
            const size_t rowS = (size_t)b * T + vq * 16 + r;
            SeqOps ops[PF];
#define SQ_LOAD(dst, chn) do { const size_t o_ = (size_t)(chn) * 64; \
                dst.g0 = *(const v4u*)(PR + (rowG + o_) * N1P + 2048 + h * 64 + 8 * q); dst.g1 = *(const v4u*)(PR + (rowG + o_) * N1P + 2048 + h * 64 + 32 + 8 * q); \
                dst.p0 = *(const v4u*)(RP + (rowG + o_) * D + h * 64 + 8 * q); dst.p1 = *(const v4u*)(RP + (rowG + o_) * D + h * 64 + 32 + 8 * q); \
                dst.sl = *(const v2u*)(SLB + (rowS + o_) * D + h * 64 + 16 * w + 4 * q); dst.yl = *(const v2u*)(Y + (rowG + o_) * D + h * 64 + vq * 16 + 4 * q); } while (0)
#pragma unroll
            for (int i = 0; i < PF; ++i) SQ_LOAD(ops[i], i);
            for (int ch0 = 0; ch0 < 64; ch0 += PF) {
#pragma unroll
                for (int i = 0; i < PF; ++i) {
                    const int ch = ch0 + i;
                    const SeqOps cur = ops[i];
                    if (ch + PF < 64) SQ_LOAD(ops[i], ch + PF);
                    const LAS bf16* Sc = SL + (i & 1) * 16 * CK_TS; LAS bf16* Sn = SL + ((i + 1) & 1) * 16 * CK_TS;
                    const bf16x8 s0 = *(const LAS bf16x8*)(Sc + r * CK_TS + 8 * q), s1 = *(const LAS bf16x8*)(Sc + r * CK_TS + 32 + 8 * q);
                    f32x4 accS = (f32x4){bflo(cur.sl.x), bfhi(cur.sl.x), bflo(cur.sl.y), bfhi(cur.sl.y)};
                    accS = __builtin_amdgcn_mfma_f32_16x16x32_bf16(__builtin_bit_cast(bf16x8, cur.g0), s0, accS, 0, 0, 0);
                    accS = __builtin_amdgcn_mfma_f32_16x16x32_bf16(__builtin_bit_cast(bf16x8, cur.g1), s1, accS, 0, 0, 0);
                    f32x4 accY = (f32x4){bflo(cur.yl.x), bfhi(cur.yl.x), bflo(cur.yl.y), bfhi(cur.yl.y)};
                    accY = __builtin_amdgcn_mfma_f32_16x16x32_bf16(s0, __builtin_bit_cast(bf16x8, cur.p0), accY, 0, 0, 0);
                    accY = __builtin_amdgcn_mfma_f32_16x16x32_bf16(s1, __builtin_bit_cast(bf16x8, cur.p1), accY, 0, 0, 0);
                    { v2u o; o.x = pk2c(accS[0], accS[1]); o.y = pk2c(accS[2], accS[3]); *(LAS v2u*)(Sn + r * CK_TS + 16 * w + 4 * q) = o; }
                    if (commit || accY[0] == 123456.789f) { v2u o; o.x = pk2c(accY[0], accY[1]); o.y = pk2c(accY[2], accY[3]); *(v2u*)(Y + (rowG + (size_t)ch * 64) * D + h * 64 + vq * 16 + 4 * q) = o; }
                    lds_barrier();
                }
            }
#undef SQ_LOAD
        } else {
            for (int ch = 0; ch < 64; ++ch) lds_barrier();
        }
        __syncthreads();
    }
}

__device__ __forceinline__ void phase_rwkv_post(const Ctx& c, KArgs& a, int l, int hb) {
    unsigned char* ws = a.ws;
    const bf16* GG = (const bf16*)(ws + WS_OV + OV_GG);
    const bf16* VS = l == 0 ? (const bf16*)(ws + WS_VF) + (size_t)hb * MH * D : (const bf16*)(ws + WS_OV + OV_VMIX);
    const float* BON = (const float*)(ws + WS_OV + OV_BON);
    bf16* Y = (bf16*)(ws + WS_OV + OV_YA);
    const int lane = c.lane, c0 = 16 * lane;
    float lw[16], lb[16];
#pragma unroll
    for (int e = 0; e < 16; ++e) { lw[e] = a.in[I_LNW][(size_t)l * D + c0 + e]; lb[e] = a.in[I_LNB][(size_t)l * D + c0 + e]; }
    const int gw = c.bid * 8 + c.wave, NGW = c.G * 8;
    v4u ny0, ny1, nv0, nv1, ng0, ng1; float nbon = 0.f;
#define RP_LOAD(mm) do { ny0 = *(const v4u*)(Y + (size_t)(mm) * D + c0); ny1 = *(const v4u*)(Y + (size_t)(mm) * D + c0 + 8); nv0 = *(const v4u*)(VS + (size_t)(mm) * D + c0); nv1 = *(const v4u*)(VS + (size_t)(mm) * D + c0 + 8); \
        ng0 = *(const v4u*)(GG + (size_t)(mm) * D + c0); ng1 = *(const v4u*)(GG + (size_t)(mm) * D + c0 + 8); nbon = BON[(size_t)(mm) * 16 + (lane >> 2)]; } while (0)
    if (gw < MH) RP_LOAD(gw);
    for (int m = gw; m < MH; m += NGW) {
        float y[16], v[16], g[16], t8[8];
        const v4u cy0 = ny0, cy1 = ny1, cv0 = nv0, cv1 = nv1, cg0 = ng0, cg1 = ng1; const float bon = nbon;
        if (m + NGW < MH) RP_LOAD(m + NGW);
#define UP16(dst, qa, qb) do { unpack8(qa, t8); _Pragma("unroll") for (int e = 0; e < 8; ++e) dst[e] = t8[e]; unpack8(qb, t8); _Pragma("unroll") for (int e = 0; e < 8; ++e) dst[8 + e] = t8[e]; } while (0)
        UP16(y, cy0, cy1); UP16(v, cv0, cv1); UP16(g, cg0, cg1);
#undef UP16
        float s1 = 0.f;
#pragma unroll
        for (int e = 0; e < 16; ++e) s1 += y[e];
        s1 = sum4(s1);
        const float mean = s1 * (1.f / 64.f);
        float s2 = 0.f;
#pragma unroll
        for (int e = 0; e < 16; ++e) { const float d = y[e] - mean; s2 += d * d; }
        s2 = sum4(s2);
        const float rstd = rsqrtf(s2 * (1.f / 64.f) + 64e-5f);
        float o[16];
#pragma unroll
        for (int e = 0; e < 16; ++e) o[e] = ((y[e] - mean) * rstd * lw[e] + lb[e] + bon * v[e]) * g[e];
        v4u o0, o1;
        o0.x = pk2(o[0], o[1]); o0.y = pk2(o[2], o[3]); o0.z = pk2(o[4], o[5]); o0.w = pk2(o[6], o[7]);
        o1.x = pk2(o[8], o[9]); o1.y = pk2(o[10], o[11]); o1.z = pk2(o[12], o[13]); o1.w = pk2(o[14], o[15]);
        *(v4u*)(Y + (size_t)m * D + c0) = o0; *(v4u*)(Y + (size_t)m * D + c0 + 8) = o1;
    }
}

__device__ __forceinline__ void phase_ssd_conv(const Ctx& c, KArgs& a, int l) {
    unsigned char* ws = a.ws;
    const bf16* PS = (const bf16*)(ws + WS_OV + OV_PS);
    bf16* XBC = (bf16*)(ws + WS_OV + OV_XBC);
    float* DT = (float*)(ws + WS_OV + OV_DT); float* DA = (float*)(ws + WS_OV + OV_DA);
    const float* cw = a.in[I_CW] + (size_t)l * 4 * 3072; const float* cb = a.in[I_CB] + (size_t)l * 3072;
    const int gw = c.bid * 8 + c.wave, NGW = c.G * 8, lane = c.lane;
    constexpr int RUN = 16, NRUN = MH / RUN;
    for (int it = gw; it < 2 * NRUN; it += NGW) {
        const int cb_ = 4 + (it & 1), run = it >> 1, ch0 = cb_ * 512 + lane * 8, m0 = run * RUN;
        float w[4][8], bias[8];
#pragma unroll
        for (int j = 0; j < 4; ++j)
#pragma unroll
            for (int e = 0; e < 8; ++e) w[j][e] = cw[j * 3072 + ch0 + e];
#pragma unroll
        for (int e = 0; e < 8; ++e) bias[e] = cb[ch0 + e];
        float x0[8], x1[8], x2[8], x3[8];
        const bf16* base = PS + (size_t)m0 * N2P + 2048 + ch0;
        const int t0 = m0 & (T - 1);
        if (t0 >= 3) { unpack8(*(const v4u*)(base - 3 * N2P), x0); unpack8(*(const v4u*)(base - 2 * N2P), x1); unpack8(*(const v4u*)(base - N2P), x2); }
        else {
#pragma unroll
            for (int e = 0; e < 8; ++e) { x0[e] = 0.f; x1[e] = 0.f; x2[e] = 0.f; }
        }
        v4u nx = *(const v4u*)base;
#pragma unroll 4
        for (int i = 0; i < RUN; ++i) {
            unpack8(nx, x3);
            if (i + 1 < RUN) nx = *(const v4u*)(base + (size_t)(i + 1) * N2P);
            float o[8];
#pragma unroll
            for (int e = 0; e < 8; ++e) { const float y = bias[e] + x0[e] * w[0][e] + x1[e] * w[1][e] + x2[e] * w[2][e] + x3[e] * w[3][e]; o[e] = siluf_(y); x0[e] = x1[e]; x1[e] = x2[e]; x2[e] = x3[e]; }
            *(v4u*)(XBC + (size_t)(m0 + i) * 3072 + ch0) = pack8(o);
        }
    }
}

__device__ __forceinline__ void tr_bm2(unsigned a, bf16x8& f0, bf16x8& f1) {
    s16x4 l0, h0, l1, h1;
    asm volatile("ds_read_b64_tr_b16 %0, %4\n\tds_read_b64_tr_b16 %1, %4 offset:1088\n\tds_read_b64_tr_b16 %2, %4 offset:8704\n\tds_read_b64_tr_b16 %3, %4 offset:9792\n\ts_waitcnt lgkmcnt(0)"
                 : "=&v"(l0), "=&v"(h0), "=&v"(l1), "=&v"(h1) : "v"(a) : "memory");
    f0 = __builtin_shufflevector(l0, h0, 0, 1, 2, 3, 4, 5, 6, 7); f1 = __builtin_shufflevector(l1, h1, 0, 1, 2, 3, 4, 5, 6, 7);
}
__device__ __forceinline__ void tr_x2(unsigned a, bf16x8& f0, bf16x8& f1) {
    s16x4 l0, h0, l1, h1;
    asm volatile("ds_read_b64_tr_b16 %0, %4\n\tds_read_b64_tr_b16 %1, %4 offset:320\n\tds_read_b64_tr_b16 %2, %4 offset:2560\n\tds_read_b64_tr_b16 %3, %4 offset:2880\n\ts_waitcnt lgkmcnt(0)"
                 : "=&v"(l0), "=&v"(h0), "=&v"(l1), "=&v"(h1) : "v"(a) : "memory");
    f0 = __builtin_shufflevector(l0, h0, 0, 1, 2, 3, 4, 5, 6, 7); f1 = __builtin_shufflevector(l1, h1, 0, 1, 2, 3, 4, 5, 6, 7);
}
__device__ __forceinline__ void tr_x4(unsigned a, bf16x8& f00, bf16x8& f01, bf16x8& f10, bf16x8& f11) {
    s16x4 l0, h0, l1, h1, l2, h2, l3, h3;
    asm volatile("ds_read_b64_tr_b16 %0, %8\n\tds_read_b64_tr_b16 %1, %8 offset:320\n\tds_read_b64_tr_b16 %2, %8 offset:2560\n\tds_read_b64_tr_b16 %3, %8 offset:2880\n\t"
                 "ds_read_b64_tr_b16 %4, %8 offset:32\n\tds_read_b64_tr_b16 %5, %8 offset:352\n\tds_read_b64_tr_b16 %6, %8 offset:2592\n\tds_read_b64_tr_b16 %7, %8 offset:2912\n\ts_waitcnt lgkmcnt(0)"
                 : "=&v"(l0), "=&v"(h0), "=&v"(l1), "=&v"(h1), "=&v"(l2), "=&v"(h2), "=&v"(l3), "=&v"(h3) : "v"(a) : "memory");
    f00 = __builtin_shufflevector(l0, h0, 0, 1, 2, 3, 4, 5, 6, 7); f01 = __builtin_shufflevector(l1, h1, 0, 1, 2, 3, 4, 5, 6, 7);
    f10 = __builtin_shufflevector(l2, h2, 0, 1, 2, 3, 4, 5, 6, 7); f11 = __builtin_shufflevector(l3, h3, 0, 1, 2, 3, 4, 5, 6, 7);
}
__device__ __forceinline__ void phase_ssd_scan(const Ctx& c, KArgs& a, int l) {
    unsigned char* ws = a.ws;
    const bf16* PS = (const bf16*)(ws + WS_OV + OV_PS);
    bf16* XBC = (bf16*)(ws + WS_OV + OV_XBC);
    const float* cw = a.in[I_CW] + (size_t)l * 4 * 3072; const float* cb = a.in[I_CB] + (size_t)l * 3072;
    const float* DT = (const float*)(ws + WS_OV + OV_DT); const float* ACS = (const float*)(ws + WS_OV + OV_DA);
    constexpr int SC = 136, SM = 72, SX = 40;
    LAS bf16* Cm = (LAS bf16*)c.lds;
    LAS bf16* Bm = Cm + 64 * SC;
    LAS bf16* Xd = Bm + 64 * SC;
    LAS bf16* Xs = Xd + 64 * SX;
    LAS bf16* Xr = Xs + 64 * SX;
    LAS bf16* MtT = Xr + 64 * SX;
    LAS bf16* SL = MtT + 64 * SM;
    LAS float* acsL = (LAS float*)(SL + 32 * SC);
    const unsigned BmB = (unsigned)(size_t)Bm, XdB = (unsigned)(size_t)Xd, XsB = (unsigned)(size_t)Xs;
    const int tid = c.tid, lane = c.lane, w = c.wave, r = lane & 15, q = lane >> 4;
    const int sj = tid >> 3, sn = (tid & 7) * 16, sp = (tid & 7) * 4;
    const int trq = ((lane & 15) >> 2), trp = lane & 3;
    const unsigned troffB = (unsigned)(((8 * q + trq) * SC + 4 * trp) * 2), troffX = (unsigned)(((8 * q + trq) * SX + 4 * trp) * 2);
    for (int unit = c.bid; unit < 256; unit += c.G) {
        const int b = unit >> 6, h = (unit >> 1) & 31, ph = unit & 1, g = h >> 3;
        const size_t m0 = (size_t)b * T;
        f32x4 st[2] = {(f32x4){0.f, 0.f, 0.f, 0.f}, (f32x4){0.f, 0.f, 0.f, 0.f}};
        for (int e = tid; e < 32 * SC / 2; e += 512) ((LAS unsigned*)SL)[e] = 0u;
        v4u gB0, gB1, gC0, gC1; v2u gX0, gX1, gX2, gX3; float gacs, gacsE, gdt;
        const int chx = h * 64 + ph * 32 + sp; const float Dh = a.in[I_SD][l * 32 + h];
        float cwt[4][4], cbs[4];
#pragma unroll
        for (int e2 = 0; e2 < 4; ++e2) { cbs[e2] = cb[chx + e2];
#pragma unroll
            for (int j = 0; j < 4; ++j) cwt[j][e2] = cw[j * 3072 + chx + e2]; }
#define SS_LOAD(chunk) do { const size_t row = m0 + (size_t)(chunk) * 64 + sj; const bf16* xr = XBC + row * 3072; \
            gB0 = *(const v4u*)(xr + 2048 + g * 128 + sn); gB1 = *(const v4u*)(xr + 2048 + g * 128 + sn + 8); \
            gC0 = *(const v4u*)(xr + 2560 + g * 128 + sn); gC1 = *(const v4u*)(xr + 2560 + g * 128 + sn + 8); \
            { const int t_ = (chunk) * 64 + sj; const bf16* pr_ = PS + row * N2P + 2048 + chx; const v2u z2 = (v2u){0u, 0u}; \
              gX3 = *(const v2u*)pr_; gX2 = t_ >= 1 ? *(const v2u*)(pr_ - N2P) : z2; gX1 = t_ >= 2 ? *(const v2u*)(pr_ - 2 * N2P) : z2; gX0 = t_ >= 3 ? *(const v2u*)(pr_ - 3 * N2P) : z2; } \
            gacs = ACS[row * 32 + h]; gacsE = ACS[(m0 + (size_t)(chunk) * 64 + 63) * 32 + h]; gdt = DT[row * 32 + h]; } while (0)
#define SS_STAGE() do { \
            *(LAS v4u*)(Bm + sj * SC + sn) = gB0; *(LAS v4u*)(Bm + sj * SC + sn + 8) = gB1; *(LAS v4u*)(Cm + sj * SC + sn) = gC0; *(LAS v4u*)(Cm + sj * SC + sn + 8) = gC1; \
            const float sc_ = gdt * __expf(gacsE - gacs); \
            const float r0_[4] = {bflo(gX0.x), bfhi(gX0.x), bflo(gX0.y), bfhi(gX0.y)}, r1_[4] = {bflo(gX1.x), bfhi(gX1.x), bflo(gX1.y), bfhi(gX1.y)}; \
            const float r2_[4] = {bflo(gX2.x), bfhi(gX2.x), bflo(gX2.y), bfhi(gX2.y)}, r3_[4] = {bflo(gX3.x), bfhi(gX3.x), bflo(gX3.y), bfhi(gX3.y)}; \
            float xa_[4]; _Pragma("unroll") for (int e2 = 0; e2 < 4; ++e2) xa_[e2] = siluf_(cbs[e2] + r0_[e2] * cwt[0][e2] + r1_[e2] * cwt[1][e2] + r2_[e2] * cwt[2][e2] + r3_[e2] * cwt[3][e2]); \
            const float x0_ = xa_[0], x1_ = xa_[1], x2_ = xa_[2], x3_ = xa_[3]; \
            v2u o1_, o2_; o1_.x = pk2(x0_ * gdt, x1_ * gdt); o1_.y = pk2(x2_ * gdt, x3_ * gdt); o2_.x = pk2(x0_ * sc_, x1_ * sc_); o2_.y = pk2(x2_ * sc_, x3_ * sc_); \
            *(LAS v2u*)(Xd + sj * SX + sp) = o1_; *(LAS v2u*)(Xs + sj * SX + sp) = o2_; { v2u o3_; o3_.x = pk2(x0_, x1_); o3_.y = pk2(x2_, x3_); *(LAS v2u*)(Xr + sj * SX + sp) = o3_; } \
            if ((tid & 7) == 0) acsL[sj] = gacs; } while (0)
        SS_LOAD(0);
        SS_STAGE();
        __syncthreads();
        for (int ch = 0; ch < T / 64; ++ch) {
            if (ch + 1 < T / 64) SS_LOAD(ch + 1);
            {
                const int jt = w >> 1, it0 = 2 * (w & 1);
                f32x4 acc0 = (f32x4){0.f, 0.f, 0.f, 0.f}, acc1 = acc0;
                if (it0 + 1 >= jt) {
#pragma unroll
                    for (int ks = 0; ks < 4; ++ks) {
                        const bf16x8 af = *(const LAS bf16x8*)(Bm + (16 * jt + r) * SC + 32 * ks + 8 * q);
                        const bf16x8 b0 = *(const LAS bf16x8*)(Cm + (16 * it0 + r) * SC + 32 * ks + 8 * q);
                        const bf16x8 b1 = *(const LAS bf16x8*)(Cm + (16 * (it0 + 1) + r) * SC + 32 * ks + 8 * q);
                        acc0 = __builtin_amdgcn_mfma_f32_16x16x32_bf16(af, b0, acc0, 0, 0, 0);
                        acc1 = __builtin_amdgcn_mfma_f32_16x16x32_bf16(af, b1, acc1, 0, 0, 0);
                    }
                }
                const int i0 = 16 * it0 + r, i1 = i0 + 16;
                const float ai0 = acsL[i0], ai1 = acsL[i1];
                float m0v[4], m1v[4];
#pragma unroll
                for (int e = 0; e < 4; ++e) { const int j = 16 * jt + 4 * q + e; const float aj = acsL[j];
                    m0v[e] = (j <= i0) ? acc0[e] * __expf(ai0 - aj) : 0.f; m1v[e] = (j <= i1) ? acc1[e] * __expf(ai1 - aj) : 0.f; }
                { v2u o0, o1; o0.x = pk2(m0v[0], m0v[1]); o0.y = pk2(m0v[2], m0v[3]); o1.x = pk2(m1v[0], m1v[1]); o1.y = pk2(m1v[2], m1v[3]);
                  *(LAS v2u*)(MtT + i0 * SM + 16 * jt + 4 * q) = o0; *(LAS v2u*)(MtT + i1 * SM + 16 * jt + 4 * q) = o1; }
            }
            lds_barrier();
            {
                const int it = w >> 1, pt = w & 1;
                f32x4 accD = (f32x4){0.f, 0.f, 0.f, 0.f}, accO = accD;
                {
                    bf16x8 xb0, xb1; tr_x2(XdB + troffX + 32u * pt, xb0, xb1);
                    const bf16x8 af0 = *(const LAS bf16x8*)(MtT + (16 * it + r) * SM + 8 * q);
                    accD = __builtin_amdgcn_mfma_f32_16x16x32_bf16(af0, xb0, accD, 0, 0, 0);
                    if (it >= 2) {
                        const bf16x8 af1 = *(const LAS bf16x8*)(MtT + (16 * it + r) * SM + 32 + 8 * q);
                        accD = __builtin_amdgcn_mfma_f32_16x16x32_bf16(af1, xb1, accD, 0, 0, 0);
                    }
                }
#pragma unroll
                for (int ks = 0; ks < 4; ++ks) {
                    const bf16x8 af = *(const LAS bf16x8*)(Cm + (16 * it + r) * SC + 32 * ks + 8 * q);
                    const bf16x8 bf_ = *(const LAS bf16x8*)(SL + (16 * pt + r) * SC + 32 * ks + 8 * q);
                    accO = __builtin_amdgcn_mfma_f32_16x16x32_bf16(af, bf_, accO, 0, 0, 0);
                }
                const int p = 16 * pt + r;
#pragma unroll
                for (int e = 0; e < 4; ++e) { const int i = 16 * it + 4 * q + e; const float y = accD[e] + __expf(acsL[i]) * accO[e] + Dh * bf1(Xr[i * SX + p]);
                    XBC[(m0 + (size_t)ch * 64 + i) * 3072 + h * 64 + ph * 32 + p] = (bf16)f2bf(y); }
            }
            {
                const float dec = __expf(acsL[63]);
                bf16x8 a0, a1, bx[2][2];
                tr_bm2(BmB + troffB + 32u * w, a0, a1);
                tr_x4(XsB + troffX, bx[0][0], bx[0][1], bx[1][0], bx[1][1]);
#pragma unroll
                for (int pt = 0; pt < 2; ++pt) {
                    f32x4 s = st[pt] * dec;
                    s = __builtin_amdgcn_mfma_f32_16x16x32_bf16(a0, bx[pt][0], s, 0, 0, 0);
                    s = __builtin_amdgcn_mfma_f32_16x16x32_bf16(a1, bx[pt][1], s, 0, 0, 0);
                    st[pt] = s;
                }
            }
            lds_barrier();
#pragma unroll
            for (int pt = 0; pt < 2; ++pt) { v2u o; o.x = pk2c(st[pt][0], st[pt][1]); o.y = pk2c(st[pt][2], st[pt][3]);
                *(LAS v2u*)(SL + (16 * pt + r) * SC + 16 * w + 4 * q) = o; }
            if (ch + 1 < T / 64) SS_STAGE();
            lds_barrier();
        }
#undef SS_LOAD
#undef SS_STAGE
    }
}

__device__ __forceinline__ void phase_ssd_post(const Ctx& c, KArgs& a, int l) {
    unsigned char* ws = a.ws;
    bf16* PS = (bf16*)(ws + WS_OV + OV_PS);
    const bf16* XBC = (const bf16*)(ws + WS_OV + OV_XBC);
    const int lane = c.lane, c0 = 32 * lane;
    const float* ng = a.in[I_SNG] + (size_t)l * 2048 + c0;
    const int gw = c.bid * 8 + c.wave, NGW = c.G * 8;
    v4u nyy[4], nzz[4];
#define SP_LOAD(mm) do { _Pragma("unroll") for (int q = 0; q < 4; ++q) { nyy[q] = *(const v4u*)(XBC + (size_t)(mm) * 3072 + c0 + 8 * q); nzz[q] = *(const v4u*)(PS + (size_t)(mm) * N2P + c0 + 8 * q); } } while (0)
    if (gw < MH) SP_LOAD(gw);
    for (int m = gw; m < MH; m += NGW) {
        float y[32]; float ss = 0.f;
        v4u cyy[4], czz[4];
#pragma unroll
        for (int q = 0; q < 4; ++q) { cyy[q] = nyy[q]; czz[q] = nzz[q]; }
        if (m + NGW < MH) SP_LOAD(m + NGW);
#pragma unroll
        for (int q = 0; q < 4; ++q) {
            float yy[8], zz[8];
            unpack8(cyy[q], yy); unpack8(czz[q], zz);
#pragma unroll
            for (int e = 0; e < 8; ++e) { const float v = yy[e] * siluf_(zz[e]); y[8 * q + e] = v; ss += v * v; }
        }
        ss = sum16(ss);
        const float r = rsqrtf(ss * (1.f / 512.f) + 1e-6f);
#pragma unroll
        for (int q = 0; q < 4; ++q) {
            float o[8];
#pragma unroll
            for (int e = 0; e < 8; ++e) o[e] = y[8 * q + e] * r * ng[8 * q + e];
            *(v4u*)(PS + (size_t)m * N2P + 2048 + c0 + 8 * q) = pack8(o);
        }
    }
}

__device__ __forceinline__ void phase_peer_convert(const Ctx& c, KArgs& a, int l) {
    unsigned char* ws = a.ws;
    const int gw = c.bid * 8 + c.wave, NGW = c.G * 8, lane = c.lane;
    f32x4 n0, n1, n2, n3;
#define PC_LOAD(itt) do { const int tb_ = (itt) >= NEXP, e_ = (itt) - tb_ * NEXP; const float* s_ = (tb_ ? a.in[I_PU] : a.in[I_PD]) + ((size_t)l * NEXP + e_) * D + 16 * lane; \
        n0 = *(const f32x4*)s_; n1 = *(const f32x4*)(s_ + 4); n2 = *(const f32x4*)(s_ + 8); n3 = *(const f32x4*)(s_ + 12); } while (0)
    if (gw < 2 * NEXP) PC_LOAD(gw);
    for (int it = gw; it < 2 * NEXP; it += NGW) {
        const int tb = it >= NEXP, e = it - tb * NEXP;
        const f32x4 x0 = n0, x1 = n1, x2 = n2, x3 = n3;
        if (it + NGW < 2 * NEXP) PC_LOAD(it + NGW);
        float am = fmaxf(fmaxf(fmaxf(fabsf(x0.x), fabsf(x0.y)), fmaxf(fabsf(x0.z), fabsf(x0.w))), fmaxf(fmaxf(fabsf(x1.x), fabsf(x1.y)), fmaxf(fabsf(x1.z), fabsf(x1.w))));
        am = fmaxf(am, fmaxf(fmaxf(fmaxf(fabsf(x2.x), fabsf(x2.y)), fmaxf(fabsf(x2.z), fabsf(x2.w))), fmaxf(fmaxf(fabsf(x3.x), fabsf(x3.y)), fmaxf(fabsf(x3.z), fabsf(x3.w)))));
#pragma unroll
        for (int o = 1; o < 64; o <<= 1) am = fmaxf(am, __shfl_xor(am, o));
        am = fmaxf(am, 1e-30f);
        const float s = 384.f / am;
        v4u q;
        int w;
        w = __builtin_amdgcn_cvt_pk_fp8_f32(x0.x * s, x0.y * s, 0, false); w = __builtin_amdgcn_cvt_pk_fp8_f32(x0.z * s, x0.w * s, w, true); q.x = (unsigned)w;
        w = __builtin_amdgcn_cvt_pk_fp8_f32(x1.x * s, x1.y * s, 0, false); w = __builtin_amdgcn_cvt_pk_fp8_f32(x1.z * s, x1.w * s, w, true); q.y = (unsigned)w;
        w = __builtin_amdgcn_cvt_pk_fp8_f32(x2.x * s, x2.y * s, 0, false); w = __builtin_amdgcn_cvt_pk_fp8_f32(x2.z * s, x2.w * s, w, true); q.z = (unsigned)w;
        w = __builtin_amdgcn_cvt_pk_fp8_f32(x3.x * s, x3.y * s, 0, false); w = __builtin_amdgcn_cvt_pk_fp8_f32(x3.z * s, x3.w * s, w, true); q.w = (unsigned)w;
        *(v4u*)(ws + WS_OV + (tb ? OV_UP : OV_DOWN) + (size_t)e * D + 16 * lane) = q;
        if (lane == 0) ((float*)(ws + WS_OV + OV_PSCALE))[it] = am * (1.f / 384.f);
    }
}

template <class TT> __device__ __forceinline__ void ce_desc(TT& a, TT& b) { const TT hi = a > b ? a : b, lo = a > b ? b : a; a = hi; b = lo; }
__device__ __forceinline__ void cef(float& a, float& b) { const float hi = fmaxf(a, b), lo = fminf(a, b); a = hi; b = lo; }
__device__ __forceinline__ void ced(double& a, double& b) { const double hi = fmax(a, b), lo = fmin(a, b); a = hi; b = lo; }
template <class TT, class CE> __device__ __forceinline__ void bitonic_sort16_desc(TT (&v)[16], CE ce) {
#pragma unroll
    for (int k = 2; k <= 16; k <<= 1)
#pragma unroll
        for (int j = k >> 1; j > 0; j >>= 1)
#pragma unroll
            for (int i = 0; i < 16; ++i) { const int p = i ^ j; if (p > i) { if ((i & k) == 0) ce(v[i], v[p]); else ce(v[p], v[i]); } }
}
template <class TT, class CE> __device__ __forceinline__ void bitonic_merge16_desc(TT (&v)[16], CE ce) {
#pragma unroll
    for (int j = 8; j > 0; j >>= 1)
#pragma unroll
        for (int i = 0; i < 16; ++i) { const int p = i ^ j; if (p > i) ce(v[i], v[p]); }
}
struct CEF { __device__ __forceinline__ void operator()(float& a, float& b) const { cef(a, b); } };
struct CED { __device__ __forceinline__ void operator()(double& a, double& b) const { ced(a, b); } };

__device__ __forceinline__ void top16_of_128(const bf16* p, float (&top)[16]) {
#pragma unroll
    for (int grp = 0; grp < 8; ++grp) {
        float cur[16];
        const v4u q0 = *(const v4u*)(p + grp * 16), q1 = *(const v4u*)(p + grp * 16 + 8);
        const unsigned w[8] = {q0.x, q0.y, q0.z, q0.w, q1.x, q1.y, q1.z, q1.w};
#pragma unroll
        for (int e = 0; e < 8; ++e) {
            const unsigned lo = w[e] << 16, hi = w[e] & 0xffff0000u;
            const unsigned i0 = grp * 16 + 2 * e, i1 = i0 + 1;
            cur[2 * e] = __builtin_bit_cast(float, lo | ((lo >> 31) ? i0 : (127u - i0)));
            cur[2 * e + 1] = __builtin_bit_cast(float, hi | ((hi >> 31) ? i1 : (127u - i1)));
        }
        bitonic_sort16_desc(cur, CEF());
        if (grp == 0) {
#pragma unroll
            for (int i = 0; i < 16; ++i) top[i] = cur[i];
        } else {
#pragma unroll
            for (int i = 0; i < 16; ++i) top[i] = fmaxf(top[i], cur[15 - i]);
            bitonic_merge16_desc(top, CEF());
        }
    }
}
__device__ __forceinline__ unsigned key_index(float k) { const unsigned u = __builtin_bit_cast(unsigned, k); const unsigned lo = u & 0x7fu; return (u >> 31) ? lo : 127u - lo; }
__device__ __forceinline__ float key_value(float k) { return __builtin_bit_cast(float, __builtin_bit_cast(unsigned, k) & 0xffff0000u); }

__device__ __forceinline__ void phase_peer_topk(const Ctx& c, KArgs& a) {
    unsigned char* ws = a.ws;
    const bf16* SC = (const bf16*)(ws + WS_OV + OV_SC);
    int* IDX = (int*)(ws + WS_OV + OV_IDX); float* GATE = (float*)(ws + WS_OV + OV_GATE);
    for (int it = c.bid * 512 + c.tid; it < M * 8; it += c.G * 512) {
        const bf16* p = SC + (size_t)it * 256;
        float t0[16], t1[16];
        top16_of_128(p, t0); top16_of_128(p + 128, t1);
        float v0[16], v1[16]; unsigned i0[16], i1[16];
#pragma unroll
        for (int i = 0; i < 16; ++i) { v0[i] = key_value(t0[i]); v1[i] = key_value(t1[i]); i0[i] = key_index(t0[i]); i1[i] = key_index(t1[i]); }
        double top[16];
        const double NEG = -1.0e300;
#pragma unroll
        for (int grp = 0; grp < 4; ++grp) {
            double cur[16];
#pragma unroll
            for (int s = 0; s < 16; ++s) cur[s] = NEG;
            int n = 0;
#pragma unroll
            for (int i = 0; i < 16; ++i)
#pragma unroll
                for (int j = 0; j < 16; ++j) if ((i + 1) * (j + 1) <= 16) {
                    if (n / 16 == grp) {
                        const double d = (double)(v0[i] + v1[j]);
                        const unsigned long long eid = (unsigned long long)(i0[i] * 128u + i1[j]);
                        const unsigned long long bits = __builtin_bit_cast(unsigned long long, d);
                        cur[n % 16] = __builtin_bit_cast(double, bits | ((bits >> 63) ? eid : (16383ull - eid)));
                    }
                    ++n;
                }
            bitonic_sort16_desc(cur, CED());
            if (grp == 0) {
#pragma unroll
                for (int i = 0; i < 16; ++i) top[i] = cur[i];
            } else {
#pragma unroll
                for (int i = 0; i < 16; ++i) top[i] = fmax(top[i], cur[15 - i]);
                bitonic_merge16_desc(top, CED());
            }
        }
        float sv[16]; int id[16];
#pragma unroll
        for (int i = 0; i < 16; ++i) { const unsigned long long bits = __builtin_bit_cast(unsigned long long, top[i]); const unsigned lo = (unsigned)(bits & 0x3fffull);
            id[i] = (int)((bits >> 63) ? lo : 16383u - lo); sv[i] = (float)top[i]; }
        float den = 0.f, ex[16];
#pragma unroll
        for (int i = 0; i < 16; ++i) { ex[i] = __expf(sv[i] - sv[0]); den += ex[i]; }
        const float inv = 1.f / den;
        unsigned cw[4] = {0u, 0u, 0u, 0u};
#pragma unroll
        for (int i = 0; i < 16; ++i) { const unsigned s = (unsigned)id[i] >> PEER_SLICE_SHIFT, inc = 1u << (8 * (s & 3)), ws_ = s >> 2;
            cw[0] += ws_ == 0 ? inc : 0u; cw[1] += ws_ == 1 ? inc : 0u; cw[2] += ws_ == 2 ? inc : 0u; cw[3] += ws_ == 3 ? inc : 0u; }
        unsigned lp[4], tot[4], st[4];
        const int l8 = c.lane & 7;
#pragma unroll
        for (int k = 0; k < 4; ++k) { unsigned v = cw[k];
#pragma unroll
            for (int o = 1; o < 8; o <<= 1) { const unsigned y = __shfl_up(v, o, 8); v += (l8 >= o) ? y : 0u; }
            tot[k] = __shfl(v, 7, 8); lp[k] = v - cw[k]; }
        {   unsigned carry = 0u;
#pragma unroll
            for (int k = 0; k < 4; ++k) { st[k] = tot[k] * 0x01010100u + carry * 0x01010101u; carry += (tot[k] * 0x01010101u) >> 24; } }
        unsigned run[4] = {st[0] + lp[0], st[1] + lp[1], st[2] + lp[2], st[3] + lp[3]};
        const size_t tok = (size_t)(it >> 3);
#pragma unroll
        for (int i = 0; i < 16; ++i) { const unsigned s = (unsigned)id[i] >> PEER_SLICE_SHIFT, sh = 8 * (s & 3), ws_ = s >> 2, inc = 1u << sh;
            const unsigned wsel = ws_ == 0 ? run[0] : (ws_ == 1 ? run[1] : (ws_ == 2 ? run[2] : run[3]));
            const unsigned pos = (wsel >> sh) & 0xffu;
            run[0] += ws_ == 0 ? inc : 0u; run[1] += ws_ == 1 ? inc : 0u; run[2] += ws_ == 2 ? inc : 0u; run[3] += ws_ == 3 ? inc : 0u;
            IDX[tok * 128 + pos] = id[i]; GATE[tok * 128 + pos] = ex[i] * inv; }
        if (l8 == 0) ((v4u*)(ws + WS_OV + OV_POFF))[tok] = (v4u){st[0], st[1], st[2], st[3]};
    }
}

__device__ __forceinline__ float gelu_tanh(float x) { const float u = 0.7978845608f * (x + 0.044715f * x * x * x); const float t = 1.f - 2.f / (1.f + __expf(2.f * u)); return 0.5f * x * (1.f + t); }
__device__ __forceinline__ void unpack16_fp8(const v4u& q, float (&o)[16]) {
    const unsigned w[4] = {q.x, q.y, q.z, q.w};
#pragma unroll
    for (int i = 0; i < 4; ++i) { const f32x2 lo = __builtin_amdgcn_cvt_pk_f32_fp8((int)w[i], false), hi = __builtin_amdgcn_cvt_pk_f32_fp8((int)w[i], true);
        o[4 * i] = lo.x; o[4 * i + 1] = lo.y; o[4 * i + 2] = hi.x; o[4 * i + 3] = hi.y; }
}
__device__ __forceinline__ int slice_start(unsigned o0, unsigned o1, unsigned o2, unsigned o3, int s) {
    const unsigned wsel = s < 4 ? o0 : (s < 8 ? o1 : (s < 12 ? o2 : o3));
    return s >= PEER_NSLICE ? 128 : (int)((wsel >> (8 * (s & 3))) & 0xffu);
}
template <int MODE> __device__ __forceinline__ void phase_peer_down(const Ctx& c, KArgs& a, int l, int qset) {
    unsigned char* ws = a.ws;
    const unsigned char* U8 = ws + WS_OV + OV_U8; const float* XS = (const float*)(ws + WS_OV + OV_XS);
    const unsigned char* DN = ws + WS_OV + OV_DOWN;
    const int* IDX = (const int*)(ws + WS_OV + OV_IDX);
    const v4u* POFF = (const v4u*)(ws + WS_OV + OV_POFF);
    float* ACT = (float*)(ws + WS_OV + (qset ? 278 * MiB : OV_ACT));
    unsigned* QC = (unsigned*)(ws + WS_CTL) + CW_QUEUE + (qset * 2 + l) * PEER_NSLICE * 64;
    constexpr int RS = 528;
    LAS unsigned char* wb = c.lds + c.wave * (8192 + 16 * RS);
    LAS unsigned* lpk = (LAS unsigned*)wb;
    LAS unsigned char* RB = wb + 8192;
    const int lane = c.lane, r16 = lane & 15, q = lane >> 4, hsel = lane >> 5, l32 = lane & 31;
    constexpr int NBLK = M / 16;
    const int s = c.bid & (PEER_NSLICE - 1);
    const int nrank = ((c.G - s + PEER_NSLICE - 1) >> 3) * 8, rank = (c.bid >> 3) * 8 + c.wave;
    {
#pragma unroll 1
        for (int blk = rank; blk < NBLK; blk += nrank) {
            const size_t mb = (size_t)blk * 16;
            v4u xb[16];
            { const unsigned char* xp = U8 + (mb + r16) * D + 16 * q;
#pragma unroll
              for (int j = 0; j < 16; ++j) xb[j] = *(const v4u*)(xp + 64 * j); }
            const float xs = XS[mb + r16];
            int pav = 0, nv = 0;
            if (lane < 16) { const v4u po = POFF[mb + lane]; pav = slice_start(po.x, po.y, po.z, po.w, s); nv = slice_start(po.x, po.y, po.z, po.w, s + 1) - pav; }
            int incl = nv;
#pragma unroll
            for (int o = 1; o < 16; o <<= 1) { const int y = __shfl_up(incl, o, 16); incl += (r16 >= o) ? y : 0; }
            const int offv = incl - nv;
            const int P = __builtin_amdgcn_readlane(incl, 15);
            {
                int idr[16];
#pragma unroll
                for (int ti = 0; ti < 16; ++ti) { const int pa = __builtin_amdgcn_readlane(pav, ti); const int e = pa + lane; idr[ti] = IDX[(mb + ti) * 128 + (e < 127 ? e : 127)]; }
#pragma unroll
                for (int ti = 0; ti < 16; ++ti) { const int pa = __builtin_amdgcn_readlane(pav, ti), n = __builtin_amdgcn_readlane(nv, ti), off = __builtin_amdgcn_readlane(offv, ti);
                    if (lane < n) lpk[off + lane] = (unsigned)idr[ti] | ((unsigned)ti << 14) | ((unsigned)(pa + lane) << 18); }
                if (__builtin_amdgcn_ballot_w64(nv > 64) != 0ull) {
#pragma unroll 1
                    for (int ti = 0; ti < 16; ++ti) { const int pa = __builtin_amdgcn_readlane(pav, ti), n = __builtin_amdgcn_readlane(nv, ti), off = __builtin_amdgcn_readlane(offv, ti);
                        if (lane + 64 < n) lpk[off + 64 + lane] = (unsigned)IDX[(mb + ti) * 128 + pa + 64 + lane] | ((unsigned)ti << 14) | ((unsigned)(pa + 64 + lane) << 18); }
                }
            }
            asm volatile("s_waitcnt vmcnt(0) lgkmcnt(0)" ::: "memory");
            const int nb = (P + 15) >> 4;
#define PD_IDS(PW, B) { const v4u ia = *(const LAS v4u*)(lpk + (B) * 16 + 8 * hsel), ib = *(const LAS v4u*)(lpk + (B) * 16 + 8 * hsel + 4); \
                PW[0] = ia.x; PW[1] = ia.y; PW[2] = ia.z; PW[3] = ia.w; PW[4] = ib.x; PW[5] = ib.y; PW[6] = ib.z; PW[7] = ib.w; }
#define PD_LOADH(PW, H) { _Pragma("unroll") for (int i = 0; i < 8; ++i) { const unsigned id = MODE == 1 ? (PW[i] & 63u) : (PW[i] & 16383u); \
                    rr[8 * (H) + i] = *(const v4u*)(DN + (size_t)(id * 1024u + 512u * (H) + 16u * l32)); } }
            if (nb > 0) {
                v4u rr[16];
                { unsigned pw[8]; PD_IDS(pw, 0) PD_LOADH(pw, 0) PD_LOADH(pw, 1) }
#pragma unroll 1
                for (int b = 0; b < nb; ++b) {
                    const int bn = b + 1 < nb ? b + 1 : b;
                    unsigned pwn[8]; PD_IDS(pwn, bn)
                    const v4u mt = *(const LAS v4u*)(lpk + b * 16 + 4 * q);
                    f32x4 acc0 = {0.f, 0.f, 0.f, 0.f}, acc1 = {0.f, 0.f, 0.f, 0.f};
#pragma unroll
                    for (int h = 0; h < 2; ++h) {
#pragma unroll
                        for (int i = 0; i < 8; ++i) *(LAS v4u*)(RB + (8 * hsel + i) * RS + 16 * l32) = rr[8 * h + i];
                        PD_LOADH(pwn, h)
#pragma unroll
                        for (int jj = 0; jj < 8; ++jj) {
                            const v4u av = *(const LAS v4u*)(RB + r16 * RS + 64 * jj + 16 * q);
                            const v4u bv = xb[8 * h + jj];
                            const long a0 = (long)(((unsigned long long)av.y << 32) | av.x), a1 = (long)(((unsigned long long)av.w << 32) | av.z);
                            const long b0 = (long)(((unsigned long long)bv.y << 32) | bv.x), b1 = (long)(((unsigned long long)bv.w << 32) | bv.z);
                            acc0 = __builtin_amdgcn_mfma_f32_16x16x32_fp8_fp8(a0, b0, acc0, 0, 0, 0);
                            acc1 = __builtin_amdgcn_mfma_f32_16x16x32_fp8_fp8(a1, b1, acc1, 0, 0, 0);
                        }
                    }
                    const f32x4 dv = (acc0 + acc1) * xs;
                    const unsigned me[4] = {mt.x, mt.y, mt.z, mt.w};
                    const float dd[4] = {dv.x, dv.y, dv.z, dv.w};
#pragma unroll
                    for (int i = 0; i < 4; ++i) if (b * 16 + 4 * q + i < P && (int)((me[i] >> 14) & 15u) == r16) lpk[b * 16 + 4 * q + i] = __builtin_bit_cast(unsigned, dd[i]);
                }
            }
#pragma unroll
            for (int ti = 0; ti < 16; ++ti) { const int pa = __builtin_amdgcn_readlane(pav, ti), n = __builtin_amdgcn_readlane(nv, ti), off = __builtin_amdgcn_readlane(offv, ti);
                if (lane < n) ACT[(mb + ti) * 128 + pa + lane] = __builtin_bit_cast(float, lpk[off + lane]); }
            if (__builtin_amdgcn_ballot_w64(nv > 64) != 0ull) {
#pragma unroll 1
                for (int ti = 0; ti < 16; ++ti) { const int pa = __builtin_amdgcn_readlane(pav, ti), n = __builtin_amdgcn_readlane(nv, ti), off = __builtin_amdgcn_readlane(offv, ti);
                    if (lane + 64 < n) ACT[(mb + ti) * 128 + pa + 64 + lane] = __builtin_bit_cast(float, lpk[off + 64 + lane]); }
            }
        }
    }
}

template <int FUSE> __device__ __forceinline__ void phase_peer_experts(const Ctx& c, KArgs& a, const float* gnext, const bool commit = true) {
    unsigned char* ws = a.ws;
    const unsigned char* UP = ws + WS_OV + OV_UP;
    const float* SCD = (const float*)(ws + WS_OV + OV_PSCALE); const float* SCU = SCD + NEXP;
    const int* IDX = (const int*)(ws + WS_OV + OV_IDX); const float* GATE = (const float*)(ws + WS_OV + OV_GATE);
    const float* ACT = (const float*)(ws + WS_OV + OV_ACT);
    float* H = a.out;
    constexpr int TPW = 16, RS = 144;
    LAS unsigned char* wb = c.lds + c.wave * 16384;
    LAS int* idw = (LAS int*)wb;
    LAS unsigned char* wq8 = wb + 8192;
    LAS unsigned char* tile = wb + 10240;
    LAS float* swl = (LAS float*)(wb + 10240 + 32 * RS);
    const int lane = c.lane, r16 = lane & 15, q = lane >> 4, g8 = lane >> 3, c8 = lane & 7;
    const int gw = c.bid * 8 + c.wave, NGW = c.G * 8;
    const unsigned tr_addr = (unsigned)(size_t)(tile + (8 * q + (r16 >> 1)) * RS + 8 * (r16 & 1));
    for (int m0 = gw; m0 < M; m0 += NGW * TPW) {
#pragma unroll 1
        for (int ti = 0; ti < TPW; ++ti) {
            const int m = m0 + ti * NGW;
            float w0 = 0.f, w1 = 0.f; int id0 = 0, id1 = 0;
            if (m < M) {
                id0 = IDX[(size_t)m * 128 + lane]; id1 = IDX[(size_t)m * 128 + 64 + lane];
                const float g0 = GATE[(size_t)m * 128 + lane], g1 = GATE[(size_t)m * 128 + 64 + lane];
                const float a0 = ACT[(size_t)m * 128 + lane], a1 = ACT[(size_t)m * 128 + 64 + lane];
                w0 = g0 * gelu_tanh(a0 * SCD[id0]) * SCU[id0]; w1 = g1 * gelu_tanh(a1 * SCD[id1]) * SCU[id1];
            }
            float am = fmaxf(fabsf(w0), fabsf(w1));
#pragma unroll
            for (int o = 1; o < 64; o <<= 1) am = fmaxf(am, __shfl_xor(am, o));
            am = fmaxf(am, 1e-30f);
            const float qs = 384.f / am;
            const int pk = __builtin_amdgcn_cvt_pk_fp8_f32(w0 * qs, w1 * qs, 0, false);
            wq8[ti * 128 + lane] = (unsigned char)(pk & 0xff); wq8[ti * 128 + 64 + lane] = (unsigned char)((pk >> 8) & 0xff);
            idw[ti * 128 + lane] = id0; idw[ti * 128 + 64 + lane] = id1;
            if (lane == 0) swl[ti] = am * (1.f / 384.f);
        }
        asm volatile("s_waitcnt lgkmcnt(0)" ::: "memory");
        const f32x4 iscv = *(const LAS f32x4*)(swl + 4 * q);
        const float isc[4] = {iscv.x, iscv.y, iscv.z, iscv.w};
        float ssq[4] = {0.f, 0.f, 0.f, 0.f};
#define UPM_W(T4) { _Pragma("unroll") for (int i = 0; i < 4; ++i) *(LAS v4u*)(tile + (4 * g8 + i) * RS + 16 * c8) = rr[4 * (T4) + i]; }
#define UPM_LK(T4, TIN) { if ((TIN) < TPW) { const v4u i4 = *(const LAS v4u*)(idw + (TIN) * 128 + 32 * (T4) + 4 * g8); \
            rr[4 * (T4) + 0] = *(const v4u*)(UPc + (size_t)(i4.x * 1024u)); rr[4 * (T4) + 1] = *(const v4u*)(UPc + (size_t)(i4.y * 1024u)); \
            rr[4 * (T4) + 2] = *(const v4u*)(UPc + (size_t)(i4.z * 1024u)); rr[4 * (T4) + 3] = *(const v4u*)(UPc + (size_t)(i4.w * 1024u)); } }
#define UPM_R(B) asm volatile("ds_read_b64_tr_b8 %0, %8\n\tds_read_b64_tr_b8 %1, %8 offset:16\n\tds_read_b64_tr_b8 %2, %8 offset:32\n\tds_read_b64_tr_b8 %3, %8 offset:48\n\t" \
                         "ds_read_b64_tr_b8 %4, %8 offset:64\n\tds_read_b64_tr_b8 %5, %8 offset:80\n\tds_read_b64_tr_b8 %6, %8 offset:96\n\tds_read_b64_tr_b8 %7, %8 offset:112" \
                         : "=&v"(B[0]), "=&v"(B[1]), "=&v"(B[2]), "=&v"(B[3]), "=&v"(B[4]), "=&v"(B[5]), "=&v"(B[6]), "=&v"(B[7]) : "v"(tr_addr) : "memory")
#define UPM_WAIT(B) asm volatile("s_waitcnt lgkmcnt(0)" : "+v"(B[0]), "+v"(B[1]), "+v"(B[2]), "+v"(B[3]), "+v"(B[4]), "+v"(B[5]), "+v"(B[6]), "+v"(B[7]) :: "memory")
#define UPM_M(B, TI, T4) { v2u wa = *(const LAS v2u*)(wq8 + (TI) * 128 + 32 * (T4) + 8 * q); if (r16 != (TI)) { wa.x = 0u; wa.y = 0u; } \
            const long wal = (long)(((unsigned long long)wa.y << 32) | wa.x); \
            _Pragma("unroll") for (int ct = 0; ct < 8; ++ct) acc[ct] = __builtin_amdgcn_mfma_f32_16x16x32_fp8_fp8(wal, B[ct], acc[ct], 0, 0, 0); }
#define UPM_STEP(BC, BN, J, T4W, TINW, T4M) { if (s0 + (J) + 1 < 4 * TPW) UPM_R(BN); if (s0 + (J) + 2 < 4 * TPW) { UPM_W(T4W) UPM_LK(T4W, TINW) } UPM_M(BC, ti, T4M) UPM_WAIT(BN); }
#pragma unroll 1
        for (int cq = 0; cq < 8; ++cq) {
            const unsigned char* UPc = UP + 128 * cq + 16 * c8;
            f32x4 acc[8];
#pragma unroll
            for (int ct = 0; ct < 8; ++ct) acc[ct] = (f32x4){0.f, 0.f, 0.f, 0.f};
            {
                v4u rr[16]; long bA[8], bB[8];
                UPM_LK(0, 0) UPM_LK(1, 0) UPM_LK(2, 0) UPM_LK(3, 0)
                UPM_W(0) UPM_LK(0, 1) UPM_R(bA); UPM_WAIT(bA); UPM_W(1) UPM_LK(1, 1)
#pragma unroll 1
                for (int ti = 0; ti < TPW; ++ti) {
                    const int s0 = 4 * ti;
                    UPM_STEP(bA, bB, 0, 2, ti + 1, 0)
                    UPM_STEP(bB, bA, 1, 3, ti + 1, 1)
                    UPM_STEP(bA, bB, 2, 0, ti + 2, 2)
                    UPM_STEP(bB, bA, 3, 1, ti + 2, 3)
                }
            }
            if (!commit) { if (acc[0].x != 123456.789f) continue; }
            {
                float hv[4][8];
#pragma unroll
                for (int i = 0; i < 4; ++i) { const int m = m0 + (4 * q + i) * NGW; const float* hp = H + (size_t)(m < M ? m : 0) * D + 128 * cq + r16;
#pragma unroll
                    for (int ct = 0; ct < 8; ++ct) hv[i][ct] = hp[16 * ct]; }
#pragma unroll
                for (int i = 0; i < 4; ++i) { const int m = m0 + (4 * q + i) * NGW; float* hp = H + (size_t)(m < M ? m : 0) * D + 128 * cq + r16;
#pragma unroll
                    for (int ct = 0; ct < 8; ++ct) { const float d = i == 0 ? acc[ct].x : (i == 1 ? acc[ct].y : (i == 2 ? acc[ct].z : acc[ct].w)); hv[i][ct] += d * isc[i]; ssq[i] += hv[i][ct] * hv[i][ct]; }
                    if (m < M) {
#pragma unroll
                        for (int ct = 0; ct < 8; ++ct) hp[16 * ct] = hv[i][ct]; } }
            }
        }
        if (!commit) continue;
#pragma unroll
        for (int i = 0; i < 4; ++i) { float s = ssq[i]; s += __shfl_xor(s, 1); s += __shfl_xor(s, 2); s += __shfl_xor(s, 4); s += __shfl_xor(s, 8); ssq[i] = s; }
        asm volatile("s_waitcnt vmcnt(0)" ::: "memory");
        const f32x4 gn0 = *(const f32x4*)(gnext + lane * 16), gn1 = *(const f32x4*)(gnext + lane * 16 + 4), gn2 = *(const f32x4*)(gnext + lane * 16 + 8), gn3 = *(const f32x4*)(gnext + lane * 16 + 12);
#pragma unroll
        for (int i = 0; i < 4; ++i)
#pragma unroll 1
            for (int qv = 0; qv < 4; ++qv) {
                const int ti = 4 * qv + i, m = m0 + ti * NGW; if (m >= M) continue;
                const float ss = __builtin_bit_cast(float, __builtin_amdgcn_readlane(__builtin_bit_cast(int, ssq[i]), qv * 16));
                const float rn = rsqrtf(ss * (1.f / D) + 1e-6f);
                f32x4* hp = (f32x4*)(H + (size_t)m * D + lane * 16);
                const f32x4 h0 = hp[0], h1 = hp[1], h2 = hp[2], h3 = hp[3];
                const f32x4 n0 = h0 * rn * gn0, n1 = h1 * rn * gn1, n2 = h2 * rn * gn2, n3 = h3 * rn * gn3;
                if (FUSE == 0) {
                    float am = fmaxf(fmaxf(fmaxf(fmaxf(fabsf(n0.x), fabsf(n0.y)), fmaxf(fabsf(n0.z), fabsf(n0.w))), fmaxf(fmaxf(fabsf(n1.x), fabsf(n1.y)), fmaxf(fabsf(n1.z), fabsf(n1.w)))),
                                     fmaxf(fmaxf(fmaxf(fabsf(n2.x), fabsf(n2.y)), fmaxf(fabsf(n2.z), fabsf(n2.w))), fmaxf(fmaxf(fabsf(n3.x), fabsf(n3.y)), fmaxf(fabsf(n3.z), fabsf(n3.w)))));
#pragma unroll
                    for (int o = 1; o < 64; o <<= 1) am = fmaxf(am, __shfl_xor(am, o));
                    am = fmaxf(am, 1e-30f);
                    const float qs = 384.f / am;
                    v4u u8; int w8;
                    w8 = __builtin_amdgcn_cvt_pk_fp8_f32(n0.x * qs, n0.y * qs, 0, false); w8 = __builtin_amdgcn_cvt_pk_fp8_f32(n0.z * qs, n0.w * qs, w8, true); u8.x = (unsigned)w8;
                    w8 = __builtin_amdgcn_cvt_pk_fp8_f32(n1.x * qs, n1.y * qs, 0, false); w8 = __builtin_amdgcn_cvt_pk_fp8_f32(n1.z * qs, n1.w * qs, w8, true); u8.y = (unsigned)w8;
                    w8 = __builtin_amdgcn_cvt_pk_fp8_f32(n2.x * qs, n2.y * qs, 0, false); w8 = __builtin_amdgcn_cvt_pk_fp8_f32(n2.z * qs, n2.w * qs, w8, true); u8.z = (unsigned)w8;
                    w8 = __builtin_amdgcn_cvt_pk_fp8_f32(n3.x * qs, n3.y * qs, 0, false); w8 = __builtin_amdgcn_cvt_pk_fp8_f32(n3.z * qs, n3.w * qs, w8, true); u8.w = (unsigned)w8;
                    *(v4u*)(ws + WS_U + (size_t)m * D + lane * 16) = u8;
                    if (lane == 0) ((float*)(ws + WS_U + U8IN_XS))[m] = am * (1.f / 384.f);
                } else { hp[0] = n0; hp[1] = n1; hp[2] = n2; hp[3] = n3; }
            }
    }
}

constexpr int PH_PER_HALF = 11, PH_PER_LAYER = 1 + 2 * PH_PER_HALF + 5, N_PHASES = 1 + DEPTH * PH_PER_LAYER;
__device__ __forceinline__ Ctx make_ctx() {
    extern __shared__ __attribute__((aligned(16))) unsigned char lds_raw[];
    Ctx c; int t = threadIdx.x; asm volatile("" : "+v"(t)); c.lds = (LAS unsigned char*)lds_raw; c.tid = t; c.lane = t & 63; c.wave = __builtin_amdgcn_readfirstlane(t >> 6); c.G = gridDim.x; c.bid = blockIdx.x; return c; }
__device__ __forceinline__ KArgs* kargs_fresh() { KArgs* p = (KArgs*)__builtin_amdgcn_kernarg_segment_ptr(); asm volatile("" : "+s"(p)); return p; }
#define PH_BEGIN(K) if (lo <= (K) && (K) < hi) { const Ctx c = make_ctx(); KArgs& args = *kargs_fresh(); unsigned char* ws = args.ws; (void)ws;
#define PH_END(K)   if ((K) + 1 < hi) xcd_barrier(bar); }

template <int L, int HB> __device__ __forceinline__ void half_pass(const XcdBarrier& bar, const int lo, const int hi) {
    constexpr int P0 = 1 + L * PH_PER_LAYER + 1 + HB * PH_PER_HALF;
#define WIN ((const bf16*)(ws + WS_WIN + L * WIN8_L))
#define KP 512
#define XSh ((const float*)(ws + WS_U + U8IN_XS) + (size_t)HB * MH)
#define WSC ((const float*)(ws + WS_CTL) + CW_WSC + L)
#define Uh ((const bf16*)(ws + WS_U) + (size_t)HB * MH * KP)
    PH_BEGIN(P0 + 0) {
        pg8::Gemm g{Uh, WIN, MH, N1P, KP, KP, 0}; pg8::StaticOrder S; S.init(MH, N1P, c.G, c.bid);
        pg8::EpiRow8<FStoreBf16S> E{{(bf16*)(ws + WS_OV + OV_PR), N1P, XSh, WSC}};
        pg8::gemm_phase(c.lds, g, S, E); if (PROBE_DUP == 5) pg8::gemm_phase(c.lds, g, S, E); } PH_END(P0 + 0)
    PH_BEGIN(P0 + 1) if (PROBE_DUP == 6) phase_rwkv_prep(c, args, L, HB); phase_rwkv_prep(c, args, L, HB); PH_END(P0 + 1)
    PH_BEGIN(P0 + 2) {
        constexpr int NL = L == 0 ? 3072 : 4096;
        pg8::Gemm g{(const bf16*)(ws + WS_OV + OV_AL), (const bf16*)(ws + WS_WLORA + L * WLORA_L), MH, NL, KL, KL, 1}; pg8::StaticOrder S; S.init(MH, NL, c.G, c.bid);
        EpiLora E{(bf16*)(ws + WS_OV + OV_ELOG), (bf16*)(ws + WS_OV + OV_ASIG), (bf16*)(ws + WS_OV + OV_GG), (bf16*)(ws + WS_OV + OV_VMIX),
                               (const bf16*)(ws + WS_VF) + (size_t)HB * MH * D, args.in[I_W0] + (size_t)L * D, args.in[I_A0] + (size_t)L * D, args.in[I_V0]};
        pg8::gemm_phase(c.lds, g, S, E); } PH_END(P0 + 2)
    PH_BEGIN(P0 + 3) phase_rwkv_chunk_par(c, args, L, HB); PH_END(P0 + 3)
    PH_BEGIN(P0 + 4) if (PROBE_DUP == 8) phase_rwkv_chunk_seq(c, args, false); phase_rwkv_chunk_seq(c, args); PH_END(P0 + 4)
    PH_BEGIN(P0 + 5) {
        phase_rwkv_post(c, args, L, HB); __syncthreads();
        pg8::Gemm g{Uh, WIN + (size_t)N1P * KP, MH, N2P, KP, KP, 0}; pg8::StaticOrder S; S.init(MH, N2P, c.G, c.bid);
        pg8::EpiRow8<FStoreBf16S> E{{(bf16*)(ws + WS_OV + OV_PS), N2P, XSh, WSC}};
        pg8::gemm_phase(c.lds, g, S, E); if (PROBE_DUP == 5) pg8::gemm_phase(c.lds, g, S, E); } PH_END(P0 + 5)
    PH_BEGIN(P0 + 6) if (PROBE_DUP == 6) phase_ssd_conv(c, args, L); phase_ssd_conv(c, args, L); PH_END(P0 + 6)
    PH_BEGIN(P0 + 7) phase_ssd_scan(c, args, L); PH_END(P0 + 7)
    PH_BEGIN(P0 + 8) phase_ssd_post(c, args, L); PH_END(P0 + 8)
    PH_BEGIN(P0 + 9) {
      { pg8::Gemm g{Uh, WIN + (size_t)(N1P + N2P) * KP, MH, D, KP, KP, 0}; pg8::StaticOrder S; S.init(MH, D, c.G, c.bid);
        pg8::EpiRow8<FSigmoidBf16S> E{{(bf16*)(ws + WS_OV + OV_GATES), 2048, XSh, WSC}};
        pg8::gemm_phase(c.lds, g, S, E); }
      { pg8::Gemm g{Uh, WIN + (size_t)(N1P + N2P + D) * KP, MH, D, KP, KP, 0}; pg8::StaticOrder S; S.init(MH, D, c.G, c.bid);
        pg8::EpiRow8<FSigmoidBf16S> E{{(bf16*)(ws + WS_OV + OV_GATES) + 1024, 2048, XSh, WSC}};
        pg8::gemm_phase(c.lds, g, S, E); }
      {
        pg8::Gemm g{(const bf16*)(ws + WS_OV + OV_YA), (const bf16*)(ws + WS_WA) + (size_t)L * D * D, MH, D, D, D, 0}; pg8::StaticOrder S; S.init(MH, D, c.G, c.bid);
        pg8::EpiRow8<FMixA> E{{(const bf16*)(ws + WS_OV + OV_GATES), (bf16*)(ws + WS_OV + OV_MIXED)}};
        pg8::gemm_phase(c.lds, g, S, E); }
      {
        pg8::Gemm g{(const bf16*)(ws + WS_OV + OV_PS) + 2048, (const bf16*)(ws + WS_WB) + (size_t)L * D * 2048, MH, D, 2048, N2P, 0}; pg8::StaticOrder S; S.init(MH, D, c.G, c.bid);
        pg8::EpiRow8<FMixB> E{{(const bf16*)(ws + WS_OV + OV_GATES), (bf16*)(ws + WS_OV + OV_MIXED)}};
        pg8::gemm_phase(c.lds, g, S, E); } } PH_END(P0 + 9)
    PH_BEGIN(P0 + 10) {
        pg8::Gemm g{(const bf16*)(ws + WS_OV + OV_MIXED), (const bf16*)(ws + WS_WO) + (size_t)L * D * D, MH, D, D, D, 0}; pg8::StaticOrder S; S.init(MH, D, c.G, c.bid);
        pg8::EpiRow8<FResid> E{{(L == 0 ? args.in[I_X] : (const float*)args.out) + (size_t)HB * MH * D, args.out + (size_t)HB * MH * D}};
        pg8::gemm_phase(c.lds, g, S, E); } PH_END(P0 + 10)
#undef WIN
#undef KP
#undef XSh
#undef WSC
#undef Uh
}

template <int L> __device__ __forceinline__ void layer_pass(const XcdBarrier& bar, const int lo, const int hi) {
    constexpr int P0 = 1 + L * PH_PER_LAYER, P1 = P0 + 1 + 2 * PH_PER_HALF;
    PH_BEGIN(P0) if (L == 0) phase_rmsnorm_q8(c, args.in[I_X], args.in[I_NMG], nullptr, ws + WS_U, (float*)(ws + WS_U + U8IN_XS)); PH_END(P0)
    half_pass<L, 0>(bar, lo, hi);
    half_pass<L, 1>(bar, lo, hi);
    PH_BEGIN(P1 + 0) phase_rmsnorm_q8(c, args.out, args.in[I_NFG] + (size_t)L * D, (bf16*)(ws + WS_U), ws + WS_OV + OV_U8, (float*)(ws + WS_OV + OV_XS)); phase_peer_convert(c, args, L); PH_END(P1 + 0)
    PH_BEGIN(P1 + 1) {
        pg8::Gemm g{(const bf16*)(ws + WS_U), (const bf16*)(ws + WS_WQK) + (size_t)L * 2048 * D, M, 2048, D, D, 0}; pg8::StaticOrder S; S.init(M, 2048, c.G, c.bid);
        pg8::EpiRow8<FStoreBf16> E{{(bf16*)(ws + WS_OV + OV_SC), 2048}};
        pg8::gemm_phase(c.lds, g, S, E); } PH_END(P1 + 1)
    PH_BEGIN(P1 + 2) if (PROBE_DUP == 4) phase_peer_topk(c, args); phase_peer_topk(c, args); PH_END(P1 + 2)
    PH_BEGIN(P1 + 3) phase_peer_down<0>(c, args, L, 0); if (PROBE_DOWN >= 0) phase_peer_down<PROBE_DOWN < 0 ? 0 : PROBE_DOWN>(c, args, L, 1); PH_END(P1 + 3)
    PH_BEGIN(P1 + 4) phase_peer_experts<L == DEPTH - 1 ? 1 : 0>(c, args, L == DEPTH - 1 ? args.in[I_NFIN] : args.in[I_NMG] + (size_t)(L + 1) * D); PH_END(P1 + 4)
}

__global__ void __launch_bounds__(512, 2) mk_fwd(Args kargs_) {
    extern __shared__ __attribute__((aligned(16))) unsigned char lds_raw[];
    LAS unsigned char* lds0 = (LAS unsigned char*)lds_raw;
    unsigned char* ws0 = kargs_.ws;
    const int lo = kargs_.lo, hi = kargs_.hi;
    if (threadIdx.x < 4) ((LAS unsigned*)(lds0 + LDS_MISC))[threadIdx.x] = 0u;
    __syncthreads();
    XcdBarrier bar; bar.bar = (unsigned*)(ws0 + WS_CTL) + CW_BAR; bar.x = 0; bar.st = (volatile LAS unsigned*)(lds0 + LDS_MISC);
    if (hi - lo > 1) bar = xcd_barrier_post((unsigned*)(ws0 + WS_CTL) + CW_BAR, (volatile LAS unsigned*)(lds0 + LDS_MISC));
    PH_BEGIN(0) phase_winmax(c, args); if (hi - lo > 1) xcd_barrier(bar); phase_prologue(c, args); PH_END(0)
    layer_pass<0>(bar, lo, hi);
    layer_pass<1>(bar, lo, hi);
}

extern "C" void kernel_launch(void* const* d_in, const int* in_sizes, int n_in, void* d_out, int out_size, void* d_ws, size_t ws_size, hipStream_t stream) {
    static int grid = 0;
    if (grid == 0) {
        if (n_in != 32 || out_size != M * D || ws_size < WS_END) { fprintf(stderr, "kernel_launch: unexpected problem (n_in %d, out %d, ws %zu < %zu)\n", n_in, out_size, ws_size, (size_t)WS_END); grid = -1; return; }
        int dev = 0, cus = 0, per_cu = 0;
        if (hipGetDevice(&dev) != hipSuccess || hipDeviceGetAttribute(&cus, hipDeviceAttributeMultiprocessorCount, dev) != hipSuccess) { grid = -1; return; }
        if (hipFuncSetAttribute((const void*)mk_fwd, hipFuncAttributeMaxDynamicSharedMemorySize, LDS_BYTES) != hipSuccess) { fprintf(stderr, "kernel_launch: hipFuncSetAttribute failed\n"); grid = -1; return; }
        if (hipOccupancyMaxActiveBlocksPerMultiprocessor(&per_cu, (const void*)mk_fwd, 512, LDS_BYTES) != hipSuccess || per_cu < 1) { fprintf(stderr, "kernel_launch: occupancy query says %d\n", per_cu); per_cu = 1; }
        (void)hipGetLastError();
        grid = cus;
    }
    if (grid < 0) return;
    (void)hipMemsetAsync((char*)d_ws + WS_CTL, 0, CTL_BYTES, stream);
    Args a{};
    for (int i = 0; i < 32; ++i) a.in[i] = (const float*)d_in[i];
    a.out = (float*)d_out; a.ws = (unsigned char*)d_ws;
#if MK_MULTI
    for (int p = 0; p < N_PHASES; ++p) { a.lo = p; a.hi = p + 1; hipLaunchKernelGGL(mk_fwd, dim3(grid), dim3(512), LDS_BYTES, stream, a); }
#else
    a.lo = 0; a.hi = N_PHASES;
    hipLaunchKernelGGL(mk_fwd, dim3(grid), dim3(512), LDS_BYTES, stream, a);
#endif
}
```

```cpp
#include <hip/hip_runtime.h>
#include <cstdio>
#include <cstdint>

#ifndef PROBE_DUP
#define PROBE_DUP 0
#endif
#ifndef MK_MULTI
#define MK_MULTI 0
#endif

#define GAS __attribute__((address_space(1)))
#define LAS __attribute__((address_space(3)))
typedef unsigned short bf16;
typedef unsigned v4u __attribute__((ext_vector_type(4)));
typedef unsigned v2u __attribute__((ext_vector_type(2)));
typedef float f32x4 __attribute__((ext_vector_type(4)));
typedef float f32x2 __attribute__((ext_vector_type(2)));
typedef short bf16x8 __attribute__((ext_vector_type(8)));
typedef __bf16 bf2_t __attribute__((ext_vector_type(2)));

constexpr int D = 1024, BATCH = 8, T = 4096, M = BATCH * T, MH = M / 2, DEPTH = 2;
constexpr int RW_PROJ = 3360, SSD_PROJ = 5152, IN_PROJ = 10560;
constexpr int N1P = 3584, N2P = 5120, N3P = 2048, NINP = N1P + N2P + N3P;
constexpr int DT_COL = RW_PROJ;
constexpr int KL = 384;
constexpr int NEXP = 16384;
#ifndef PROBE_DOWN
#define PROBE_DOWN -1
#endif
constexpr int PEER_SLICE_SHIFT = 11, PEER_NSLICE = NEXP >> PEER_SLICE_SHIFT;
constexpr int CW_WMAX = 12288, CW_WSC = 12304;
constexpr int CW_QUEUE = 8192;

constexpr size_t MiB = 1u << 20;
constexpr size_t WS_CTL = 0, CTL_BYTES = 1 * MiB;
constexpr size_t WS_WIN = 1 * MiB;
constexpr size_t WIN_L = (size_t)NINP * D * 2;
constexpr size_t WIN8_L = (size_t)NINP * D;
constexpr size_t U8IN_XS = 33 * MiB;
constexpr size_t WS_WA = 44 * MiB;
constexpr size_t WS_WB = 48 * MiB;
constexpr size_t WS_WO = 56 * MiB;
constexpr size_t WS_WQK = 60 * MiB;
constexpr size_t WS_WLORA = 68 * MiB;
constexpr size_t WLORA_L = (size_t)4096 * KL * 2;
constexpr size_t WS_U = 74 * MiB;
constexpr size_t WS_VF = 138 * MiB;
constexpr size_t WS_OV = 202 * MiB;
constexpr size_t OV_PR = 0, OV_ELOG = 112 * MiB, OV_ASIG = 144 * MiB, OV_GG = 176 * MiB, OV_VMIX = 208 * MiB, OV_AL = 240 * MiB, OV_YA = 272 * MiB;
constexpr size_t OV_PS = 0, OV_XBC = 168 * MiB, OV_DT = 305 * MiB, OV_DA = 307 * MiB;
constexpr size_t OV_GATES = 168 * MiB, OV_MIXED = 232 * MiB;
constexpr size_t OV_DOWN = 0, OV_UP = 32 * MiB, OV_PSCALE = 48 * MiB  , OV_SC = 64 * MiB, OV_IDX = 192 * MiB, OV_GATE = 208 * MiB, OV_POFF = 224 * MiB  , OV_ACT = 226 * MiB  , OV_U8 = 244 * MiB  , OV_XS = 276 * MiB  ;
constexpr size_t OV_BON = 304 * MiB;
constexpr size_t WS_END = WS_OV + 309 * MiB;
static_assert(WS_WIN + 2 * WIN_L <= WS_WA, "map");

constexpr int LDS_BYTES = 147456;
constexpr int LDS_MISC = 145408;
constexpr int CW_BAR = 4096;

__device__ __forceinline__ unsigned f2bf(float f) { unsigned u = __builtin_bit_cast(unsigned, f); return (u + 0x7fffu + ((u >> 16) & 1u)) >> 16; }
__device__ __forceinline__ unsigned pk2(float lo, float hi) { unsigned r; asm volatile("v_cvt_pk_bf16_f32 %0, %1, %2" : "=v"(r) : "v"(lo), "v"(hi)); return r; }
typedef __bf16 bf16x2_t __attribute__((ext_vector_type(2)));
__device__ __forceinline__ unsigned pk2c(float lo, float hi) { bf16x2_t v; v.x = (__bf16)lo; v.y = (__bf16)hi; return __builtin_bit_cast(unsigned, v); }
__device__ __forceinline__ float bflo(unsigned u) { return __builtin_bit_cast(float, u << 16); }
__device__ __forceinline__ float bfhi(unsigned u) { return __builtin_bit_cast(float, u & 0xffff0000u); }
__device__ __forceinline__ float bf1(bf16 u) { return __builtin_bit_cast(float, ((unsigned)u) << 16); }
__device__ __forceinline__ float sigmoidf_(float x) { return 1.f / (1.f + __expf(-x)); }
__device__ __forceinline__ float siluf_(float x) { return x / (1.f + __expf(-x)); }
template <int CTRL> __device__ __forceinline__ float dpp_mov(float x) { return __int_as_float(__builtin_amdgcn_update_dpp(0, __float_as_int(x), CTRL, 0xF, 0xF, true)); }
__device__ __forceinline__ float sum4(float x) { x += dpp_mov<0xB1>(x); x += dpp_mov<0x4E>(x); return x; }
__device__ __forceinline__ float sum16(float x) { x += dpp_mov<0xB1>(x); x += dpp_mov<0x4E>(x); x += dpp_mov<0x141>(x); x += dpp_mov<0x140>(x); return x; }
__device__ __forceinline__ float sum64(float x) { x = sum16(x); x += __shfl_xor(x, 16); x += __shfl_xor(x, 32); return x; }
__device__ __forceinline__ void unpack8(const v4u& q, float (&o)[8]) { o[0] = bflo(q.x); o[1] = bfhi(q.x); o[2] = bflo(q.y); o[3] = bfhi(q.y); o[4] = bflo(q.z); o[5] = bfhi(q.z); o[6] = bflo(q.w); o[7] = bfhi(q.w); }
__device__ __forceinline__ v4u pack8(const float (&o)[8]) { v4u q; q.x = pk2(o[0], o[1]); q.y = pk2(o[2], o[3]); q.z = pk2(o[4], o[5]); q.w = pk2(o[6], o[7]); return q; }

typedef short s16x4 __attribute__((ext_vector_type(4)));
__device__ __forceinline__ void lds_barrier() { asm volatile("s_waitcnt lgkmcnt(0)\n\ts_barrier" ::: "memory"); }
__device__ __forceinline__ bf16x8 tr_frag(unsigned base_bytes, int stride, int k0, int c0, int lane) {
    const int i16 = lane & 15, qq = i16 >> 2, p = i16 & 3, q = lane >> 4;
    const unsigned a0 = base_bytes + (unsigned)(((k0 + 8 * q + qq) * stride + c0 + 4 * p) * 2), a1 = a0 + (unsigned)(8 * stride);
    s16x4 lo, hi;
    asm volatile("ds_read_b64_tr_b16 %0, %2\n\tds_read_b64_tr_b16 %1, %3\n\ts_waitcnt lgkmcnt(0)" : "=&v"(lo), "=&v"(hi) : "v"(a0), "v"(a1) : "memory");
    return __builtin_shufflevector(lo, hi, 0, 1, 2, 3, 4, 5, 6, 7);
}

namespace pg8 {
typedef int i32x4_t __attribute__((ext_vector_type(4)));
constexpr int BM = 256, BK = 64, HALF = 128, HTB = HALF * BK * 2, STAGE_BYTES = 8 * HTB, NXCD = 8, WGM = 8;
__host__ __device__ __forceinline__ int lds_byte(int r, int c) { const int st = (r >> 4) * 2 + (c >> 5), rr = r & 15, cc = c & 31, ob = rr * 64 + cc * 2; return st * 1024 + (ob ^ (((ob >> 9) & 1) << 5)); }
__host__ __device__ __forceinline__ void stage_rc(int b, int& R, int& C) { const int st = b / 1024, sb = b % 1024, swz = sb ^ (((sb >> 9) & 1) << 5); R = (st >> 1) * 16 + swz / 64; C = (st & 1) * 32 + (swz % 64) / 2; }
__host__ __device__ __forceinline__ int perm32(int rho) { const int n = rho >> 4, i = rho & 15; return 8 * (i >> 2) + 4 * n + (i & 3); }
struct Unit { int pm, pn; };
struct Gemm { const bf16* A; const bf16* Bt; int M, N, K, lda; int kwin; };
__device__ __forceinline__ void unit_kwin(const Gemm& g, const Unit& u, int& k0t, int& ntl) { k0t = 0; ntl = g.K / BK; if (g.kwin) { const int blk = u.pn >> 2; if (blk < 2) { k0t = 0; ntl = 2; } else if (blk == 2) { k0t = 2; ntl = 4; } else { k0t = 4; ntl = 2; } } }
struct StaticOrder {
    int nM, nN, nwg, G, c;
    __device__ void init(int M_, int N_, int G_, int c_) { nM = M_ / BM; nN = N_ / BM; nwg = nM * nN; G = G_; c = c_; }
    __device__ bool next(int i, Unit& u) const {
        const long L = (long)i * G + c; if (L >= nwg) return false;
        int wgid = (int)L; { const int q = nwg / NXCD, r = nwg % NXCD, xcd = wgid % NXCD, off = wgid / NXCD; wgid = (xcd < r ? xcd * (q + 1) : r * (q + 1) + (xcd - r) * q) + off; }
        const int nig = WGM * nN, gid = wgid / nig, fm = gid * WGM, gsz = (nM - fm) < WGM ? (nM - fm) : WGM;
        u.pm = fm + ((wgid % nig) % gsz); u.pn = (wgid % nig) / gsz; return true;
    }
};
template <class F> struct EpiRow8 {
    static constexpr bool PERM = true;
    F f;
    __device__ __forceinline__ void operator()(const f32x4 (&acc)[2][2][4][2], const Unit& u, int wr, int wc, int fr, int fq) const {
        const int row0 = u.pm * BM + wr * 64 + fr, col0 = u.pn * BM + wc * 32 + 8 * fq;
#pragma unroll
        for (int g0 = 0; g0 < 16; g0 += F::GRP) {
            typename F::Tmp t[F::GRP];
#pragma unroll
            for (int j = 0; j < F::GRP; ++j) { const int i = g0 + j, ai = i >> 3, m = (i >> 1) & 3, bj = i & 1; f.load(row0 + ai * HALF + m * 16, col0 + bj * HALF, u.pn, t[j]); }
#pragma unroll
            for (int j = 0; j < F::GRP; ++j) { const int i = g0 + j, ai = i >> 3, m = (i >> 1) & 3, bj = i & 1; f.apply(row0 + ai * HALF + m * 16, col0 + bj * HALF, acc[ai][bj][m][0], acc[ai][bj][m][1], u.pn, t[j]); }
        }
    }
};


typedef int i32x8 __attribute__((ext_vector_type(8)));
template <class E> struct epi_f8 { static constexpr bool v = false; };
struct FragB16 { bf16x8 k[2]; };
template <bool F8> struct FragT { typedef FragB16 T; };
template <> struct FragT<true> { typedef i32x8 T; };
__device__ __forceinline__ void ld_frag(FragB16& d, const LAS unsigned char* p) { d.k[0] = *(const LAS bf16x8*)p; d.k[1] = *(const LAS bf16x8*)(p + 1024); }
__device__ __forceinline__ void ld_frag(i32x8& d, const LAS unsigned char* p) { const i32x4_t lo = *(const LAS i32x4_t*)p, hi = *(const LAS i32x4_t*)(p + 1024); d = __builtin_shufflevector(lo, hi, 0, 1, 2, 3, 4, 5, 6, 7); }
__device__ __forceinline__ void mma_frag(f32x4& acc, const FragB16& b, const FragB16& a) { acc = __builtin_amdgcn_mfma_f32_16x16x32_bf16(b.k[0], a.k[0], acc, 0, 0, 0); acc = __builtin_amdgcn_mfma_f32_16x16x32_bf16(b.k[1], a.k[1], acc, 0, 0, 0); }
__device__ __forceinline__ void lda_group(FragB16 (&At)[4], const LAS unsigned char* ab) {
#pragma unroll
    for (int m = 0; m < 4; ++m) ld_frag(At[m], ab + m * 2048); }
__device__ __forceinline__ void lda_group(i32x8 (&At)[4], const LAS unsigned char* ab) { ld_frag(At[0], ab); ld_frag(At[1], ab + 2048); }
__device__ __forceinline__ void lda_again(FragB16 (&)[4], const LAS unsigned char*) {}
__device__ __forceinline__ void lda_again(i32x8 (&At)[4], const LAS unsigned char* ab) { ld_frag(At[0], ab); ld_frag(At[1], ab + 2048); }
__device__ __forceinline__ void mma_frag(f32x4& acc, const i32x8& b, const i32x8& a);
__device__ __forceinline__ void mma_frag(f32x4& acc, const FragB16& b, const FragB16& a);
__device__ __forceinline__ void mma_group(f32x4 (&acc)[4][2], FragB16 (&At)[4], const FragB16 (&Bt)[2], const LAS unsigned char*) {
#pragma unroll
    for (int m = 0; m < 4; ++m)
#pragma unroll
        for (int n = 0; n < 2; ++n) mma_frag(acc[m][n], Bt[n], At[m]); }
__device__ __forceinline__ void mma_group(f32x4 (&acc)[4][2], i32x8 (&At)[4], const i32x8 (&Bt)[2], const LAS unsigned char* ab) {
    mma_frag(acc[0][0], Bt[0], At[0]); mma_frag(acc[0][1], Bt[1], At[0]);
    ld_frag(At[0], ab + 2 * 2048);
    mma_frag(acc[1][0], Bt[0], At[1]); mma_frag(acc[1][1], Bt[1], At[1]);
    ld_frag(At[1], ab + 3 * 2048);
    mma_frag(acc[2][0], Bt[0], At[0]); mma_frag(acc[2][1], Bt[1], At[0]);
    mma_frag(acc[3][0], Bt[0], At[1]); mma_frag(acc[3][1], Bt[1], At[1]); }
__device__ __forceinline__ void mma_frag(f32x4& acc, const i32x8& b, const i32x8& a) { acc = __builtin_amdgcn_mfma_scale_f32_16x16x128_f8f6f4(b, a, acc, 0, 0, 0, 0x7f7f7f7f, 0, 0x7f7f7f7f); }
template <class Epi>
__device__ __forceinline__ void gemm_phase(LAS unsigned char* lds, const Gemm g, const StaticOrder& S, const Epi& E) {
    const int tid = threadIdx.x, wid = __builtin_amdgcn_readfirstlane(tid >> 6), lane = tid & 63, wr = wid >> 2, wc = wid & 3, fr = lane & 15, fq = lane >> 4;
    const int K = g.K, lda = g.lda;
    unsigned voffA, voffB;
    { int R, C; stage_rc(tid * 16, R, C); const int Rb = Epi::PERM ? ((R & ~31) + perm32(R & 31)) : R;
      voffA = (unsigned)(R * lda + C) * 2u; voffB = (unsigned)(Rb * K + C) * 2u; }
    const size_t voffA_step = (size_t)64 * lda * 2, voffB_step = (size_t)64 * K * 2;
    const size_t kstep = (size_t)(BK * 2);
    const size_t hstepA = (size_t)HALF * lda * 2, hstepB = (size_t)HALF * K * 2;
    const size_t tstepA = 2 * hstepA, tstepB = 2 * hstepB;
    const unsigned ldsw = (unsigned)wid * 1024u;
    const int aoff = lds_byte(wr * 64 + fr, fq * 8), boff = lds_byte(wc * 32 + fr, fq * 8);
#define PG8_SA(b, h) (((b) * 2 + (h)) * HTB)
#define PG8_SB(b, h) ((4 + (b) * 2 + (h)) * HTB)
#define PG8_STAGE(bufoff, gbase, voff) do { _Pragma("unroll") for (int _i = 0; _i < 2; ++_i) \
        __builtin_amdgcn_global_load_lds((const unsigned*)((const char*)(gbase) + _i * voff##_step + (voff)), (LAS unsigned*)(lds + (bufoff) + ldsw + _i * 8192), 16, 0, 0); } while (0)
#define PG8_LDA(dst, b, h) lda_group(dst, lds + PG8_SA(b, h) + aoff)
#define PG8_LDB(dst, b, h) do { _Pragma("unroll") for (int n = 0; n < 2; ++n) ld_frag(dst[n], lds + PG8_SB(b, h) + boff + n * 2048); } while (0)
#define PG8_LDAR(dst, b, h) lda_again(dst, lds + PG8_SA(b, h) + aoff)
#define PG8_MMA(b, ai, bj, At, Bt) do { __builtin_amdgcn_s_setprio(1); mma_group(acc[ai][bj], At, Bt, lds + PG8_SA(b, ai) + aoff); __builtin_amdgcn_s_setprio(0); } while (0)
#define PG8_WAIT_V(n) asm volatile("s_waitcnt vmcnt(" #n ")" ::: "memory")
#define PG8_WAIT_L(n) asm volatile("s_waitcnt lgkmcnt(" #n ")" ::: "memory")
#define PG8_BAR __builtin_amdgcn_s_barrier()
#define PG8_SCHED __builtin_amdgcn_sched_barrier(0)
    Unit cur, nxt; int ui = 0;
    if (!S.next(0, cur)) return;
    f32x4 acc[2][2][4][2];
#pragma unroll
    for (int a = 0; a < 2; ++a)
#pragma unroll
        for (int b = 0; b < 2; ++b)
#pragma unroll
            for (int m = 0; m < 4; ++m)
#pragma unroll
                for (int n = 0; n < 2; ++n) acc[a][b][m][n] = (f32x4){0.f, 0.f, 0.f, 0.f};
    typename FragT<epi_f8<Epi>::v>::T At[4], B0[2], B1[2];
    int k0c, nt; unit_kwin(g, cur, k0c, nt);
    const char* cA = (const char*)g.A + (size_t)cur.pm * tstepA + (size_t)k0c * kstep; const char* cB = (const char*)g.Bt + (size_t)cur.pn * tstepB + (size_t)k0c * kstep;
    PG8_STAGE(PG8_SB(0, 0), cB, voffB); PG8_STAGE(PG8_SA(0, 0), cA, voffA); PG8_STAGE(PG8_SB(0, 1), cB + hstepB, voffB); PG8_STAGE(PG8_SA(0, 1), cA + hstepA, voffA);
    if (wr == 1) PG8_BAR;
    PG8_WAIT_V(4); PG8_BAR;
    PG8_STAGE(PG8_SB(1, 0), cB + kstep, voffB); PG8_STAGE(PG8_SA(1, 0), cA + kstep, voffA); PG8_STAGE(PG8_SB(1, 1), cB + hstepB + kstep, voffB);
    PG8_WAIT_V(6); PG8_BAR;
    for (;;) {
        const bool has_next = S.next(ui + 1, nxt);
        int k0n = 0, ntn = nt; if (has_next) unit_kwin(g, nxt, k0n, ntn);
        const char* nA = has_next ? (const char*)g.A + (size_t)nxt.pm * tstepA + (size_t)k0n * kstep : cA; const char* nB = has_next ? (const char*)g.Bt + (size_t)nxt.pn * tstepB + (size_t)k0n * kstep : cB;
        for (int t = 0; t < nt; t += 2) {
            const bool last = (t == nt - 2);
            const char* a1 = cA + (size_t)(t + 1) * kstep;
            const char* a2 = last ? nA : cA + (size_t)(t + 2) * kstep; const char* b2 = last ? nB : cB + (size_t)(t + 2) * kstep;
            const char* a3 = a2 + kstep; const char* b3 = b2 + kstep;
            PG8_LDB(B0, 0, 0); PG8_SCHED; PG8_LDA(At, 0, 0); PG8_STAGE(PG8_SA(1, 1), a1 + hstepA, voffA);
            PG8_WAIT_L(8); PG8_BAR; PG8_WAIT_L(0); PG8_MMA(0, 0, 0, At, B0); PG8_LDAR(At, 0, 0); PG8_BAR; PG8_SCHED;
            PG8_LDB(B1, 0, 1); PG8_STAGE(PG8_SB(0, 0), b2, voffB);
            PG8_BAR; PG8_WAIT_L(0); PG8_MMA(0, 0, 1, At, B1); PG8_BAR;
            PG8_LDA(At, 0, 1); PG8_STAGE(PG8_SA(0, 0), a2, voffA);
            PG8_BAR; PG8_WAIT_L(0); PG8_MMA(0, 1, 0, At, B0); PG8_LDAR(At, 0, 1); PG8_BAR; PG8_SCHED;
            PG8_STAGE(PG8_SB(0, 1), b2 + hstepB, voffB);
            PG8_WAIT_V(6); PG8_BAR; PG8_MMA(0, 1, 1, At, B1); PG8_BAR;
            PG8_LDB(B0, 1, 0); PG8_SCHED; PG8_LDA(At, 1, 0); PG8_STAGE(PG8_SA(0, 1), a2 + hstepA, voffA);
            PG8_WAIT_L(8); PG8_BAR; PG8_WAIT_L(0); PG8_MMA(1, 0, 0, At, B0); PG8_LDAR(At, 1, 0); PG8_BAR; PG8_SCHED;
            PG8_LDB(B1, 1, 1); PG8_STAGE(PG8_SB(1, 0), b3, voffB);
            PG8_BAR; PG8_WAIT_L(0); PG8_MMA(1, 0, 1, At, B1); PG8_BAR;
            PG8_LDA(At, 1, 1); PG8_STAGE(PG8_SA(1, 0), a3, voffA);
            PG8_BAR; PG8_WAIT_L(0); PG8_MMA(1, 1, 0, At, B0); PG8_LDAR(At, 1, 1); PG8_BAR; PG8_SCHED;
            PG8_STAGE(PG8_SB(1, 1), b3 + hstepB, voffB);
            PG8_WAIT_V(6); PG8_BAR; PG8_MMA(1, 1, 1, At, B1); PG8_BAR;
        }
        E(acc, cur, wr, wc, fr, fq);
        if (!has_next) break;
#pragma unroll
        for (int a = 0; a < 2; ++a)
#pragma unroll
            for (int b = 0; b < 2; ++b)
#pragma unroll
                for (int m = 0; m < 4; ++m)
#pragma unroll
                    for (int n = 0; n < 2; ++n) acc[a][b][m][n] = (f32x4){0.f, 0.f, 0.f, 0.f};
        cur = nxt; cA = nA; cB = nB; nt = ntn; ++ui;
    }
    PG8_WAIT_V(0);
    if (wr == 0) PG8_BAR;
    PG8_BAR;
#undef PG8_SA
#undef PG8_SB
#undef PG8_STAGE
#undef PG8_LDA
#undef PG8_LDB
#undef PG8_MMA
#undef PG8_WAIT_V
#undef PG8_WAIT_L
#undef PG8_BAR
#undef PG8_SCHED
}
}

#define XB_TMO      128
#define XB_XCNT(j)  (256  + 64 * (j))
#define XB_XSUB(j)  (1280 + 64 * (j))
#define XB_XGEN(j)  (2304 + 64 * (j))
#define XB_TOP      3328
#define XB_TOPGEN   3392
#define XCD_BAR_WORDS 3456
#define XB_SPIN_CAP (1u << 18)
__device__ __forceinline__ unsigned xb_ld(unsigned* p)              { return __hip_atomic_load(p, __ATOMIC_RELAXED, __HIP_MEMORY_SCOPE_AGENT); }
__device__ __forceinline__ unsigned xb_add(unsigned* p, unsigned v) { return __hip_atomic_fetch_add(p, v, __ATOMIC_RELAXED, __HIP_MEMORY_SCOPE_AGENT); }
__device__ __forceinline__ unsigned xb_xcc_id() { return (unsigned)__builtin_amdgcn_s_getreg((3 << 11) | 20) & 0xFu; }
#define XB_SPIN(cond, bar) do { unsigned _sp = 0; while (cond) { __builtin_amdgcn_s_sleep(1); \
    if ((++_sp & 255u) == 0u) { if (xb_ld(&(bar)[XB_TMO])) break; if (_sp > XB_SPIN_CAP) { atomicAdd(&(bar)[XB_TMO], 1u); break; } } } } while (0)
struct XcdBarrier { unsigned* bar; unsigned x; volatile LAS unsigned* st; };
__device__ __forceinline__ XcdBarrier xcd_barrier_post(unsigned* bar, volatile LAS unsigned* st) {
    XcdBarrier b; b.bar = bar; b.x = xb_xcc_id(); b.st = st;
    if (threadIdx.x == 0) (void)xb_add(&bar[XB_XCNT(b.x)], 1u);
    return b;
}
__device__ __forceinline__ void xcd_barrier_complete(unsigned* bar, unsigned x, unsigned& nloc, unsigned& nx) {
    const unsigned G = gridDim.x * gridDim.y * gridDim.z;
    unsigned sum, cnt, mine, sp = 0u;
    for (;;) {
        sum = 0u; cnt = 0u; mine = 0u;
#pragma unroll
        for (unsigned j = 0; j < 16; ++j) { const unsigned c = xb_ld(&bar[XB_XCNT(j)]); sum += c; cnt += (c > 0u) ? 1u : 0u; mine = (j == x) ? c : mine; }
        if (sum == G) break;
        __builtin_amdgcn_s_sleep(1);
        if ((++sp & 255u) == 0u) { if (xb_ld(&bar[XB_TMO])) break; if (sp > XB_SPIN_CAP) { atomicAdd(&bar[XB_TMO], 1u); break; } }
    }
    nloc = mine > 0u ? mine : 1u; nx = cnt > 0u ? cnt : 1u;
}
__device__ __forceinline__ void xcd_barrier(const XcdBarrier& b) {
    asm volatile("s_waitcnt vmcnt(0)" ::: "memory");
    __syncthreads();
    if (threadIdx.x == 0) {
        unsigned* bar = b.bar;
        __builtin_amdgcn_s_waitcnt(0);
        unsigned nloc = b.st[0], nx = b.st[1];
        if (nloc == 0u) { xcd_barrier_complete(bar, b.x, nloc, nx); b.st[0] = nloc; b.st[1] = nx; }
        const unsigned old = xb_add(&bar[XB_XSUB(b.x)], 1u);
        const unsigned gen = old / nloc;
        if (old + 1u == (gen + 1u) * nloc) {
            __builtin_amdgcn_fence(__ATOMIC_RELEASE, "agent");
            asm volatile("s_waitcnt vmcnt(0)" ::: "memory");
            const unsigned og = xb_add(&bar[XB_TOP], 1u);
            const unsigned tg = og / nx;
            if (og + 1u == (tg + 1u) * nx) xb_add(&bar[XB_TOPGEN], 1u);
            else XB_SPIN(xb_ld(&bar[XB_TOPGEN]) == tg, bar);
            __builtin_amdgcn_fence(__ATOMIC_ACQUIRE, "agent");
            xb_add(&bar[XB_XGEN(b.x)], 1u);
            asm volatile("s_waitcnt vmcnt(0)" ::: "memory");
        } else {
            XB_SPIN(xb_ld(&bar[XB_XGEN(b.x)]) == gen, bar);
            __builtin_amdgcn_fence(__ATOMIC_ACQUIRE, "agent");
            asm volatile("s_waitcnt vmcnt(0)" ::: "memory");
        }
    }
    __syncthreads();
}

struct Args { const float* in[32]; float* out; unsigned char* ws; int lo, hi; };
typedef const Args __attribute__((address_space(4))) KArgs;
enum { I_X = 0, I_NMG, I_WIN, I_MU, I_W0, I_W2, I_A0, I_A2, I_G2, I_V0, I_V1, I_V2, I_KK, I_KA, I_RK, I_LNW, I_LNB, I_WRB, I_CW, I_CB, I_DTB, I_ALOG, I_SD, I_SNG, I_WSB, I_WOUT, I_NFG, I_WQ, I_SK, I_PD, I_PU, I_NFIN };

struct NoTmp {};
struct FStoreBf16 { bf16* O; int ldc; typedef NoTmp Tmp; static constexpr int GRP = 16;
    __device__ __forceinline__ void load(int, int, int, Tmp&) const {}
    __device__ __forceinline__ void apply(int row, int col, f32x4 v0, f32x4 v1, int, const Tmp&) const {
        v4u w; w.x = pk2(v0[0], v0[1]); w.y = pk2(v0[2], v0[3]); w.z = pk2(v1[0], v1[1]); w.w = pk2(v1[2], v1[3]);
        *(v4u*)(O + (size_t)row * ldc + col) = w; } };
struct FSigmoidBf16 { bf16* O; int ldc; typedef NoTmp Tmp; static constexpr int GRP = 16;
    __device__ __forceinline__ void load(int, int, int, Tmp&) const {}
    __device__ __forceinline__ void apply(int row, int col, f32x4 v0, f32x4 v1, int, const Tmp&) const {
        v4u w; w.x = pk2(sigmoidf_(v0[0]), sigmoidf_(v0[1])); w.y = pk2(sigmoidf_(v0[2]), sigmoidf_(v0[3])); w.z = pk2(sigmoidf_(v1[0]), sigmoidf_(v1[1])); w.w = pk2(sigmoidf_(v1[2]), sigmoidf_(v1[3]));
        *(v4u*)(O + (size_t)row * ldc + col) = w; } };
struct FStoreBf16S { bf16* O; int ldc; const float* xs; const float* wsc; typedef float Tmp; static constexpr int GRP = 4;
    __device__ __forceinline__ void load(int row, int, int, Tmp& t) const { t = xs[row] * wsc[0]; }
    __device__ __forceinline__ void apply(int row, int col, f32x4 v0, f32x4 v1, int, const Tmp& t) const {
        v0 *= t; v1 *= t;
        v4u w; w.x = pk2c(v0[0], v0[1]); w.y = pk2c(v0[2], v0[3]); w.z = pk2c(v1[0], v1[1]); w.w = pk2c(v1[2], v1[3]);
        *(v4u*)(O + (size_t)row * ldc + col) = w; } };
struct FSigmoidBf16S { bf16* O; int ldc; const float* xs; const float* wsc; typedef float Tmp; static constexpr int GRP = 4;
    __device__ __forceinline__ void load(int row, int, int, Tmp& t) const { t = xs[row] * wsc[0]; }
    __device__ __forceinline__ void apply(int row, int col, f32x4 v0, f32x4 v1, int, const Tmp& t) const {
        v0 *= t; v1 *= t;
        v4u w; w.x = pk2c(sigmoidf_(v0[0]), sigmoidf_(v0[1])); w.y = pk2c(sigmoidf_(v0[2]), sigmoidf_(v0[3])); w.z = pk2c(sigmoidf_(v1[0]), sigmoidf_(v1[1])); w.w = pk2c(sigmoidf_(v1[2]), sigmoidf_(v1[3]));
        *(v4u*)(O + (size_t)row * ldc + col) = w; } };
namespace pg8 { template <> struct epi_f8<EpiRow8<FStoreBf16S>> { static constexpr bool v = true; }; template <> struct epi_f8<EpiRow8<FSigmoidBf16S>> { static constexpr bool v = true; }; }
struct EpiLora {
    static constexpr bool PERM = true;
    bf16 *elog, *asig, *gg, *vmix; const bf16* vf; const float *w0, *a0, *v0;
    template <int BLK> __device__ __forceinline__ void run(const f32x4 (&acc)[2][2][4][2], int row0, int col0) const {
#pragma unroll
        for (int bj = 0; bj < 2; ++bj) {
            const int c = (col0 + bj * 128) & 1023;
            float bias[8];
            if (BLK == 0 || BLK == 1 || BLK == 3) { const float* bp = (BLK == 0 ? w0 : (BLK == 1 ? a0 : v0)) + c; const f32x4 b0 = *(const f32x4*)bp, b1 = *(const f32x4*)(bp + 4);
                bias[0] = b0[0]; bias[1] = b0[1]; bias[2] = b0[2]; bias[3] = b0[3]; bias[4] = b1[0]; bias[5] = b1[1]; bias[6] = b1[2]; bias[7] = b1[3]; }
#pragma unroll
            for (int ai = 0; ai < 2; ++ai) {
            v4u qvs[4], qvf[4];
            if (BLK == 3) {
#pragma unroll
                for (int i = 0; i < 4; ++i) { const size_t o = (size_t)(row0 + ai * 128 + i * 16) * D + c; qvs[i] = *(const v4u*)(vmix + o); qvf[i] = *(const v4u*)(vf + o); }
            }
#pragma unroll
                for (int m = 0; m < 4; ++m) {
                    const int row = row0 + ai * 128 + m * 16; const size_t o = (size_t)row * D + c;
                    const f32x4 v0_ = acc[ai][bj][m][0], v1_ = acc[ai][bj][m][1];
                    float a[8] = {v0_[0], v0_[1], v0_[2], v0_[3], v1_[0], v1_[1], v1_[2], v1_[3]};
                    if (BLK == 0) {
#pragma unroll
                        for (int e = 0; e < 8; ++e) a[e] = -0.6065306597f * sigmoidf_(bias[e] + a[e]);
                        *(v4u*)(elog + o) = pack8(a);
                    } else if (BLK == 1) {
#pragma unroll
                        for (int e = 0; e < 8; ++e) a[e] = sigmoidf_(bias[e] + a[e]);
                        *(v4u*)(asig + o) = pack8(a);
                    } else if (BLK == 2) {
                        *(v4u*)(gg + o) = pack8(a);
                    } else {
                        float vs[8], vfv[8]; unpack8(qvs[m], vs); unpack8(qvf[m], vfv);
#pragma unroll
                        for (int e = 0; e < 8; ++e) a[e] = vs[e] + (vfv[e] - vs[e]) * sigmoidf_(bias[e] + a[e]);
                        *(v4u*)(vmix + o) = pack8(a);
                    }
                }
            }
        }
    }
    __device__ __forceinline__ void operator()(const f32x4 (&acc)[2][2][4][2], const pg8::Unit& u, int wr, int wc, int fr, int fq) const {
        const int row0 = u.pm * 256 + wr * 64 + fr, col0 = u.pn * 256 + wc * 32 + 8 * fq;
        const int blk = u.pn >> 2;
        if (blk == 0) run<0>(acc, row0, col0); else if (blk == 1) run<1>(acc, row0, col0); else if (blk == 2) run<2>(acc, row0, col0); else run<3>(acc, row0, col0);
    }
};
struct FMixA { const bf16* gates; bf16* mixed;
    struct Tmp { v4u g; }; static constexpr int GRP = 8;
    __device__ __forceinline__ void load(int row, int col, int, Tmp& t) const { t.g = *(const v4u*)(gates + (size_t)row * 2048 + col); }
    __device__ __forceinline__ void apply(int row, int col, f32x4 v0, f32x4 v1, int, const Tmp& t) const {
        float g[8]; unpack8(t.g, g);
        float a[8] = {v0[0] * g[0], v0[1] * g[1], v0[2] * g[2], v0[3] * g[3], v1[0] * g[4], v1[1] * g[5], v1[2] * g[6], v1[3] * g[7]};
        *(v4u*)(mixed + (size_t)row * D + col) = pack8(a); } };
struct FMixB { const bf16* gates; bf16* mixed;
    struct Tmp { v4u g, mx; }; static constexpr int GRP = 8;
    __device__ __forceinline__ void load(int row, int col, int, Tmp& t) const { t.g = *(const v4u*)(gates + (size_t)row * 2048 + 1024 + col); t.mx = *(const v4u*)(mixed + (size_t)row * D + col); }
    __device__ __forceinline__ void apply(int row, int col, f32x4 v0, f32x4 v1, int, const Tmp& t) const {
        float g[8], mx[8]; unpack8(t.g, g); unpack8(t.mx, mx);
        float a[8] = {mx[0] + v0[0] * g[0], mx[1] + v0[1] * g[1], mx[2] + v0[2] * g[2], mx[3] + v0[3] * g[3], mx[4] + v1[0] * g[4], mx[5] + v1[1] * g[5], mx[6] + v1[2] * g[6], mx[7] + v1[3] * g[7]};
        *(v4u*)(mixed + (size_t)row * D + col) = pack8(a); } };
struct FResid { const float* base; float* h;
    struct Tmp { f32x4 a, b; }; static constexpr int GRP = 8;
    __device__ __forceinline__ void load(int row, int col, int, Tmp& t) const { const f32x4* s = (const f32x4*)(base + (size_t)row * D + col); t.a = s[0]; t.b = s[1]; }
    __device__ __forceinline__ void apply(int row, int col, f32x4 v0, f32x4 v1, int, const Tmp& t) const {
        f32x4* p = (f32x4*)(h + (size_t)row * D + col); p[0] = t.a + v0; p[1] = t.b + v1; } };

struct Ctx { int tid, lane, wave, G, bid; LAS unsigned char* lds; };

__device__ __forceinline__ void transpose_item(const float* W, int K, int N, bf16* WT, int row_off, LAS float* scr, int item, int lane) {
    const int nblk = N / 32, kb = item / nblk, nb = item % nblk, k0 = 64 * kb, n0 = 32 * nb;
#pragma unroll 8
    for (int i = 0; i < 32; ++i) { const int kk = 2 * i + (lane >> 5); scr[kk * 33 + (lane & 31)] = W[(size_t)(k0 + kk) * N + n0 + (lane & 31)]; }
    asm volatile("s_waitcnt lgkmcnt(0)" ::: "memory");
    const int c = lane & 7;
#pragma unroll
    for (int j = 0; j < 4; ++j) { const int n = (lane >> 3) + 8 * j; const LAS float* s = scr + (8 * c) * 33 + n;
        v4u o; o.x = pk2(s[0 * 33], s[1 * 33]); o.y = pk2(s[2 * 33], s[3 * 33]); o.z = pk2(s[4 * 33], s[5 * 33]); o.w = pk2(s[6 * 33], s[7 * 33]);
        *(v4u*)(WT + (size_t)(row_off + n0 + n) * K + k0 + 8 * c) = o; }
    asm volatile("s_waitcnt lgkmcnt(0)" ::: "memory");
}
__device__ __forceinline__ void transpose_item8(const float* W, int K, int N, unsigned char* WT, int row_off, LAS float* scr, int item, int lane, float qs) {
    const int nblk = N / 32, kb = item / nblk, nb = item % nblk, k0 = 64 * kb, n0 = 32 * nb;
#pragma unroll 8
    for (int i = 0; i < 32; ++i) { const int kk = 2 * i + (lane >> 5); scr[kk * 33 + (lane & 31)] = W[(size_t)(k0 + kk) * N + n0 + (lane & 31)]; }
    asm volatile("s_waitcnt lgkmcnt(0)" ::: "memory");
    const int c = lane & 7;
#pragma unroll
    for (int j = 0; j < 4; ++j) { const int n = (lane >> 3) + 8 * j; const LAS float* s = scr + (8 * c) * 33 + n;
        int w0 = __builtin_amdgcn_cvt_pk_fp8_f32(s[0 * 33] * qs, s[1 * 33] * qs, 0, false); w0 = __builtin_amdgcn_cvt_pk_fp8_f32(s[2 * 33] * qs, s[3 * 33] * qs, w0, true);
        int w1 = __builtin_amdgcn_cvt_pk_fp8_f32(s[4 * 33] * qs, s[5 * 33] * qs, 0, false); w1 = __builtin_amdgcn_cvt_pk_fp8_f32(s[6 * 33] * qs, s[7 * 33] * qs, w1, true);
        v2u o; o.x = (unsigned)w0; o.y = (unsigned)w1;
        *(v2u*)(WT + (size_t)(row_off + n0 + n) * K + k0 + 8 * c) = o; }
    asm volatile("s_waitcnt lgkmcnt(0)" ::: "memory");
}
__device__ __forceinline__ void phase_winmax(const Ctx& c, KArgs& a) {
    unsigned* CT = (unsigned*)(a.ws + WS_CTL);
#pragma unroll 1
    for (int l = 0; l < 2; ++l) {
        const f32x4* W = (const f32x4*)(a.in[I_WIN] + (size_t)l * D * IN_PROJ);
        float am = 0.f;
        for (int i = c.bid * 512 + c.tid; i < D * IN_PROJ / 4; i += c.G * 512) { const f32x4 v = W[i]; am = fmaxf(am, fmaxf(fmaxf(fabsf(v.x), fabsf(v.y)), fmaxf(fabsf(v.z), fabsf(v.w)))); }
#pragma unroll
        for (int o = 1; o < 64; o <<= 1) am = fmaxf(am, __shfl_xor(am, o));
        if (c.lane == 0) __hip_atomic_fetch_max(CT + CW_WMAX + l, __builtin_bit_cast(unsigned, am), __ATOMIC_RELAXED, __HIP_MEMORY_SCOPE_AGENT);
    }
}
__device__ __forceinline__ int winrow(int n) {
    if (n < RW_PROJ) return n;
    if (n < RW_PROJ + 5120) return N1P + (n - RW_PROJ);
    if (n < RW_PROJ + SSD_PROJ) return DT_COL + (n - RW_PROJ - 5120);
    return N1P + N2P + (n - RW_PROJ - SSD_PROJ); }

__device__ __forceinline__ void phase_prologue(const Ctx& c, KArgs& a) {
    unsigned char* ws = a.ws;
    LAS float* scr = (LAS float*)(c.lds + c.wave * 16384);
    const int gw = c.bid * 8 + c.wave, NGW = c.G * 8;
    constexpr int I_IN = 16 * (IN_PROJ / 32), I_A = 16 * 32, I_B = 32 * 32, I_O = 16 * 32, I_L = I_IN + I_A + I_B + I_O;
    for (int it = gw; it < 2 * I_L; it += NGW) {
        const int l = it / I_L; int r = it % I_L;
        if (r < I_IN) { const int nb = r % (IN_PROJ / 32); const float am = fmaxf(__builtin_bit_cast(float, __hip_atomic_load((const unsigned*)(ws + WS_CTL) + CW_WMAX + l, __ATOMIC_RELAXED, __HIP_MEMORY_SCOPE_AGENT)), 1e-30f);
            transpose_item8(a.in[I_WIN] + (size_t)l * D * IN_PROJ, D, IN_PROJ, ws + WS_WIN + l * WIN8_L, winrow(nb * 32) - nb * 32, scr, r, c.lane, 384.f / am); continue; } r -= I_IN;
        if (r < I_A) { transpose_item(a.in[I_WRB] + (size_t)l * D * D, D, D, (bf16*)(ws + WS_WA) + (size_t)l * D * D, 0, scr, r, c.lane); continue; } r -= I_A;
        if (r < I_B) { transpose_item(a.in[I_WSB] + (size_t)l * 2048 * D, 2048, D, (bf16*)(ws + WS_WB) + (size_t)l * D * 2048, 0, scr, r, c.lane); continue; } r -= I_B;
        transpose_item(a.in[I_WOUT] + (size_t)l * D * D, D, D, (bf16*)(ws + WS_WO) + (size_t)l * D * D, 0, scr, r, c.lane);
    }
    for (int it = c.bid * 512 + c.tid; it < 2 * 192 * 64; it += c.G * 512) {
        const int l = it / (192 * 64), r = (it / 64) % 192, q = it % 64;
        *(v4u*)(ws + WS_WIN + l * WIN8_L + (size_t)(DT_COL + 32 + r) * D + q * 16) = (v4u){0u, 0u, 0u, 0u};
    }
    if (c.bid == 0 && c.tid < 2) ((float*)(ws + WS_CTL))[CW_WSC + c.tid] = fmaxf(__builtin_bit_cast(float, __hip_atomic_load((const unsigned*)(ws + WS_CTL) + CW_WMAX + c.tid, __ATOMIC_RELAXED, __HIP_MEMORY_SCOPE_AGENT)), 1e-30f) * (1.f / 384.f);
    for (int it = c.bid * 512 + c.tid; it < 2 * 4096 * KL; it += c.G * 512) {
        const int l = it / (4096 * KL), n = (it / KL) % 4096, k = it % KL; const int blk = n >> 10, cc = n & 1023;
        float v = 0.f;
        if (blk == 0) { if (k < 64) v = a.in[I_W2][((size_t)l * 64 + k) * D + cc]; }
        else if (blk == 1) { if (k >= 64 && k < 128) v = a.in[I_A2][((size_t)l * 64 + (k - 64)) * D + cc]; }
        else if (blk == 2) { if (k >= 128 && k < 288) v = a.in[I_G2][((size_t)l * 160 + (k - 128)) * D + cc]; }
        else { if (l == 1 && k >= 288 && k < 320) v = a.in[I_V2][(size_t)(k - 288) * D + cc]; }
        ((bf16*)(ws + WS_WLORA + l * WLORA_L))[(size_t)n * KL + k] = (bf16)f2bf(v);
    }
    __syncthreads();
    LAS float* wqL = (LAS float*)c.lds;
    LAS float* kyL = (LAS float*)(c.lds + 32768);
    for (int it = c.bid; it < 2 * 16 * 16; it += c.G) {
        const int l = it >> 8, hc = (it >> 4) & 15, k0 = (it & 15) * 64;
        const float* wq = a.in[I_WQ] + (size_t)l * D * 2048; const float* ky = a.in[I_SK] + ((size_t)l * 16 + hc) * 128 * 128;
        for (int e = c.tid; e < 64 * 128; e += 512) wqL[e] = wq[(size_t)(k0 + (e >> 7)) * 2048 + hc * 128 + (e & 127)];
        for (int e = c.tid; e < 128 * 128; e += 512) kyL[(e >> 7) * 129 + (e & 127)] = ky[e];
        __syncthreads();
        const int key = c.tid & 127, kg = c.tid >> 7;
        float acc[16];
#pragma unroll
        for (int i = 0; i < 16; ++i) acc[i] = 0.f;
        for (int d = 0; d < 128; ++d) { const float kv = kyL[key * 129 + d];
#pragma unroll
            for (int i = 0; i < 16; ++i) acc[i] += wqL[(kg * 16 + i) * 128 + d] * kv; }
        bf16* o = (bf16*)(ws + WS_WQK) + ((size_t)l * 2048 + hc * 128 + key) * D + k0 + kg * 16;
        v4u q0, q1; q0.x = pk2(acc[0], acc[1]); q0.y = pk2(acc[2], acc[3]); q0.z = pk2(acc[4], acc[5]); q0.w = pk2(acc[6], acc[7]);
        q1.x = pk2(acc[8], acc[9]); q1.y = pk2(acc[10], acc[11]); q1.z = pk2(acc[12], acc[13]); q1.w = pk2(acc[14], acc[15]);
        *(v4u*)o = q0; *(v4u*)(o + 8) = q1;
        __syncthreads();
    }
}

__device__ __forceinline__ void phase_rmsnorm(const Ctx& c, const float* src, const float* g, bf16* U, float* copy_to) {
    const int gw = c.bid * 8 + c.wave, NGW = c.G * 8;
    f32x4 gv[4];
#pragma unroll
    for (int j = 0; j < 4; ++j) gv[j] = *((const f32x4*)g + c.lane + 64 * j);
    f32x4 nv[4];
    if (gw < M) { const f32x4* xr0 = (const f32x4*)(src + (size_t)gw * D) + c.lane;
#pragma unroll
        for (int j = 0; j < 4; ++j) nv[j] = xr0[64 * j]; }
    for (int m = gw; m < M; m += NGW) {
        f32x4 v[4]; float s = 0.f;
#pragma unroll
        for (int j = 0; j < 4; ++j) { v[j] = nv[j]; s += (v[j].x * v[j].x + v[j].y * v[j].y) + (v[j].z * v[j].z + v[j].w * v[j].w); }
        if (m + NGW < M) { const f32x4* xn = (const f32x4*)(src + (size_t)(m + NGW) * D) + c.lane;
#pragma unroll
            for (int j = 0; j < 4; ++j) nv[j] = xn[64 * j]; }
        if (copy_to) { f32x4* cr = (f32x4*)(copy_to + (size_t)m * D) + c.lane;
#pragma unroll
            for (int j = 0; j < 4; ++j) cr[64 * j] = v[j]; }
        const float r = rsqrtf(sum64(s) * (1.f / D) + 1e-6f);
        v2u* o = (v2u*)(U + (size_t)m * D) + c.lane;
#pragma unroll
        for (int j = 0; j < 4; ++j) { v2u w; w.x = pk2(v[j].x * r * gv[j].x, v[j].y * r * gv[j].y); w.y = pk2(v[j].z * r * gv[j].z, v[j].w * r * gv[j].w); o[64 * j] = w; }
    }
}
__device__ __forceinline__ void phase_rmsnorm_q8(const Ctx& c, const float* src, const float* g, bf16* U, unsigned char* U8, float* XS) {
    const int gw = c.bid * 8 + c.wave, NGW = c.G * 8;
    f32x4 gv[4];
#pragma unroll
    for (int j = 0; j < 4; ++j) gv[j] = *((const f32x4*)g + c.lane + 64 * j);
    f32x4 nv[4];
    if (gw < M) { const f32x4* xr0 = (const f32x4*)(src + (size_t)gw * D) + c.lane;
#pragma unroll
        for (int j = 0; j < 4; ++j) nv[j] = xr0[64 * j]; }
    for (int m = gw; m < M; m += NGW) {
        f32x4 v[4]; float s = 0.f;
#pragma unroll
        for (int j = 0; j < 4; ++j) { v[j] = nv[j]; s += (v[j].x * v[j].x + v[j].y * v[j].y) + (v[j].z * v[j].z + v[j].w * v[j].w); }
        if (m + NGW < M) { const f32x4* xn = (const f32x4*)(src + (size_t)(m + NGW) * D) + c.lane;
#pragma unroll
            for (int j = 0; j < 4; ++j) nv[j] = xn[64 * j]; }
        const float r = rsqrtf(sum64(s) * (1.f / D) + 1e-6f);
        float am = 0.f;
#pragma unroll
        for (int j = 0; j < 4; ++j) { v[j] = v[j] * r * gv[j]; am = fmaxf(am, fmaxf(fmaxf(fabsf(v[j].x), fabsf(v[j].y)), fmaxf(fabsf(v[j].z), fabsf(v[j].w)))); }
#pragma unroll
        for (int o = 1; o < 64; o <<= 1) am = fmaxf(am, __shfl_xor(am, o));
        am = fmaxf(am, 1e-30f);
        const float qs = 384.f / am;
        v2u* o = (v2u*)(U + (size_t)m * D) + c.lane;
        unsigned* o8 = (unsigned*)(U8 + (size_t)m * D) + c.lane;
#pragma unroll
        for (int j = 0; j < 4; ++j) { if (U) { v2u w; w.x = pk2(v[j].x, v[j].y); w.y = pk2(v[j].z, v[j].w); o[64 * j] = w; }
            int w8 = __builtin_amdgcn_cvt_pk_fp8_f32(v[j].x * qs, v[j].y * qs, 0, false); w8 = __builtin_amdgcn_cvt_pk_fp8_f32(v[j].z * qs, v[j].w * qs, w8, true); o8[64 * j] = (unsigned)w8; }
        if (c.lane == 0) XS[m] = am * (1.f / 384.f);
    }
}
__device__ __forceinline__ void phase_final(const Ctx& c, float* out, const float* g) {
    const int gw = c.bid * 8 + c.wave, NGW = c.G * 8;
    f32x4 gv[4];
#pragma unroll
    for (int j = 0; j < 4; ++j) gv[j] = *((const f32x4*)g + c.lane + 64 * j);
    for (int m = gw; m < M; m += NGW) {
        f32x4* xr = (f32x4*)(out + (size_t)m * D) + c.lane;
        f32x4 v[4]; float s = 0.f;
#pragma unroll
        for (int j = 0; j < 4; ++j) { v[j] = xr[64 * j]; s += (v[j].x * v[j].x + v[j].y * v[j].y) + (v[j].z * v[j].z + v[j].w * v[j].w); }
        const float r = rsqrtf(sum64(s) * (1.f / D) + 1e-6f);
#pragma unroll
        for (int j = 0; j < 4; ++j) xr[64 * j] = v[j] * r * gv[j];
    }
}

__device__ __forceinline__ void phase_rwkv_prep(const Ctx& c, KArgs& a, int l, int hb) {
    unsigned char* ws = a.ws;
    const bf16* PR = (const bf16*)(ws + WS_OV + OV_PR);
    bf16* AL = (bf16*)(ws + WS_OV + OV_AL);
    bf16* VS = l == 0 ? (bf16*)(ws + WS_VF) + (size_t)hb * MH * D : (bf16*)(ws + WS_OV + OV_VMIX);
    const float* mu = a.in[I_MU] + (size_t)l * RW_PROJ;
    LAS bf16* v1L = (LAS bf16*)c.lds;
    if (l == 1) {
        const float* v1 = a.in[I_V1];
        for (int e = c.tid; e < 1024 * 32; e += 512) { const int cc = e >> 5, j = e & 31; v1L[((cc & 15) * 64 + (cc >> 4)) * 40 + j] = (bf16)f2bf(v1[e]); }
        __syncthreads();
    }
    const int gw = c.bid * 8 + c.wave, NGW = c.G * 8, lane = c.lane;
    float muv[16], mul[8];
#pragma unroll
    for (int e = 0; e < 16; ++e) muv[e] = mu[2048 + 16 * lane + e];
#pragma unroll
    for (int e = 0; e < 8; ++e) mul[e] = lane < 36 ? mu[3072 + 8 * lane + e] : 0.f;
    const int per = (MH + NGW - 1) / NGW;
    const int mA = gw * per, mB = (mA + per < MH) ? mA + per : MH;
    v4u cq0, cq1, cql, pq0, pq1, pql;
    const v4u zz4 = (v4u){0u, 0u, 0u, 0u};
    const int lcol = lane < 36 ? 3072 + 8 * lane : 3072;
    if (mA < mB) {
        const bf16* row = PR + (size_t)mA * N1P;
        cq0 = *(const v4u*)(row + 2048 + 16 * lane); cq1 = *(const v4u*)(row + 2048 + 16 * lane + 8); cql = *(const v4u*)(row + lcol);
        if ((mA & (T - 1)) != 0) { pq0 = *(const v4u*)(row - N1P + 2048 + 16 * lane); pq1 = *(const v4u*)(row - N1P + 2048 + 16 * lane + 8); pql = *(const v4u*)(row - N1P + lcol); }
        else { pq0 = zz4; pq1 = zz4; pql = zz4; }
    }
    for (int m = mA; m < mB; ++m) {
        const v4u q0 = cq0, q1 = cq1, ql = cql;
        v4u r0 = pq0, r1 = pq1, rl = pql;
        if ((m & (T - 1)) == 0) { r0 = zz4; r1 = zz4; rl = zz4; }
        if (m + 1 < mB) { const bf16* nrow = PR + (size_t)(m + 1) * N1P; cq0 = *(const v4u*)(nrow + 2048 + 16 * lane); cq1 = *(const v4u*)(nrow + 2048 + 16 * lane + 8); cql = *(const v4u*)(nrow + lcol); }
        pq0 = q0; pq1 = q1; pql = ql;
        float vs[16];
        {
            float p[16], pp[16];
            float t8[8];
            unpack8(q0, t8);
#pragma unroll
            for (int e = 0; e < 8; ++e) p[e] = t8[e];
            unpack8(q1, t8);
#pragma unroll
            for (int e = 0; e < 8; ++e) p[8 + e] = t8[e];
            unpack8(r0, t8);
#pragma unroll
            for (int e = 0; e < 8; ++e) pp[e] = t8[e];
            unpack8(r1, t8);
#pragma unroll
            for (int e = 0; e < 8; ++e) pp[8 + e] = t8[e];
#pragma unroll
            for (int e = 0; e < 16; ++e) vs[e] = p[e] + (pp[e] - p[e]) * muv[e];
            v4u o0, o1;
            o0.x = pk2(vs[0], vs[1]); o0.y = pk2(vs[2], vs[3]); o0.z = pk2(vs[4], vs[5]); o0.w = pk2(vs[6], vs[7]);
            o1.x = pk2(vs[8], vs[9]); o1.y = pk2(vs[10], vs[11]); o1.z = pk2(vs[12], vs[13]); o1.w = pk2(vs[14], vs[15]);
            *(v4u*)(VS + (size_t)m * D + 16 * lane) = o0; *(v4u*)(VS + (size_t)m * D + 16 * lane + 8) = o1;
        }
        if (lane < 36) {
            float p[8], pp[8], s[8];
            unpack8(ql, p);
            unpack8(rl, pp);
#pragma unroll
            for (int e = 0; e < 8; ++e) { const float x = p[e] + (pp[e] - p[e]) * mul[e]; s[e] = lane < 8 ? tanhf(x) : (lane < 16 ? x : sigmoidf_(x)); }
            *(v4u*)(AL + (size_t)m * KL + 8 * lane) = pack8(s);
        } else if (lane < 48 && !(l == 1 && lane < 40)) {
            *(v4u*)(AL + (size_t)m * KL + 8 * lane) = (v4u){0u, 0u, 0u, 0u};
        }
        if (l == 1) {
            float acc[32];
#pragma unroll
            for (int j = 0; j < 32; ++j) acc[j] = 0.f;
#pragma unroll
            for (int i = 0; i < 16; ++i) {
                const LAS v4u* wp = (const LAS v4u*)(v1L + (i * 64 + lane) * 40);
#pragma unroll
                for (int q = 0; q < 4; ++q) { float w8[8]; const v4u wq_ = wp[q]; unpack8(wq_, w8);
#pragma unroll
                    for (int e = 0; e < 8; ++e) acc[q * 8 + e] += vs[i] * w8[e]; }
            }
#pragma unroll
            for (int s = 32, half = 16; s >= 2; s >>= 1, half >>= 1) {
                const bool up = (lane & s) != 0;
#pragma unroll
                for (int i = 0; i < 16; ++i) if (i < half) { const float send = up ? acc[i] : acc[i + half]; const float keep = up ? acc[i + half] : acc[i]; acc[i] = keep + __shfl_xor(send, s); }
            }
            acc[0] += __shfl_xor(acc[0], 1);
            const int j = ((lane & 32) ? 16 : 0) + ((lane & 16) ? 8 : 0) + ((lane & 8) ? 4 : 0) + ((lane & 4) ? 2 : 0) + ((lane & 2) ? 1 : 0);
            if ((lane & 1) == 0) AL[(size_t)m * KL + 288 + j] = (bf16)f2bf(acc[0]);
        }
    }
    { float* DT = (float*)(ws + WS_OV + OV_DT); float* DA = (float*)(ws + WS_OV + OV_DA);
      for (int it = gw; it < (MH / 64) * 32; it += NGW) {
        const int ck = it >> 5, h = it & 31;
        const size_t m = (size_t)ck * 64 + lane;
        const float x = bf1(PR[m * N1P + DT_COL + h]) + a.in[I_DTB][l * 32 + h];
        const float dt = x > 20.f ? x : log1pf(__expf(x));
        float cs = -dt * __expf(a.in[I_ALOG][l * 32 + h]);
#pragma unroll
        for (int o = 1; o < 64; o <<= 1) { const float y = __shfl_up(cs, o); cs += (lane >= o) ? y : 0.f; }
        DT[m * 32 + h] = dt; DA[m * 32 + h] = cs;
      } }
}

__device__ __forceinline__ float sum8(float x) { x += dpp_mov<0xB1>(x); x += dpp_mov<0x4E>(x); x += dpp_mov<0x141>(x); return x; }
__device__ __forceinline__ void phase_rwkv_rec(const Ctx& c, KArgs& a, int l, int hb) {
    unsigned char* ws = a.ws;
    const bf16* PR = (const bf16*)(ws + WS_OV + OV_PR);
    const bf16* ELOG = (const bf16*)(ws + WS_OV + OV_ELOG);
    const bf16* ASIG = (const bf16*)(ws + WS_OV + OV_ASIG);
    const bf16* VS = l == 0 ? (const bf16*)(ws + WS_VF) + (size_t)hb * MH * D : (const bf16*)(ws + WS_OV + OV_VMIX);
    bf16* Y = (bf16*)(ws + WS_OV + OV_YA);
    const float* mu = a.in[I_MU] + (size_t)l * RW_PROJ;
    const float* k_k = a.in[I_KK] + (size_t)l * D; const float* k_a = a.in[I_KA] + (size_t)l * D;
    constexpr int CH = 32, NCH = T / CH;
    constexpr int ARRF = CH * 64;
    constexpr int BUFF = 5 * ARRF + CH * 16 + CH * 2;
    LAS float* ldsf = (LAS float*)c.lds;
    LAS float* yt = ldsf + 2 * BUFF;
    const int tid = c.tid, lane = c.lane;
    const bool is_prep = c.wave >= 4;
    const int ptid = tid - 256, tt = ptid >> 3, l8 = ptid & 7, pc = l8 * 8;
    const int rrow = c.wave * 4 + (lane >> 4), cc4 = (lane & 15) * 4;
    for (int unit = c.bid; unit < 256; unit += c.G) {
        const int b = unit >> 6, h = (unit >> 2) & 15, rq = unit & 3;
        const size_t m0 = (size_t)b * T;
        const int hc = h * 64 + pc;
        float mur[8], muk[8], kkc[8], kac[8];
        if (is_prep) {
#pragma unroll
            for (int e = 0; e < 8; ++e) { mur[e] = mu[hc + e]; muk[e] = mu[1024 + hc + e]; kkc[e] = k_k[hc + e]; kac[e] = k_a[hc + e]; }
        }
        float S[4] = {0.f, 0.f, 0.f, 0.f}, sa = 0.f;
#define RW_PREP(chunk, bufp) do { \
            const int t_ = (chunk) * CH + tt; const size_t mm = m0 + t_; const bf16* row = PR + mm * N1P + hc; \
            const v4u zr = (v4u){0u, 0u, 0u, 0u}; \
            const v4u qr = *(const v4u*)row, qk = *(const v4u*)(row + 1024); \
            const v4u qrp = t_ > 0 ? *(const v4u*)(row - N1P) : zr, qkp = t_ > 0 ? *(const v4u*)(row - N1P + 1024) : zr; \
            const v4u qkn = t_ + 1 < T ? *(const v4u*)(row + N1P + 1024) : zr; \
            const v4u qas = *(const v4u*)(ASIG + mm * D + hc), qel = *(const v4u*)(ELOG + mm * D + hc); \
            v4u qv = zr; if (l8 < 2) qv = *(const v4u*)(VS + mm * D + h * 64 + rq * 16 + l8 * 8); \
            float r_[8], rp_[8], k_[8], kp_[8], kn_[8], as_[8], el_[8]; \
            unpack8(qr, r_); unpack8(qrp, rp_); unpack8(qk, k_); unpack8(qkp, kp_); unpack8(qkn, kn_); unpack8(qas, as_); unpack8(qel, el_); \
            float ks_[8], kk_[8], kkn_[8], s1 = 0.f, s2 = 0.f; \
            _Pragma("unroll") for (int e = 0; e < 8; ++e) { ks_[e] = k_[e] + (kp_[e] - k_[e]) * muk[e]; const float kn1 = kn_[e] + (k_[e] - kn_[e]) * muk[e]; \
                kk_[e] = ks_[e] * kkc[e]; kkn_[e] = kn1 * kkc[e]; s1 += kk_[e] * kk_[e]; s2 += kkn_[e] * kkn_[e]; } \
            s1 = sum8(s1); s2 = sum8(s2); \
            const float i1 = rsqrtf(s1 + 1e-12f), i2 = (t_ + 1 < T) ? rsqrtf(s2 + 1e-12f) : 0.f; \
            float ow[8], ok[8], ob[8], orr[8], owa[8], c1 = 0.f, c2 = 0.f; \
            _Pragma("unroll") for (int e = 0; e < 8; ++e) { const float kn = kk_[e] * i1, an = -kkn_[e] * i2; \
                ow[e] = __expf(el_[e]); ok[e] = ks_[e] * (1.f + (as_[e] - 1.f) * kac[e]); ob[e] = kn * as_[e]; orr[e] = r_[e] + (rp_[e] - r_[e]) * mur[e]; \
                owa[e] = ow[e] * an; c1 += ob[e] * an; c2 += ok[e] * an; } \
            c1 = sum8(c1); c2 = sum8(c2); \
            LAS float* bp_ = (bufp) + tt * 64 + pc; \
            *(LAS f32x4*)(bp_) = (f32x4){ow[0], ow[1], ow[2], ow[3]}; *(LAS f32x4*)(bp_ + 4) = (f32x4){ow[4], ow[5], ow[6], ow[7]}; \
            *(LAS f32x4*)(bp_ + ARRF) = (f32x4){ok[0], ok[1], ok[2], ok[3]}; *(LAS f32x4*)(bp_ + ARRF + 4) = (f32x4){ok[4], ok[5], ok[6], ok[7]}; \
            *(LAS f32x4*)(bp_ + 2 * ARRF) = (f32x4){ob[0], ob[1], ob[2], ob[3]}; *(LAS f32x4*)(bp_ + 2 * ARRF + 4) = (f32x4){ob[4], ob[5], ob[6], ob[7]}; \
            *(LAS f32x4*)(bp_ + 3 * ARRF) = (f32x4){orr[0], orr[1], orr[2], orr[3]}; *(LAS f32x4*)(bp_ + 3 * ARRF + 4) = (f32x4){orr[4], orr[5], orr[6], orr[7]}; \
            *(LAS f32x4*)(bp_ + 4 * ARRF) = (f32x4){owa[0], owa[1], owa[2], owa[3]}; *(LAS f32x4*)(bp_ + 4 * ARRF + 4) = (f32x4){owa[4], owa[5], owa[6], owa[7]}; \
            if (l8 < 2) { float v_[8]; unpack8(qv, v_); LAS float* vp_ = (bufp) + 5 * ARRF + tt * 16 + l8 * 8; \
                *(LAS f32x4*)vp_ = (f32x4){v_[0], v_[1], v_[2], v_[3]}; *(LAS f32x4*)(vp_ + 4) = (f32x4){v_[4], v_[5], v_[6], v_[7]}; } \
            if (l8 == 0) { (bufp)[5 * ARRF + CH * 16 + tt * 2] = c1; (bufp)[5 * ARRF + CH * 16 + tt * 2 + 1] = c2; } } while (0)
#define RW_YSTORE(chunk) do { const LAS float* yp_ = yt + ((chunk) & 1) * CH * 16 + tt * 16 + l8 * 2; \
            *(unsigned*)(Y + (m0 + (size_t)(chunk) * CH + tt) * D + h * 64 + rq * 16 + l8 * 2) = pk2(yp_[0], yp_[1]); } while (0)
        if (is_prep) RW_PREP(0, ldsf);
        __syncthreads();
        for (int ch = 0; ch < NCH; ++ch) {
            if (is_prep) {
                if (ch + 1 < NCH) RW_PREP(ch + 1, ldsf + ((ch + 1) & 1) * BUFF);
                if (ch > 0) RW_YSTORE(ch - 1);
            } else {
                const LAS float* buf = ldsf + (ch & 1) * BUFF;
                LAS float* yw = yt + (ch & 1) * CH * 16;
                const int lane15 = lane & 15;
                f32x4 w4 = *(const LAS f32x4*)(buf + cc4), k4 = *(const LAS f32x4*)(buf + ARRF + cc4), b4 = *(const LAS f32x4*)(buf + 2 * ARRF + cc4);
                f32x4 r4 = *(const LAS f32x4*)(buf + 3 * ARRF + cc4), wa4 = *(const LAS f32x4*)(buf + 4 * ARRF + cc4);
                float v = buf[5 * ARRF + rrow]; f32x2 cc = *(const LAS f32x2*)(buf + 5 * ARRF + CH * 16);
#pragma unroll 1
                for (int t16 = 0; t16 < CH; t16 += 16) {
                    float ysave = 0.f;
#pragma unroll
                    for (int u = 0; u < 16; ++u) {
                        const int tn = (t16 + u + 1 < CH) ? t16 + u + 1 : t16 + u;
                        const f32x4 nw4 = *(const LAS f32x4*)(buf + tn * 64 + cc4), nk4 = *(const LAS f32x4*)(buf + ARRF + tn * 64 + cc4), nb4 = *(const LAS f32x4*)(buf + 2 * ARRF + tn * 64 + cc4);
                        const f32x4 nr4 = *(const LAS f32x4*)(buf + 3 * ARRF + tn * 64 + cc4), nwa4 = *(const LAS f32x4*)(buf + 4 * ARRF + tn * 64 + cc4);
                        const float nv = buf[5 * ARRF + tn * 16 + rrow]; const f32x2 ncc = *(const LAS f32x2*)(buf + 5 * ARRF + CH * 16 + tn * 2);
                        float d = S[0] * wa4[0]; d = __builtin_fmaf(S[1], wa4[1], d); d = __builtin_fmaf(S[2], wa4[2], d); d = __builtin_fmaf(S[3], wa4[3], d);
#pragma unroll
                        for (int e = 0; e < 4; ++e) { float tmp = S[e] * w4[e]; asm volatile("" : "+v"(tmp)); tmp = __builtin_fmaf(v, k4[e], tmp); S[e] = __builtin_fmaf(sa, b4[e], tmp); asm volatile("" : "+v"(S[e])); }
                        const float sa_next = __builtin_fmaf(v, cc.y, sa * cc.x);
                        float y = S[0] * r4[0]; y = __builtin_fmaf(S[1], r4[1], y); y = __builtin_fmaf(S[2], r4[2], y); y = __builtin_fmaf(S[3], r4[3], y);
                        d = sum16(d); y = sum16(y);
                        sa = d + sa_next;
                        ysave = (lane15 == u) ? y : ysave;
                        w4 = nw4; k4 = nk4; b4 = nb4; r4 = nr4; wa4 = nwa4; v = nv; cc = ncc;
                    }
                    yw[(t16 + lane15) * 16 + rrow] = ysave;
                }
            }
            __syncthreads();
        }
        if (is_prep) RW_YSTORE(NCH - 1);
        __syncthreads();
#undef RW_PREP
#undef RW_YSTORE
    }
}

constexpr int CK_TS = 72, CK_TB = 64 * CK_TS;
__device__ __forceinline__ void tr_a2(unsigned a, bf16x8& f0, bf16x8& f1) {
    s16x4 l0, h0, l1, h1;
    asm volatile("ds_read_b64_tr_b16 %0, %4\n\tds_read_b64_tr_b16 %1, %4 offset:576\n\tds_read_b64_tr_b16 %2, %4 offset:4608\n\tds_read_b64_tr_b16 %3, %4 offset:5184\n\ts_waitcnt lgkmcnt(0)"
                 : "=&v"(l0), "=&v"(h0), "=&v"(l1), "=&v"(h1) : "v"(a) : "memory");
    f0 = __builtin_shufflevector(l0, h0, 0, 1, 2, 3, 4, 5, 6, 7); f1 = __builtin_shufflevector(l1, h1, 0, 1, 2, 3, 4, 5, 6, 7);
}
__device__ __forceinline__ void tr_b4(unsigned a, bf16x8& f00, bf16x8& f01, bf16x8& f10, bf16x8& f11) {
    s16x4 l0, h0, l1, h1, l2, h2, l3, h3;
    asm volatile("ds_read_b64_tr_b16 %0, %8\n\tds_read_b64_tr_b16 %1, %8 offset:576\n\tds_read_b64_tr_b16 %2, %8 offset:4608\n\tds_read_b64_tr_b16 %3, %8 offset:5184\n\t"
                 "ds_read_b64_tr_b16 %4, %8 offset:32\n\tds_read_b64_tr_b16 %5, %8 offset:608\n\tds_read_b64_tr_b16 %6, %8 offset:4640\n\tds_read_b64_tr_b16 %7, %8 offset:5216\n\ts_waitcnt lgkmcnt(0)"
                 : "=&v"(l0), "=&v"(h0), "=&v"(l1), "=&v"(h1), "=&v"(l2), "=&v"(h2), "=&v"(l3), "=&v"(h3) : "v"(a) : "memory");
    f00 = __builtin_shufflevector(l0, h0, 0, 1, 2, 3, 4, 5, 6, 7); f01 = __builtin_shufflevector(l1, h1, 0, 1, 2, 3, 4, 5, 6, 7);
    f10 = __builtin_shufflevector(l2, h2, 0, 1, 2, 3, 4, 5, 6, 7); f11 = __builtin_shufflevector(l3, h3, 0, 1, 2, 3, 4, 5, 6, 7);
}
template <int PA, int QA, int MASK, int NINIT, int NPAIR, int POST>
__device__ __forceinline__ void mm64(LAS bf16* X, const LAS bf16* P, const LAS bf16* Q, const LAS bf16* P2, const LAS bf16* Q2, const LAS bf16* E1, const LAS bf16* E2,
                                     const LAS float* cscale, const LAS float* wc, int w, int lane) {
    const int r = lane & 15, q = lane >> 4, Ct = w >> 1, Rt0 = 2 * (w & 1);
    const int i16 = lane & 15, qq = i16 >> 2, p4 = i16 & 3;
    const int troff = ((8 * q + qq) * CK_TS + 4 * p4) * 2;
    f32x4 acc[2];
#pragma unroll
    for (int i = 0; i < 2; ++i) {
        const int R = 16 * (Rt0 + i) + r;
        if (NINIT == 0) acc[i] = (f32x4){0.f, 0.f, 0.f, 0.f};
        else { const v2u e1 = *(const LAS v2u*)(E1 + R * CK_TS + 16 * Ct + 4 * q); acc[i] = (f32x4){bflo(e1.x), bfhi(e1.x), bflo(e1.y), bfhi(e1.y)};
            if (NINIT == 2) { const v2u e2 = *(const LAS v2u*)(E2 + R * CK_TS + 16 * Ct + 4 * q); acc[i] += (f32x4){bflo(e2.x), bfhi(e2.x), bflo(e2.y), bfhi(e2.y)}; } }
    }
#pragma unroll
    for (int pr = 0; pr < NPAIR; ++pr) {
        const LAS bf16* Pp = pr == 0 ? P : P2; const LAS bf16* Qp = pr == 0 ? Q : Q2;
        bf16x8 af[2], bfr[2][2];
        if (PA == 0) {
#pragma unroll
            for (int i = 0; i < 2; ++i)
#pragma unroll
                for (int ks = 0; ks < 2; ++ks) bfr[i][ks] = *(const LAS bf16x8*)(Pp + (16 * (Rt0 + i) + r) * CK_TS + 32 * ks + 8 * q);
        }
        if (QA == 1) {
#pragma unroll
            for (int ks = 0; ks < 2; ++ks) af[ks] = *(const LAS bf16x8*)(Qp + (16 * Ct + r) * CK_TS + 32 * ks + 8 * q);
        } else tr_a2((unsigned)(size_t)Qp + (unsigned)(troff + 32 * Ct), af[0], af[1]);
        if (PA == 1) tr_b4((unsigned)(size_t)Pp + (unsigned)(troff + 32 * Rt0), bfr[0][0], bfr[0][1], bfr[1][0], bfr[1][1]);
#pragma unroll
        for (int ks = 0; ks < 2; ++ks)
#pragma unroll
            for (int i = 0; i < 2; ++i) acc[i] = __builtin_amdgcn_mfma_f32_16x16x32_bf16(af[ks], bfr[i][ks], acc[i], 0, 0, 0);
    }
#pragma unroll
    for (int i = 0; i < 2; ++i) {
        const int R = 16 * (Rt0 + i) + r;
        float v[4];
#pragma unroll
        for (int e = 0; e < 4; ++e) { const int C = 16 * Ct + 4 * q + e; float x = acc[i][e];
            if (MASK == 1) x = (C < R) ? x : 0.f;
            if (MASK == 2) x = (C <= R) ? x : 0.f;
            if (POST >= 1) x *= cscale[C];
            if (POST == 2) x += (C == R) ? wc[C] : 0.f;
            v[e] = x; }
        v2u o; o.x = pk2c(v[0], v[1]); o.y = pk2c(v[2], v[3]);
        *(LAS v2u*)(X + R * CK_TS + 16 * Ct + 4 * q) = o;
    }
}

template <int PA, int QA, int MASK, int NINIT, int NPAIR, int POST>
__device__ __forceinline__ void mm64h(LAS bf16* X, const LAS bf16* P, const LAS bf16* Q, const LAS bf16* P2, const LAS bf16* Q2, const LAS bf16* E1, const LAS bf16* E2,
                                      const LAS float* cscale, const LAS float* wc, int ws, int lane) {
    const int r = lane & 15, q = lane >> 4, Cb = ws >> 1, Rb = ws & 1;
    const int i16 = lane & 15, qq = i16 >> 2, p4 = i16 & 3;
    const int troff = ((8 * q + qq) * CK_TS + 4 * p4) * 2;
    f32x4 acc[2][2];
#pragma unroll
    for (int ci = 0; ci < 2; ++ci)
#pragma unroll
        for (int ri = 0; ri < 2; ++ri) {
            const int R = 16 * (2 * Rb + ri) + r, C0 = 16 * (2 * Cb + ci) + 4 * q;
            if (NINIT == 0) acc[ci][ri] = (f32x4){0.f, 0.f, 0.f, 0.f};
            else { const v2u e1 = *(const LAS v2u*)(E1 + R * CK_TS + C0); acc[ci][ri] = (f32x4){bflo(e1.x), bfhi(e1.x), bflo(e1.y), bfhi(e1.y)};
                if (NINIT == 2) { const v2u e2 = *(const LAS v2u*)(E2 + R * CK_TS + C0); acc[ci][ri] += (f32x4){bflo(e2.x), bfhi(e2.x), bflo(e2.y), bfhi(e2.y)}; } }
        }
#pragma unroll
    for (int pr = 0; pr < NPAIR; ++pr) {
        const LAS bf16* Pp = pr == 0 ? P : P2; const LAS bf16* Qp = pr == 0 ? Q : Q2;
        bf16x8 af[2][2], bfr[2][2];
        if (PA == 0) {
#pragma unroll
            for (int ri = 0; ri < 2; ++ri)
#pragma unroll
                for (int ks = 0; ks < 2; ++ks) bfr[ri][ks] = *(const LAS bf16x8*)(Pp + (16 * (2 * Rb + ri) + r) * CK_TS + 32 * ks + 8 * q);
        }
        if (QA == 1) {
#pragma unroll
            for (int ci = 0; ci < 2; ++ci)
#pragma unroll
                for (int ks = 0; ks < 2; ++ks) af[ci][ks] = *(const LAS bf16x8*)(Qp + (16 * (2 * Cb + ci) + r) * CK_TS + 32 * ks + 8 * q);
        } else tr_b4((unsigned)(size_t)Qp + (unsigned)(troff + 64 * Cb), af[0][0], af[0][1], af[1][0], af[1][1]);
        if (PA == 1) tr_b4((unsigned)(size_t)Pp + (unsigned)(troff + 64 * Rb), bfr[0][0], bfr[0][1], bfr[1][0], bfr[1][1]);
#pragma unroll
        for (int ks = 0; ks < 2; ++ks)
#pragma unroll
            for (int ci = 0; ci < 2; ++ci)
#pragma unroll
                for (int ri = 0; ri < 2; ++ri) acc[ci][ri] = __builtin_amdgcn_mfma_f32_16x16x32_bf16(af[ci][ks], bfr[ri][ks], acc[ci][ri], 0, 0, 0);
    }
#pragma unroll
    for (int ci = 0; ci < 2; ++ci)
#pragma unroll
        for (int ri = 0; ri < 2; ++ri) {
            const int R = 16 * (2 * Rb + ri) + r;
            float v[4];
#pragma unroll
            for (int e = 0; e < 4; ++e) { const int C = 16 * (2 * Cb + ci) + 4 * q + e; float x = acc[ci][ri][e];
                if (MASK == 1) x = (C < R) ? x : 0.f;
                if (MASK == 2) x = (C <= R) ? x : 0.f;
                if (POST >= 1) x *= cscale[C];
                if (POST == 2) x += (C == R) ? wc[C] : 0.f;
                v[e] = x; }
            v2u o; o.x = pk2c(v[0], v[1]); o.y = pk2c(v[2], v[3]);
            *(LAS v2u*)(X + R * CK_TS + 16 * (2 * Cb + ci) + 4 * q) = o;
        }
}

__device__ __forceinline__ void phase_rwkv_chunk_par(const Ctx& c, KArgs& a, int l, int hb) {
    unsigned char* ws = a.ws;
    bf16* PR = (bf16*)(ws + WS_OV + OV_PR);
    bf16* ELOG = (bf16*)(ws + WS_OV + OV_ELOG);
    const bf16* ASIG = (const bf16*)(ws + WS_OV + OV_ASIG);
    const bf16* VS = l == 0 ? (const bf16*)(ws + WS_VF) + (size_t)hb * MH * D : (const bf16*)(ws + WS_OV + OV_VMIX);
    bf16* Y = (bf16*)(ws + WS_OV + OV_YA);
    bf16* SLB = (bf16*)(ws + WS_OV + OV_AL);
    const float* mu = a.in[I_MU] + (size_t)l * RW_PROJ;
    const float* k_k = a.in[I_KK] + (size_t)l * D; const float* k_a = a.in[I_KA] + (size_t)l * D; const float* rk_ = a.in[I_RK] + (size_t)l * D;
    float* BON = (float*)(ws + WS_OV + OV_BON);
    LAS bf16* tile = (LAS bf16*)c.lds;
    enum { tA = 0, tR, tBt, tKt, tBh, tKh, tV, tNab, tNak, tNrb, tNrk, tM0, tM1, tP1, tX1, NT };
#define TL(i) (tile + (i) * CK_TB)
    LAS float* cscale = (LAS float*)(tile + NT * CK_TB);
    LAS float* wcv = cscale + 64;
    LAS float* SCR = (LAS float*)TL(tM0);
    LAS float* SEGT = SCR + 64 * 64;
    const int tid = c.tid, lane = c.lane, w = c.wave;
    const int tt = tid >> 3, l8 = tid & 7, pc = l8 * 8;
    v4u qr, qk, qrp, qkp, qas, qel, qv;
#define CK_LOAD(un) do { const int b_ = (un) >> 10, h_ = ((un) >> 6) & 15, ch_ = (un) & 63; const int t_ = ch_ * 64 + tt; \
        const size_t mm = (size_t)b_ * T + (size_t)t_; const bf16* row = PR + mm * N1P + h_ * 64 + pc; const v4u zr = (v4u){0u, 0u, 0u, 0u}; \
        qr = *(const v4u*)row; qk = *(const v4u*)(row + 1024); qrp = t_ > 0 ? *(const v4u*)(row - N1P) : zr; qkp = t_ > 0 ? *(const v4u*)(row - N1P + 1024) : zr; \
        qas = *(const v4u*)(ASIG + mm * D + h_ * 64 + pc); qel = *(const v4u*)(ELOG + mm * D + h_ * 64 + pc); qv = *(const v4u*)(VS + mm * D + h_ * 64 + pc); } while (0)
    if (c.bid < 4096) CK_LOAD(c.bid);
    for (int unit = c.bid; unit < 4096; unit += c.G) {
        const int b = unit >> 10, h = (unit >> 6) & 15, ch = unit & 63;
        const size_t m0 = (size_t)b * T + (size_t)ch * 64;
        const int hc = h * 64 + pc;
        for (int rep = 0; rep < (PROBE_DUP == 7 ? 2 : 1); ++rep) {
        if (PROBE_DUP == 7) { CK_LOAD(unit); }
        float r_[8], k_[8], as_[8], el_[8], v_[8], kk_[8], ks_[8];
        {
            float rp_[8], kp_[8];
            unpack8(qr, r_); unpack8(qrp, rp_); unpack8(qk, k_); unpack8(qkp, kp_); unpack8(qas, as_); unpack8(qel, el_); unpack8(qv, v_);
            if (PROBE_DUP != 7 && unit + c.G < 4096) CK_LOAD(unit + c.G);
            float s1 = 0.f;
#pragma unroll
            for (int e = 0; e < 8; ++e) { r_[e] = r_[e] + (rp_[e] - r_[e]) * mu[hc + e]; ks_[e] = k_[e] + (kp_[e] - k_[e]) * mu[1024 + hc + e]; kk_[e] = ks_[e] * k_k[hc + e]; s1 += kk_[e] * kk_[e]; }
            s1 = sum8(s1);
            const float i1 = rsqrtf(s1 + 1e-12f);
#pragma unroll
            for (int e = 0; e < 8; ++e) { kk_[e] *= i1; k_[e] = ks_[e] * (1.f + (as_[e] - 1.f) * k_a[hc + e]); }
            { float bn = 0.f;
#pragma unroll
              for (int e = 0; e < 8; ++e) bn += r_[e] * k_[e] * rk_[hc + e];
              bn = sum8(bn);
              if (l8 == 0) BON[(m0 + tt) * 16 + h] = bn; }
            *(LAS f32x4*)(SCR + tt * 64 + pc) = (f32x4){el_[0], el_[1], el_[2], el_[3]}; *(LAS f32x4*)(SCR + tt * 64 + pc + 4) = (f32x4){el_[4], el_[5], el_[6], el_[7]};
        }
        lds_barrier();
        {
            const int col = tid & 63, seg = tid >> 6; float s = 0.f;
#pragma unroll
            for (int i = 0; i < 8; ++i) { s += SCR[(8 * seg + i) * 64 + col]; SCR[(8 * seg + i) * 64 + col] = s; }
            SEGT[seg * 64 + col] = s;
        }
        lds_barrier();
        {
            const int col = tid & 63, seg = tid >> 6; float pre = 0.f;
#pragma unroll
            for (int s2 = 0; s2 < 7; ++s2) pre += (s2 < seg) ? SEGT[s2 * 64 + col] : 0.f;
#pragma unroll
            for (int i = 0; i < 8; ++i) SCR[(8 * seg + i) * 64 + col] += pre;
        }
        lds_barrier();
        {
            float L[8], Lr[8], Le[8];
            { const f32x4 x0 = *(const LAS f32x4*)(SCR + tt * 64 + pc), x1 = *(const LAS f32x4*)(SCR + tt * 64 + pc + 4);
              const f32x4 y0 = *(const LAS f32x4*)(SCR + 31 * 64 + pc), y1 = *(const LAS f32x4*)(SCR + 31 * 64 + pc + 4);
              const f32x4 z0 = *(const LAS f32x4*)(SCR + 63 * 64 + pc), z1 = *(const LAS f32x4*)(SCR + 63 * 64 + pc + 4);
#pragma unroll
              for (int e = 0; e < 4; ++e) { L[e] = x0[e]; L[4 + e] = x1[e]; Lr[e] = y0[e]; Lr[4 + e] = y1[e]; Le[e] = z0[e]; Le[4 + e] = z1[e]; } }
            float oA[8], oR[8], oBt[8], oKt[8], oBh[8], oKh[8];
#pragma unroll
            for (int e = 0; e < 8; ++e) {
                const float ea = __expf(L[e] - el_[e] - Lr[e]), er = __expf(L[e] - Lr[e]), eb = __expf(Lr[e] - L[e]), eh = __expf(Le[e] - L[e]);
                const float bb = kk_[e] * as_[e];
                oA[e] = -kk_[e] * ea; oR[e] = r_[e] * er; oBt[e] = bb * eb; oKt[e] = k_[e] * eb; oBh[e] = bb * eh; oKh[e] = k_[e] * eh;
            }
            const int o = tt * CK_TS + pc;
            *(LAS v4u*)(TL(tA) + o) = pack8(oA); *(LAS v4u*)(TL(tR) + o) = pack8(oR); *(LAS v4u*)(TL(tBt) + o) = pack8(oBt); *(LAS v4u*)(TL(tKt) + o) = pack8(oKt);
            *(LAS v4u*)(TL(tBh) + o) = pack8(oBh); *(LAS v4u*)(TL(tKh) + o) = pack8(oKh); *(LAS v4u*)(TL(tV) + o) = pack8(v_);
            if (tt == 0) {
#pragma unroll
                for (int e = 0; e < 8; ++e) { cscale[pc + e] = __expf(Lr[e]); wcv[pc + e] = __expf(Le[e]); }
            }
        }
        lds_barrier();
        const LAS bf16* Z = nullptr;
        const int wg_ = w >> 2, ws_ = w & 3;
        if (wg_ == 0) { mm64h<0, 1, 1, 0, 1, 0>(TL(tNab), TL(tA), TL(tBt), Z, Z, Z, Z, cscale, wcv, ws_, lane);
                        mm64h<0, 1, 1, 0, 1, 0>(TL(tNak), TL(tA), TL(tKt), Z, Z, Z, Z, cscale, wcv, ws_, lane); }
        else          { mm64h<0, 1, 2, 0, 1, 0>(TL(tNrb), TL(tR), TL(tBt), Z, Z, Z, Z, cscale, wcv, ws_, lane);
                        mm64h<0, 1, 2, 0, 1, 0>(TL(tNrk), TL(tR), TL(tKt), Z, Z, Z, Z, cscale, wcv, ws_, lane); }
        lds_barrier();
        if (wg_ == 0) mm64h<0, 0, 0, 0, 1, 0>(TL(tM0), TL(tNab), TL(tNab), Z, Z, Z, Z, cscale, wcv, ws_, lane);
        else          mm64h<0, 0, 0, 0, 1, 0>(TL(tX1), TL(tNak), TL(tV), Z, Z, Z, Z, cscale, wcv, ws_, lane);
        lds_barrier();
        if (wg_ == 0) mm64h<0, 0, 0, 2, 1, 0>(TL(tP1), TL(tNab), TL(tM0), Z, Z, TL(tNab), TL(tM0), cscale, wcv, ws_, lane);
        else          mm64h<0, 0, 0, 0, 1, 0>(TL(tM1), TL(tM0), TL(tM0), Z, Z, Z, Z, cscale, wcv, ws_, lane);
        lds_barrier();
        if (wg_ == 0) mm64h<0, 0, 0, 2, 1, 0>(TL(tNab), TL(tP1), TL(tM1), Z, Z, TL(tP1), TL(tM1), cscale, wcv, ws_, lane);
        else          mm64h<0, 0, 0, 0, 1, 0>(TL(tM0), TL(tM1), TL(tM1), Z, Z, Z, Z, cscale, wcv, ws_, lane);
        lds_barrier();
        if (wg_ == 0) mm64h<0, 0, 0, 2, 1, 0>(TL(tP1), TL(tNab), TL(tM0), Z, Z, TL(tNab), TL(tM0), cscale, wcv, ws_, lane);
        else          mm64h<0, 0, 0, 0, 1, 0>(TL(tM1), TL(tM0), TL(tM0), Z, Z, Z, Z, cscale, wcv, ws_, lane);
        lds_barrier();
        if (wg_ == 0) mm64h<0, 0, 0, 2, 1, 0>(TL(tNab), TL(tP1), TL(tM1), Z, Z, TL(tP1), TL(tM1), cscale, wcv, ws_, lane);
        else          mm64h<0, 0, 0, 0, 1, 0>(TL(tM0), TL(tM1), TL(tM1), Z, Z, Z, Z, cscale, wcv, ws_, lane);
        lds_barrier();
        mm64<0, 0, 0, 2, 1, 0>(TL(tP1), TL(tNab), TL(tM0), Z, Z, TL(tNab), TL(tM0), cscale, wcv, w, lane);
        lds_barrier();
        if (wg_ == 0) mm64h<0, 0, 0, 1, 1, 0>(TL(tBt), TL(tP1), TL(tA), Z, Z, TL(tA), Z, cscale, wcv, ws_, lane);
        else          mm64h<0, 0, 0, 1, 1, 0>(TL(tKt), TL(tP1), TL(tX1), Z, Z, TL(tX1), Z, cscale, wcv, ws_, lane);
        lds_barrier();
        if (wg_ == 0) { mm64h<0, 0, 0, 1, 1, 1>(TL(tM0), TL(tNrb), TL(tBt), Z, Z, TL(tR), Z, cscale, wcv, ws_, lane);
                        mm64h<0, 0, 0, 0, 2, 0>(TL(tM1), TL(tNrb), TL(tKt), TL(tNrk), TL(tV), Z, Z, cscale, wcv, ws_, lane); }
        else          { mm64h<1, 0, 0, 0, 1, 2>(TL(tNab), TL(tBh), TL(tBt), Z, Z, Z, Z, cscale, wcv, ws_, lane);
                        mm64h<1, 0, 0, 0, 2, 0>(TL(tX1), TL(tKt), TL(tBh), TL(tV), TL(tKh), Z, Z, cscale, wcv, ws_, lane); }
        lds_barrier();
        }
        {
            const size_t grow = m0 + tt;
            *(v4u*)(ELOG + grow * D + hc) = *(const LAS v4u*)(TL(tM0) + tt * CK_TS + pc);
            *(v4u*)(Y + grow * D + hc) = *(const LAS v4u*)(TL(tM1) + tt * CK_TS + pc);
            *(v4u*)(PR + grow * N1P + 2048 + hc) = *(const LAS v4u*)(TL(tNab) + tt * CK_TS + pc);
            *(v4u*)(SLB + grow * D + hc) = *(const LAS v4u*)(TL(tX1) + tt * CK_TS + pc);
        }
        lds_barrier();
    }
#undef TL
#undef CK_LOAD
}

struct SeqOps { v4u g0, g1, p0, p1; v2u sl, yl; };
__device__ __forceinline__ void phase_rwkv_chunk_seq(const Ctx& c, KArgs& a, const bool commit = true) {
    unsigned char* ws = a.ws;
    const bf16* PR = (const bf16*)(ws + WS_OV + OV_PR);
    const bf16* RP = (const bf16*)(ws + WS_OV + OV_ELOG);
    bf16* Y = (bf16*)(ws + WS_OV + OV_YA);
    const bf16* SLB = (const bf16*)(ws + WS_OV + OV_AL);
    LAS bf16* SL = (LAS bf16*)c.lds;
    const int tid = c.tid, lane = c.lane, w = c.wave, r = lane & 15, q = lane >> 4;
    constexpr int PF = 4;
    for (int unit = c.bid; unit < 256; unit += c.G) {
        const int b = unit >> 6, h = (unit >> 2) & 15, vq = unit & 3;
        for (int e = tid; e < 2 * 16 * CK_TS / 2; e += 512) ((LAS unsigned*)SL)[e] = 0u;
        __syncthreads();
        if (w < 4) {
            const size_t rowG = (size_t)b * T + 16 * w + r;
            const size_t rowS = (size_t)b * T + vq * 16 + r;
            SeqOps ops[PF];
#define SQ_LOAD(dst, chn) do { const size_t o_ = (size_t)(chn) * 64; \
                dst.g0 = *(const v4u*)(PR + (rowG + o_) * N1P + 2048 + h * 64 + 8 * q); dst.g1 = *(const v4u*)(PR + (rowG + o_) * N1P + 2048 + h * 64 + 32 + 8 * q); \
                dst.p0 = *(const v4u*)(RP + (rowG + o_) * D + h * 64 + 8 * q); dst.p1 = *(const v4u*)(RP + (rowG + o_) * D + h * 64 + 32 + 8 * q); \
                dst.sl = *(const v2u*)(SLB + (rowS + o_) * D + h * 64 + 16 * w + 4 * q); dst.yl = *(const v2u*)(Y + (rowG + o_) * D + h * 64 + vq * 16 + 4 * q); } while (0)
#pragma unroll
            for (int i = 0; i < PF; ++i) SQ_LOAD(ops[i], i);
            for (int ch0 = 0; ch0 < 64; ch0 += PF) {
#pragma unroll
                for (int i = 0; i < PF; ++i) {
                    const int ch = ch0 + i;
                    const SeqOps cur = ops[i];
                    if (ch + PF < 64) SQ_LOAD(ops[i], ch + PF);
                    const LAS bf16* Sc = SL + (i & 1) * 16 * CK_TS; LAS bf16* Sn = SL + ((i + 1) & 1) * 16 * CK_TS;
                    const bf16x8 s0 = *(const LAS bf16x8*)(Sc + r * CK_TS + 8 * q), s1 = *(const LAS bf16x8*)(Sc + r * CK_TS + 32 + 8 * q);
                    f32x4 accS = (f32x4){bflo(cur.sl.x), bfhi(cur.sl.x), bflo(cur.sl.y), bfhi(cur.sl.y)};
                    accS = __builtin_amdgcn_mfma_f32_16x16x32_bf16(__builtin_bit_cast(bf16x8, cur.g0), s0, accS, 0, 0, 0);
                    accS = __builtin_amdgcn_mfma_f32_16x16x32_bf16(__builtin_bit_cast(bf16x8, cur.g1), s1, accS, 0, 0, 0);
                    f32x4 accY = (f32x4){bflo(cur.yl.x), bfhi(cur.yl.x), bflo(cur.yl.y), bfhi(cur.yl.y)};
                    accY = __builtin_amdgcn_mfma_f32_16x16x32_bf16(s0, __builtin_bit_cast(bf16x8, cur.p0), accY, 0, 0, 0);
                    accY = __builtin_amdgcn_mfma_f32_16x16x32_bf16(s1, __builtin_bit_cast(bf16x8, cur.p1), accY, 0, 0, 0);
                    { v2u o; o.x = pk2c(accS[0], accS[1]); o.y = pk2c(accS[2], accS[3]); *(LAS v2u*)(Sn + r * CK_TS + 16 * w + 4 * q) = o; }
                    if (commit || accY[0] == 123456.789f) { v2u o; o.x = pk2c(accY[0], accY[1]); o.y = pk2c(accY[2], accY[3]); *(v2u*)(Y + (rowG + (size_t)ch * 64) * D + h * 64 + vq * 16 + 4 * q) = o; }
                    lds_barrier();
                }
            }
#undef SQ_LOAD
        } else {
            for (int ch = 0; ch < 64; ++ch) lds_barrier();
        }
        __syncthreads();
    }
}

__device__ __forceinline__ void phase_rwkv_post(const Ctx& c, KArgs& a, int l, int hb) {
    unsigned char* ws = a.ws;
    const bf16* GG = (const bf16*)(ws + WS_OV + OV_GG);
    const bf16* VS = l == 0 ? (const bf16*)(ws + WS_VF) + (size_t)hb * MH * D : (const bf16*)(ws + WS_OV + OV_VMIX);
    const float* BON = (const float*)(ws + WS_OV + OV_BON);
    bf16* Y = (bf16*)(ws + WS_OV + OV_YA);
    const int lane = c.lane, c0 = 16 * lane;
    float lw[16], lb[16];
#pragma unroll
    for (int e = 0; e < 16; ++e) { lw[e] = a.in[I_LNW][(size_t)l * D + c0 + e]; lb[e] = a.in[I_LNB][(size_t)l * D + c0 + e]; }
    const int gw = c.bid * 8 + c.wave, NGW = c.G * 8;
    v4u ny0, ny1, nv0, nv1, ng0, ng1; float nbon = 0.f;
#define RP_LOAD(mm) do { ny0 = *(const v4u*)(Y + (size_t)(mm) * D + c0); ny1 = *(const v4u*)(Y + (size_t)(mm) * D + c0 + 8); nv0 = *(const v4u*)(VS + (size_t)(mm) * D + c0); nv1 = *(const v4u*)(VS + (size_t)(mm) * D + c0 + 8); \
        ng0 = *(const v4u*)(GG + (size_t)(mm) * D + c0); ng1 = *(const v4u*)(GG + (size_t)(mm) * D + c0 + 8); nbon = BON[(size_t)(mm) * 16 + (lane >> 2)]; } while (0)
    if (gw < MH) RP_LOAD(gw);
    for (int m = gw; m < MH; m += NGW) {
        float y[16], v[16], g[16], t8[8];
        const v4u cy0 = ny0, cy1 = ny1, cv0 = nv0, cv1 = nv1, cg0 = ng0, cg1 = ng1; const float bon = nbon;
        if (m + NGW < MH) RP_LOAD(m + NGW);
#define UP16(dst, qa, qb) do { unpack8(qa, t8); _Pragma("unroll") for (int e = 0; e < 8; ++e) dst[e] = t8[e]; unpack8(qb, t8); _Pragma("unroll") for (int e = 0; e < 8; ++e) dst[8 + e] = t8[e]; } while (0)
        UP16(y, cy0, cy1); UP16(v, cv0, cv1); UP16(g, cg0, cg1);
#undef UP16
        float s1 = 0.f;
#pragma unroll
        for (int e = 0; e < 16; ++e) s1 += y[e];
        s1 = sum4(s1);
        const float mean = s1 * (1.f / 64.f);
        float s2 = 0.f;
#pragma unroll
        for (int e = 0; e < 16; ++e) { const float d = y[e] - mean; s2 += d * d; }
        s2 = sum4(s2);
        const float rstd = rsqrtf(s2 * (1.f / 64.f) + 64e-5f);
        float o[16];
#pragma unroll
        for (int e = 0; e < 16; ++e) o[e] = ((y[e] - mean) * rstd * lw[e] + lb[e] + bon * v[e]) * g[e];
        v4u o0, o1;
        o0.x = pk2(o[0], o[1]); o0.y = pk2(o[2], o[3]); o0.z = pk2(o[4], o[5]); o0.w = pk2(o[6], o[7]);
        o1.x = pk2(o[8], o[9]); o1.y = pk2(o[10], o[11]); o1.z = pk2(o[12], o[13]); o1.w = pk2(o[14], o[15]);
        *(v4u*)(Y + (size_t)m * D + c0) = o0; *(v4u*)(Y + (size_t)m * D + c0 + 8) = o1;
    }
}

__device__ __forceinline__ void phase_ssd_conv(const Ctx& c, KArgs& a, int l) {
    unsigned char* ws = a.ws;
    const bf16* PS = (const bf16*)(ws + WS_OV + OV_PS);
    bf16* XBC = (bf16*)(ws + WS_OV + OV_XBC);
    float* DT = (float*)(ws + WS_OV + OV_DT); float* DA = (float*)(ws + WS_OV + OV_DA);
    const float* cw = a.in[I_CW] + (size_t)l * 4 * 3072; const float* cb = a.in[I_CB] + (size_t)l * 3072;
    const int gw = c.bid * 8 + c.wave, NGW = c.G * 8, lane = c.lane;
    constexpr int RUN = 16, NRUN = MH / RUN;
    for (int it = gw; it < 2 * NRUN; it += NGW) {
        const int cb_ = 4 + (it & 1), run = it >> 1, ch0 = cb_ * 512 + lane * 8, m0 = run * RUN;
        float w[4][8], bias[8];
#pragma unroll
        for (int j = 0; j < 4; ++j)
#pragma unroll
            for (int e = 0; e < 8; ++e) w[j][e] = cw[j * 3072 + ch0 + e];
#pragma unroll
        for (int e = 0; e < 8; ++e) bias[e] = cb[ch0 + e];
        float x0[8], x1[8], x2[8], x3[8];
        const bf16* base = PS + (size_t)m0 * N2P + 2048 + ch0;
        const int t0 = m0 & (T - 1);
        if (t0 >= 3) { unpack8(*(const v4u*)(base - 3 * N2P), x0); unpack8(*(const v4u*)(base - 2 * N2P), x1); unpack8(*(const v4u*)(base - N2P), x2); }
        else {
#pragma unroll
            for (int e = 0; e < 8; ++e) { x0[e] = 0.f; x1[e] = 0.f; x2[e] = 0.f; }
        }
        v4u nx = *(const v4u*)base;
#pragma unroll 4
        for (int i = 0; i < RUN; ++i) {
            unpack8(nx, x3);
            if (i + 1 < RUN) nx = *(const v4u*)(base + (size_t)(i + 1) * N2P);
            float o[8];
#pragma unroll
            for (int e = 0; e < 8; ++e) { const float y = bias[e] + x0[e] * w[0][e] + x1[e] * w[1][e] + x2[e] * w[2][e] + x3[e] * w[3][e]; o[e] = siluf_(y); x0[e] = x1[e]; x1[e] = x2[e]; x2[e] = x3[e]; }
            *(v4u*)(XBC + (size_t)(m0 + i) * 3072 + ch0) = pack8(o);
        }
    }
}

__device__ __forceinline__ void tr_bm2(unsigned a, bf16x8& f0, bf16x8& f1) {
    s16x4 l0, h0, l1, h1;
    asm volatile("ds_read_b64_tr_b16 %0, %4\n\tds_read_b64_tr_b16 %1, %4 offset:1088\n\tds_read_b64_tr_b16 %2, %4 offset:8704\n\tds_read_b64_tr_b16 %3, %4 offset:9792\n\ts_waitcnt lgkmcnt(0)"
                 : "=&v"(l0), "=&v"(h0), "=&v"(l1), "=&v"(h1) : "v"(a) : "memory");
    f0 = __builtin_shufflevector(l0, h0, 0, 1, 2, 3, 4, 5, 6, 7); f1 = __builtin_shufflevector(l1, h1, 0, 1, 2, 3, 4, 5, 6, 7);
}
__device__ __forceinline__ void tr_x2(unsigned a, bf16x8& f0, bf16x8& f1) {
    s16x4 l0, h0, l1, h1;
    asm volatile("ds_read_b64_tr_b16 %0, %4\n\tds_read_b64_tr_b16 %1, %4 offset:320\n\tds_read_b64_tr_b16 %2, %4 offset:2560\n\tds_read_b64_tr_b16 %3, %4 offset:2880\n\ts_waitcnt lgkmcnt(0)"
                 : "=&v"(l0), "=&v"(h0), "=&v"(l1), "=&v"(h1) : "v"(a) : "memory");
    f0 = __builtin_shufflevector(l0, h0, 0, 1, 2, 3, 4, 5, 6, 7); f1 = __builtin_shufflevector(l1, h1, 0, 1, 2, 3, 4, 5, 6, 7);
}
__device__ __forceinline__ void tr_x4(unsigned a, bf16x8& f00, bf16x8& f01, bf16x8& f10, bf16x8& f11) {
    s16x4 l0, h0, l1, h1, l2, h2, l3, h3;
    asm volatile("ds_read_b64_tr_b16 %0, %8\n\tds_read_b64_tr_b16 %1, %8 offset:320\n\tds_read_b64_tr_b16 %2, %8 offset:2560\n\tds_read_b64_tr_b16 %3, %8 offset:2880\n\t"
                 "ds_read_b64_tr_b16 %4, %8 offset:32\n\tds_read_b64_tr_b16 %5, %8 offset:352\n\tds_read_b64_tr_b16 %6, %8 offset:2592\n\tds_read_b64_tr_b16 %7, %8 offset:2912\n\ts_waitcnt lgkmcnt(0)"
                 : "=&v"(l0), "=&v"(h0), "=&v"(l1), "=&v"(h1), "=&v"(l2), "=&v"(h2), "=&v"(l3), "=&v"(h3) : "v"(a) : "memory");
    f00 = __builtin_shufflevector(l0, h0, 0, 1, 2, 3, 4, 5, 6, 7); f01 = __builtin_shufflevector(l1, h1, 0, 1, 2, 3, 4, 5, 6, 7);
    f10 = __builtin_shufflevector(l2, h2, 0, 1, 2, 3, 4, 5, 6, 7); f11 = __builtin_shufflevector(l3, h3, 0, 1, 2, 3, 4, 5, 6, 7);
}
__device__ __forceinline__ void phase_ssd_scan(const Ctx& c, KArgs& a, int l) {
    unsigned char* ws = a.ws;
    const bf16* PS = (const bf16*)(ws + WS_OV + OV_PS);
    bf16* XBC = (bf16*)(ws + WS_OV + OV_XBC);
    const float* cw = a.in[I_CW] + (size_t)l * 4 * 3072; const float* cb = a.in[I_CB] + (size_t)l * 3072;
    const float* DT = (const float*)(ws + WS_OV + OV_DT); const float* ACS = (const float*)(ws + WS_OV + OV_DA);
    constexpr int SC = 136, SM = 72, SX = 40;
    LAS bf16* Cm = (LAS bf16*)c.lds;
    LAS bf16* Bm = Cm + 64 * SC;
    LAS bf16* Xd = Bm + 64 * SC;
    LAS bf16* Xs = Xd + 64 * SX;
    LAS bf16* Xr = Xs + 64 * SX;
    LAS bf16* MtT = Xr + 64 * SX;
    LAS bf16* SL = MtT + 64 * SM;
    LAS float* acsL = (LAS float*)(SL + 32 * SC);
    const unsigned BmB = (unsigned)(size_t)Bm, XdB = (unsigned)(size_t)Xd, XsB = (unsigned)(size_t)Xs;
    const int tid = c.tid, lane = c.lane, w = c.wave, r = lane & 15, q = lane >> 4;
    const int sj = tid >> 3, sn = (tid & 7) * 16, sp = (tid & 7) * 4;
    const int trq = ((lane & 15) >> 2), trp = lane & 3;
    const unsigned troffB = (unsigned)(((8 * q + trq) * SC + 4 * trp) * 2), troffX = (unsigned)(((8 * q + trq) * SX + 4 * trp) * 2);
    for (int unit = c.bid; unit < 256; unit += c.G) {
        const int b = unit >> 6, h = (unit >> 1) & 31, ph = unit & 1, g = h >> 3;
        const size_t m0 = (size_t)b * T;
        f32x4 st[2] = {(f32x4){0.f, 0.f, 0.f, 0.f}, (f32x4){0.f, 0.f, 0.f, 0.f}};
        for (int e = tid; e < 32 * SC / 2; e += 512) ((LAS unsigned*)SL)[e] = 0u;
        v4u gB0, gB1, gC0, gC1; v2u gX0, gX1, gX2, gX3; float gacs, gacsE, gdt;
        const int chx = h * 64 + ph * 32 + sp; const float Dh = a.in[I_SD][l * 32 + h];
        float cwt[4][4], cbs[4];
#pragma unroll
        for (int e2 = 0; e2 < 4; ++e2) { cbs[e2] = cb[chx + e2];
#pragma unroll
            for (int j = 0; j < 4; ++j) cwt[j][e2] = cw[j * 3072 + chx + e2]; }
#define SS_LOAD(chunk) do { const size_t row = m0 + (size_t)(chunk) * 64 + sj; const bf16* xr = XBC + row * 3072; \
            gB0 = *(const v4u*)(xr + 2048 + g * 128 + sn); gB1 = *(const v4u*)(xr + 2048 + g * 128 + sn + 8); \
            gC0 = *(const v4u*)(xr + 2560 + g * 128 + sn); gC1 = *(const v4u*)(xr + 2560 + g * 128 + sn + 8); \
            { const int t_ = (chunk) * 64 + sj; const bf16* pr_ = PS + row * N2P + 2048 + chx; const v2u z2 = (v2u){0u, 0u}; \
              gX3 = *(const v2u*)pr_; gX2 = t_ >= 1 ? *(const v2u*)(pr_ - N2P) : z2; gX1 = t_ >= 2 ? *(const v2u*)(pr_ - 2 * N2P) : z2; gX0 = t_ >= 3 ? *(const v2u*)(pr_ - 3 * N2P) : z2; } \
            gacs = ACS[row * 32 + h]; gacsE = ACS[(m0 + (size_t)(chunk) * 64 + 63) * 32 + h]; gdt = DT[row * 32 + h]; } while (0)
#define SS_STAGE() do { \
            *(LAS v4u*)(Bm + sj * SC + sn) = gB0; *(LAS v4u*)(Bm + sj * SC + sn + 8) = gB1; *(LAS v4u*)(Cm + sj * SC + sn) = gC0; *(LAS v4u*)(Cm + sj * SC + sn + 8) = gC1; \
            const float sc_ = gdt * __expf(gacsE - gacs); \
            const float r0_[4] = {bflo(gX0.x), bfhi(gX0.x), bflo(gX0.y), bfhi(gX0.y)}, r1_[4] = {bflo(gX1.x), bfhi(gX1.x), bflo(gX1.y), bfhi(gX1.y)}; \
            const float r2_[4] = {bflo(gX2.x), bfhi(gX2.x), bflo(gX2.y), bfhi(gX2.y)}, r3_[4] = {bflo(gX3.x), bfhi(gX3.x), bflo(gX3.y), bfhi(gX3.y)}; \
            float xa_[4]; _Pragma("unroll") for (int e2 = 0; e2 < 4; ++e2) xa_[e2] = siluf_(cbs[e2] + r0_[e2] * cwt[0][e2] + r1_[e2] * cwt[1][e2] + r2_[e2] * cwt[2][e2] + r3_[e2] * cwt[3][e2]); \
            const float x0_ = xa_[0], x1_ = xa_[1], x2_ = xa_[2], x3_ = xa_[3]; \
            v2u o1_, o2_; o1_.x = pk2(x0_ * gdt, x1_ * gdt); o1_.y = pk2(x2_ * gdt, x3_ * gdt); o2_.x = pk2(x0_ * sc_, x1_ * sc_); o2_.y = pk2(x2_ * sc_, x3_ * sc_); \
            *(LAS v2u*)(Xd + sj * SX + sp) = o1_; *(LAS v2u*)(Xs + sj * SX + sp) = o2_; { v2u o3_; o3_.x = pk2(x0_, x1_); o3_.y = pk2(x2_, x3_); *(LAS v2u*)(Xr + sj * SX + sp) = o3_; } \
            if ((tid & 7) == 0) acsL[sj] = gacs; } while (0)
        SS_LOAD(0);
        SS_STAGE();
        __syncthreads();
        for (int ch = 0; ch < T / 64; ++ch) {
            if (ch + 1 < T / 64) SS_LOAD(ch + 1);
            {
                const int jt = w >> 1, it0 = 2 * (w & 1);
                f32x4 acc0 = (f32x4){0.f, 0.f, 0.f, 0.f}, acc1 = acc0;
                if (it0 + 1 >= jt) {
#pragma unroll
                    for (int ks = 0; ks < 4; ++ks) {
                        const bf16x8 af = *(const LAS bf16x8*)(Bm + (16 * jt + r) * SC + 32 * ks + 8 * q);
                        const bf16x8 b0 = *(const LAS bf16x8*)(Cm + (16 * it0 + r) * SC + 32 * ks + 8 * q);
                        const bf16x8 b1 = *(const LAS bf16x8*)(Cm + (16 * (it0 + 1) + r) * SC + 32 * ks + 8 * q);
                        acc0 = __builtin_amdgcn_mfma_f32_16x16x32_bf16(af, b0, acc0, 0, 0, 0);
                        acc1 = __builtin_amdgcn_mfma_f32_16x16x32_bf16(af, b1, acc1, 0, 0, 0);
                    }
                }
                const int i0 = 16 * it0 + r, i1 = i0 + 16;
                const float ai0 = acsL[i0], ai1 = acsL[i1];
                float m0v[4], m1v[4];
#pragma unroll
                for (int e = 0; e < 4; ++e) { const int j = 16 * jt + 4 * q + e; const float aj = acsL[j];
                    m0v[e] = (j <= i0) ? acc0[e] * __expf(ai0 - aj) : 0.f; m1v[e] = (j <= i1) ? acc1[e] * __expf(ai1 - aj) : 0.f; }
                { v2u o0, o1; o0.x = pk2(m0v[0], m0v[1]); o0.y = pk2(m0v[2], m0v[3]); o1.x = pk2(m1v[0], m1v[1]); o1.y = pk2(m1v[2], m1v[3]);
                  *(LAS v2u*)(MtT + i0 * SM + 16 * jt + 4 * q) = o0; *(LAS v2u*)(MtT + i1 * SM + 16 * jt + 4 * q) = o1; }
            }
            lds_barrier();
            {
                const int it = w >> 1, pt = w & 1;
                f32x4 accD = (f32x4){0.f, 0.f, 0.f, 0.f}, accO = accD;
                {
                    bf16x8 xb0, xb1; tr_x2(XdB + troffX + 32u * pt, xb0, xb1);
                    const bf16x8 af0 = *(const LAS bf16x8*)(MtT + (16 * it + r) * SM + 8 * q);
                    accD = __builtin_amdgcn_mfma_f32_16x16x32_bf16(af0, xb0, accD, 0, 0, 0);
                    if (it >= 2) {
                        const bf16x8 af1 = *(const LAS bf16x8*)(MtT + (16 * it + r) * SM + 32 + 8 * q);
                        accD = __builtin_amdgcn_mfma_f32_16x16x32_bf16(af1, xb1, accD, 0, 0, 0);
                    }
                }
#pragma unroll
                for (int ks = 0; ks < 4; ++ks) {
                    const bf16x8 af = *(const LAS bf16x8*)(Cm + (16 * it + r) * SC + 32 * ks + 8 * q);
                    const bf16x8 bf_ = *(const LAS bf16x8*)(SL + (16 * pt + r) * SC + 32 * ks + 8 * q);
                    accO = __builtin_amdgcn_mfma_f32_16x16x32_bf16(af, bf_, accO, 0, 0, 0);
                }
                const int p = 16 * pt + r;
#pragma unroll
                for (int e = 0; e < 4; ++e) { const int i = 16 * it + 4 * q + e; const float y = accD[e] + __expf(acsL[i]) * accO[e] + Dh * bf1(Xr[i * SX + p]);
                    XBC[(m0 + (size_t)ch * 64 + i) * 3072 + h * 64 + ph * 32 + p] = (bf16)f2bf(y); }
            }
            {
                const float dec = __expf(acsL[63]);
                bf16x8 a0, a1, bx[2][2];
                tr_bm2(BmB + troffB + 32u * w, a0, a1);
                tr_x4(XsB + troffX, bx[0][0], bx[0][1], bx[1][0], bx[1][1]);
#pragma unroll
                for (int pt = 0; pt < 2; ++pt) {
                    f32x4 s = st[pt] * dec;
                    s = __builtin_amdgcn_mfma_f32_16x16x32_bf16(a0, bx[pt][0], s, 0, 0, 0);
                    s = __builtin_amdgcn_mfma_f32_16x16x32_bf16(a1, bx[pt][1], s, 0, 0, 0);
                    st[pt] = s;
                }
            }
            lds_barrier();
#pragma unroll
            for (int pt = 0; pt < 2; ++pt) { v2u o; o.x = pk2c(st[pt][0], st[pt][1]); o.y = pk2c(st[pt][2], st[pt][3]);
                *(LAS v2u*)(SL + (16 * pt + r) * SC + 16 * w + 4 * q) = o; }
            if (ch + 1 < T / 64) SS_STAGE();
            lds_barrier();
        }
#undef SS_LOAD
#undef SS_STAGE
    }
}

__device__ __forceinline__ void phase_ssd_post(const Ctx& c, KArgs& a, int l) {
    unsigned char* ws = a.ws;
    bf16* PS = (bf16*)(ws + WS_OV + OV_PS);
    const bf16* XBC = (const bf16*)(ws + WS_OV + OV_XBC);
    const int lane = c.lane, c0 = 32 * lane;
    const float* ng = a.in[I_SNG] + (size_t)l * 2048 + c0;
    const int gw = c.bid * 8 + c.wave, NGW = c.G * 8;
    v4u nyy[4], nzz[4];
#define SP_LOAD(mm) do { _Pragma("unroll") for (int q = 0; q < 4; ++q) { nyy[q] = *(const v4u*)(XBC + (size_t)(mm) * 3072 + c0 + 8 * q); nzz[q] = *(const v4u*)(PS + (size_t)(mm) * N2P + c0 + 8 * q); } } while (0)
    if (gw < MH) SP_LOAD(gw);
    for (int m = gw; m < MH; m += NGW) {
        float y[32]; float ss = 0.f;
        v4u cyy[4], czz[4];
#pragma unroll
        for (int q = 0; q < 4; ++q) { cyy[q] = nyy[q]; czz[q] = nzz[q]; }
        if (m + NGW < MH) SP_LOAD(m + NGW);
#pragma unroll
        for (int q = 0; q < 4; ++q) {
            float yy[8], zz[8];
            unpack8(cyy[q], yy); unpack8(czz[q], zz);
#pragma unroll
            for (int e = 0; e < 8; ++e) { const float v = yy[e] * siluf_(zz[e]); y[8 * q + e] = v; ss += v * v; }
        }
        ss = sum16(ss);
        const float r = rsqrtf(ss * (1.f / 512.f) + 1e-6f);
#pragma unroll
        for (int q = 0; q < 4; ++q) {
            float o[8];
#pragma unroll
            for (int e = 0; e < 8; ++e) o[e] = y[8 * q + e] * r * ng[8 * q + e];
            *(v4u*)(PS + (size_t)m * N2P + 2048 + c0 + 8 * q) = pack8(o);
        }
    }
}

__device__ __forceinline__ void phase_peer_convert(const Ctx& c, KArgs& a, int l) {
    unsigned char* ws = a.ws;
    const int gw = c.bid * 8 + c.wave, NGW = c.G * 8, lane = c.lane;
    f32x4 n0, n1, n2, n3;
#define PC_LOAD(itt) do { const int tb_ = (itt) >= NEXP, e_ = (itt) - tb_ * NEXP; const float* s_ = (tb_ ? a.in[I_PU] : a.in[I_PD]) + ((size_t)l * NEXP + e_) * D + 16 * lane; \
        n0 = *(const f32x4*)s_; n1 = *(const f32x4*)(s_ + 4); n2 = *(const f32x4*)(s_ + 8); n3 = *(const f32x4*)(s_ + 12); } while (0)
    if (gw < 2 * NEXP) PC_LOAD(gw);
    for (int it = gw; it < 2 * NEXP; it += NGW) {
        const int tb = it >= NEXP, e = it - tb * NEXP;
        const f32x4 x0 = n0, x1 = n1, x2 = n2, x3 = n3;
        if (it + NGW < 2 * NEXP) PC_LOAD(it + NGW);
        float am = fmaxf(fmaxf(fmaxf(fabsf(x0.x), fabsf(x0.y)), fmaxf(fabsf(x0.z), fabsf(x0.w))), fmaxf(fmaxf(fabsf(x1.x), fabsf(x1.y)), fmaxf(fabsf(x1.z), fabsf(x1.w))));
        am = fmaxf(am, fmaxf(fmaxf(fmaxf(fabsf(x2.x), fabsf(x2.y)), fmaxf(fabsf(x2.z), fabsf(x2.w))), fmaxf(fmaxf(fabsf(x3.x), fabsf(x3.y)), fmaxf(fabsf(x3.z), fabsf(x3.w)))));
#pragma unroll
        for (int o = 1; o < 64; o <<= 1) am = fmaxf(am, __shfl_xor(am, o));
        am = fmaxf(am, 1e-30f);
        const float s = 384.f / am;
        v4u q;
        int w;
        w = __builtin_amdgcn_cvt_pk_fp8_f32(x0.x * s, x0.y * s, 0, false); w = __builtin_amdgcn_cvt_pk_fp8_f32(x0.z * s, x0.w * s, w, true); q.x = (unsigned)w;
        w = __builtin_amdgcn_cvt_pk_fp8_f32(x1.x * s, x1.y * s, 0, false); w = __builtin_amdgcn_cvt_pk_fp8_f32(x1.z * s, x1.w * s, w, true); q.y = (unsigned)w;
        w = __builtin_amdgcn_cvt_pk_fp8_f32(x2.x * s, x2.y * s, 0, false); w = __builtin_amdgcn_cvt_pk_fp8_f32(x2.z * s, x2.w * s, w, true); q.z = (unsigned)w;
        w = __builtin_amdgcn_cvt_pk_fp8_f32(x3.x * s, x3.y * s, 0, false); w = __builtin_amdgcn_cvt_pk_fp8_f32(x3.z * s, x3.w * s, w, true); q.w = (unsigned)w;
        *(v4u*)(ws + WS_OV + (tb ? OV_UP : OV_DOWN) + (size_t)e * D + 16 * lane) = q;
        if (lane == 0) ((float*)(ws + WS_OV + OV_PSCALE))[it] = am * (1.f / 384.f);
    }
}

template <class TT> __device__ __forceinline__ void ce_desc(TT& a, TT& b) { const TT hi = a > b ? a : b, lo = a > b ? b : a; a = hi; b = lo; }
__device__ __forceinline__ void cef(float& a, float& b) { const float hi = fmaxf(a, b), lo = fminf(a, b); a = hi; b = lo; }
__device__ __forceinline__ void ced(double& a, double& b) { const double hi = fmax(a, b), lo = fmin(a, b); a = hi; b = lo; }
template <class TT, class CE> __device__ __forceinline__ void bitonic_sort16_desc(TT (&v)[16], CE ce) {
#pragma unroll
    for (int k = 2; k <= 16; k <<= 1)
#pragma unroll
        for (int j = k >> 1; j > 0; j >>= 1)
#pragma unroll
            for (int i = 0; i < 16; ++i) { const int p = i ^ j; if (p > i) { if ((i & k) == 0) ce(v[i], v[p]); else ce(v[p], v[i]); } }
}
template <class TT, class CE> __device__ __forceinline__ void bitonic_merge16_desc(TT (&v)[16], CE ce) {
#pragma unroll
    for (int j = 8; j > 0; j >>= 1)
#pragma unroll
        for (int i = 0; i < 16; ++i) { const int p = i ^ j; if (p > i) ce(v[i], v[p]); }
}
struct CEF { __device__ __forceinline__ void operator()(float& a, float& b) const { cef(a, b); } };
struct CED { __device__ __forceinline__ void operator()(double& a, double& b) const { ced(a, b); } };

__device__ __forceinline__ void top16_of_128(const bf16* p, float (&top)[16]) {
#pragma unroll
    for (int grp = 0; grp < 8; ++grp) {
        float cur[16];
        const v4u q0 = *(const v4u*)(p + grp * 16), q1 = *(const v4u*)(p + grp * 16 + 8);
        const unsigned w[8] = {q0.x, q0.y, q0.z, q0.w, q1.x, q1.y, q1.z, q1.w};
#pragma unroll
        for (int e = 0; e < 8; ++e) {
            const unsigned lo = w[e] << 16, hi = w[e] & 0xffff0000u;
            const unsigned i0 = grp * 16 + 2 * e, i1 = i0 + 1;
            cur[2 * e] = __builtin_bit_cast(float, lo | ((lo >> 31) ? i0 : (127u - i0)));
            cur[2 * e + 1] = __builtin_bit_cast(float, hi | ((hi >> 31) ? i1 : (127u - i1)));
        }
        bitonic_sort16_desc(cur, CEF());
        if (grp == 0) {
#pragma unroll
            for (int i = 0; i < 16; ++i) top[i] = cur[i];
        } else {
#pragma unroll
            for (int i = 0; i < 16; ++i) top[i] = fmaxf(top[i], cur[15 - i]);
            bitonic_merge16_desc(top, CEF());
        }
    }
}
__device__ __forceinline__ unsigned key_index(float k) { const unsigned u = __builtin_bit_cast(unsigned, k); const unsigned lo = u & 0x7fu; return (u >> 31) ? lo : 127u - lo; }
__device__ __forceinline__ float key_value(float k) { return __builtin_bit_cast(float, __builtin_bit_cast(unsigned, k) & 0xffff0000u); }

__device__ __forceinline__ void phase_peer_topk(const Ctx& c, KArgs& a) {
    unsigned char* ws = a.ws;
    const bf16* SC = (const bf16*)(ws + WS_OV + OV_SC);
    int* IDX = (int*)(ws + WS_OV + OV_IDX); float* GATE = (float*)(ws + WS_OV + OV_GATE);
    for (int it = c.bid * 512 + c.tid; it < M * 8; it += c.G * 512) {
        const bf16* p = SC + (size_t)it * 256;
        float t0[16], t1[16];
        top16_of_128(p, t0); top16_of_128(p + 128, t1);
        float v0[16], v1[16]; unsigned i0[16], i1[16];
#pragma unroll
        for (int i = 0; i < 16; ++i) { v0[i] = key_value(t0[i]); v1[i] = key_value(t1[i]); i0[i] = key_index(t0[i]); i1[i] = key_index(t1[i]); }
        double top[16];
        const double NEG = -1.0e300;
#pragma unroll
        for (int grp = 0; grp < 4; ++grp) {
            double cur[16];
#pragma unroll
            for (int s = 0; s < 16; ++s) cur[s] = NEG;
            int n = 0;
#pragma unroll
            for (int i = 0; i < 16; ++i)
#pragma unroll
                for (int j = 0; j < 16; ++j) if ((i + 1) * (j + 1) <= 16) {
                    if (n / 16 == grp) {
                        const double d = (double)(v0[i] + v1[j]);
                        const unsigned long long eid = (unsigned long long)(i0[i] * 128u + i1[j]);
                        const unsigned long long bits = __builtin_bit_cast(unsigned long long, d);
                        cur[n % 16] = __builtin_bit_cast(double, bits | ((bits >> 63) ? eid : (16383ull - eid)));
                    }
                    ++n;
                }
            bitonic_sort16_desc(cur, CED());
            if (grp == 0) {
#pragma unroll
                for (int i = 0; i < 16; ++i) top[i] = cur[i];
            } else {
#pragma unroll
                for (int i = 0; i < 16; ++i) top[i] = fmax(top[i], cur[15 - i]);
                bitonic_merge16_desc(top, CED());
            }
        }
        float sv[16]; int id[16];
#pragma unroll
        for (int i = 0; i < 16; ++i) { const unsigned long long bits = __builtin_bit_cast(unsigned long long, top[i]); const unsigned lo = (unsigned)(bits & 0x3fffull);
            id[i] = (int)((bits >> 63) ? lo : 16383u - lo); sv[i] = (float)top[i]; }
        float den = 0.f, ex[16];
#pragma unroll
        for (int i = 0; i < 16; ++i) { ex[i] = __expf(sv[i] - sv[0]); den += ex[i]; }
        const float inv = 1.f / den;
        unsigned cw[4] = {0u, 0u, 0u, 0u};
#pragma unroll
        for (int i = 0; i < 16; ++i) { const unsigned s = (unsigned)id[i] >> PEER_SLICE_SHIFT, inc = 1u << (8 * (s & 3)), ws_ = s >> 2;
            cw[0] += ws_ == 0 ? inc : 0u; cw[1] += ws_ == 1 ? inc : 0u; cw[2] += ws_ == 2 ? inc : 0u; cw[3] += ws_ == 3 ? inc : 0u; }
        unsigned lp[4], tot[4], st[4];
        const int l8 = c.lane & 7;
#pragma unroll
        for (int k = 0; k < 4; ++k) { unsigned v = cw[k];
#pragma unroll
            for (int o = 1; o < 8; o <<= 1) { const unsigned y = __shfl_up(v, o, 8); v += (l8 >= o) ? y : 0u; }
            tot[k] = __shfl(v, 7, 8); lp[k] = v - cw[k]; }
        {   unsigned carry = 0u;
#pragma unroll
            for (int k = 0; k < 4; ++k) { st[k] = tot[k] * 0x01010100u + carry * 0x01010101u; carry += (tot[k] * 0x01010101u) >> 24; } }
        unsigned run[4] = {st[0] + lp[0], st[1] + lp[1], st[2] + lp[2], st[3] + lp[3]};
        const size_t tok = (size_t)(it >> 3);
#pragma unroll
        for (int i = 0; i < 16; ++i) { const unsigned s = (unsigned)id[i] >> PEER_SLICE_SHIFT, sh = 8 * (s & 3), ws_ = s >> 2, inc = 1u << sh;
            const unsigned wsel = ws_ == 0 ? run[0] : (ws_ == 1 ? run[1] : (ws_ == 2 ? run[2] : run[3]));
            const unsigned pos = (wsel >> sh) & 0xffu;
            run[0] += ws_ == 0 ? inc : 0u; run[1] += ws_ == 1 ? inc : 0u; run[2] += ws_ == 2 ? inc : 0u; run[3] += ws_ == 3 ? inc : 0u;
            IDX[tok * 128 + pos] = id[i]; GATE[tok * 128 + pos] = ex[i] * inv; }
        if (l8 == 0) ((v4u*)(ws + WS_OV + OV_POFF))[tok] = (v4u){st[0], st[1], st[2], st[3]};
    }
}

__device__ __forceinline__ float gelu_tanh(float x) { const float u = 0.7978845608f * (x + 0.044715f * x * x * x); const float t = 1.f - 2.f / (1.f + __expf(2.f * u)); return 0.5f * x * (1.f + t); }
__device__ __forceinline__ void unpack16_fp8(const v4u& q, float (&o)[16]) {
    const unsigned w[4] = {q.x, q.y, q.z, q.w};
#pragma unroll
    for (int i = 0; i < 4; ++i) { const f32x2 lo = __builtin_amdgcn_cvt_pk_f32_fp8((int)w[i], false), hi = __builtin_amdgcn_cvt_pk_f32_fp8((int)w[i], true);
        o[4 * i] = lo.x; o[4 * i + 1] = lo.y; o[4 * i + 2] = hi.x; o[4 * i + 3] = hi.y; }
}
__device__ __forceinline__ int slice_start(unsigned o0, unsigned o1, unsigned o2, unsigned o3, int s) {
    const unsigned wsel = s < 4 ? o0 : (s < 8 ? o1 : (s < 12 ? o2 : o3));
    return s >= PEER_NSLICE ? 128 : (int)((wsel >> (8 * (s & 3))) & 0xffu);
}
template <int MODE> __device__ __forceinline__ void phase_peer_down(const Ctx& c, KArgs& a, int l, int qset) {
    unsigned char* ws = a.ws;
    const unsigned char* U8 = ws + WS_OV + OV_U8; const float* XS = (const float*)(ws + WS_OV + OV_XS);
    const unsigned char* DN = ws + WS_OV + OV_DOWN;
    const int* IDX = (const int*)(ws + WS_OV + OV_IDX);
    const v4u* POFF = (const v4u*)(ws + WS_OV + OV_POFF);
    float* ACT = (float*)(ws + WS_OV + (qset ? 278 * MiB : OV_ACT));
    unsigned* QC = (unsigned*)(ws + WS_CTL) + CW_QUEUE + (qset * 2 + l) * PEER_NSLICE * 64;
    constexpr int RS = 528;
    LAS unsigned char* wb = c.lds + c.wave * (8192 + 16 * RS);
    LAS unsigned* lpk = (LAS unsigned*)wb;
    LAS unsigned char* RB = wb + 8192;
    const int lane = c.lane, r16 = lane & 15, q = lane >> 4, hsel = lane >> 5, l32 = lane & 31;
    constexpr int NBLK = M / 16;
    const int s = c.bid & (PEER_NSLICE - 1);
    const int nrank = ((c.G - s + PEER_NSLICE - 1) >> 3) * 8, rank = (c.bid >> 3) * 8 + c.wave;
    {
#pragma unroll 1
        for (int blk = rank; blk < NBLK; blk += nrank) {
            const size_t mb = (size_t)blk * 16;
            v4u xb[16];
            { const unsigned char* xp = U8 + (mb + r16) * D + 16 * q;
#pragma unroll
              for (int j = 0; j < 16; ++j) xb[j] = *(const v4u*)(xp + 64 * j); }
            const float xs = XS[mb + r16];
            int pav = 0, nv = 0;
            if (lane < 16) { const v4u po = POFF[mb + lane]; pav = slice_start(po.x, po.y, po.z, po.w, s); nv = slice_start(po.x, po.y, po.z, po.w, s + 1) - pav; }
            int incl = nv;
#pragma unroll
            for (int o = 1; o < 16; o <<= 1) { const int y = __shfl_up(incl, o, 16); incl += (r16 >= o) ? y : 0; }
            const int offv = incl - nv;
            const int P = __builtin_amdgcn_readlane(incl, 15);
            {
                int idr[16];
#pragma unroll
                for (int ti = 0; ti < 16; ++ti) { const int pa = __builtin_amdgcn_readlane(pav, ti); const int e = pa + lane; idr[ti] = IDX[(mb + ti) * 128 + (e < 127 ? e : 127)]; }
#pragma unroll
                for (int ti = 0; ti < 16; ++ti) { const int pa = __builtin_amdgcn_readlane(pav, ti), n = __builtin_amdgcn_readlane(nv, ti), off = __builtin_amdgcn_readlane(offv, ti);
                    if (lane < n) lpk[off + lane] = (unsigned)idr[ti] | ((unsigned)ti << 14) | ((unsigned)(pa + lane) << 18); }
                if (__builtin_amdgcn_ballot_w64(nv > 64) != 0ull) {
#pragma unroll 1
                    for (int ti = 0; ti < 16; ++ti) { const int pa = __builtin_amdgcn_readlane(pav, ti), n = __builtin_amdgcn_readlane(nv, ti), off = __builtin_amdgcn_readlane(offv, ti);
                        if (lane + 64 < n) lpk[off + 64 + lane] = (unsigned)IDX[(mb + ti) * 128 + pa + 64 + lane] | ((unsigned)ti << 14) | ((unsigned)(pa + 64 + lane) << 18); }
                }
            }
            asm volatile("s_waitcnt vmcnt(0) lgkmcnt(0)" ::: "memory");
            const int nb = (P + 15) >> 4;
#define PD_IDS(PW, B) { const v4u ia = *(const LAS v4u*)(lpk + (B) * 16 + 8 * hsel), ib = *(const LAS v4u*)(lpk + (B) * 16 + 8 * hsel + 4); \
                PW[0] = ia.x; PW[1] = ia.y; PW[2] = ia.z; PW[3] = ia.w; PW[4] = ib.x; PW[5] = ib.y; PW[6] = ib.z; PW[7] = ib.w; }
#define PD_LOADH(PW, H) { _Pragma("unroll") for (int i = 0; i < 8; ++i) { const unsigned id = MODE == 1 ? (PW[i] & 63u) : (PW[i] & 16383u); \
                    rr[8 * (H) + i] = *(const v4u*)(DN + (size_t)(id * 1024u + 512u * (H) + 16u * l32)); } }
            if (nb > 0) {
                v4u rr[16];
                { unsigned pw[8]; PD_IDS(pw, 0) PD_LOADH(pw, 0) PD_LOADH(pw, 1) }
#pragma unroll 1
                for (int b = 0; b < nb; ++b) {
                    const int bn = b + 1 < nb ? b + 1 : b;
                    unsigned pwn[8]; PD_IDS(pwn, bn)
                    const v4u mt = *(const LAS v4u*)(lpk + b * 16 + 4 * q);
                    f32x4 acc0 = {0.f, 0.f, 0.f, 0.f}, acc1 = {0.f, 0.f, 0.f, 0.f};
#pragma unroll
                    for (int h = 0; h < 2; ++h) {
#pragma unroll
                        for (int i = 0; i < 8; ++i) *(LAS v4u*)(RB + (8 * hsel + i) * RS + 16 * l32) = rr[8 * h + i];
                        PD_LOADH(pwn, h)
#pragma unroll
                        for (int jj = 0; jj < 8; ++jj) {
                            const v4u av = *(const LAS v4u*)(RB + r16 * RS + 64 * jj + 16 * q);
                            const v4u bv = xb[8 * h + jj];
                            const long a0 = (long)(((unsigned long long)av.y << 32) | av.x), a1 = (long)(((unsigned long long)av.w << 32) | av.z);
                            const long b0 = (long)(((unsigned long long)bv.y << 32) | bv.x), b1 = (long)(((unsigned long long)bv.w << 32) | bv.z);
                            acc0 = __builtin_amdgcn_mfma_f32_16x16x32_fp8_fp8(a0, b0, acc0, 0, 0, 0);
                            acc1 = __builtin_amdgcn_mfma_f32_16x16x32_fp8_fp8(a1, b1, acc1, 0, 0, 0);
                        }
                    }
                    const f32x4 dv = (acc0 + acc1) * xs;
                    const unsigned me[4] = {mt.x, mt.y, mt.z, mt.w};
                    const float dd[4] = {dv.x, dv.y, dv.z, dv.w};
#pragma unroll
                    for (int i = 0; i < 4; ++i) if (b * 16 + 4 * q + i < P && (int)((me[i] >> 14) & 15u) == r16) lpk[b * 16 + 4 * q + i] = __builtin_bit_cast(unsigned, dd[i]);
                }
            }
#pragma unroll
            for (int ti = 0; ti < 16; ++ti) { const int pa = __builtin_amdgcn_readlane(pav, ti), n = __builtin_amdgcn_readlane(nv, ti), off = __builtin_amdgcn_readlane(offv, ti);
                if (lane < n) ACT[(mb + ti) * 128 + pa + lane] = __builtin_bit_cast(float, lpk[off + lane]); }
            if (__builtin_amdgcn_ballot_w64(nv > 64) != 0ull) {
#pragma unroll 1
                for (int ti = 0; ti < 16; ++ti) { const int pa = __builtin_amdgcn_readlane(pav, ti), n = __builtin_amdgcn_readlane(nv, ti), off = __builtin_amdgcn_readlane(offv, ti);
                    if (lane + 64 < n) ACT[(mb + ti) * 128 + pa + 64 + lane] = __builtin_bit_cast(float, lpk[off + 64 + lane]); }
            }
        }
    }
}

template <int FUSE> __device__ __forceinline__ void phase_peer_experts(const Ctx& c, KArgs& a, const float* gnext, const bool commit = true) {
    unsigned char* ws = a.ws;
    const unsigned char* UP = ws + WS_OV + OV_UP;
    const float* SCD = (const float*)(ws + WS_OV + OV_PSCALE); const float* SCU = SCD + NEXP;
    const int* IDX = (const int*)(ws + WS_OV + OV_IDX); const float* GATE = (const float*)(ws + WS_OV + OV_GATE);
    const float* ACT = (const float*)(ws + WS_OV + OV_ACT);
    float* H = a.out;
    constexpr int TPW = 16, RS = 144;
    LAS unsigned char* wb = c.lds + c.wave * 16384;
    LAS int* idw = (LAS int*)wb;
    LAS unsigned char* wq8 = wb + 8192;
    LAS unsigned char* tile = wb + 10240;
    LAS float* swl = (LAS float*)(wb + 10240 + 32 * RS);
    const int lane = c.lane, r16 = lane & 15, q = lane >> 4, g8 = lane >> 3, c8 = lane & 7;
    const int gw = c.bid * 8 + c.wave, NGW = c.G * 8;
    const unsigned tr_addr = (unsigned)(size_t)(tile + (8 * q + (r16 >> 1)) * RS + 8 * (r16 & 1));
    for (int m0 = gw; m0 < M; m0 += NGW * TPW) {
#pragma unroll 1
        for (int ti = 0; ti < TPW; ++ti) {
            const int m = m0 + ti * NGW;
            float w0 = 0.f, w1 = 0.f; int id0 = 0, id1 = 0;
            if (m < M) {
                id0 = IDX[(size_t)m * 128 + lane]; id1 = IDX[(size_t)m * 128 + 64 + lane];
                const float g0 = GATE[(size_t)m * 128 + lane], g1 = GATE[(size_t)m * 128 + 64 + lane];
                const float a0 = ACT[(size_t)m * 128 + lane], a1 = ACT[(size_t)m * 128 + 64 + lane];
                w0 = g0 * gelu_tanh(a0 * SCD[id0]) * SCU[id0]; w1 = g1 * gelu_tanh(a1 * SCD[id1]) * SCU[id1];
            }
            float am = fmaxf(fabsf(w0), fabsf(w1));
#pragma unroll
            for (int o = 1; o < 64; o <<= 1) am = fmaxf(am, __shfl_xor(am, o));
            am = fmaxf(am, 1e-30f);
            const float qs = 384.f / am;
            const int pk = __builtin_amdgcn_cvt_pk_fp8_f32(w0 * qs, w1 * qs, 0, false);
            wq8[ti * 128 + lane] = (unsigned char)(pk & 0xff); wq8[ti * 128 + 64 + lane] = (unsigned char)((pk >> 8) & 0xff);
            idw[ti * 128 + lane] = id0; idw[ti * 128 + 64 + lane] = id1;
            if (lane == 0) swl[ti] = am * (1.f / 384.f);
        }
        asm volatile("s_waitcnt lgkmcnt(0)" ::: "memory");
        const f32x4 iscv = *(const LAS f32x4*)(swl + 4 * q);
        const float isc[4] = {iscv.x, iscv.y, iscv.z, iscv.w};
        float ssq[4] = {0.f, 0.f, 0.f, 0.f};
#define UPM_W(T4) { _Pragma("unroll") for (int i = 0; i < 4; ++i) *(LAS v4u*)(tile + (4 * g8 + i) * RS + 16 * c8) = rr[4 * (T4) + i]; }
#define UPM_LK(T4, TIN) { if ((TIN) < TPW) { const v4u i4 = *(const LAS v4u*)(idw + (TIN) * 128 + 32 * (T4) + 4 * g8); \
            rr[4 * (T4) + 0] = *(const v4u*)(UPc + (size_t)(i4.x * 1024u)); rr[4 * (T4) + 1] = *(const v4u*)(UPc + (size_t)(i4.y * 1024u)); \
            rr[4 * (T4) + 2] = *(const v4u*)(UPc + (size_t)(i4.z * 1024u)); rr[4 * (T4) + 3] = *(const v4u*)(UPc + (size_t)(i4.w * 1024u)); } }
#define UPM_R(B) asm volatile("ds_read_b64_tr_b8 %0, %8\n\tds_read_b64_tr_b8 %1, %8 offset:16\n\tds_read_b64_tr_b8 %2, %8 offset:32\n\tds_read_b64_tr_b8 %3, %8 offset:48\n\t" \
                         "ds_read_b64_tr_b8 %4, %8 offset:64\n\tds_read_b64_tr_b8 %5, %8 offset:80\n\tds_read_b64_tr_b8 %6, %8 offset:96\n\tds_read_b64_tr_b8 %7, %8 offset:112" \
                         : "=&v"(B[0]), "=&v"(B[1]), "=&v"(B[2]), "=&v"(B[3]), "=&v"(B[4]), "=&v"(B[5]), "=&v"(B[6]), "=&v"(B[7]) : "v"(tr_addr) : "memory")
#define UPM_WAIT(B) asm volatile("s_waitcnt lgkmcnt(0)" : "+v"(B[0]), "+v"(B[1]), "+v"(B[2]), "+v"(B[3]), "+v"(B[4]), "+v"(B[5]), "+v"(B[6]), "+v"(B[7]) :: "memory")
#define UPM_M(B, TI, T4) { v2u wa = *(const LAS v2u*)(wq8 + (TI) * 128 + 32 * (T4) + 8 * q); if (r16 != (TI)) { wa.x = 0u; wa.y = 0u; } \
            const long wal = (long)(((unsigned long long)wa.y << 32) | wa.x); \
            _Pragma("unroll") for (int ct = 0; ct < 8; ++ct) acc[ct] = __builtin_amdgcn_mfma_f32_16x16x32_fp8_fp8(wal, B[ct], acc[ct], 0, 0, 0); }
#define UPM_STEP(BC, BN, J, T4W, TINW, T4M) { if (s0 + (J) + 1 < 4 * TPW) UPM_R(BN); if (s0 + (J) + 2 < 4 * TPW) { UPM_W(T4W) UPM_LK(T4W, TINW) } UPM_M(BC, ti, T4M) UPM_WAIT(BN); }
#pragma unroll 1
        for (int cq = 0; cq < 8; ++cq) {
            const unsigned char* UPc = UP + 128 * cq + 16 * c8;
            f32x4 acc[8];
#pragma unroll
            for (int ct = 0; ct < 8; ++ct) acc[ct] = (f32x4){0.f, 0.f, 0.f, 0.f};
            {
                v4u rr[16]; long bA[8], bB[8];
                UPM_LK(0, 0) UPM_LK(1, 0) UPM_LK(2, 0) UPM_LK(3, 0)
                UPM_W(0) UPM_LK(0, 1) UPM_R(bA); UPM_WAIT(bA); UPM_W(1) UPM_LK(1, 1)
#pragma unroll 1
                for (int ti = 0; ti < TPW; ++ti) {
                    const int s0 = 4 * ti;
                    UPM_STEP(bA, bB, 0, 2, ti + 1, 0)
                    UPM_STEP(bB, bA, 1, 3, ti + 1, 1)
                    UPM_STEP(bA, bB, 2, 0, ti + 2, 2)
                    UPM_STEP(bB, bA, 3, 1, ti + 2, 3)
                }
            }
            if (!commit) { if (acc[0].x != 123456.789f) continue; }
            {
                float hv[4][8];
#pragma unroll
                for (int i = 0; i < 4; ++i) { const int m = m0 + (4 * q + i) * NGW; const float* hp = H + (size_t)(m < M ? m : 0) * D + 128 * cq + r16;
#pragma unroll
                    for (int ct = 0; ct < 8; ++ct) hv[i][ct] = hp[16 * ct]; }
#pragma unroll
                for (int i = 0; i < 4; ++i) { const int m = m0 + (4 * q + i) * NGW; float* hp = H + (size_t)(m < M ? m : 0) * D + 128 * cq + r16;
#pragma unroll
                    for (int ct = 0; ct < 8; ++ct) { const float d = i == 0 ? acc[ct].x : (i == 1 ? acc[ct].y : (i == 2 ? acc[ct].z : acc[ct].w)); hv[i][ct] += d * isc[i]; ssq[i] += hv[i][ct] * hv[i][ct]; }
                    if (m < M) {
#pragma unroll
                        for (int ct = 0; ct < 8; ++ct) hp[16 * ct] = hv[i][ct]; } }
            }
        }
        if (!commit) continue;
#pragma unroll
        for (int i = 0; i < 4; ++i) { float s = ssq[i]; s += __shfl_xor(s, 1); s += __shfl_xor(s, 2); s += __shfl_xor(s, 4); s += __shfl_xor(s, 8); ssq[i] = s; }
        asm volatile("s_waitcnt vmcnt(0)" ::: "memory");
        const f32x4 gn0 = *(const f32x4*)(gnext + lane * 16), gn1 = *(const f32x4*)(gnext + lane * 16 + 4), gn2 = *(const f32x4*)(gnext + lane * 16 + 8), gn3 = *(const f32x4*)(gnext + lane * 16 + 12);
#pragma unroll
        for (int i = 0; i < 4; ++i)
#pragma unroll 1
            for (int qv = 0; qv < 4; ++qv) {
                const int ti = 4 * qv + i, m = m0 + ti * NGW; if (m >= M) continue;
                const float ss = __builtin_bit_cast(float, __builtin_amdgcn_readlane(__builtin_bit_cast(int, ssq[i]), qv * 16));
                const float rn = rsqrtf(ss * (1.f / D) + 1e-6f);
                f32x4* hp = (f32x4*)(H + (size_t)m * D + lane * 16);
                const f32x4 h0 = hp[0], h1 = hp[1], h2 = hp[2], h3 = hp[3];
                const f32x4 n0 = h0 * rn * gn0, n1 = h1 * rn * gn1, n2 = h2 * rn * gn2, n3 = h3 * rn * gn3;
                if (FUSE == 0) {
                    float am = fmaxf(fmaxf(fmaxf(fmaxf(fabsf(n0.x), fabsf(n0.y)), fmaxf(fabsf(n0.z), fabsf(n0.w))), fmaxf(fmaxf(fabsf(n1.x), fabsf(n1.y)), fmaxf(fabsf(n1.z), fabsf(n1.w)))),
                                     fmaxf(fmaxf(fmaxf(fabsf(n2.x), fabsf(n2.y)), fmaxf(fabsf(n2.z), fabsf(n2.w))), fmaxf(fmaxf(fabsf(n3.x), fabsf(n3.y)), fmaxf(fabsf(n3.z), fabsf(n3.w)))));
#pragma unroll
                    for (int o = 1; o < 64; o <<= 1) am = fmaxf(am, __shfl_xor(am, o));
                    am = fmaxf(am, 1e-30f);
                    const float qs = 384.f / am;
                    v4u u8; int w8;
                    w8 = __builtin_amdgcn_cvt_pk_fp8_f32(n0.x * qs, n0.y * qs, 0, false); w8 = __builtin_amdgcn_cvt_pk_fp8_f32(n0.z * qs, n0.w * qs, w8, true); u8.x = (unsigned)w8;
                    w8 = __builtin_amdgcn_cvt_pk_fp8_f32(n1.x * qs, n1.y * qs, 0, false); w8 = __builtin_amdgcn_cvt_pk_fp8_f32(n1.z * qs, n1.w * qs, w8, true); u8.y = (unsigned)w8;
                    w8 = __builtin_amdgcn_cvt_pk_fp8_f32(n2.x * qs, n2.y * qs, 0, false); w8 = __builtin_amdgcn_cvt_pk_fp8_f32(n2.z * qs, n2.w * qs, w8, true); u8.z = (unsigned)w8;
                    w8 = __builtin_amdgcn_cvt_pk_fp8_f32(n3.x * qs, n3.y * qs, 0, false); w8 = __builtin_amdgcn_cvt_pk_fp8_f32(n3.z * qs, n3.w * qs, w8, true); u8.w = (unsigned)w8;
                    *(v4u*)(ws + WS_U + (size_t)m * D + lane * 16) = u8;
                    if (lane == 0) ((float*)(ws + WS_U + U8IN_XS))[m] = am * (1.f / 384.f);
                } else { hp[0] = n0; hp[1] = n1; hp[2] = n2; hp[3] = n3; }
            }
    }
}

constexpr int PH_PER_HALF = 11, PH_PER_LAYER = 1 + 2 * PH_PER_HALF + 5, N_PHASES = 1 + DEPTH * PH_PER_LAYER;
__device__ __forceinline__ Ctx make_ctx() {
    extern __shared__ __attribute__((aligned(16))) unsigned char lds_raw[];
    Ctx c; int t = threadIdx.x; asm volatile("" : "+v"(t)); c.lds = (LAS unsigned char*)lds_raw; c.tid = t; c.lane = t & 63; c.wave = __builtin_amdgcn_readfirstlane(t >> 6); c.G = gridDim.x; c.bid = blockIdx.x; return c; }
__device__ __forceinline__ KArgs* kargs_fresh() { KArgs* p = (KArgs*)__builtin_amdgcn_kernarg_segment_ptr(); asm volatile("" : "+s"(p)); return p; }
#define PH_BEGIN(K) if (lo <= (K) && (K) < hi) { const Ctx c = make_ctx(); KArgs& args = *kargs_fresh(); unsigned char* ws = args.ws; (void)ws;
#define PH_END(K)   if ((K) + 1 < hi) xcd_barrier(bar); }

template <int L, int HB> __device__ __forceinline__ void half_pass(const XcdBarrier& bar, const int lo, const int hi) {
    constexpr int P0 = 1 + L * PH_PER_LAYER + 1 + HB * PH_PER_HALF;
#define WIN ((const bf16*)(ws + WS_WIN + L * WIN8_L))
#define KP 512
#define XSh ((const float*)(ws + WS_U + U8IN_XS) + (size_t)HB * MH)
#define WSC ((const float*)(ws + WS_CTL) + CW_WSC + L)
#define Uh ((const bf16*)(ws + WS_U) + (size_t)HB * MH * KP)
    PH_BEGIN(P0 + 0) {
        pg8::Gemm g{Uh, WIN, MH, N1P, KP, KP, 0}; pg8::StaticOrder S; S.init(MH, N1P, c.G, c.bid);
        pg8::EpiRow8<FStoreBf16S> E{{(bf16*)(ws + WS_OV + OV_PR), N1P, XSh, WSC}};
        pg8::gemm_phase(c.lds, g, S, E); if (PROBE_DUP == 5) pg8::gemm_phase(c.lds, g, S, E); } PH_END(P0 + 0)
    PH_BEGIN(P0 + 1) if (PROBE_DUP == 6) phase_rwkv_prep(c, args, L, HB); phase_rwkv_prep(c, args, L, HB); PH_END(P0 + 1)
    PH_BEGIN(P0 + 2) {
        constexpr int NL = L == 0 ? 3072 : 4096;
        pg8::Gemm g{(const bf16*)(ws + WS_OV + OV_AL), (const bf16*)(ws + WS_WLORA + L * WLORA_L), MH, NL, KL, KL, 1}; pg8::StaticOrder S; S.init(MH, NL, c.G, c.bid);
        EpiLora E{(bf16*)(ws + WS_OV + OV_ELOG), (bf16*)(ws + WS_OV + OV_ASIG), (bf16*)(ws + WS_OV + OV_GG), (bf16*)(ws + WS_OV + OV_VMIX),
                               (const bf16*)(ws + WS_VF) + (size_t)HB * MH * D, args.in[I_W0] + (size_t)L * D, args.in[I_A0] + (size_t)L * D, args.in[I_V0]};
        pg8::gemm_phase(c.lds, g, S, E); } PH_END(P0 + 2)
    PH_BEGIN(P0 + 3) phase_rwkv_chunk_par(c, args, L, HB); PH_END(P0 + 3)
    PH_BEGIN(P0 + 4) if (PROBE_DUP == 8) phase_rwkv_chunk_seq(c, args, false); phase_rwkv_chunk_seq(c, args); PH_END(P0 + 4)
    PH_BEGIN(P0 + 5) {
        phase_rwkv_post(c, args, L, HB); __syncthreads();
        pg8::Gemm g{Uh, WIN + (size_t)N1P * KP, MH, N2P, KP, KP, 0}; pg8::StaticOrder S; S.init(MH, N2P, c.G, c.bid);
        pg8::EpiRow8<FStoreBf16S> E{{(bf16*)(ws + WS_OV + OV_PS), N2P, XSh, WSC}};
        pg8::gemm_phase(c.lds, g, S, E); if (PROBE_DUP == 5) pg8::gemm_phase(c.lds, g, S, E); } PH_END(P0 + 5)
    PH_BEGIN(P0 + 6) if (PROBE_DUP == 6) phase_ssd_conv(c, args, L); phase_ssd_conv(c, args, L); PH_END(P0 + 6)
    PH_BEGIN(P0 + 7) phase_ssd_scan(c, args, L); PH_END(P0 + 7)
    PH_BEGIN(P0 + 8) phase_ssd_post(c, args, L); PH_END(P0 + 8)
    PH_BEGIN(P0 + 9) {
      { pg8::Gemm g{Uh, WIN + (size_t)(N1P + N2P) * KP, MH, D, KP, KP, 0}; pg8::StaticOrder S; S.init(MH, D, c.G, c.bid);
        pg8::EpiRow8<FSigmoidBf16S> E{{(bf16*)(ws + WS_OV + OV_GATES), 2048, XSh, WSC}};
        pg8::gemm_phase(c.lds, g, S, E); }
      { pg8::Gemm g{Uh, WIN + (size_t)(N1P + N2P + D) * KP, MH, D, KP, KP, 0}; pg8::StaticOrder S; S.init(MH, D, c.G, c.bid);
        pg8::EpiRow8<FSigmoidBf16S> E{{(bf16*)(ws + WS_OV + OV_GATES) + 1024, 2048, XSh, WSC}};
        pg8::gemm_phase(c.lds, g, S, E); }
      {
        pg8::Gemm g{(const bf16*)(ws + WS_OV + OV_YA), (const bf16*)(ws + WS_WA) + (size_t)L * D * D, MH, D, D, D, 0}; pg8::StaticOrder S; S.init(MH, D, c.G, c.bid);
        pg8::EpiRow8<FMixA> E{{(const bf16*)(ws + WS_OV + OV_GATES), (bf16*)(ws + WS_OV + OV_MIXED)}};
        pg8::gemm_phase(c.lds, g, S, E); }
      {
        pg8::Gemm g{(const bf16*)(ws + WS_OV + OV_PS) + 2048, (const bf16*)(ws + WS_WB) + (size_t)L * D * 2048, MH, D, 2048, N2P, 0}; pg8::StaticOrder S; S.init(MH, D, c.G, c.bid);
        pg8::EpiRow8<FMixB> E{{(const bf16*)(ws + WS_OV + OV_GATES), (bf16*)(ws + WS_OV + OV_MIXED)}};
        pg8::gemm_phase(c.lds, g, S, E); } } PH_END(P0 + 9)
    PH_BEGIN(P0 + 10) {
        pg8::Gemm g{(const bf16*)(ws + WS_OV + OV_MIXED), (const bf16*)(ws + WS_WO) + (size_t)L * D * D, MH, D, D, D, 0}; pg8::StaticOrder S; S.init(MH, D, c.G, c.bid);
        pg8::EpiRow8<FResid> E{{(L == 0 ? args.in[I_X] : (const float*)args.out) + (size_t)HB * MH * D, args.out + (size_t)HB * MH * D}};
        pg8::gemm_phase(c.lds, g, S, E); } PH_END(P0 + 10)
#undef WIN
#undef KP
#undef XSh
#undef WSC
#undef Uh
}

template <int L> __device__ __forceinline__ void layer_pass(const XcdBarrier& bar, const int lo, const int hi) {
    constexpr int P0 = 1 + L * PH_PER_LAYER, P1 = P0 + 1 + 2 * PH_PER_HALF;
    PH_BEGIN(P0) if (L == 0) phase_rmsnorm_q8(c, args.in[I_X], args.in[I_NMG], nullptr, ws + WS_U, (float*)(ws + WS_U + U8IN_XS)); PH_END(P0)
    half_pass<L, 0>(bar, lo, hi);
    half_pass<L, 1>(bar, lo, hi);
    PH_BEGIN(P1 + 0) phase_rmsnorm_q8(c, args.out, args.in[I_NFG] + (size_t)L * D, (bf16*)(ws + WS_U), ws + WS_OV + OV_U8, (float*)(ws + WS_OV + OV_XS)); phase_peer_convert(c, args, L); PH_END(P1 + 0)
    PH_BEGIN(P1 + 1) {
        pg8::Gemm g{(const bf16*)(ws + WS_U), (const bf16*)(ws + WS_WQK) + (size_t)L * 2048 * D, M, 2048, D, D, 0}; pg8::StaticOrder S; S.init(M, 2048, c.G, c.bid);
        pg8::EpiRow8<FStoreBf16> E{{(bf16*)(ws + WS_OV + OV_SC), 2048}};
        pg8::gemm_phase(c.lds, g, S, E); } PH_END(P1 + 1)
    PH_BEGIN(P1 + 2) if (PROBE_DUP == 4) phase_peer_topk(c, args); phase_peer_topk(c, args); PH_END(P1 + 2)
    PH_BEGIN(P1 + 3) phase_peer_down<0>(c, args, L, 0); if (PROBE_DOWN >= 0) phase_peer_down<PROBE_DOWN < 0 ? 0 : PROBE_DOWN>(c, args, L, 1); PH_END(P1 + 3)
    PH_BEGIN(P1 + 4) phase_peer_experts<L == DEPTH - 1 ? 1 : 0>(c, args, L == DEPTH - 1 ? args.in[I_NFIN] : args.in[I_NMG] + (size_t)(L + 1) * D); PH_END(P1 + 4)
}

__global__ void __launch_bounds__(512, 2) mk_fwd(Args kargs_) {
    extern __shared__ __attribute__((aligned(16))) unsigned char lds_raw[];
    LAS unsigned char* lds0 = (LAS unsigned char*)lds_raw;
    unsigned char* ws0 = kargs_.ws;
    const int lo = kargs_.lo, hi = kargs_.hi;
    if (threadIdx.x < 4) ((LAS unsigned*)(lds0 + LDS_MISC))[threadIdx.x] = 0u;
    __syncthreads();
    XcdBarrier bar; bar.bar = (unsigned*)(ws0 + WS_CTL) + CW_BAR; bar.x = 0; bar.st = (volatile LAS unsigned*)(lds0 + LDS_MISC);
    if (hi - lo > 1) bar = xcd_barrier_post((unsigned*)(ws0 + WS_CTL) + CW_BAR, (volatile LAS unsigned*)(lds0 + LDS_MISC));
    PH_BEGIN(0) phase_winmax(c, args); if (hi - lo > 1) xcd_barrier(bar); phase_prologue(c, args); PH_END(0)
    layer_pass<0>(bar, lo, hi);
    layer_pass<1>(bar, lo, hi);
}

extern "C" void kernel_launch(void* const* d_in, const int* in_sizes, int n_in, void* d_out, int out_size, void* d_ws, size_t ws_size, hipStream_t stream) {
    static int grid = 0;
    if (grid == 0) {
        if (n_in != 32 || out_size != M * D || ws_size < WS_END) { fprintf(stderr, "kernel_launch: unexpected problem (n_in %d, out %d, ws %zu < %zu)\n", n_in, out_size, ws_size, (size_t)WS_END); grid = -1; return; }
        int dev = 0, cus = 0, per_cu = 0;
        if (hipGetDevice(&dev) != hipSuccess || hipDeviceGetAttribute(&cus, hipDeviceAttributeMultiprocessorCount, dev) != hipSuccess) { grid = -1; return; }
        if (hipFuncSetAttribute((const void*)mk_fwd, hipFuncAttributeMaxDynamicSharedMemorySize, LDS_BYTES) != hipSuccess) { fprintf(stderr, "kernel_launch: hipFuncSetAttribute failed\n"); grid = -1; return; }
        if (hipOccupancyMaxActiveBlocksPerMultiprocessor(&per_cu, (const void*)mk_fwd, 512, LDS_BYTES) != hipSuccess || per_cu < 1) { fprintf(stderr, "kernel_launch: occupancy query says %d\n", per_cu); per_cu = 1; }
        (void)hipGetLastError();
        grid = cus;
    }
    if (grid < 0) return;
    (void)hipMemsetAsync((char*)d_ws + WS_CTL, 0, CTL_BYTES, stream);
    Args a{};
    for (int i = 0; i < 32; ++i) a.in[i] = (const float*)d_in[i];
    a.out = (float*)d_out; a.ws = (unsigned char*)d_ws;
#if MK_MULTI
    for (int p = 0; p < N_PHASES; ++p) { a.lo = p; a.hi = p + 1; hipLaunchKernelGGL(mk_fwd, dim3(grid), dim3(512), LDS_BYTES, stream, a); }
#else
    a.lo = 0; a.hi = N_PHASES;
    hipLaunchKernelGGL(mk_fwd, dim3(grid), dim3(512), LDS_BYTES, stream, a);
#endif
}
```

```cpp
#include <hip/hip_runtime.h>
#include <cstdio>
#include <cstdint>

#ifndef PROBE_DUP
#define PROBE_DUP 0
#endif
#ifndef MK_MULTI
#define MK_MULTI 0
#endif

#define GAS __attribute__((address_space(1)))
#define LAS __attribute__((address_space(3)))
typedef unsigned short bf16;
typedef unsigned v4u __attribute__((ext_vector_type(4)));
typedef unsigned v2u __attribute__((ext_vector_type(2)));
typedef float f32x4 __attribute__((ext_vector_type(4)));
typedef float f32x2 __attribute__((ext_vector_type(2)));
typedef short bf16x8 __attribute__((ext_vector_type(8)));
typedef __bf16 bf2_t __attribute__((ext_vector_type(2)));

constexpr int D = 1024, BATCH = 8, T = 4096, M = BATCH * T, MH = M / 2, DEPTH = 2;
constexpr int RW_PROJ = 3360, SSD_PROJ = 5152, IN_PROJ = 10560;
constexpr int N1P = 3584, N2P = 5120, N3P = 2048, NINP = N1P + N2P + N3P;
constexpr int DT_COL = RW_PROJ;
constexpr int KL = 384;
constexpr int NEXP = 16384;
#ifndef PROBE_DOWN
#define PROBE_DOWN -1
#endif
constexpr int PEER_SLICE_SHIFT = 11, PEER_NSLICE = NEXP >> PEER_SLICE_SHIFT;
constexpr int CW_WMAX = 12288, CW_WSC = 12304;
constexpr int CW_QUEUE = 8192;

constexpr size_t MiB = 1u << 20;
constexpr size_t WS_CTL = 0, CTL_BYTES = 1 * MiB;
constexpr size_t WS_WIN = 1 * MiB;
constexpr size_t WIN_L = (size_t)NINP * D * 2;
constexpr size_t WIN8_L = (size_t)NINP * D;
constexpr size_t U8IN_XS = 33 * MiB;
constexpr size_t WS_WA = 44 * MiB;
constexpr size_t WS_WB = 48 * MiB;
constexpr size_t WS_WO = 56 * MiB;
constexpr size_t WS_WQK = 60 * MiB;
constexpr size_t WS_WLORA = 68 * MiB;
constexpr size_t WLORA_L = (size_t)4096 * KL * 2;
constexpr size_t WS_U = 74 * MiB;
constexpr size_t WS_VF = 138 * MiB;
constexpr size_t WS_OV = 202 * MiB;
constexpr size_t OV_PR = 0, OV_ELOG = 112 * MiB, OV_ASIG = 144 * MiB, OV_GG = 176 * MiB, OV_VMIX = 208 * MiB, OV_AL = 240 * MiB, OV_YA = 272 * MiB;
constexpr size_t OV_PS = 0, OV_XBC = 168 * MiB, OV_DT = 305 * MiB, OV_DA = 307 * MiB;
constexpr size_t OV_GATES = 168 * MiB, OV_MIXED = 232 * MiB;
constexpr size_t OV_DOWN = 0, OV_UP = 32 * MiB, OV_PSCALE = 48 * MiB  , OV_SC = 64 * MiB, OV_IDX = 192 * MiB, OV_GATE = 208 * MiB, OV_POFF = 224 * MiB  , OV_ACT = 226 * MiB  , OV_U8 = 244 * MiB  , OV_XS = 276 * MiB  ;
constexpr size_t OV_BON = 304 * MiB;
constexpr size_t WS_END = WS_OV + 309 * MiB;
static_assert(WS_WIN + 2 * WIN_L <= WS_WA, "map");

constexpr int LDS_BYTES = 147456;
constexpr int LDS_MISC = 145408;
constexpr int CW_BAR = 4096;

__device__ __forceinline__ unsigned f2bf(float f) { unsigned u = __builtin_bit_cast(unsigned, f); return (u + 0x7fffu + ((u >> 16) & 1u)) >> 16; }
__device__ __forceinline__ unsigned pk2(float lo, float hi) { unsigned r; asm volatile("v_cvt_pk_bf16_f32 %0, %1, %2" : "=v"(r) : "v"(lo), "v"(hi)); return r; }
typedef __bf16 bf16x2_t __attribute__((ext_vector_type(2)));
__device__ __forceinline__ unsigned pk2c(float lo, float hi) { bf16x2_t v; v.x = (__bf16)lo; v.y = (__bf16)hi; return __builtin_bit_cast(unsigned, v); }
__device__ __forceinline__ float bflo(unsigned u) { return __builtin_bit_cast(float, u << 16); }
__device__ __forceinline__ float bfhi(unsigned u) { return __builtin_bit_cast(float, u & 0xffff0000u); }
__device__ __forceinline__ float bf1(bf16 u) { return __builtin_bit_cast(float, ((unsigned)u) << 16); }
__device__ __forceinline__ float sigmoidf_(float x) { return 1.f / (1.f + __expf(-x)); }
__device__ __forceinline__ float siluf_(float x) { return x / (1.f + __expf(-x)); }
template <int CTRL> __device__ __forceinline__ float dpp_mov(float x) { return __int_as_float(__builtin_amdgcn_update_dpp(0, __float_as_int(x), CTRL, 0xF, 0xF, true)); }
__device__ __forceinline__ float sum4(float x) { x += dpp_mov<0xB1>(x); x += dpp_mov<0x4E>(x); return x; }
__device__ __forceinline__ float sum16(float x) { x += dpp_mov<0xB1>(x); x += dpp_mov<0x4E>(x); x += dpp_mov<0x141>(x); x += dpp_mov<0x140>(x); return x; }
__device__ __forceinline__ float sum64(float x) { x = sum16(x); x += __shfl_xor(x, 16); x += __shfl_xor(x, 32); return x; }
__device__ __forceinline__ void unpack8(const v4u& q, float (&o)[8]) { o[0] = bflo(q.x); o[1] = bfhi(q.x); o[2] = bflo(q.y); o[3] = bfhi(q.y); o[4] = bflo(q.z); o[5] = bfhi(q.z); o[6] = bflo(q.w); o[7] = bfhi(q.w); }
__device__ __forceinline__ v4u pack8(const float (&o)[8]) { v4u q; q.x = pk2(o[0], o[1]); q.y = pk2(o[2], o[3]); q.z = pk2(o[4], o[5]); q.w = pk2(o[6], o[7]); return q; }

typedef short s16x4 __attribute__((ext_vector_type(4)));
__device__ __forceinline__ void lds_barrier() { asm volatile("s_waitcnt lgkmcnt(0)\n\ts_barrier" ::: "memory"); }
__device__ __forceinline__ bf16x8 tr_frag(unsigned base_bytes, int stride, int k0, int c0, int lane) {
    const int i16 = lane & 15, qq = i16 >> 2, p = i16 & 3, q = lane >> 4;
    const unsigned a0 = base_bytes + (unsigned)(((k0 + 8 * q + qq) * stride + c0 + 4 * p) * 2), a1 = a0 + (unsigned)(8 * stride);
    s16x4 lo, hi;
    asm volatile("ds_read_b64_tr_b16 %0, %2\n\tds_read_b64_tr_b16 %1, %3\n\ts_waitcnt lgkmcnt(0)" : "=&v"(lo), "=&v"(hi) : "v"(a0), "v"(a1) : "memory");
    return __builtin_shufflevector(lo, hi, 0, 1, 2, 3, 4, 5, 6, 7);
}

namespace pg8 {
typedef int i32x4_t __attribute__((ext_vector_type(4)));
constexpr int BM = 256, BK = 64, HALF = 128, HTB = HALF * BK * 2, STAGE_BYTES = 8 * HTB, NXCD = 8, WGM = 8;
__host__ __device__ __forceinline__ int lds_byte(int r, int c) { const int st = (r >> 4) * 2 + (c >> 5), rr = r & 15, cc = c & 31, ob = rr * 64 + cc * 2; return st * 1024 + (ob ^ (((ob >> 9) & 1) << 5)); }
__host__ __device__ __forceinline__ void stage_rc(int b, int& R, int& C) { const int st = b / 1024, sb = b % 1024, swz = sb ^ (((sb >> 9) & 1) << 5); R = (st >> 1) * 16 + swz / 64; C = (st & 1) * 32 + (swz % 64) / 2; }
__host__ __device__ __forceinline__ int perm32(int rho) { const int n = rho >> 4, i = rho & 15; return 8 * (i >> 2) + 4 * n + (i & 3); }
struct Unit { int pm, pn; };
struct Gemm { const bf16* A; const bf16* Bt; int M, N, K, lda; int kwin; };
__device__ __forceinline__ void unit_kwin(const Gemm& g, const Unit& u, int& k0t, int& ntl) { k0t = 0; ntl = g.K / BK; if (g.kwin) { const int blk = u.pn >> 2; if (blk < 2) { k0t = 0; ntl = 2; } else if (blk == 2) { k0t = 2; ntl = 4; } else { k0t = 4; ntl = 2; } } }
struct StaticOrder {
    int nM, nN, nwg, G, c;
    __device__ void init(int M_, int N_, int G_, int c_) { nM = M_ / BM; nN = N_ / BM; nwg = nM * nN; G = G_; c = c_; }
    __device__ bool next(int i, Unit& u) const {
        const long L = (long)i * G + c; if (L >= nwg) return false;
        int wgid = (int)L; { const int q = nwg / NXCD, r = nwg % NXCD, xcd = wgid % NXCD, off = wgid / NXCD; wgid = (xcd < r ? xcd * (q + 1) : r * (q + 1) + (xcd - r) * q) + off; }
        const int nig = WGM * nN, gid = wgid / nig, fm = gid * WGM, gsz = (nM - fm) < WGM ? (nM - fm) : WGM;
        u.pm = fm + ((wgid % nig) % gsz); u.pn = (wgid % nig) / gsz; return true;
    }
};
template <class F> struct EpiRow8 {
    static constexpr bool PERM = true;
    F f;
    __device__ __forceinline__ void operator()(const f32x4 (&acc)[2][2][4][2], const Unit& u, int wr, int wc, int fr, int fq) const {
        const int row0 = u.pm * BM + wr * 64 + fr, col0 = u.pn * BM + wc * 32 + 8 * fq;
#pragma unroll
        for (int g0 = 0; g0 < 16; g0 += F::GRP) {
            typename F::Tmp t[F::GRP];
#pragma unroll
            for (int j = 0; j < F::GRP; ++j) { const int i = g0 + j, ai = i >> 3, m = (i >> 1) & 3, bj = i & 1; f.load(row0 + ai * HALF + m * 16, col0 + bj * HALF, u.pn, t[j]); }
#pragma unroll
            for (int j = 0; j < F::GRP; ++j) { const int i = g0 + j, ai = i >> 3, m = (i >> 1) & 3, bj = i & 1; f.apply(row0 + ai * HALF + m * 16, col0 + bj * HALF, acc[ai][bj][m][0], acc[ai][bj][m][1], u.pn, t[j]); }
        }
    }
};


typedef int i32x8 __attribute__((ext_vector_type(8)));
template <class E> struct epi_f8 { static constexpr bool v = false; };
struct FragB16 { bf16x8 k[2]; };
template <bool F8> struct FragT { typedef FragB16 T; };
template <> struct FragT<true> { typedef i32x8 T; };
__device__ __forceinline__ void ld_frag(FragB16& d, const LAS unsigned char* p) { d.k[0] = *(const LAS bf16x8*)p; d.k[1] = *(const LAS bf16x8*)(p + 1024); }
__device__ __forceinline__ void ld_frag(i32x8& d, const LAS unsigned char* p) { const i32x4_t lo = *(const LAS i32x4_t*)p, hi = *(const LAS i32x4_t*)(p + 1024); d = __builtin_shufflevector(lo, hi, 0, 1, 2, 3, 4, 5, 6, 7); }
__device__ __forceinline__ void mma_frag(f32x4& acc, const FragB16& b, const FragB16& a) { acc = __builtin_amdgcn_mfma_f32_16x16x32_bf16(b.k[0], a.k[0], acc, 0, 0, 0); acc = __builtin_amdgcn_mfma_f32_16x16x32_bf16(b.k[1], a.k[1], acc, 0, 0, 0); }
__device__ __forceinline__ void lda_group(FragB16 (&At)[4], const LAS unsigned char* ab) {
#pragma unroll
    for (int m = 0; m < 4; ++m) ld_frag(At[m], ab + m * 2048); }
__device__ __forceinline__ void lda_group(i32x8 (&At)[4], const LAS unsigned char* ab) { ld_frag(At[0], ab); ld_frag(At[1], ab + 2048); ld_frag(At[2], ab + 2 * 2048); }
__device__ __forceinline__ void lda_again(FragB16 (&)[4], const LAS unsigned char*) {}
__device__ __forceinline__ void lda_again(i32x8 (&At)[4], const LAS unsigned char* ab) { ld_frag(At[0], ab); ld_frag(At[1], ab + 2048); ld_frag(At[2], ab + 2 * 2048); }
__device__ __forceinline__ void mma_frag(f32x4& acc, const i32x8& b, const i32x8& a);
__device__ __forceinline__ void mma_frag(f32x4& acc, const FragB16& b, const FragB16& a);
__device__ __forceinline__ void mma_group(f32x4 (&acc)[4][2], FragB16 (&At)[4], const FragB16 (&Bt)[2], const LAS unsigned char*) {
#pragma unroll
    for (int m = 0; m < 4; ++m)
#pragma unroll
        for (int n = 0; n < 2; ++n) mma_frag(acc[m][n], Bt[n], At[m]); }
__device__ __forceinline__ void mma_group(f32x4 (&acc)[4][2], i32x8 (&At)[4], const i32x8 (&Bt)[2], const LAS unsigned char* ab) {
    mma_frag(acc[0][0], Bt[0], At[0]); mma_frag(acc[0][1], Bt[1], At[0]);
    ld_frag(At[0], ab + 3 * 2048);
    mma_frag(acc[1][0], Bt[0], At[1]); mma_frag(acc[1][1], Bt[1], At[1]);
    mma_frag(acc[2][0], Bt[0], At[2]); mma_frag(acc[2][1], Bt[1], At[2]);
    mma_frag(acc[3][0], Bt[0], At[0]); mma_frag(acc[3][1], Bt[1], At[0]); }
__device__ __forceinline__ void mma_frag(f32x4& acc, const i32x8& b, const i32x8& a) { acc = __builtin_amdgcn_mfma_scale_f32_16x16x128_f8f6f4(b, a, acc, 0, 0, 0, 0x7f7f7f7f, 0, 0x7f7f7f7f); }
template <class Epi>
__device__ __forceinline__ void gemm_phase(LAS unsigned char* lds, const Gemm g, const StaticOrder& S, const Epi& E) {
    const int tid = threadIdx.x, wid = __builtin_amdgcn_readfirstlane(tid >> 6), lane = tid & 63, wr = wid >> 2, wc = wid & 3, fr = lane & 15, fq = lane >> 4;
    const int K = g.K, lda = g.lda;
    unsigned voffA, voffB;
    { int R, C; stage_rc(tid * 16, R, C); const int Rb = Epi::PERM ? ((R & ~31) + perm32(R & 31)) : R;
      voffA = (unsigned)(R * lda + C) * 2u; voffB = (unsigned)(Rb * K + C) * 2u; }
    const size_t voffA_step = (size_t)64 * lda * 2, voffB_step = (size_t)64 * K * 2;
    const size_t kstep = (size_t)(BK * 2);
    const size_t hstepA = (size_t)HALF * lda * 2, hstepB = (size_t)HALF * K * 2;
    const size_t tstepA = 2 * hstepA, tstepB = 2 * hstepB;
    const unsigned ldsw = (unsigned)wid * 1024u;
    const int aoff = lds_byte(wr * 64 + fr, fq * 8), boff = lds_byte(wc * 32 + fr, fq * 8);
#define PG8_SA(b, h) (((b) * 2 + (h)) * HTB)
#define PG8_SB(b, h) ((4 + (b) * 2 + (h)) * HTB)
#define PG8_STAGE(bufoff, gbase, voff) do { _Pragma("unroll") for (int _i = 0; _i < 2; ++_i) \
        __builtin_amdgcn_global_load_lds((const unsigned*)((const char*)(gbase) + _i * voff##_step + (voff)), (LAS unsigned*)(lds + (bufoff) + ldsw + _i * 8192), 16, 0, 0); } while (0)
#define PG8_LDA(dst, b, h) lda_group(dst, lds + PG8_SA(b, h) + aoff)
#define PG8_LDB(dst, b, h) do { _Pragma("unroll") for (int n = 0; n < 2; ++n) ld_frag(dst[n], lds + PG8_SB(b, h) + boff + n * 2048); } while (0)
#define PG8_LDAR(dst, b, h) lda_again(dst, lds + PG8_SA(b, h) + aoff)
#define PG8_MMA(b, ai, bj, At, Bt) do { __builtin_amdgcn_s_setprio(1); mma_group(acc[ai][bj], At, Bt, lds + PG8_SA(b, ai) + aoff); __builtin_amdgcn_s_setprio(0); } while (0)
#define PG8_WAIT_V(n) asm volatile("s_waitcnt vmcnt(" #n ")" ::: "memory")
#define PG8_WAIT_L(n) asm volatile("s_waitcnt lgkmcnt(" #n ")" ::: "memory")
#define PG8_BAR __builtin_amdgcn_s_barrier()
#define PG8_SCHED __builtin_amdgcn_sched_barrier(0)
    Unit cur, nxt; int ui = 0;
    if (!S.next(0, cur)) return;
    f32x4 acc[2][2][4][2];
#pragma unroll
    for (int a = 0; a < 2; ++a)
#pragma unroll
        for (int b = 0; b < 2; ++b)
#pragma unroll
            for (int m = 0; m < 4; ++m)
#pragma unroll
                for (int n = 0; n < 2; ++n) acc[a][b][m][n] = (f32x4){0.f, 0.f, 0.f, 0.f};
    typename FragT<epi_f8<Epi>::v>::T At[4], B0[2], B1[2];
    int k0c, nt; unit_kwin(g, cur, k0c, nt);
    const char* cA = (const char*)g.A + (size_t)cur.pm * tstepA + (size_t)k0c * kstep; const char* cB = (const char*)g.Bt + (size_t)cur.pn * tstepB + (size_t)k0c * kstep;
    PG8_STAGE(PG8_SB(0, 0), cB, voffB); PG8_STAGE(PG8_SA(0, 0), cA, voffA); PG8_STAGE(PG8_SB(0, 1), cB + hstepB, voffB); PG8_STAGE(PG8_SA(0, 1), cA + hstepA, voffA);
    if (wr == 1) PG8_BAR;
    PG8_WAIT_V(4); PG8_BAR;
    PG8_STAGE(PG8_SB(1, 0), cB + kstep, voffB); PG8_STAGE(PG8_SA(1, 0), cA + kstep, voffA); PG8_STAGE(PG8_SB(1, 1), cB + hstepB + kstep, voffB);
    PG8_WAIT_V(6); PG8_BAR;
    for (;;) {
        const bool has_next = S.next(ui + 1, nxt);
        int k0n = 0, ntn = nt; if (has_next) unit_kwin(g, nxt, k0n, ntn);
        const char* nA = has_next ? (const char*)g.A + (size_t)nxt.pm * tstepA + (size_t)k0n * kstep : cA; const char* nB = has_next ? (const char*)g.Bt + (size_t)nxt.pn * tstepB + (size_t)k0n * kstep : cB;
        for (int t = 0; t < nt; t += 2) {
            const bool last = (t == nt - 2);
            const char* a1 = cA + (size_t)(t + 1) * kstep;
            const char* a2 = last ? nA : cA + (size_t)(t + 2) * kstep; const char* b2 = last ? nB : cB + (size_t)(t + 2) * kstep;
            const char* a3 = a2 + kstep; const char* b3 = b2 + kstep;
            PG8_LDB(B0, 0, 0); PG8_SCHED; PG8_LDA(At, 0, 0); PG8_STAGE(PG8_SA(1, 1), a1 + hstepA, voffA);
            PG8_WAIT_L(8); PG8_BAR; PG8_WAIT_L(0); PG8_MMA(0, 0, 0, At, B0); PG8_LDAR(At, 0, 0); PG8_BAR; PG8_SCHED;
            PG8_LDB(B1, 0, 1); PG8_STAGE(PG8_SB(0, 0), b2, voffB);
            PG8_BAR; PG8_WAIT_L(0); PG8_MMA(0, 0, 1, At, B1); PG8_BAR;
            PG8_LDA(At, 0, 1); PG8_STAGE(PG8_SA(0, 0), a2, voffA);
            PG8_BAR; PG8_WAIT_L(0); PG8_MMA(0, 1, 0, At, B0); PG8_LDAR(At, 0, 1); PG8_BAR; PG8_SCHED;
            PG8_STAGE(PG8_SB(0, 1), b2 + hstepB, voffB);
            PG8_WAIT_V(6); PG8_BAR; PG8_MMA(0, 1, 1, At, B1); PG8_BAR;
            PG8_LDB(B0, 1, 0); PG8_SCHED; PG8_LDA(At, 1, 0); PG8_STAGE(PG8_SA(0, 1), a2 + hstepA, voffA);
            PG8_WAIT_L(8); PG8_BAR; PG8_WAIT_L(0); PG8_MMA(1, 0, 0, At, B0); PG8_LDAR(At, 1, 0); PG8_BAR; PG8_SCHED;
            PG8_LDB(B1, 1, 1); PG8_STAGE(PG8_SB(1, 0), b3, voffB);
            PG8_BAR; PG8_WAIT_L(0); PG8_MMA(1, 0, 1, At, B1); PG8_BAR;
            PG8_LDA(At, 1, 1); PG8_STAGE(PG8_SA(1, 0), a3, voffA);
            PG8_BAR; PG8_WAIT_L(0); PG8_MMA(1, 1, 0, At, B0); PG8_LDAR(At, 1, 1); PG8_BAR; PG8_SCHED;
            PG8_STAGE(PG8_SB(1, 1), b3 + hstepB, voffB);
            PG8_WAIT_V(6); PG8_BAR; PG8_MMA(1, 1, 1, At, B1); PG8_BAR;
        }
        E(acc, cur, wr, wc, fr, fq);
        if (!has_next) break;
#pragma unroll
        for (int a = 0; a < 2; ++a)
#pragma unroll
            for (int b = 0; b < 2; ++b)
#pragma unroll
                for (int m = 0; m < 4; ++m)
#pragma unroll
                    for (int n = 0; n < 2; ++n) acc[a][b][m][n] = (f32x4){0.f, 0.f, 0.f, 0.f};
        cur = nxt; cA = nA; cB = nB; nt = ntn; ++ui;
    }
    PG8_WAIT_V(0);
    if (wr == 0) PG8_BAR;
    PG8_BAR;
#undef PG8_SA
#undef PG8_SB
#undef PG8_STAGE
#undef PG8_LDA
#undef PG8_LDB
#undef PG8_MMA
#undef PG8_WAIT_V
#undef PG8_WAIT_L
#undef PG8_BAR
#undef PG8_SCHED
}
}

#define XB_TMO      128
#define XB_XCNT(j)  (256  + 64 * (j))
#define XB_XSUB(j)  (1280 + 64 * (j))
#define XB_XGEN(j)  (2304 + 64 * (j))
#define XB_TOP      3328
#define XB_TOPGEN   3392
#define XCD_BAR_WORDS 3456
#define XB_SPIN_CAP (1u << 18)
__device__ __forceinline__ unsigned xb_ld(unsigned* p)              { return __hip_atomic_load(p, __ATOMIC_RELAXED, __HIP_MEMORY_SCOPE_AGENT); }
__device__ __forceinline__ unsigned xb_add(unsigned* p, unsigned v) { return __hip_atomic_fetch_add(p, v, __ATOMIC_RELAXED, __HIP_MEMORY_SCOPE_AGENT); }
__device__ __forceinline__ unsigned xb_xcc_id() { return (unsigned)__builtin_amdgcn_s_getreg((3 << 11) | 20) & 0xFu; }
#define XB_SPIN(cond, bar) do { unsigned _sp = 0; while (cond) { __builtin_amdgcn_s_sleep(1); \
    if ((++_sp & 255u) == 0u) { if (xb_ld(&(bar)[XB_TMO])) break; if (_sp > XB_SPIN_CAP) { atomicAdd(&(bar)[XB_TMO], 1u); break; } } } } while (0)
struct XcdBarrier { unsigned* bar; unsigned x; volatile LAS unsigned* st; };
__device__ __forceinline__ XcdBarrier xcd_barrier_post(unsigned* bar, volatile LAS unsigned* st) {
    XcdBarrier b; b.bar = bar; b.x = xb_xcc_id(); b.st = st;
    if (threadIdx.x == 0) (void)xb_add(&bar[XB_XCNT(b.x)], 1u);
    return b;
}
__device__ __forceinline__ void xcd_barrier_complete(unsigned* bar, unsigned x, unsigned& nloc, unsigned& nx) {
    const unsigned G = gridDim.x * gridDim.y * gridDim.z;
    unsigned sum, cnt, mine, sp = 0u;
    for (;;) {
        sum = 0u; cnt = 0u; mine = 0u;
#pragma unroll
        for (unsigned j = 0; j < 16; ++j) { const unsigned c = xb_ld(&bar[XB_XCNT(j)]); sum += c; cnt += (c > 0u) ? 1u : 0u; mine = (j == x) ? c : mine; }
        if (sum == G) break;
        __builtin_amdgcn_s_sleep(1);
        if ((++sp & 255u) == 0u) { if (xb_ld(&bar[XB_TMO])) break; if (sp > XB_SPIN_CAP) { atomicAdd(&bar[XB_TMO], 1u); break; } }
    }
    nloc = mine > 0u ? mine : 1u; nx = cnt > 0u ? cnt : 1u;
}
__device__ __forceinline__ void xcd_barrier(const XcdBarrier& b) {
    asm volatile("s_waitcnt vmcnt(0)" ::: "memory");
    __syncthreads();
    if (threadIdx.x == 0) {
        unsigned* bar = b.bar;
        __builtin_amdgcn_s_waitcnt(0);
        unsigned nloc = b.st[0], nx = b.st[1];
        if (nloc == 0u) { xcd_barrier_complete(bar, b.x, nloc, nx); b.st[0] = nloc; b.st[1] = nx; }
        const unsigned old = xb_add(&bar[XB_XSUB(b.x)], 1u);
        const unsigned gen = old / nloc;
        if (old + 1u == (gen + 1u) * nloc) {
            __builtin_amdgcn_fence(__ATOMIC_RELEASE, "agent");
            asm volatile("s_waitcnt vmcnt(0)" ::: "memory");
            const unsigned og = xb_add(&bar[XB_TOP], 1u);
            const unsigned tg = og / nx;
            if (og + 1u == (tg + 1u) * nx) xb_add(&bar[XB_TOPGEN], 1u);
            else XB_SPIN(xb_ld(&bar[XB_TOPGEN]) == tg, bar);
            __builtin_amdgcn_fence(__ATOMIC_ACQUIRE, "agent");
            xb_add(&bar[XB_XGEN(b.x)], 1u);
            asm volatile("s_waitcnt vmcnt(0)" ::: "memory");
        } else {
            XB_SPIN(xb_ld(&bar[XB_XGEN(b.x)]) == gen, bar);
            __builtin_amdgcn_fence(__ATOMIC_ACQUIRE, "agent");
            asm volatile("s_waitcnt vmcnt(0)" ::: "memory");
        }
    }
    __syncthreads();
}

struct Args { const float* in[32]; float* out; unsigned char* ws; int lo, hi; };
typedef const Args __attribute__((address_space(4))) KArgs;
enum { I_X = 0, I_NMG, I_WIN, I_MU, I_W0, I_W2, I_A0, I_A2, I_G2, I_V0, I_V1, I_V2, I_KK, I_KA, I_RK, I_LNW, I_LNB, I_WRB, I_CW, I_CB, I_DTB, I_ALOG, I_SD, I_SNG, I_WSB, I_WOUT, I_NFG, I_WQ, I_SK, I_PD, I_PU, I_NFIN };

struct NoTmp {};
struct FStoreBf16 { bf16* O; int ldc; typedef NoTmp Tmp; static constexpr int GRP = 16;
    __device__ __forceinline__ void load(int, int, int, Tmp&) const {}
    __device__ __forceinline__ void apply(int row, int col, f32x4 v0, f32x4 v1, int, const Tmp&) const {
        v4u w; w.x = pk2(v0[0], v0[1]); w.y = pk2(v0[2], v0[3]); w.z = pk2(v1[0], v1[1]); w.w = pk2(v1[2], v1[3]);
        *(v4u*)(O + (size_t)row * ldc + col) = w; } };
struct FSigmoidBf16 { bf16* O; int ldc; typedef NoTmp Tmp; static constexpr int GRP = 16;
    __device__ __forceinline__ void load(int, int, int, Tmp&) const {}
    __device__ __forceinline__ void apply(int row, int col, f32x4 v0, f32x4 v1, int, const Tmp&) const {
        v4u w; w.x = pk2(sigmoidf_(v0[0]), sigmoidf_(v0[1])); w.y = pk2(sigmoidf_(v0[2]), sigmoidf_(v0[3])); w.z = pk2(sigmoidf_(v1[0]), sigmoidf_(v1[1])); w.w = pk2(sigmoidf_(v1[2]), sigmoidf_(v1[3]));
        *(v4u*)(O + (size_t)row * ldc + col) = w; } };
struct FStoreBf16S { bf16* O; int ldc; const float* xs; const float* wsc; typedef float Tmp; static constexpr int GRP = 4;
    __device__ __forceinline__ void load(int row, int, int, Tmp& t) const { t = xs[row] * wsc[0]; }
    __device__ __forceinline__ void apply(int row, int col, f32x4 v0, f32x4 v1, int, const Tmp& t) const {
        v0 *= t; v1 *= t;
        v4u w; w.x = pk2c(v0[0], v0[1]); w.y = pk2c(v0[2], v0[3]); w.z = pk2c(v1[0], v1[1]); w.w = pk2c(v1[2], v1[3]);
        *(v4u*)(O + (size_t)row * ldc + col) = w; } };
struct FSigmoidBf16S { bf16* O; int ldc; const float* xs; const float* wsc; typedef float Tmp; static constexpr int GRP = 4;
    __device__ __forceinline__ void load(int row, int, int, Tmp& t) const { t = xs[row] * wsc[0]; }
    __device__ __forceinline__ void apply(int row, int col, f32x4 v0, f32x4 v1, int, const Tmp& t) const {
        v0 *= t; v1 *= t;
        v4u w; w.x = pk2c(sigmoidf_(v0[0]), sigmoidf_(v0[1])); w.y = pk2c(sigmoidf_(v0[2]), sigmoidf_(v0[3])); w.z = pk2c(sigmoidf_(v1[0]), sigmoidf_(v1[1])); w.w = pk2c(sigmoidf_(v1[2]), sigmoidf_(v1[3]));
        *(v4u*)(O + (size_t)row * ldc + col) = w; } };
namespace pg8 { template <> struct epi_f8<EpiRow8<FStoreBf16S>> { static constexpr bool v = true; }; template <> struct epi_f8<EpiRow8<FSigmoidBf16S>> { static constexpr bool v = true; }; }
struct EpiLora {
    static constexpr bool PERM = true;
    bf16 *elog, *asig, *gg, *vmix; const bf16* vf; const float *w0, *a0, *v0;
    template <int BLK> __device__ __forceinline__ void run(const f32x4 (&acc)[2][2][4][2], int row0, int col0) const {
#pragma unroll
        for (int bj = 0; bj < 2; ++bj) {
            const int c = (col0 + bj * 128) & 1023;
            float bias[8];
            if (BLK == 0 || BLK == 1 || BLK == 3) { const float* bp = (BLK == 0 ? w0 : (BLK == 1 ? a0 : v0)) + c; const f32x4 b0 = *(const f32x4*)bp, b1 = *(const f32x4*)(bp + 4);
                bias[0] = b0[0]; bias[1] = b0[1]; bias[2] = b0[2]; bias[3] = b0[3]; bias[4] = b1[0]; bias[5] = b1[1]; bias[6] = b1[2]; bias[7] = b1[3]; }
#pragma unroll
            for (int ai = 0; ai < 2; ++ai) {
            v4u qvs[4], qvf[4];
            if (BLK == 3) {
#pragma unroll
                for (int i = 0; i < 4; ++i) { const size_t o = (size_t)(row0 + ai * 128 + i * 16) * D + c; qvs[i] = *(const v4u*)(vmix + o); qvf[i] = *(const v4u*)(vf + o); }
            }
#pragma unroll
                for (int m = 0; m < 4; ++m) {
                    const int row = row0 + ai * 128 + m * 16; const size_t o = (size_t)row * D + c;
                    const f32x4 v0_ = acc[ai][bj][m][0], v1_ = acc[ai][bj][m][1];
                    float a[8] = {v0_[0], v0_[1], v0_[2], v0_[3], v1_[0], v1_[1], v1_[2], v1_[3]};
                    if (BLK == 0) {
#pragma unroll
                        for (int e = 0; e < 8; ++e) a[e] = -0.6065306597f * sigmoidf_(bias[e] + a[e]);
                        *(v4u*)(elog + o) = pack8(a);
                    } else if (BLK == 1) {
#pragma unroll
                        for (int e = 0; e < 8; ++e) a[e] = sigmoidf_(bias[e] + a[e]);
                        *(v4u*)(asig + o) = pack8(a);
                    } else if (BLK == 2) {
                        *(v4u*)(gg + o) = pack8(a);
                    } else {
                        float vs[8], vfv[8]; unpack8(qvs[m], vs); unpack8(qvf[m], vfv);
#pragma unroll
                        for (int e = 0; e < 8; ++e) a[e] = vs[e] + (vfv[e] - vs[e]) * sigmoidf_(bias[e] + a[e]);
                        *(v4u*)(vmix + o) = pack8(a);
                    }
                }
            }
        }
    }
    __device__ __forceinline__ void operator()(const f32x4 (&acc)[2][2][4][2], const pg8::Unit& u, int wr, int wc, int fr, int fq) const {
        const int row0 = u.pm * 256 + wr * 64 + fr, col0 = u.pn * 256 + wc * 32 + 8 * fq;
        const int blk = u.pn >> 2;
        if (blk == 0) run<0>(acc, row0, col0); else if (blk == 1) run<1>(acc, row0, col0); else if (blk == 2) run<2>(acc, row0, col0); else run<3>(acc, row0, col0);
    }
};
struct FMixA { const bf16* gates; bf16* mixed;
    struct Tmp { v4u g; }; static constexpr int GRP = 8;
    __device__ __forceinline__ void load(int row, int col, int, Tmp& t) const { t.g = *(const v4u*)(gates + (size_t)row * 2048 + col); }
    __device__ __forceinline__ void apply(int row, int col, f32x4 v0, f32x4 v1, int, const Tmp& t) const {
        float g[8]; unpack8(t.g, g);
        float a[8] = {v0[0] * g[0], v0[1] * g[1], v0[2] * g[2], v0[3] * g[3], v1[0] * g[4], v1[1] * g[5], v1[2] * g[6], v1[3] * g[7]};
        *(v4u*)(mixed + (size_t)row * D + col) = pack8(a); } };
struct FMixB { const bf16* gates; bf16* mixed;
    struct Tmp { v4u g, mx; }; static constexpr int GRP = 8;
    __device__ __forceinline__ void load(int row, int col, int, Tmp& t) const { t.g = *(const v4u*)(gates + (size_t)row * 2048 + 1024 + col); t.mx = *(const v4u*)(mixed + (size_t)row * D + col); }
    __device__ __forceinline__ void apply(int row, int col, f32x4 v0, f32x4 v1, int, const Tmp& t) const {
        float g[8], mx[8]; unpack8(t.g, g); unpack8(t.mx, mx);
        float a[8] = {mx[0] + v0[0] * g[0], mx[1] + v0[1] * g[1], mx[2] + v0[2] * g[2], mx[3] + v0[3] * g[3], mx[4] + v1[0] * g[4], mx[5] + v1[1] * g[5], mx[6] + v1[2] * g[6], mx[7] + v1[3] * g[7]};
        *(v4u*)(mixed + (size_t)row * D + col) = pack8(a); } };
struct FResid { const float* base; float* h;
    struct Tmp { f32x4 a, b; }; static constexpr int GRP = 8;
    __device__ __forceinline__ void load(int row, int col, int, Tmp& t) const { const f32x4* s = (const f32x4*)(base + (size_t)row * D + col); t.a = s[0]; t.b = s[1]; }
    __device__ __forceinline__ void apply(int row, int col, f32x4 v0, f32x4 v1, int, const Tmp& t) const {
        f32x4* p = (f32x4*)(h + (size_t)row * D + col); p[0] = t.a + v0; p[1] = t.b + v1; } };

struct Ctx { int tid, lane, wave, G, bid; LAS unsigned char* lds; };

__device__ __forceinline__ void transpose_item(const float* W, int K, int N, bf16* WT, int row_off, LAS float* scr, int item, int lane) {
    const int nblk = N / 32, kb = item / nblk, nb = item % nblk, k0 = 64 * kb, n0 = 32 * nb;
#pragma unroll 8
    for (int i = 0; i < 32; ++i) { const int kk = 2 * i + (lane >> 5); scr[kk * 33 + (lane & 31)] = W[(size_t)(k0 + kk) * N + n0 + (lane & 31)]; }
    asm volatile("s_waitcnt lgkmcnt(0)" ::: "memory");
    const int c = lane & 7;
#pragma unroll
    for (int j = 0; j < 4; ++j) { const int n = (lane >> 3) + 8 * j; const LAS float* s = scr + (8 * c) * 33 + n;
        v4u o; o.x = pk2(s[0 * 33], s[1 * 33]); o.y = pk2(s[2 * 33], s[3 * 33]); o.z = pk2(s[4 * 33], s[5 * 33]); o.w = pk2(s[6 * 33], s[7 * 33]);
        *(v4u*)(WT + (size_t)(row_off + n0 + n) * K + k0 + 8 * c) = o; }
    asm volatile("s_waitcnt lgkmcnt(0)" ::: "memory");
}
__device__ __forceinline__ void transpose_item8(const float* W, int K, int N, unsigned char* WT, int row_off, LAS float* scr, int item, int lane, float qs) {
    const int nblk = N / 32, kb = item / nblk, nb = item % nblk, k0 = 64 * kb, n0 = 32 * nb;
#pragma unroll 8
    for (int i = 0; i < 32; ++i) { const int kk = 2 * i + (lane >> 5); scr[kk * 33 + (lane & 31)] = W[(size_t)(k0 + kk) * N + n0 + (lane & 31)]; }
    asm volatile("s_waitcnt lgkmcnt(0)" ::: "memory");
    const int c = lane & 7;
#pragma unroll
    for (int j = 0; j < 4; ++j) { const int n = (lane >> 3) + 8 * j; const LAS float* s = scr + (8 * c) * 33 + n;
        int w0 = __builtin_amdgcn_cvt_pk_fp8_f32(s[0 * 33] * qs, s[1 * 33] * qs, 0, false); w0 = __builtin_amdgcn_cvt_pk_fp8_f32(s[2 * 33] * qs, s[3 * 33] * qs, w0, true);
        int w1 = __builtin_amdgcn_cvt_pk_fp8_f32(s[4 * 33] * qs, s[5 * 33] * qs, 0, false); w1 = __builtin_amdgcn_cvt_pk_fp8_f32(s[6 * 33] * qs, s[7 * 33] * qs, w1, true);
        v2u o; o.x = (unsigned)w0; o.y = (unsigned)w1;
        *(v2u*)(WT + (size_t)(row_off + n0 + n) * K + k0 + 8 * c) = o; }
    asm volatile("s_waitcnt lgkmcnt(0)" ::: "memory");
}
__device__ __forceinline__ void phase_winmax(const Ctx& c, KArgs& a) {
    unsigned* CT = (unsigned*)(a.ws + WS_CTL);
#pragma unroll 1
    for (int l = 0; l < 2; ++l) {
        const f32x4* W = (const f32x4*)(a.in[I_WIN] + (size_t)l * D * IN_PROJ);
        float am = 0.f;
        for (int i = c.bid * 512 + c.tid; i < D * IN_PROJ / 4; i += c.G * 512) { const f32x4 v = W[i]; am = fmaxf(am, fmaxf(fmaxf(fabsf(v.x), fabsf(v.y)), fmaxf(fabsf(v.z), fabsf(v.w)))); }
#pragma unroll
        for (int o = 1; o < 64; o <<= 1) am = fmaxf(am, __shfl_xor(am, o));
        if (c.lane == 0) __hip_atomic_fetch_max(CT + CW_WMAX + l, __builtin_bit_cast(unsigned, am), __ATOMIC_RELAXED, __HIP_MEMORY_SCOPE_AGENT);
    }
}
__device__ __forceinline__ int winrow(int n) {
    if (n < RW_PROJ) return n;
    if (n < RW_PROJ + 5120) return N1P + (n - RW_PROJ);
    if (n < RW_PROJ + SSD_PROJ) return DT_COL + (n - RW_PROJ - 5120);
    return N1P + N2P + (n - RW_PROJ - SSD_PROJ); }

__device__ __forceinline__ void phase_prologue(const Ctx& c, KArgs& a) {
    unsigned char* ws = a.ws;
    LAS float* scr = (LAS float*)(c.lds + c.wave * 16384);
    const int gw = c.bid * 8 + c.wave, NGW = c.G * 8;
    constexpr int I_IN = 16 * (IN_PROJ / 32), I_A = 16 * 32, I_B = 32 * 32, I_O = 16 * 32, I_L = I_IN + I_A + I_B + I_O;
    for (int it = gw; it < 2 * I_L; it += NGW) {
        const int l = it / I_L; int r = it % I_L;
        if (r < I_IN) { const int nb = r % (IN_PROJ / 32); const float am = fmaxf(__builtin_bit_cast(float, __hip_atomic_load((const unsigned*)(ws + WS_CTL) + CW_WMAX + l, __ATOMIC_RELAXED, __HIP_MEMORY_SCOPE_AGENT)), 1e-30f);
            transpose_item8(a.in[I_WIN] + (size_t)l * D * IN_PROJ, D, IN_PROJ, ws + WS_WIN + l * WIN8_L, winrow(nb * 32) - nb * 32, scr, r, c.lane, 384.f / am); continue; } r -= I_IN;
        if (r < I_A) { transpose_item(a.in[I_WRB] + (size_t)l * D * D, D, D, (bf16*)(ws + WS_WA) + (size_t)l * D * D, 0, scr, r, c.lane); continue; } r -= I_A;
        if (r < I_B) { transpose_item(a.in[I_WSB] + (size_t)l * 2048 * D, 2048, D, (bf16*)(ws + WS_WB) + (size_t)l * D * 2048, 0, scr, r, c.lane); continue; } r -= I_B;
        transpose_item(a.in[I_WOUT] + (size_t)l * D * D, D, D, (bf16*)(ws + WS_WO) + (size_t)l * D * D, 0, scr, r, c.lane);
    }
    for (int it = c.bid * 512 + c.tid; it < 2 * 192 * 64; it += c.G * 512) {
        const int l = it / (192 * 64), r = (it / 64) % 192, q = it % 64;
        *(v4u*)(ws + WS_WIN + l * WIN8_L + (size_t)(DT_COL + 32 + r) * D + q * 16) = (v4u){0u, 0u, 0u, 0u};
    }
    if (c.bid == 0 && c.tid < 2) ((float*)(ws + WS_CTL))[CW_WSC + c.tid] = fmaxf(__builtin_bit_cast(float, __hip_atomic_load((const unsigned*)(ws + WS_CTL) + CW_WMAX + c.tid, __ATOMIC_RELAXED, __HIP_MEMORY_SCOPE_AGENT)), 1e-30f) * (1.f / 384.f);
    for (int it = c.bid * 512 + c.tid; it < 2 * 4096 * KL; it += c.G * 512) {
        const int l = it / (4096 * KL), n = (it / KL) % 4096, k = it % KL; const int blk = n >> 10, cc = n & 1023;
        float v = 0.f;
        if (blk == 0) { if (k < 64) v = a.in[I_W2][((size_t)l * 64 + k) * D + cc]; }
        else if (blk == 1) { if (k >= 64 && k < 128) v = a.in[I_A2][((size_t)l * 64 + (k - 64)) * D + cc]; }
        else if (blk == 2) { if (k >= 128 && k < 288) v = a.in[I_G2][((size_t)l * 160 + (k - 128)) * D + cc]; }
        else { if (l == 1 && k >= 288 && k < 320) v = a.in[I_V2][(size_t)(k - 288) * D + cc]; }
        ((bf16*)(ws + WS_WLORA + l * WLORA_L))[(size_t)n * KL + k] = (bf16)f2bf(v);
    }
    __syncthreads();
    LAS float* wqL = (LAS float*)c.lds;
    LAS float* kyL = (LAS float*)(c.lds + 32768);
    for (int it = c.bid; it < 2 * 16 * 16; it += c.G) {
        const int l = it >> 8, hc = (it >> 4) & 15, k0 = (it & 15) * 64;
        const float* wq = a.in[I_WQ] + (size_t)l * D * 2048; const float* ky = a.in[I_SK] + ((size_t)l * 16 + hc) * 128 * 128;
        for (int e = c.tid; e < 64 * 128; e += 512) wqL[e] = wq[(size_t)(k0 + (e >> 7)) * 2048 + hc * 128 + (e & 127)];
        for (int e = c.tid; e < 128 * 128; e += 512) kyL[(e >> 7) * 129 + (e & 127)] = ky[e];
        __syncthreads();
        const int key = c.tid & 127, kg = c.tid >> 7;
        float acc[16];
#pragma unroll
        for (int i = 0; i < 16; ++i) acc[i] = 0.f;
        for (int d = 0; d < 128; ++d) { const float kv = kyL[key * 129 + d];
#pragma unroll
            for (int i = 0; i < 16; ++i) acc[i] += wqL[(kg * 16 + i) * 128 + d] * kv; }
        bf16* o = (bf16*)(ws + WS_WQK) + ((size_t)l * 2048 + hc * 128 + key) * D + k0 + kg * 16;
        v4u q0, q1; q0.x = pk2(acc[0], acc[1]); q0.y = pk2(acc[2], acc[3]); q0.z = pk2(acc[4], acc[5]); q0.w = pk2(acc[6], acc[7]);
        q1.x = pk2(acc[8], acc[9]); q1.y = pk2(acc[10], acc[11]); q1.z = pk2(acc[12], acc[13]); q1.w = pk2(acc[14], acc[15]);
        *(v4u*)o = q0; *(v4u*)(o + 8) = q1;
        __syncthreads();
    }
}

__device__ __forceinline__ void phase_rmsnorm(const Ctx& c, const float* src, const float* g, bf16* U, float* copy_to) {
    const int gw = c.bid * 8 + c.wave, NGW = c.G * 8;
    f32x4 gv[4];
#pragma unroll
    for (int j = 0; j < 4; ++j) gv[j] = *((const f32x4*)g + c.lane + 64 * j);
    f32x4 nv[4];
    if (gw < M) { const f32x4* xr0 = (const f32x4*)(src + (size_t)gw * D) + c.lane;
#pragma unroll
        for (int j = 0; j < 4; ++j) nv[j] = xr0[64 * j]; }
    for (int m = gw; m < M; m += NGW) {
        f32x4 v[4]; float s = 0.f;
#pragma unroll
        for (int j = 0; j < 4; ++j) { v[j] = nv[j]; s += (v[j].x * v[j].x + v[j].y * v[j].y) + (v[j].z * v[j].z + v[j].w * v[j].w); }
        if (m + NGW < M) { const f32x4* xn = (const f32x4*)(src + (size_t)(m + NGW) * D) + c.lane;
#pragma unroll
            for (int j = 0; j < 4; ++j) nv[j] = xn[64 * j]; }
        if (copy_to) { f32x4* cr = (f32x4*)(copy_to + (size_t)m * D) + c.lane;
#pragma unroll
            for (int j = 0; j < 4; ++j) cr[64 * j] = v[j]; }
        const float r = rsqrtf(sum64(s) * (1.f / D) + 1e-6f);
        v2u* o = (v2u*)(U + (size_t)m * D) + c.lane;
#pragma unroll
        for (int j = 0; j < 4; ++j) { v2u w; w.x = pk2(v[j].x * r * gv[j].x, v[j].y * r * gv[j].y); w.y = pk2(v[j].z * r * gv[j].z, v[j].w * r * gv[j].w); o[64 * j] = w; }
    }
}
__device__ __forceinline__ void phase_rmsnorm_q8(const Ctx& c, const float* src, const float* g, bf16* U, unsigned char* U8, float* XS) {
    const int gw = c.bid * 8 + c.wave, NGW = c.G * 8;
    f32x4 gv[4];
#pragma unroll
    for (int j = 0; j < 4; ++j) gv[j] = *((const f32x4*)g + c.lane + 64 * j);
    f32x4 nv[4];
    if (gw < M) { const f32x4* xr0 = (const f32x4*)(src + (size_t)gw * D) + c.lane;
#pragma unroll
        for (int j = 0; j < 4; ++j) nv[j] = xr0[64 * j]; }
    for (int m = gw; m < M; m += NGW) {
        f32x4 v[4]; float s = 0.f;
#pragma unroll
        for (int j = 0; j < 4; ++j) { v[j] = nv[j]; s += (v[j].x * v[j].x + v[j].y * v[j].y) + (v[j].z * v[j].z + v[j].w * v[j].w); }
        if (m + NGW < M) { const f32x4* xn = (const f32x4*)(src + (size_t)(m + NGW) * D) + c.lane;
#pragma unroll
            for (int j = 0; j < 4; ++j) nv[j] = xn[64 * j]; }
        const float r = rsqrtf(sum64(s) * (1.f / D) + 1e-6f);
        float am = 0.f;
#pragma unroll
        for (int j = 0; j < 4; ++j) { v[j] = v[j] * r * gv[j]; am = fmaxf(am, fmaxf(fmaxf(fabsf(v[j].x), fabsf(v[j].y)), fmaxf(fabsf(v[j].z), fabsf(v[j].w)))); }
#pragma unroll
        for (int o = 1; o < 64; o <<= 1) am = fmaxf(am, __shfl_xor(am, o));
        am = fmaxf(am, 1e-30f);
        const float qs = 384.f / am;
        v2u* o = (v2u*)(U + (size_t)m * D) + c.lane;
        unsigned* o8 = (unsigned*)(U8 + (size_t)m * D) + c.lane;
#pragma unroll
        for (int j = 0; j < 4; ++j) { if (U) { v2u w; w.x = pk2(v[j].x, v[j].y); w.y = pk2(v[j].z, v[j].w); o[64 * j] = w; }
            int w8 = __builtin_amdgcn_cvt_pk_fp8_f32(v[j].x * qs, v[j].y * qs, 0, false); w8 = __builtin_amdgcn_cvt_pk_fp8_f32(v[j].z * qs, v[j].w * qs, w8, true); o8[64 * j] = (unsigned)w8; }
        if (c.lane == 0) XS[m] = am * (1.f / 384.f);
    }
}
__device__ __forceinline__ void phase_final(const Ctx& c, float* out, const float* g) {
    const int gw = c.bid * 8 + c.wave, NGW = c.G * 8;
    f32x4 gv[4];
#pragma unroll
    for (int j = 0; j < 4; ++j) gv[j] = *((const f32x4*)g + c.lane + 64 * j);
    for (int m = gw; m < M; m += NGW) {
        f32x4* xr = (f32x4*)(out + (size_t)m * D) + c.lane;
        f32x4 v[4]; float s = 0.f;
#pragma unroll
        for (int j = 0; j < 4; ++j) { v[j] = xr[64 * j]; s += (v[j].x * v[j].x + v[j].y * v[j].y) + (v[j].z * v[j].z + v[j].w * v[j].w); }
        const float r = rsqrtf(sum64(s) * (1.f / D) + 1e-6f);
#pragma unroll
        for (int j = 0; j < 4; ++j) xr[64 * j] = v[j] * r * gv[j];
    }
}

__device__ __forceinline__ void phase_rwkv_prep(const Ctx& c, KArgs& a, int l, int hb) {
    unsigned char* ws = a.ws;
    const bf16* PR = (const bf16*)(ws + WS_OV + OV_PR);
    bf16* AL = (bf16*)(ws + WS_OV + OV_AL);
    bf16* VS = l == 0 ? (bf16*)(ws + WS_VF) + (size_t)hb * MH * D : (bf16*)(ws + WS_OV + OV_VMIX);
    const float* mu = a.in[I_MU] + (size_t)l * RW_PROJ;
    LAS bf16* v1L = (LAS bf16*)c.lds;
    if (l == 1) {
        const float* v1 = a.in[I_V1];
        for (int e = c.tid; e < 1024 * 32; e += 512) { const int cc = e >> 5, j = e & 31; v1L[((cc & 15) * 64 + (cc >> 4)) * 40 + j] = (bf16)f2bf(v1[e]); }
        __syncthreads();
    }
    const int gw = c.bid * 8 + c.wave, NGW = c.G * 8, lane = c.lane;
    float muv[16], mul[8];
#pragma unroll
    for (int e = 0; e < 16; ++e) muv[e] = mu[2048 + 16 * lane + e];
#pragma unroll
    for (int e = 0; e < 8; ++e) mul[e] = lane < 36 ? mu[3072 + 8 * lane + e] : 0.f;
    const int per = (MH + NGW - 1) / NGW;
    const int mA = gw * per, mB = (mA + per < MH) ? mA + per : MH;
    v4u cq0, cq1, cql, pq0, pq1, pql;
    const v4u zz4 = (v4u){0u, 0u, 0u, 0u};
    const int lcol = lane < 36 ? 3072 + 8 * lane : 3072;
    if (mA < mB) {
        const bf16* row = PR + (size_t)mA * N1P;
        cq0 = *(const v4u*)(row + 2048 + 16 * lane); cq1 = *(const v4u*)(row + 2048 + 16 * lane + 8); cql = *(const v4u*)(row + lcol);
        if ((mA & (T - 1)) != 0) { pq0 = *(const v4u*)(row - N1P + 2048 + 16 * lane); pq1 = *(const v4u*)(row - N1P + 2048 + 16 * lane + 8); pql = *(const v4u*)(row - N1P + lcol); }
        else { pq0 = zz4; pq1 = zz4; pql = zz4; }
    }
    for (int m = mA; m < mB; ++m) {
        const v4u q0 = cq0, q1 = cq1, ql = cql;
        v4u r0 = pq0, r1 = pq1, rl = pql;
        if ((m & (T - 1)) == 0) { r0 = zz4; r1 = zz4; rl = zz4; }
        if (m + 1 < mB) { const bf16* nrow = PR + (size_t)(m + 1) * N1P; cq0 = *(const v4u*)(nrow + 2048 + 16 * lane); cq1 = *(const v4u*)(nrow + 2048 + 16 * lane + 8); cql = *(const v4u*)(nrow + lcol); }
        pq0 = q0; pq1 = q1; pql = ql;
        float vs[16];
        {
            float p[16], pp[16];
            float t8[8];
            unpack8(q0, t8);
#pragma unroll
            for (int e = 0; e < 8; ++e) p[e] = t8[e];
            unpack8(q1, t8);
#pragma unroll
            for (int e = 0; e < 8; ++e) p[8 + e] = t8[e];
            unpack8(r0, t8);
#pragma unroll
            for (int e = 0; e < 8; ++e) pp[e] = t8[e];
            unpack8(r1, t8);
#pragma unroll
            for (int e = 0; e < 8; ++e) pp[8 + e] = t8[e];
#pragma unroll
            for (int e = 0; e < 16; ++e) vs[e] = p[e] + (pp[e] - p[e]) * muv[e];
            v4u o0, o1;
            o0.x = pk2(vs[0], vs[1]); o0.y = pk2(vs[2], vs[3]); o0.z = pk2(vs[4], vs[5]); o0.w = pk2(vs[6], vs[7]);
            o1.x = pk2(vs[8], vs[9]); o1.y = pk2(vs[10], vs[11]); o1.z = pk2(vs[12], vs[13]); o1.w = pk2(vs[14], vs[15]);
            *(v4u*)(VS + (size_t)m * D + 16 * lane) = o0; *(v4u*)(VS + (size_t)m * D + 16 * lane + 8) = o1;
        }
        if (lane < 36) {
            float p[8], pp[8], s[8];
            unpack8(ql, p);
            unpack8(rl, pp);
#pragma unroll
            for (int e = 0; e < 8; ++e) { const float x = p[e] + (pp[e] - p[e]) * mul[e]; s[e] = lane < 8 ? tanhf(x) : (lane < 16 ? x : sigmoidf_(x)); }
            *(v4u*)(AL + (size_t)m * KL + 8 * lane) = pack8(s);
        } else if (lane < 48 && !(l == 1 && lane < 40)) {
            *(v4u*)(AL + (size_t)m * KL + 8 * lane) = (v4u){0u, 0u, 0u, 0u};
        }
        if (l == 1) {
            float acc[32];
#pragma unroll
            for (int j = 0; j < 32; ++j) acc[j] = 0.f;
#pragma unroll
            for (int i = 0; i < 16; ++i) {
                const LAS v4u* wp = (const LAS v4u*)(v1L + (i * 64 + lane) * 40);
#pragma unroll
                for (int q = 0; q < 4; ++q) { float w8[8]; const v4u wq_ = wp[q]; unpack8(wq_, w8);
#pragma unroll
                    for (int e = 0; e < 8; ++e) acc[q * 8 + e] += vs[i] * w8[e]; }
            }
#pragma unroll
            for (int s = 32, half = 16; s >= 2; s >>= 1, half >>= 1) {
                const bool up = (lane & s) != 0;
#pragma unroll
                for (int i = 0; i < 16; ++i) if (i < half) { const float send = up ? acc[i] : acc[i + half]; const float keep = up ? acc[i + half] : acc[i]; acc[i] = keep + __shfl_xor(send, s); }
            }
            acc[0] += __shfl_xor(acc[0], 1);
            const int j = ((lane & 32) ? 16 : 0) + ((lane & 16) ? 8 : 0) + ((lane & 8) ? 4 : 0) + ((lane & 4) ? 2 : 0) + ((lane & 2) ? 1 : 0);
            if ((lane & 1) == 0) AL[(size_t)m * KL + 288 + j] = (bf16)f2bf(acc[0]);
        }
    }
    { float* DT = (float*)(ws + WS_OV + OV_DT); float* DA = (float*)(ws + WS_OV + OV_DA);
      for (int it = gw; it < (MH / 64) * 32; it += NGW) {
        const int ck = it >> 5, h = it & 31;
        const size_t m = (size_t)ck * 64 + lane;
        const float x = bf1(PR[m * N1P + DT_COL + h]) + a.in[I_DTB][l * 32 + h];
        const float dt = x > 20.f ? x : log1pf(__expf(x));
        float cs = -dt * __expf(a.in[I_ALOG][l * 32 + h]);
#pragma unroll
        for (int o = 1; o < 64; o <<= 1) { const float y = __shfl_up(cs, o); cs += (lane >= o) ? y : 0.f; }
        DT[m * 32 + h] = dt; DA[m * 32 + h] = cs;
      } }
}

__device__ __forceinline__ float sum8(float x) { x += dpp_mov<0xB1>(x); x += dpp_mov<0x4E>(x); x += dpp_mov<0x141>(x); return x; }
__device__ __forceinline__ void phase_rwkv_rec(const Ctx& c, KArgs& a, int l, int hb) {
    unsigned char* ws = a.ws;
    const bf16* PR = (const bf16*)(ws + WS_OV + OV_PR);
    const bf16* ELOG = (const bf16*)(ws + WS_OV + OV_ELOG);
    const bf16* ASIG = (const bf16*)(ws + WS_OV + OV_ASIG);
    const bf16* VS = l == 0 ? (const bf16*)(ws + WS_VF) + (size_t)hb * MH * D : (const bf16*)(ws + WS_OV + OV_VMIX);
    bf16* Y = (bf16*)(ws + WS_OV + OV_YA);
    const float* mu = a.in[I_MU] + (size_t)l * RW_PROJ;
    const float* k_k = a.in[I_KK] + (size_t)l * D; const float* k_a = a.in[I_KA] + (size_t)l * D;
    constexpr int CH = 32, NCH = T / CH;
    constexpr int ARRF = CH * 64;
    constexpr int BUFF = 5 * ARRF + CH * 16 + CH * 2;
    LAS float* ldsf = (LAS float*)c.lds;
    LAS float* yt = ldsf + 2 * BUFF;
    const int tid = c.tid, lane = c.lane;
    const bool is_prep = c.wave >= 4;
    const int ptid = tid - 256, tt = ptid >> 3, l8 = ptid & 7, pc = l8 * 8;
    const int rrow = c.wave * 4 + (lane >> 4), cc4 = (lane & 15) * 4;
    for (int unit = c.bid; unit < 256; unit += c.G) {
        const int b = unit >> 6, h = (unit >> 2) & 15, rq = unit & 3;
        const size_t m0 = (size_t)b * T;
        const int hc = h * 64 + pc;
        float mur[8], muk[8], kkc[8], kac[8];
        if (is_prep) {
#pragma unroll
            for (int e = 0; e < 8; ++e) { mur[e] = mu[hc + e]; muk[e] = mu[1024 + hc + e]; kkc[e] = k_k[hc + e]; kac[e] = k_a[hc + e]; }
        }
        float S[4] = {0.f, 0.f, 0.f, 0.f}, sa = 0.f;
#define RW_PREP(chunk, bufp) do { \
            const int t_ = (chunk) * CH + tt; const size_t mm = m0 + t_; const bf16* row = PR + mm * N1P + hc; \
            const v4u zr = (v4u){0u, 0u, 0u, 0u}; \
            const v4u qr = *(const v4u*)row, qk = *(const v4u*)(row + 1024); \
            const v4u qrp = t_ > 0 ? *(const v4u*)(row - N1P) : zr, qkp = t_ > 0 ? *(const v4u*)(row - N1P + 1024) : zr; \
            const v4u qkn = t_ + 1 < T ? *(const v4u*)(row + N1P + 1024) : zr; \
            const v4u qas = *(const v4u*)(ASIG + mm * D + hc), qel = *(const v4u*)(ELOG + mm * D + hc); \
            v4u qv = zr; if (l8 < 2) qv = *(const v4u*)(VS + mm * D + h * 64 + rq * 16 + l8 * 8); \
            float r_[8], rp_[8], k_[8], kp_[8], kn_[8], as_[8], el_[8]; \
            unpack8(qr, r_); unpack8(qrp, rp_); unpack8(qk, k_); unpack8(qkp, kp_); unpack8(qkn, kn_); unpack8(qas, as_); unpack8(qel, el_); \
            float ks_[8], kk_[8], kkn_[8], s1 = 0.f, s2 = 0.f; \
            _Pragma("unroll") for (int e = 0; e < 8; ++e) { ks_[e] = k_[e] + (kp_[e] - k_[e]) * muk[e]; const float kn1 = kn_[e] + (k_[e] - kn_[e]) * muk[e]; \
                kk_[e] = ks_[e] * kkc[e]; kkn_[e] = kn1 * kkc[e]; s1 += kk_[e] * kk_[e]; s2 += kkn_[e] * kkn_[e]; } \
            s1 = sum8(s1); s2 = sum8(s2); \
            const float i1 = rsqrtf(s1 + 1e-12f), i2 = (t_ + 1 < T) ? rsqrtf(s2 + 1e-12f) : 0.f; \
            float ow[8], ok[8], ob[8], orr[8], owa[8], c1 = 0.f, c2 = 0.f; \
            _Pragma("unroll") for (int e = 0; e < 8; ++e) { const float kn = kk_[e] * i1, an = -kkn_[e] * i2; \
                ow[e] = __expf(el_[e]); ok[e] = ks_[e] * (1.f + (as_[e] - 1.f) * kac[e]); ob[e] = kn * as_[e]; orr[e] = r_[e] + (rp_[e] - r_[e]) * mur[e]; \
                owa[e] = ow[e] * an; c1 += ob[e] * an; c2 += ok[e] * an; } \
            c1 = sum8(c1); c2 = sum8(c2); \
            LAS float* bp_ = (bufp) + tt * 64 + pc; \
            *(LAS f32x4*)(bp_) = (f32x4){ow[0], ow[1], ow[2], ow[3]}; *(LAS f32x4*)(bp_ + 4) = (f32x4){ow[4], ow[5], ow[6], ow[7]}; \
            *(LAS f32x4*)(bp_ + ARRF) = (f32x4){ok[0], ok[1], ok[2], ok[3]}; *(LAS f32x4*)(bp_ + ARRF + 4) = (f32x4){ok[4], ok[5], ok[6], ok[7]}; \
            *(LAS f32x4*)(bp_ + 2 * ARRF) = (f32x4){ob[0], ob[1], ob[2], ob[3]}; *(LAS f32x4*)(bp_ + 2 * ARRF + 4) = (f32x4){ob[4], ob[5], ob[6], ob[7]}; \
            *(LAS f32x4*)(bp_ + 3 * ARRF) = (f32x4){orr[0], orr[1], orr[2], orr[3]}; *(LAS f32x4*)(bp_ + 3 * ARRF + 4) = (f32x4){orr[4], orr[5], orr[6], orr[7]}; \
            *(LAS f32x4*)(bp_ + 4 * ARRF) = (f32x4){owa[0], owa[1], owa[2], owa[3]}; *(LAS f32x4*)(bp_ + 4 * ARRF + 4) = (f32x4){owa[4], owa[5], owa[6], owa[7]}; \
            if (l8 < 2) { float v_[8]; unpack8(qv, v_); LAS float* vp_ = (bufp) + 5 * ARRF + tt * 16 + l8 * 8; \
                *(LAS f32x4*)vp_ = (f32x4){v_[0], v_[1], v_[2], v_[3]}; *(LAS f32x4*)(vp_ + 4) = (f32x4){v_[4], v_[5], v_[6], v_[7]}; } \
            if (l8 == 0) { (bufp)[5 * ARRF + CH * 16 + tt * 2] = c1; (bufp)[5 * ARRF + CH * 16 + tt * 2 + 1] = c2; } } while (0)
#define RW_YSTORE(chunk) do { const LAS float* yp_ = yt + ((chunk) & 1) * CH * 16 + tt * 16 + l8 * 2; \
            *(unsigned*)(Y + (m0 + (size_t)(chunk) * CH + tt) * D + h * 64 + rq * 16 + l8 * 2) = pk2(yp_[0], yp_[1]); } while (0)
        if (is_prep) RW_PREP(0, ldsf);
        __syncthreads();
        for (int ch = 0; ch < NCH; ++ch) {
            if (is_prep) {
                if (ch + 1 < NCH) RW_PREP(ch + 1, ldsf + ((ch + 1) & 1) * BUFF);
                if (ch > 0) RW_YSTORE(ch - 1);
            } else {
                const LAS float* buf = ldsf + (ch & 1) * BUFF;
                LAS float* yw = yt + (ch & 1) * CH * 16;
                const int lane15 = lane & 15;
                f32x4 w4 = *(const LAS f32x4*)(buf + cc4), k4 = *(const LAS f32x4*)(buf + ARRF + cc4), b4 = *(const LAS f32x4*)(buf + 2 * ARRF + cc4);
                f32x4 r4 = *(const LAS f32x4*)(buf + 3 * ARRF + cc4), wa4 = *(const LAS f32x4*)(buf + 4 * ARRF + cc4);
                float v = buf[5 * ARRF + rrow]; f32x2 cc = *(const LAS f32x2*)(buf + 5 * ARRF + CH * 16);
#pragma unroll 1
                for (int t16 = 0; t16 < CH; t16 += 16) {
                    float ysave = 0.f;
#pragma unroll
                    for (int u = 0; u < 16; ++u) {
                        const int tn = (t16 + u + 1 < CH) ? t16 + u + 1 : t16 + u;
                        const f32x4 nw4 = *(const LAS f32x4*)(buf + tn * 64 + cc4), nk4 = *(const LAS f32x4*)(buf + ARRF + tn * 64 + cc4), nb4 = *(const LAS f32x4*)(buf + 2 * ARRF + tn * 64 + cc4);
                        const f32x4 nr4 = *(const LAS f32x4*)(buf + 3 * ARRF + tn * 64 + cc4), nwa4 = *(const LAS f32x4*)(buf + 4 * ARRF + tn * 64 + cc4);
                        const float nv = buf[5 * ARRF + tn * 16 + rrow]; const f32x2 ncc = *(const LAS f32x2*)(buf + 5 * ARRF + CH * 16 + tn * 2);
                        float d = S[0] * wa4[0]; d = __builtin_fmaf(S[1], wa4[1], d); d = __builtin_fmaf(S[2], wa4[2], d); d = __builtin_fmaf(S[3], wa4[3], d);
#pragma unroll
                        for (int e = 0; e < 4; ++e) { float tmp = S[e] * w4[e]; asm volatile("" : "+v"(tmp)); tmp = __builtin_fmaf(v, k4[e], tmp); S[e] = __builtin_fmaf(sa, b4[e], tmp); asm volatile("" : "+v"(S[e])); }
                        const float sa_next = __builtin_fmaf(v, cc.y, sa * cc.x);
                        float y = S[0] * r4[0]; y = __builtin_fmaf(S[1], r4[1], y); y = __builtin_fmaf(S[2], r4[2], y); y = __builtin_fmaf(S[3], r4[3], y);
                        d = sum16(d); y = sum16(y);
                        sa = d + sa_next;
                        ysave = (lane15 == u) ? y : ysave;
                        w4 = nw4; k4 = nk4; b4 = nb4; r4 = nr4; wa4 = nwa4; v = nv; cc = ncc;
                    }
                    yw[(t16 + lane15) * 16 + rrow] = ysave;
                }
            }
            __syncthreads();
        }
        if (is_prep) RW_YSTORE(NCH - 1);
        __syncthreads();
#undef RW_PREP
#undef RW_YSTORE
    }
}

constexpr int CK_TS = 72, CK_TB = 64 * CK_TS;
__device__ __forceinline__ void tr_a2(unsigned a, bf16x8& f0, bf16x8& f1) {
    s16x4 l0, h0, l1, h1;
    asm volatile("ds_read_b64_tr_b16 %0, %4\n\tds_read_b64_tr_b16 %1, %4 offset:576\n\tds_read_b64_tr_b16 %2, %4 offset:4608\n\tds_read_b64_tr_b16 %3, %4 offset:5184\n\ts_waitcnt lgkmcnt(0)"
                 : "=&v"(l0), "=&v"(h0), "=&v"(l1), "=&v"(h1) : "v"(a) : "memory");
    f0 = __builtin_shufflevector(l0, h0, 0, 1, 2, 3, 4, 5, 6, 7); f1 = __builtin_shufflevector(l1, h1, 0, 1, 2, 3, 4, 5, 6, 7);
}
__device__ __forceinline__ void tr_b4(unsigned a, bf16x8& f00, bf16x8& f01, bf16x8& f10, bf16x8& f11) {
    s16x4 l0, h0, l1, h1, l2, h2, l3, h3;
    asm volatile("ds_read_b64_tr_b16 %0, %8\n\tds_read_b64_tr_b16 %1, %8 offset:576\n\tds_read_b64_tr_b16 %2, %8 offset:4608\n\tds_read_b64_tr_b16 %3, %8 offset:5184\n\t"
                 "ds_read_b64_tr_b16 %4, %8 offset:32\n\tds_read_b64_tr_b16 %5, %8 offset:608\n\tds_read_b64_tr_b16 %6, %8 offset:4640\n\tds_read_b64_tr_b16 %7, %8 offset:5216\n\ts_waitcnt lgkmcnt(0)"
                 : "=&v"(l0), "=&v"(h0), "=&v"(l1), "=&v"(h1), "=&v"(l2), "=&v"(h2), "=&v"(l3), "=&v"(h3) : "v"(a) : "memory");
    f00 = __builtin_shufflevector(l0, h0, 0, 1, 2, 3, 4, 5, 6, 7); f01 = __builtin_shufflevector(l1, h1, 0, 1, 2, 3, 4, 5, 6, 7);
    f10 = __builtin_shufflevector(l2, h2, 0, 1, 2, 3, 4, 5, 6, 7); f11 = __builtin_shufflevector(l3, h3, 0, 1, 2, 3, 4, 5, 6, 7);
}
template <int PA, int QA, int MASK, int NINIT, int NPAIR, int POST>
__device__ __forceinline__ void mm64(LAS bf16* X, const LAS bf16* P, const LAS bf16* Q, const LAS bf16* P2, const LAS bf16* Q2, const LAS bf16* E1, const LAS bf16* E2,
                                     const LAS float* cscale, const LAS float* wc, int w, int lane) {
    const int r = lane & 15, q = lane >> 4, Ct = w >> 1, Rt0 = 2 * (w & 1);
    const int i16 = lane & 15, qq = i16 >> 2, p4 = i16 & 3;
    const int troff = ((8 * q + qq) * CK_TS + 4 * p4) * 2;
    f32x4 acc[2];
#pragma unroll
    for (int i = 0; i < 2; ++i) {
        const int R = 16 * (Rt0 + i) + r;
        if (NINIT == 0) acc[i] = (f32x4){0.f, 0.f, 0.f, 0.f};
        else { const v2u e1 = *(const LAS v2u*)(E1 + R * CK_TS + 16 * Ct + 4 * q); acc[i] = (f32x4){bflo(e1.x), bfhi(e1.x), bflo(e1.y), bfhi(e1.y)};
            if (NINIT == 2) { const v2u e2 = *(const LAS v2u*)(E2 + R * CK_TS + 16 * Ct + 4 * q); acc[i] += (f32x4){bflo(e2.x), bfhi(e2.x), bflo(e2.y), bfhi(e2.y)}; } }
    }
#pragma unroll
    for (int pr = 0; pr < NPAIR; ++pr) {
        const LAS bf16* Pp = pr == 0 ? P : P2; const LAS bf16* Qp = pr == 0 ? Q : Q2;
        bf16x8 af[2], bfr[2][2];
        if (PA == 0) {
#pragma unroll
            for (int i = 0; i < 2; ++i)
#pragma unroll
                for (int ks = 0; ks < 2; ++ks) bfr[i][ks] = *(const LAS bf16x8*)(Pp + (16 * (Rt0 + i) + r) * CK_TS + 32 * ks + 8 * q);
        }
        if (QA == 1) {
#pragma unroll
            for (int ks = 0; ks < 2; ++ks) af[ks] = *(const LAS bf16x8*)(Qp + (16 * Ct + r) * CK_TS + 32 * ks + 8 * q);
        } else tr_a2((unsigned)(size_t)Qp + (unsigned)(troff + 32 * Ct), af[0], af[1]);
        if (PA == 1) tr_b4((unsigned)(size_t)Pp + (unsigned)(troff + 32 * Rt0), bfr[0][0], bfr[0][1], bfr[1][0], bfr[1][1]);
#pragma unroll
        for (int ks = 0; ks < 2; ++ks)
#pragma unroll
            for (int i = 0; i < 2; ++i) acc[i] = __builtin_amdgcn_mfma_f32_16x16x32_bf16(af[ks], bfr[i][ks], acc[i], 0, 0, 0);
    }
#pragma unroll
    for (int i = 0; i < 2; ++i) {
        const int R = 16 * (Rt0 + i) + r;
        float v[4];
#pragma unroll
        for (int e = 0; e < 4; ++e) { const int C = 16 * Ct + 4 * q + e; float x = acc[i][e];
            if (MASK == 1) x = (C < R) ? x : 0.f;
            if (MASK == 2) x = (C <= R) ? x : 0.f;
            if (POST >= 1) x *= cscale[C];
            if (POST == 2) x += (C == R) ? wc[C] : 0.f;
            v[e] = x; }
        v2u o; o.x = pk2c(v[0], v[1]); o.y = pk2c(v[2], v[3]);
        *(LAS v2u*)(X + R * CK_TS + 16 * Ct + 4 * q) = o;
    }
}

template <int PA, int QA, int MASK, int NINIT, int NPAIR, int POST>
__device__ __forceinline__ void mm64h(LAS bf16* X, const LAS bf16* P, const LAS bf16* Q, const LAS bf16* P2, const LAS bf16* Q2, const LAS bf16* E1, const LAS bf16* E2,
                                      const LAS float* cscale, const LAS float* wc, int ws, int lane) {
    const int r = lane & 15, q = lane >> 4, Cb = ws >> 1, Rb = ws & 1;
    const int i16 = lane & 15, qq = i16 >> 2, p4 = i16 & 3;
    const int troff = ((8 * q + qq) * CK_TS + 4 * p4) * 2;
    f32x4 acc[2][2];
#pragma unroll
    for (int ci = 0; ci < 2; ++ci)
#pragma unroll
        for (int ri = 0; ri < 2; ++ri) {
            const int R = 16 * (2 * Rb + ri) + r, C0 = 16 * (2 * Cb + ci) + 4 * q;
            if (NINIT == 0) acc[ci][ri] = (f32x4){0.f, 0.f, 0.f, 0.f};
            else { const v2u e1 = *(const LAS v2u*)(E1 + R * CK_TS + C0); acc[ci][ri] = (f32x4){bflo(e1.x), bfhi(e1.x), bflo(e1.y), bfhi(e1.y)};
                if (NINIT == 2) { const v2u e2 = *(const LAS v2u*)(E2 + R * CK_TS + C0); acc[ci][ri] += (f32x4){bflo(e2.x), bfhi(e2.x), bflo(e2.y), bfhi(e2.y)}; } }
        }
#pragma unroll
    for (int pr = 0; pr < NPAIR; ++pr) {
        const LAS bf16* Pp = pr == 0 ? P : P2; const LAS bf16* Qp = pr == 0 ? Q : Q2;
        bf16x8 af[2][2], bfr[2][2];
        if (PA == 0) {
#pragma unroll
            for (int ri = 0; ri < 2; ++ri)
#pragma unroll
                for (int ks = 0; ks < 2; ++ks) bfr[ri][ks] = *(const LAS bf16x8*)(Pp + (16 * (2 * Rb + ri) + r) * CK_TS + 32 * ks + 8 * q);
        }
        if (QA == 1) {
#pragma unroll
            for (int ci = 0; ci < 2; ++ci)
#pragma unroll
                for (int ks = 0; ks < 2; ++ks) af[ci][ks] = *(const LAS bf16x8*)(Qp + (16 * (2 * Cb + ci) + r) * CK_TS + 32 * ks + 8 * q);
        } else tr_b4((unsigned)(size_t)Qp + (unsigned)(troff + 64 * Cb), af[0][0], af[0][1], af[1][0], af[1][1]);
        if (PA == 1) tr_b4((unsigned)(size_t)Pp + (unsigned)(troff + 64 * Rb), bfr[0][0], bfr[0][1], bfr[1][0], bfr[1][1]);
#pragma unroll
        for (int ks = 0; ks < 2; ++ks)
#pragma unroll
            for (int ci = 0; ci < 2; ++ci)
#pragma unroll
                for (int ri = 0; ri < 2; ++ri) acc[ci][ri] = __builtin_amdgcn_mfma_f32_16x16x32_bf16(af[ci][ks], bfr[ri][ks], acc[ci][ri], 0, 0, 0);
    }
#pragma unroll
    for (int ci = 0; ci < 2; ++ci)
#pragma unroll
        for (int ri = 0; ri < 2; ++ri) {
            const int R = 16 * (2 * Rb + ri) + r;
            float v[4];
#pragma unroll
            for (int e = 0; e < 4; ++e) { const int C = 16 * (2 * Cb + ci) + 4 * q + e; float x = acc[ci][ri][e];
                if (MASK == 1) x = (C < R) ? x : 0.f;
                if (MASK == 2) x = (C <= R) ? x : 0.f;
                if (POST >= 1) x *= cscale[C];
                if (POST == 2) x += (C == R) ? wc[C] : 0.f;
                v[e] = x; }
            v2u o; o.x = pk2c(v[0], v[1]); o.y = pk2c(v[2], v[3]);
            *(LAS v2u*)(X + R * CK_TS + 16 * (2 * Cb + ci) + 4 * q) = o;
        }
}

__device__ __forceinline__ void phase_rwkv_chunk_par(const Ctx& c, KArgs& a, int l, int hb) {
    unsigned char* ws = a.ws;
    bf16* PR = (bf16*)(ws + WS_OV + OV_PR);
    bf16* ELOG = (bf16*)(ws + WS_OV + OV_ELOG);
    const bf16* ASIG = (const bf16*)(ws + WS_OV + OV_ASIG);
    const bf16* VS = l == 0 ? (const bf16*)(ws + WS_VF) + (size_t)hb * MH * D : (const bf16*)(ws + WS_OV + OV_VMIX);
    bf16* Y = (bf16*)(ws + WS_OV + OV_YA);
    bf16* SLB = (bf16*)(ws + WS_OV + OV_AL);
    const float* mu = a.in[I_MU] + (size_t)l * RW_PROJ;
    const float* k_k = a.in[I_KK] + (size_t)l * D; const float* k_a = a.in[I_KA] + (size_t)l * D; const float* rk_ = a.in[I_RK] + (size_t)l * D;
    float* BON = (float*)(ws + WS_OV + OV_BON);
    LAS bf16* tile = (LAS bf16*)c.lds;
    enum { tA = 0, tR, tBt, tKt, tBh, tKh, tV, tNab, tNak, tNrb, tNrk, tM0, tM1, tP1, tX1, NT };
#define TL(i) (tile + (i) * CK_TB)
    LAS float* cscale = (LAS float*)(tile + NT * CK_TB);
    LAS float* wcv = cscale + 64;
    LAS float* SCR = (LAS float*)TL(tM0);
    LAS float* SEGT = SCR + 64 * 64;
    const int tid = c.tid, lane = c.lane, w = c.wave;
    const int tt = tid >> 3, l8 = tid & 7, pc = l8 * 8;
    v4u qr, qk, qrp, qkp, qas, qel, qv;
#define CK_LOAD(un) do { const int b_ = (un) >> 10, h_ = ((un) >> 6) & 15, ch_ = (un) & 63; const int t_ = ch_ * 64 + tt; \
        const size_t mm = (size_t)b_ * T + (size_t)t_; const bf16* row = PR + mm * N1P + h_ * 64 + pc; const v4u zr = (v4u){0u, 0u, 0u, 0u}; \
        qr = *(const v4u*)row; qk = *(const v4u*)(row + 1024); qrp = t_ > 0 ? *(const v4u*)(row - N1P) : zr; qkp = t_ > 0 ? *(const v4u*)(row - N1P + 1024) : zr; \
        qas = *(const v4u*)(ASIG + mm * D + h_ * 64 + pc); qel = *(const v4u*)(ELOG + mm * D + h_ * 64 + pc); qv = *(const v4u*)(VS + mm * D + h_ * 64 + pc); } while (0)
    if (c.bid < 4096) CK_LOAD(c.bid);
    for (int unit = c.bid; unit < 4096; unit += c.G) {
        const int b = unit >> 10, h = (unit >> 6) & 15, ch = unit & 63;
        const size_t m0 = (size_t)b * T + (size_t)ch * 64;
        const int hc = h * 64 + pc;
        for (int rep = 0; rep < (PROBE_DUP == 7 ? 2 : 1); ++rep) {
        if (PROBE_DUP == 7) { CK_LOAD(unit); }
        float r_[8], k_[8], as_[8], el_[8], v_[8], kk_[8], ks_[8];
        {
            float rp_[8], kp_[8];
            unpack8(qr, r_); unpack8(qrp, rp_); unpack8(qk, k_); unpack8(qkp, kp_); unpack8(qas, as_); unpack8(qel, el_); unpack8(qv, v_);
            if (PROBE_DUP != 7 && unit + c.G < 4096) CK_LOAD(unit + c.G);
            float s1 = 0.f;
#pragma unroll
            for (int e = 0; e < 8; ++e) { r_[e] = r_[e] + (rp_[e] - r_[e]) * mu[hc + e]; ks_[e] = k_[e] + (kp_[e] - k_[e]) * mu[1024 + hc + e]; kk_[e] = ks_[e] * k_k[hc + e]; s1 += kk_[e] * kk_[e]; }
            s1 = sum8(s1);
            const float i1 = rsqrtf(s1 + 1e-12f);
#pragma unroll
            for (int e = 0; e < 8; ++e) { kk_[e] *= i1; k_[e] = ks_[e] * (1.f + (as_[e] - 1.f) * k_a[hc + e]); }
            { float bn = 0.f;
#pragma unroll
              for (int e = 0; e < 8; ++e) bn += r_[e] * k_[e] * rk_[hc + e];
              bn = sum8(bn);
              if (l8 == 0) BON[(m0 + tt) * 16 + h] = bn; }
            *(LAS f32x4*)(SCR + tt * 64 + pc) = (f32x4){el_[0], el_[1], el_[2], el_[3]}; *(LAS f32x4*)(SCR + tt * 64 + pc + 4) = (f32x4){el_[4], el_[5], el_[6], el_[7]};
        }
        lds_barrier();
        {
            const int col = tid & 63, seg = tid >> 6; float s = 0.f;
#pragma unroll
            for (int i = 0; i < 8; ++i) { s += SCR[(8 * seg + i) * 64 + col]; SCR[(8 * seg + i) * 64 + col] = s; }
            SEGT[seg * 64 + col] = s;
        }
        lds_barrier();
        {
            const int col = tid & 63, seg = tid >> 6; float pre = 0.f;
#pragma unroll
            for (int s2 = 0; s2 < 7; ++s2) pre += (s2 < seg) ? SEGT[s2 * 64 + col] : 0.f;
#pragma unroll
            for (int i = 0; i < 8; ++i) SCR[(8 * seg + i) * 64 + col] += pre;
        }
        lds_barrier();
        {
            float L[8], Lr[8], Le[8];
            { const f32x4 x0 = *(const LAS f32x4*)(SCR + tt * 64 + pc), x1 = *(const LAS f32x4*)(SCR + tt * 64 + pc + 4);
              const f32x4 y0 = *(const LAS f32x4*)(SCR + 31 * 64 + pc), y1 = *(const LAS f32x4*)(SCR + 31 * 64 + pc + 4);
              const f32x4 z0 = *(const LAS f32x4*)(SCR + 63 * 64 + pc), z1 = *(const LAS f32x4*)(SCR + 63 * 64 + pc + 4);
#pragma unroll
              for (int e = 0; e < 4; ++e) { L[e] = x0[e]; L[4 + e] = x1[e]; Lr[e] = y0[e]; Lr[4 + e] = y1[e]; Le[e] = z0[e]; Le[4 + e] = z1[e]; } }
            float oA[8], oR[8], oBt[8], oKt[8], oBh[8], oKh[8];
#pragma unroll
            for (int e = 0; e < 8; ++e) {
                const float ea = __expf(L[e] - el_[e] - Lr[e]), er = __expf(L[e] - Lr[e]), eb = __expf(Lr[e] - L[e]), eh = __expf(Le[e] - L[e]);
                const float bb = kk_[e] * as_[e];
                oA[e] = -kk_[e] * ea; oR[e] = r_[e] * er; oBt[e] = bb * eb; oKt[e] = k_[e] * eb; oBh[e] = bb * eh; oKh[e] = k_[e] * eh;
            }
            const int o = tt * CK_TS + pc;
            *(LAS v4u*)(TL(tA) + o) = pack8(oA); *(LAS v4u*)(TL(tR) + o) = pack8(oR); *(LAS v4u*)(TL(tBt) + o) = pack8(oBt); *(LAS v4u*)(TL(tKt) + o) = pack8(oKt);
            *(LAS v4u*)(TL(tBh) + o) = pack8(oBh); *(LAS v4u*)(TL(tKh) + o) = pack8(oKh); *(LAS v4u*)(TL(tV) + o) = pack8(v_);
            if (tt == 0) {
#pragma unroll
                for (int e = 0; e < 8; ++e) { cscale[pc + e] = __expf(Lr[e]); wcv[pc + e] = __expf(Le[e]); }
            }
        }
        lds_barrier();
        const LAS bf16* Z = nullptr;
        const int wg_ = w >> 2, ws_ = w & 3;
        if (wg_ == 0) { mm64h<0, 1, 1, 0, 1, 0>(TL(tNab), TL(tA), TL(tBt), Z, Z, Z, Z, cscale, wcv, ws_, lane);
                        mm64h<0, 1, 1, 0, 1, 0>(TL(tNak), TL(tA), TL(tKt), Z, Z, Z, Z, cscale, wcv, ws_, lane); }
        else          { mm64h<0, 1, 2, 0, 1, 0>(TL(tNrb), TL(tR), TL(tBt), Z, Z, Z, Z, cscale, wcv, ws_, lane);
                        mm64h<0, 1, 2, 0, 1, 0>(TL(tNrk), TL(tR), TL(tKt), Z, Z, Z, Z, cscale, wcv, ws_, lane); }
        lds_barrier();
        if (wg_ == 0) mm64h<0, 0, 0, 0, 1, 0>(TL(tM0), TL(tNab), TL(tNab), Z, Z, Z, Z, cscale, wcv, ws_, lane);
        else          mm64h<0, 0, 0, 0, 1, 0>(TL(tX1), TL(tNak), TL(tV), Z, Z, Z, Z, cscale, wcv, ws_, lane);
        lds_barrier();
        if (wg_ == 0) mm64h<0, 0, 0, 2, 1, 0>(TL(tP1), TL(tNab), TL(tM0), Z, Z, TL(tNab), TL(tM0), cscale, wcv, ws_, lane);
        else          mm64h<0, 0, 0, 0, 1, 0>(TL(tM1), TL(tM0), TL(tM0), Z, Z, Z, Z, cscale, wcv, ws_, lane);
        lds_barrier();
        if (wg_ == 0) mm64h<0, 0, 0, 2, 1, 0>(TL(tNab), TL(tP1), TL(tM1), Z, Z, TL(tP1), TL(tM1), cscale, wcv, ws_, lane);
        else          mm64h<0, 0, 0, 0, 1, 0>(TL(tM0), TL(tM1), TL(tM1), Z, Z, Z, Z, cscale, wcv, ws_, lane);
        lds_barrier();
        if (wg_ == 0) mm64h<0, 0, 0, 2, 1, 0>(TL(tP1), TL(tNab), TL(tM0), Z, Z, TL(tNab), TL(tM0), cscale, wcv, ws_, lane);
        else          mm64h<0, 0, 0, 0, 1, 0>(TL(tM1), TL(tM0), TL(tM0), Z, Z, Z, Z, cscale, wcv, ws_, lane);
        lds_barrier();
        if (wg_ == 0) mm64h<0, 0, 0, 2, 1, 0>(TL(tNab), TL(tP1), TL(tM1), Z, Z, TL(tP1), TL(tM1), cscale, wcv, ws_, lane);
        else          mm64h<0, 0, 0, 0, 1, 0>(TL(tM0), TL(tM1), TL(tM1), Z, Z, Z, Z, cscale, wcv, ws_, lane);
        lds_barrier();
        mm64<0, 0, 0, 2, 1, 0>(TL(tP1), TL(tNab), TL(tM0), Z, Z, TL(tNab), TL(tM0), cscale, wcv, w, lane);
        lds_barrier();
        if (wg_ == 0) mm64h<0, 0, 0, 1, 1, 0>(TL(tBt), TL(tP1), TL(tA), Z, Z, TL(tA), Z, cscale, wcv, ws_, lane);
        else          mm64h<0, 0, 0, 1, 1, 0>(TL(tKt), TL(tP1), TL(tX1), Z, Z, TL(tX1), Z, cscale, wcv, ws_, lane);
        lds_barrier();
        if (wg_ == 0) { mm64h<0, 0, 0, 1, 1, 1>(TL(tM0), TL(tNrb), TL(tBt), Z, Z, TL(tR), Z, cscale, wcv, ws_, lane);
                        mm64h<0, 0, 0, 0, 2, 0>(TL(tM1), TL(tNrb), TL(tKt), TL(tNrk), TL(tV), Z, Z, cscale, wcv, ws_, lane); }
        else          { mm64h<1, 0, 0, 0, 1, 2>(TL(tNab), TL(tBh), TL(tBt), Z, Z, Z, Z, cscale, wcv, ws_, lane);
                        mm64h<1, 0, 0, 0, 2, 0>(TL(tX1), TL(tKt), TL(tBh), TL(tV), TL(tKh), Z, Z, cscale, wcv, ws_, lane); }
        lds_barrier();
        }
        {
            const size_t grow = m0 + tt;
            *(v4u*)(ELOG + grow * D + hc) = *(const LAS v4u*)(TL(tM0) + tt * CK_TS + pc);
            *(v4u*)(Y + grow * D + hc) = *(const LAS v4u*)(TL(tM1) + tt * CK_TS + pc);
            *(v4u*)(PR + grow * N1P + 2048 + hc) = *(const LAS v4u*)(TL(tNab) + tt * CK_TS + pc);
            *(v4u*)(SLB + grow * D + hc) = *(const LAS v4u*)(TL(tX1) + tt * CK_TS + pc);
        }
        lds_barrier();
    }
#undef TL
#undef CK_LOAD
}

struct SeqOps { v4u g0, g1, p0, p1; v2u sl, yl; };
__device__ __forceinline__ void phase_rwkv_chunk_seq(const Ctx& c, KArgs& a, const bool commit = true) {
    unsigned char* ws = a.ws;
    const bf16* PR = (const bf16*)(ws + WS_OV + OV_PR);
    const bf16* RP = (const bf16*)(ws + WS_OV + OV_ELOG);
    bf16* Y = (bf16*)(ws + WS_OV + OV_YA);
    const bf16* SLB = (const bf16*)(ws + WS_OV + OV_AL);
    LAS bf16* SL = (LAS bf16*)c.lds;
    const int tid = c.tid, lane = c.lane, w = c.wave, r = lane & 15, q = lane >> 4;
    constexpr int PF = 4;
    for (int unit = c.bid; unit < 256; unit += c.G) {
        const int b = unit >> 6, h = (unit >> 2) & 15, vq = unit & 3;
        for (int e = tid; e < 2 * 16 * CK_TS / 2; e += 512) ((LAS unsigned*)SL)[e] = 0u;
        __syncthreads();
        if (w < 4) {
            const size_t rowG = (size_t)b * T + 16 * w + r;
            const size_t rowS = (size_t)b * T + vq * 16 + r;
            SeqOps ops[PF];
#define SQ_LOAD(dst, chn) do { const size_t o_ = (size_t)(chn) * 64; \
                dst.g0 = *(const v4u*)(PR + (rowG + o_) * N1P + 2048 + h * 64 + 8 * q); dst.g1 = *(const v4u*)(PR + (rowG + o_) * N1P + 2048 + h * 64 + 32 + 8 * q); \
                dst.p0 = *(const v4u*)(RP + (rowG + o_) * D + h * 64 + 8 * q); dst.p1 = *(const v4u*)(RP + (rowG + o_) * D + h * 64 + 32 + 8 * q); \
                dst.sl = *(const v2u*)(SLB + (rowS + o_) * D + h * 64 + 16 * w + 4 * q); dst.yl = *(const v2u*)(Y + (rowG + o_) * D + h * 64 + vq * 16 + 4 * q); } while (0)
#pragma unroll
            for (int i = 0; i < PF; ++i) SQ_LOAD(ops[i], i);
            for (int ch0 = 0; ch0 < 64; ch0 += PF) {
#pragma unroll
                for (int i = 0; i < PF; ++i) {
                    const int ch = ch0 + i;
                    const SeqOps cur = ops[i];
                    if (ch + PF < 64) SQ_LOAD(ops[i], ch + PF);
                    const LAS bf16* Sc = SL + (i & 1) * 16 * CK_TS; LAS bf16* Sn = SL + ((i + 1) & 1) * 16 * CK_TS;
                    const bf16x8 s0 = *(const LAS bf16x8*)(Sc + r * CK_TS + 8 * q), s1 = *(const LAS bf16x8*)(Sc + r * CK_TS + 32 + 8 * q);
                    f32x4 accS = (f32x4){bflo(cur.sl.x), bfhi(cur.sl.x), bflo(cur.sl.y), bfhi(cur.sl.y)};
                    accS = __builtin_amdgcn_mfma_f32_16x16x32_bf16(__builtin_bit_cast(bf16x8, cur.g0), s0, accS, 0, 0, 0);
                    accS = __builtin_amdgcn_mfma_f32_16x16x32_bf16(__builtin_bit_cast(bf16x8, cur.g1), s1, accS, 0, 0, 0);
                    f32x4 accY = (f32x4){bflo(cur.yl.x), bfhi(cur.yl.x), bflo(cur.yl.y), bfhi(cur.yl.y)};
                    accY = __builtin_amdgcn_mfma_f32_16x16x32_bf16(s0, __builtin_bit_cast(bf16x8, cur.p0), accY, 0, 0, 0);
                    accY = __builtin_amdgcn_mfma_f32_16x16x32_bf16(s1, __builtin_bit_cast(bf16x8, cur.p1), accY, 0, 0, 0);
                    { v2u o; o.x = pk2c(accS[0], accS[1]); o.y = pk2c(accS[2], accS[3]); *(LAS v2u*)(Sn + r * CK_TS + 16 * w + 4 * q) = o; }
                    if (commit || accY[0] == 123456.789f) { v2u o; o.x = pk2c(accY[0], accY[1]); o.y = pk2c(accY[2], accY[3]); *(v2u*)(Y + (rowG + (size_t)ch * 64) * D + h * 64 + vq * 16 + 4 * q) = o; }
                    lds_barrier();
                }
            }
#undef SQ_LOAD
        } else {
            for (int ch = 0; ch < 64; ++ch) lds_barrier();
        }
        __syncthreads();
    }
}

__device__ __forceinline__ void phase_rwkv_post(const Ctx& c, KArgs& a, int l, int hb) {
    unsigned char* ws = a.ws;
    const bf16* GG = (const bf16*)(ws + WS_OV + OV_GG);
    const bf16* VS = l == 0 ? (const bf16*)(ws + WS_VF) + (size_t)hb * MH * D : (const bf16*)(ws + WS_OV + OV_VMIX);
    const float* BON = (const float*)(ws + WS_OV + OV_BON);
    bf16* Y = (bf16*)(ws + WS_OV + OV_YA);
    const int lane = c.lane, c0 = 16 * lane;
    float lw[16], lb[16];
#pragma unroll
    for (int e = 0; e < 16; ++e) { lw[e] = a.in[I_LNW][(size_t)l * D + c0 + e]; lb[e] = a.in[I_LNB][(size_t)l * D + c0 + e]; }
    const int gw = c.bid * 8 + c.wave, NGW = c.G * 8;
    v4u ny0, ny1, nv0, nv1, ng0, ng1; float nbon = 0.f;
#define RP_LOAD(mm) do { ny0 = *(const v4u*)(Y + (size_t)(mm) * D + c0); ny1 = *(const v4u*)(Y + (size_t)(mm) * D + c0 + 8); nv0 = *(const v4u*)(VS + (size_t)(mm) * D + c0); nv1 = *(const v4u*)(VS + (size_t)(mm) * D + c0 + 8); \
        ng0 = *(const v4u*)(GG + (size_t)(mm) * D + c0); ng1 = *(const v4u*)(GG + (size_t)(mm) * D + c0 + 8); nbon = BON[(size_t)(mm) * 16 + (lane >> 2)]; } while (0)
    if (gw < MH) RP_LOAD(gw);
    for (int m = gw; m < MH; m += NGW) {
        float y[16], v[16], g[16], t8[8];
        const v4u cy0 = ny0, cy1 = ny1, cv0 = nv0, cv1 = nv1, cg0 = ng0, cg1 = ng1; const float bon = nbon;
        if (m + NGW < MH) RP_LOAD(m + NGW);
#define UP16(dst, qa, qb) do { unpack8(qa, t8); _Pragma("unroll") for (int e = 0; e < 8; ++e) dst[e] = t8[e]; unpack8(qb, t8); _Pragma("unroll") for (int e = 0; e < 8; ++e) dst[8 + e] = t8[e]; } while (0)
        UP16(y, cy0, cy1); UP16(v, cv0, cv1); UP16(g, cg0, cg1);
#undef UP16
        float s1 = 0.f;
#pragma unroll
        for (int e = 0; e < 16; ++e) s1 += y[e];
        s1 = sum4(s1);
        const float mean = s1 * (1.f / 64.f);
        float s2 = 0.f;
#pragma unroll
        for (int e = 0; e < 16; ++e) { const float d = y[e] - mean; s2 += d * d; }
        s2 = sum4(s2);
        const float rstd = rsqrtf(s2 * (1.f / 64.f) + 64e-5f);
        float o[16];
#pragma unroll
        for (int e = 0; e < 16; ++e) o[e] = ((y[e] - mean) * rstd * lw[e] + lb[e] + bon * v[e]) * g[e];
        v4u o0, o1;
        o0.x = pk2(o[0], o[1]); o0.y = pk2(o[2], o[3]); o0.z = pk2(o[4], o[5]); o0.w = pk2(o[6], o[7]);
        o1.x = pk2(o[8], o[9]); o1.y = pk2(o[10], o[11]); o1.z = pk2(o[12], o[13]); o1.w = pk2(o[14], o[15]);
        *(v4u*)(Y + (size_t)m * D + c0) = o0; *(v4u*)(Y + (size_t)m * D + c0 + 8) = o1;
    }
}

__device__ __forceinline__ void phase_ssd_conv(const Ctx& c, KArgs& a, int l) {
    unsigned char* ws = a.ws;
    const bf16* PS = (const bf16*)(ws + WS_OV + OV_PS);
    bf16* XBC = (bf16*)(ws + WS_OV + OV_XBC);
    float* DT = (float*)(ws + WS_OV + OV_DT); float* DA = (float*)(ws + WS_OV + OV_DA);
    const float* cw = a.in[I_CW] + (size_t)l * 4 * 3072; const float* cb = a.in[I_CB] + (size_t)l * 3072;
    const int gw = c.bid * 8 + c.wave, NGW = c.G * 8, lane = c.lane;
    constexpr int RUN = 16, NRUN = MH / RUN;
    for (int it = gw; it < 2 * NRUN; it += NGW) {
        const int cb_ = 4 + (it & 1), run = it >> 1, ch0 = cb_ * 512 + lane * 8, m0 = run * RUN;
        float w[4][8], bias[8];
#pragma unroll
        for (int j = 0; j < 4; ++j)
#pragma unroll
            for (int e = 0; e < 8; ++e) w[j][e] = cw[j * 3072 + ch0 + e];
#pragma unroll
        for (int e = 0; e < 8; ++e) bias[e] = cb[ch0 + e];
        float x0[8], x1[8], x2[8], x3[8];
        const bf16* base = PS + (size_t)m0 * N2P + 2048 + ch0;
        const int t0 = m0 & (T - 1);
        if (t0 >= 3) { unpack8(*(const v4u*)(base - 3 * N2P), x0); unpack8(*(const v4u*)(base - 2 * N2P), x1); unpack8(*(const v4u*)(base - N2P), x2); }
        else {
#pragma unroll
            for (int e = 0; e < 8; ++e) { x0[e] = 0.f; x1[e] = 0.f; x2[e] = 0.f; }
        }
        v4u nx = *(const v4u*)base;
#pragma unroll 4
        for (int i = 0; i < RUN; ++i) {
            unpack8(nx, x3);
            if (i + 1 < RUN) nx = *(const v4u*)(base + (size_t)(i + 1) * N2P);
            float o[8];
#pragma unroll
            for (int e = 0; e < 8; ++e) { const float y = bias[e] + x0[e] * w[0][e] + x1[e] * w[1][e] + x2[e] * w[2][e] + x3[e] * w[3][e]; o[e] = siluf_(y); x0[e] = x1[e]; x1[e] = x2[e]; x2[e] = x3[e]; }
            *(v4u*)(XBC + (size_t)(m0 + i) * 3072 + ch0) = pack8(o);
        }
    }
}

__device__ __forceinline__ void tr_bm2(unsigned a, bf16x8& f0, bf16x8& f1) {
    s16x4 l0, h0, l1, h1;
    asm volatile("ds_read_b64_tr_b16 %0, %4\n\tds_read_b64_tr_b16 %1, %4 offset:1088\n\tds_read_b64_tr_b16 %2, %4 offset:8704\n\tds_read_b64_tr_b16 %3, %4 offset:9792\n\ts_waitcnt lgkmcnt(0)"
                 : "=&v"(l0), "=&v"(h0), "=&v"(l1), "=&v"(h1) : "v"(a) : "memory");
    f0 = __builtin_shufflevector(l0, h0, 0, 1, 2, 3, 4, 5, 6, 7); f1 = __builtin_shufflevector(l1, h1, 0, 1, 2, 3, 4, 5, 6, 7);
}
__device__ __forceinline__ void tr_x2(unsigned a, bf16x8& f0, bf16x8& f1) {
    s16x4 l0, h0, l1, h1;
    asm volatile("ds_read_b64_tr_b16 %0, %4\n\tds_read_b64_tr_b16 %1, %4 offset:320\n\tds_read_b64_tr_b16 %2, %4 offset:2560\n\tds_read_b64_tr_b16 %3, %4 offset:2880\n\ts_waitcnt lgkmcnt(0)"
                 : "=&v"(l0), "=&v"(h0), "=&v"(l1), "=&v"(h1) : "v"(a) : "memory");
    f0 = __builtin_shufflevector(l0, h0, 0, 1, 2, 3, 4, 5, 6, 7); f1 = __builtin_shufflevector(l1, h1, 0, 1, 2, 3, 4, 5, 6, 7);
}
__device__ __forceinline__ void tr_x4(unsigned a, bf16x8& f00, bf16x8& f01, bf16x8& f10, bf16x8& f11) {
    s16x4 l0, h0, l1, h1, l2, h2, l3, h3;
    asm volatile("ds_read_b64_tr_b16 %0, %8\n\tds_read_b64_tr_b16 %1, %8 offset:320\n\tds_read_b64_tr_b16 %2, %8 offset:2560\n\tds_read_b64_tr_b16 %3, %8 offset:2880\n\t"
                 "ds_read_b64_tr_b16 %4, %8 offset:32\n\tds_read_b64_tr_b16 %5, %8 offset:352\n\tds_read_b64_tr_b16 %6, %8 offset:2592\n\tds_read_b64_tr_b16 %7, %8 offset:2912\n\ts_waitcnt lgkmcnt(0)"
                 : "=&v"(l0), "=&v"(h0), "=&v"(l1), "=&v"(h1), "=&v"(l2), "=&v"(h2), "=&v"(l3), "=&v"(h3) : "v"(a) : "memory");
    f00 = __builtin_shufflevector(l0, h0, 0, 1, 2, 3, 4, 5, 6, 7); f01 = __builtin_shufflevector(l1, h1, 0, 1, 2, 3, 4, 5, 6, 7);
    f10 = __builtin_shufflevector(l2, h2, 0, 1, 2, 3, 4, 5, 6, 7); f11 = __builtin_shufflevector(l3, h3, 0, 1, 2, 3, 4, 5, 6, 7);
}
__device__ __forceinline__ void phase_ssd_scan(const Ctx& c, KArgs& a, int l) {
    unsigned char* ws = a.ws;
    const bf16* PS = (const bf16*)(ws + WS_OV + OV_PS);
    bf16* XBC = (bf16*)(ws + WS_OV + OV_XBC);
    const float* cw = a.in[I_CW] + (size_t)l * 4 * 3072; const float* cb = a.in[I_CB] + (size_t)l * 3072;
    const float* DT = (const float*)(ws + WS_OV + OV_DT); const float* ACS = (const float*)(ws + WS_OV + OV_DA);
    constexpr int SC = 136, SM = 72, SX = 40;
    LAS bf16* Cm = (LAS bf16*)c.lds;
    LAS bf16* Bm = Cm + 64 * SC;
    LAS bf16* Xd = Bm + 64 * SC;
    LAS bf16* Xs = Xd + 64 * SX;
    LAS bf16* Xr = Xs + 64 * SX;
    LAS bf16* MtT = Xr + 64 * SX;
    LAS bf16* SL = MtT + 64 * SM;
    LAS float* acsL = (LAS float*)(SL + 32 * SC);
    const unsigned BmB = (unsigned)(size_t)Bm, XdB = (unsigned)(size_t)Xd, XsB = (unsigned)(size_t)Xs;
    const int tid = c.tid, lane = c.lane, w = c.wave, r = lane & 15, q = lane >> 4;
    const int sj = tid >> 3, sn = (tid & 7) * 16, sp = (tid & 7) * 4;
    const int trq = ((lane & 15) >> 2), trp = lane & 3;
    const unsigned troffB = (unsigned)(((8 * q + trq) * SC + 4 * trp) * 2), troffX = (unsigned)(((8 * q + trq) * SX + 4 * trp) * 2);
    for (int unit = c.bid; unit < 256; unit += c.G) {
        const int b = unit >> 6, h = (unit >> 1) & 31, ph = unit & 1, g = h >> 3;
        const size_t m0 = (size_t)b * T;
        f32x4 st[2] = {(f32x4){0.f, 0.f, 0.f, 0.f}, (f32x4){0.f, 0.f, 0.f, 0.f}};
        for (int e = tid; e < 32 * SC / 2; e += 512) ((LAS unsigned*)SL)[e] = 0u;
        v4u gB0, gB1, gC0, gC1; v2u gX0, gX1, gX2, gX3; float gacs, gacsE, gdt;
        const int chx = h * 64 + ph * 32 + sp; const float Dh = a.in[I_SD][l * 32 + h];
        float cwt[4][4], cbs[4];
#pragma unroll
        for (int e2 = 0; e2 < 4; ++e2) { cbs[e2] = cb[chx + e2];
#pragma unroll
            for (int j = 0; j < 4; ++j) cwt[j][e2] = cw[j * 3072 + chx + e2]; }
#define SS_LOAD(chunk) do { const size_t row = m0 + (size_t)(chunk) * 64 + sj; const bf16* xr = XBC + row * 3072; \
            gB0 = *(const v4u*)(xr + 2048 + g * 128 + sn); gB1 = *(const v4u*)(xr + 2048 + g * 128 + sn + 8); \
            gC0 = *(const v4u*)(xr + 2560 + g * 128 + sn); gC1 = *(const v4u*)(xr + 2560 + g * 128 + sn + 8); \
            { const int t_ = (chunk) * 64 + sj; const bf16* pr_ = PS + row * N2P + 2048 + chx; const v2u z2 = (v2u){0u, 0u}; \
              gX3 = *(const v2u*)pr_; gX2 = t_ >= 1 ? *(const v2u*)(pr_ - N2P) : z2; gX1 = t_ >= 2 ? *(const v2u*)(pr_ - 2 * N2P) : z2; gX0 = t_ >= 3 ? *(const v2u*)(pr_ - 3 * N2P) : z2; } \
            gacs = ACS[row * 32 + h]; gacsE = ACS[(m0 + (size_t)(chunk) * 64 + 63) * 32 + h]; gdt = DT[row * 32 + h]; } while (0)
#define SS_STAGE() do { \
            *(LAS v4u*)(Bm + sj * SC + sn) = gB0; *(LAS v4u*)(Bm + sj * SC + sn + 8) = gB1; *(LAS v4u*)(Cm + sj * SC + sn) = gC0; *(LAS v4u*)(Cm + sj * SC + sn + 8) = gC1; \
            const float sc_ = gdt * __expf(gacsE - gacs); \
            const float r0_[4] = {bflo(gX0.x), bfhi(gX0.x), bflo(gX0.y), bfhi(gX0.y)}, r1_[4] = {bflo(gX1.x), bfhi(gX1.x), bflo(gX1.y), bfhi(gX1.y)}; \
            const float r2_[4] = {bflo(gX2.x), bfhi(gX2.x), bflo(gX2.y), bfhi(gX2.y)}, r3_[4] = {bflo(gX3.x), bfhi(gX3.x), bflo(gX3.y), bfhi(gX3.y)}; \
            float xa_[4]; _Pragma("unroll") for (int e2 = 0; e2 < 4; ++e2) xa_[e2] = siluf_(cbs[e2] + r0_[e2] * cwt[0][e2] + r1_[e2] * cwt[1][e2] + r2_[e2] * cwt[2][e2] + r3_[e2] * cwt[3][e2]); \
            const float x0_ = xa_[0], x1_ = xa_[1], x2_ = xa_[2], x3_ = xa_[3]; \
            v2u o1_, o2_; o1_.x = pk2(x0_ * gdt, x1_ * gdt); o1_.y = pk2(x2_ * gdt, x3_ * gdt); o2_.x = pk2(x0_ * sc_, x1_ * sc_); o2_.y = pk2(x2_ * sc_, x3_ * sc_); \
            *(LAS v2u*)(Xd + sj * SX + sp) = o1_; *(LAS v2u*)(Xs + sj * SX + sp) = o2_; { v2u o3_; o3_.x = pk2(x0_, x1_); o3_.y = pk2(x2_, x3_); *(LAS v2u*)(Xr + sj * SX + sp) = o3_; } \
            if ((tid & 7) == 0) acsL[sj] = gacs; } while (0)
        SS_LOAD(0);
        SS_STAGE();
        __syncthreads();
        for (int ch = 0; ch < T / 64; ++ch) {
            if (ch + 1 < T / 64) SS_LOAD(ch + 1);
            {
                const int jt = w >> 1, it0 = 2 * (w & 1);
                f32x4 acc0 = (f32x4){0.f, 0.f, 0.f, 0.f}, acc1 = acc0;
                if (it0 + 1 >= jt) {
#pragma unroll
                    for (int ks = 0; ks < 4; ++ks) {
                        const bf16x8 af = *(const LAS bf16x8*)(Bm + (16 * jt + r) * SC + 32 * ks + 8 * q);
                        const bf16x8 b0 = *(const LAS bf16x8*)(Cm + (16 * it0 + r) * SC + 32 * ks + 8 * q);
                        const bf16x8 b1 = *(const LAS bf16x8*)(Cm + (16 * (it0 + 1) + r) * SC + 32 * ks + 8 * q);
                        acc0 = __builtin_amdgcn_mfma_f32_16x16x32_bf16(af, b0, acc0, 0, 0, 0);
                        acc1 = __builtin_amdgcn_mfma_f32_16x16x32_bf16(af, b1, acc1, 0, 0, 0);
                    }
                }
                const int i0 = 16 * it0 + r, i1 = i0 + 16;
                const float ai0 = acsL[i0], ai1 = acsL[i1];
                float m0v[4], m1v[4];
#pragma unroll
                for (int e = 0; e < 4; ++e) { const int j = 16 * jt + 4 * q + e; const float aj = acsL[j];
                    m0v[e] = (j <= i0) ? acc0[e] * __expf(ai0 - aj) : 0.f; m1v[e] = (j <= i1) ? acc1[e] * __expf(ai1 - aj) : 0.f; }
                { v2u o0, o1; o0.x = pk2(m0v[0], m0v[1]); o0.y = pk2(m0v[2], m0v[3]); o1.x = pk2(m1v[0], m1v[1]); o1.y = pk2(m1v[2], m1v[3]);
                  *(LAS v2u*)(MtT + i0 * SM + 16 * jt + 4 * q) = o0; *(LAS v2u*)(MtT + i1 * SM + 16 * jt + 4 * q) = o1; }
            }
            lds_barrier();
            {
                const int it = w >> 1, pt = w & 1;
                f32x4 accD = (f32x4){0.f, 0.f, 0.f, 0.f}, accO = accD;
                {
                    bf16x8 xb0, xb1; tr_x2(XdB + troffX + 32u * pt, xb0, xb1);
                    const bf16x8 af0 = *(const LAS bf16x8*)(MtT + (16 * it + r) * SM + 8 * q);
                    accD = __builtin_amdgcn_mfma_f32_16x16x32_bf16(af0, xb0, accD, 0, 0, 0);
                    if (it >= 2) {
                        const bf16x8 af1 = *(const LAS bf16x8*)(MtT + (16 * it + r) * SM + 32 + 8 * q);
                        accD = __builtin_amdgcn_mfma_f32_16x16x32_bf16(af1, xb1, accD, 0, 0, 0);
                    }
                }
#pragma unroll
                for (int ks = 0; ks < 4; ++ks) {
                    const bf16x8 af = *(const LAS bf16x8*)(Cm + (16 * it + r) * SC + 32 * ks + 8 * q);
                    const bf16x8 bf_ = *(const LAS bf16x8*)(SL + (16 * pt + r) * SC + 32 * ks + 8 * q);
                    accO = __builtin_amdgcn_mfma_f32_16x16x32_bf16(af, bf_, accO, 0, 0, 0);
                }
                const int p = 16 * pt + r;
#pragma unroll
                for (int e = 0; e < 4; ++e) { const int i = 16 * it + 4 * q + e; const float y = accD[e] + __expf(acsL[i]) * accO[e] + Dh * bf1(Xr[i * SX + p]);
                    XBC[(m0 + (size_t)ch * 64 + i) * 3072 + h * 64 + ph * 32 + p] = (bf16)f2bf(y); }
            }
            {
                const float dec = __expf(acsL[63]);
                bf16x8 a0, a1, bx[2][2];
                tr_bm2(BmB + troffB + 32u * w, a0, a1);
                tr_x4(XsB + troffX, bx[0][0], bx[0][1], bx[1][0], bx[1][1]);
#pragma unroll
                for (int pt = 0; pt < 2; ++pt) {
                    f32x4 s = st[pt] * dec;
                    s = __builtin_amdgcn_mfma_f32_16x16x32_bf16(a0, bx[pt][0], s, 0, 0, 0);
                    s = __builtin_amdgcn_mfma_f32_16x16x32_bf16(a1, bx[pt][1], s, 0, 0, 0);
                    st[pt] = s;
                }
            }
            lds_barrier();
#pragma unroll
            for (int pt = 0; pt < 2; ++pt) { v2u o; o.x = pk2c(st[pt][0], st[pt][1]); o.y = pk2c(st[pt][2], st[pt][3]);
                *(LAS v2u*)(SL + (16 * pt + r) * SC + 16 * w + 4 * q) = o; }
            if (ch + 1 < T / 64) SS_STAGE();
            lds_barrier();
        }
#undef SS_LOAD
#undef SS_STAGE
    }
}

__device__ __forceinline__ void phase_ssd_post(const Ctx& c, KArgs& a, int l) {
    unsigned char* ws = a.ws;
    bf16* PS = (bf16*)(ws + WS_OV + OV_PS);
    const bf16* XBC = (const bf16*)(ws + WS_OV + OV_XBC);
    const int lane = c.lane, c0 = 32 * lane;
    const float* ng = a.in[I_SNG] + (size_t)l * 2048 + c0;
    const int gw = c.bid * 8 + c.wave, NGW = c.G * 8;
    v4u nyy[4], nzz[4];
#define SP_LOAD(mm) do { _Pragma("unroll") for (int q = 0; q < 4; ++q) { nyy[q] = *(const v4u*)(XBC + (size_t)(mm) * 3072 + c0 + 8 * q); nzz[q] = *(const v4u*)(PS + (size_t)(mm) * N2P + c0 + 8 * q); } } while (0)
    if (gw < MH) SP_LOAD(gw);
    for (int m = gw; m < MH; m += NGW) {
        float y[32]; float ss = 0.f;
        v4u cyy[4], czz[4];
#pragma unroll
        for (int q = 0; q < 4; ++q) { cyy[q] = nyy[q]; czz[q] = nzz[q]; }
        if (m + NGW < MH) SP_LOAD(m + NGW);
#pragma unroll
        for (int q = 0; q < 4; ++q) {
            float yy[8], zz[8];
            unpack8(cyy[q], yy); unpack8(czz[q], zz);
#pragma unroll
            for (int e = 0; e < 8; ++e) { const float v = yy[e] * siluf_(zz[e]); y[8 * q + e] = v; ss += v * v; }
        }
        ss = sum16(ss);
        const float r = rsqrtf(ss * (1.f / 512.f) + 1e-6f);
#pragma unroll
        for (int q = 0; q < 4; ++q) {
            float o[8];
#pragma unroll
            for (int e = 0; e < 8; ++e) o[e] = y[8 * q + e] * r * ng[8 * q + e];
            *(v4u*)(PS + (size_t)m * N2P + 2048 + c0 + 8 * q) = pack8(o);
        }
    }
}

__device__ __forceinline__ void phase_peer_convert(const Ctx& c, KArgs& a, int l) {
    unsigned char* ws = a.ws;
    const int gw = c.bid * 8 + c.wave, NGW = c.G * 8, lane = c.lane;
    f32x4 n0, n1, n2, n3;
#define PC_LOAD(itt) do { const int tb_ = (itt) >= NEXP, e_ = (itt) - tb_ * NEXP; const float* s_ = (tb_ ? a.in[I_PU] : a.in[I_PD]) + ((size_t)l * NEXP + e_) * D + 16 * lane; \
        n0 = *(const f32x4*)s_; n1 = *(const f32x4*)(s_ + 4); n2 = *(const f32x4*)(s_ + 8); n3 = *(const f32x4*)(s_ + 12); } while (0)
    if (gw < 2 * NEXP) PC_LOAD(gw);
    for (int it = gw; it < 2 * NEXP; it += NGW) {
        const int tb = it >= NEXP, e = it - tb * NEXP;
        const f32x4 x0 = n0, x1 = n1, x2 = n2, x3 = n3;
        if (it + NGW < 2 * NEXP) PC_LOAD(it + NGW);
        float am = fmaxf(fmaxf(fmaxf(fabsf(x0.x), fabsf(x0.y)), fmaxf(fabsf(x0.z), fabsf(x0.w))), fmaxf(fmaxf(fabsf(x1.x), fabsf(x1.y)), fmaxf(fabsf(x1.z), fabsf(x1.w))));
        am = fmaxf(am, fmaxf(fmaxf(fmaxf(fabsf(x2.x), fabsf(x2.y)), fmaxf(fabsf(x2.z), fabsf(x2.w))), fmaxf(fmaxf(fabsf(x3.x), fabsf(x3.y)), fmaxf(fabsf(x3.z), fabsf(x3.w)))));
#pragma unroll
        for (int o = 1; o < 64; o <<= 1) am = fmaxf(am, __shfl_xor(am, o));
        am = fmaxf(am, 1e-30f);
        const float s = 384.f / am;
        v4u q;
        int w;
        w = __builtin_amdgcn_cvt_pk_fp8_f32(x0.x * s, x0.y * s, 0, false); w = __builtin_amdgcn_cvt_pk_fp8_f32(x0.z * s, x0.w * s, w, true); q.x = (unsigned)w;
        w = __builtin_amdgcn_cvt_pk_fp8_f32(x1.x * s, x1.y * s, 0, false); w = __builtin_amdgcn_cvt_pk_fp8_f32(x1.z * s, x1.w * s, w, true); q.y = (unsigned)w;
        w = __builtin_amdgcn_cvt_pk_fp8_f32(x2.x * s, x2.y * s, 0, false); w = __builtin_amdgcn_cvt_pk_fp8_f32(x2.z * s, x2.w * s, w, true); q.z = (unsigned)w;
        w = __builtin_amdgcn_cvt_pk_fp8_f32(x3.x * s, x3.y * s, 0, false); w = __builtin_amdgcn_cvt_pk_fp8_f32(x3.z * s, x3.w * s, w, true); q.w = (unsigned)w;
        *(v4u*)(ws + WS_OV + (tb ? OV_UP : OV_DOWN) + (size_t)e * D + 16 * lane) = q;
        if (lane == 0) ((float*)(ws + WS_OV + OV_PSCALE))[it] = am * (1.f / 384.f);
    }
}

template <class TT> __device__ __forceinline__ void ce_desc(TT& a, TT& b) { const TT hi = a > b ? a : b, lo = a > b ? b : a; a = hi; b = lo; }
__device__ __forceinline__ void cef(float& a, float& b) { const float hi = fmaxf(a, b), lo = fminf(a, b); a = hi; b = lo; }
__device__ __forceinline__ void ced(double& a, double& b) { const double hi = fmax(a, b), lo = fmin(a, b); a = hi; b = lo; }
template <class TT, class CE> __device__ __forceinline__ void bitonic_sort16_desc(TT (&v)[16], CE ce) {
#pragma unroll
    for (int k = 2; k <= 16; k <<= 1)
#pragma unroll
        for (int j = k >> 1; j > 0; j >>= 1)
#pragma unroll
            for (int i = 0; i < 16; ++i) { const int p = i ^ j; if (p > i) { if ((i & k) == 0) ce(v[i], v[p]); else ce(v[p], v[i]); } }
}
template <class TT, class CE> __device__ __forceinline__ void bitonic_merge16_desc(TT (&v)[16], CE ce) {
#pragma unroll
    for (int j = 8; j > 0; j >>= 1)
#pragma unroll
        for (int i = 0; i < 16; ++i) { const int p = i ^ j; if (p > i) ce(v[i], v[p]); }
}
struct CEF { __device__ __forceinline__ void operator()(float& a, float& b) const { cef(a, b); } };
struct CED { __device__ __forceinline__ void operator()(double& a, double& b) const { ced(a, b); } };

__device__ __forceinline__ void top16_of_128(const bf16* p, float (&top)[16]) {
#pragma unroll
    for (int grp = 0; grp < 8; ++grp) {
        float cur[16];
        const v4u q0 = *(const v4u*)(p + grp * 16), q1 = *(const v4u*)(p + grp * 16 + 8);
        const unsigned w[8] = {q0.x, q0.y, q0.z, q0.w, q1.x, q1.y, q1.z, q1.w};
#pragma unroll
        for (int e = 0; e < 8; ++e) {
            const unsigned lo = w[e] << 16, hi = w[e] & 0xffff0000u;
            const unsigned i0 = grp * 16 + 2 * e, i1 = i0 + 1;
            cur[2 * e] = __builtin_bit_cast(float, lo | ((lo >> 31) ? i0 : (127u - i0)));
            cur[2 * e + 1] = __builtin_bit_cast(float, hi | ((hi >> 31) ? i1 : (127u - i1)));
        }
        bitonic_sort16_desc(cur, CEF());
        if (grp == 0) {
#pragma unroll
            for (int i = 0; i < 16; ++i) top[i] = cur[i];
        } else {
#pragma unroll
            for (int i = 0; i < 16; ++i) top[i] = fmaxf(top[i], cur[15 - i]);
            bitonic_merge16_desc(top, CEF());
        }
    }
}
__device__ __forceinline__ unsigned key_index(float k) { const unsigned u = __builtin_bit_cast(unsigned, k); const unsigned lo = u & 0x7fu; return (u >> 31) ? lo : 127u - lo; }
__device__ __forceinline__ float key_value(float k) { return __builtin_bit_cast(float, __builtin_bit_cast(unsigned, k) & 0xffff0000u); }

__device__ __forceinline__ void phase_peer_topk(const Ctx& c, KArgs& a) {
    unsigned char* ws = a.ws;
    const bf16* SC = (const bf16*)(ws + WS_OV + OV_SC);
    int* IDX = (int*)(ws + WS_OV + OV_IDX); float* GATE = (float*)(ws + WS_OV + OV_GATE);
    for (int it = c.bid * 512 + c.tid; it < M * 8; it += c.G * 512) {
        const bf16* p = SC + (size_t)it * 256;
        float t0[16], t1[16];
        top16_of_128(p, t0); top16_of_128(p + 128, t1);
        float v0[16], v1[16]; unsigned i0[16], i1[16];
#pragma unroll
        for (int i = 0; i < 16; ++i) { v0[i] = key_value(t0[i]); v1[i] = key_value(t1[i]); i0[i] = key_index(t0[i]); i1[i] = key_index(t1[i]); }
        double top[16];
        const double NEG = -1.0e300;
#pragma unroll
        for (int grp = 0; grp < 4; ++grp) {
            double cur[16];
#pragma unroll
            for (int s = 0; s < 16; ++s) cur[s] = NEG;
            int n = 0;
#pragma unroll
            for (int i = 0; i < 16; ++i)
#pragma unroll
                for (int j = 0; j < 16; ++j) if ((i + 1) * (j + 1) <= 16) {
                    if (n / 16 == grp) {
                        const double d = (double)(v0[i] + v1[j]);
                        const unsigned long long eid = (unsigned long long)(i0[i] * 128u + i1[j]);
                        const unsigned long long bits = __builtin_bit_cast(unsigned long long, d);
                        cur[n % 16] = __builtin_bit_cast(double, bits | ((bits >> 63) ? eid : (16383ull - eid)));
                    }
                    ++n;
                }
            bitonic_sort16_desc(cur, CED());
            if (grp == 0) {
#pragma unroll
                for (int i = 0; i < 16; ++i) top[i] = cur[i];
            } else {
#pragma unroll
                for (int i = 0; i < 16; ++i) top[i] = fmax(top[i], cur[15 - i]);
                bitonic_merge16_desc(top, CED());
            }
        }
        float sv[16]; int id[16];
#pragma unroll
        for (int i = 0; i < 16; ++i) { const unsigned long long bits = __builtin_bit_cast(unsigned long long, top[i]); const unsigned lo = (unsigned)(bits & 0x3fffull);
            id[i] = (int)((bits >> 63) ? lo : 16383u - lo); sv[i] = (float)top[i]; }
        float den = 0.f, ex[16];
#pragma unroll
        for (int i = 0; i < 16; ++i) { ex[i] = __expf(sv[i] - sv[0]); den += ex[i]; }
        const float inv = 1.f / den;
        unsigned cw[4] = {0u, 0u, 0u, 0u};
#pragma unroll
        for (int i = 0; i < 16; ++i) { const unsigned s = (unsigned)id[i] >> PEER_SLICE_SHIFT, inc = 1u << (8 * (s & 3)), ws_ = s >> 2;
            cw[0] += ws_ == 0 ? inc : 0u; cw[1] += ws_ == 1 ? inc : 0u; cw[2] += ws_ == 2 ? inc : 0u; cw[3] += ws_ == 3 ? inc : 0u; }
        unsigned lp[4], tot[4], st[4];
        const int l8 = c.lane & 7;
#pragma unroll
        for (int k = 0; k < 4; ++k) { unsigned v = cw[k];
#pragma unroll
            for (int o = 1; o < 8; o <<= 1) { const unsigned y = __shfl_up(v, o, 8); v += (l8 >= o) ? y : 0u; }
            tot[k] = __shfl(v, 7, 8); lp[k] = v - cw[k]; }
        {   unsigned carry = 0u;
#pragma unroll
            for (int k = 0; k < 4; ++k) { st[k] = tot[k] * 0x01010100u + carry * 0x01010101u; carry += (tot[k] * 0x01010101u) >> 24; } }
        unsigned run[4] = {st[0] + lp[0], st[1] + lp[1], st[2] + lp[2], st[3] + lp[3]};
        const size_t tok = (size_t)(it >> 3);
#pragma unroll
        for (int i = 0; i < 16; ++i) { const unsigned s = (unsigned)id[i] >> PEER_SLICE_SHIFT, sh = 8 * (s & 3), ws_ = s >> 2, inc = 1u << sh;
            const unsigned wsel = ws_ == 0 ? run[0] : (ws_ == 1 ? run[1] : (ws_ == 2 ? run[2] : run[3]));
            const unsigned pos = (wsel >> sh) & 0xffu;
            run[0] += ws_ == 0 ? inc : 0u; run[1] += ws_ == 1 ? inc : 0u; run[2] += ws_ == 2 ? inc : 0u; run[3] += ws_ == 3 ? inc : 0u;
            IDX[tok * 128 + pos] = id[i]; GATE[tok * 128 + pos] = ex[i] * inv; }
        if (l8 == 0) ((v4u*)(ws + WS_OV + OV_POFF))[tok] = (v4u){st[0], st[1], st[2], st[3]};
    }
}

__device__ __forceinline__ float gelu_tanh(float x) { const float u = 0.7978845608f * (x + 0.044715f * x * x * x); const float t = 1.f - 2.f / (1.f + __expf(2.f * u)); return 0.5f * x * (1.f + t); }
__device__ __forceinline__ void unpack16_fp8(const v4u& q, float (&o)[16]) {
    const unsigned w[4] = {q.x, q.y, q.z, q.w};
#pragma unroll
    for (int i = 0; i < 4; ++i) { const f32x2 lo = __builtin_amdgcn_cvt_pk_f32_fp8((int)w[i], false), hi = __builtin_amdgcn_cvt_pk_f32_fp8((int)w[i], true);
        o[4 * i] = lo.x; o[4 * i + 1] = lo.y; o[4 * i + 2] = hi.x; o[4 * i + 3] = hi.y; }
}
__device__ __forceinline__ int slice_start(unsigned o0, unsigned o1, unsigned o2, unsigned o3, int s) {
    const unsigned wsel = s < 4 ? o0 : (s < 8 ? o1 : (s < 12 ? o2 : o3));
    return s >= PEER_NSLICE ? 128 : (int)((wsel >> (8 * (s & 3))) & 0xffu);
}
template <int MODE> __device__ __forceinline__ void phase_peer_down(const Ctx& c, KArgs& a, int l, int qset) {
    unsigned char* ws = a.ws;
    const unsigned char* U8 = ws + WS_OV + OV_U8; const float* XS = (const float*)(ws + WS_OV + OV_XS);
    const unsigned char* DN = ws + WS_OV + OV_DOWN;
    const int* IDX = (const int*)(ws + WS_OV + OV_IDX);
    const v4u* POFF = (const v4u*)(ws + WS_OV + OV_POFF);
    float* ACT = (float*)(ws + WS_OV + (qset ? 278 * MiB : OV_ACT));
    unsigned* QC = (unsigned*)(ws + WS_CTL) + CW_QUEUE + (qset * 2 + l) * PEER_NSLICE * 64;
    constexpr int RS = 528;
    LAS unsigned char* wb = c.lds + c.wave * (8192 + 16 * RS);
    LAS unsigned* lpk = (LAS unsigned*)wb;
    LAS unsigned char* RB = wb + 8192;
    const int lane = c.lane, r16 = lane & 15, q = lane >> 4, hsel = lane >> 5, l32 = lane & 31;
    constexpr int NBLK = M / 16;
    const int s = c.bid & (PEER_NSLICE - 1);
    const int nrank = ((c.G - s + PEER_NSLICE - 1) >> 3) * 8, rank = (c.bid >> 3) * 8 + c.wave;
    {
#pragma unroll 1
        for (int blk = rank; blk < NBLK; blk += nrank) {
            const size_t mb = (size_t)blk * 16;
            v4u xb[16];
            { const unsigned char* xp = U8 + (mb + r16) * D + 16 * q;
#pragma unroll
              for (int j = 0; j < 16; ++j) xb[j] = *(const v4u*)(xp + 64 * j); }
            const float xs = XS[mb + r16];
            int pav = 0, nv = 0;
            if (lane < 16) { const v4u po = POFF[mb + lane]; pav = slice_start(po.x, po.y, po.z, po.w, s); nv = slice_start(po.x, po.y, po.z, po.w, s + 1) - pav; }
            int incl = nv;
#pragma unroll
            for (int o = 1; o < 16; o <<= 1) { const int y = __shfl_up(incl, o, 16); incl += (r16 >= o) ? y : 0; }
            const int offv = incl - nv;
            const int P = __builtin_amdgcn_readlane(incl, 15);
            {
                int idr[16];
#pragma unroll
                for (int ti = 0; ti < 16; ++ti) { const int pa = __builtin_amdgcn_readlane(pav, ti); const int e = pa + lane; idr[ti] = IDX[(mb + ti) * 128 + (e < 127 ? e : 127)]; }
#pragma unroll
                for (int ti = 0; ti < 16; ++ti) { const int pa = __builtin_amdgcn_readlane(pav, ti), n = __builtin_amdgcn_readlane(nv, ti), off = __builtin_amdgcn_readlane(offv, ti);
                    if (lane < n) lpk[off + lane] = (unsigned)idr[ti] | ((unsigned)ti << 14) | ((unsigned)(pa + lane) << 18); }
                if (__builtin_amdgcn_ballot_w64(nv > 64) != 0ull) {
#pragma unroll 1
                    for (int ti = 0; ti < 16; ++ti) { const int pa = __builtin_amdgcn_readlane(pav, ti), n = __builtin_amdgcn_readlane(nv, ti), off = __builtin_amdgcn_readlane(offv, ti);
                        if (lane + 64 < n) lpk[off + 64 + lane] = (unsigned)IDX[(mb + ti) * 128 + pa + 64 + lane] | ((unsigned)ti << 14) | ((unsigned)(pa + 64 + lane) << 18); }
                }
            }
            asm volatile("s_waitcnt vmcnt(0) lgkmcnt(0)" ::: "memory");
            const int nb = (P + 15) >> 4;
#define PD_IDS(PW, B) { const v4u ia = *(const LAS v4u*)(lpk + (B) * 16 + 8 * hsel), ib = *(const LAS v4u*)(lpk + (B) * 16 + 8 * hsel + 4); \
                PW[0] = ia.x; PW[1] = ia.y; PW[2] = ia.z; PW[3] = ia.w; PW[4] = ib.x; PW[5] = ib.y; PW[6] = ib.z; PW[7] = ib.w; }
#define PD_LOADH(PW, H) { _Pragma("unroll") for (int i = 0; i < 8; ++i) { const unsigned id = MODE == 1 ? (PW[i] & 63u) : (PW[i] & 16383u); \
                    rr[8 * (H) + i] = *(const v4u*)(DN + (size_t)(id * 1024u + 512u * (H) + 16u * l32)); } }
            if (nb > 0) {
                v4u rr[16];
                { unsigned pw[8]; PD_IDS(pw, 0) PD_LOADH(pw, 0) PD_LOADH(pw, 1) }
#pragma unroll 1
                for (int b = 0; b < nb; ++b) {
                    const int bn = b + 1 < nb ? b + 1 : b;
                    unsigned pwn[8]; PD_IDS(pwn, bn)
                    const v4u mt = *(const LAS v4u*)(lpk + b * 16 + 4 * q);
                    f32x4 acc0 = {0.f, 0.f, 0.f, 0.f}, acc1 = {0.f, 0.f, 0.f, 0.f};
#pragma unroll
                    for (int h = 0; h < 2; ++h) {
#pragma unroll
                        for (int i = 0; i < 8; ++i) *(LAS v4u*)(RB + (8 * hsel + i) * RS + 16 * l32) = rr[8 * h + i];
                        PD_LOADH(pwn, h)
#pragma unroll
                        for (int jj = 0; jj < 8; ++jj) {
                            const v4u av = *(const LAS v4u*)(RB + r16 * RS + 64 * jj + 16 * q);
                            const v4u bv = xb[8 * h + jj];
                            const long a0 = (long)(((unsigned long long)av.y << 32) | av.x), a1 = (long)(((unsigned long long)av.w << 32) | av.z);
                            const long b0 = (long)(((unsigned long long)bv.y << 32) | bv.x), b1 = (long)(((unsigned long long)bv.w << 32) | bv.z);
                            acc0 = __builtin_amdgcn_mfma_f32_16x16x32_fp8_fp8(a0, b0, acc0, 0, 0, 0);
                            acc1 = __builtin_amdgcn_mfma_f32_16x16x32_fp8_fp8(a1, b1, acc1, 0, 0, 0);
                        }
                    }
                    const f32x4 dv = (acc0 + acc1) * xs;
                    const unsigned me[4] = {mt.x, mt.y, mt.z, mt.w};
                    const float dd[4] = {dv.x, dv.y, dv.z, dv.w};
#pragma unroll
                    for (int i = 0; i < 4; ++i) if (b * 16 + 4 * q + i < P && (int)((me[i] >> 14) & 15u) == r16) lpk[b * 16 + 4 * q + i] = __builtin_bit_cast(unsigned, dd[i]);
                }
            }
#pragma unroll
            for (int ti = 0; ti < 16; ++ti) { const int pa = __builtin_amdgcn_readlane(pav, ti), n = __builtin_amdgcn_readlane(nv, ti), off = __builtin_amdgcn_readlane(offv, ti);
                if (lane < n) ACT[(mb + ti) * 128 + pa + lane] = __builtin_bit_cast(float, lpk[off + lane]); }
            if (__builtin_amdgcn_ballot_w64(nv > 64) != 0ull) {
#pragma unroll 1
                for (int ti = 0; ti < 16; ++ti) { const int pa = __builtin_amdgcn_readlane(pav, ti), n = __builtin_amdgcn_readlane(nv, ti), off = __builtin_amdgcn_readlane(offv, ti);
                    if (lane + 64 < n) ACT[(mb + ti) * 128 + pa + 64 + lane] = __builtin_bit_cast(float, lpk[off + 64 + lane]); }
            }
        }
    }
}

template <int FUSE> __device__ __forceinline__ void phase_peer_experts(const Ctx& c, KArgs& a, const float* gnext, const bool commit = true) {
    unsigned char* ws = a.ws;
    const unsigned char* UP = ws + WS_OV + OV_UP;
    const float* SCD = (const float*)(ws + WS_OV + OV_PSCALE); const float* SCU = SCD + NEXP;
    const int* IDX = (const int*)(ws + WS_OV + OV_IDX); const float* GATE = (const float*)(ws + WS_OV + OV_GATE);
    const float* ACT = (const float*)(ws + WS_OV + OV_ACT);
    float* H = a.out;
    constexpr int TPW = 16, RS = 144;
    LAS unsigned char* wb = c.lds + c.wave * 16384;
    LAS int* idw = (LAS int*)wb;
    LAS unsigned char* wq8 = wb + 8192;
    LAS unsigned char* tile = wb + 10240;
    LAS float* swl = (LAS float*)(wb + 10240 + 32 * RS);
    const int lane = c.lane, r16 = lane & 15, q = lane >> 4, g8 = lane >> 3, c8 = lane & 7;
    const int gw = c.bid * 8 + c.wave, NGW = c.G * 8;
    const unsigned tr_addr = (unsigned)(size_t)(tile + (8 * q + (r16 >> 1)) * RS + 8 * (r16 & 1));
    for (int m0 = gw; m0 < M; m0 += NGW * TPW) {
#pragma unroll 1
        for (int ti = 0; ti < TPW; ++ti) {
            const int m = m0 + ti * NGW;
            float w0 = 0.f, w1 = 0.f; int id0 = 0, id1 = 0;
            if (m < M) {
                id0 = IDX[(size_t)m * 128 + lane]; id1 = IDX[(size_t)m * 128 + 64 + lane];
                const float g0 = GATE[(size_t)m * 128 + lane], g1 = GATE[(size_t)m * 128 + 64 + lane];
                const float a0 = ACT[(size_t)m * 128 + lane], a1 = ACT[(size_t)m * 128 + 64 + lane];
                w0 = g0 * gelu_tanh(a0 * SCD[id0]) * SCU[id0]; w1 = g1 * gelu_tanh(a1 * SCD[id1]) * SCU[id1];
            }
            float am = fmaxf(fabsf(w0), fabsf(w1));
#pragma unroll
            for (int o = 1; o < 64; o <<= 1) am = fmaxf(am, __shfl_xor(am, o));
            am = fmaxf(am, 1e-30f);
            const float qs = 384.f / am;
            const int pk = __builtin_amdgcn_cvt_pk_fp8_f32(w0 * qs, w1 * qs, 0, false);
            wq8[ti * 128 + lane] = (unsigned char)(pk & 0xff); wq8[ti * 128 + 64 + lane] = (unsigned char)((pk >> 8) & 0xff);
            idw[ti * 128 + lane] = id0; idw[ti * 128 + 64 + lane] = id1;
            if (lane == 0) swl[ti] = am * (1.f / 384.f);
        }
        asm volatile("s_waitcnt lgkmcnt(0)" ::: "memory");
        const f32x4 iscv = *(const LAS f32x4*)(swl + 4 * q);
        const float isc[4] = {iscv.x, iscv.y, iscv.z, iscv.w};
        float ssq[4] = {0.f, 0.f, 0.f, 0.f};
#define UPM_W(T4) { _Pragma("unroll") for (int i = 0; i < 4; ++i) *(LAS v4u*)(tile + (4 * g8 + i) * RS + 16 * c8) = rr[4 * (T4) + i]; }
#define UPM_LK(T4, TIN) { if ((TIN) < TPW) { const v4u i4 = *(const LAS v4u*)(idw + (TIN) * 128 + 32 * (T4) + 4 * g8); \
            rr[4 * (T4) + 0] = *(const v4u*)(UPc + (size_t)(i4.x * 1024u)); rr[4 * (T4) + 1] = *(const v4u*)(UPc + (size_t)(i4.y * 1024u)); \
            rr[4 * (T4) + 2] = *(const v4u*)(UPc + (size_t)(i4.z * 1024u)); rr[4 * (T4) + 3] = *(const v4u*)(UPc + (size_t)(i4.w * 1024u)); } }
#define UPM_R(B) asm volatile("ds_read_b64_tr_b8 %0, %8\n\tds_read_b64_tr_b8 %1, %8 offset:16\n\tds_read_b64_tr_b8 %2, %8 offset:32\n\tds_read_b64_tr_b8 %3, %8 offset:48\n\t" \
                         "ds_read_b64_tr_b8 %4, %8 offset:64\n\tds_read_b64_tr_b8 %5, %8 offset:80\n\tds_read_b64_tr_b8 %6, %8 offset:96\n\tds_read_b64_tr_b8 %7, %8 offset:112" \
                         : "=&v"(B[0]), "=&v"(B[1]), "=&v"(B[2]), "=&v"(B[3]), "=&v"(B[4]), "=&v"(B[5]), "=&v"(B[6]), "=&v"(B[7]) : "v"(tr_addr) : "memory")
#define UPM_WAIT(B) asm volatile("s_waitcnt lgkmcnt(0)" : "+v"(B[0]), "+v"(B[1]), "+v"(B[2]), "+v"(B[3]), "+v"(B[4]), "+v"(B[5]), "+v"(B[6]), "+v"(B[7]) :: "memory")
#define UPM_M(B, TI, T4) { v2u wa = *(const LAS v2u*)(wq8 + (TI) * 128 + 32 * (T4) + 8 * q); if (r16 != (TI)) { wa.x = 0u; wa.y = 0u; } \
            const long wal = (long)(((unsigned long long)wa.y << 32) | wa.x); \
            _Pragma("unroll") for (int ct = 0; ct < 8; ++ct) acc[ct] = __builtin_amdgcn_mfma_f32_16x16x32_fp8_fp8(wal, B[ct], acc[ct], 0, 0, 0); }
#define UPM_STEP(BC, BN, J, T4W, TINW, T4M) { if (s0 + (J) + 1 < 4 * TPW) UPM_R(BN); if (s0 + (J) + 2 < 4 * TPW) { UPM_W(T4W) UPM_LK(T4W, TINW) } UPM_M(BC, ti, T4M) UPM_WAIT(BN); }
#pragma unroll 1
        for (int cq = 0; cq < 8; ++cq) {
            const unsigned char* UPc = UP + 128 * cq + 16 * c8;
            f32x4 acc[8];
#pragma unroll
            for (int ct = 0; ct < 8; ++ct) acc[ct] = (f32x4){0.f, 0.f, 0.f, 0.f};
            {
                v4u rr[16]; long bA[8], bB[8];
                UPM_LK(0, 0) UPM_LK(1, 0) UPM_LK(2, 0) UPM_LK(3, 0)
                UPM_W(0) UPM_LK(0, 1) UPM_R(bA); UPM_WAIT(bA); UPM_W(1) UPM_LK(1, 1)
#pragma unroll 1
                for (int ti = 0; ti < TPW; ++ti) {
                    const int s0 = 4 * ti;
                    UPM_STEP(bA, bB, 0, 2, ti + 1, 0)
                    UPM_STEP(bB, bA, 1, 3, ti + 1, 1)
                    UPM_STEP(bA, bB, 2, 0, ti + 2, 2)
                    UPM_STEP(bB, bA, 3, 1, ti + 2, 3)
                }
            }
            if (!commit) { if (acc[0].x != 123456.789f) continue; }
            {
                float hv[4][8];
#pragma unroll
                for (int i = 0; i < 4; ++i) { const int m = m0 + (4 * q + i) * NGW; const float* hp = H + (size_t)(m < M ? m : 0) * D + 128 * cq + r16;
#pragma unroll
                    for (int ct = 0; ct < 8; ++ct) hv[i][ct] = hp[16 * ct]; }
#pragma unroll
                for (int i = 0; i < 4; ++i) { const int m = m0 + (4 * q + i) * NGW; float* hp = H + (size_t)(m < M ? m : 0) * D + 128 * cq + r16;
#pragma unroll
                    for (int ct = 0; ct < 8; ++ct) { const float d = i == 0 ? acc[ct].x : (i == 1 ? acc[ct].y : (i == 2 ? acc[ct].z : acc[ct].w)); hv[i][ct] += d * isc[i]; ssq[i] += hv[i][ct] * hv[i][ct]; }
                    if (m < M) {
#pragma unroll
                        for (int ct = 0; ct < 8; ++ct) hp[16 * ct] = hv[i][ct]; } }
            }
        }
        if (!commit) continue;
#pragma unroll
        for (int i = 0; i < 4; ++i) { float s = ssq[i]; s += __shfl_xor(s, 1); s += __shfl_xor(s, 2); s += __shfl_xor(s, 4); s += __shfl_xor(s, 8); ssq[i] = s; }
        asm volatile("s_waitcnt vmcnt(0)" ::: "memory");
        const f32x4 gn0 = *(const f32x4*)(gnext + lane * 16), gn1 = *(const f32x4*)(gnext + lane * 16 + 4), gn2 = *(const f32x4*)(gnext + lane * 16 + 8), gn3 = *(const f32x4*)(gnext + lane * 16 + 12);
#pragma unroll
        for (int i = 0; i < 4; ++i)
#pragma unroll 1
            for (int qv = 0; qv < 4; ++qv) {
                const int ti = 4 * qv + i, m = m0 + ti * NGW; if (m >= M) continue;
                const float ss = __builtin_bit_cast(float, __builtin_amdgcn_readlane(__builtin_bit_cast(int, ssq[i]), qv * 16));
                const float rn = rsqrtf(ss * (1.f / D) + 1e-6f);
                f32x4* hp = (f32x4*)(H + (size_t)m * D + lane * 16);
                const f32x4 h0 = hp[0], h1 = hp[1], h2 = hp[2], h3 = hp[3];
                const f32x4 n0 = h0 * rn * gn0, n1 = h1 * rn * gn1, n2 = h2 * rn * gn2, n3 = h3 * rn * gn3;
                if (FUSE == 0) {
                    float am = fmaxf(fmaxf(fmaxf(fmaxf(fabsf(n0.x), fabsf(n0.y)), fmaxf(fabsf(n0.z), fabsf(n0.w))), fmaxf(fmaxf(fabsf(n1.x), fabsf(n1.y)), fmaxf(fabsf(n1.z), fabsf(n1.w)))),
                                     fmaxf(fmaxf(fmaxf(fabsf(n2.x), fabsf(n2.y)), fmaxf(fabsf(n2.z), fabsf(n2.w))), fmaxf(fmaxf(fabsf(n3.x), fabsf(n3.y)), fmaxf(fabsf(n3.z), fabsf(n3.w)))));
#pragma unroll
                    for (int o = 1; o < 64; o <<= 1) am = fmaxf(am, __shfl_xor(am, o));
                    am = fmaxf(am, 1e-30f);
                    const float qs = 384.f / am;
                    v4u u8; int w8;
                    w8 = __builtin_amdgcn_cvt_pk_fp8_f32(n0.x * qs, n0.y * qs, 0, false); w8 = __builtin_amdgcn_cvt_pk_fp8_f32(n0.z * qs, n0.w * qs, w8, true); u8.x = (unsigned)w8;
                    w8 = __builtin_amdgcn_cvt_pk_fp8_f32(n1.x * qs, n1.y * qs, 0, false); w8 = __builtin_amdgcn_cvt_pk_fp8_f32(n1.z * qs, n1.w * qs, w8, true); u8.y = (unsigned)w8;
                    w8 = __builtin_amdgcn_cvt_pk_fp8_f32(n2.x * qs, n2.y * qs, 0, false); w8 = __builtin_amdgcn_cvt_pk_fp8_f32(n2.z * qs, n2.w * qs, w8, true); u8.z = (unsigned)w8;
                    w8 = __builtin_amdgcn_cvt_pk_fp8_f32(n3.x * qs, n3.y * qs, 0, false); w8 = __builtin_amdgcn_cvt_pk_fp8_f32(n3.z * qs, n3.w * qs, w8, true); u8.w = (unsigned)w8;
                    *(v4u*)(ws + WS_U + (size_t)m * D + lane * 16) = u8;
                    if (lane == 0) ((float*)(ws + WS_U + U8IN_XS))[m] = am * (1.f / 384.f);
                } else { hp[0] = n0; hp[1] = n1; hp[2] = n2; hp[3] = n3; }
            }
    }
}

constexpr int PH_PER_HALF = 11, PH_PER_LAYER = 1 + 2 * PH_PER_HALF + 5, N_PHASES = 1 + DEPTH * PH_PER_LAYER;
__device__ __forceinline__ Ctx make_ctx() {
    extern __shared__ __attribute__((aligned(16))) unsigned char lds_raw[];
    Ctx c; int t = threadIdx.x; asm volatile("" : "+v"(t)); c.lds = (LAS unsigned char*)lds_raw; c.tid = t; c.lane = t & 63; c.wave = __builtin_amdgcn_readfirstlane(t >> 6); c.G = gridDim.x; c.bid = blockIdx.x; return c; }
__device__ __forceinline__ KArgs* kargs_fresh() { KArgs* p = (KArgs*)__builtin_amdgcn_kernarg_segment_ptr(); asm volatile("" : "+s"(p)); return p; }
#define PH_BEGIN(K) if (lo <= (K) && (K) < hi) { const Ctx c = make_ctx(); KArgs& args = *kargs_fresh(); unsigned char* ws = args.ws; (void)ws;
#define PH_END(K)   if ((K) + 1 < hi) xcd_barrier(bar); }

template <int L, int HB> __device__ __forceinline__ void half_pass(const XcdBarrier& bar, const int lo, const int hi) {
    constexpr int P0 = 1 + L * PH_PER_LAYER + 1 + HB * PH_PER_HALF;
#define WIN ((const bf16*)(ws + WS_WIN + L * WIN8_L))
#define KP 512
#define XSh ((const float*)(ws + WS_U + U8IN_XS) + (size_t)HB * MH)
#define WSC ((const float*)(ws + WS_CTL) + CW_WSC + L)
#define Uh ((const bf16*)(ws + WS_U) + (size_t)HB * MH * KP)
    PH_BEGIN(P0 + 0) {
        pg8::Gemm g{Uh, WIN, MH, N1P, KP, KP, 0}; pg8::StaticOrder S; S.init(MH, N1P, c.G, c.bid);
        pg8::EpiRow8<FStoreBf16S> E{{(bf16*)(ws + WS_OV + OV_PR), N1P, XSh, WSC}};
        pg8::gemm_phase(c.lds, g, S, E); if (PROBE_DUP == 5) pg8::gemm_phase(c.lds, g, S, E); } PH_END(P0 + 0)
    PH_BEGIN(P0 + 1) if (PROBE_DUP == 6) phase_rwkv_prep(c, args, L, HB); phase_rwkv_prep(c, args, L, HB); PH_END(P0 + 1)
    PH_BEGIN(P0 + 2) {
        constexpr int NL = L == 0 ? 3072 : 4096;
        pg8::Gemm g{(const bf16*)(ws + WS_OV + OV_AL), (const bf16*)(ws + WS_WLORA + L * WLORA_L), MH, NL, KL, KL, 1}; pg8::StaticOrder S; S.init(MH, NL, c.G, c.bid);
        EpiLora E{(bf16*)(ws + WS_OV + OV_ELOG), (bf16*)(ws + WS_OV + OV_ASIG), (bf16*)(ws + WS_OV + OV_GG), (bf16*)(ws + WS_OV + OV_VMIX),
                               (const bf16*)(ws + WS_VF) + (size_t)HB * MH * D, args.in[I_W0] + (size_t)L * D, args.in[I_A0] + (size_t)L * D, args.in[I_V0]};
        pg8::gemm_phase(c.lds, g, S, E); } PH_END(P0 + 2)
    PH_BEGIN(P0 + 3) phase_rwkv_chunk_par(c, args, L, HB); PH_END(P0 + 3)
    PH_BEGIN(P0 + 4) if (PROBE_DUP == 8) phase_rwkv_chunk_seq(c, args, false); phase_rwkv_chunk_seq(c, args); PH_END(P0 + 4)
    PH_BEGIN(P0 + 5) {
        phase_rwkv_post(c, args, L, HB); __syncthreads();
        pg8::Gemm g{Uh, WIN + (size_t)N1P * KP, MH, N2P, KP, KP, 0}; pg8::StaticOrder S; S.init(MH, N2P, c.G, c.bid);
        pg8::EpiRow8<FStoreBf16S> E{{(bf16*)(ws + WS_OV + OV_PS), N2P, XSh, WSC}};
        pg8::gemm_phase(c.lds, g, S, E); if (PROBE_DUP == 5) pg8::gemm_phase(c.lds, g, S, E); } PH_END(P0 + 5)
    PH_BEGIN(P0 + 6) if (PROBE_DUP == 6) phase_ssd_conv(c, args, L); phase_ssd_conv(c, args, L); PH_END(P0 + 6)
    PH_BEGIN(P0 + 7) phase_ssd_scan(c, args, L); PH_END(P0 + 7)
    PH_BEGIN(P0 + 8) phase_ssd_post(c, args, L); PH_END(P0 + 8)
    PH_BEGIN(P0 + 9) {
      { pg8::Gemm g{Uh, WIN + (size_t)(N1P + N2P) * KP, MH, D, KP, KP, 0}; pg8::StaticOrder S; S.init(MH, D, c.G, c.bid);
        pg8::EpiRow8<FSigmoidBf16S> E{{(bf16*)(ws + WS_OV + OV_GATES), 2048, XSh, WSC}};
        pg8::gemm_phase(c.lds, g, S, E); }
      { pg8::Gemm g{Uh, WIN + (size_t)(N1P + N2P + D) * KP, MH, D, KP, KP, 0}; pg8::StaticOrder S; S.init(MH, D, c.G, c.bid);
        pg8::EpiRow8<FSigmoidBf16S> E{{(bf16*)(ws + WS_OV + OV_GATES) + 1024, 2048, XSh, WSC}};
        pg8::gemm_phase(c.lds, g, S, E); }
      {
        pg8::Gemm g{(const bf16*)(ws + WS_OV + OV_YA), (const bf16*)(ws + WS_WA) + (size_t)L * D * D, MH, D, D, D, 0}; pg8::StaticOrder S; S.init(MH, D, c.G, c.bid);
        pg8::EpiRow8<FMixA> E{{(const bf16*)(ws + WS_OV + OV_GATES), (bf16*)(ws + WS_OV + OV_MIXED)}};
        pg8::gemm_phase(c.lds, g, S, E); }
      {
        pg8::Gemm g{(const bf16*)(ws + WS_OV + OV_PS) + 2048, (const bf16*)(ws + WS_WB) + (size_t)L * D * 2048, MH, D, 2048, N2P, 0}; pg8::StaticOrder S; S.init(MH, D, c.G, c.bid);
        pg8::EpiRow8<FMixB> E{{(const bf16*)(ws + WS_OV + OV_GATES), (bf16*)(ws + WS_OV + OV_MIXED)}};
        pg8::gemm_phase(c.lds, g, S, E); } } PH_END(P0 + 9)
    PH_BEGIN(P0 + 10) {
        pg8::Gemm g{(const bf16*)(ws + WS_OV + OV_MIXED), (const bf16*)(ws + WS_WO) + (size_t)L * D * D, MH, D, D, D, 0}; pg8::StaticOrder S; S.init(MH, D, c.G, c.bid);
        pg8::EpiRow8<FResid> E{{(L == 0 ? args.in[I_X] : (const float*)args.out) + (size_t)HB * MH * D, args.out + (size_t)HB * MH * D}};
        pg8::gemm_phase(c.lds, g, S, E); } PH_END(P0 + 10)
#undef WIN
#undef KP
#undef XSh
#undef WSC
#undef Uh
}

template <int L> __device__ __forceinline__ void layer_pass(const XcdBarrier& bar, const int lo, const int hi) {
    constexpr int P0 = 1 + L * PH_PER_LAYER, P1 = P0 + 1 + 2 * PH_PER_HALF;
    PH_BEGIN(P0) if (L == 0) phase_rmsnorm_q8(c, args.in[I_X], args.in[I_NMG], nullptr, ws + WS_U, (float*)(ws + WS_U + U8IN_XS)); PH_END(P0)
    half_pass<L, 0>(bar, lo, hi);
    half_pass<L, 1>(bar, lo, hi);
    PH_BEGIN(P1 + 0) phase_rmsnorm_q8(c, args.out, args.in[I_NFG] + (size_t)L * D, (bf16*)(ws + WS_U), ws + WS_OV + OV_U8, (float*)(ws + WS_OV + OV_XS)); phase_peer_convert(c, args, L); PH_END(P1 + 0)
    PH_BEGIN(P1 + 1) {
        pg8::Gemm g{(const bf16*)(ws + WS_U), (const bf16*)(ws + WS_WQK) + (size_t)L * 2048 * D, M, 2048, D, D, 0}; pg8::StaticOrder S; S.init(M, 2048, c.G, c.bid);
        pg8::EpiRow8<FStoreBf16> E{{(bf16*)(ws + WS_OV + OV_SC), 2048}};
        pg8::gemm_phase(c.lds, g, S, E); } PH_END(P1 + 1)
    PH_BEGIN(P1 + 2) if (PROBE_DUP == 4) phase_peer_topk(c, args); phase_peer_topk(c, args); PH_END(P1 + 2)
    PH_BEGIN(P1 + 3) phase_peer_down<0>(c, args, L, 0); if (PROBE_DOWN >= 0) phase_peer_down<PROBE_DOWN < 0 ? 0 : PROBE_DOWN>(c, args, L, 1); PH_END(P1 + 3)
    PH_BEGIN(P1 + 4) phase_peer_experts<L == DEPTH - 1 ? 1 : 0>(c, args, L == DEPTH - 1 ? args.in[I_NFIN] : args.in[I_NMG] + (size_t)(L + 1) * D); PH_END(P1 + 4)
}

__global__ void __launch_bounds__(512, 2) mk_fwd(Args kargs_) {
    extern __shared__ __attribute__((aligned(16))) unsigned char lds_raw[];
    LAS unsigned char* lds0 = (LAS unsigned char*)lds_raw;
    unsigned char* ws0 = kargs_.ws;
    const int lo = kargs_.lo, hi = kargs_.hi;
    if (threadIdx.x < 4) ((LAS unsigned*)(lds0 + LDS_MISC))[threadIdx.x] = 0u;
    __syncthreads();
    XcdBarrier bar; bar.bar = (unsigned*)(ws0 + WS_CTL) + CW_BAR; bar.x = 0; bar.st = (volatile LAS unsigned*)(lds0 + LDS_MISC);
    if (hi - lo > 1) bar = xcd_barrier_post((unsigned*)(ws0 + WS_CTL) + CW_BAR, (volatile LAS unsigned*)(lds0 + LDS_MISC));
    PH_BEGIN(0) phase_winmax(c, args); if (hi - lo > 1) xcd_barrier(bar); phase_prologue(c, args); PH_END(0)
    layer_pass<0>(bar, lo, hi);
    layer_pass<1>(bar, lo, hi);
}

extern "C" void kernel_launch(void* const* d_in, const int* in_sizes, int n_in, void* d_out, int out_size, void* d_ws, size_t ws_size, hipStream_t stream) {
    static int grid = 0;
    if (grid == 0) {
        if (n_in != 32 || out_size != M * D || ws_size < WS_END) { fprintf(stderr, "kernel_launch: unexpected problem (n_in %d, out %d, ws %zu < %zu)\n", n_in, out_size, ws_size, (size_t)WS_END); grid = -1; return; }
        int dev = 0, cus = 0, per_cu = 0;
        if (hipGetDevice(&dev) != hipSuccess || hipDeviceGetAttribute(&cus, hipDeviceAttributeMultiprocessorCount, dev) != hipSuccess) { grid = -1; return; }
        if (hipFuncSetAttribute((const void*)mk_fwd, hipFuncAttributeMaxDynamicSharedMemorySize, LDS_BYTES) != hipSuccess) { fprintf(stderr, "kernel_launch: hipFuncSetAttribute failed\n"); grid = -1; return; }
        if (hipOccupancyMaxActiveBlocksPerMultiprocessor(&per_cu, (const void*)mk_fwd, 512, LDS_BYTES) != hipSuccess || per_cu < 1) { fprintf(stderr, "kernel_launch: occupancy query says %d\n", per_cu); per_cu = 1; }
        (void)hipGetLastError();
        grid = cus;
    }
    if (grid < 0) return;
    (void)hipMemsetAsync((char*)d_ws + WS_CTL, 0, CTL_BYTES, stream);
    Args a{};
    for (int i = 0; i < 32; ++i) a.in[i] = (const float*)d_in[i];
    a.out = (float*)d_out; a.ws = (unsigned char*)d_ws;
#if MK_MULTI
    for (int p = 0; p < N_PHASES; ++p) { a.lo = p; a.hi = p + 1; hipLaunchKernelGGL(mk_fwd, dim3(grid), dim3(512), LDS_BYTES, stream, a); }
#else
    a.lo = 0; a.hi = N_PHASES;
    hipLaunchKernelGGL(mk_fwd, dim3(grid), dim3(512), LDS_BYTES, stream, a);
#endif
}
```

```cpp
#include <hip/hip_runtime.h>
#include <cstdio>
#include <cstdint>

#ifndef PROBE_DUP
#define PROBE_DUP 0
#endif
#ifndef MK_MULTI
#define MK_MULTI 0
#endif

#define GAS __attribute__((address_space(1)))
#define LAS __attribute__((address_space(3)))
typedef unsigned short bf16;
typedef unsigned v4u __attribute__((ext_vector_type(4)));
typedef unsigned v2u __attribute__((ext_vector_type(2)));
typedef float f32x4 __attribute__((ext_vector_type(4)));
typedef float f32x2 __attribute__((ext_vector_type(2)));
typedef short bf16x8 __attribute__((ext_vector_type(8)));
typedef __bf16 bf2_t __attribute__((ext_vector_type(2)));

constexpr int D = 1024, BATCH = 8, T = 4096, M = BATCH * T, MH = M / 2, DEPTH = 2;
constexpr int RW_PROJ = 3360, SSD_PROJ = 5152, IN_PROJ = 10560;
constexpr int N1P = 3584, N2P = 5120, N3P = 2048, NINP = N1P + N2P + N3P;
constexpr int DT_COL = RW_PROJ;
constexpr int KL = 384;
constexpr int NEXP = 16384;
#ifndef PROBE_DOWN
#define PROBE_DOWN -1
#endif
constexpr int PEER_SLICE_SHIFT = 11, PEER_NSLICE = NEXP >> PEER_SLICE_SHIFT;
constexpr int CW_WMAX = 12288, CW_WSC = 12304;
constexpr int CW_QUEUE = 8192;

constexpr size_t MiB = 1u << 20;
constexpr size_t WS_CTL = 0, CTL_BYTES = 1 * MiB;
constexpr size_t WS_WIN = 1 * MiB;
constexpr size_t WIN_L = (size_t)NINP * D * 2;
constexpr size_t WIN8_L = (size_t)NINP * D;
constexpr size_t U8IN_XS = 33 * MiB;
constexpr size_t WS_WA = 44 * MiB;
constexpr size_t WS_WB = 48 * MiB;
constexpr size_t WS_WO = 56 * MiB;
constexpr size_t WS_WQK = 60 * MiB;
constexpr size_t WS_WLORA = 68 * MiB;
constexpr size_t WLORA_L = (size_t)4096 * KL * 2;
constexpr size_t WS_U = 74 * MiB;
constexpr size_t WS_VF = 138 * MiB;
constexpr size_t WS_OV = 202 * MiB;
constexpr size_t OV_PR = 0, OV_ELOG = 112 * MiB, OV_ASIG = 144 * MiB, OV_GG = 176 * MiB, OV_VMIX = 208 * MiB, OV_AL = 240 * MiB, OV_YA = 272 * MiB;
constexpr size_t OV_PS = 0, OV_XBC = 168 * MiB, OV_DT = 305 * MiB, OV_DA = 307 * MiB;
constexpr size_t OV_GATES = 168 * MiB, OV_MIXED = 232 * MiB;
constexpr size_t OV_DOWN = 0, OV_UP = 32 * MiB, OV_PSCALE = 48 * MiB  , OV_SC = 64 * MiB, OV_IDX = 192 * MiB, OV_GATE = 208 * MiB, OV_POFF = 224 * MiB  , OV_ACT = 226 * MiB  , OV_U8 = 244 * MiB  , OV_XS = 276 * MiB  ;
constexpr size_t OV_BON = 304 * MiB;
constexpr size_t WS_END = WS_OV + 309 * MiB;
static_assert(WS_WIN + 2 * WIN_L <= WS_WA, "map");

constexpr int LDS_BYTES = 147456;
constexpr int LDS_MISC = 145408;
constexpr int CW_BAR = 4096;

__device__ __forceinline__ unsigned f2bf(float f) { unsigned u = __builtin_bit_cast(unsigned, f); return (u + 0x7fffu + ((u >> 16) & 1u)) >> 16; }
__device__ __forceinline__ unsigned pk2(float lo, float hi) { unsigned r; asm volatile("v_cvt_pk_bf16_f32 %0, %1, %2" : "=v"(r) : "v"(lo), "v"(hi)); return r; }
typedef __bf16 bf16x2_t __attribute__((ext_vector_type(2)));
__device__ __forceinline__ unsigned pk2c(float lo, float hi) { bf16x2_t v; v.x = (__bf16)lo; v.y = (__bf16)hi; return __builtin_bit_cast(unsigned, v); }
__device__ __forceinline__ float bflo(unsigned u) { return __builtin_bit_cast(float, u << 16); }
__device__ __forceinline__ float bfhi(unsigned u) { return __builtin_bit_cast(float, u & 0xffff0000u); }
__device__ __forceinline__ float bf1(bf16 u) { return __builtin_bit_cast(float, ((unsigned)u) << 16); }
__device__ __forceinline__ float sigmoidf_(float x) { return 1.f / (1.f + __expf(-x)); }
__device__ __forceinline__ float siluf_(float x) { return x / (1.f + __expf(-x)); }
template <int CTRL> __device__ __forceinline__ float dpp_mov(float x) { return __int_as_float(__builtin_amdgcn_update_dpp(0, __float_as_int(x), CTRL, 0xF, 0xF, true)); }
__device__ __forceinline__ float sum4(float x) { x += dpp_mov<0xB1>(x); x += dpp_mov<0x4E>(x); return x; }
__device__ __forceinline__ float sum16(float x) { x += dpp_mov<0xB1>(x); x += dpp_mov<0x4E>(x); x += dpp_mov<0x141>(x); x += dpp_mov<0x140>(x); return x; }
__device__ __forceinline__ float sum64(float x) { x = sum16(x); x += __shfl_xor(x, 16); x += __shfl_xor(x, 32); return x; }
__device__ __forceinline__ void unpack8(const v4u& q, float (&o)[8]) { o[0] = bflo(q.x); o[1] = bfhi(q.x); o[2] = bflo(q.y); o[3] = bfhi(q.y); o[4] = bflo(q.z); o[5] = bfhi(q.z); o[6] = bflo(q.w); o[7] = bfhi(q.w); }
__device__ __forceinline__ v4u pack8(const float (&o)[8]) { v4u q; q.x = pk2(o[0], o[1]); q.y = pk2(o[2], o[3]); q.z = pk2(o[4], o[5]); q.w = pk2(o[6], o[7]); return q; }

typedef short s16x4 __attribute__((ext_vector_type(4)));
__device__ __forceinline__ void lds_barrier() { asm volatile("s_waitcnt lgkmcnt(0)\n\ts_barrier" ::: "memory"); }
__device__ __forceinline__ bf16x8 tr_frag(unsigned base_bytes, int stride, int k0, int c0, int lane) {
    const int i16 = lane & 15, qq = i16 >> 2, p = i16 & 3, q = lane >> 4;
    const unsigned a0 = base_bytes + (unsigned)(((k0 + 8 * q + qq) * stride + c0 + 4 * p) * 2), a1 = a0 + (unsigned)(8 * stride);
    s16x4 lo, hi;
    asm volatile("ds_read_b64_tr_b16 %0, %2\n\tds_read_b64_tr_b16 %1, %3\n\ts_waitcnt lgkmcnt(0)" : "=&v"(lo), "=&v"(hi) : "v"(a0), "v"(a1) : "memory");
    return __builtin_shufflevector(lo, hi, 0, 1, 2, 3, 4, 5, 6, 7);
}

namespace pg8 {
typedef int i32x4_t __attribute__((ext_vector_type(4)));
constexpr int BM = 256, BK = 64, HALF = 128, HTB = HALF * BK * 2, STAGE_BYTES = 8 * HTB, NXCD = 8, WGM = 8;
__host__ __device__ __forceinline__ int lds_byte(int r, int c) { const int st = (r >> 4) * 2 + (c >> 5), rr = r & 15, cc = c & 31, ob = rr * 64 + cc * 2; return st * 1024 + (ob ^ (((ob >> 9) & 1) << 5)); }
__host__ __device__ __forceinline__ void stage_rc(int b, int& R, int& C) { const int st = b / 1024, sb = b % 1024, swz = sb ^ (((sb >> 9) & 1) << 5); R = (st >> 1) * 16 + swz / 64; C = (st & 1) * 32 + (swz % 64) / 2; }
__host__ __device__ __forceinline__ int perm32(int rho) { const int n = rho >> 4, i = rho & 15; return 8 * (i >> 2) + 4 * n + (i & 3); }
struct Unit { int pm, pn; };
struct Gemm { const bf16* A; const bf16* Bt; int M, N, K, lda; int kwin; };
__device__ __forceinline__ void unit_kwin(const Gemm& g, const Unit& u, int& k0t, int& ntl) { k0t = 0; ntl = g.K / BK; if (g.kwin) { const int blk = u.pn >> 2; if (blk < 2) { k0t = 0; ntl = 2; } else if (blk == 2) { k0t = 2; ntl = 4; } else { k0t = 4; ntl = 2; } } }
struct StaticOrder {
    int nM, nN, nwg, G, c;
    __device__ void init(int M_, int N_, int G_, int c_) { nM = M_ / BM; nN = N_ / BM; nwg = nM * nN; G = G_; c = c_; }
    __device__ bool next(int i, Unit& u) const {
        const long L = (long)i * G + c; if (L >= nwg) return false;
        int wgid = (int)L; { const int q = nwg / NXCD, r = nwg % NXCD, xcd = wgid % NXCD, off = wgid / NXCD; wgid = (xcd < r ? xcd * (q + 1) : r * (q + 1) + (xcd - r) * q) + off; }
        const int nig = WGM * nN, gid = wgid / nig, fm = gid * WGM, gsz = (nM - fm) < WGM ? (nM - fm) : WGM;
        u.pm = fm + ((wgid % nig) % gsz); u.pn = (wgid % nig) / gsz; return true;
    }
};
template <class F> struct EpiRow8 {
    static constexpr bool PERM = true;
    F f;
    __device__ __forceinline__ void operator()(const f32x4 (&acc)[2][2][4][2], const Unit& u, int wr, int wc, int fr, int fq) const {
        const int row0 = u.pm * BM + wr * 64 + fr, col0 = u.pn * BM + wc * 32 + 8 * fq;
#pragma unroll
        for (int g0 = 0; g0 < 16; g0 += F::GRP) {
            typename F::Tmp t[F::GRP];
#pragma unroll
            for (int j = 0; j < F::GRP; ++j) { const int i = g0 + j, ai = i >> 3, m = (i >> 1) & 3, bj = i & 1; f.load(row0 + ai * HALF + m * 16, col0 + bj * HALF, u.pn, t[j]); }
#pragma unroll
            for (int j = 0; j < F::GRP; ++j) { const int i = g0 + j, ai = i >> 3, m = (i >> 1) & 3, bj = i & 1; f.apply(row0 + ai * HALF + m * 16, col0 + bj * HALF, acc[ai][bj][m][0], acc[ai][bj][m][1], u.pn, t[j]); }
        }
    }
};


typedef int i32x8 __attribute__((ext_vector_type(8)));
template <class E> struct epi_f8 { static constexpr bool v = false; };
struct FragB16 { bf16x8 k[2]; };
template <bool F8> struct FragT { typedef FragB16 T; };
template <> struct FragT<true> { typedef i32x8 T; };
__device__ __forceinline__ void ld_frag(FragB16& d, const LAS unsigned char* p) { d.k[0] = *(const LAS bf16x8*)p; d.k[1] = *(const LAS bf16x8*)(p + 1024); }
__device__ __forceinline__ void ld_frag(i32x8& d, const LAS unsigned char* p) { const i32x4_t lo = *(const LAS i32x4_t*)p, hi = *(const LAS i32x4_t*)(p + 1024); d = __builtin_shufflevector(lo, hi, 0, 1, 2, 3, 4, 5, 6, 7); }
__device__ __forceinline__ void mma_frag(f32x4& acc, const FragB16& b, const FragB16& a) { acc = __builtin_amdgcn_mfma_f32_16x16x32_bf16(b.k[0], a.k[0], acc, 0, 0, 0); acc = __builtin_amdgcn_mfma_f32_16x16x32_bf16(b.k[1], a.k[1], acc, 0, 0, 0); }
__device__ __forceinline__ void lda_group(FragB16 (&At)[4], const LAS unsigned char* ab) {
#pragma unroll
    for (int m = 0; m < 4; ++m) ld_frag(At[m], ab + m * 2048); }
__device__ __forceinline__ void lda_group(i32x8 (&At)[4], const LAS unsigned char* ab) { ld_frag(At[0], ab); ld_frag(At[1], ab + 2048); ld_frag(At[2], ab + 2 * 2048); }
__device__ __forceinline__ void lda_again(FragB16 (&)[4], const LAS unsigned char*) {}
__device__ __forceinline__ void lda_again(i32x8 (&At)[4], const LAS unsigned char* ab) { ld_frag(At[0], ab); ld_frag(At[1], ab + 2048); ld_frag(At[2], ab + 2 * 2048); }
__device__ __forceinline__ void mma_frag(f32x4& acc, const i32x8& b, const i32x8& a);
__device__ __forceinline__ void mma_frag(f32x4& acc, const FragB16& b, const FragB16& a);
__device__ __forceinline__ void mma_group(f32x4 (&acc)[4][2], FragB16 (&At)[4], const FragB16 (&Bt)[2], const LAS unsigned char*) {
#pragma unroll
    for (int m = 0; m < 4; ++m)
#pragma unroll
        for (int n = 0; n < 2; ++n) mma_frag(acc[m][n], Bt[n], At[m]); }
__device__ __forceinline__ void mma_group(f32x4 (&acc)[4][2], i32x8 (&At)[4], const i32x8 (&Bt)[2], const LAS unsigned char* ab) {
    mma_frag(acc[0][0], Bt[0], At[0]); mma_frag(acc[0][1], Bt[1], At[0]);
    ld_frag(At[0], ab + 3 * 2048);
    mma_frag(acc[1][0], Bt[0], At[1]); mma_frag(acc[1][1], Bt[1], At[1]);
    mma_frag(acc[2][0], Bt[0], At[2]); mma_frag(acc[2][1], Bt[1], At[2]);
    mma_frag(acc[3][0], Bt[0], At[0]); mma_frag(acc[3][1], Bt[1], At[0]); }
__device__ __forceinline__ void mma_frag(f32x4& acc, const i32x8& b, const i32x8& a) { acc = __builtin_amdgcn_mfma_scale_f32_16x16x128_f8f6f4(b, a, acc, 0, 0, 0, 0x7f7f7f7f, 0, 0x7f7f7f7f); }
template <class Epi>
__device__ __forceinline__ void gemm_phase(LAS unsigned char* lds, const Gemm g, const StaticOrder& S, const Epi& E) {
    const int tid = threadIdx.x, wid = __builtin_amdgcn_readfirstlane(tid >> 6), lane = tid & 63, wr = wid >> 2, wc = wid & 3, fr = lane & 15, fq = lane >> 4;
    const int K = g.K, lda = g.lda;
    unsigned voffA, voffB;
    { int R, C; stage_rc(tid * 16, R, C); const int Rb = Epi::PERM ? ((R & ~31) + perm32(R & 31)) : R;
      voffA = (unsigned)(R * lda + C) * 2u; voffB = (unsigned)(Rb * K + C) * 2u; }
    const size_t voffA_step = (size_t)64 * lda * 2, voffB_step = (size_t)64 * K * 2;
    const size_t kstep = (size_t)(BK * 2);
    const size_t hstepA = (size_t)HALF * lda * 2, hstepB = (size_t)HALF * K * 2;
    const size_t tstepA = 2 * hstepA, tstepB = 2 * hstepB;
    const unsigned ldsw = (unsigned)wid * 1024u;
    const int aoff = lds_byte(wr * 64 + fr, fq * 8), boff = lds_byte(wc * 32 + fr, fq * 8);
#define PG8_SA(b, h) (((b) * 2 + (h)) * HTB)
#define PG8_SB(b, h) ((4 + (b) * 2 + (h)) * HTB)
#define PG8_STAGE(bufoff, gbase, voff) do { _Pragma("unroll") for (int _i = 0; _i < 2; ++_i) \
        __builtin_amdgcn_global_load_lds((const unsigned*)((const char*)(gbase) + _i * voff##_step + (voff)), (LAS unsigned*)(lds + (bufoff) + ldsw + _i * 8192), 16, 0, 0); } while (0)
#define PG8_LDA(dst, b, h) lda_group(dst, lds + PG8_SA(b, h) + aoff)
#define PG8_LDB(dst, b, h) do { _Pragma("unroll") for (int n = 0; n < 2; ++n) ld_frag(dst[n], lds + PG8_SB(b, h) + boff + n * 2048); } while (0)
#define PG8_LDAR(dst, b, h) lda_again(dst, lds + PG8_SA(b, h) + aoff)
#define PG8_MMA(b, ai, bj, At, Bt) do { __builtin_amdgcn_s_setprio(1); mma_group(acc[ai][bj], At, Bt, lds + PG8_SA(b, ai) + aoff); __builtin_amdgcn_s_setprio(0); } while (0)
#define PG8_WAIT_V(n) asm volatile("s_waitcnt vmcnt(" #n ")" ::: "memory")
#define PG8_WAIT_L(n) asm volatile("s_waitcnt lgkmcnt(" #n ")" ::: "memory")
#define PG8_BAR __builtin_amdgcn_s_barrier()
#define PG8_SCHED __builtin_amdgcn_sched_barrier(0)
    Unit cur, nxt; int ui = 0;
    if (!S.next(0, cur)) return;
    f32x4 acc[2][2][4][2];
#pragma unroll
    for (int a = 0; a < 2; ++a)
#pragma unroll
        for (int b = 0; b < 2; ++b)
#pragma unroll
            for (int m = 0; m < 4; ++m)
#pragma unroll
                for (int n = 0; n < 2; ++n) acc[a][b][m][n] = (f32x4){0.f, 0.f, 0.f, 0.f};
    typename FragT<epi_f8<Epi>::v>::T At[4], B0[2], B1[2];
    int k0c, nt; unit_kwin(g, cur, k0c, nt);
    const char* cA = (const char*)g.A + (size_t)cur.pm * tstepA + (size_t)k0c * kstep; const char* cB = (const char*)g.Bt + (size_t)cur.pn * tstepB + (size_t)k0c * kstep;
    PG8_STAGE(PG8_SB(0, 0), cB, voffB); PG8_STAGE(PG8_SA(0, 0), cA, voffA); PG8_STAGE(PG8_SB(0, 1), cB + hstepB, voffB); PG8_STAGE(PG8_SA(0, 1), cA + hstepA, voffA);
    if (wr == 1) PG8_BAR;
    PG8_WAIT_V(4); PG8_BAR;
    PG8_STAGE(PG8_SB(1, 0), cB + kstep, voffB); PG8_STAGE(PG8_SA(1, 0), cA + kstep, voffA); PG8_STAGE(PG8_SB(1, 1), cB + hstepB + kstep, voffB);
    PG8_WAIT_V(6); PG8_BAR;
    for (;;) {
        const bool has_next = S.next(ui + 1, nxt);
        int k0n = 0, ntn = nt; if (has_next) unit_kwin(g, nxt, k0n, ntn);
        const char* nA = has_next ? (const char*)g.A + (size_t)nxt.pm * tstepA + (size_t)k0n * kstep : cA; const char* nB = has_next ? (const char*)g.Bt + (size_t)nxt.pn * tstepB + (size_t)k0n * kstep : cB;
        for (int t = 0; t < nt; t += 2) {
            const bool last = (t == nt - 2);
            const char* a1 = cA + (size_t)(t + 1) * kstep;
            const char* a2 = last ? nA : cA + (size_t)(t + 2) * kstep; const char* b2 = last ? nB : cB + (size_t)(t + 2) * kstep;
            const char* a3 = a2 + kstep; const char* b3 = b2 + kstep;
            PG8_LDB(B0, 0, 0); PG8_SCHED; PG8_LDA(At, 0, 0); PG8_STAGE(PG8_SA(1, 1), a1 + hstepA, voffA);
            PG8_WAIT_L(8); PG8_BAR; PG8_WAIT_L(0); PG8_MMA(0, 0, 0, At, B0); PG8_LDAR(At, 0, 0); PG8_BAR; PG8_SCHED;
            PG8_LDB(B1, 0, 1); PG8_STAGE(PG8_SB(0, 0), b2, voffB);
            PG8_BAR; PG8_WAIT_L(0); PG8_MMA(0, 0, 1, At, B1); PG8_BAR;
            PG8_LDA(At, 0, 1); PG8_STAGE(PG8_SA(0, 0), a2, voffA);
            PG8_BAR; PG8_WAIT_L(0); PG8_MMA(0, 1, 0, At, B0); PG8_LDAR(At, 0, 1); PG8_BAR; PG8_SCHED;
            PG8_STAGE(PG8_SB(0, 1), b2 + hstepB, voffB);
            PG8_WAIT_V(6); PG8_BAR; PG8_MMA(0, 1, 1, At, B1); PG8_BAR;
            PG8_LDB(B0, 1, 0); PG8_SCHED; PG8_LDA(At, 1, 0); PG8_STAGE(PG8_SA(0, 1), a2 + hstepA, voffA);
            PG8_WAIT_L(8); PG8_BAR; PG8_WAIT_L(0); PG8_MMA(1, 0, 0, At, B0); PG8_LDAR(At, 1, 0); PG8_BAR; PG8_SCHED;
            PG8_LDB(B1, 1, 1); PG8_STAGE(PG8_SB(1, 0), b3, voffB);
            PG8_BAR; PG8_WAIT_L(0); PG8_MMA(1, 0, 1, At, B1); PG8_BAR;
            PG8_LDA(At, 1, 1); PG8_STAGE(PG8_SA(1, 0), a3, voffA);
            PG8_BAR; PG8_WAIT_L(0); PG8_MMA(1, 1, 0, At, B0); PG8_LDAR(At, 1, 1); PG8_BAR; PG8_SCHED;
            PG8_STAGE(PG8_SB(1, 1), b3 + hstepB, voffB);
            PG8_WAIT_V(6); PG8_BAR; PG8_MMA(1, 1, 1, At, B1); PG8_BAR;
        }
        E(acc, cur, wr, wc, fr, fq);
        if (!has_next) break;
#pragma unroll
        for (int a = 0; a < 2; ++a)
#pragma unroll
            for (int b = 0; b < 2; ++b)
#pragma unroll
                for (int m = 0; m < 4; ++m)
#pragma unroll
                    for (int n = 0; n < 2; ++n) acc[a][b][m][n] = (f32x4){0.f, 0.f, 0.f, 0.f};
        cur = nxt; cA = nA; cB = nB; nt = ntn; ++ui;
    }
    PG8_WAIT_V(0);
    if (wr == 0) PG8_BAR;
    PG8_BAR;
#undef PG8_SA
#undef PG8_SB
#undef PG8_STAGE
#undef PG8_LDA
#undef PG8_LDB
#undef PG8_MMA
#undef PG8_WAIT_V
#undef PG8_WAIT_L
#undef PG8_BAR
#undef PG8_SCHED
}
}

#define XB_TMO      128
#define XB_XCNT(j)  (256  + 64 * (j))
#define XB_XSUB(j)  (1280 + 64 * (j))
#define XB_XGEN(j)  (2304 + 64 * (j))
#define XB_TOP      3328
#define XB_TOPGEN   3392
#define XCD_BAR_WORDS 3456
#define XB_SPIN_CAP (1u << 18)
__device__ __forceinline__ unsigned xb_ld(unsigned* p)              { return __hip_atomic_load(p, __ATOMIC_RELAXED, __HIP_MEMORY_SCOPE_AGENT); }
__device__ __forceinline__ unsigned xb_add(unsigned* p, unsigned v) { return __hip_atomic_fetch_add(p, v, __ATOMIC_RELAXED, __HIP_MEMORY_SCOPE_AGENT); }
__device__ __forceinline__ unsigned xb_xcc_id() { return (unsigned)__builtin_amdgcn_s_getreg((3 << 11) | 20) & 0xFu; }
#define XB_SPIN(cond, bar) do { unsigned _sp = 0; while (cond) { __builtin_amdgcn_s_sleep(1); \
    if ((++_sp & 255u) == 0u) { if (xb_ld(&(bar)[XB_TMO])) break; if (_sp > XB_SPIN_CAP) { atomicAdd(&(bar)[XB_TMO], 1u); break; } } } } while (0)
struct XcdBarrier { unsigned* bar; unsigned x; volatile LAS unsigned* st; };
__device__ __forceinline__ XcdBarrier xcd_barrier_post(unsigned* bar, volatile LAS unsigned* st) {
    XcdBarrier b; b.bar = bar; b.x = xb_xcc_id(); b.st = st;
    if (threadIdx.x == 0) (void)xb_add(&bar[XB_XCNT(b.x)], 1u);
    return b;
}
__device__ __forceinline__ void xcd_barrier_complete(unsigned* bar, unsigned x, unsigned& nloc, unsigned& nx) {
    const unsigned G = gridDim.x * gridDim.y * gridDim.z;
    unsigned sum, cnt, mine, sp = 0u;
    for (;;) {
        sum = 0u; cnt = 0u; mine = 0u;
#pragma unroll
        for (unsigned j = 0; j < 16; ++j) { const unsigned c = xb_ld(&bar[XB_XCNT(j)]); sum += c; cnt += (c > 0u) ? 1u : 0u; mine = (j == x) ? c : mine; }
        if (sum == G) break;
        __builtin_amdgcn_s_sleep(1);
        if ((++sp & 255u) == 0u) { if (xb_ld(&bar[XB_TMO])) break; if (sp > XB_SPIN_CAP) { atomicAdd(&bar[XB_TMO], 1u); break; } }
    }
    nloc = mine > 0u ? mine : 1u; nx = cnt > 0u ? cnt : 1u;
}
__device__ __forceinline__ void xcd_barrier(const XcdBarrier& b) {
    asm volatile("s_waitcnt vmcnt(0)" ::: "memory");
    __syncthreads();
    if (threadIdx.x == 0) {
        unsigned* bar = b.bar;
        __builtin_amdgcn_s_waitcnt(0);
        unsigned nloc = b.st[0], nx = b.st[1];
        if (nloc == 0u) { xcd_barrier_complete(bar, b.x, nloc, nx); b.st[0] = nloc; b.st[1] = nx; }
        const unsigned old = xb_add(&bar[XB_XSUB(b.x)], 1u);
        const unsigned gen = old / nloc;
        if (old + 1u == (gen + 1u) * nloc) {
            __builtin_amdgcn_fence(__ATOMIC_RELEASE, "agent");
            asm volatile("s_waitcnt vmcnt(0)" ::: "memory");
            const unsigned og = xb_add(&bar[XB_TOP], 1u);
            const unsigned tg = og / nx;
            if (og + 1u == (tg + 1u) * nx) xb_add(&bar[XB_TOPGEN], 1u);
            else XB_SPIN(xb_ld(&bar[XB_TOPGEN]) == tg, bar);
            __builtin_amdgcn_fence(__ATOMIC_ACQUIRE, "agent");
            xb_add(&bar[XB_XGEN(b.x)], 1u);
            asm volatile("s_waitcnt vmcnt(0)" ::: "memory");
        } else {
            XB_SPIN(xb_ld(&bar[XB_XGEN(b.x)]) == gen, bar);
            __builtin_amdgcn_fence(__ATOMIC_ACQUIRE, "agent");
            asm volatile("s_waitcnt vmcnt(0)" ::: "memory");
        }
    }
    __syncthreads();
}

struct Args { const float* in[32]; float* out; unsigned char* ws; int lo, hi; };
typedef const Args __attribute__((address_space(4))) KArgs;
enum { I_X = 0, I_NMG, I_WIN, I_MU, I_W0, I_W2, I_A0, I_A2, I_G2, I_V0, I_V1, I_V2, I_KK, I_KA, I_RK, I_LNW, I_LNB, I_WRB, I_CW, I_CB, I_DTB, I_ALOG, I_SD, I_SNG, I_WSB, I_WOUT, I_NFG, I_WQ, I_SK, I_PD, I_PU, I_NFIN };

struct NoTmp {};
struct FStoreBf16 { bf16* O; int ldc; typedef NoTmp Tmp; static constexpr int GRP = 16;
    __device__ __forceinline__ void load(int, int, int, Tmp&) const {}
    __device__ __forceinline__ void apply(int row, int col, f32x4 v0, f32x4 v1, int, const Tmp&) const {
        v4u w; w.x = pk2(v0[0], v0[1]); w.y = pk2(v0[2], v0[3]); w.z = pk2(v1[0], v1[1]); w.w = pk2(v1[2], v1[3]);
        *(v4u*)(O + (size_t)row * ldc + col) = w; } };
struct FSigmoidBf16 { bf16* O; int ldc; typedef NoTmp Tmp; static constexpr int GRP = 16;
    __device__ __forceinline__ void load(int, int, int, Tmp&) const {}
    __device__ __forceinline__ void apply(int row, int col, f32x4 v0, f32x4 v1, int, const Tmp&) const {
        v4u w; w.x = pk2(sigmoidf_(v0[0]), sigmoidf_(v0[1])); w.y = pk2(sigmoidf_(v0[2]), sigmoidf_(v0[3])); w.z = pk2(sigmoidf_(v1[0]), sigmoidf_(v1[1])); w.w = pk2(sigmoidf_(v1[2]), sigmoidf_(v1[3]));
        *(v4u*)(O + (size_t)row * ldc + col) = w; } };
struct FStoreBf16S { bf16* O; int ldc; const float* xs; const float* wsc; typedef float Tmp; static constexpr int GRP = 16;
    __device__ __forceinline__ void load(int row, int, int, Tmp& t) const { t = xs[row] * wsc[0]; }
    __device__ __forceinline__ void apply(int row, int col, f32x4 v0, f32x4 v1, int, const Tmp& t) const {
        v0 *= t; v1 *= t;
        v4u w; w.x = pk2c(v0[0], v0[1]); w.y = pk2c(v0[2], v0[3]); w.z = pk2c(v1[0], v1[1]); w.w = pk2c(v1[2], v1[3]);
        *(v4u*)(O + (size_t)row * ldc + col) = w; } };
struct FSigmoidBf16S { bf16* O; int ldc; const float* xs; const float* wsc; typedef float Tmp; static constexpr int GRP = 16;
    __device__ __forceinline__ void load(int row, int, int, Tmp& t) const { t = xs[row] * wsc[0]; }
    __device__ __forceinline__ void apply(int row, int col, f32x4 v0, f32x4 v1, int, const Tmp& t) const {
        v0 *= t; v1 *= t;
        v4u w; w.x = pk2c(sigmoidf_(v0[0]), sigmoidf_(v0[1])); w.y = pk2c(sigmoidf_(v0[2]), sigmoidf_(v0[3])); w.z = pk2c(sigmoidf_(v1[0]), sigmoidf_(v1[1])); w.w = pk2c(sigmoidf_(v1[2]), sigmoidf_(v1[3]));
        *(v4u*)(O + (size_t)row * ldc + col) = w; } };
namespace pg8 { template <> struct epi_f8<EpiRow8<FStoreBf16S>> { static constexpr bool v = true; }; template <> struct epi_f8<EpiRow8<FSigmoidBf16S>> { static constexpr bool v = true; }; }
struct EpiLora {
    static constexpr bool PERM = true;
    bf16 *elog, *asig, *gg, *vmix; const bf16* vf; const float *w0, *a0, *v0;
    template <int BLK> __device__ __forceinline__ void run(const f32x4 (&acc)[2][2][4][2], int row0, int col0) const {
#pragma unroll
        for (int bj = 0; bj < 2; ++bj) {
            const int c = (col0 + bj * 128) & 1023;
            float bias[8];
            if (BLK == 0 || BLK == 1 || BLK == 3) { const float* bp = (BLK == 0 ? w0 : (BLK == 1 ? a0 : v0)) + c; const f32x4 b0 = *(const f32x4*)bp, b1 = *(const f32x4*)(bp + 4);
                bias[0] = b0[0]; bias[1] = b0[1]; bias[2] = b0[2]; bias[3] = b0[3]; bias[4] = b1[0]; bias[5] = b1[1]; bias[6] = b1[2]; bias[7] = b1[3]; }
#pragma unroll
            for (int ai = 0; ai < 2; ++ai) {
            v4u qvs[4], qvf[4];
            if (BLK == 3) {
#pragma unroll
                for (int i = 0; i < 4; ++i) { const size_t o = (size_t)(row0 + ai * 128 + i * 16) * D + c; qvs[i] = *(const v4u*)(vmix + o); qvf[i] = *(const v4u*)(vf + o); }
            }
#pragma unroll
                for (int m = 0; m < 4; ++m) {
                    const int row = row0 + ai * 128 + m * 16; const size_t o = (size_t)row * D + c;
                    const f32x4 v0_ = acc[ai][bj][m][0], v1_ = acc[ai][bj][m][1];
                    float a[8] = {v0_[0], v0_[1], v0_[2], v0_[3], v1_[0], v1_[1], v1_[2], v1_[3]};
                    if (BLK == 0) {
#pragma unroll
                        for (int e = 0; e < 8; ++e) a[e] = -0.6065306597f * sigmoidf_(bias[e] + a[e]);
                        *(v4u*)(elog + o) = pack8(a);
                    } else if (BLK == 1) {
#pragma unroll
                        for (int e = 0; e < 8; ++e) a[e] = sigmoidf_(bias[e] + a[e]);
                        *(v4u*)(asig + o) = pack8(a);
                    } else if (BLK == 2) {
                        *(v4u*)(gg + o) = pack8(a);
                    } else {
                        float vs[8], vfv[8]; unpack8(qvs[m], vs); unpack8(qvf[m], vfv);
#pragma unroll
                        for (int e = 0; e < 8; ++e) a[e] = vs[e] + (vfv[e] - vs[e]) * sigmoidf_(bias[e] + a[e]);
                        *(v4u*)(vmix + o) = pack8(a);
                    }
                }
            }
        }
    }
    __device__ __forceinline__ void operator()(const f32x4 (&acc)[2][2][4][2], const pg8::Unit& u, int wr, int wc, int fr, int fq) const {
        const int row0 = u.pm * 256 + wr * 64 + fr, col0 = u.pn * 256 + wc * 32 + 8 * fq;
        const int blk = u.pn >> 2;
        if (blk == 0) run<0>(acc, row0, col0); else if (blk == 1) run<1>(acc, row0, col0); else if (blk == 2) run<2>(acc, row0, col0); else run<3>(acc, row0, col0);
    }
};
struct FMixA { const bf16* gates; bf16* mixed;
    struct Tmp { v4u g; }; static constexpr int GRP = 8;
    __device__ __forceinline__ void load(int row, int col, int, Tmp& t) const { t.g = *(const v4u*)(gates + (size_t)row * 2048 + col); }
    __device__ __forceinline__ void apply(int row, int col, f32x4 v0, f32x4 v1, int, const Tmp& t) const {
        float g[8]; unpack8(t.g, g);
        float a[8] = {v0[0] * g[0], v0[1] * g[1], v0[2] * g[2], v0[3] * g[3], v1[0] * g[4], v1[1] * g[5], v1[2] * g[6], v1[3] * g[7]};
        *(v4u*)(mixed + (size_t)row * D + col) = pack8(a); } };
struct FMixB { const bf16* gates; bf16* mixed;
    struct Tmp { v4u g, mx; }; static constexpr int GRP = 8;
    __device__ __forceinline__ void load(int row, int col, int, Tmp& t) const { t.g = *(const v4u*)(gates + (size_t)row * 2048 + 1024 + col); t.mx = *(const v4u*)(mixed + (size_t)row * D + col); }
    __device__ __forceinline__ void apply(int row, int col, f32x4 v0, f32x4 v1, int, const Tmp& t) const {
        float g[8], mx[8]; unpack8(t.g, g); unpack8(t.mx, mx);
        float a[8] = {mx[0] + v0[0] * g[0], mx[1] + v0[1] * g[1], mx[2] + v0[2] * g[2], mx[3] + v0[3] * g[3], mx[4] + v1[0] * g[4], mx[5] + v1[1] * g[5], mx[6] + v1[2] * g[6], mx[7] + v1[3] * g[7]};
        *(v4u*)(mixed + (size_t)row * D + col) = pack8(a); } };
struct FResid { const float* base; float* h;
    struct Tmp { f32x4 a, b; }; static constexpr int GRP = 8;
    __device__ __forceinline__ void load(int row, int col, int, Tmp& t) const { const f32x4* s = (const f32x4*)(base + (size_t)row * D + col); t.a = s[0]; t.b = s[1]; }
    __device__ __forceinline__ void apply(int row, int col, f32x4 v0, f32x4 v1, int, const Tmp& t) const {
        f32x4* p = (f32x4*)(h + (size_t)row * D + col); p[0] = t.a + v0; p[1] = t.b + v1; } };

struct Ctx { int tid, lane, wave, G, bid; LAS unsigned char* lds; };

__device__ __forceinline__ void transpose_item(const float* W, int K, int N, bf16* WT, int row_off, LAS float* scr, int item, int lane) {
    const int nblk = N / 32, kb = item / nblk, nb = item % nblk, k0 = 64 * kb, n0 = 32 * nb;
#pragma unroll 8
    for (int i = 0; i < 32; ++i) { const int kk = 2 * i + (lane >> 5); scr[kk * 33 + (lane & 31)] = W[(size_t)(k0 + kk) * N + n0 + (lane & 31)]; }
    asm volatile("s_waitcnt lgkmcnt(0)" ::: "memory");
    const int c = lane & 7;
#pragma unroll
    for (int j = 0; j < 4; ++j) { const int n = (lane >> 3) + 8 * j; const LAS float* s = scr + (8 * c) * 33 + n;
        v4u o; o.x = pk2(s[0 * 33], s[1 * 33]); o.y = pk2(s[2 * 33], s[3 * 33]); o.z = pk2(s[4 * 33], s[5 * 33]); o.w = pk2(s[6 * 33], s[7 * 33]);
        *(v4u*)(WT + (size_t)(row_off + n0 + n) * K + k0 + 8 * c) = o; }
    asm volatile("s_waitcnt lgkmcnt(0)" ::: "memory");
}
__device__ __forceinline__ void transpose_item8(const float* W, int K, int N, unsigned char* WT, int row_off, LAS float* scr, int item, int lane, float qs) {
    const int nblk = N / 32, kb = item / nblk, nb = item % nblk, k0 = 64 * kb, n0 = 32 * nb;
#pragma unroll 8
    for (int i = 0; i < 32; ++i) { const int kk = 2 * i + (lane >> 5); scr[kk * 33 + (lane & 31)] = W[(size_t)(k0 + kk) * N + n0 + (lane & 31)]; }
    asm volatile("s_waitcnt lgkmcnt(0)" ::: "memory");
    const int c = lane & 7;
#pragma unroll
    for (int j = 0; j < 4; ++j) { const int n = (lane >> 3) + 8 * j; const LAS float* s = scr + (8 * c) * 33 + n;
        int w0 = __builtin_amdgcn_cvt_pk_fp8_f32(s[0 * 33] * qs, s[1 * 33] * qs, 0, false); w0 = __builtin_amdgcn_cvt_pk_fp8_f32(s[2 * 33] * qs, s[3 * 33] * qs, w0, true);
        int w1 = __builtin_amdgcn_cvt_pk_fp8_f32(s[4 * 33] * qs, s[5 * 33] * qs, 0, false); w1 = __builtin_amdgcn_cvt_pk_fp8_f32(s[6 * 33] * qs, s[7 * 33] * qs, w1, true);
        v2u o; o.x = (unsigned)w0; o.y = (unsigned)w1;
        *(v2u*)(WT + (size_t)(row_off + n0 + n) * K + k0 + 8 * c) = o; }
    asm volatile("s_waitcnt lgkmcnt(0)" ::: "memory");
}
__device__ __forceinline__ void phase_winmax(const Ctx& c, KArgs& a) {
    unsigned* CT = (unsigned*)(a.ws + WS_CTL);
#pragma unroll 1
    for (int l = 0; l < 2; ++l) {
        const f32x4* W = (const f32x4*)(a.in[I_WIN] + (size_t)l * D * IN_PROJ);
        float am = 0.f;
        for (int i = c.bid * 512 + c.tid; i < D * IN_PROJ / 4; i += c.G * 512) { const f32x4 v = W[i]; am = fmaxf(am, fmaxf(fmaxf(fabsf(v.x), fabsf(v.y)), fmaxf(fabsf(v.z), fabsf(v.w)))); }
#pragma unroll
        for (int o = 1; o < 64; o <<= 1) am = fmaxf(am, __shfl_xor(am, o));
        if (c.lane == 0) __hip_atomic_fetch_max(CT + CW_WMAX + l, __builtin_bit_cast(unsigned, am), __ATOMIC_RELAXED, __HIP_MEMORY_SCOPE_AGENT);
    }
}
__device__ __forceinline__ int winrow(int n) {
    if (n < RW_PROJ) return n;
    if (n < RW_PROJ + 5120) return N1P + (n - RW_PROJ);
    if (n < RW_PROJ + SSD_PROJ) return DT_COL + (n - RW_PROJ - 5120);
    return N1P + N2P + (n - RW_PROJ - SSD_PROJ); }

__device__ __forceinline__ void phase_prologue(const Ctx& c, KArgs& a) {
    unsigned char* ws = a.ws;
    LAS float* scr = (LAS float*)(c.lds + c.wave * 16384);
    const int gw = c.bid * 8 + c.wave, NGW = c.G * 8;
    constexpr int I_IN = 16 * (IN_PROJ / 32), I_A = 16 * 32, I_B = 32 * 32, I_O = 16 * 32, I_L = I_IN + I_A + I_B + I_O;
    for (int it = gw; it < 2 * I_L; it += NGW) {
        const int l = it / I_L; int r = it % I_L;
        if (r < I_IN) { const int nb = r % (IN_PROJ / 32); const float am = fmaxf(__builtin_bit_cast(float, __hip_atomic_load((const unsigned*)(ws + WS_CTL) + CW_WMAX + l, __ATOMIC_RELAXED, __HIP_MEMORY_SCOPE_AGENT)), 1e-30f);
            transpose_item8(a.in[I_WIN] + (size_t)l * D * IN_PROJ, D, IN_PROJ, ws + WS_WIN + l * WIN8_L, winrow(nb * 32) - nb * 32, scr, r, c.lane, 384.f / am); continue; } r -= I_IN;
        if (r < I_A) { transpose_item(a.in[I_WRB] + (size_t)l * D * D, D, D, (bf16*)(ws + WS_WA) + (size_t)l * D * D, 0, scr, r, c.lane); continue; } r -= I_A;
        if (r < I_B) { transpose_item(a.in[I_WSB] + (size_t)l * 2048 * D, 2048, D, (bf16*)(ws + WS_WB) + (size_t)l * D * 2048, 0, scr, r, c.lane); continue; } r -= I_B;
        transpose_item(a.in[I_WOUT] + (size_t)l * D * D, D, D, (bf16*)(ws + WS_WO) + (size_t)l * D * D, 0, scr, r, c.lane);
    }
    for (int it = c.bid * 512 + c.tid; it < 2 * 192 * 64; it += c.G * 512) {
        const int l = it / (192 * 64), r = (it / 64) % 192, q = it % 64;
        *(v4u*)(ws + WS_WIN + l * WIN8_L + (size_t)(DT_COL + 32 + r) * D + q * 16) = (v4u){0u, 0u, 0u, 0u};
    }
    if (c.bid == 0 && c.tid < 2) ((float*)(ws + WS_CTL))[CW_WSC + c.tid] = fmaxf(__builtin_bit_cast(float, __hip_atomic_load((const unsigned*)(ws + WS_CTL) + CW_WMAX + c.tid, __ATOMIC_RELAXED, __HIP_MEMORY_SCOPE_AGENT)), 1e-30f) * (1.f / 384.f);
    for (int it = c.bid * 512 + c.tid; it < 2 * 4096 * KL; it += c.G * 512) {
        const int l = it / (4096 * KL), n = (it / KL) % 4096, k = it % KL; const int blk = n >> 10, cc = n & 1023;
        float v = 0.f;
        if (blk == 0) { if (k < 64) v = a.in[I_W2][((size_t)l * 64 + k) * D + cc]; }
        else if (blk == 1) { if (k >= 64 && k < 128) v = a.in[I_A2][((size_t)l * 64 + (k - 64)) * D + cc]; }
        else if (blk == 2) { if (k >= 128 && k < 288) v = a.in[I_G2][((size_t)l * 160 + (k - 128)) * D + cc]; }
        else { if (l == 1 && k >= 288 && k < 320) v = a.in[I_V2][(size_t)(k - 288) * D + cc]; }
        ((bf16*)(ws + WS_WLORA + l * WLORA_L))[(size_t)n * KL + k] = (bf16)f2bf(v);
    }
    __syncthreads();
    LAS float* wqL = (LAS float*)c.lds;
    LAS float* kyL = (LAS float*)(c.lds + 32768);
    for (int it = c.bid; it < 2 * 16 * 16; it += c.G) {
        const int l = it >> 8, hc = (it >> 4) & 15, k0 = (it & 15) * 64;
        const float* wq = a.in[I_WQ] + (size_t)l * D * 2048; const float* ky = a.in[I_SK] + ((size_t)l * 16 + hc) * 128 * 128;
        for (int e = c.tid; e < 64 * 128; e += 512) wqL[e] = wq[(size_t)(k0 + (e >> 7)) * 2048 + hc * 128 + (e & 127)];
        for (int e = c.tid; e < 128 * 128; e += 512) kyL[(e >> 7) * 129 + (e & 127)] = ky[e];
        __syncthreads();
        const int key = c.tid & 127, kg = c.tid >> 7;
        float acc[16];
#pragma unroll
        for (int i = 0; i < 16; ++i) acc[i] = 0.f;
        for (int d = 0; d < 128; ++d) { const float kv = kyL[key * 129 + d];
#pragma unroll
            for (int i = 0; i < 16; ++i) acc[i] += wqL[(kg * 16 + i) * 128 + d] * kv; }
        bf16* o = (bf16*)(ws + WS_WQK) + ((size_t)l * 2048 + hc * 128 + key) * D + k0 + kg * 16;
        v4u q0, q1; q0.x = pk2(acc[0], acc[1]); q0.y = pk2(acc[2], acc[3]); q0.z = pk2(acc[4], acc[5]); q0.w = pk2(acc[6], acc[7]);
        q1.x = pk2(acc[8], acc[9]); q1.y = pk2(acc[10], acc[11]); q1.z = pk2(acc[12], acc[13]); q1.w = pk2(acc[14], acc[15]);
        *(v4u*)o = q0; *(v4u*)(o + 8) = q1;
        __syncthreads();
    }
}

__device__ __forceinline__ void phase_rmsnorm(const Ctx& c, const float* src, const float* g, bf16* U, float* copy_to) {
    const int gw = c.bid * 8 + c.wave, NGW = c.G * 8;
    f32x4 gv[4];
#pragma unroll
    for (int j = 0; j < 4; ++j) gv[j] = *((const f32x4*)g + c.lane + 64 * j);
    f32x4 nv[4];
    if (gw < M) { const f32x4* xr0 = (const f32x4*)(src + (size_t)gw * D) + c.lane;
#pragma unroll
        for (int j = 0; j < 4; ++j) nv[j] = xr0[64 * j]; }
    for (int m = gw; m < M; m += NGW) {
        f32x4 v[4]; float s = 0.f;
#pragma unroll
        for (int j = 0; j < 4; ++j) { v[j] = nv[j]; s += (v[j].x * v[j].x + v[j].y * v[j].y) + (v[j].z * v[j].z + v[j].w * v[j].w); }
        if (m + NGW < M) { const f32x4* xn = (const f32x4*)(src + (size_t)(m + NGW) * D) + c.lane;
#pragma unroll
            for (int j = 0; j < 4; ++j) nv[j] = xn[64 * j]; }
        if (copy_to) { f32x4* cr = (f32x4*)(copy_to + (size_t)m * D) + c.lane;
#pragma unroll
            for (int j = 0; j < 4; ++j) cr[64 * j] = v[j]; }
        const float r = rsqrtf(sum64(s) * (1.f / D) + 1e-6f);
        v2u* o = (v2u*)(U + (size_t)m * D) + c.lane;
#pragma unroll
        for (int j = 0; j < 4; ++j) { v2u w; w.x = pk2(v[j].x * r * gv[j].x, v[j].y * r * gv[j].y); w.y = pk2(v[j].z * r * gv[j].z, v[j].w * r * gv[j].w); o[64 * j] = w; }
    }
}
__device__ __forceinline__ void phase_rmsnorm_q8(const Ctx& c, const float* src, const float* g, bf16* U, unsigned char* U8, float* XS) {
    const int gw = c.bid * 8 + c.wave, NGW = c.G * 8;
    f32x4 gv[4];
#pragma unroll
    for (int j = 0; j < 4; ++j) gv[j] = *((const f32x4*)g + c.lane + 64 * j);
    f32x4 nv[4];
    if (gw < M) { const f32x4* xr0 = (const f32x4*)(src + (size_t)gw * D) + c.lane;
#pragma unroll
        for (int j = 0; j < 4; ++j) nv[j] = xr0[64 * j]; }
    for (int m = gw; m < M; m += NGW) {
        f32x4 v[4]; float s = 0.f;
#pragma unroll
        for (int j = 0; j < 4; ++j) { v[j] = nv[j]; s += (v[j].x * v[j].x + v[j].y * v[j].y) + (v[j].z * v[j].z + v[j].w * v[j].w); }
        if (m + NGW < M) { const f32x4* xn = (const f32x4*)(src + (size_t)(m + NGW) * D) + c.lane;
#pragma unroll
            for (int j = 0; j < 4; ++j) nv[j] = xn[64 * j]; }
        const float r = rsqrtf(sum64(s) * (1.f / D) + 1e-6f);
        float am = 0.f;
#pragma unroll
        for (int j = 0; j < 4; ++j) { v[j] = v[j] * r * gv[j]; am = fmaxf(am, fmaxf(fmaxf(fabsf(v[j].x), fabsf(v[j].y)), fmaxf(fabsf(v[j].z), fabsf(v[j].w)))); }
#pragma unroll
        for (int o = 1; o < 64; o <<= 1) am = fmaxf(am, __shfl_xor(am, o));
        am = fmaxf(am, 1e-30f);
        const float qs = 384.f / am;
        v2u* o = (v2u*)(U + (size_t)m * D) + c.lane;
        unsigned* o8 = (unsigned*)(U8 + (size_t)m * D) + c.lane;
#pragma unroll
        for (int j = 0; j < 4; ++j) { if (U) { v2u w; w.x = pk2(v[j].x, v[j].y); w.y = pk2(v[j].z, v[j].w); o[64 * j] = w; }
            int w8 = __builtin_amdgcn_cvt_pk_fp8_f32(v[j].x * qs, v[j].y * qs, 0, false); w8 = __builtin_amdgcn_cvt_pk_fp8_f32(v[j].z * qs, v[j].w * qs, w8, true); o8[64 * j] = (unsigned)w8; }
        if (c.lane == 0) XS[m] = am * (1.f / 384.f);
    }
}
__device__ __forceinline__ void phase_final(const Ctx& c, float* out, const float* g) {
    const int gw = c.bid * 8 + c.wave, NGW = c.G * 8;
    f32x4 gv[4];
#pragma unroll
    for (int j = 0; j < 4; ++j) gv[j] = *((const f32x4*)g + c.lane + 64 * j);
    for (int m = gw; m < M; m += NGW) {
        f32x4* xr = (f32x4*)(out + (size_t)m * D) + c.lane;
        f32x4 v[4]; float s = 0.f;
#pragma unroll
        for (int j = 0; j < 4; ++j) { v[j] = xr[64 * j]; s += (v[j].x * v[j].x + v[j].y * v[j].y) + (v[j].z * v[j].z + v[j].w * v[j].w); }
        const float r = rsqrtf(sum64(s) * (1.f / D) + 1e-6f);
#pragma unroll
        for (int j = 0; j < 4; ++j) xr[64 * j] = v[j] * r * gv[j];
    }
}

__device__ __forceinline__ void phase_rwkv_prep(const Ctx& c, KArgs& a, int l, int hb) {
    unsigned char* ws = a.ws;
    const bf16* PR = (const bf16*)(ws + WS_OV + OV_PR);
    bf16* AL = (bf16*)(ws + WS_OV + OV_AL);
    bf16* VS = l == 0 ? (bf16*)(ws + WS_VF) + (size_t)hb * MH * D : (bf16*)(ws + WS_OV + OV_VMIX);
    const float* mu = a.in[I_MU] + (size_t)l * RW_PROJ;
    LAS bf16* v1L = (LAS bf16*)c.lds;
    if (l == 1) {
        const float* v1 = a.in[I_V1];
        for (int e = c.tid; e < 1024 * 32; e += 512) { const int cc = e >> 5, j = e & 31; v1L[((cc & 15) * 64 + (cc >> 4)) * 40 + j] = (bf16)f2bf(v1[e]); }
        __syncthreads();
    }
    const int gw = c.bid * 8 + c.wave, NGW = c.G * 8, lane = c.lane;
    float muv[16], mul[8];
#pragma unroll
    for (int e = 0; e < 16; ++e) muv[e] = mu[2048 + 16 * lane + e];
#pragma unroll
    for (int e = 0; e < 8; ++e) mul[e] = lane < 36 ? mu[3072 + 8 * lane + e] : 0.f;
    const int per = (MH + NGW - 1) / NGW;
    const int mA = gw * per, mB = (mA + per < MH) ? mA + per : MH;
    v4u cq0, cq1, cql, pq0, pq1, pql;
    const v4u zz4 = (v4u){0u, 0u, 0u, 0u};
    const int lcol = lane < 36 ? 3072 + 8 * lane : 3072;
    if (mA < mB) {
        const bf16* row = PR + (size_t)mA * N1P;
        cq0 = *(const v4u*)(row + 2048 + 16 * lane); cq1 = *(const v4u*)(row + 2048 + 16 * lane + 8); cql = *(const v4u*)(row + lcol);
        if ((mA & (T - 1)) != 0) { pq0 = *(const v4u*)(row - N1P + 2048 + 16 * lane); pq1 = *(const v4u*)(row - N1P + 2048 + 16 * lane + 8); pql = *(const v4u*)(row - N1P + lcol); }
        else { pq0 = zz4; pq1 = zz4; pql = zz4; }
    }
    for (int m = mA; m < mB; ++m) {
        const v4u q0 = cq0, q1 = cq1, ql = cql;
        v4u r0 = pq0, r1 = pq1, rl = pql;
        if ((m & (T - 1)) == 0) { r0 = zz4; r1 = zz4; rl = zz4; }
        if (m + 1 < mB) { const bf16* nrow = PR + (size_t)(m + 1) * N1P; cq0 = *(const v4u*)(nrow + 2048 + 16 * lane); cq1 = *(const v4u*)(nrow + 2048 + 16 * lane + 8); cql = *(const v4u*)(nrow + lcol); }
        pq0 = q0; pq1 = q1; pql = ql;
        float vs[16];
        {
            float p[16], pp[16];
            float t8[8];
            unpack8(q0, t8);
#pragma unroll
            for (int e = 0; e < 8; ++e) p[e] = t8[e];
            unpack8(q1, t8);
#pragma unroll
            for (int e = 0; e < 8; ++e) p[8 + e] = t8[e];
            unpack8(r0, t8);
#pragma unroll
            for (int e = 0; e < 8; ++e) pp[e] = t8[e];
            unpack8(r1, t8);
#pragma unroll
            for (int e = 0; e < 8; ++e) pp[8 + e] = t8[e];
#pragma unroll
            for (int e = 0; e < 16; ++e) vs[e] = p[e] + (pp[e] - p[e]) * muv[e];
            v4u o0, o1;
            o0.x = pk2(vs[0], vs[1]); o0.y = pk2(vs[2], vs[3]); o0.z = pk2(vs[4], vs[5]); o0.w = pk2(vs[6], vs[7]);
            o1.x = pk2(vs[8], vs[9]); o1.y = pk2(vs[10], vs[11]); o1.z = pk2(vs[12], vs[13]); o1.w = pk2(vs[14], vs[15]);
            *(v4u*)(VS + (size_t)m * D + 16 * lane) = o0; *(v4u*)(VS + (size_t)m * D + 16 * lane + 8) = o1;
        }
        if (lane < 36) {
            float p[8], pp[8], s[8];
            unpack8(ql, p);
            unpack8(rl, pp);
#pragma unroll
            for (int e = 0; e < 8; ++e) { const float x = p[e] + (pp[e] - p[e]) * mul[e]; s[e] = lane < 8 ? tanhf(x) : (lane < 16 ? x : sigmoidf_(x)); }
            *(v4u*)(AL + (size_t)m * KL + 8 * lane) = pack8(s);
        } else if (lane < 48 && !(l == 1 && lane < 40)) {
            *(v4u*)(AL + (size_t)m * KL + 8 * lane) = (v4u){0u, 0u, 0u, 0u};
        }
        if (l == 1) {
            float acc[32];
#pragma unroll
            for (int j = 0; j < 32; ++j) acc[j] = 0.f;
#pragma unroll
            for (int i = 0; i < 16; ++i) {
                const LAS v4u* wp = (const LAS v4u*)(v1L + (i * 64 + lane) * 40);
#pragma unroll
                for (int q = 0; q < 4; ++q) { float w8[8]; const v4u wq_ = wp[q]; unpack8(wq_, w8);
#pragma unroll
                    for (int e = 0; e < 8; ++e) acc[q * 8 + e] += vs[i] * w8[e]; }
            }
#pragma unroll
            for (int s = 32, half = 16; s >= 2; s >>= 1, half >>= 1) {
                const bool up = (lane & s) != 0;
#pragma unroll
                for (int i = 0; i < 16; ++i) if (i < half) { const float send = up ? acc[i] : acc[i + half]; const float keep = up ? acc[i + half] : acc[i]; acc[i] = keep + __shfl_xor(send, s); }
            }
            acc[0] += __shfl_xor(acc[0], 1);
            const int j = ((lane & 32) ? 16 : 0) + ((lane & 16) ? 8 : 0) + ((lane & 8) ? 4 : 0) + ((lane & 4) ? 2 : 0) + ((lane & 2) ? 1 : 0);
            if ((lane & 1) == 0) AL[(size_t)m * KL + 288 + j] = (bf16)f2bf(acc[0]);
        }
    }
    { float* DT = (float*)(ws + WS_OV + OV_DT); float* DA = (float*)(ws + WS_OV + OV_DA);
      for (int it = gw; it < (MH / 64) * 32; it += NGW) {
        const int ck = it >> 5, h = it & 31;
        const size_t m = (size_t)ck * 64 + lane;
        const float x = bf1(PR[m * N1P + DT_COL + h]) + a.in[I_DTB][l * 32 + h];
        const float dt = x > 20.f ? x : log1pf(__expf(x));
        float cs = -dt * __expf(a.in[I_ALOG][l * 32 + h]);
#pragma unroll
        for (int o = 1; o < 64; o <<= 1) { const float y = __shfl_up(cs, o); cs += (lane >= o) ? y : 0.f; }
        DT[m * 32 + h] = dt; DA[m * 32 + h] = cs;
      } }
}

__device__ __forceinline__ float sum8(float x) { x += dpp_mov<0xB1>(x); x += dpp_mov<0x4E>(x); x += dpp_mov<0x141>(x); return x; }
__device__ __forceinline__ void phase_rwkv_rec(const Ctx& c, KArgs& a, int l, int hb) {
    unsigned char* ws = a.ws;
    const bf16* PR = (const bf16*)(ws + WS_OV + OV_PR);
    const bf16* ELOG = (const bf16*)(ws + WS_OV + OV_ELOG);
    const bf16* ASIG = (const bf16*)(ws + WS_OV + OV_ASIG);
    const bf16* VS = l == 0 ? (const bf16*)(ws + WS_VF) + (size_t)hb * MH * D : (const bf16*)(ws + WS_OV + OV_VMIX);
    bf16* Y = (bf16*)(ws + WS_OV + OV_YA);
    const float* mu = a.in[I_MU] + (size_t)l * RW_PROJ;
    const float* k_k = a.in[I_KK] + (size_t)l * D; const float* k_a = a.in[I_KA] + (size_t)l * D;
    constexpr int CH = 32, NCH = T / CH;
    constexpr int ARRF = CH * 64;
    constexpr int BUFF = 5 * ARRF + CH * 16 + CH * 2;
    LAS float* ldsf = (LAS float*)c.lds;
    LAS float* yt = ldsf + 2 * BUFF;
    const int tid = c.tid, lane = c.lane;
    const bool is_prep = c.wave >= 4;
    const int ptid = tid - 256, tt = ptid >> 3, l8 = ptid & 7, pc = l8 * 8;
    const int rrow = c.wave * 4 + (lane >> 4), cc4 = (lane & 15) * 4;
    for (int unit = c.bid; unit < 256; unit += c.G) {
        const int b = unit >> 6, h = (unit >> 2) & 15, rq = unit & 3;
        const size_t m0 = (size_t)b * T;
        const int hc = h * 64 + pc;
        float mur[8], muk[8], kkc[8], kac[8];
        if (is_prep) {
#pragma unroll
            for (int e = 0; e < 8; ++e) { mur[e] = mu[hc + e]; muk[e] = mu[1024 + hc + e]; kkc[e] = k_k[hc + e]; kac[e] = k_a[hc + e]; }
        }
        float S[4] = {0.f, 0.f, 0.f, 0.f}, sa = 0.f;
#define RW_PREP(chunk, bufp) do { \
            const int t_ = (chunk) * CH + tt; const size_t mm = m0 + t_; const bf16* row = PR + mm * N1P + hc; \
            const v4u zr = (v4u){0u, 0u, 0u, 0u}; \
            const v4u qr = *(const v4u*)row, qk = *(const v4u*)(row + 1024); \
            const v4u qrp = t_ > 0 ? *(const v4u*)(row - N1P) : zr, qkp = t_ > 0 ? *(const v4u*)(row - N1P + 1024) : zr; \
            const v4u qkn = t_ + 1 < T ? *(const v4u*)(row + N1P + 1024) : zr; \
            const v4u qas = *(const v4u*)(ASIG + mm * D + hc), qel = *(const v4u*)(ELOG + mm * D + hc); \
            v4u qv = zr; if (l8 < 2) qv = *(const v4u*)(VS + mm * D + h * 64 + rq * 16 + l8 * 8); \
            float r_[8], rp_[8], k_[8], kp_[8], kn_[8], as_[8], el_[8]; \
            unpack8(qr, r_); unpack8(qrp, rp_); unpack8(qk, k_); unpack8(qkp, kp_); unpack8(qkn, kn_); unpack8(qas, as_); unpack8(qel, el_); \
            float ks_[8], kk_[8], kkn_[8], s1 = 0.f, s2 = 0.f; \
            _Pragma("unroll") for (int e = 0; e < 8; ++e) { ks_[e] = k_[e] + (kp_[e] - k_[e]) * muk[e]; const float kn1 = kn_[e] + (k_[e] - kn_[e]) * muk[e]; \
                kk_[e] = ks_[e] * kkc[e]; kkn_[e] = kn1 * kkc[e]; s1 += kk_[e] * kk_[e]; s2 += kkn_[e] * kkn_[e]; } \
            s1 = sum8(s1); s2 = sum8(s2); \
            const float i1 = rsqrtf(s1 + 1e-12f), i2 = (t_ + 1 < T) ? rsqrtf(s2 + 1e-12f) : 0.f; \
            float ow[8], ok[8], ob[8], orr[8], owa[8], c1 = 0.f, c2 = 0.f; \
            _Pragma("unroll") for (int e = 0; e < 8; ++e) { const float kn = kk_[e] * i1, an = -kkn_[e] * i2; \
                ow[e] = __expf(el_[e]); ok[e] = ks_[e] * (1.f + (as_[e] - 1.f) * kac[e]); ob[e] = kn * as_[e]; orr[e] = r_[e] + (rp_[e] - r_[e]) * mur[e]; \
                owa[e] = ow[e] * an; c1 += ob[e] * an; c2 += ok[e] * an; } \
            c1 = sum8(c1); c2 = sum8(c2); \
            LAS float* bp_ = (bufp) + tt * 64 + pc; \
            *(LAS f32x4*)(bp_) = (f32x4){ow[0], ow[1], ow[2], ow[3]}; *(LAS f32x4*)(bp_ + 4) = (f32x4){ow[4], ow[5], ow[6], ow[7]}; \
            *(LAS f32x4*)(bp_ + ARRF) = (f32x4){ok[0], ok[1], ok[2], ok[3]}; *(LAS f32x4*)(bp_ + ARRF + 4) = (f32x4){ok[4], ok[5], ok[6], ok[7]}; \
            *(LAS f32x4*)(bp_ + 2 * ARRF) = (f32x4){ob[0], ob[1], ob[2], ob[3]}; *(LAS f32x4*)(bp_ + 2 * ARRF + 4) = (f32x4){ob[4], ob[5], ob[6], ob[7]}; \
            *(LAS f32x4*)(bp_ + 3 * ARRF) = (f32x4){orr[0], orr[1], orr[2], orr[3]}; *(LAS f32x4*)(bp_ + 3 * ARRF + 4) = (f32x4){orr[4], orr[5], orr[6], orr[7]}; \
            *(LAS f32x4*)(bp_ + 4 * ARRF) = (f32x4){owa[0], owa[1], owa[2], owa[3]}; *(LAS f32x4*)(bp_ + 4 * ARRF + 4) = (f32x4){owa[4], owa[5], owa[6], owa[7]}; \
            if (l8 < 2) { float v_[8]; unpack8(qv, v_); LAS float* vp_ = (bufp) + 5 * ARRF + tt * 16 + l8 * 8; \
                *(LAS f32x4*)vp_ = (f32x4){v_[0], v_[1], v_[2], v_[3]}; *(LAS f32x4*)(vp_ + 4) = (f32x4){v_[4], v_[5], v_[6], v_[7]}; } \
            if (l8 == 0) { (bufp)[5 * ARRF + CH * 16 + tt * 2] = c1; (bufp)[5 * ARRF + CH * 16 + tt * 2 + 1] = c2; } } while (0)
#define RW_YSTORE(chunk) do { const LAS float* yp_ = yt + ((chunk) & 1) * CH * 16 + tt * 16 + l8 * 2; \
            *(unsigned*)(Y + (m0 + (size_t)(chunk) * CH + tt) * D + h * 64 + rq * 16 + l8 * 2) = pk2(yp_[0], yp_[1]); } while (0)
        if (is_prep) RW_PREP(0, ldsf);
        __syncthreads();
        for (int ch = 0; ch < NCH; ++ch) {
            if (is_prep) {
                if (ch + 1 < NCH) RW_PREP(ch + 1, ldsf + ((ch + 1) & 1) * BUFF);
                if (ch > 0) RW_YSTORE(ch - 1);
            } else {
                const LAS float* buf = ldsf + (ch & 1) * BUFF;
                LAS float* yw = yt + (ch & 1) * CH * 16;
                const int lane15 = lane & 15;
                f32x4 w4 = *(const LAS f32x4*)(buf + cc4), k4 = *(const LAS f32x4*)(buf + ARRF + cc4), b4 = *(const LAS f32x4*)(buf + 2 * ARRF + cc4);
                f32x4 r4 = *(const LAS f32x4*)(buf + 3 * ARRF + cc4), wa4 = *(const LAS f32x4*)(buf + 4 * ARRF + cc4);
                float v = buf[5 * ARRF + rrow]; f32x2 cc = *(const LAS f32x2*)(buf + 5 * ARRF + CH * 16);
#pragma unroll 1
                for (int t16 = 0; t16 < CH; t16 += 16) {
                    float ysave = 0.f;
#pragma unroll
                    for (int u = 0; u < 16; ++u) {
                        const int tn = (t16 + u + 1 < CH) ? t16 + u + 1 : t16 + u;
                        const f32x4 nw4 = *(const LAS f32x4*)(buf + tn * 64 + cc4), nk4 = *(const LAS f32x4*)(buf + ARRF + tn * 64 + cc4), nb4 = *(const LAS f32x4*)(buf + 2 * ARRF + tn * 64 + cc4);
                        const f32x4 nr4 = *(const LAS f32x4*)(buf + 3 * ARRF + tn * 64 + cc4), nwa4 = *(const LAS f32x4*)(buf + 4 * ARRF + tn * 64 + cc4);
                        const float nv = buf[5 * ARRF + tn * 16 + rrow]; const f32x2 ncc = *(const LAS f32x2*)(buf + 5 * ARRF + CH * 16 + tn * 2);
                        float d = S[0] * wa4[0]; d = __builtin_fmaf(S[1], wa4[1], d); d = __builtin_fmaf(S[2], wa4[2], d); d = __builtin_fmaf(S[3], wa4[3], d);
#pragma unroll
                        for (int e = 0; e < 4; ++e) { float tmp = S[e] * w4[e]; asm volatile("" : "+v"(tmp)); tmp = __builtin_fmaf(v, k4[e], tmp); S[e] = __builtin_fmaf(sa, b4[e], tmp); asm volatile("" : "+v"(S[e])); }
                        const float sa_next = __builtin_fmaf(v, cc.y, sa * cc.x);
                        float y = S[0] * r4[0]; y = __builtin_fmaf(S[1], r4[1], y); y = __builtin_fmaf(S[2], r4[2], y); y = __builtin_fmaf(S[3], r4[3], y);
                        d = sum16(d); y = sum16(y);
                        sa = d + sa_next;
                        ysave = (lane15 == u) ? y : ysave;
                        w4 = nw4; k4 = nk4; b4 = nb4; r4 = nr4; wa4 = nwa4; v = nv; cc = ncc;
                    }
                    yw[(t16 + lane15) * 16 + rrow] = ysave;
                }
            }
            __syncthreads();
        }
        if (is_prep) RW_YSTORE(NCH - 1);
        __syncthreads();
#undef RW_PREP
#undef RW_YSTORE
    }
}

constexpr int CK_TS = 72, CK_TB = 64 * CK_TS;
__device__ __forceinline__ void tr_a2(unsigned a, bf16x8& f0, bf16x8& f1) {
    s16x4 l0, h0, l1, h1;
    asm volatile("ds_read_b64_tr_b16 %0, %4\n\tds_read_b64_tr_b16 %1, %4 offset:576\n\tds_read_b64_tr_b16 %2, %4 offset:4608\n\tds_read_b64_tr_b16 %3, %4 offset:5184\n\ts_waitcnt lgkmcnt(0)"
                 : "=&v"(l0), "=&v"(h0), "=&v"(l1), "=&v"(h1) : "v"(a) : "memory");
    f0 = __builtin_shufflevector(l0, h0, 0, 1, 2, 3, 4, 5, 6, 7); f1 = __builtin_shufflevector(l1, h1, 0, 1, 2, 3, 4, 5, 6, 7);
}
__device__ __forceinline__ void tr_b4(unsigned a, bf16x8& f00, bf16x8& f01, bf16x8& f10, bf16x8& f11) {
    s16x4 l0, h0, l1, h1, l2, h2, l3, h3;
    asm volatile("ds_read_b64_tr_b16 %0, %8\n\tds_read_b64_tr_b16 %1, %8 offset:576\n\tds_read_b64_tr_b16 %2, %8 offset:4608\n\tds_read_b64_tr_b16 %3, %8 offset:5184\n\t"
                 "ds_read_b64_tr_b16 %4, %8 offset:32\n\tds_read_b64_tr_b16 %5, %8 offset:608\n\tds_read_b64_tr_b16 %6, %8 offset:4640\n\tds_read_b64_tr_b16 %7, %8 offset:5216\n\ts_waitcnt lgkmcnt(0)"
                 : "=&v"(l0), "=&v"(h0), "=&v"(l1), "=&v"(h1), "=&v"(l2), "=&v"(h2), "=&v"(l3), "=&v"(h3) : "v"(a) : "memory");
    f00 = __builtin_shufflevector(l0, h0, 0, 1, 2, 3, 4, 5, 6, 7); f01 = __builtin_shufflevector(l1, h1, 0, 1, 2, 3, 4, 5, 6, 7);
    f10 = __builtin_shufflevector(l2, h2, 0, 1, 2, 3, 4, 5, 6, 7); f11 = __builtin_shufflevector(l3, h3, 0, 1, 2, 3, 4, 5, 6, 7);
}
template <int PA, int QA, int MASK, int NINIT, int NPAIR, int POST>
__device__ __forceinline__ void mm64(LAS bf16* X, const LAS bf16* P, const LAS bf16* Q, const LAS bf16* P2, const LAS bf16* Q2, const LAS bf16* E1, const LAS bf16* E2,
                                     const LAS float* cscale, const LAS float* wc, int w, int lane) {
    const int r = lane & 15, q = lane >> 4, Ct = w >> 1, Rt0 = 2 * (w & 1);
    const int i16 = lane & 15, qq = i16 >> 2, p4 = i16 & 3;
    const int troff = ((8 * q + qq) * CK_TS + 4 * p4) * 2;
    f32x4 acc[2];
#pragma unroll
    for (int i = 0; i < 2; ++i) {
        const int R = 16 * (Rt0 + i) + r;
        if (NINIT == 0) acc[i] = (f32x4){0.f, 0.f, 0.f, 0.f};
        else { const v2u e1 = *(const LAS v2u*)(E1 + R * CK_TS + 16 * Ct + 4 * q); acc[i] = (f32x4){bflo(e1.x), bfhi(e1.x), bflo(e1.y), bfhi(e1.y)};
            if (NINIT == 2) { const v2u e2 = *(const LAS v2u*)(E2 + R * CK_TS + 16 * Ct + 4 * q); acc[i] += (f32x4){bflo(e2.x), bfhi(e2.x), bflo(e2.y), bfhi(e2.y)}; } }
    }
#pragma unroll
    for (int pr = 0; pr < NPAIR; ++pr) {
        const LAS bf16* Pp = pr == 0 ? P : P2; const LAS bf16* Qp = pr == 0 ? Q : Q2;
        bf16x8 af[2], bfr[2][2];
        if (PA == 0) {
#pragma unroll
            for (int i = 0; i < 2; ++i)
#pragma unroll
                for (int ks = 0; ks < 2; ++ks) bfr[i][ks] = *(const LAS bf16x8*)(Pp + (16 * (Rt0 + i) + r) * CK_TS + 32 * ks + 8 * q);
        }
        if (QA == 1) {
#pragma unroll
            for (int ks = 0; ks < 2; ++ks) af[ks] = *(const LAS bf16x8*)(Qp + (16 * Ct + r) * CK_TS + 32 * ks + 8 * q);
        } else tr_a2((unsigned)(size_t)Qp + (unsigned)(troff + 32 * Ct), af[0], af[1]);
        if (PA == 1) tr_b4((unsigned)(size_t)Pp + (unsigned)(troff + 32 * Rt0), bfr[0][0], bfr[0][1], bfr[1][0], bfr[1][1]);
#pragma unroll
        for (int ks = 0; ks < 2; ++ks)
#pragma unroll
            for (int i = 0; i < 2; ++i) acc[i] = __builtin_amdgcn_mfma_f32_16x16x32_bf16(af[ks], bfr[i][ks], acc[i], 0, 0, 0);
    }
#pragma unroll
    for (int i = 0; i < 2; ++i) {
        const int R = 16 * (Rt0 + i) + r;
        float v[4];
#pragma unroll
        for (int e = 0; e < 4; ++e) { const int C = 16 * Ct + 4 * q + e; float x = acc[i][e];
            if (MASK == 1) x = (C < R) ? x : 0.f;
            if (MASK == 2) x = (C <= R) ? x : 0.f;
            if (POST >= 1) x *= cscale[C];
            if (POST == 2) x += (C == R) ? wc[C] : 0.f;
            v[e] = x; }
        v2u o; o.x = pk2c(v[0], v[1]); o.y = pk2c(v[2], v[3]);
        *(LAS v2u*)(X + R * CK_TS + 16 * Ct + 4 * q) = o;
    }
}

template <int PA, int QA, int MASK, int NINIT, int NPAIR, int POST>
__device__ __forceinline__ void mm64h(LAS bf16* X, const LAS bf16* P, const LAS bf16* Q, const LAS bf16* P2, const LAS bf16* Q2, const LAS bf16* E1, const LAS bf16* E2,
                                      const LAS float* cscale, const LAS float* wc, int ws, int lane) {
    const int r = lane & 15, q = lane >> 4, Cb = ws >> 1, Rb = ws & 1;
    const int i16 = lane & 15, qq = i16 >> 2, p4 = i16 & 3;
    const int troff = ((8 * q + qq) * CK_TS + 4 * p4) * 2;
    f32x4 acc[2][2];
#pragma unroll
    for (int ci = 0; ci < 2; ++ci)
#pragma unroll
        for (int ri = 0; ri < 2; ++ri) {
            const int R = 16 * (2 * Rb + ri) + r, C0 = 16 * (2 * Cb + ci) + 4 * q;
            if (NINIT == 0) acc[ci][ri] = (f32x4){0.f, 0.f, 0.f, 0.f};
            else { const v2u e1 = *(const LAS v2u*)(E1 + R * CK_TS + C0); acc[ci][ri] = (f32x4){bflo(e1.x), bfhi(e1.x), bflo(e1.y), bfhi(e1.y)};
                if (NINIT == 2) { const v2u e2 = *(const LAS v2u*)(E2 + R * CK_TS + C0); acc[ci][ri] += (f32x4){bflo(e2.x), bfhi(e2.x), bflo(e2.y), bfhi(e2.y)}; } }
        }
#pragma unroll
    for (int pr = 0; pr < NPAIR; ++pr) {
        const LAS bf16* Pp = pr == 0 ? P : P2; const LAS bf16* Qp = pr == 0 ? Q : Q2;
        bf16x8 af[2][2], bfr[2][2];
        if (PA == 0) {
#pragma unroll
            for (int ri = 0; ri < 2; ++ri)
#pragma unroll
                for (int ks = 0; ks < 2; ++ks) bfr[ri][ks] = *(const LAS bf16x8*)(Pp + (16 * (2 * Rb + ri) + r) * CK_TS + 32 * ks + 8 * q);
        }
        if (QA == 1) {
#pragma unroll
            for (int ci = 0; ci < 2; ++ci)
#pragma unroll
                for (int ks = 0; ks < 2; ++ks) af[ci][ks] = *(const LAS bf16x8*)(Qp + (16 * (2 * Cb + ci) + r) * CK_TS + 32 * ks + 8 * q);
        } else tr_b4((unsigned)(size_t)Qp + (unsigned)(troff + 64 * Cb), af[0][0], af[0][1], af[1][0], af[1][1]);
        if (PA == 1) tr_b4((unsigned)(size_t)Pp + (unsigned)(troff + 64 * Rb), bfr[0][0], bfr[0][1], bfr[1][0], bfr[1][1]);
#pragma unroll
        for (int ks = 0; ks < 2; ++ks)
#pragma unroll
            for (int ci = 0; ci < 2; ++ci)
#pragma unroll
                for (int ri = 0; ri < 2; ++ri) acc[ci][ri] = __builtin_amdgcn_mfma_f32_16x16x32_bf16(af[ci][ks], bfr[ri][ks], acc[ci][ri], 0, 0, 0);
    }
#pragma unroll
    for (int ci = 0; ci < 2; ++ci)
#pragma unroll
        for (int ri = 0; ri < 2; ++ri) {
            const int R = 16 * (2 * Rb + ri) + r;
            float v[4];
#pragma unroll
            for (int e = 0; e < 4; ++e) { const int C = 16 * (2 * Cb + ci) + 4 * q + e; float x = acc[ci][ri][e];
                if (MASK == 1) x = (C < R) ? x : 0.f;
                if (MASK == 2) x = (C <= R) ? x : 0.f;
                if (POST >= 1) x *= cscale[C];
                if (POST == 2) x += (C == R) ? wc[C] : 0.f;
                v[e] = x; }
            v2u o; o.x = pk2c(v[0], v[1]); o.y = pk2c(v[2], v[3]);
            *(LAS v2u*)(X + R * CK_TS + 16 * (2 * Cb + ci) + 4 * q) = o;
        }
}

__device__ __forceinline__ void phase_rwkv_chunk_par(const Ctx& c, KArgs& a, int l, int hb) {
    unsigned char* ws = a.ws;
    bf16* PR = (bf16*)(ws + WS_OV + OV_PR);
    bf16* ELOG = (bf16*)(ws + WS_OV + OV_ELOG);
    const bf16* ASIG = (const bf16*)(ws + WS_OV + OV_ASIG);
    const bf16* VS = l == 0 ? (const bf16*)(ws + WS_VF) + (size_t)hb * MH * D : (const bf16*)(ws + WS_OV + OV_VMIX);
    bf16* Y = (bf16*)(ws + WS_OV + OV_YA);
    bf16* SLB = (bf16*)(ws + WS_OV + OV_AL);
    const float* mu = a.in[I_MU] + (size_t)l * RW_PROJ;
    const float* k_k = a.in[I_KK] + (size_t)l * D; const float* k_a = a.in[I_KA] + (size_t)l * D; const float* rk_ = a.in[I_RK] + (size_t)l * D;
    float* BON = (float*)(ws + WS_OV + OV_BON);
    LAS bf16* tile = (LAS bf16*)c.lds;
    enum { tA = 0, tR, tBt, tKt, tBh, tKh, tV, tNab, tNak, tNrb, tNrk, tM0, tM1, tP1, tX1, NT };
#define TL(i) (tile + (i) * CK_TB)
    LAS float* cscale = (LAS float*)(tile + NT * CK_TB);
    LAS float* wcv = cscale + 64;
    LAS float* SCR = (LAS float*)TL(tM0);
    LAS float* SEGT = SCR + 64 * 64;
    const int tid = c.tid, lane = c.lane, w = c.wave;
    const int tt = tid >> 3, l8 = tid & 7, pc = l8 * 8;
    v4u qr, qk, qrp, qkp, qas, qel, qv;
#define CK_LOAD(un) do { const int b_ = (un) >> 10, h_ = ((un) >> 6) & 15, ch_ = (un) & 63; const int t_ = ch_ * 64 + tt; \
        const size_t mm = (size_t)b_ * T + (size_t)t_; const bf16* row = PR + mm * N1P + h_ * 64 + pc; const v4u zr = (v4u){0u, 0u, 0u, 0u}; \
        qr = *(const v4u*)row; qk = *(const v4u*)(row + 1024); qrp = t_ > 0 ? *(const v4u*)(row - N1P) : zr; qkp = t_ > 0 ? *(const v4u*)(row - N1P + 1024) : zr; \
        qas = *(const v4u*)(ASIG + mm * D + h_ * 64 + pc); qel = *(const v4u*)(ELOG + mm * D + h_ * 64 + pc); qv = *(const v4u*)(VS + mm * D + h_ * 64 + pc); } while (0)
    if (c.bid < 4096) CK_LOAD(c.bid);
    for (int unit = c.bid; unit < 4096; unit += c.G) {
        const int b = unit >> 10, h = (unit >> 6) & 15, ch = unit & 63;
        const size_t m0 = (size_t)b * T + (size_t)ch * 64;
        const int hc = h * 64 + pc;
        for (int rep = 0; rep < (PROBE_DUP == 7 ? 2 : 1); ++rep) {
        if (PROBE_DUP == 7) { CK_LOAD(unit); }
        float r_[8], k_[8], as_[8], el_[8], v_[8], kk_[8], ks_[8];
        {
            float rp_[8], kp_[8];
            unpack8(qr, r_); unpack8(qrp, rp_); unpack8(qk, k_); unpack8(qkp, kp_); unpack8(qas, as_); unpack8(qel, el_); unpack8(qv, v_);
            if (PROBE_DUP != 7 && unit + c.G < 4096) CK_LOAD(unit + c.G);
            float s1 = 0.f;
#pragma unroll
            for (int e = 0; e < 8; ++e) { r_[e] = r_[e] + (rp_[e] - r_[e]) * mu[hc + e]; ks_[e] = k_[e] + (kp_[e] - k_[e]) * mu[1024 + hc + e]; kk_[e] = ks_[e] * k_k[hc + e]; s1 += kk_[e] * kk_[e]; }
            s1 = sum8(s1);
            const float i1 = rsqrtf(s1 + 1e-12f);
#pragma unroll
            for (int e = 0; e < 8; ++e) { kk_[e] *= i1; k_[e] = ks_[e] * (1.f + (as_[e] - 1.f) * k_a[hc + e]); }
            { float bn = 0.f;
#pragma unroll
              for (int e = 0; e < 8; ++e) bn += r_[e] * k_[e] * rk_[hc + e];
              bn = sum8(bn);
              if (l8 == 0) BON[(m0 + tt) * 16 + h] = bn; }
            *(LAS f32x4*)(SCR + tt * 64 + pc) = (f32x4){el_[0], el_[1], el_[2], el_[3]}; *(LAS f32x4*)(SCR + tt * 64 + pc + 4) = (f32x4){el_[4], el_[5], el_[6], el_[7]};
        }
        lds_barrier();
        {
            const int col = tid & 63, seg = tid >> 6; float s = 0.f;
#pragma unroll
            for (int i = 0; i < 8; ++i) { s += SCR[(8 * seg + i) * 64 + col]; SCR[(8 * seg + i) * 64 + col] = s; }
            SEGT[seg * 64 + col] = s;
        }
        lds_barrier();
        {
            const int col = tid & 63, seg = tid >> 6; float pre = 0.f;
#pragma unroll
            for (int s2 = 0; s2 < 7; ++s2) pre += (s2 < seg) ? SEGT[s2 * 64 + col] : 0.f;
#pragma unroll
            for (int i = 0; i < 8; ++i) SCR[(8 * seg + i) * 64 + col] += pre;
        }
        lds_barrier();
        {
            float L[8], Lr[8], Le[8];
            { const f32x4 x0 = *(const LAS f32x4*)(SCR + tt * 64 + pc), x1 = *(const LAS f32x4*)(SCR + tt * 64 + pc + 4);
              const f32x4 y0 = *(const LAS f32x4*)(SCR + 31 * 64 + pc), y1 = *(const LAS f32x4*)(SCR + 31 * 64 + pc + 4);
              const f32x4 z0 = *(const LAS f32x4*)(SCR + 63 * 64 + pc), z1 = *(const LAS f32x4*)(SCR + 63 * 64 + pc + 4);
#pragma unroll
              for (int e = 0; e < 4; ++e) { L[e] = x0[e]; L[4 + e] = x1[e]; Lr[e] = y0[e]; Lr[4 + e] = y1[e]; Le[e] = z0[e]; Le[4 + e] = z1[e]; } }
            float oA[8], oR[8], oBt[8], oKt[8], oBh[8], oKh[8];
#pragma unroll
            for (int e = 0; e < 8; ++e) {
                const float ea = __expf(L[e] - el_[e] - Lr[e]), er = __expf(L[e] - Lr[e]), eb = __expf(Lr[e] - L[e]), eh = __expf(Le[e] - L[e]);
                const float bb = kk_[e] * as_[e];
                oA[e] = -kk_[e] * ea; oR[e] = r_[e] * er; oBt[e] = bb * eb; oKt[e] = k_[e] * eb; oBh[e] = bb * eh; oKh[e] = k_[e] * eh;
            }
            const int o = tt * CK_TS + pc;
            *(LAS v4u*)(TL(tA) + o) = pack8(oA); *(LAS v4u*)(TL(tR) + o) = pack8(oR); *(LAS v4u*)(TL(tBt) + o) = pack8(oBt); *(LAS v4u*)(TL(tKt) + o) = pack8(oKt);
            *(LAS v4u*)(TL(tBh) + o) = pack8(oBh); *(LAS v4u*)(TL(tKh) + o) = pack8(oKh); *(LAS v4u*)(TL(tV) + o) = pack8(v_);
            if (tt == 0) {
#pragma unroll
                for (int e = 0; e < 8; ++e) { cscale[pc + e] = __expf(Lr[e]); wcv[pc + e] = __expf(Le[e]); }
            }
        }
        lds_barrier();
        const LAS bf16* Z = nullptr;
        const int wg_ = w >> 2, ws_ = w & 3;
        if (wg_ == 0) { mm64h<0, 1, 1, 0, 1, 0>(TL(tNab), TL(tA), TL(tBt), Z, Z, Z, Z, cscale, wcv, ws_, lane);
                        mm64h<0, 1, 1, 0, 1, 0>(TL(tNak), TL(tA), TL(tKt), Z, Z, Z, Z, cscale, wcv, ws_, lane); }
        else          { mm64h<0, 1, 2, 0, 1, 0>(TL(tNrb), TL(tR), TL(tBt), Z, Z, Z, Z, cscale, wcv, ws_, lane);
                        mm64h<0, 1, 2, 0, 1, 0>(TL(tNrk), TL(tR), TL(tKt), Z, Z, Z, Z, cscale, wcv, ws_, lane); }
        lds_barrier();
        if (wg_ == 0) mm64h<0, 0, 0, 0, 1, 0>(TL(tM0), TL(tNab), TL(tNab), Z, Z, Z, Z, cscale, wcv, ws_, lane);
        else          mm64h<0, 0, 0, 0, 1, 0>(TL(tX1), TL(tNak), TL(tV), Z, Z, Z, Z, cscale, wcv, ws_, lane);
        lds_barrier();
        if (wg_ == 0) mm64h<0, 0, 0, 2, 1, 0>(TL(tP1), TL(tNab), TL(tM0), Z, Z, TL(tNab), TL(tM0), cscale, wcv, ws_, lane);
        else          mm64h<0, 0, 0, 0, 1, 0>(TL(tM1), TL(tM0), TL(tM0), Z, Z, Z, Z, cscale, wcv, ws_, lane);
        lds_barrier();
        if (wg_ == 0) mm64h<0, 0, 0, 2, 1, 0>(TL(tNab), TL(tP1), TL(tM1), Z, Z, TL(tP1), TL(tM1), cscale, wcv, ws_, lane);
        else          mm64h<0, 0, 0, 0, 1, 0>(TL(tM0), TL(tM1), TL(tM1), Z, Z, Z, Z, cscale, wcv, ws_, lane);
        lds_barrier();
        if (wg_ == 0) mm64h<0, 0, 0, 2, 1, 0>(TL(tP1), TL(tNab), TL(tM0), Z, Z, TL(tNab), TL(tM0), cscale, wcv, ws_, lane);
        else          mm64h<0, 0, 0, 0, 1, 0>(TL(tM1), TL(tM0), TL(tM0), Z, Z, Z, Z, cscale, wcv, ws_, lane);
        lds_barrier();
        if (wg_ == 0) mm64h<0, 0, 0, 2, 1, 0>(TL(tNab), TL(tP1), TL(tM1), Z, Z, TL(tP1), TL(tM1), cscale, wcv, ws_, lane);
        else          mm64h<0, 0, 0, 0, 1, 0>(TL(tM0), TL(tM1), TL(tM1), Z, Z, Z, Z, cscale, wcv, ws_, lane);
        lds_barrier();
        mm64<0, 0, 0, 2, 1, 0>(TL(tP1), TL(tNab), TL(tM0), Z, Z, TL(tNab), TL(tM0), cscale, wcv, w, lane);
        lds_barrier();
        if (wg_ == 0) mm64h<0, 0, 0, 1, 1, 0>(TL(tBt), TL(tP1), TL(tA), Z, Z, TL(tA), Z, cscale, wcv, ws_, lane);
        else          mm64h<0, 0, 0, 1, 1, 0>(TL(tKt), TL(tP1), TL(tX1), Z, Z, TL(tX1), Z, cscale, wcv, ws_, lane);
        lds_barrier();
        if (wg_ == 0) { mm64h<0, 0, 0, 1, 1, 1>(TL(tM0), TL(tNrb), TL(tBt), Z, Z, TL(tR), Z, cscale, wcv, ws_, lane);
                        mm64h<0, 0, 0, 0, 2, 0>(TL(tM1), TL(tNrb), TL(tKt), TL(tNrk), TL(tV), Z, Z, cscale, wcv, ws_, lane); }
        else          { mm64h<1, 0, 0, 0, 1, 2>(TL(tNab), TL(tBh), TL(tBt), Z, Z, Z, Z, cscale, wcv, ws_, lane);
                        mm64h<1, 0, 0, 0, 2, 0>(TL(tX1), TL(tKt), TL(tBh), TL(tV), TL(tKh), Z, Z, cscale, wcv, ws_, lane); }
        lds_barrier();
        }
        {
            const size_t grow = m0 + tt;
            *(v4u*)(ELOG + grow * D + hc) = *(const LAS v4u*)(TL(tM0) + tt * CK_TS + pc);
            *(v4u*)(Y + grow * D + hc) = *(const LAS v4u*)(TL(tM1) + tt * CK_TS + pc);
            *(v4u*)(PR + grow * N1P + 2048 + hc) = *(const LAS v4u*)(TL(tNab) + tt * CK_TS + pc);
            *(v4u*)(SLB + grow * D + hc) = *(const LAS v4u*)(TL(tX1) + tt * CK_TS + pc);
        }
        lds_barrier();
    }
#undef TL
#undef CK_LOAD
}

struct SeqOps { v4u g0, g1, p0, p1; v2u sl, yl; };
__device__ __forceinline__ void phase_rwkv_chunk_seq(const Ctx& c, KArgs& a, const bool commit = true) {
    unsigned char* ws = a.ws;
    const bf16* PR = (const bf16*)(ws + WS_OV + OV_PR);
    const bf16* RP = (const bf16*)(ws + WS_OV + OV_ELOG);
    bf16* Y = (bf16*)(ws + WS_OV + OV_YA);
    const bf16* SLB = (const bf16*)(ws + WS_OV + OV_AL);
    LAS bf16* SL = (LAS bf16*)c.lds;
    const int tid = c.tid, lane = c.lane, w = c.wave, r = lane & 15, q = lane >> 4;
    constexpr int PF = 4;
    for (int unit = c.bid; unit < 256; unit += c.G) {
        const int b = unit >> 6, h = (unit >> 2) & 15, vq = unit & 3;
        for (int e = tid; e < 2 * 16 * CK_TS / 2; e += 512) ((LAS unsigned*)SL)[e] = 0u;
        __syncthreads();
        if (w < 4) {
            const size_t rowG = (size_t)b * T + 16 * w + r;
            const size_t rowS = (size_t)b * T + vq * 16 + r;
            SeqOps ops[PF];
#define SQ_LOAD(dst, chn) do { const size_t o_ = (size_t)(chn) * 64; \
                dst.g0 = *(const v4u*)(PR + (rowG + o_) * N1P + 2048 + h * 64 + 8 * q); dst.g1 = *(const v4u*)(PR + (rowG + o_) * N1P + 2048 + h * 64 + 32 + 8 * q); \
                dst.p0 = *(const v4u*)(RP + (rowG + o_) * D + h * 64 + 8 * q); dst.p1 = *(const v4u*)(RP + (rowG + o_) * D + h * 64 + 32 + 8 * q); \
                dst.sl = *(const v2u*)(SLB + (rowS + o_) * D + h * 64 + 16 * w + 4 * q); dst.yl = *(const v2u*)(Y + (rowG + o_) * D + h * 64 + vq * 16 + 4 * q); } while (0)
#pragma unroll
            for (int i = 0; i < PF; ++i) SQ_LOAD(ops[i], i);
            for (int ch0 = 0; ch0 < 64; ch0 += PF) {
#pragma unroll
                for (int i = 0; i < PF; ++i) {
                    const int ch = ch0 + i;
                    const SeqOps cur = ops[i];
                    if (ch + PF < 64) SQ_LOAD(ops[i], ch + PF);
                    const LAS bf16* Sc = SL + (i & 1) * 16 * CK_TS; LAS bf16* Sn = SL + ((i + 1) & 1) * 16 * CK_TS;
                    const bf16x8 s0 = *(const LAS bf16x8*)(Sc + r * CK_TS + 8 * q), s1 = *(const LAS bf16x8*)(Sc + r * CK_TS + 32 + 8 * q);
                    f32x4 accS = (f32x4){bflo(cur.sl.x), bfhi(cur.sl.x), bflo(cur.sl.y), bfhi(cur.sl.y)};
                    accS = __builtin_amdgcn_mfma_f32_16x16x32_bf16(__builtin_bit_cast(bf16x8, cur.g0), s0, accS, 0, 0, 0);
                    accS = __builtin_amdgcn_mfma_f32_16x16x32_bf16(__builtin_bit_cast(bf16x8, cur.g1), s1, accS, 0, 0, 0);
                    f32x4 accY = (f32x4){bflo(cur.yl.x), bfhi(cur.yl.x), bflo(cur.yl.y), bfhi(cur.yl.y)};
                    accY = __builtin_amdgcn_mfma_f32_16x16x32_bf16(s0, __builtin_bit_cast(bf16x8, cur.p0), accY, 0, 0, 0);
                    accY = __builtin_amdgcn_mfma_f32_16x16x32_bf16(s1, __builtin_bit_cast(bf16x8, cur.p1), accY, 0, 0, 0);
                    { v2u o; o.x = pk2c(accS[0], accS[1]); o.y = pk2c(accS[2], accS[3]); *(LAS v2u*)(Sn + r * CK_TS + 16 * w + 4 * q) = o; }
                    if (commit || accY[0] == 123456.789f) { v2u o; o.x = pk2c(accY[0], accY[1]); o.y = pk2c(accY[2], accY[3]); *(v2u*)(Y + (rowG + (size_t)ch * 64) * D + h * 64 + vq * 16 + 4 * q) = o; }
                    lds_barrier();
                }
            }
#undef SQ_LOAD
        } else {
            for (int ch = 0; ch < 64; ++ch) lds_barrier();
        }
        __syncthreads();
    }
}

__device__ __forceinline__ void phase_rwkv_post(const Ctx& c, KArgs& a, int l, int hb) {
    unsigned char* ws = a.ws;
    const bf16* GG = (const bf16*)(ws + WS_OV + OV_GG);
    const bf16* VS = l == 0 ? (const bf16*)(ws + WS_VF) + (size_t)hb * MH * D : (const bf16*)(ws + WS_OV + OV_VMIX);
    const float* BON = (const float*)(ws + WS_OV + OV_BON);
    bf16* Y = (bf16*)(ws + WS_OV + OV_YA);
    const int lane = c.lane, c0 = 16 * lane;
    float lw[16], lb[16];
#pragma unroll
    for (int e = 0; e < 16; ++e) { lw[e] = a.in[I_LNW][(size_t)l * D + c0 + e]; lb[e] = a.in[I_LNB][(size_t)l * D + c0 + e]; }
    const int gw = c.bid * 8 + c.wave, NGW = c.G * 8;
    v4u ny0, ny1, nv0, nv1, ng0, ng1; float nbon = 0.f;
#define RP_LOAD(mm) do { ny0 = *(const v4u*)(Y + (size_t)(mm) * D + c0); ny1 = *(const v4u*)(Y + (size_t)(mm) * D + c0 + 8); nv0 = *(const v4u*)(VS + (size_t)(mm) * D + c0); nv1 = *(const v4u*)(VS + (size_t)(mm) * D + c0 + 8); \
        ng0 = *(const v4u*)(GG + (size_t)(mm) * D + c0); ng1 = *(const v4u*)(GG + (size_t)(mm) * D + c0 + 8); nbon = BON[(size_t)(mm) * 16 + (lane >> 2)]; } while (0)
    if (gw < MH) RP_LOAD(gw);
    for (int m = gw; m < MH; m += NGW) {
        float y[16], v[16], g[16], t8[8];
        const v4u cy0 = ny0, cy1 = ny1, cv0 = nv0, cv1 = nv1, cg0 = ng0, cg1 = ng1; const float bon = nbon;
        if (m + NGW < MH) RP_LOAD(m + NGW);
#define UP16(dst, qa, qb) do { unpack8(qa, t8); _Pragma("unroll") for (int e = 0; e < 8; ++e) dst[e] = t8[e]; unpack8(qb, t8); _Pragma("unroll") for (int e = 0; e < 8; ++e) dst[8 + e] = t8[e]; } while (0)
        UP16(y, cy0, cy1); UP16(v, cv0, cv1); UP16(g, cg0, cg1);
#undef UP16
        float s1 = 0.f;
#pragma unroll
        for (int e = 0; e < 16; ++e) s1 += y[e];
        s1 = sum4(s1);
        const float mean = s1 * (1.f / 64.f);
        float s2 = 0.f;
#pragma unroll
        for (int e = 0; e < 16; ++e) { const float d = y[e] - mean; s2 += d * d; }
        s2 = sum4(s2);
        const float rstd = rsqrtf(s2 * (1.f / 64.f) + 64e-5f);
        float o[16];
#pragma unroll
        for (int e = 0; e < 16; ++e) o[e] = ((y[e] - mean) * rstd * lw[e] + lb[e] + bon * v[e]) * g[e];
        v4u o0, o1;
        o0.x = pk2(o[0], o[1]); o0.y = pk2(o[2], o[3]); o0.z = pk2(o[4], o[5]); o0.w = pk2(o[6], o[7]);
        o1.x = pk2(o[8], o[9]); o1.y = pk2(o[10], o[11]); o1.z = pk2(o[12], o[13]); o1.w = pk2(o[14], o[15]);
        *(v4u*)(Y + (size_t)m * D + c0) = o0; *(v4u*)(Y + (size_t)m * D + c0 + 8) = o1;
    }
}

__device__ __forceinline__ void phase_ssd_conv(const Ctx& c, KArgs& a, int l) {
    unsigned char* ws = a.ws;
    const bf16* PS = (const bf16*)(ws + WS_OV + OV_PS);
    bf16* XBC = (bf16*)(ws + WS_OV + OV_XBC);
    float* DT = (float*)(ws + WS_OV + OV_DT); float* DA = (float*)(ws + WS_OV + OV_DA);
    const float* cw = a.in[I_CW] + (size_t)l * 4 * 3072; const float* cb = a.in[I_CB] + (size_t)l * 3072;
    const int gw = c.bid * 8 + c.wave, NGW = c.G * 8, lane = c.lane;
    constexpr int RUN = 16, NRUN = MH / RUN;
    for (int it = gw; it < 2 * NRUN; it += NGW) {
        const int cb_ = 4 + (it & 1), run = it >> 1, ch0 = cb_ * 512 + lane * 8, m0 = run * RUN;
        float w[4][8], bias[8];
#pragma unroll
        for (int j = 0; j < 4; ++j)
#pragma unroll
            for (int e = 0; e < 8; ++e) w[j][e] = cw[j * 3072 + ch0 + e];
#pragma unroll
        for (int e = 0; e < 8; ++e) bias[e] = cb[ch0 + e];
        float x0[8], x1[8], x2[8], x3[8];
        const bf16* base = PS + (size_t)m0 * N2P + 2048 + ch0;
        const int t0 = m0 & (T - 1);
        if (t0 >= 3) { unpack8(*(const v4u*)(base - 3 * N2P), x0); unpack8(*(const v4u*)(base - 2 * N2P), x1); unpack8(*(const v4u*)(base - N2P), x2); }
        else {
#pragma unroll
            for (int e = 0; e < 8; ++e) { x0[e] = 0.f; x1[e] = 0.f; x2[e] = 0.f; }
        }
        v4u nx = *(const v4u*)base;
#pragma unroll 4
        for (int i = 0; i < RUN; ++i) {
            unpack8(nx, x3);
            if (i + 1 < RUN) nx = *(const v4u*)(base + (size_t)(i + 1) * N2P);
            float o[8];
#pragma unroll
            for (int e = 0; e < 8; ++e) { const float y = bias[e] + x0[e] * w[0][e] + x1[e] * w[1][e] + x2[e] * w[2][e] + x3[e] * w[3][e]; o[e] = siluf_(y); x0[e] = x1[e]; x1[e] = x2[e]; x2[e] = x3[e]; }
            *(v4u*)(XBC + (size_t)(m0 + i) * 3072 + ch0) = pack8(o);
        }
    }
}

__device__ __forceinline__ void tr_bm2(unsigned a, bf16x8& f0, bf16x8& f1) {
    s16x4 l0, h0, l1, h1;
    asm volatile("ds_read_b64_tr_b16 %0, %4\n\tds_read_b64_tr_b16 %1, %4 offset:1088\n\tds_read_b64_tr_b16 %2, %4 offset:8704\n\tds_read_b64_tr_b16 %3, %4 offset:9792\n\ts_waitcnt lgkmcnt(0)"
                 : "=&v"(l0), "=&v"(h0), "=&v"(l1), "=&v"(h1) : "v"(a) : "memory");
    f0 = __builtin_shufflevector(l0, h0, 0, 1, 2, 3, 4, 5, 6, 7); f1 = __builtin_shufflevector(l1, h1, 0, 1, 2, 3, 4, 5, 6, 7);
}
__device__ __forceinline__ void tr_x2(unsigned a, bf16x8& f0, bf16x8& f1) {
    s16x4 l0, h0, l1, h1;
    asm volatile("ds_read_b64_tr_b16 %0, %4\n\tds_read_b64_tr_b16 %1, %4 offset:320\n\tds_read_b64_tr_b16 %2, %4 offset:2560\n\tds_read_b64_tr_b16 %3, %4 offset:2880\n\ts_waitcnt lgkmcnt(0)"
                 : "=&v"(l0), "=&v"(h0), "=&v"(l1), "=&v"(h1) : "v"(a) : "memory");
    f0 = __builtin_shufflevector(l0, h0, 0, 1, 2, 3, 4, 5, 6, 7); f1 = __builtin_shufflevector(l1, h1, 0, 1, 2, 3, 4, 5, 6, 7);
}
__device__ __forceinline__ void tr_x4(unsigned a, bf16x8& f00, bf16x8& f01, bf16x8& f10, bf16x8& f11) {
    s16x4 l0, h0, l1, h1, l2, h2, l3, h3;
    asm volatile("ds_read_b64_tr_b16 %0, %8\n\tds_read_b64_tr_b16 %1, %8 offset:320\n\tds_read_b64_tr_b16 %2, %8 offset:2560\n\tds_read_b64_tr_b16 %3, %8 offset:2880\n\t"
                 "ds_read_b64_tr_b16 %4, %8 offset:32\n\tds_read_b64_tr_b16 %5, %8 offset:352\n\tds_read_b64_tr_b16 %6, %8 offset:2592\n\tds_read_b64_tr_b16 %7, %8 offset:2912\n\ts_waitcnt lgkmcnt(0)"
                 : "=&v"(l0), "=&v"(h0), "=&v"(l1), "=&v"(h1), "=&v"(l2), "=&v"(h2), "=&v"(l3), "=&v"(h3) : "v"(a) : "memory");
    f00 = __builtin_shufflevector(l0, h0, 0, 1, 2, 3, 4, 5, 6, 7); f01 = __builtin_shufflevector(l1, h1, 0, 1, 2, 3, 4, 5, 6, 7);
    f10 = __builtin_shufflevector(l2, h2, 0, 1, 2, 3, 4, 5, 6, 7); f11 = __builtin_shufflevector(l3, h3, 0, 1, 2, 3, 4, 5, 6, 7);
}
__device__ __forceinline__ void phase_ssd_scan(const Ctx& c, KArgs& a, int l) {
    unsigned char* ws = a.ws;
    const bf16* PS = (const bf16*)(ws + WS_OV + OV_PS);
    bf16* XBC = (bf16*)(ws + WS_OV + OV_XBC);
    const float* cw = a.in[I_CW] + (size_t)l * 4 * 3072; const float* cb = a.in[I_CB] + (size_t)l * 3072;
    const float* DT = (const float*)(ws + WS_OV + OV_DT); const float* ACS = (const float*)(ws + WS_OV + OV_DA);
    constexpr int SC = 136, SM = 72, SX = 40;
    LAS bf16* Cm = (LAS bf16*)c.lds;
    LAS bf16* Bm = Cm + 64 * SC;
    LAS bf16* Xd = Bm + 64 * SC;
    LAS bf16* Xs = Xd + 64 * SX;
    LAS bf16* Xr = Xs + 64 * SX;
    LAS bf16* MtT = Xr + 64 * SX;
    LAS bf16* SL = MtT + 64 * SM;
    LAS float* acsL = (LAS float*)(SL + 32 * SC);
    const unsigned BmB = (unsigned)(size_t)Bm, XdB = (unsigned)(size_t)Xd, XsB = (unsigned)(size_t)Xs;
    const int tid = c.tid, lane = c.lane, w = c.wave, r = lane & 15, q = lane >> 4;
    const int sj = tid >> 3, sn = (tid & 7) * 16, sp = (tid & 7) * 4;
    const int trq = ((lane & 15) >> 2), trp = lane & 3;
    const unsigned troffB = (unsigned)(((8 * q + trq) * SC + 4 * trp) * 2), troffX = (unsigned)(((8 * q + trq) * SX + 4 * trp) * 2);
    for (int unit = c.bid; unit < 256; unit += c.G) {
        const int b = unit >> 6, h = (unit >> 1) & 31, ph = unit & 1, g = h >> 3;
        const size_t m0 = (size_t)b * T;
        f32x4 st[2] = {(f32x4){0.f, 0.f, 0.f, 0.f}, (f32x4){0.f, 0.f, 0.f, 0.f}};
        for (int e = tid; e < 32 * SC / 2; e += 512) ((LAS unsigned*)SL)[e] = 0u;
        v4u gB0, gB1, gC0, gC1; v2u gX0, gX1, gX2, gX3; float gacs, gacsE, gdt;
        const int chx = h * 64 + ph * 32 + sp; const float Dh = a.in[I_SD][l * 32 + h];
        float cwt[4][4], cbs[4];
#pragma unroll
        for (int e2 = 0; e2 < 4; ++e2) { cbs[e2] = cb[chx + e2];
#pragma unroll
            for (int j = 0; j < 4; ++j) cwt[j][e2] = cw[j * 3072 + chx + e2]; }
#define SS_LOAD(chunk) do { const size_t row = m0 + (size_t)(chunk) * 64 + sj; const bf16* xr = XBC + row * 3072; \
            gB0 = *(const v4u*)(xr + 2048 + g * 128 + sn); gB1 = *(const v4u*)(xr + 2048 + g * 128 + sn + 8); \
            gC0 = *(const v4u*)(xr + 2560 + g * 128 + sn); gC1 = *(const v4u*)(xr + 2560 + g * 128 + sn + 8); \
            { const int t_ = (chunk) * 64 + sj; const bf16* pr_ = PS + row * N2P + 2048 + chx; const v2u z2 = (v2u){0u, 0u}; \
              gX3 = *(const v2u*)pr_; gX2 = t_ >= 1 ? *(const v2u*)(pr_ - N2P) : z2; gX1 = t_ >= 2 ? *(const v2u*)(pr_ - 2 * N2P) : z2; gX0 = t_ >= 3 ? *(const v2u*)(pr_ - 3 * N2P) : z2; } \
            gacs = ACS[row * 32 + h]; gacsE = ACS[(m0 + (size_t)(chunk) * 64 + 63) * 32 + h]; gdt = DT[row * 32 + h]; } while (0)
#define SS_STAGE() do { \
            *(LAS v4u*)(Bm + sj * SC + sn) = gB0; *(LAS v4u*)(Bm + sj * SC + sn + 8) = gB1; *(LAS v4u*)(Cm + sj * SC + sn) = gC0; *(LAS v4u*)(Cm + sj * SC + sn + 8) = gC1; \
            const float sc_ = gdt * __expf(gacsE - gacs); \
            const float r0_[4] = {bflo(gX0.x), bfhi(gX0.x), bflo(gX0.y), bfhi(gX0.y)}, r1_[4] = {bflo(gX1.x), bfhi(gX1.x), bflo(gX1.y), bfhi(gX1.y)}; \
            const float r2_[4] = {bflo(gX2.x), bfhi(gX2.x), bflo(gX2.y), bfhi(gX2.y)}, r3_[4] = {bflo(gX3.x), bfhi(gX3.x), bflo(gX3.y), bfhi(gX3.y)}; \
            float xa_[4]; _Pragma("unroll") for (int e2 = 0; e2 < 4; ++e2) xa_[e2] = siluf_(cbs[e2] + r0_[e2] * cwt[0][e2] + r1_[e2] * cwt[1][e2] + r2_[e2] * cwt[2][e2] + r3_[e2] * cwt[3][e2]); \
            const float x0_ = xa_[0], x1_ = xa_[1], x2_ = xa_[2], x3_ = xa_[3]; \
            v2u o1_, o2_; o1_.x = pk2(x0_ * gdt, x1_ * gdt); o1_.y = pk2(x2_ * gdt, x3_ * gdt); o2_.x = pk2(x0_ * sc_, x1_ * sc_); o2_.y = pk2(x2_ * sc_, x3_ * sc_); \
            *(LAS v2u*)(Xd + sj * SX + sp) = o1_; *(LAS v2u*)(Xs + sj * SX + sp) = o2_; { v2u o3_; o3_.x = pk2(x0_, x1_); o3_.y = pk2(x2_, x3_); *(LAS v2u*)(Xr + sj * SX + sp) = o3_; } \
            if ((tid & 7) == 0) acsL[sj] = gacs; } while (0)
        SS_LOAD(0);
        SS_STAGE();
        __syncthreads();
        for (int ch = 0; ch < T / 64; ++ch) {
            if (ch + 1 < T / 64) SS_LOAD(ch + 1);
            {
                const int jt = w >> 1, it0 = 2 * (w & 1);
                f32x4 acc0 = (f32x4){0.f, 0.f, 0.f, 0.f}, acc1 = acc0;
                if (it0 + 1 >= jt) {
#pragma unroll
                    for (int ks = 0; ks < 4; ++ks) {
                        const bf16x8 af = *(const LAS bf16x8*)(Bm + (16 * jt + r) * SC + 32 * ks + 8 * q);
                        const bf16x8 b0 = *(const LAS bf16x8*)(Cm + (16 * it0 + r) * SC + 32 * ks + 8 * q);
                        const bf16x8 b1 = *(const LAS bf16x8*)(Cm + (16 * (it0 + 1) + r) * SC + 32 * ks + 8 * q);
                        acc0 = __builtin_amdgcn_mfma_f32_16x16x32_bf16(af, b0, acc0, 0, 0, 0);
                        acc1 = __builtin_amdgcn_mfma_f32_16x16x32_bf16(af, b1, acc1, 0, 0, 0);
                    }
                }
                const int i0 = 16 * it0 + r, i1 = i0 + 16;
                const float ai0 = acsL[i0], ai1 = acsL[i1];
                float m0v[4], m1v[4];
#pragma unroll
                for (int e = 0; e < 4; ++e) { const int j = 16 * jt + 4 * q + e; const float aj = acsL[j];
                    m0v[e] = (j <= i0) ? acc0[e] * __expf(ai0 - aj) : 0.f; m1v[e] = (j <= i1) ? acc1[e] * __expf(ai1 - aj) : 0.f; }
                { v2u o0, o1; o0.x = pk2(m0v[0], m0v[1]); o0.y = pk2(m0v[2], m0v[3]); o1.x = pk2(m1v[0], m1v[1]); o1.y = pk2(m1v[2], m1v[3]);
                  *(LAS v2u*)(MtT + i0 * SM + 16 * jt + 4 * q) = o0; *(LAS v2u*)(MtT + i1 * SM + 16 * jt + 4 * q) = o1; }
            }
            lds_barrier();
            {
                const int it = w >> 1, pt = w & 1;
                f32x4 accD = (f32x4){0.f, 0.f, 0.f, 0.f}, accO = accD;
                {
                    bf16x8 xb0, xb1; tr_x2(XdB + troffX + 32u * pt, xb0, xb1);
                    const bf16x8 af0 = *(const LAS bf16x8*)(MtT + (16 * it + r) * SM + 8 * q);
                    accD = __builtin_amdgcn_mfma_f32_16x16x32_bf16(af0, xb0, accD, 0, 0, 0);
                    if (it >= 2) {
                        const bf16x8 af1 = *(const LAS bf16x8*)(MtT + (16 * it + r) * SM + 32 + 8 * q);
                        accD = __builtin_amdgcn_mfma_f32_16x16x32_bf16(af1, xb1, accD, 0, 0, 0);
                    }
                }
#pragma unroll
                for (int ks = 0; ks < 4; ++ks) {
                    const bf16x8 af = *(const LAS bf16x8*)(Cm + (16 * it + r) * SC + 32 * ks + 8 * q);
                    const bf16x8 bf_ = *(const LAS bf16x8*)(SL + (16 * pt + r) * SC + 32 * ks + 8 * q);
                    accO = __builtin_amdgcn_mfma_f32_16x16x32_bf16(af, bf_, accO, 0, 0, 0);
                }
                const int p = 16 * pt + r;
#pragma unroll
                for (int e = 0; e < 4; ++e) { const int i = 16 * it + 4 * q + e; const float y = accD[e] + __expf(acsL[i]) * accO[e] + Dh * bf1(Xr[i * SX + p]);
                    XBC[(m0 + (size_t)ch * 64 + i) * 3072 + h * 64 + ph * 32 + p] = (bf16)f2bf(y); }
            }
            {
                const float dec = __expf(acsL[63]);
                bf16x8 a0, a1, bx[2][2];
                tr_bm2(BmB + troffB + 32u * w, a0, a1);
                tr_x4(XsB + troffX, bx[0][0], bx[0][1], bx[1][0], bx[1][1]);
#pragma unroll
                for (int pt = 0; pt < 2; ++pt) {
                    f32x4 s = st[pt] * dec;
                    s = __builtin_amdgcn_mfma_f32_16x16x32_bf16(a0, bx[pt][0], s, 0, 0, 0);
                    s = __builtin_amdgcn_mfma_f32_16x16x32_bf16(a1, bx[pt][1], s, 0, 0, 0);
                    st[pt] = s;
                }
            }
            lds_barrier();
#pragma unroll
            for (int pt = 0; pt < 2; ++pt) { v2u o; o.x = pk2c(st[pt][0], st[pt][1]); o.y = pk2c(st[pt][2], st[pt][3]);
                *(LAS v2u*)(SL + (16 * pt + r) * SC + 16 * w + 4 * q) = o; }
            if (ch + 1 < T / 64) SS_STAGE();
            lds_barrier();
        }
#undef SS_LOAD
#undef SS_STAGE
    }
}

__device__ __forceinline__ void phase_ssd_post(const Ctx& c, KArgs& a, int l) {
    unsigned char* ws = a.ws;
    bf16* PS = (bf16*)(ws + WS_OV + OV_PS);
    const bf16* XBC = (const bf16*)(ws + WS_OV + OV_XBC);
    const int lane = c.lane, c0 = 32 * lane;
    const float* ng = a.in[I_SNG] + (size_t)l * 2048 + c0;
    const int gw = c.bid * 8 + c.wave, NGW = c.G * 8;
    v4u nyy[4], nzz[4];
#define SP_LOAD(mm) do { _Pragma("unroll") for (int q = 0; q < 4; ++q) { nyy[q] = *(const v4u*)(XBC + (size_t)(mm) * 3072 + c0 + 8 * q); nzz[q] = *(const v4u*)(PS + (size_t)(mm) * N2P + c0 + 8 * q); } } while (0)
    if (gw < MH) SP_LOAD(gw);
    for (int m = gw; m < MH; m += NGW) {
        float y[32]; float ss = 0.f;
        v4u cyy[4], czz[4];
#pragma unroll
        for (int q = 0; q < 4; ++q) { cyy[q] = nyy[q]; czz[q] = nzz[q]; }
        if (m + NGW < MH) SP_LOAD(m + NGW);
#pragma unroll
        for (int q = 0; q < 4; ++q) {
            float yy[8], zz[8];
            unpack8(cyy[q], yy); unpack8(czz[q], zz);
#pragma unroll
            for (int e = 0; e < 8; ++e) { const float v = yy[e] * siluf_(zz[e]); y[8 * q + e] = v; ss += v * v; }
        }
        ss = sum16(ss);
        const float r = rsqrtf(ss * (1.f / 512.f) + 1e-6f);
#pragma unroll
        for (int q = 0; q < 4; ++q) {
            float o[8];
#pragma unroll
            for (int e = 0; e < 8; ++e) o[e] = y[8 * q + e] * r * ng[8 * q + e];
            *(v4u*)(PS + (size_t)m * N2P + 2048 + c0 + 8 * q) = pack8(o);
        }
    }
}

__device__ __forceinline__ void phase_peer_convert(const Ctx& c, KArgs& a, int l) {
    unsigned char* ws = a.ws;
    const int gw = c.bid * 8 + c.wave, NGW = c.G * 8, lane = c.lane;
    f32x4 n0, n1, n2, n3;
#define PC_LOAD(itt) do { const int tb_ = (itt) >= NEXP, e_ = (itt) - tb_ * NEXP; const float* s_ = (tb_ ? a.in[I_PU] : a.in[I_PD]) + ((size_t)l * NEXP + e_) * D + 16 * lane; \
        n0 = *(const f32x4*)s_; n1 = *(const f32x4*)(s_ + 4); n2 = *(const f32x4*)(s_ + 8); n3 = *(const f32x4*)(s_ + 12); } while (0)
    if (gw < 2 * NEXP) PC_LOAD(gw);
    for (int it = gw; it < 2 * NEXP; it += NGW) {
        const int tb = it >= NEXP, e = it - tb * NEXP;
        const f32x4 x0 = n0, x1 = n1, x2 = n2, x3 = n3;
        if (it + NGW < 2 * NEXP) PC_LOAD(it + NGW);
        float am = fmaxf(fmaxf(fmaxf(fabsf(x0.x), fabsf(x0.y)), fmaxf(fabsf(x0.z), fabsf(x0.w))), fmaxf(fmaxf(fabsf(x1.x), fabsf(x1.y)), fmaxf(fabsf(x1.z), fabsf(x1.w))));
        am = fmaxf(am, fmaxf(fmaxf(fmaxf(fabsf(x2.x), fabsf(x2.y)), fmaxf(fabsf(x2.z), fabsf(x2.w))), fmaxf(fmaxf(fabsf(x3.x), fabsf(x3.y)), fmaxf(fabsf(x3.z), fabsf(x3.w)))));
#pragma unroll
        for (int o = 1; o < 64; o <<= 1) am = fmaxf(am, __shfl_xor(am, o));
        am = fmaxf(am, 1e-30f);
        const float s = 384.f / am;
        v4u q;
        int w;
        w = __builtin_amdgcn_cvt_pk_fp8_f32(x0.x * s, x0.y * s, 0, false); w = __builtin_amdgcn_cvt_pk_fp8_f32(x0.z * s, x0.w * s, w, true); q.x = (unsigned)w;
        w = __builtin_amdgcn_cvt_pk_fp8_f32(x1.x * s, x1.y * s, 0, false); w = __builtin_amdgcn_cvt_pk_fp8_f32(x1.z * s, x1.w * s, w, true); q.y = (unsigned)w;
        w = __builtin_amdgcn_cvt_pk_fp8_f32(x2.x * s, x2.y * s, 0, false); w = __builtin_amdgcn_cvt_pk_fp8_f32(x2.z * s, x2.w * s, w, true); q.z = (unsigned)w;
        w = __builtin_amdgcn_cvt_pk_fp8_f32(x3.x * s, x3.y * s, 0, false); w = __builtin_amdgcn_cvt_pk_fp8_f32(x3.z * s, x3.w * s, w, true); q.w = (unsigned)w;
        *(v4u*)(ws + WS_OV + (tb ? OV_UP : OV_DOWN) + (size_t)e * D + 16 * lane) = q;
        if (lane == 0) ((float*)(ws + WS_OV + OV_PSCALE))[it] = am * (1.f / 384.f);
    }
}

template <class TT> __device__ __forceinline__ void ce_desc(TT& a, TT& b) { const TT hi = a > b ? a : b, lo = a > b ? b : a; a = hi; b = lo; }
__device__ __forceinline__ void cef(float& a, float& b) { const float hi = fmaxf(a, b), lo = fminf(a, b); a = hi; b = lo; }
__device__ __forceinline__ void ced(double& a, double& b) { const double hi = fmax(a, b), lo = fmin(a, b); a = hi; b = lo; }
template <class TT, class CE> __device__ __forceinline__ void bitonic_sort16_desc(TT (&v)[16], CE ce) {
#pragma unroll
    for (int k = 2; k <= 16; k <<= 1)
#pragma unroll
        for (int j = k >> 1; j > 0; j >>= 1)
#pragma unroll
            for (int i = 0; i < 16; ++i) { const int p = i ^ j; if (p > i) { if ((i & k) == 0) ce(v[i], v[p]); else ce(v[p], v[i]); } }
}
template <class TT, class CE> __device__ __forceinline__ void bitonic_merge16_desc(TT (&v)[16], CE ce) {
#pragma unroll
    for (int j = 8; j > 0; j >>= 1)
#pragma unroll
        for (int i = 0; i < 16; ++i) { const int p = i ^ j; if (p > i) ce(v[i], v[p]); }
}
struct CEF { __device__ __forceinline__ void operator()(float& a, float& b) const { cef(a, b); } };
struct CED { __device__ __forceinline__ void operator()(double& a, double& b) const { ced(a, b); } };

__device__ __forceinline__ void top16_of_128(const bf16* p, float (&top)[16]) {
#pragma unroll
    for (int grp = 0; grp < 8; ++grp) {
        float cur[16];
        const v4u q0 = *(const v4u*)(p + grp * 16), q1 = *(const v4u*)(p + grp * 16 + 8);
        const unsigned w[8] = {q0.x, q0.y, q0.z, q0.w, q1.x, q1.y, q1.z, q1.w};
#pragma unroll
        for (int e = 0; e < 8; ++e) {
            const unsigned lo = w[e] << 16, hi = w[e] & 0xffff0000u;
            const unsigned i0 = grp * 16 + 2 * e, i1 = i0 + 1;
            cur[2 * e] = __builtin_bit_cast(float, lo | ((lo >> 31) ? i0 : (127u - i0)));
            cur[2 * e + 1] = __builtin_bit_cast(float, hi | ((hi >> 31) ? i1 : (127u - i1)));
        }
        bitonic_sort16_desc(cur, CEF());
        if (grp == 0) {
#pragma unroll
            for (int i = 0; i < 16; ++i) top[i] = cur[i];
        } else {
#pragma unroll
            for (int i = 0; i < 16; ++i) top[i] = fmaxf(top[i], cur[15 - i]);
            bitonic_merge16_desc(top, CEF());
        }
    }
}
__device__ __forceinline__ unsigned key_index(float k) { const unsigned u = __builtin_bit_cast(unsigned, k); const unsigned lo = u & 0x7fu; return (u >> 31) ? lo : 127u - lo; }
__device__ __forceinline__ float key_value(float k) { return __builtin_bit_cast(float, __builtin_bit_cast(unsigned, k) & 0xffff0000u); }

__device__ __forceinline__ void phase_peer_topk(const Ctx& c, KArgs& a) {
    unsigned char* ws = a.ws;
    const bf16* SC = (const bf16*)(ws + WS_OV + OV_SC);
    int* IDX = (int*)(ws + WS_OV + OV_IDX); float* GATE = (float*)(ws + WS_OV + OV_GATE);
    for (int it = c.bid * 512 + c.tid; it < M * 8; it += c.G * 512) {
        const bf16* p = SC + (size_t)it * 256;
        float t0[16], t1[16];
        top16_of_128(p, t0); top16_of_128(p + 128, t1);
        float v0[16], v1[16]; unsigned i0[16], i1[16];
#pragma unroll
        for (int i = 0; i < 16; ++i) { v0[i] = key_value(t0[i]); v1[i] = key_value(t1[i]); i0[i] = key_index(t0[i]); i1[i] = key_index(t1[i]); }
        double top[16];
        const double NEG = -1.0e300;
#pragma unroll
        for (int grp = 0; grp < 4; ++grp) {
            double cur[16];
#pragma unroll
            for (int s = 0; s < 16; ++s) cur[s] = NEG;
            int n = 0;
#pragma unroll
            for (int i = 0; i < 16; ++i)
#pragma unroll
                for (int j = 0; j < 16; ++j) if ((i + 1) * (j + 1) <= 16) {
                    if (n / 16 == grp) {
                        const double d = (double)(v0[i] + v1[j]);
                        const unsigned long long eid = (unsigned long long)(i0[i] * 128u + i1[j]);
                        const unsigned long long bits = __builtin_bit_cast(unsigned long long, d);
                        cur[n % 16] = __builtin_bit_cast(double, bits | ((bits >> 63) ? eid : (16383ull - eid)));
                    }
                    ++n;
                }
            bitonic_sort16_desc(cur, CED());
            if (grp == 0) {
#pragma unroll
                for (int i = 0; i < 16; ++i) top[i] = cur[i];
            } else {
#pragma unroll
                for (int i = 0; i < 16; ++i) top[i] = fmax(top[i], cur[15 - i]);
                bitonic_merge16_desc(top, CED());
            }
        }
        float sv[16]; int id[16];
#pragma unroll
        for (int i = 0; i < 16; ++i) { const unsigned long long bits = __builtin_bit_cast(unsigned long long, top[i]); const unsigned lo = (unsigned)(bits & 0x3fffull);
            id[i] = (int)((bits >> 63) ? lo : 16383u - lo); sv[i] = (float)top[i]; }
        float den = 0.f, ex[16];
#pragma unroll
        for (int i = 0; i < 16; ++i) { ex[i] = __expf(sv[i] - sv[0]); den += ex[i]; }
        const float inv = 1.f / den;
        unsigned cw[4] = {0u, 0u, 0u, 0u};
#pragma unroll
        for (int i = 0; i < 16; ++i) { const unsigned s = (unsigned)id[i] >> PEER_SLICE_SHIFT, inc = 1u << (8 * (s & 3)), ws_ = s >> 2;
            cw[0] += ws_ == 0 ? inc : 0u; cw[1] += ws_ == 1 ? inc : 0u; cw[2] += ws_ == 2 ? inc : 0u; cw[3] += ws_ == 3 ? inc : 0u; }
        unsigned lp[4], tot[4], st[4];
        const int l8 = c.lane & 7;
#pragma unroll
        for (int k = 0; k < 4; ++k) { unsigned v = cw[k];
#pragma unroll
            for (int o = 1; o < 8; o <<= 1) { const unsigned y = __shfl_up(v, o, 8); v += (l8 >= o) ? y : 0u; }
            tot[k] = __shfl(v, 7, 8); lp[k] = v - cw[k]; }
        {   unsigned carry = 0u;
#pragma unroll
            for (int k = 0; k < 4; ++k) { st[k] = tot[k] * 0x01010100u + carry * 0x01010101u; carry += (tot[k] * 0x01010101u) >> 24; } }
        unsigned run[4] = {st[0] + lp[0], st[1] + lp[1], st[2] + lp[2], st[3] + lp[3]};
        const size_t tok = (size_t)(it >> 3);
#pragma unroll
        for (int i = 0; i < 16; ++i) { const unsigned s = (unsigned)id[i] >> PEER_SLICE_SHIFT, sh = 8 * (s & 3), ws_ = s >> 2, inc = 1u << sh;
            const unsigned wsel = ws_ == 0 ? run[0] : (ws_ == 1 ? run[1] : (ws_ == 2 ? run[2] : run[3]));
            const unsigned pos = (wsel >> sh) & 0xffu;
            run[0] += ws_ == 0 ? inc : 0u; run[1] += ws_ == 1 ? inc : 0u; run[2] += ws_ == 2 ? inc : 0u; run[3] += ws_ == 3 ? inc : 0u;
            IDX[tok * 128 + pos] = id[i]; GATE[tok * 128 + pos] = ex[i] * inv; }
        if (l8 == 0) ((v4u*)(ws + WS_OV + OV_POFF))[tok] = (v4u){st[0], st[1], st[2], st[3]};
    }
}

__device__ __forceinline__ float gelu_tanh(float x) { const float u = 0.7978845608f * (x + 0.044715f * x * x * x); const float t = 1.f - 2.f / (1.f + __expf(2.f * u)); return 0.5f * x * (1.f + t); }
__device__ __forceinline__ void unpack16_fp8(const v4u& q, float (&o)[16]) {
    const unsigned w[4] = {q.x, q.y, q.z, q.w};
#pragma unroll
    for (int i = 0; i < 4; ++i) { const f32x2 lo = __builtin_amdgcn_cvt_pk_f32_fp8((int)w[i], false), hi = __builtin_amdgcn_cvt_pk_f32_fp8((int)w[i], true);
        o[4 * i] = lo.x; o[4 * i + 1] = lo.y; o[4 * i + 2] = hi.x; o[4 * i + 3] = hi.y; }
}
__device__ __forceinline__ int slice_start(unsigned o0, unsigned o1, unsigned o2, unsigned o3, int s) {
    const unsigned wsel = s < 4 ? o0 : (s < 8 ? o1 : (s < 12 ? o2 : o3));
    return s >= PEER_NSLICE ? 128 : (int)((wsel >> (8 * (s & 3))) & 0xffu);
}
template <int MODE> __device__ __forceinline__ void phase_peer_down(const Ctx& c, KArgs& a, int l, int qset) {
    unsigned char* ws = a.ws;
    const unsigned char* U8 = ws + WS_OV + OV_U8; const float* XS = (const float*)(ws + WS_OV + OV_XS);
    const unsigned char* DN = ws + WS_OV + OV_DOWN;
    const int* IDX = (const int*)(ws + WS_OV + OV_IDX);
    const v4u* POFF = (const v4u*)(ws + WS_OV + OV_POFF);
    float* ACT = (float*)(ws + WS_OV + (qset ? 278 * MiB : OV_ACT));
    unsigned* QC = (unsigned*)(ws + WS_CTL) + CW_QUEUE + (qset * 2 + l) * PEER_NSLICE * 64;
    constexpr int RS = 528;
    LAS unsigned char* wb = c.lds + c.wave * (8192 + 16 * RS);
    LAS unsigned* lpk = (LAS unsigned*)wb;
    LAS unsigned char* RB = wb + 8192;
    const int lane = c.lane, r16 = lane & 15, q = lane >> 4, hsel = lane >> 5, l32 = lane & 31;
    constexpr int NBLK = M / 16;
    const int s = c.bid & (PEER_NSLICE - 1);
    const int nrank = ((c.G - s + PEER_NSLICE - 1) >> 3) * 8, rank = (c.bid >> 3) * 8 + c.wave;
    {
#pragma unroll 1
        for (int blk = rank; blk < NBLK; blk += nrank) {
            const size_t mb = (size_t)blk * 16;
            v4u xb[16];
            { const unsigned char* xp = U8 + (mb + r16) * D + 16 * q;
#pragma unroll
              for (int j = 0; j < 16; ++j) xb[j] = *(const v4u*)(xp + 64 * j); }
            const float xs = XS[mb + r16];
            int pav = 0, nv = 0;
            if (lane < 16) { const v4u po = POFF[mb + lane]; pav = slice_start(po.x, po.y, po.z, po.w, s); nv = slice_start(po.x, po.y, po.z, po.w, s + 1) - pav; }
            int incl = nv;
#pragma unroll
            for (int o = 1; o < 16; o <<= 1) { const int y = __shfl_up(incl, o, 16); incl += (r16 >= o) ? y : 0; }
            const int offv = incl - nv;
            const int P = __builtin_amdgcn_readlane(incl, 15);
            {
                int idr[16];
#pragma unroll
                for (int ti = 0; ti < 16; ++ti) { const int pa = __builtin_amdgcn_readlane(pav, ti); const int e = pa + lane; idr[ti] = IDX[(mb + ti) * 128 + (e < 127 ? e : 127)]; }
#pragma unroll
                for (int ti = 0; ti < 16; ++ti) { const int pa = __builtin_amdgcn_readlane(pav, ti), n = __builtin_amdgcn_readlane(nv, ti), off = __builtin_amdgcn_readlane(offv, ti);
                    if (lane < n) lpk[off + lane] = (unsigned)idr[ti] | ((unsigned)ti << 14) | ((unsigned)(pa + lane) << 18); }
                if (__builtin_amdgcn_ballot_w64(nv > 64) != 0ull) {
#pragma unroll 1
                    for (int ti = 0; ti < 16; ++ti) { const int pa = __builtin_amdgcn_readlane(pav, ti), n = __builtin_amdgcn_readlane(nv, ti), off = __builtin_amdgcn_readlane(offv, ti);
                        if (lane + 64 < n) lpk[off + 64 + lane] = (unsigned)IDX[(mb + ti) * 128 + pa + 64 + lane] | ((unsigned)ti << 14) | ((unsigned)(pa + 64 + lane) << 18); }
                }
            }
            asm volatile("s_waitcnt vmcnt(0) lgkmcnt(0)" ::: "memory");
            const int nb = (P + 15) >> 4;
#define PD_IDS(PW, B) { const v4u ia = *(const LAS v4u*)(lpk + (B) * 16 + 8 * hsel), ib = *(const LAS v4u*)(lpk + (B) * 16 + 8 * hsel + 4); \
                PW[0] = ia.x; PW[1] = ia.y; PW[2] = ia.z; PW[3] = ia.w; PW[4] = ib.x; PW[5] = ib.y; PW[6] = ib.z; PW[7] = ib.w; }
#define PD_LOADH(PW, H) { _Pragma("unroll") for (int i = 0; i < 8; ++i) { const unsigned id = MODE == 1 ? (PW[i] & 63u) : (PW[i] & 16383u); \
                    rr[8 * (H) + i] = *(const v4u*)(DN + (size_t)(id * 1024u + 512u * (H) + 16u * l32)); } }
            if (nb > 0) {
                v4u rr[16];
                { unsigned pw[8]; PD_IDS(pw, 0) PD_LOADH(pw, 0) PD_LOADH(pw, 1) }
#pragma unroll 1
                for (int b = 0; b < nb; ++b) {
                    const int bn = b + 1 < nb ? b + 1 : b;
                    unsigned pwn[8]; PD_IDS(pwn, bn)
                    const v4u mt = *(const LAS v4u*)(lpk + b * 16 + 4 * q);
                    f32x4 acc0 = {0.f, 0.f, 0.f, 0.f}, acc1 = {0.f, 0.f, 0.f, 0.f};
#pragma unroll
                    for (int h = 0; h < 2; ++h) {
#pragma unroll
                        for (int i = 0; i < 8; ++i) *(LAS v4u*)(RB + (8 * hsel + i) * RS + 16 * l32) = rr[8 * h + i];
                        PD_LOADH(pwn, h)
#pragma unroll
                        for (int jj = 0; jj < 8; ++jj) {
                            const v4u av = *(const LAS v4u*)(RB + r16 * RS + 64 * jj + 16 * q);
                            const v4u bv = xb[8 * h + jj];
                            const long a0 = (long)(((unsigned long long)av.y << 32) | av.x), a1 = (long)(((unsigned long long)av.w << 32) | av.z);
                            const long b0 = (long)(((unsigned long long)bv.y << 32) | bv.x), b1 = (long)(((unsigned long long)bv.w << 32) | bv.z);
                            acc0 = __builtin_amdgcn_mfma_f32_16x16x32_fp8_fp8(a0, b0, acc0, 0, 0, 0);
                            acc1 = __builtin_amdgcn_mfma_f32_16x16x32_fp8_fp8(a1, b1, acc1, 0, 0, 0);
                        }
                    }
                    const f32x4 dv = (acc0 + acc1) * xs;
                    const unsigned me[4] = {mt.x, mt.y, mt.z, mt.w};
                    const float dd[4] = {dv.x, dv.y, dv.z, dv.w};
#pragma unroll
                    for (int i = 0; i < 4; ++i) if (b * 16 + 4 * q + i < P && (int)((me[i] >> 14) & 15u) == r16) lpk[b * 16 + 4 * q + i] = __builtin_bit_cast(unsigned, dd[i]);
                }
            }
#pragma unroll
            for (int ti = 0; ti < 16; ++ti) { const int pa = __builtin_amdgcn_readlane(pav, ti), n = __builtin_amdgcn_readlane(nv, ti), off = __builtin_amdgcn_readlane(offv, ti);
                if (lane < n) ACT[(mb + ti) * 128 + pa + lane] = __builtin_bit_cast(float, lpk[off + lane]); }
            if (__builtin_amdgcn_ballot_w64(nv > 64) != 0ull) {
#pragma unroll 1
                for (int ti = 0; ti < 16; ++ti) { const int pa = __builtin_amdgcn_readlane(pav, ti), n = __builtin_amdgcn_readlane(nv, ti), off = __builtin_amdgcn_readlane(offv, ti);
                    if (lane + 64 < n) ACT[(mb + ti) * 128 + pa + 64 + lane] = __builtin_bit_cast(float, lpk[off + 64 + lane]); }
            }
        }
    }
}

template <int FUSE> __device__ __forceinline__ void phase_peer_experts(const Ctx& c, KArgs& a, const float* gnext, const bool commit = true) {
    unsigned char* ws = a.ws;
    const unsigned char* UP = ws + WS_OV + OV_UP;
    const float* SCD = (const float*)(ws + WS_OV + OV_PSCALE); const float* SCU = SCD + NEXP;
    const int* IDX = (const int*)(ws + WS_OV + OV_IDX); const float* GATE = (const float*)(ws + WS_OV + OV_GATE);
    const float* ACT = (const float*)(ws + WS_OV + OV_ACT);
    float* H = a.out;
    constexpr int TPW = 16, RS = 144;
    LAS unsigned char* wb = c.lds + c.wave * 16384;
    LAS int* idw = (LAS int*)wb;
    LAS unsigned char* wq8 = wb + 8192;
    LAS unsigned char* tile = wb + 10240;
    LAS float* swl = (LAS float*)(wb + 10240 + 32 * RS);
    const int lane = c.lane, r16 = lane & 15, q = lane >> 4, g8 = lane >> 3, c8 = lane & 7;
    const int gw = c.bid * 8 + c.wave, NGW = c.G * 8;
    const unsigned tr_addr = (unsigned)(size_t)(tile + (8 * q + (r16 >> 1)) * RS + 8 * (r16 & 1));
    for (int m0 = gw; m0 < M; m0 += NGW * TPW) {
#pragma unroll 1
        for (int ti = 0; ti < TPW; ++ti) {
            const int m = m0 + ti * NGW;
            float w0 = 0.f, w1 = 0.f; int id0 = 0, id1 = 0;
            if (m < M) {
                id0 = IDX[(size_t)m * 128 + lane]; id1 = IDX[(size_t)m * 128 + 64 + lane];
                const float g0 = GATE[(size_t)m * 128 + lane], g1 = GATE[(size_t)m * 128 + 64 + lane];
                const float a0 = ACT[(size_t)m * 128 + lane], a1 = ACT[(size_t)m * 128 + 64 + lane];
                w0 = g0 * gelu_tanh(a0 * SCD[id0]) * SCU[id0]; w1 = g1 * gelu_tanh(a1 * SCD[id1]) * SCU[id1];
            }
            float am = fmaxf(fabsf(w0), fabsf(w1));
#pragma unroll
            for (int o = 1; o < 64; o <<= 1) am = fmaxf(am, __shfl_xor(am, o));
            am = fmaxf(am, 1e-30f);
            const float qs = 384.f / am;
            const int pk = __builtin_amdgcn_cvt_pk_fp8_f32(w0 * qs, w1 * qs, 0, false);
            wq8[ti * 128 + lane] = (unsigned char)(pk & 0xff); wq8[ti * 128 + 64 + lane] = (unsigned char)((pk >> 8) & 0xff);
            idw[ti * 128 + lane] = id0; idw[ti * 128 + 64 + lane] = id1;
            if (lane == 0) swl[ti] = am * (1.f / 384.f);
        }
        asm volatile("s_waitcnt lgkmcnt(0)" ::: "memory");
        const f32x4 iscv = *(const LAS f32x4*)(swl + 4 * q);
        const float isc[4] = {iscv.x, iscv.y, iscv.z, iscv.w};
        float ssq[4] = {0.f, 0.f, 0.f, 0.f};
#define UPM_W(T4) { _Pragma("unroll") for (int i = 0; i < 4; ++i) *(LAS v4u*)(tile + (4 * g8 + i) * RS + 16 * c8) = rr[4 * (T4) + i]; }
#define UPM_LK(T4, TIN) { if ((TIN) < TPW) { const v4u i4 = *(const LAS v4u*)(idw + (TIN) * 128 + 32 * (T4) + 4 * g8); \
            rr[4 * (T4) + 0] = *(const v4u*)(UPc + (size_t)(i4.x * 1024u)); rr[4 * (T4) + 1] = *(const v4u*)(UPc + (size_t)(i4.y * 1024u)); \
            rr[4 * (T4) + 2] = *(const v4u*)(UPc + (size_t)(i4.z * 1024u)); rr[4 * (T4) + 3] = *(const v4u*)(UPc + (size_t)(i4.w * 1024u)); } }
#define UPM_R(B) asm volatile("ds_read_b64_tr_b8 %0, %8\n\tds_read_b64_tr_b8 %1, %8 offset:16\n\tds_read_b64_tr_b8 %2, %8 offset:32\n\tds_read_b64_tr_b8 %3, %8 offset:48\n\t" \
                         "ds_read_b64_tr_b8 %4, %8 offset:64\n\tds_read_b64_tr_b8 %5, %8 offset:80\n\tds_read_b64_tr_b8 %6, %8 offset:96\n\tds_read_b64_tr_b8 %7, %8 offset:112" \
                         : "=&v"(B[0]), "=&v"(B[1]), "=&v"(B[2]), "=&v"(B[3]), "=&v"(B[4]), "=&v"(B[5]), "=&v"(B[6]), "=&v"(B[7]) : "v"(tr_addr) : "memory")
#define UPM_WAIT(B) asm volatile("s_waitcnt lgkmcnt(0)" : "+v"(B[0]), "+v"(B[1]), "+v"(B[2]), "+v"(B[3]), "+v"(B[4]), "+v"(B[5]), "+v"(B[6]), "+v"(B[7]) :: "memory")
#define UPM_M(B, TI, T4) { v2u wa = *(const LAS v2u*)(wq8 + (TI) * 128 + 32 * (T4) + 8 * q); if (r16 != (TI)) { wa.x = 0u; wa.y = 0u; } \
            const long wal = (long)(((unsigned long long)wa.y << 32) | wa.x); \
            _Pragma("unroll") for (int ct = 0; ct < 8; ++ct) acc[ct] = __builtin_amdgcn_mfma_f32_16x16x32_fp8_fp8(wal, B[ct], acc[ct], 0, 0, 0); }
#define UPM_STEP(BC, BN, J, T4W, TINW, T4M) { if (s0 + (J) + 1 < 4 * TPW) UPM_R(BN); if (s0 + (J) + 2 < 4 * TPW) { UPM_W(T4W) UPM_LK(T4W, TINW) } UPM_M(BC, ti, T4M) UPM_WAIT(BN); }
#pragma unroll 1
        for (int cq = 0; cq < 8; ++cq) {
            const unsigned char* UPc = UP + 128 * cq + 16 * c8;
            f32x4 acc[8];
#pragma unroll
            for (int ct = 0; ct < 8; ++ct) acc[ct] = (f32x4){0.f, 0.f, 0.f, 0.f};
            {
                v4u rr[16]; long bA[8], bB[8];
                UPM_LK(0, 0) UPM_LK(1, 0) UPM_LK(2, 0) UPM_LK(3, 0)
                UPM_W(0) UPM_LK(0, 1) UPM_R(bA); UPM_WAIT(bA); UPM_W(1) UPM_LK(1, 1)
#pragma unroll 1
                for (int ti = 0; ti < TPW; ++ti) {
                    const int s0 = 4 * ti;
                    UPM_STEP(bA, bB, 0, 2, ti + 1, 0)
                    UPM_STEP(bB, bA, 1, 3, ti + 1, 1)
                    UPM_STEP(bA, bB, 2, 0, ti + 2, 2)
                    UPM_STEP(bB, bA, 3, 1, ti + 2, 3)
                }
            }
            if (!commit) { if (acc[0].x != 123456.789f) continue; }
            {
                float hv[4][8];
#pragma unroll
                for (int i = 0; i < 4; ++i) { const int m = m0 + (4 * q + i) * NGW; const float* hp = H + (size_t)(m < M ? m : 0) * D + 128 * cq + r16;
#pragma unroll
                    for (int ct = 0; ct < 8; ++ct) hv[i][ct] = hp[16 * ct]; }
#pragma unroll
                for (int i = 0; i < 4; ++i) { const int m = m0 + (4 * q + i) * NGW; float* hp = H + (size_t)(m < M ? m : 0) * D + 128 * cq + r16;
#pragma unroll
                    for (int ct = 0; ct < 8; ++ct) { const float d = i == 0 ? acc[ct].x : (i == 1 ? acc[ct].y : (i == 2 ? acc[ct].z : acc[ct].w)); hv[i][ct] += d * isc[i]; ssq[i] += hv[i][ct] * hv[i][ct]; }
                    if (m < M) {
#pragma unroll
                        for (int ct = 0; ct < 8; ++ct) hp[16 * ct] = hv[i][ct]; } }
            }
        }
        if (!commit) continue;
#pragma unroll
        for (int i = 0; i < 4; ++i) { float s = ssq[i]; s += __shfl_xor(s, 1); s += __shfl_xor(s, 2); s += __shfl_xor(s, 4); s += __shfl_xor(s, 8); ssq[i] = s; }
        asm volatile("s_waitcnt vmcnt(0)" ::: "memory");
        const f32x4 gn0 = *(const f32x4*)(gnext + lane * 16), gn1 = *(const f32x4*)(gnext + lane * 16 + 4), gn2 = *(const f32x4*)(gnext + lane * 16 + 8), gn3 = *(const f32x4*)(gnext + lane * 16 + 12);
#pragma unroll
        for (int i = 0; i < 4; ++i)
#pragma unroll 1
            for (int qv = 0; qv < 4; ++qv) {
                const int ti = 4 * qv + i, m = m0 + ti * NGW; if (m >= M) continue;
                const float ss = __builtin_bit_cast(float, __builtin_amdgcn_readlane(__builtin_bit_cast(int, ssq[i]), qv * 16));
                const float rn = rsqrtf(ss * (1.f / D) + 1e-6f);
                f32x4* hp = (f32x4*)(H + (size_t)m * D + lane * 16);
                const f32x4 h0 = hp[0], h1 = hp[1], h2 = hp[2], h3 = hp[3];
                const f32x4 n0 = h0 * rn * gn0, n1 = h1 * rn * gn1, n2 = h2 * rn * gn2, n3 = h3 * rn * gn3;
                if (FUSE == 0) {
                    float am = fmaxf(fmaxf(fmaxf(fmaxf(fabsf(n0.x), fabsf(n0.y)), fmaxf(fabsf(n0.z), fabsf(n0.w))), fmaxf(fmaxf(fabsf(n1.x), fabsf(n1.y)), fmaxf(fabsf(n1.z), fabsf(n1.w)))),
                                     fmaxf(fmaxf(fmaxf(fabsf(n2.x), fabsf(n2.y)), fmaxf(fabsf(n2.z), fabsf(n2.w))), fmaxf(fmaxf(fabsf(n3.x), fabsf(n3.y)), fmaxf(fabsf(n3.z), fabsf(n3.w)))));
#pragma unroll
                    for (int o = 1; o < 64; o <<= 1) am = fmaxf(am, __shfl_xor(am, o));
                    am = fmaxf(am, 1e-30f);
                    const float qs = 384.f / am;
                    v4u u8; int w8;
                    w8 = __builtin_amdgcn_cvt_pk_fp8_f32(n0.x * qs, n0.y * qs, 0, false); w8 = __builtin_amdgcn_cvt_pk_fp8_f32(n0.z * qs, n0.w * qs, w8, true); u8.x = (unsigned)w8;
                    w8 = __builtin_amdgcn_cvt_pk_fp8_f32(n1.x * qs, n1.y * qs, 0, false); w8 = __builtin_amdgcn_cvt_pk_fp8_f32(n1.z * qs, n1.w * qs, w8, true); u8.y = (unsigned)w8;
                    w8 = __builtin_amdgcn_cvt_pk_fp8_f32(n2.x * qs, n2.y * qs, 0, false); w8 = __builtin_amdgcn_cvt_pk_fp8_f32(n2.z * qs, n2.w * qs, w8, true); u8.z = (unsigned)w8;
                    w8 = __builtin_amdgcn_cvt_pk_fp8_f32(n3.x * qs, n3.y * qs, 0, false); w8 = __builtin_amdgcn_cvt_pk_fp8_f32(n3.z * qs, n3.w * qs, w8, true); u8.w = (unsigned)w8;
                    *(v4u*)(ws + WS_U + (size_t)m * D + lane * 16) = u8;
                    if (lane == 0) ((float*)(ws + WS_U + U8IN_XS))[m] = am * (1.f / 384.f);
                } else { hp[0] = n0; hp[1] = n1; hp[2] = n2; hp[3] = n3; }
            }
    }
}

constexpr int PH_PER_HALF = 11, PH_PER_LAYER = 1 + 2 * PH_PER_HALF + 5, N_PHASES = 1 + DEPTH * PH_PER_LAYER;
__device__ __forceinline__ Ctx make_ctx() {
    extern __shared__ __attribute__((aligned(16))) unsigned char lds_raw[];
    Ctx c; int t = threadIdx.x; asm volatile("" : "+v"(t)); c.lds = (LAS unsigned char*)lds_raw; c.tid = t; c.lane = t & 63; c.wave = __builtin_amdgcn_readfirstlane(t >> 6); c.G = gridDim.x; c.bid = blockIdx.x; return c; }
__device__ __forceinline__ KArgs* kargs_fresh() { KArgs* p = (KArgs*)__builtin_amdgcn_kernarg_segment_ptr(); asm volatile("" : "+s"(p)); return p; }
#define PH_BEGIN(K) if (lo <= (K) && (K) < hi) { const Ctx c = make_ctx(); KArgs& args = *kargs_fresh(); unsigned char* ws = args.ws; (void)ws;
#define PH_END(K)   if ((K) + 1 < hi) xcd_barrier(bar); }

template <int L, int HB> __device__ __forceinline__ void half_pass(const XcdBarrier& bar, const int lo, const int hi) {
    constexpr int P0 = 1 + L * PH_PER_LAYER + 1 + HB * PH_PER_HALF;
#define WIN ((const bf16*)(ws + WS_WIN + L * WIN8_L))
#define KP 512
#define XSh ((const float*)(ws + WS_U + U8IN_XS) + (size_t)HB * MH)
#define WSC ((const float*)(ws + WS_CTL) + CW_WSC + L)
#define Uh ((const bf16*)(ws + WS_U) + (size_t)HB * MH * KP)
    PH_BEGIN(P0 + 0) {
        pg8::Gemm g{Uh, WIN, MH, N1P, KP, KP, 0}; pg8::StaticOrder S; S.init(MH, N1P, c.G, c.bid);
        pg8::EpiRow8<FStoreBf16S> E{{(bf16*)(ws + WS_OV + OV_PR), N1P, XSh, WSC}};
        pg8::gemm_phase(c.lds, g, S, E); if (PROBE_DUP == 5) pg8::gemm_phase(c.lds, g, S, E); } PH_END(P0 + 0)
    PH_BEGIN(P0 + 1) if (PROBE_DUP == 6) phase_rwkv_prep(c, args, L, HB); phase_rwkv_prep(c, args, L, HB); PH_END(P0 + 1)
    PH_BEGIN(P0 + 2) {
        constexpr int NL = L == 0 ? 3072 : 4096;
        pg8::Gemm g{(const bf16*)(ws + WS_OV + OV_AL), (const bf16*)(ws + WS_WLORA + L * WLORA_L), MH, NL, KL, KL, 1}; pg8::StaticOrder S; S.init(MH, NL, c.G, c.bid);
        EpiLora E{(bf16*)(ws + WS_OV + OV_ELOG), (bf16*)(ws + WS_OV + OV_ASIG), (bf16*)(ws + WS_OV + OV_GG), (bf16*)(ws + WS_OV + OV_VMIX),
                               (const bf16*)(ws + WS_VF) + (size_t)HB * MH * D, args.in[I_W0] + (size_t)L * D, args.in[I_A0] + (size_t)L * D, args.in[I_V0]};
        pg8::gemm_phase(c.lds, g, S, E); } PH_END(P0 + 2)
    PH_BEGIN(P0 + 3) phase_rwkv_chunk_par(c, args, L, HB); PH_END(P0 + 3)
    PH_BEGIN(P0 + 4) if (PROBE_DUP == 8) phase_rwkv_chunk_seq(c, args, false); phase_rwkv_chunk_seq(c, args); PH_END(P0 + 4)
    PH_BEGIN(P0 + 5) {
        phase_rwkv_post(c, args, L, HB); __syncthreads();
        pg8::Gemm g{Uh, WIN + (size_t)N1P * KP, MH, N2P, KP, KP, 0}; pg8::StaticOrder S; S.init(MH, N2P, c.G, c.bid);
        pg8::EpiRow8<FStoreBf16S> E{{(bf16*)(ws + WS_OV + OV_PS), N2P, XSh, WSC}};
        pg8::gemm_phase(c.lds, g, S, E); if (PROBE_DUP == 5) pg8::gemm_phase(c.lds, g, S, E); } PH_END(P0 + 5)
    PH_BEGIN(P0 + 6) if (PROBE_DUP == 6) phase_ssd_conv(c, args, L); phase_ssd_conv(c, args, L); PH_END(P0 + 6)
    PH_BEGIN(P0 + 7) phase_ssd_scan(c, args, L); PH_END(P0 + 7)
    PH_BEGIN(P0 + 8) phase_ssd_post(c, args, L); PH_END(P0 + 8)
    PH_BEGIN(P0 + 9) {
      { pg8::Gemm g{Uh, WIN + (size_t)(N1P + N2P) * KP, MH, D, KP, KP, 0}; pg8::StaticOrder S; S.init(MH, D, c.G, c.bid);
        pg8::EpiRow8<FSigmoidBf16S> E{{(bf16*)(ws + WS_OV + OV_GATES), 2048, XSh, WSC}};
        pg8::gemm_phase(c.lds, g, S, E); }
      { pg8::Gemm g{Uh, WIN + (size_t)(N1P + N2P + D) * KP, MH, D, KP, KP, 0}; pg8::StaticOrder S; S.init(MH, D, c.G, c.bid);
        pg8::EpiRow8<FSigmoidBf16S> E{{(bf16*)(ws + WS_OV + OV_GATES) + 1024, 2048, XSh, WSC}};
        pg8::gemm_phase(c.lds, g, S, E); }
      {
        pg8::Gemm g{(const bf16*)(ws + WS_OV + OV_YA), (const bf16*)(ws + WS_WA) + (size_t)L * D * D, MH, D, D, D, 0}; pg8::StaticOrder S; S.init(MH, D, c.G, c.bid);
        pg8::EpiRow8<FMixA> E{{(const bf16*)(ws + WS_OV + OV_GATES), (bf16*)(ws + WS_OV + OV_MIXED)}};
        pg8::gemm_phase(c.lds, g, S, E); }
      {
        pg8::Gemm g{(const bf16*)(ws + WS_OV + OV_PS) + 2048, (const bf16*)(ws + WS_WB) + (size_t)L * D * 2048, MH, D, 2048, N2P, 0}; pg8::StaticOrder S; S.init(MH, D, c.G, c.bid);
        pg8::EpiRow8<FMixB> E{{(const bf16*)(ws + WS_OV + OV_GATES), (bf16*)(ws + WS_OV + OV_MIXED)}};
        pg8::gemm_phase(c.lds, g, S, E); } } PH_END(P0 + 9)
    PH_BEGIN(P0 + 10) {
        pg8::Gemm g{(const bf16*)(ws + WS_OV + OV_MIXED), (const bf16*)(ws + WS_WO) + (size_t)L * D * D, MH, D, D, D, 0}; pg8::StaticOrder S; S.init(MH, D, c.G, c.bid);
        pg8::EpiRow8<FResid> E{{(L == 0 ? args.in[I_X] : (const float*)args.out) + (size_t)HB * MH * D, args.out + (size_t)HB * MH * D}};
        pg8::gemm_phase(c.lds, g, S, E); } PH_END(P0 + 10)
#undef WIN
#undef KP
#undef XSh
#undef WSC
#undef Uh
}

template <int L> __device__ __forceinline__ void layer_pass(const XcdBarrier& bar, const int lo, const int hi) {
    constexpr int P0 = 1 + L * PH_PER_LAYER, P1 = P0 + 1 + 2 * PH_PER_HALF;
    PH_BEGIN(P0) if (L == 0) phase_rmsnorm_q8(c, args.in[I_X], args.in[I_NMG], nullptr, ws + WS_U, (float*)(ws + WS_U + U8IN_XS)); PH_END(P0)
    half_pass<L, 0>(bar, lo, hi);
    half_pass<L, 1>(bar, lo, hi);
    PH_BEGIN(P1 + 0) phase_rmsnorm_q8(c, args.out, args.in[I_NFG] + (size_t)L * D, (bf16*)(ws + WS_U), ws + WS_OV + OV_U8, (float*)(ws + WS_OV + OV_XS)); phase_peer_convert(c, args, L); PH_END(P1 + 0)
    PH_BEGIN(P1 + 1) {
        pg8::Gemm g{(const bf16*)(ws + WS_U), (const bf16*)(ws + WS_WQK) + (size_t)L * 2048 * D, M, 2048, D, D, 0}; pg8::StaticOrder S; S.init(M, 2048, c.G, c.bid);
        pg8::EpiRow8<FStoreBf16> E{{(bf16*)(ws + WS_OV + OV_SC), 2048}};
        pg8::gemm_phase(c.lds, g, S, E); } PH_END(P1 + 1)
    PH_BEGIN(P1 + 2) if (PROBE_DUP == 4) phase_peer_topk(c, args); phase_peer_topk(c, args); PH_END(P1 + 2)
    PH_BEGIN(P1 + 3) phase_peer_down<0>(c, args, L, 0); if (PROBE_DOWN >= 0) phase_peer_down<PROBE_DOWN < 0 ? 0 : PROBE_DOWN>(c, args, L, 1); PH_END(P1 + 3)
    PH_BEGIN(P1 + 4) phase_peer_experts<L == DEPTH - 1 ? 1 : 0>(c, args, L == DEPTH - 1 ? args.in[I_NFIN] : args.in[I_NMG] + (size_t)(L + 1) * D); PH_END(P1 + 4)
}

__global__ void __launch_bounds__(512, 2) mk_fwd(Args kargs_) {
    extern __shared__ __attribute__((aligned(16))) unsigned char lds_raw[];
    LAS unsigned char* lds0 = (LAS unsigned char*)lds_raw;
    unsigned char* ws0 = kargs_.ws;
    const int lo = kargs_.lo, hi = kargs_.hi;
    if (threadIdx.x < 4) ((LAS unsigned*)(lds0 + LDS_MISC))[threadIdx.x] = 0u;
    __syncthreads();
    XcdBarrier bar; bar.bar = (unsigned*)(ws0 + WS_CTL) + CW_BAR; bar.x = 0; bar.st = (volatile LAS unsigned*)(lds0 + LDS_MISC);
    if (hi - lo > 1) bar = xcd_barrier_post((unsigned*)(ws0 + WS_CTL) + CW_BAR, (volatile LAS unsigned*)(lds0 + LDS_MISC));
    PH_BEGIN(0) phase_winmax(c, args); if (hi - lo > 1) xcd_barrier(bar); phase_prologue(c, args); PH_END(0)
    layer_pass<0>(bar, lo, hi);
    layer_pass<1>(bar, lo, hi);
}

extern "C" void kernel_launch(void* const* d_in, const int* in_sizes, int n_in, void* d_out, int out_size, void* d_ws, size_t ws_size, hipStream_t stream) {
    static int grid = 0;
    if (grid == 0) {
        if (n_in != 32 || out_size != M * D || ws_size < WS_END) { fprintf(stderr, "kernel_launch: unexpected problem (n_in %d, out %d, ws %zu < %zu)\n", n_in, out_size, ws_size, (size_t)WS_END); grid = -1; return; }
        int dev = 0, cus = 0, per_cu = 0;
        if (hipGetDevice(&dev) != hipSuccess || hipDeviceGetAttribute(&cus, hipDeviceAttributeMultiprocessorCount, dev) != hipSuccess) { grid = -1; return; }
        if (hipFuncSetAttribute((const void*)mk_fwd, hipFuncAttributeMaxDynamicSharedMemorySize, LDS_BYTES) != hipSuccess) { fprintf(stderr, "kernel_launch: hipFuncSetAttribute failed\n"); grid = -1; return; }
        if (hipOccupancyMaxActiveBlocksPerMultiprocessor(&per_cu, (const void*)mk_fwd, 512, LDS_BYTES) != hipSuccess || per_cu < 1) { fprintf(stderr, "kernel_launch: occupancy query says %d\n", per_cu); per_cu = 1; }
        (void)hipGetLastError();
        grid = cus;
    }
    if (grid < 0) return;
    (void)hipMemsetAsync((char*)d_ws + WS_CTL, 0, CTL_BYTES, stream);
    Args a{};
    for (int i = 0; i < 32; ++i) a.in[i] = (const float*)d_in[i];
    a.out = (float*)d_out; a.ws = (unsigned char*)d_ws;
#if MK_MULTI
    for (int p = 0; p < N_PHASES; ++p) { a.lo = p; a.hi = p + 1; hipLaunchKernelGGL(mk_fwd, dim3(grid), dim3(512), LDS_BYTES, stream, a); }
#else
    a.lo = 0; a.hi = N_PHASES;
    hipLaunchKernelGGL(mk_fwd, dim3(grid), dim3(512), LDS_BYTES, stream, a);
#endif
}
```
